# Optimizing an MI355X kernel written in HIP

```python
import math
import jax, jax.numpy as jnp
from jax import lax
import numpy as np

D_MODEL = 1024
BATCH = 8
SEQ = 4096
DEPTH = 2

PLE_DIM = 256
D_FF = 2816
RMS_EPS = 1e-6
N_NORMS = 8

A_GROUPS = 4
A_WIDTH = 256
A_GROUP_DIM = A_WIDTH // A_GROUPS
A_CHUNK = 128

B_GROUPS = 4
B_WIDTH = 256
B_GROUP_DIM = B_WIDTH // B_GROUPS
CONV_W = 4
LRU_C = 8.0

C_HEADS = 8
C_KV_GROUPS = 2
C_HPG = C_HEADS // C_KV_GROUPS
HEAD_DIM = 64
C_WIDTH = C_HEADS * HEAD_DIM
KV_W = C_KV_GROUPS * HEAD_DIM
CMP_LEN = 32
CMP_STRIDE = 16
CMP_HIDDEN = 128
SEL_LEN = 64
SEL_TOP = 16
WINDOW = 512
Q_BLOCK = 64
FORCE_SCORE = 1e4
NEG = -1e30

N_BUCKETS = 32
MAX_DISTANCE = 1024

D_MIX = A_WIDTH + B_WIDTH + C_WIDTH
IN_SPLITS = (A_WIDTH, A_WIDTH, B_WIDTH, B_WIDTH, C_WIDTH, KV_W, KV_W, KV_W, KV_W, KV_W, KV_W, C_HEADS, C_HEADS, C_HEADS)
N_IN = 2 * A_WIDTH + 2 * B_WIDTH + C_WIDTH + 6 * KV_W + 3 * C_HEADS

kernel_name = "hymba_style_gmlp_rglru_nsa_hybrid"


def rmsnorm(x, g):
    xf = x.astype(jnp.float32)
    y = xf * lax.rsqrt(jnp.mean(xf * xf, axis=-1, keepdims=True) + RMS_EPS)
    return (y * g.astype(jnp.float32)).astype(x.dtype)


def swiglu(x, wg, wu, wd):
    return (jax.nn.silu(x @ wg) * (x @ wu)) @ wd


def t5_bucket(dist):
    n = jnp.maximum(dist, 0)
    max_exact = N_BUCKETS // 2
    nf = jnp.maximum(n, max_exact).astype(jnp.float32)
    large = max_exact + (jnp.log(nf / max_exact) / math.log(MAX_DISTANCE / max_exact)
                         * (N_BUCKETS - max_exact)).astype(jnp.int32)
    large = jnp.minimum(large, N_BUCKETS - 1)
    return jnp.where(n < max_exact, n, large)


def spatial_gating(u, v, norm_g, w_s, b_s):
    bn, s, _ = u.shape
    nc = s // A_CHUNK
    v = rmsnorm(v, norm_g).reshape(bn, nc, A_CHUNK, A_GROUPS, A_GROUP_DIM)
    w = jnp.where(jnp.tril(jnp.ones((A_CHUNK, A_CHUNK), bool)), w_s, 0)
    mixed = jnp.einsum('gts,bcsgd->bctgd', w, v) + b_s.T[None, None, :, :, None]
    return u * mixed.reshape(bn, s, A_WIDTH)


def rg_lru_block(xb, gate, conv_w, conv_b, wa, ba, wx, bx, lam):
    bn, s, w = xb.shape
    xp = jnp.pad(xb, ((0, 0), (CONV_W - 1, 0), (0, 0)))
    xc = sum(xp[:, k:k + s] * conv_w[k] for k in range(CONV_W)) + conv_b
    xg = xc.reshape(bn, s, B_GROUPS, B_GROUP_DIM)
    r = jax.nn.sigmoid(jnp.einsum('bsgi,gij->bsgj', xg, wa).reshape(bn, s, w) + ba)
    i = jax.nn.sigmoid(jnp.einsum('bsgi,gij->bsgj', xg, wx).reshape(bn, s, w) + bx)
    log_a = -LRU_C * r.astype(jnp.float32) * jax.nn.softplus(-lam.astype(jnp.float32))
    a = jnp.exp(log_a)
    b_in = jnp.sqrt(-jnp.expm1(2.0 * log_a)) * (i * xc).astype(jnp.float32)

    def combine(left, right):
        a1, b1 = left
        a2, b2 = right
        return a1 * a2, a2 * b1 + b2

    _, hs = lax.associative_scan(combine, (a, b_in), axis=1)
    return hs.astype(xb.dtype) * jax.nn.gelu(gate)


def compress(k, pos, w1, b1, w2, b2):
    bn, s, g, d = k.shape
    n_cmp = (s - CMP_LEN) // CMP_STRIDE + 1
    idx = jnp.arange(n_cmp)[:, None] * CMP_STRIDE + jnp.arange(CMP_LEN)[None, :]
    blk = k[:, idx] + pos[None, None, :, None, :]
    blk = jnp.moveaxis(blk, 3, 2).reshape(bn, n_cmp, g, CMP_LEN * d)
    return jax.nn.gelu(blk @ w1 + b1) @ w2 + b2


def nsa(q, kc_raw, vc_raw, ks, vs, kw, vw, gc, gs, gw, rel_bias, cmp_pos, cmp_w1, cmp_b1, cmp_w2, cmp_b2):
    bn, s = q.shape[:2]
    G, R, D = C_KV_GROUPS, C_HPG, HEAD_DIM
    n_cmp = (s - CMP_LEN) // CMP_STRIDE + 1
    n_sel = s // SEL_LEN
    top = min(SEL_TOP, n_sel)
    nq = s // Q_BLOCK
    scale = HEAD_DIM ** -0.5

    kc = compress(kc_raw, cmp_pos[0], cmp_w1[0], cmp_b1[0], cmp_w2[0], cmp_b2[0])
    vc = compress(vc_raw, cmp_pos[1], cmp_w1[1], cmp_b1[1], cmp_w2[1], cmp_b2[1])
    cs = jnp.arange(n_cmp) * CMP_STRIDE
    cmp_end = cs + CMP_LEN - 1
    ss = jnp.arange(n_sel) * SEL_LEN
    overlap = jnp.clip(jnp.minimum(cs[:, None] + CMP_LEN, ss[None] + SEL_LEN)
                       - jnp.maximum(cs[:, None], ss[None]), 0, None).astype(jnp.float32) / CMP_LEN
    ks_blk = ks.reshape(bn, n_sel, SEL_LEN, G, D).transpose(0, 3, 1, 2, 4)
    vs_blk = vs.reshape(bn, n_sel, SEL_LEN, G, D).transpose(0, 3, 1, 2, 4)
    kw_pad = jnp.pad(kw, ((0, 0), (WINDOW, 0), (0, 0), (0, 0)))
    vw_pad = jnp.pad(vw, ((0, 0), (WINDOW, 0), (0, 0), (0, 0)))
    rb_heads = rel_bias.astype(jnp.float32).reshape(N_BUCKETS, G, R)
    rb_grp = rb_heads.transpose(1, 0, 2)
    bi = jnp.arange(bn)[:, None, None, None]
    gi = jnp.arange(G)[None, None, :, None]
    gi5 = jnp.arange(G)[None, None, :, None, None]
    j_sel = jnp.arange(n_sel)

    def block_fn(args):
        c, qc = args
        t = c * Q_BLOCK + jnp.arange(Q_BLOCK)
        d_c = t[:, None] - cmp_end[None]
        ok_c = d_c >= 0
        lg = (jnp.einsum('btgrd,bngd->bgrtn', qc, kc).astype(jnp.float32) * scale
              + rb_heads[t5_bucket(d_c)].transpose(2, 3, 0, 1))
        p_c = jax.nn.softmax(jnp.where(ok_c, lg, NEG), axis=-1) * ok_c
        o_c = jnp.einsum('bgrtn,bngd->btgrd', p_c.astype(vc.dtype), vc)
        imp = jnp.einsum('bgrtn,nj->btgj', p_c, overlap)
        blk_t = (t // SEL_LEN)[None, :, None, None]
        forced = (j_sel == 0) | (j_sel == blk_t) | (j_sel == blk_t - 1)
        score = jnp.where(j_sel <= blk_t, jnp.where(forced, FORCE_SCORE, imp), -1.0)
        top_v, top_i = lax.top_k(score, top)
        kg = ks_blk[bi, gi, top_i]
        vg = vs_blk[bi, gi, top_i]
        tok = top_i[..., None] * SEL_LEN + jnp.arange(SEL_LEN)
        d_s = t[None, :, None, None, None] - tok
        ok_s = (d_s >= 0) & (top_v >= 0.0)[..., None]
        bias_s = jnp.moveaxis(rb_grp[gi5, t5_bucket(d_s)], -1, 3)
        lg = jnp.einsum('btgrd,btgkld->btgrkl', qc, kg).astype(jnp.float32) * scale + bias_s
        lg = jnp.where(ok_s[:, :, :, None], lg, NEG)
        p_s = jax.nn.softmax(lg.reshape(bn, Q_BLOCK, G, R, top * SEL_LEN), axis=-1).reshape(lg.shape)
        o_s = jnp.einsum('btgrkl,btgkld->btgrd', p_s.astype(vg.dtype), vg)
        kwc = lax.dynamic_slice_in_dim(kw_pad, c * Q_BLOCK, Q_BLOCK + WINDOW, axis=1)
        vwc = lax.dynamic_slice_in_dim(vw_pad, c * Q_BLOCK, Q_BLOCK + WINDOW, axis=1)
        spos = c * Q_BLOCK - WINDOW + jnp.arange(Q_BLOCK + WINDOW)
        d_w = t[:, None] - spos[None]
        ok_w = (d_w >= 0) & (d_w < WINDOW) & (spos[None] >= 0)
        lg = (jnp.einsum('btgrd,bsgd->bgrts', qc, kwc).astype(jnp.float32) * scale
              + rb_heads[t5_bucket(d_w)].transpose(2, 3, 0, 1))
        p_w = jax.nn.softmax(jnp.where(ok_w, lg, NEG), axis=-1)
        o_w = jnp.einsum('bgrts,bsgd->btgrd', p_w.astype(vwc.dtype), vwc)
        return o_c, o_s, o_w

    q_blocks = jnp.moveaxis(q.reshape(bn, nq, Q_BLOCK, G, R, D), 1, 0)
    o_c, o_s, o_w = lax.map(block_fn, (jnp.arange(nq), q_blocks))

    def unblock(o):
        return jnp.moveaxis(o, 0, 1).reshape(bn, s, C_HEADS, D)

    out = (jax.nn.sigmoid(gc)[..., None] * unblock(o_c)
           + jax.nn.sigmoid(gs)[..., None] * unblock(o_s)
           + jax.nn.sigmoid(gw)[..., None] * unblock(o_w))
    return out.reshape(bn, s, C_WIDTH)


def setup_inputs(seed: int = 0) -> dict:
    key = jax.random.key(seed)
    ks = jax.random.split(key, 26)
    L = DEPTH

    def nrm(k, shape, scale):
        return jax.random.normal(k, shape, jnp.float32) * scale

    lam_u = jax.random.uniform(ks[17], (L, B_WIDTH), jnp.float32, 0.9, 0.999)
    lam_s = lam_u ** (1.0 / LRU_C)
    return {
        "x": nrm(ks[0], (BATCH, SEQ, D_MODEL), 1.0),
        "p": nrm(ks[1], (L, BATCH, SEQ, PLE_DIM), 1.0),
        "rel_bias": nrm(ks[2], (N_BUCKETS, C_HEADS), 0.2),
        "norm_g": 1.0 + nrm(ks[3], (L, N_NORMS, D_MODEL), 0.05),
        "ffn_w_gate": nrm(ks[4], (L, 2, D_MODEL, D_FF), D_MODEL ** -0.5),
        "ffn_w_up": nrm(ks[5], (L, 2, D_MODEL, D_FF), D_MODEL ** -0.5),
        "ffn_w_down": nrm(ks[6], (L, 2, D_FF, D_MODEL), D_FF ** -0.5),
        "w_in": nrm(ks[7], (L, D_MODEL, N_IN), D_MODEL ** -0.5),
        "w_out": nrm(ks[8], (L, D_MIX, D_MODEL), D_MIX ** -0.5),
        "sgu_norm_g": 1.0 + nrm(ks[9], (L, A_WIDTH), 0.05),
        "sgu_w": nrm(ks[10], (L, A_GROUPS, A_CHUNK, A_CHUNK), A_CHUNK ** -0.5),
        "sgu_b": 1.0 + nrm(ks[11], (L, A_GROUPS, A_CHUNK), 0.1),
        "conv_w": nrm(ks[12], (L, CONV_W, B_WIDTH), CONV_W ** -0.5),
        "conv_b": nrm(ks[13], (L, B_WIDTH), 0.01),
        "lru_wa": nrm(ks[14], (L, B_GROUPS, B_GROUP_DIM, B_GROUP_DIM), B_GROUP_DIM ** -0.5),
        "lru_ba": nrm(ks[15], (L, B_WIDTH), 0.01),
        "lru_wx": nrm(ks[16], (L, B_GROUPS, B_GROUP_DIM, B_GROUP_DIM), B_GROUP_DIM ** -0.5),
        "lru_bx": nrm(ks[18], (L, B_WIDTH), 0.01),
        "lru_lambda": jnp.log(lam_s) - jnp.log1p(-lam_s),
        "cmp_pos": nrm(ks[19], (L, 2, CMP_LEN, HEAD_DIM), 0.02),
        "cmp_w1": nrm(ks[20], (L, 2, CMP_LEN * HEAD_DIM, CMP_HIDDEN), (CMP_LEN * HEAD_DIM) ** -0.5),
        "cmp_b1": nrm(ks[21], (L, 2, CMP_HIDDEN), 0.01),
        "cmp_w2": nrm(ks[22], (L, 2, CMP_HIDDEN, HEAD_DIM), CMP_HIDDEN ** -0.5),
        "cmp_b2": nrm(ks[23], (L, 2, HEAD_DIM), 0.01),
        "ple_w_gate": nrm(ks[24], (L, D_MODEL, D_MODEL), D_MODEL ** -0.5),
        "ple_w_proj": nrm(ks[25], (L, PLE_DIM, D_MODEL), PLE_DIM ** -0.5),
    }


def reference(x, p, rel_bias, norm_g, ffn_w_gate, ffn_w_up, ffn_w_down, w_in, w_out,
              sgu_norm_g, sgu_w, sgu_b, conv_w, conv_b, lru_wa, lru_ba, lru_wx, lru_bx, lru_lambda,
              cmp_pos, cmp_w1, cmp_b1, cmp_w2, cmp_b2, ple_w_gate, ple_w_proj):
    bn, s, _ = x.shape
    split_points = np.cumsum(IN_SPLITS)[:-1].tolist()
    h = x
    for i in range(DEPTH):
        g = norm_g[i]
        f = swiglu(rmsnorm(h, g[0]), ffn_w_gate[i, 0], ffn_w_up[i, 0], ffn_w_down[i, 0])
        h = h + 0.5 * rmsnorm(f, g[1])
        z = rmsnorm(h, g[2]) @ w_in[i]
        (a_u, a_v, b_x, b_gate, c_q, c_kc, c_vc, c_ks, c_vs, c_kw, c_vw,
         c_gc, c_gs, c_gw) = jnp.split(z, split_points, axis=-1)
        y_a = spatial_gating(jax.nn.gelu(a_u), jax.nn.gelu(a_v), sgu_norm_g[i], sgu_w[i], sgu_b[i])
        y_b = rg_lru_block(b_x, b_gate, conv_w[i], conv_b[i], lru_wa[i], lru_ba[i],
                           lru_wx[i], lru_bx[i], lru_lambda[i])
        kv = [t.reshape(bn, s, C_KV_GROUPS, HEAD_DIM) for t in (c_kc, c_vc, c_ks, c_vs, c_kw, c_vw)]
        y_c = nsa(c_q.reshape(bn, s, C_KV_GROUPS, C_HPG, HEAD_DIM), kv[0], kv[1], kv[2], kv[3], kv[4], kv[5],
                  c_gc, c_gs, c_gw, rel_bias, cmp_pos[i], cmp_w1[i], cmp_b1[i], cmp_w2[i], cmp_b2[i])
        mix = jnp.concatenate([y_a, y_b, y_c], axis=-1) @ w_out[i]
        h = h + rmsnorm(mix, g[3])
        f = swiglu(rmsnorm(h, g[4]), ffn_w_gate[i, 1], ffn_w_up[i, 1], ffn_w_down[i, 1])
        h = h + 0.5 * rmsnorm(f, g[5])
        gate = jax.nn.sigmoid(rmsnorm(h, g[6]) @ ple_w_gate[i])
        h = h + rmsnorm(gate * (p[i] @ ple_w_proj[i]), g[7])
    return h
```

```cpp
#include <hip/hip_runtime.h>
#include <hip/hip_cooperative_groups.h>
#include <cstdint>
#include <cstdio>
namespace cg = cooperative_groups;

#ifndef MK_FUSED
#define MK_FUSED 0
#endif

typedef unsigned short bf16_t;
typedef short bf16x8 __attribute__((ext_vector_type(8)));
typedef short bf16x4 __attribute__((ext_vector_type(4)));
typedef float f32x4 __attribute__((ext_vector_type(4)));
typedef unsigned long long u64;
typedef unsigned u32x4 __attribute__((ext_vector_type(4)));
typedef unsigned u32x2 __attribute__((ext_vector_type(2)));

constexpr int M_TOK = 32768, DM = 1024, DFF = 2816, NGU = 5632, NIN = 2328, LDZ = 2432, SEQ = 4096;
constexpr int NPHASE = 27;
constexpr int ZC_AU = 0, ZC_AV = 256, ZC_BX = 512, ZC_BG = 768, ZC_Q = 1024, ZC_KC = 1536, ZC_VC = 1664, ZC_KS = 1792, ZC_VS = 1920,
              ZC_KW = 2048, ZC_VW = 2176, ZC_GC = 2304, ZC_GS = 2312, ZC_GW = 2320;

constexpr size_t SZ_WGU = (size_t)NGU * 1024 * 2, SZ_WD = (size_t)1024 * DFF * 2, SZ_WIN = (size_t)LDZ * 1024 * 2, SZ_SQ = (size_t)1024 * 1024 * 2,
                 SZ_WPP = (size_t)1024 * 256 * 2, SZ_CW1 = (size_t)128 * 2048 * 2;
constexpr size_t OFF_WGU = 0;
constexpr size_t OFF_WD = OFF_WGU + 4 * SZ_WGU;
constexpr size_t OFF_WIN = OFF_WD + 4 * SZ_WD;
constexpr size_t OFF_WOUT = OFF_WIN + 2 * SZ_WIN;
constexpr size_t OFF_WPG = OFF_WOUT + 2 * SZ_SQ;
constexpr size_t OFF_WPP = OFF_WPG + 2 * SZ_SQ;
constexpr size_t OFF_CW1 = OFF_WPP + 2 * SZ_WPP;
constexpr size_t OFF_CB1 = OFF_CW1 + 4 * SZ_CW1;
constexpr size_t OFF_SGUW = OFF_CB1 + 4096;
constexpr size_t OFF_WAT = OFF_SGUW + 2 * 4 * 128 * 128 * 2;
constexpr size_t OFF_WXT = OFF_WAT + 2 * 4 * 64 * 64 * 2;
constexpr size_t OFF_PBF = OFF_WXT + 2 * 4 * 64 * 64 * 2;
constexpr size_t OFF_A = OFF_PBF + (size_t)2 * M_TOK * 256 * 2;
constexpr size_t OFF_BIG = OFF_A + (size_t)M_TOK * 1024 * 2;
constexpr size_t OFF_F = OFF_BIG + (size_t)M_TOK * DFF * 2;
constexpr size_t OFF_KC = OFF_F + (size_t)M_TOK * 1024 * 4;
constexpr size_t OFF_CARRY = OFF_KC + (size_t)2 * 8 * 2 * 256 * 64 * 2;
constexpr size_t WS_NEED = OFF_CARRY + (size_t)2 * 8 * 4 * 64 * 64 * 4;

struct Params {
  const float *x, *p, *rel_bias, *norm_g, *ffn_wg, *ffn_wu, *ffn_wd, *w_in, *w_out, *sgu_ng, *sgu_w, *sgu_b, *conv_w, *conv_b,
      *lru_wa, *lru_ba, *lru_wx, *lru_bx, *lru_lam, *cmp_pos, *cmp_w1, *cmp_b1, *cmp_w2, *cmp_b2, *ple_wg, *ple_wp;
  float* out;
  char* ws;
};

__device__ __forceinline__ int opaque_tid() { int t; asm volatile("v_mov_b32 %0, %1" : "=v"(t) : "v"(threadIdx.x)); return t; }
#define TIDX opaque_tid()
__device__ __forceinline__ float bf2f(bf16_t v) { return __uint_as_float(((unsigned)v) << 16); }
__device__ __forceinline__ bf16_t f2bf(float f) { unsigned u = __float_as_uint(f); u += 0x7fffu + ((u >> 16) & 1u); return (bf16_t)(u >> 16); }
__device__ __forceinline__ unsigned pk2(float lo, float hi) { return (unsigned)f2bf(lo) | ((unsigned)f2bf(hi) << 16); }
__device__ __forceinline__ float sigm(float x) { return 1.f / (1.f + __expf(-x)); }
__device__ __forceinline__ float gelu_t(float x) { float u = 0.7978845608028654f * (x + 0.044715f * x * x * x); return x / (1.f + __expf(-2.f * u)); }
__device__ __forceinline__ float silu_f(float x) { return x / (1.f + __expf(-x)); }
__device__ __forceinline__ f32x4 mfma16(bf16x8 a, bf16x8 b, f32x4 c) { return __builtin_amdgcn_mfma_f32_16x16x32_bf16(a, b, c, 0, 0, 0); }
__device__ __forceinline__ void glds16(const void* g, void* l) {
  __builtin_amdgcn_global_load_lds((const __attribute__((address_space(1))) unsigned*)g, (__attribute__((address_space(3))) unsigned*)l, 16, 0, 0);
}
__device__ __forceinline__ float wave_sum(float v) {
#pragma unroll
  for (int o = 32; o > 0; o >>= 1) v += __shfl_xor(v, o);
  return v;
}
__device__ __forceinline__ void unpack8(const u32x4 u, float* f) {
  f[0] = __uint_as_float(u.x << 16); f[1] = __uint_as_float(u.x & 0xffff0000u);
  f[2] = __uint_as_float(u.y << 16); f[3] = __uint_as_float(u.y & 0xffff0000u);
  f[4] = __uint_as_float(u.z << 16); f[5] = __uint_as_float(u.z & 0xffff0000u);
  f[6] = __uint_as_float(u.w << 16); f[7] = __uint_as_float(u.w & 0xffff0000u);
}

__device__ __forceinline__ void tr_cvt_tile(const float* __restrict__ src, int N, int K, bf16_t* __restrict__ dst, int ldd, int rs, int ro, int tile, float* lds) {
  const int ntn = (N + 63) >> 6, tk = tile / ntn, tn = tile - tk * ntn, k0 = tk * 64, n0 = tn * 64, tid = TIDX;
#pragma unroll
  for (int ps = 0; ps < 4; ++ps) {
    const int i = ps * 16 + (tid >> 4), j = (tid & 15) * 4;
    float4 v = make_float4(0.f, 0.f, 0.f, 0.f);
    if (n0 + j < N) v = *(const float4*)(src + (size_t)(k0 + i) * N + n0 + j);
    float* d = lds + i * 65 + j; d[0] = v.x; d[1] = v.y; d[2] = v.z; d[3] = v.w;
  }
  __syncthreads();
  const int j = tid >> 2, kq = tid & 3, n = n0 + j;
  if (n < N) {
    unsigned w[8];
#pragma unroll
    for (int q = 0; q < 8; ++q) w[q] = pk2(lds[(kq * 16 + 2 * q) * 65 + j], lds[(kq * 16 + 2 * q + 1) * 65 + j]);
    bf16_t* o = dst + (size_t)((n >> 4) * rs + (n & 15) + ro) * ldd + k0 + kq * 16;
    *(uint4*)o = make_uint4(w[0], w[1], w[2], w[3]);
    *(uint4*)(o + 8) = make_uint4(w[4], w[5], w[6], w[7]);
  }
  __syncthreads();
}
__device__ __forceinline__ void tr_cvt(const float* src, int N, int K, bf16_t* dst, int ldd, int rs, int ro, float* lds) {
  const int nt = ((N + 63) >> 6) * (K >> 6);
  for (int t = blockIdx.x; t < nt; t += gridDim.x) tr_cvt_tile(src, N, K, dst, ldd, rs, ro, t, lds);
}

__device__ __forceinline__ void resnorm_phase(const float* hin, float* hout, const float* f, float scale, const float* gpost, const float* gpre, bf16_t* a) {
  const int lane = TIDX & 63;
  for (int row = blockIdx.x * 4 + (TIDX >> 6); row < M_TOK; row += gridDim.x * 4) {
    float4 hv[4];
#pragma unroll
    for (int i = 0; i < 4; ++i) hv[i] = *(const float4*)(hin + (size_t)row * 1024 + i * 256 + lane * 4);
    if (f) {
      float4 fv[4]; float ss = 0.f;
#pragma unroll
      for (int i = 0; i < 4; ++i) { fv[i] = *(const float4*)(f + (size_t)row * 1024 + i * 256 + lane * 4); ss += fv[i].x * fv[i].x + fv[i].y * fv[i].y + fv[i].z * fv[i].z + fv[i].w * fv[i].w; }
      ss = wave_sum(ss);
      const float r = rsqrtf(ss * (1.f / 1024.f) + 1e-6f) * scale;
#pragma unroll
      for (int i = 0; i < 4; ++i) { const float4 g = *(const float4*)(gpost + i * 256 + lane * 4);
        hv[i].x += fv[i].x * r * g.x; hv[i].y += fv[i].y * r * g.y; hv[i].z += fv[i].z * r * g.z; hv[i].w += fv[i].w * r * g.w; }
    }
#pragma unroll
    for (int i = 0; i < 4; ++i) *(float4*)(hout + (size_t)row * 1024 + i * 256 + lane * 4) = hv[i];
    if (a) {
      float ss = 0.f;
#pragma unroll
      for (int i = 0; i < 4; ++i) ss += hv[i].x * hv[i].x + hv[i].y * hv[i].y + hv[i].z * hv[i].z + hv[i].w * hv[i].w;
      ss = wave_sum(ss);
      const float r = rsqrtf(ss * (1.f / 1024.f) + 1e-6f);
#pragma unroll
      for (int i = 0; i < 4; ++i) { const float4 g = *(const float4*)(gpre + i * 256 + lane * 4);
        uint2 o; o.x = pk2(hv[i].x * r * g.x, hv[i].y * r * g.y); o.y = pk2(hv[i].z * r * g.z, hv[i].w * r * g.w);
        *(uint2*)(a + (size_t)row * 1024 + i * 256 + lane * 4) = o; }
    }
  }
}

__device__ __forceinline__ void prep_phase(const Params& P, char* ldsc) {
  float* lds = (float*)ldsc;
  char* ws = P.ws;
  for (int l = 0; l < 2; ++l) {
    for (int j = 0; j < 2; ++j) {
      const int lj = l * 2 + j;
      bf16_t* wgu = (bf16_t*)(ws + OFF_WGU + lj * SZ_WGU);
      tr_cvt(P.ffn_wg + (size_t)lj * 1024 * DFF, DFF, 1024, wgu, 1024, 32, 0, lds);
      tr_cvt(P.ffn_wu + (size_t)lj * 1024 * DFF, DFF, 1024, wgu, 1024, 32, 16, lds);
      tr_cvt(P.ffn_wd + (size_t)lj * DFF * 1024, 1024, DFF, (bf16_t*)(ws + OFF_WD + lj * SZ_WD), DFF, 16, 0, lds);
      tr_cvt(P.cmp_w1 + (size_t)lj * 2048 * 128, 128, 2048, (bf16_t*)(ws + OFF_CW1 + lj * SZ_CW1), 2048, 16, 0, lds);
    }
    tr_cvt(P.w_in + (size_t)l * 1024 * NIN, NIN, 1024, (bf16_t*)(ws + OFF_WIN + l * SZ_WIN), 1024, 16, 0, lds);
    tr_cvt(P.w_out + (size_t)l * 1024 * 1024, 1024, 1024, (bf16_t*)(ws + OFF_WOUT + l * SZ_SQ), 1024, 16, 0, lds);
    tr_cvt(P.ple_wg + (size_t)l * 1024 * 1024, 1024, 1024, (bf16_t*)(ws + OFF_WPG + l * SZ_SQ), 1024, 16, 0, lds);
    tr_cvt(P.ple_wp + (size_t)l * 256 * 1024, 1024, 256, (bf16_t*)(ws + OFF_WPP + l * SZ_WPP), 256, 16, 0, lds);
    for (int g = 0; g < 4; ++g) {
      tr_cvt(P.lru_wa + (size_t)(l * 4 + g) * 4096, 64, 64, (bf16_t*)(ws + OFF_WAT) + (l * 4 + g) * 4096, 64, 16, 0, lds);
      tr_cvt(P.lru_wx + (size_t)(l * 4 + g) * 4096, 64, 64, (bf16_t*)(ws + OFF_WXT) + (l * 4 + g) * 4096, 64, 16, 0, lds);
    }
  }
  const int gtid = blockIdx.x * 256 + TIDX, gn = gridDim.x * 256;
  for (int i = gtid; i < 2 * (LDZ - NIN) * 1024 / 8; i += gn) {
    const int l = i / ((LDZ - NIN) * 128), r = i - l * ((LDZ - NIN) * 128);
    *(uint4*)((bf16_t*)(ws + OFF_WIN + l * SZ_WIN) + (size_t)NIN * 1024 + (size_t)r * 8) = make_uint4(0, 0, 0, 0);
  }
  for (int i = gtid; i < 2 * 4 * 128 * 128; i += gn) { const int t = (i >> 7) & 127, s = i & 127; ((bf16_t*)(ws + OFF_SGUW))[i] = (s <= t) ? f2bf(P.sgu_w[i]) : (bf16_t)0; }
  for (int i = gtid; i < 2 * M_TOK * 256 / 4; i += gn) { const float4 v = ((const float4*)P.p)[i]; uint2 o; o.x = pk2(v.x, v.y); o.y = pk2(v.z, v.w); ((uint2*)(ws + OFF_PBF))[i] = o; }
  for (int u = blockIdx.x; u < 4; u += gridDim.x) {
    const int tid = TIDX, kq = tid >> 5, jq = tid & 31;
    const float* w1 = P.cmp_w1 + (size_t)u * 2048 * 128; const float* pos = P.cmp_pos + (size_t)u * 2048;
    float4 s = make_float4(0.f, 0.f, 0.f, 0.f);
    for (int k = kq * 256; k < kq * 256 + 256; ++k) { const float pv = pos[k]; const float4 w = *(const float4*)(w1 + (size_t)k * 128 + jq * 4); s.x += pv * w.x; s.y += pv * w.y; s.z += pv * w.z; s.w += pv * w.w; }
    __syncthreads();
    lds[kq * 128 + jq * 4 + 0] = s.x; lds[kq * 128 + jq * 4 + 1] = s.y; lds[kq * 128 + jq * 4 + 2] = s.z; lds[kq * 128 + jq * 4 + 3] = s.w;
    __syncthreads();
    if (tid < 128) { float t = P.cmp_b1[u * 128 + tid]; for (int q = 0; q < 8; ++q) t += lds[q * 128 + tid]; ((float*)(ws + OFF_CB1))[u * 128 + tid] = t; }
    __syncthreads();
  }
  resnorm_phase(P.x, P.out, nullptr, 0.f, nullptr, P.norm_g, (bf16_t*)(ws + OFF_A));
}

__device__ __forceinline__ void gemm_core(f32x4 (&acc)[4][4], const bf16_t* __restrict__ A, int lda, const bf16_t* __restrict__ Bt, int ldb, int K, char* lds) {
  const int tid = TIDX, lane = tid & 63, wid = tid >> 6, wr = wid >> 1, wc = wid & 1, fr = lane & 15, fq = lane >> 4;
  const int nk = K >> 6;
  const int rb = tid >> 3, csw = ((tid & 7) ^ (rb & 7)) * 8;
  const bf16_t* ga = A + (size_t)rb * lda + csw;
  const bf16_t* gb = Bt + (size_t)rb * ldb + csw;
  char* lw = lds + tid * 16;
#define GEMM_STAGE(kt, b)                                                                                              \
  {                                                                                                                    \
    _Pragma("unroll") for (int i = 0; i < 4; ++i) {                                                                    \
      glds16(ga + (size_t)(i * 32) * lda + (kt) * 64, lw + (b) * 32768 + i * 4096);                                    \
      glds16(gb + (size_t)(i * 32) * ldb + (kt) * 64, lw + (b) * 32768 + 16384 + i * 4096);                            \
    }                                                                                                                  \
  }
  GEMM_STAGE(0, 0);
#pragma nounroll
  for (int kt = 0; kt < nk; ++kt) {
    asm volatile("s_waitcnt vmcnt(0)" ::: "memory");
    __syncthreads();
    if (kt + 1 < nk) GEMM_STAGE(kt + 1, (kt + 1) & 1);
    const char* la = lds + (kt & 1) * 32768 + (wr * 64 + fr) * 128;
    const char* lb = lds + (kt & 1) * 32768 + 16384 + (wc * 64 + fr) * 128;
#pragma unroll
    for (int ks = 0; ks < 2; ++ks) {
      const int ch = ((ks * 4 + fq) ^ (fr & 7)) * 16;
      bf16x8 af[4], bfr[4];
#pragma unroll
      for (int m = 0; m < 4; ++m) af[m] = *(const bf16x8*)(la + m * 2048 + ch);
#pragma unroll
      for (int n = 0; n < 4; ++n) bfr[n] = *(const bf16x8*)(lb + n * 2048 + ch);
#pragma unroll
      for (int m = 0; m < 4; ++m)
#pragma unroll
        for (int n = 0; n < 4; ++n) acc[m][n] = mfma16(bfr[n], af[m], acc[m][n]);
    }
  }
  __syncthreads();
#undef GEMM_STAGE
}

template <class F> __device__ __forceinline__ void gemm_sched(int TN, F&& f) {
  const int npc = (TN + 3) >> 2, npatch = 16 * npc, xcd = blockIdx.x & 7, slot = blockIdx.x >> 3, nslot = gridDim.x >> 3;
  for (int pid = xcd; pid < npatch; pid += 8) {
    const int pr = pid / npc, pc = pid - pr * npc;
    for (int s = slot; s < 64; s += nslot) {
      const int tm = pr * 16 + (s & 15), tn = pc * 4 + (s >> 4);
      if (tn < TN) f(tm, tn);
    }
  }
}

#define GEMM_LANE const int lane_ = TIDX & 63, wid_ = TIDX >> 6, wr = wid_ >> 1, wc = wid_ & 1, fr = lane_ & 15, fq = lane_ >> 4

__device__ __forceinline__ void gemm_up_phase(const bf16_t* a, const bf16_t* wgu, bf16_t* act, char* lds) {
  gemm_sched(NGU / 128, [&](int tm, int tn) {
    f32x4 acc[4][4] = {};
    gemm_core(acc, a + (size_t)tm * 128 * 1024, 1024, wgu + (size_t)tn * 128 * 1024, 1024, 1024, lds);
    GEMM_LANE;
#pragma unroll
    for (int m = 0; m < 4; ++m) {
      const int row = tm * 128 + wr * 64 + m * 16 + fr;
#pragma unroll
      for (int i = 0; i < 2; ++i) {
        const int col = tn * 64 + wc * 32 + i * 16 + 4 * fq;
        const f32x4 g = acc[m][2 * i], u = acc[m][2 * i + 1];
        uint2 o; o.x = pk2(silu_f(g[0]) * u[0], silu_f(g[1]) * u[1]); o.y = pk2(silu_f(g[2]) * u[2], silu_f(g[3]) * u[3]);
        *(uint2*)(act + (size_t)row * DFF + col) = o;
      }
    }
  });
}

__device__ __forceinline__ void gemm_f32_phase(const bf16_t* A, int lda, const bf16_t* Bt, int K, float* out, char* lds) {
  gemm_sched(8, [&](int tm, int tn) {
    f32x4 acc[4][4] = {};
    gemm_core(acc, A + (size_t)tm * 128 * lda, lda, Bt + (size_t)tn * 128 * K, K, K, lds);
    GEMM_LANE;
#pragma unroll
    for (int m = 0; m < 4; ++m) {
      const int row = tm * 128 + wr * 64 + m * 16 + fr;
#pragma unroll
      for (int n = 0; n < 4; ++n) *(f32x4*)(out + (size_t)row * 1024 + tn * 128 + wc * 64 + n * 16 + 4 * fq) = acc[m][n];
    }
  });
}

__device__ __forceinline__ void gemm_in_phase(const bf16_t* a, const bf16_t* wint, bf16_t* z, char* lds) {
  gemm_sched(LDZ / 128, [&](int tm, int tn) {
    f32x4 acc[4][4] = {};
    gemm_core(acc, a + (size_t)tm * 128 * 1024, 1024, wint + (size_t)tn * 128 * 1024, 1024, 1024, lds);
    GEMM_LANE;
#pragma unroll
    for (int m = 0; m < 4; ++m) {
      const int row = tm * 128 + wr * 64 + m * 16 + fr;
#pragma unroll
      for (int n = 0; n < 4; ++n) {
        uint2 o; o.x = pk2(acc[m][n][0], acc[m][n][1]); o.y = pk2(acc[m][n][2], acc[m][n][3]);
        *(uint2*)(z + (size_t)row * LDZ + tn * 128 + wc * 64 + n * 16 + 4 * fq) = o;
      }
    }
  });
}

__device__ __forceinline__ void gemm_ple_phase(const bf16_t* a, const bf16_t* wpg, const bf16_t* pbf, const bf16_t* wpp, float* out, char* lds) {
  gemm_sched(8, [&](int tm, int tn) {
    f32x4 acc[4][4] = {};
    gemm_core(acc, pbf + (size_t)tm * 128 * 256, 256, wpp + (size_t)tn * 128 * 256, 256, 256, lds);
    u32x2 pp[4][4];
#pragma unroll
    for (int m = 0; m < 4; ++m)
#pragma unroll
      for (int n = 0; n < 4; ++n) { pp[m][n].x = pk2(acc[m][n][0], acc[m][n][1]); pp[m][n].y = pk2(acc[m][n][2], acc[m][n][3]); acc[m][n] = (f32x4){0.f, 0.f, 0.f, 0.f}; }
    gemm_core(acc, a + (size_t)tm * 128 * 1024, 1024, wpg + (size_t)tn * 128 * 1024, 1024, 1024, lds);
    GEMM_LANE;
#pragma unroll
    for (int m = 0; m < 4; ++m) {
      const int row = tm * 128 + wr * 64 + m * 16 + fr;
#pragma unroll
      for (int n = 0; n < 4; ++n) {
        f32x4 o;
        o[0] = sigm(acc[m][n][0]) * __uint_as_float(pp[m][n].x << 16); o[1] = sigm(acc[m][n][1]) * __uint_as_float(pp[m][n].x & 0xffff0000u);
        o[2] = sigm(acc[m][n][2]) * __uint_as_float(pp[m][n].y << 16); o[3] = sigm(acc[m][n][3]) * __uint_as_float(pp[m][n].y & 0xffff0000u);
        *(f32x4*)(out + (size_t)row * 1024 + tn * 128 + wc * 64 + n * 16 + 4 * fq) = o;
      }
    }
  });
}

__device__ __forceinline__ void mixA_item(const Params& P, int layer, int idx, const bf16_t* z, bf16_t* y, char* lds) {
  const int g = idx & 3, bc = idx >> 2, tok0 = bc * 128;
  const int tid = TIDX, lane = tid & 63, w = tid >> 6, fr = lane & 15, fq = lane >> 4;
  bf16_t* vT = (bf16_t*)lds;
  const float* ng = P.sgu_ng + layer * 256;
  {
    const int s = tid >> 1, half = tid & 1;
    const bf16_t* zr = z + (size_t)(tok0 + s) * LDZ + ZC_AV;
    float ss = 0.f;
#pragma unroll 4
    for (int i = 0; i < 16; ++i) { float v[8]; unpack8(*(const u32x4*)(zr + half * 128 + i * 8), v);
#pragma unroll
      for (int e = 0; e < 8; ++e) { const float t = gelu_t(v[e]); ss += t * t; } }
    ss += __shfl_xor(ss, 1);
    const float rs = rsqrtf(ss * (1.f / 256.f) + 1e-6f);
#pragma unroll
    for (int i = 0; i < 4; ++i) { float v[8]; unpack8(*(const u32x4*)(zr + g * 64 + half * 32 + i * 8), v);
#pragma unroll
      for (int e = 0; e < 8; ++e) { const int d = half * 32 + i * 8 + e; vT[d * 136 + s] = f2bf(gelu_t(v[e]) * rs * ng[g * 64 + d]); } }
  }
  __syncthreads();
  const bf16_t* W = (const bf16_t*)(P.ws + OFF_SGUW) + (size_t)((layer * 4 + g) * 128) * 128;
  f32x4 acc[2][4] = {};
  for (int ks = 0; ks <= w; ++ks) {
    bf16x8 wf[2], vf[4];
#pragma unroll
    for (int tm = 0; tm < 2; ++tm) wf[tm] = *(const bf16x8*)(W + (size_t)(32 * w + tm * 16 + fr) * 128 + ks * 32 + 8 * fq);
#pragma unroll
    for (int dn = 0; dn < 4; ++dn) vf[dn] = *(const bf16x8*)(vT + (dn * 16 + fr) * 136 + ks * 32 + 8 * fq);
#pragma unroll
    for (int tm = 0; tm < 2; ++tm)
#pragma unroll
      for (int dn = 0; dn < 4; ++dn) acc[tm][dn] = mfma16(vf[dn], wf[tm], acc[tm][dn]);
  }
#pragma unroll
  for (int tm = 0; tm < 2; ++tm) {
    const int t = 32 * w + tm * 16 + fr;
    const float bias = P.sgu_b[(layer * 4 + g) * 128 + t];
#pragma unroll
    for (int dn = 0; dn < 4; ++dn) {
      const int d = dn * 16 + 4 * fq;
      const uint2 uu = *(const uint2*)(z + (size_t)(tok0 + t) * LDZ + ZC_AU + g * 64 + d);
      const float u0 = gelu_t(__uint_as_float(uu.x << 16)), u1 = gelu_t(__uint_as_float(uu.x & 0xffff0000u)),
                  u2 = gelu_t(__uint_as_float(uu.y << 16)), u3 = gelu_t(__uint_as_float(uu.y & 0xffff0000u));
      uint2 o; o.x = pk2(u0 * (acc[tm][dn][0] + bias), u1 * (acc[tm][dn][1] + bias)); o.y = pk2(u2 * (acc[tm][dn][2] + bias), u3 * (acc[tm][dn][3] + bias));
      *(uint2*)(y + (size_t)(tok0 + t) * 1024 + g * 64 + d) = o;
    }
  }
  __syncthreads();
}

__device__ __forceinline__ void mixB1_item(const Params& P, int layer, int idx, const bf16_t* z, float* hsl, float* Pc, float* carryP, float* carryH, char* lds) {
  const int c = idx & 63, g = (idx >> 6) & 3, b = idx >> 8;
  const int tid = TIDX, lane = tid & 63, w = tid >> 6, fr = lane & 15, fq = lane >> 4;
  bf16_t* xcb = (bf16_t*)lds;
  float* xcf = (float*)(lds + 9216);
  float* aA = (float*)(lds + 9216 + 16384);
  float* bB = (float*)(lds + 9216 + 32768);
  float* sm = (float*)(lds + 9216 + 49152);
  const size_t tokb = (size_t)b * SEQ;
  {
    const int t = tid >> 2, q = tid & 3;
    float accv[16];
#pragma unroll
    for (int i = 0; i < 16; ++i) accv[i] = P.conv_b[layer * 256 + g * 64 + q * 16 + i];
#pragma unroll
    for (int k = 0; k < 4; ++k) {
      const int pos = c * 64 + t - 3 + k;
      if (pos >= 0) {
        const bf16_t* zr = z + (tokb + pos) * LDZ + ZC_BX + g * 64 + q * 16;
        float v[16]; unpack8(*(const u32x4*)zr, v); unpack8(*(const u32x4*)(zr + 8), v + 8);
        const float* cw = P.conv_w + (size_t)(layer * 4 + k) * 256 + g * 64 + q * 16;
#pragma unroll
        for (int i = 0; i < 16; ++i) accv[i] += v[i] * cw[i];
      }
    }
#pragma unroll
    for (int i = 0; i < 16; ++i) { xcf[t * 64 + q * 16 + i] = accv[i]; xcb[t * 72 + q * 16 + i] = f2bf(accv[i]); }
  }
  __syncthreads();
  {
    const bf16_t* wa = (const bf16_t*)(P.ws + OFF_WAT) + (layer * 4 + g) * 4096;
    const bf16_t* wx = (const bf16_t*)(P.ws + OFF_WXT) + (layer * 4 + g) * 4096;
    f32x4 ar[4] = {}, ai[4] = {};
#pragma unroll
    for (int ks = 0; ks < 2; ++ks) {
      const bf16x8 xf = *(const bf16x8*)(xcb + (16 * w + fr) * 72 + ks * 32 + 8 * fq);
#pragma unroll
      for (int jn = 0; jn < 4; ++jn) {
        const bf16x8 fa = *(const bf16x8*)(wa + (jn * 16 + fr) * 64 + ks * 32 + 8 * fq);
        const bf16x8 fx = *(const bf16x8*)(wx + (jn * 16 + fr) * 64 + ks * 32 + 8 * fq);
        ar[jn] = mfma16(fa, xf, ar[jn]); ai[jn] = mfma16(fx, xf, ai[jn]);
      }
    }
    const int t = 16 * w + fr;
#pragma unroll
    for (int jn = 0; jn < 4; ++jn)
#pragma unroll
      for (int e = 0; e < 4; ++e) {
        const int j = jn * 16 + 4 * fq + e, ch = layer * 256 + g * 64 + j;
        const float r = sigm(ar[jn][e] + P.lru_ba[ch]), ig = sigm(ai[jn][e] + P.lru_bx[ch]);
        const float lam = P.lru_lam[ch];
        const float la = -8.f * r * log1pf(__expf(-lam));
        const float av = __expf(la);
        const float bv = sqrtf(-expm1f(2.f * la)) * (ig * xcf[t * 64 + j]);
        aA[t * 64 + j] = av; bB[t * 64 + j] = bv;
      }
  }
  __syncthreads();
  {
    const int q = tid >> 6, j = tid & 63;
    float Pq = 1.f, hq = 0.f;
#pragma unroll
    for (int i = 0; i < 16; ++i) { const int t = q * 16 + i; const float av = aA[t * 64 + j], bv = bB[t * 64 + j]; hq = av * hq + bv; Pq *= av; aA[t * 64 + j] = Pq; bB[t * 64 + j] = hq; }
    sm[q * 64 + j] = Pq; sm[256 + q * 64 + j] = hq;
    __syncthreads();
    float Pin = 1.f, Hin = 0.f;
    for (int qq = 0; qq < q; ++qq) { const float pp = sm[qq * 64 + j], hh = sm[256 + qq * 64 + j]; Hin = pp * Hin + hh; Pin *= pp; }
    float hl = 0.f, pl = 1.f;
#pragma unroll
    for (int i = 0; i < 16; ++i) { const int t = q * 16 + i; hl = bB[t * 64 + j] + aA[t * 64 + j] * Hin; pl = aA[t * 64 + j] * Pin;
      const size_t o = (tokb + c * 64 + t) * 256 + g * 64 + j; hsl[o] = hl; Pc[o] = pl; }
    if (q == 3) { const int o = ((b * 4 + g) * 64 + c) * 64 + j; carryP[o] = pl; carryH[o] = hl; }
  }
  __syncthreads();
}

__device__ __forceinline__ void mixB2_item(int idx, const bf16_t* z, const float* hsl, const float* Pc, const float* carryP, const float* carryH, bf16_t* y) {
  const int c = idx & 63, g = (idx >> 6) & 3, b = idx >> 8;
  const int q = TIDX >> 6, j = TIDX & 63;
  const float* cp = carryP + (size_t)((b * 4 + g) * 64) * 64 + j;
  const float* chh = carryH + (size_t)((b * 4 + g) * 64) * 64 + j;
  float H = 0.f;
  for (int c0 = 0; c0 < c; c0 += 8) {
    float pv[8], hv[8];
#pragma unroll
    for (int i = 0; i < 8; ++i) { const bool ok = c0 + i < c; pv[i] = ok ? cp[(c0 + i) * 64] : 1.f; hv[i] = ok ? chh[(c0 + i) * 64] : 0.f; }
#pragma unroll
    for (int i = 0; i < 8; ++i) H = pv[i] * H + hv[i];
  }
  const size_t tokb = (size_t)b * SEQ + c * 64 + q * 16;
#pragma unroll 4
  for (int i = 0; i < 16; ++i) {
    const size_t o = (tokb + i) * 256 + g * 64 + j;
    const float h = hsl[o] + Pc[o] * H;
    const float gt = bf2f(z[(tokb + i) * LDZ + ZC_BG + g * 64 + j]);
    y[(tokb + i) * 1024 + 256 + g * 64 + j] = f2bf(h * gelu_t(gt));
  }
}

__device__ __forceinline__ void compress_item(const Params& P, int layer, int idx, const bf16_t* z, bf16_t* kcv, char* lds) {
  const int nb = idx & 7, g = (idx >> 3) & 1, b = (idx >> 4) & 7, kv = idx >> 7;
  const int tid = TIDX, lane = tid & 63, w = tid >> 6, fr = lane & 15, fq = lane >> 4;
  const int n0 = nb * 32, col = (kv ? ZC_VC : ZC_KC) + g * 64;
  const bf16_t* w1t = (const bf16_t*)(P.ws + OFF_CW1 + (size_t)(layer * 2 + kv) * SZ_CW1);
  float* hid = (float*)lds;
  f32x4 acc[2][2] = {};
  const bf16_t* zb[2]; const bf16_t* wb[2];
#pragma unroll
  for (int nf = 0; nf < 2; ++nf) { int n = n0 + nf * 16 + fr; if (n > 254) n = 254; zb[nf] = z + ((size_t)b * SEQ + 16 * n) * LDZ + col + 8 * fq; }
#pragma unroll
  for (int jf = 0; jf < 2; ++jf) wb[jf] = w1t + (size_t)(32 * w + jf * 16 + fr) * 2048 + 8 * fq;
#pragma unroll 4
  for (int ks = 0; ks < 64; ++ks) {
    const int l = ks >> 1, d0 = (ks & 1) * 32;
    bf16x8 xf[2], wf[2];
#pragma unroll
    for (int nf = 0; nf < 2; ++nf) xf[nf] = *(const bf16x8*)(zb[nf] + (size_t)l * LDZ + d0);
#pragma unroll
    for (int jf = 0; jf < 2; ++jf) wf[jf] = *(const bf16x8*)(wb[jf] + ks * 32);
#pragma unroll
    for (int jf = 0; jf < 2; ++jf)
#pragma unroll
      for (int nf = 0; nf < 2; ++nf) acc[jf][nf] = mfma16(wf[jf], xf[nf], acc[jf][nf]);
  }
  const float* cb1 = (const float*)(P.ws + OFF_CB1) + (layer * 2 + kv) * 128;
#pragma unroll
  for (int jf = 0; jf < 2; ++jf)
#pragma unroll
    for (int nf = 0; nf < 2; ++nf)
#pragma unroll
      for (int e = 0; e < 4; ++e) { const int j = 32 * w + jf * 16 + 4 * fq + e; hid[(nf * 16 + fr) * 129 + j] = gelu_t(acc[jf][nf][e] + cb1[j]); }
  __syncthreads();
  {
    const int n = tid >> 3, d0 = (tid & 7) * 8;
    const float* w2 = P.cmp_w2 + (size_t)(layer * 2 + kv) * 128 * 64 + d0;
    const float* b2 = P.cmp_b2 + (layer * 2 + kv) * 64 + d0;
    float o[8];
#pragma unroll
    for (int e = 0; e < 8; ++e) o[e] = b2[e];
    for (int j = 0; j < 128; ++j) {
      const float hv = hid[n * 129 + j]; const float4 wa = *(const float4*)(w2 + j * 64), wb2 = *(const float4*)(w2 + j * 64 + 4);
      o[0] += hv * wa.x; o[1] += hv * wa.y; o[2] += hv * wa.z; o[3] += hv * wa.w; o[4] += hv * wb2.x; o[5] += hv * wb2.y; o[6] += hv * wb2.z; o[7] += hv * wb2.w;
    }
    const bool valid = (n0 + n) < 255;
    uint4 ov = valid ? make_uint4(pk2(o[0], o[1]), pk2(o[2], o[3]), pk2(o[4], o[5]), pk2(o[6], o[7])) : make_uint4(0, 0, 0, 0);
    *(uint4*)(kcv + ((size_t)((kv * 8 + b) * 2 + g) * 256 + n0 + n) * 64 + d0) = ov;
  }
  __syncthreads();
}

constexpr int NSA_KT = 0, NSA_VT = 16384, NSA_BKT = 33792, NSA_RB = 37888, NSA_IMP = 38976, NSA_WU = 55616;

__device__ __forceinline__ void nsa_tables(const Params& P, char* lds) {
  unsigned char* bkt = (unsigned char*)(lds + NSA_BKT);
  float* rb = (float*)(lds + NSA_RB);
  for (int n = TIDX; n < 4096; n += 256) {
    int bk = n;
    if (n >= 16) bk = 16 + (n >= 21) + (n >= 27) + (n >= 35) + (n >= 46) + (n >= 59) + (n >= 77) + (n >= 99) + (n >= 128) + (n >= 166) + (n >= 216) + (n >= 280) + (n >= 363) + (n >= 470) + (n >= 609) + (n >= 790);
    bkt[n] = (unsigned char)bk;
  }
  rb[TIDX] = P.rel_bias[TIDX];
  if (TIDX < 8) rb[256 + TIDX] = -__builtin_inff();
  __syncthreads();
}

struct KVRegs { u32x4 k0, k1, v0, v1; };
__device__ __forceinline__ void kv_gload(KVRegs& r, const bf16_t* kb, const bf16_t* vb, size_t stride) {
  const int row = TIDX >> 2, cq = TIDX & 3;
  const bf16_t* kp = kb + row * stride + cq * 16; const bf16_t* vp = vb + row * stride + cq * 16;
  r.k0 = *(const u32x4*)kp; r.k1 = *(const u32x4*)(kp + 8); r.v0 = *(const u32x4*)vp; r.v1 = *(const u32x4*)(vp + 8);
}
__device__ __forceinline__ void kv_lwrite(const KVRegs& r, char* lds, int buf) {
  const int row = TIDX >> 2, cq = TIDX & 3;
  char* kt = lds + NSA_KT + buf * 8192 + row * 128;
  *(u32x4*)(kt + (((2 * cq) ^ (row & 7)) << 4)) = r.k0;
  *(u32x4*)(kt + (((2 * cq + 1) ^ (row & 7)) << 4)) = r.k1;
  bf16_t* vt = (bf16_t*)(lds + NSA_VT + buf * 8704) + (cq * 16) * 68 + row;
#pragma unroll
  for (int i = 0; i < 4; ++i) { vt[(2 * i) * 68] = (bf16_t)(r.v0[i] & 0xffffu); vt[(2 * i + 1) * 68] = (bf16_t)(r.v0[i] >> 16); }
#pragma unroll
  for (int i = 0; i < 4; ++i) { vt[(8 + 2 * i) * 68] = (bf16_t)(r.v1[i] & 0xffffu); vt[(8 + 2 * i + 1) * 68] = (bf16_t)(r.v1[i] >> 16); }
}

template <int MODE>
__device__ __forceinline__ void nsa_compute(int cur, int buf, int t, int hb, u64 mymask, const bf16x8 (&Qf)[2][2], f32x4 (&O)[4][2], float (&m)[2], float (&l)[2],
                                            const float (&inv)[2], float* impw, char* lds) {
  const int lane = TIDX & 63, fr = lane & 15, fq = lane >> 4;
  const unsigned char* bkt = (const unsigned char*)(lds + NSA_BKT);
  const float* rb = (const float*)(lds + NSA_RB);
  const char* kt = lds + NSA_KT + buf * 8192;
  const bf16_t* vt = (const bf16_t*)(lds + NSA_VT + buf * 8704);
  const bool selok = (MODE == 2) ? (((mymask >> cur) & 1ull) != 0ull) : true;
#pragma unroll
  for (int s2 = 0; s2 < 2; ++s2) {
    f32x4 S[2][2] = {};
#pragma unroll
    for (int ks = 0; ks < 2; ++ks)
#pragma unroll
      for (int kk = 0; kk < 2; ++kk) {
        const bf16x8 kf = *(const bf16x8*)(kt + (32 * s2 + 16 * kk + fr) * 128 + (((ks * 4 + fq) ^ (fr & 7)) << 4));
#pragma unroll
        for (int r = 0; r < 2; ++r) S[kk][r] = mfma16(kf, Qf[r][ks], S[kk][r]);
      }
    int bo[2][4];
#pragma unroll
    for (int kk = 0; kk < 2; ++kk)
#pragma unroll
      for (int e = 0; e < 4; ++e) {
        const int kl = cur * 64 + 32 * s2 + 16 * kk + 4 * fq + e;
        int dd; bool o;
        if (MODE <= 1) { dd = t - (16 * kl + 31); o = dd >= 0; }
        else if (MODE == 2) { dd = t - kl; o = (dd >= 0) && selok; }
        else { dd = t - kl; o = (dd >= 0) && (dd < 512); }
        bo[kk][e] = (o ? (int)bkt[dd] : 32) * 8 + hb;
      }
    bf16x8 Pf[2];
    float g1s[2] = {0.f, 0.f}, p3s[2] = {0.f, 0.f};
#pragma unroll
    for (int r = 0; r < 2; ++r) {
      float sv[2][4];
#pragma unroll
      for (int kk = 0; kk < 2; ++kk)
#pragma unroll
        for (int e = 0; e < 4; ++e) sv[kk][e] = S[kk][r][e] * 0.125f + rb[bo[kk][e] + r];
      float pv[2][4];
      if (MODE == 1) {
#pragma unroll
        for (int kk = 0; kk < 2; ++kk)
#pragma unroll
          for (int e = 0; e < 4; ++e) pv[kk][e] = __expf(sv[kk][e] - m[r]) * inv[r];
#pragma unroll
        for (int kk = 0; kk < 2; ++kk) { g1s[kk] += pv[kk][0] + pv[kk][1] + pv[kk][2] + 0.5f * pv[kk][3]; p3s[kk] += 0.5f * pv[kk][3]; }
      } else {
        float mx = fmaxf(fmaxf(fmaxf(sv[0][0], sv[0][1]), fmaxf(sv[0][2], sv[0][3])), fmaxf(fmaxf(sv[1][0], sv[1][1]), fmaxf(sv[1][2], sv[1][3])));
        mx = fmaxf(mx, __shfl_xor(mx, 16)); mx = fmaxf(mx, __shfl_xor(mx, 32));
        const float mn = fmaxf(m[r], mx), al = __expf(m[r] - mn);
        m[r] = mn;
        float ps = 0.f;
#pragma unroll
        for (int kk = 0; kk < 2; ++kk)
#pragma unroll
          for (int e = 0; e < 4; ++e) { pv[kk][e] = __expf(sv[kk][e] - mn); ps += pv[kk][e]; }
        l[r] = l[r] * al + ps;
        if (MODE != 0) {
#pragma unroll
          for (int df = 0; df < 4; ++df) O[df][r] *= al;
        }
      }
      if (MODE != 0) {
        const unsigned w0 = pk2(pv[0][0], pv[0][1]), w1 = pk2(pv[0][2], pv[0][3]), w2 = pk2(pv[1][0], pv[1][1]), w3 = pk2(pv[1][2], pv[1][3]);
        Pf[r][0] = (short)(w0 & 0xffff); Pf[r][1] = (short)(w0 >> 16); Pf[r][2] = (short)(w1 & 0xffff); Pf[r][3] = (short)(w1 >> 16);
        Pf[r][4] = (short)(w2 & 0xffff); Pf[r][5] = (short)(w2 >> 16); Pf[r][6] = (short)(w3 & 0xffff); Pf[r][7] = (short)(w3 >> 16);
      }
    }
    if (MODE != 0) {
#pragma unroll
      for (int df = 0; df < 4; ++df) {
        const bf16x4 va = *(const bf16x4*)(vt + (df * 16 + fr) * 68 + 32 * s2 + 4 * fq);
        const bf16x4 vb = *(const bf16x4*)(vt + (df * 16 + fr) * 68 + 32 * s2 + 16 + 4 * fq);
        bf16x8 vf; vf[0] = va[0]; vf[1] = va[1]; vf[2] = va[2]; vf[3] = va[3]; vf[4] = vb[0]; vf[5] = vb[1]; vf[6] = vb[2]; vf[7] = vb[3];
#pragma unroll
        for (int r = 0; r < 2; ++r) O[df][r] = mfma16(vf, Pf[r], O[df][r]);
      }
    }
    if (MODE == 1) {
#pragma unroll
      for (int kk = 0; kk < 2; ++kk) {
        const int j = cur * 16 + (2 * s2 + kk) * 4 + fq;
        atomicAdd(&impw[fr * 65 + j], g1s[kk]);
        if (j + 1 < 64) atomicAdd(&impw[fr * 65 + j + 1], p3s[kk]);
      }
    }
  }
}

template <int MODE>
__device__ __forceinline__ void nsa_branch(int first, int ntl, u64 U, const bf16_t* kbase, const bf16_t* vbase, size_t stride, int t, int hb, u64 mymask,
                                           const bf16x8 (&Qf)[2][2], f32x4 (&O)[4][2], float (&m)[2], float (&l)[2], const float (&inv)[2], float* impw, char* lds) {
  KVRegs kr;
  int nxt, left = ntl;
  u64 rem = U;
  if (MODE == 2) { nxt = rem ? (int)__builtin_ctzll(rem) : -1; if (rem) rem &= rem - 1; }
  else { nxt = ntl > 0 ? first : -1; }
  if (nxt >= 0) { kv_gload(kr, kbase + (size_t)nxt * 64 * stride, vbase + (size_t)nxt * 64 * stride, stride); kv_lwrite(kr, lds, 0); }
  __syncthreads();
  int buf = 0;
  while (nxt >= 0) {
    const int cur = nxt;
    if (MODE == 2) { nxt = rem ? (int)__builtin_ctzll(rem) : -1; if (rem) rem &= rem - 1; }
    else { --left; nxt = left > 0 ? cur + 1 : -1; }
    if (nxt >= 0) kv_gload(kr, kbase + (size_t)nxt * 64 * stride, vbase + (size_t)nxt * 64 * stride, stride);
    nsa_compute<MODE>(cur, buf, t, hb, mymask, Qf, O, m, l, inv, impw, lds);
    if (nxt >= 0) kv_lwrite(kr, lds, buf ^ 1);
    __syncthreads();
    buf ^= 1;
  }
}

#define NSA_RESET()                                                                         \
  _Pragma("unroll") for (int r = 0; r < 2; ++r) { m[r] = -1e30f; l[r] = 0.f; }               \
  _Pragma("unroll") for (int df = 0; df < 4; ++df) _Pragma("unroll") for (int r = 0; r < 2; ++r) O[df][r] = (f32x4){0.f, 0.f, 0.f, 0.f};
#define NSA_LOADQ(hp)                                                                       \
  _Pragma("unroll") for (int r = 0; r < 2; ++r) _Pragma("unroll") for (int ks = 0; ks < 2; ++ks)  \
      Qf[r][ks] = *(const bf16x8*)(zq + ZC_Q + g * 256 + ((hp) * 2 + r) * 64 + ks * 32 + 8 * fq);

__device__ __forceinline__ void nsa_item(const Params& P, int b, int g, int c, const bf16_t* z, const bf16_t* kcv, bf16_t* y, char* lds) {
  const int tid = TIDX, lane = tid & 63, w = tid >> 6, fr = lane & 15, fq = lane >> 4;
  const size_t tokb = (size_t)b * SEQ;
  const int t = c * 64 + 16 * w + fr;
  const bf16_t* zq = z + (tokb + t) * LDZ;
  bf16x8 Qf[2][2];
  float* impw = (float*)(lds + NSA_IMP) + w * (16 * 65);
  for (int i = lane; i < 16 * 65; i += 64) impw[i] = 0.f;
  f32x4 O[4][2];
  float m[2], l[2], inv[2];
  bf16_t* yo = y + (tokb + t) * 1024 + 512 + g * 256 + 4 * fq;
  const bf16_t* kc = kcv + (size_t)((0 * 8 + b) * 2 + g) * 256 * 64;
  const bf16_t* vc = kcv + (size_t)((1 * 8 + b) * 2 + g) * 256 * 64;
  const int nct = ((4 * c + 2) >> 6) + 1;
  for (int hp = 0; hp < 2; ++hp) {
    NSA_LOADQ(hp);
    NSA_RESET();
    inv[0] = 0.f; inv[1] = 0.f;
    nsa_branch<0>(0, nct, 0ull, kc, vc, 64, t, g * 4 + hp * 2, 0ull, Qf, O, m, l, inv, impw, lds);
#pragma unroll
    for (int r = 0; r < 2; ++r) { float lt = l[r]; lt += __shfl_xor(lt, 16); lt += __shfl_xor(lt, 32); inv[r] = lt > 0.f ? 1.f / lt : 0.f; }
    nsa_branch<1>(0, nct, 0ull, kc, vc, 64, t, g * 4 + hp * 2, 0ull, Qf, O, m, l, inv, impw, lds);
#pragma unroll
    for (int r = 0; r < 2; ++r) {
      const float gt = sigm(bf2f(zq[ZC_GC + g * 4 + hp * 2 + r]));
#pragma unroll
      for (int df = 0; df < 4; ++df) { u32x2 o; o.x = pk2(O[df][r][0] * gt, O[df][r][1] * gt); o.y = pk2(O[df][r][2] * gt, O[df][r][3] * gt); *(u32x2*)(yo + (hp * 2 + r) * 64 + df * 16) = o; }
    }
  }
  __syncthreads();
  u64 mymask = 0ull, wU = 0ull;
  for (int qq = 0; qq < 16; ++qq) {
    const float s = impw[qq * 65 + lane];
    const int j = lane;
    const bool forced = (j == 0) | (j == c) | (j == c - 1);
    const float sc = (j <= c) ? (forced ? 1e4f : s) : -1.0f;
    int rank = 0;
#pragma unroll 16
    for (int k = 0; k < 64; ++k) { const float sk = __int_as_float(__builtin_amdgcn_readlane(__float_as_int(sc), k)); rank += ((sk > sc) || (sk == sc && k < j)) ? 1 : 0; }
    const bool sel = (rank < 16) && (sc >= 0.f);
    const u64 mk = __ballot(sel);
    if (fr == qq) mymask = mk;
    wU |= mk;
  }
  u64* WU = (u64*)(lds + NSA_WU);
  if (lane == 0) WU[w] = wU;
  __syncthreads();
  const u64 U = WU[0] | WU[1] | WU[2] | WU[3];
  for (int br = 0; br < 2; ++br) {
    for (int hp = 0; hp < 2; ++hp) {
      NSA_LOADQ(hp);
      NSA_RESET();
      int zg;
      if (br == 0) {
        nsa_branch<2>(0, 0, U, z + tokb * LDZ + ZC_KS + g * 64, z + tokb * LDZ + ZC_VS + g * 64, LDZ, t, g * 4 + hp * 2, mymask, Qf, O, m, l, inv, impw, lds);
        zg = ZC_GS;
      } else {
        const int kt0 = c > 8 ? c - 8 : 0;
        nsa_branch<3>(kt0, c - kt0 + 1, 0ull, z + tokb * LDZ + ZC_KW + g * 64, z + tokb * LDZ + ZC_VW + g * 64, LDZ, t, g * 4 + hp * 2, 0ull, Qf, O, m, l, inv, impw, lds);
        zg = ZC_GW;
      }
#pragma unroll
      for (int r = 0; r < 2; ++r) {
        float lt = l[r]; lt += __shfl_xor(lt, 16); lt += __shfl_xor(lt, 32);
        const float gt = sigm(bf2f(zq[zg + g * 4 + hp * 2 + r])) * (lt > 0.f ? 1.f / lt : 0.f);
#pragma unroll
        for (int df = 0; df < 4; ++df) {
          bf16_t* yp = yo + (hp * 2 + r) * 64 + df * 16;
          const u32x2 pr = *(const u32x2*)yp;
          u32x2 o; o.x = pk2(__uint_as_float(pr.x << 16) + O[df][r][0] * gt, __uint_as_float(pr.x & 0xffff0000u) + O[df][r][1] * gt);
          o.y = pk2(__uint_as_float(pr.y << 16) + O[df][r][2] * gt, __uint_as_float(pr.y & 0xffff0000u) + O[df][r][3] * gt);
          *(u32x2*)yp = o;
        }
      }
    }
  }
  __syncthreads();
}

__device__ __forceinline__ void run_phase(const Params& P, int ph, char* lds) {
  char* ws = P.ws;
  bf16_t* abuf = (bf16_t*)(ws + OFF_A);
  bf16_t* big = (bf16_t*)(ws + OFF_BIG);
  float* fbuf = (float*)(ws + OFF_F);
  float* hsl = fbuf; float* Pc = fbuf + (size_t)M_TOK * 256;
  bf16_t* kcv = (bf16_t*)(ws + OFF_KC);
  float* carryP = (float*)(ws + OFF_CARRY); float* carryH = carryP + 8 * 4 * 64 * 64;
  if (ph == 0) { prep_phase(P, lds); return; }
  const int layer = (ph - 1) / 13, sp = (ph - 1) % 13;
  const float* ng = P.norm_g + (size_t)layer * 8 * 1024;
#ifdef ONLY_SP
  if (sp != ONLY_SP) return;
#endif
  switch (sp) {
    case 0: case 8: {
      const int lj = layer * 2 + (sp == 8);
      gemm_up_phase(abuf, (const bf16_t*)(ws + OFF_WGU + lj * SZ_WGU), big, lds);
    } break;
    case 1: case 9: {
      const int lj = layer * 2 + (sp == 9);
      gemm_f32_phase(big, DFF, (const bf16_t*)(ws + OFF_WD + lj * SZ_WD), DFF, fbuf, lds);
    } break;
    case 2: resnorm_phase(P.out, P.out, fbuf, 0.5f, ng + 1 * 1024, ng + 2 * 1024, abuf); break;
    case 3: gemm_in_phase(abuf, (const bf16_t*)(ws + OFF_WIN + layer * SZ_WIN), big, lds); break;
    case 4:
      for (int it = blockIdx.x; it < 256 + 1024 + 2048; it += gridDim.x) {
        if (it < 256) compress_item(P, layer, it, big, kcv, lds);
        else if (it < 1280) mixA_item(P, layer, it - 256, big, abuf, lds);
        else mixB1_item(P, layer, it - 1280, big, hsl, Pc, carryP, carryH, lds);
      }
      break;
    case 5:
      nsa_tables(P, lds);
      for (int it = blockIdx.x; it < 1024 + 2048; it += gridDim.x) {
        if (it < 1024) { const int c = it < 512 ? 63 - (it >> 4) : ((it - 512) >> 4); const int bg = it & 15; nsa_item(P, bg >> 1, bg & 1, c, big, kcv, abuf, lds); }
        else mixB2_item(it - 1024, big, hsl, Pc, carryP, carryH, abuf);
      }
      break;
    case 6: gemm_f32_phase(abuf, 1024, (const bf16_t*)(ws + OFF_WOUT + layer * SZ_SQ), 1024, fbuf, lds); break;
    case 7: resnorm_phase(P.out, P.out, fbuf, 1.0f, ng + 3 * 1024, ng + 4 * 1024, abuf); break;
    case 10: resnorm_phase(P.out, P.out, fbuf, 0.5f, ng + 5 * 1024, ng + 6 * 1024, abuf); break;
    case 11:
      gemm_ple_phase(abuf, (const bf16_t*)(ws + OFF_WPG + layer * SZ_SQ), (const bf16_t*)(ws + OFF_PBF) + (size_t)layer * M_TOK * 256,
                     (const bf16_t*)(ws + OFF_WPP + layer * SZ_WPP), fbuf, lds);
      break;
    case 12: resnorm_phase(P.out, P.out, fbuf, 1.0f, ng + 7 * 1024, layer == 0 ? P.norm_g + 8 * 1024 : nullptr, layer == 0 ? abuf : nullptr); break;
  }
}

__global__ void __launch_bounds__(256, 2) fwd_megakernel(Params P) {
  __shared__ __attribute__((aligned(16))) char lds[65536];
  cg::grid_group grid = cg::this_grid();
  for (int ph = 0; ph < NPHASE; ++ph) {
    run_phase(P, ph, lds);
    if (ph + 1 < NPHASE) grid.sync();
  }
}

__global__ void __launch_bounds__(256, 2) phase_kernel(Params P, int ph) {
  __shared__ __attribute__((aligned(16))) char lds[65536];
  run_phase(P, ph, lds);
}

extern "C" void kernel_launch(void* const* d_in, const int* in_sizes, int n_in, void* d_out, int out_size, void* d_ws, size_t ws_size, hipStream_t stream) {
  Params P{};
  const float** pp = (const float**)&P;
  for (int i = 0; i < 26; ++i) pp[i] = (const float*)d_in[i];
  P.out = (float*)d_out;
  P.ws = (char*)d_ws;
  if (ws_size < WS_NEED) { fprintf(stderr, "workspace too small: %zu < %zu\n", ws_size, (size_t)WS_NEED); return; }
#if MK_FUSED
  static int grid_blocks = 0;
  if (!grid_blocks) {
    int dev = 0, cus = 0, per_cu = 0;
    hipGetDevice(&dev);
    hipDeviceGetAttribute(&cus, hipDeviceAttributeMultiprocessorCount, dev);
    hipOccupancyMaxActiveBlocksPerMultiprocessor(&per_cu, fwd_megakernel, 256, 0);
    if (per_cu > 2) per_cu = 2;
    if (per_cu < 1) per_cu = 1;
    grid_blocks = cus * per_cu;
  }
  void* args[] = {&P};
  hipError_t e = hipLaunchCooperativeKernel((void*)fwd_megakernel, dim3(grid_blocks), dim3(256), args, 0, stream);
  if (e != hipSuccess) fprintf(stderr, "cooperative launch failed: %s (grid %d)\n", hipGetErrorString(e), grid_blocks);
#else
  for (int ph = 0; ph < NPHASE; ++ph) phase_kernel<<<512, 256, 0, stream>>>(P, ph);
#endif
}
```

```cpp
#include <hip/hip_runtime.h>
#include <hip/hip_cooperative_groups.h>
#include <cstdint>
#include <cstdio>
namespace cg = cooperative_groups;

#ifndef MK_FUSED
#define MK_FUSED 1
#endif

typedef unsigned short bf16_t;
typedef short bf16x8 __attribute__((ext_vector_type(8)));
typedef short bf16x4 __attribute__((ext_vector_type(4)));
typedef float f32x4 __attribute__((ext_vector_type(4)));
typedef unsigned long long u64;
typedef unsigned u32x4 __attribute__((ext_vector_type(4)));
typedef unsigned u32x2 __attribute__((ext_vector_type(2)));

constexpr int M_TOK = 32768, DM = 1024, DFF = 2816, NGU = 5632, NIN = 2328, LDZ = 2432, SEQ = 4096;
constexpr int NPHASE = 27;
constexpr int ZC_AU = 0, ZC_AV = 256, ZC_BX = 512, ZC_BG = 768, ZC_Q = 1024, ZC_KC = 1536, ZC_VC = 1664, ZC_KS = 1792, ZC_VS = 1920,
              ZC_KW = 2048, ZC_VW = 2176, ZC_GC = 2304, ZC_GS = 2312, ZC_GW = 2320;

constexpr size_t SZ_WGU = (size_t)NGU * 1024 * 2, SZ_WD = (size_t)1024 * DFF * 2, SZ_WIN = (size_t)LDZ * 1024 * 2, SZ_SQ = (size_t)1024 * 1024 * 2,
                 SZ_WPP = (size_t)1024 * 256 * 2, SZ_CW1 = (size_t)128 * 2048 * 2;
constexpr size_t OFF_WGU = 0;
constexpr size_t OFF_WD = OFF_WGU + 4 * SZ_WGU;
constexpr size_t OFF_WIN = OFF_WD + 4 * SZ_WD;
constexpr size_t OFF_WOUT = OFF_WIN + 2 * SZ_WIN;
constexpr size_t OFF_WPG = OFF_WOUT + 2 * SZ_SQ;
constexpr size_t OFF_WPP = OFF_WPG + 2 * SZ_SQ;
constexpr size_t OFF_CW1 = OFF_WPP + 2 * SZ_WPP;
constexpr size_t OFF_CB1 = OFF_CW1 + 4 * SZ_CW1;
constexpr size_t OFF_SGUW = OFF_CB1 + 4096;
constexpr size_t OFF_WAT = OFF_SGUW + 2 * 4 * 128 * 128 * 2;
constexpr size_t OFF_WXT = OFF_WAT + 2 * 4 * 64 * 64 * 2;
constexpr size_t OFF_PBF = OFF_WXT + 2 * 4 * 64 * 64 * 2;
constexpr size_t OFF_A = OFF_PBF + (size_t)2 * M_TOK * 256 * 2;
constexpr size_t OFF_BIG = OFF_A + (size_t)M_TOK * 1024 * 2;
constexpr size_t OFF_F = OFF_BIG + (size_t)M_TOK * DFF * 2;
constexpr size_t OFF_KC = OFF_F + (size_t)M_TOK * 1024 * 4;
constexpr size_t OFF_CARRY = OFF_KC + (size_t)2 * 8 * 2 * 256 * 64 * 2;
constexpr size_t WS_NEED = OFF_CARRY + (size_t)2 * 8 * 4 * 64 * 64 * 4;

struct Params {
  const float *x, *p, *rel_bias, *norm_g, *ffn_wg, *ffn_wu, *ffn_wd, *w_in, *w_out, *sgu_ng, *sgu_w, *sgu_b, *conv_w, *conv_b,
      *lru_wa, *lru_ba, *lru_wx, *lru_bx, *lru_lam, *cmp_pos, *cmp_w1, *cmp_b1, *cmp_w2, *cmp_b2, *ple_wg, *ple_wp;
  float* out;
  char* ws;
};

__device__ __forceinline__ int opaque_tid() { int t; asm volatile("v_mov_b32 %0, %1" : "=v"(t) : "v"(threadIdx.x)); return t; }
#define TIDX opaque_tid()
__device__ __forceinline__ float bf2f(bf16_t v) { return __uint_as_float(((unsigned)v) << 16); }
__device__ __forceinline__ bf16_t f2bf(float f) { unsigned u = __float_as_uint(f); u += 0x7fffu + ((u >> 16) & 1u); return (bf16_t)(u >> 16); }
__device__ __forceinline__ unsigned pk2(float lo, float hi) { return (unsigned)f2bf(lo) | ((unsigned)f2bf(hi) << 16); }
__device__ __forceinline__ float sigm(float x) { return 1.f / (1.f + __expf(-x)); }
__device__ __forceinline__ float gelu_t(float x) { float u = 0.7978845608028654f * (x + 0.044715f * x * x * x); return x / (1.f + __expf(-2.f * u)); }
__device__ __forceinline__ float silu_f(float x) { return x / (1.f + __expf(-x)); }
__device__ __forceinline__ f32x4 mfma16(bf16x8 a, bf16x8 b, f32x4 c) { return __builtin_amdgcn_mfma_f32_16x16x32_bf16(a, b, c, 0, 0, 0); }
__device__ __forceinline__ void glds16(const void* g, void* l) {
  __builtin_amdgcn_global_load_lds((const __attribute__((address_space(1))) unsigned*)g, (__attribute__((address_space(3))) unsigned*)l, 16, 0, 0);
}
__device__ __forceinline__ float wave_sum(float v) {
#pragma unroll
  for (int o = 32; o > 0; o >>= 1) v += __shfl_xor(v, o);
  return v;
}
__device__ __forceinline__ void unpack8(const u32x4 u, float* f) {
  f[0] = __uint_as_float(u.x << 16); f[1] = __uint_as_float(u.x & 0xffff0000u);
  f[2] = __uint_as_float(u.y << 16); f[3] = __uint_as_float(u.y & 0xffff0000u);
  f[4] = __uint_as_float(u.z << 16); f[5] = __uint_as_float(u.z & 0xffff0000u);
  f[6] = __uint_as_float(u.w << 16); f[7] = __uint_as_float(u.w & 0xffff0000u);
}

__device__ __forceinline__ void tr_cvt_tile(const float* __restrict__ src, int N, int K, bf16_t* __restrict__ dst, int ldd, int rs, int ro, int tile, float* lds) {
  const int ntn = (N + 63) >> 6, tk = tile / ntn, tn = tile - tk * ntn, k0 = tk * 64, n0 = tn * 64, tid = TIDX;
#pragma unroll
  for (int ps = 0; ps < 4; ++ps) {
    const int i = ps * 16 + (tid >> 4), j = (tid & 15) * 4;
    float4 v = make_float4(0.f, 0.f, 0.f, 0.f);
    if (n0 + j < N) v = *(const float4*)(src + (size_t)(k0 + i) * N + n0 + j);
    float* d = lds + i * 65 + j; d[0] = v.x; d[1] = v.y; d[2] = v.z; d[3] = v.w;
  }
  __syncthreads();
  const int j = tid >> 2, kq = tid & 3, n = n0 + j;
  if (n < N) {
    unsigned w[8];
#pragma unroll
    for (int q = 0; q < 8; ++q) w[q] = pk2(lds[(kq * 16 + 2 * q) * 65 + j], lds[(kq * 16 + 2 * q + 1) * 65 + j]);
    bf16_t* o = dst + (size_t)((n >> 4) * rs + (n & 15) + ro) * ldd + k0 + kq * 16;
    *(uint4*)o = make_uint4(w[0], w[1], w[2], w[3]);
    *(uint4*)(o + 8) = make_uint4(w[4], w[5], w[6], w[7]);
  }
  __syncthreads();
}
__device__ __forceinline__ void tr_cvt(const float* src, int N, int K, bf16_t* dst, int ldd, int rs, int ro, float* lds) {
  const int nt = ((N + 63) >> 6) * (K >> 6);
  for (int t = blockIdx.x; t < nt; t += gridDim.x) tr_cvt_tile(src, N, K, dst, ldd, rs, ro, t, lds);
}

__device__ __forceinline__ void resnorm_phase(const float* hin, float* hout, const float* f, float scale, const float* gpost, const float* gpre, bf16_t* a) {
  const int lane = TIDX & 63;
  for (int row = blockIdx.x * 4 + (TIDX >> 6); row < M_TOK; row += gridDim.x * 4) {
    float4 hv[4];
#pragma unroll
    for (int i = 0; i < 4; ++i) hv[i] = *(const float4*)(hin + (size_t)row * 1024 + i * 256 + lane * 4);
    if (f) {
      float4 fv[4]; float ss = 0.f;
#pragma unroll
      for (int i = 0; i < 4; ++i) { fv[i] = *(const float4*)(f + (size_t)row * 1024 + i * 256 + lane * 4); ss += fv[i].x * fv[i].x + fv[i].y * fv[i].y + fv[i].z * fv[i].z + fv[i].w * fv[i].w; }
      ss = wave_sum(ss);
      const float r = rsqrtf(ss * (1.f / 1024.f) + 1e-6f) * scale;
#pragma unroll
      for (int i = 0; i < 4; ++i) { const float4 g = *(const float4*)(gpost + i * 256 + lane * 4);
        hv[i].x += fv[i].x * r * g.x; hv[i].y += fv[i].y * r * g.y; hv[i].z += fv[i].z * r * g.z; hv[i].w += fv[i].w * r * g.w; }
    }
#pragma unroll
    for (int i = 0; i < 4; ++i) *(float4*)(hout + (size_t)row * 1024 + i * 256 + lane * 4) = hv[i];
    if (a) {
      float ss = 0.f;
#pragma unroll
      for (int i = 0; i < 4; ++i) ss += hv[i].x * hv[i].x + hv[i].y * hv[i].y + hv[i].z * hv[i].z + hv[i].w * hv[i].w;
      ss = wave_sum(ss);
      const float r = rsqrtf(ss * (1.f / 1024.f) + 1e-6f);
#pragma unroll
      for (int i = 0; i < 4; ++i) { const float4 g = *(const float4*)(gpre + i * 256 + lane * 4);
        uint2 o; o.x = pk2(hv[i].x * r * g.x, hv[i].y * r * g.y); o.y = pk2(hv[i].z * r * g.z, hv[i].w * r * g.w);
        *(uint2*)(a + (size_t)row * 1024 + i * 256 + lane * 4) = o; }
    }
  }
}

__device__ __forceinline__ void prep_phase(const Params& P, char* ldsc) {
  float* lds = (float*)ldsc;
  char* ws = P.ws;
  for (int l = 0; l < 2; ++l) {
    for (int j = 0; j < 2; ++j) {
      const int lj = l * 2 + j;
      bf16_t* wgu = (bf16_t*)(ws + OFF_WGU + lj * SZ_WGU);
      tr_cvt(P.ffn_wg + (size_t)lj * 1024 * DFF, DFF, 1024, wgu, 1024, 32, 0, lds);
      tr_cvt(P.ffn_wu + (size_t)lj * 1024 * DFF, DFF, 1024, wgu, 1024, 32, 16, lds);
      tr_cvt(P.ffn_wd + (size_t)lj * DFF * 1024, 1024, DFF, (bf16_t*)(ws + OFF_WD + lj * SZ_WD), DFF, 16, 0, lds);
      tr_cvt(P.cmp_w1 + (size_t)lj * 2048 * 128, 128, 2048, (bf16_t*)(ws + OFF_CW1 + lj * SZ_CW1), 2048, 16, 0, lds);
    }
    tr_cvt(P.w_in + (size_t)l * 1024 * NIN, NIN, 1024, (bf16_t*)(ws + OFF_WIN + l * SZ_WIN), 1024, 16, 0, lds);
    tr_cvt(P.w_out + (size_t)l * 1024 * 1024, 1024, 1024, (bf16_t*)(ws + OFF_WOUT + l * SZ_SQ), 1024, 16, 0, lds);
    tr_cvt(P.ple_wg + (size_t)l * 1024 * 1024, 1024, 1024, (bf16_t*)(ws + OFF_WPG + l * SZ_SQ), 1024, 16, 0, lds);
    tr_cvt(P.ple_wp + (size_t)l * 256 * 1024, 1024, 256, (bf16_t*)(ws + OFF_WPP + l * SZ_WPP), 256, 16, 0, lds);
    for (int g = 0; g < 4; ++g) {
      tr_cvt(P.lru_wa + (size_t)(l * 4 + g) * 4096, 64, 64, (bf16_t*)(ws + OFF_WAT) + (l * 4 + g) * 4096, 64, 16, 0, lds);
      tr_cvt(P.lru_wx + (size_t)(l * 4 + g) * 4096, 64, 64, (bf16_t*)(ws + OFF_WXT) + (l * 4 + g) * 4096, 64, 16, 0, lds);
    }
  }
  const int gtid = blockIdx.x * 256 + TIDX, gn = gridDim.x * 256;
  for (int i = gtid; i < 2 * (LDZ - NIN) * 1024 / 8; i += gn) {
    const int l = i / ((LDZ - NIN) * 128), r = i - l * ((LDZ - NIN) * 128);
    *(uint4*)((bf16_t*)(ws + OFF_WIN + l * SZ_WIN) + (size_t)NIN * 1024 + (size_t)r * 8) = make_uint4(0, 0, 0, 0);
  }
  for (int i = gtid; i < 2 * 4 * 128 * 128; i += gn) { const int t = (i >> 7) & 127, s = i & 127; ((bf16_t*)(ws + OFF_SGUW))[i] = (s <= t) ? f2bf(P.sgu_w[i]) : (bf16_t)0; }
  for (int i = gtid; i < 2 * M_TOK * 256 / 4; i += gn) { const float4 v = ((const float4*)P.p)[i]; uint2 o; o.x = pk2(v.x, v.y); o.y = pk2(v.z, v.w); ((uint2*)(ws + OFF_PBF))[i] = o; }
  for (int u = blockIdx.x; u < 4; u += gridDim.x) {
    const int tid = TIDX, kq = tid >> 5, jq = tid & 31;
    const float* w1 = P.cmp_w1 + (size_t)u * 2048 * 128; const float* pos = P.cmp_pos + (size_t)u * 2048;
    float4 s = make_float4(0.f, 0.f, 0.f, 0.f);
    for (int k = kq * 256; k < kq * 256 + 256; ++k) { const float pv = pos[k]; const float4 w = *(const float4*)(w1 + (size_t)k * 128 + jq * 4); s.x += pv * w.x; s.y += pv * w.y; s.z += pv * w.z; s.w += pv * w.w; }
    __syncthreads();
    lds[kq * 128 + jq * 4 + 0] = s.x; lds[kq * 128 + jq * 4 + 1] = s.y; lds[kq * 128 + jq * 4 + 2] = s.z; lds[kq * 128 + jq * 4 + 3] = s.w;
    __syncthreads();
    if (tid < 128) { float t = P.cmp_b1[u * 128 + tid]; for (int q = 0; q < 8; ++q) t += lds[q * 128 + tid]; ((float*)(ws + OFF_CB1))[u * 128 + tid] = t; }
    __syncthreads();
  }
  resnorm_phase(P.x, P.out, nullptr, 0.f, nullptr, P.norm_g, (bf16_t*)(ws + OFF_A));
}

__device__ __forceinline__ void gemm_core(f32x4 (&acc)[4][4], const bf16_t* __restrict__ A, int lda, const bf16_t* __restrict__ Bt, int ldb, int K, char* lds) {
  const int tid = TIDX, lane = tid & 63, wid = tid >> 6, wr = wid >> 1, wc = wid & 1, fr = lane & 15, fq = lane >> 4;
  const int nk = K >> 6;
  const int rb = tid >> 3, csw = ((tid & 7) ^ (rb & 7)) * 8;
  const bf16_t* ga = A + (size_t)rb * lda + csw;
  const bf16_t* gb = Bt + (size_t)rb * ldb + csw;
  char* lw = lds + tid * 16;
#define GEMM_STAGE(kt, b)                                                                                              \
  {                                                                                                                    \
    _Pragma("unroll") for (int i = 0; i < 4; ++i) {                                                                    \
      glds16(ga + (size_t)(i * 32) * lda + (kt) * 64, lw + (b) * 32768 + i * 4096);                                    \
      glds16(gb + (size_t)(i * 32) * ldb + (kt) * 64, lw + (b) * 32768 + 16384 + i * 4096);                            \
    }                                                                                                                  \
  }
  GEMM_STAGE(0, 0);
#pragma nounroll
  for (int kt = 0; kt < nk; ++kt) {
    asm volatile("s_waitcnt vmcnt(0)" ::: "memory");
    __syncthreads();
    if (kt + 1 < nk) GEMM_STAGE(kt + 1, (kt + 1) & 1);
    const char* la = lds + (kt & 1) * 32768 + (wr * 64 + fr) * 128;
    const char* lb = lds + (kt & 1) * 32768 + 16384 + (wc * 64 + fr) * 128;
#pragma unroll
    for (int ks = 0; ks < 2; ++ks) {
      const int ch = ((ks * 4 + fq) ^ (fr & 7)) * 16;
      bf16x8 af[4], bfr[4];
#pragma unroll
      for (int m = 0; m < 4; ++m) af[m] = *(const bf16x8*)(la + m * 2048 + ch);
#pragma unroll
      for (int n = 0; n < 4; ++n) bfr[n] = *(const bf16x8*)(lb + n * 2048 + ch);
#pragma unroll
      for (int m = 0; m < 4; ++m)
#pragma unroll
        for (int n = 0; n < 4; ++n) acc[m][n] = mfma16(bfr[n], af[m], acc[m][n]);
    }
  }
  __syncthreads();
#undef GEMM_STAGE
}

template <class F> __device__ __forceinline__ void gemm_sched(int TN, F&& f) {
  const int npc = (TN + 3) >> 2, npatch = 16 * npc, xcd = blockIdx.x & 7, slot = blockIdx.x >> 3, nslot = gridDim.x >> 3;
  for (int pid = xcd; pid < npatch; pid += 8) {
    const int pr = pid / npc, pc = pid - pr * npc;
    for (int s = slot; s < 64; s += nslot) {
      const int tm = pr * 16 + (s & 15), tn = pc * 4 + (s >> 4);
      if (tn < TN) f(tm, tn);
    }
  }
}

#define GEMM_LANE const int lane_ = TIDX & 63, wid_ = TIDX >> 6, wr = wid_ >> 1, wc = wid_ & 1, fr = lane_ & 15, fq = lane_ >> 4

__device__ __forceinline__ void gemm_up_phase(const bf16_t* a, const bf16_t* wgu, bf16_t* act, char* lds) {
  gemm_sched(NGU / 128, [&](int tm, int tn) {
    f32x4 acc[4][4] = {};
    gemm_core(acc, a + (size_t)tm * 128 * 1024, 1024, wgu + (size_t)tn * 128 * 1024, 1024, 1024, lds);
    GEMM_LANE;
#pragma unroll
    for (int m = 0; m < 4; ++m) {
      const int row = tm * 128 + wr * 64 + m * 16 + fr;
#pragma unroll
      for (int i = 0; i < 2; ++i) {
        const int col = tn * 64 + wc * 32 + i * 16 + 4 * fq;
        const f32x4 g = acc[m][2 * i], u = acc[m][2 * i + 1];
        uint2 o; o.x = pk2(silu_f(g[0]) * u[0], silu_f(g[1]) * u[1]); o.y = pk2(silu_f(g[2]) * u[2], silu_f(g[3]) * u[3]);
        *(uint2*)(act + (size_t)row * DFF + col) = o;
      }
    }
  });
}

__device__ __forceinline__ void gemm_f32_phase(const bf16_t* A, int lda, const bf16_t* Bt, int K, float* out, char* lds) {
  gemm_sched(8, [&](int tm, int tn) {
    f32x4 acc[4][4] = {};
    gemm_core(acc, A + (size_t)tm * 128 * lda, lda, Bt + (size_t)tn * 128 * K, K, K, lds);
    GEMM_LANE;
#pragma unroll
    for (int m = 0; m < 4; ++m) {
      const int row = tm * 128 + wr * 64 + m * 16 + fr;
#pragma unroll
      for (int n = 0; n < 4; ++n) *(f32x4*)(out + (size_t)row * 1024 + tn * 128 + wc * 64 + n * 16 + 4 * fq) = acc[m][n];
    }
  });
}

__device__ __forceinline__ void gemm_in_phase(const bf16_t* a, const bf16_t* wint, bf16_t* z, char* lds) {
  gemm_sched(LDZ / 128, [&](int tm, int tn) {
    f32x4 acc[4][4] = {};
    gemm_core(acc, a + (size_t)tm * 128 * 1024, 1024, wint + (size_t)tn * 128 * 1024, 1024, 1024, lds);
    GEMM_LANE;
#pragma unroll
    for (int m = 0; m < 4; ++m) {
      const int row = tm * 128 + wr * 64 + m * 16 + fr;
#pragma unroll
      for (int n = 0; n < 4; ++n) {
        uint2 o; o.x = pk2(acc[m][n][0], acc[m][n][1]); o.y = pk2(acc[m][n][2], acc[m][n][3]);
        *(uint2*)(z + (size_t)row * LDZ + tn * 128 + wc * 64 + n * 16 + 4 * fq) = o;
      }
    }
  });
}

__device__ __forceinline__ void gemm_ple_phase(const bf16_t* a, const bf16_t* wpg, const bf16_t* pbf, const bf16_t* wpp, float* out, char* lds) {
  gemm_sched(8, [&](int tm, int tn) {
    f32x4 acc[4][4] = {};
    gemm_core(acc, pbf + (size_t)tm * 128 * 256, 256, wpp + (size_t)tn * 128 * 256, 256, 256, lds);
    u32x2 pp[4][4];
#pragma unroll
    for (int m = 0; m < 4; ++m)
#pragma unroll
      for (int n = 0; n < 4; ++n) { pp[m][n].x = pk2(acc[m][n][0], acc[m][n][1]); pp[m][n].y = pk2(acc[m][n][2], acc[m][n][3]); acc[m][n] = (f32x4){0.f, 0.f, 0.f, 0.f}; }
    gemm_core(acc, a + (size_t)tm * 128 * 1024, 1024, wpg + (size_t)tn * 128 * 1024, 1024, 1024, lds);
    GEMM_LANE;
#pragma unroll
    for (int m = 0; m < 4; ++m) {
      const int row = tm * 128 + wr * 64 + m * 16 + fr;
#pragma unroll
      for (int n = 0; n < 4; ++n) {
        f32x4 o;
        o[0] = sigm(acc[m][n][0]) * __uint_as_float(pp[m][n].x << 16); o[1] = sigm(acc[m][n][1]) * __uint_as_float(pp[m][n].x & 0xffff0000u);
        o[2] = sigm(acc[m][n][2]) * __uint_as_float(pp[m][n].y << 16); o[3] = sigm(acc[m][n][3]) * __uint_as_float(pp[m][n].y & 0xffff0000u);
        *(f32x4*)(out + (size_t)row * 1024 + tn * 128 + wc * 64 + n * 16 + 4 * fq) = o;
      }
    }
  });
}

__device__ __forceinline__ void mixA_item(const Params& P, int layer, int idx, const bf16_t* z, bf16_t* y, char* lds) {
  const int g = idx & 3, bc = idx >> 2, tok0 = bc * 128;
  const int tid = TIDX, lane = tid & 63, w = tid >> 6, fr = lane & 15, fq = lane >> 4;
  bf16_t* vT = (bf16_t*)lds;
  const float* ng = P.sgu_ng + layer * 256;
  {
    const int s = tid >> 1, half = tid & 1;
    const bf16_t* zr = z + (size_t)(tok0 + s) * LDZ + ZC_AV;
    float ss = 0.f;
#pragma unroll 4
    for (int i = 0; i < 16; ++i) { float v[8]; unpack8(*(const u32x4*)(zr + half * 128 + i * 8), v);
#pragma unroll
      for (int e = 0; e < 8; ++e) { const float t = gelu_t(v[e]); ss += t * t; } }
    ss += __shfl_xor(ss, 1);
    const float rs = rsqrtf(ss * (1.f / 256.f) + 1e-6f);
#pragma unroll
    for (int i = 0; i < 4; ++i) { float v[8]; unpack8(*(const u32x4*)(zr + g * 64 + half * 32 + i * 8), v);
#pragma unroll
      for (int e = 0; e < 8; ++e) { const int d = half * 32 + i * 8 + e; vT[d * 136 + s] = f2bf(gelu_t(v[e]) * rs * ng[g * 64 + d]); } }
  }
  __syncthreads();
  const bf16_t* W = (const bf16_t*)(P.ws + OFF_SGUW) + (size_t)((layer * 4 + g) * 128) * 128;
  f32x4 acc[2][4] = {};
  for (int ks = 0; ks <= w; ++ks) {
    bf16x8 wf[2], vf[4];
#pragma unroll
    for (int tm = 0; tm < 2; ++tm) wf[tm] = *(const bf16x8*)(W + (size_t)(32 * w + tm * 16 + fr) * 128 + ks * 32 + 8 * fq);
#pragma unroll
    for (int dn = 0; dn < 4; ++dn) vf[dn] = *(const bf16x8*)(vT + (dn * 16 + fr) * 136 + ks * 32 + 8 * fq);
#pragma unroll
    for (int tm = 0; tm < 2; ++tm)
#pragma unroll
      for (int dn = 0; dn < 4; ++dn) acc[tm][dn] = mfma16(vf[dn], wf[tm], acc[tm][dn]);
  }
#pragma unroll
  for (int tm = 0; tm < 2; ++tm) {
    const int t = 32 * w + tm * 16 + fr;
    const float bias = P.sgu_b[(layer * 4 + g) * 128 + t];
#pragma unroll
    for (int dn = 0; dn < 4; ++dn) {
      const int d = dn * 16 + 4 * fq;
      const uint2 uu = *(const uint2*)(z + (size_t)(tok0 + t) * LDZ + ZC_AU + g * 64 + d);
      const float u0 = gelu_t(__uint_as_float(uu.x << 16)), u1 = gelu_t(__uint_as_float(uu.x & 0xffff0000u)),
                  u2 = gelu_t(__uint_as_float(uu.y << 16)), u3 = gelu_t(__uint_as_float(uu.y & 0xffff0000u));
      uint2 o; o.x = pk2(u0 * (acc[tm][dn][0] + bias), u1 * (acc[tm][dn][1] + bias)); o.y = pk2(u2 * (acc[tm][dn][2] + bias), u3 * (acc[tm][dn][3] + bias));
      *(uint2*)(y + (size_t)(tok0 + t) * 1024 + g * 64 + d) = o;
    }
  }
  __syncthreads();
}

__device__ __forceinline__ void mixB1_item(const Params& P, int layer, int idx, const bf16_t* z, float* hsl, float* Pc, float* carryP, float* carryH, char* lds) {
  const int c = idx & 63, g = (idx >> 6) & 3, b = idx >> 8;
  const int tid = TIDX, lane = tid & 63, w = tid >> 6, fr = lane & 15, fq = lane >> 4;
  bf16_t* xcb = (bf16_t*)lds;
  float* xcf = (float*)(lds + 9216);
  float* aA = (float*)(lds + 9216 + 16384);
  float* bB = (float*)(lds + 9216 + 32768);
  float* sm = (float*)(lds + 9216 + 49152);
  const size_t tokb = (size_t)b * SEQ;
  {
    const int t = tid >> 2, q = tid & 3;
    float accv[16];
#pragma unroll
    for (int i = 0; i < 16; ++i) accv[i] = P.conv_b[layer * 256 + g * 64 + q * 16 + i];
#pragma unroll
    for (int k = 0; k < 4; ++k) {
      const int pos = c * 64 + t - 3 + k;
      if (pos >= 0) {
        const bf16_t* zr = z + (tokb + pos) * LDZ + ZC_BX + g * 64 + q * 16;
        float v[16]; unpack8(*(const u32x4*)zr, v); unpack8(*(const u32x4*)(zr + 8), v + 8);
        const float* cw = P.conv_w + (size_t)(layer * 4 + k) * 256 + g * 64 + q * 16;
#pragma unroll
        for (int i = 0; i < 16; ++i) accv[i] += v[i] * cw[i];
      }
    }
#pragma unroll
    for (int i = 0; i < 16; ++i) { xcf[t * 64 + q * 16 + i] = accv[i]; xcb[t * 72 + q * 16 + i] = f2bf(accv[i]); }
  }
  __syncthreads();
  {
    const bf16_t* wa = (const bf16_t*)(P.ws + OFF_WAT) + (layer * 4 + g) * 4096;
    const bf16_t* wx = (const bf16_t*)(P.ws + OFF_WXT) + (layer * 4 + g) * 4096;
    f32x4 ar[4] = {}, ai[4] = {};
#pragma unroll
    for (int ks = 0; ks < 2; ++ks) {
      const bf16x8 xf = *(const bf16x8*)(xcb + (16 * w + fr) * 72 + ks * 32 + 8 * fq);
#pragma unroll
      for (int jn = 0; jn < 4; ++jn) {
        const bf16x8 fa = *(const bf16x8*)(wa + (jn * 16 + fr) * 64 + ks * 32 + 8 * fq);
        const bf16x8 fx = *(const bf16x8*)(wx + (jn * 16 + fr) * 64 + ks * 32 + 8 * fq);
        ar[jn] = mfma16(fa, xf, ar[jn]); ai[jn] = mfma16(fx, xf, ai[jn]);
      }
    }
    const int t = 16 * w + fr;
#pragma unroll
    for (int jn = 0; jn < 4; ++jn)
#pragma unroll
      for (int e = 0; e < 4; ++e) {
        const int j = jn * 16 + 4 * fq + e, ch = layer * 256 + g * 64 + j;
        const float r = sigm(ar[jn][e] + P.lru_ba[ch]), ig = sigm(ai[jn][e] + P.lru_bx[ch]);
        const float lam = P.lru_lam[ch];
        const float la = -8.f * r * log1pf(__expf(-lam));
        const float av = __expf(la);
        const float bv = sqrtf(-expm1f(2.f * la)) * (ig * xcf[t * 64 + j]);
        aA[t * 64 + j] = av; bB[t * 64 + j] = bv;
      }
  }
  __syncthreads();
  {
    const int q = tid >> 6, j = tid & 63;
    float Pq = 1.f, hq = 0.f;
#pragma unroll
    for (int i = 0; i < 16; ++i) { const int t = q * 16 + i; const float av = aA[t * 64 + j], bv = bB[t * 64 + j]; hq = av * hq + bv; Pq *= av; aA[t * 64 + j] = Pq; bB[t * 64 + j] = hq; }
    sm[q * 64 + j] = Pq; sm[256 + q * 64 + j] = hq;
    __syncthreads();
    float Pin = 1.f, Hin = 0.f;
    for (int qq = 0; qq < q; ++qq) { const float pp = sm[qq * 64 + j], hh = sm[256 + qq * 64 + j]; Hin = pp * Hin + hh; Pin *= pp; }
    float hl = 0.f, pl = 1.f;
#pragma unroll
    for (int i = 0; i < 16; ++i) { const int t = q * 16 + i; hl = bB[t * 64 + j] + aA[t * 64 + j] * Hin; pl = aA[t * 64 + j] * Pin;
      const size_t o = (tokb + c * 64 + t) * 256 + g * 64 + j; hsl[o] = hl; Pc[o] = pl; }
    if (q == 3) { const int o = ((b * 4 + g) * 64 + c) * 64 + j; carryP[o] = pl; carryH[o] = hl; }
  }
  __syncthreads();
}

__device__ __forceinline__ void mixB2_item(int idx, const bf16_t* z, const float* hsl, const float* Pc, const float* carryP, const float* carryH, bf16_t* y) {
  const int c = idx & 63, g = (idx >> 6) & 3, b = idx >> 8;
  const int q = TIDX >> 6, j = TIDX & 63;
  const float* cp = carryP + (size_t)((b * 4 + g) * 64) * 64 + j;
  const float* chh = carryH + (size_t)((b * 4 + g) * 64) * 64 + j;
  float H = 0.f;
  for (int c0 = 0; c0 < c; c0 += 8) {
    float pv[8], hv[8];
#pragma unroll
    for (int i = 0; i < 8; ++i) { const bool ok = c0 + i < c; pv[i] = ok ? cp[(c0 + i) * 64] : 1.f; hv[i] = ok ? chh[(c0 + i) * 64] : 0.f; }
#pragma unroll
    for (int i = 0; i < 8; ++i) H = pv[i] * H + hv[i];
  }
  const size_t tokb = (size_t)b * SEQ + c * 64 + q * 16;
#pragma unroll 4
  for (int i = 0; i < 16; ++i) {
    const size_t o = (tokb + i) * 256 + g * 64 + j;
    const float h = hsl[o] + Pc[o] * H;
    const float gt = bf2f(z[(tokb + i) * LDZ + ZC_BG + g * 64 + j]);
    y[(tokb + i) * 1024 + 256 + g * 64 + j] = f2bf(h * gelu_t(gt));
  }
}

__device__ __forceinline__ void compress_item(const Params& P, int layer, int idx, const bf16_t* z, bf16_t* kcv, char* lds) {
  const int nb = idx & 7, g = (idx >> 3) & 1, b = (idx >> 4) & 7, kv = idx >> 7;
  const int tid = TIDX, lane = tid & 63, w = tid >> 6, fr = lane & 15, fq = lane >> 4;
  const int n0 = nb * 32, col = (kv ? ZC_VC : ZC_KC) + g * 64;
  const bf16_t* w1t = (const bf16_t*)(P.ws + OFF_CW1 + (size_t)(layer * 2 + kv) * SZ_CW1);
  float* hid = (float*)lds;
  f32x4 acc[2][2] = {};
  const bf16_t* zb[2]; const bf16_t* wb[2];
#pragma unroll
  for (int nf = 0; nf < 2; ++nf) { int n = n0 + nf * 16 + fr; if (n > 254) n = 254; zb[nf] = z + ((size_t)b * SEQ + 16 * n) * LDZ + col + 8 * fq; }
#pragma unroll
  for (int jf = 0; jf < 2; ++jf) wb[jf] = w1t + (size_t)(32 * w + jf * 16 + fr) * 2048 + 8 * fq;
#pragma unroll 4
  for (int ks = 0; ks < 64; ++ks) {
    const int l = ks >> 1, d0 = (ks & 1) * 32;
    bf16x8 xf[2], wf[2];
#pragma unroll
    for (int nf = 0; nf < 2; ++nf) xf[nf] = *(const bf16x8*)(zb[nf] + (size_t)l * LDZ + d0);
#pragma unroll
    for (int jf = 0; jf < 2; ++jf) wf[jf] = *(const bf16x8*)(wb[jf] + ks * 32);
#pragma unroll
    for (int jf = 0; jf < 2; ++jf)
#pragma unroll
      for (int nf = 0; nf < 2; ++nf) acc[jf][nf] = mfma16(wf[jf], xf[nf], acc[jf][nf]);
  }
  const float* cb1 = (const float*)(P.ws + OFF_CB1) + (layer * 2 + kv) * 128;
#pragma unroll
  for (int jf = 0; jf < 2; ++jf)
#pragma unroll
    for (int nf = 0; nf < 2; ++nf)
#pragma unroll
      for (int e = 0; e < 4; ++e) { const int j = 32 * w + jf * 16 + 4 * fq + e; hid[(nf * 16 + fr) * 129 + j] = gelu_t(acc[jf][nf][e] + cb1[j]); }
  __syncthreads();
  {
    const int n = tid >> 3, d0 = (tid & 7) * 8;
    const float* w2 = P.cmp_w2 + (size_t)(layer * 2 + kv) * 128 * 64 + d0;
    const float* b2 = P.cmp_b2 + (layer * 2 + kv) * 64 + d0;
    float o[8];
#pragma unroll
    for (int e = 0; e < 8; ++e) o[e] = b2[e];
    for (int j = 0; j < 128; ++j) {
      const float hv = hid[n * 129 + j]; const float4 wa = *(const float4*)(w2 + j * 64), wb2 = *(const float4*)(w2 + j * 64 + 4);
      o[0] += hv * wa.x; o[1] += hv * wa.y; o[2] += hv * wa.z; o[3] += hv * wa.w; o[4] += hv * wb2.x; o[5] += hv * wb2.y; o[6] += hv * wb2.z; o[7] += hv * wb2.w;
    }
    const bool valid = (n0 + n) < 255;
    uint4 ov = valid ? make_uint4(pk2(o[0], o[1]), pk2(o[2], o[3]), pk2(o[4], o[5]), pk2(o[6], o[7])) : make_uint4(0, 0, 0, 0);
    *(uint4*)(kcv + ((size_t)((kv * 8 + b) * 2 + g) * 256 + n0 + n) * 64 + d0) = ov;
  }
  __syncthreads();
}

constexpr int NSA_KT = 0, NSA_VT = 16384, NSA_BKT = 33792, NSA_RB = 37888, NSA_IMP = 38976, NSA_WU = 55616;

__device__ __forceinline__ void nsa_tables(const Params& P, char* lds) {
  unsigned char* bkt = (unsigned char*)(lds + NSA_BKT);
  float* rb = (float*)(lds + NSA_RB);
  for (int n = TIDX; n < 4096; n += 256) {
    int bk = n;
    if (n >= 16) bk = 16 + (n >= 21) + (n >= 27) + (n >= 35) + (n >= 46) + (n >= 59) + (n >= 77) + (n >= 99) + (n >= 128) + (n >= 166) + (n >= 216) + (n >= 280) + (n >= 363) + (n >= 470) + (n >= 609) + (n >= 790);
    bkt[n] = (unsigned char)bk;
  }
  rb[TIDX] = P.rel_bias[TIDX];
  if (TIDX < 8) rb[256 + TIDX] = -__builtin_inff();
  __syncthreads();
}

struct KVRegs { u32x4 k0, k1, v0, v1; };
__device__ __forceinline__ void kv_gload(KVRegs& r, const bf16_t* kb, const bf16_t* vb, size_t stride) {
  const int row = TIDX >> 2, cq = TIDX & 3;
  const bf16_t* kp = kb + row * stride + cq * 16; const bf16_t* vp = vb + row * stride + cq * 16;
  r.k0 = *(const u32x4*)kp; r.k1 = *(const u32x4*)(kp + 8); r.v0 = *(const u32x4*)vp; r.v1 = *(const u32x4*)(vp + 8);
}
__device__ __forceinline__ void kv_lwrite(const KVRegs& r, char* lds, int buf) {
  const int row = TIDX >> 2, cq = TIDX & 3;
  char* kt = lds + NSA_KT + buf * 8192 + row * 128;
  *(u32x4*)(kt + (((2 * cq) ^ (row & 7)) << 4)) = r.k0;
  *(u32x4*)(kt + (((2 * cq + 1) ^ (row & 7)) << 4)) = r.k1;
  bf16_t* vt = (bf16_t*)(lds + NSA_VT + buf * 8704) + (cq * 16) * 68 + row;
#pragma unroll
  for (int i = 0; i < 4; ++i) { vt[(2 * i) * 68] = (bf16_t)(r.v0[i] & 0xffffu); vt[(2 * i + 1) * 68] = (bf16_t)(r.v0[i] >> 16); }
#pragma unroll
  for (int i = 0; i < 4; ++i) { vt[(8 + 2 * i) * 68] = (bf16_t)(r.v1[i] & 0xffffu); vt[(8 + 2 * i + 1) * 68] = (bf16_t)(r.v1[i] >> 16); }
}

template <int MODE>
__device__ __forceinline__ void nsa_compute(int cur, int buf, int t, int hb, u64 mymask, const bf16x8 (&Qf)[2][2], f32x4 (&O)[4][2], float (&m)[2], float (&l)[2],
                                            const float (&inv)[2], float* impw, char* lds) {
  const int lane = TIDX & 63, fr = lane & 15, fq = lane >> 4;
  const unsigned char* bkt = (const unsigned char*)(lds + NSA_BKT);
  const float* rb = (const float*)(lds + NSA_RB);
  const char* kt = lds + NSA_KT + buf * 8192;
  const bf16_t* vt = (const bf16_t*)(lds + NSA_VT + buf * 8704);
  const bool selok = (MODE == 2) ? (((mymask >> cur) & 1ull) != 0ull) : true;
#pragma unroll
  for (int s2 = 0; s2 < 2; ++s2) {
    f32x4 S[2][2] = {};
#pragma unroll
    for (int ks = 0; ks < 2; ++ks)
#pragma unroll
      for (int kk = 0; kk < 2; ++kk) {
        const bf16x8 kf = *(const bf16x8*)(kt + (32 * s2 + 16 * kk + fr) * 128 + (((ks * 4 + fq) ^ (fr & 7)) << 4));
#pragma unroll
        for (int r = 0; r < 2; ++r) S[kk][r] = mfma16(kf, Qf[r][ks], S[kk][r]);
      }
    int bo[2][4];
#pragma unroll
    for (int kk = 0; kk < 2; ++kk)
#pragma unroll
      for (int e = 0; e < 4; ++e) {
        const int kl = cur * 64 + 32 * s2 + 16 * kk + 4 * fq + e;
        int dd; bool o;
        if (MODE <= 1) { dd = t - (16 * kl + 31); o = dd >= 0; }
        else if (MODE == 2) { dd = t - kl; o = (dd >= 0) && selok; }
        else { dd = t - kl; o = (dd >= 0) && (dd < 512); }
        bo[kk][e] = (o ? (int)bkt[dd] : 32) * 8 + hb;
      }
    bf16x8 Pf[2];
    float g1s[2] = {0.f, 0.f}, p3s[2] = {0.f, 0.f};
#pragma unroll
    for (int r = 0; r < 2; ++r) {
      float sv[2][4];
#pragma unroll
      for (int kk = 0; kk < 2; ++kk)
#pragma unroll
        for (int e = 0; e < 4; ++e) sv[kk][e] = S[kk][r][e] * 0.125f + rb[bo[kk][e] + r];
      float pv[2][4];
      if (MODE == 1) {
#pragma unroll
        for (int kk = 0; kk < 2; ++kk)
#pragma unroll
          for (int e = 0; e < 4; ++e) pv[kk][e] = __expf(sv[kk][e] - m[r]) * inv[r];
#pragma unroll
        for (int kk = 0; kk < 2; ++kk) { g1s[kk] += pv[kk][0] + pv[kk][1] + pv[kk][2] + 0.5f * pv[kk][3]; p3s[kk] += 0.5f * pv[kk][3]; }
      } else {
        float mx = fmaxf(fmaxf(fmaxf(sv[0][0], sv[0][1]), fmaxf(sv[0][2], sv[0][3])), fmaxf(fmaxf(sv[1][0], sv[1][1]), fmaxf(sv[1][2], sv[1][3])));
        mx = fmaxf(mx, __shfl_xor(mx, 16)); mx = fmaxf(mx, __shfl_xor(mx, 32));
        const float mn = fmaxf(m[r], mx), al = __expf(m[r] - mn);
        m[r] = mn;
        float ps = 0.f;
#pragma unroll
        for (int kk = 0; kk < 2; ++kk)
#pragma unroll
          for (int e = 0; e < 4; ++e) { pv[kk][e] = __expf(sv[kk][e] - mn); ps += pv[kk][e]; }
        l[r] = l[r] * al + ps;
        if (MODE != 0) {
#pragma unroll
          for (int df = 0; df < 4; ++df) O[df][r] *= al;
        }
      }
      if (MODE != 0) {
        const unsigned w0 = pk2(pv[0][0], pv[0][1]), w1 = pk2(pv[0][2], pv[0][3]), w2 = pk2(pv[1][0], pv[1][1]), w3 = pk2(pv[1][2], pv[1][3]);
        Pf[r][0] = (short)(w0 & 0xffff); Pf[r][1] = (short)(w0 >> 16); Pf[r][2] = (short)(w1 & 0xffff); Pf[r][3] = (short)(w1 >> 16);
        Pf[r][4] = (short)(w2 & 0xffff); Pf[r][5] = (short)(w2 >> 16); Pf[r][6] = (short)(w3 & 0xffff); Pf[r][7] = (short)(w3 >> 16);
      }
    }
    if (MODE != 0) {
#pragma unroll
      for (int df = 0; df < 4; ++df) {
        const bf16x4 va = *(const bf16x4*)(vt + (df * 16 + fr) * 68 + 32 * s2 + 4 * fq);
        const bf16x4 vb = *(const bf16x4*)(vt + (df * 16 + fr) * 68 + 32 * s2 + 16 + 4 * fq);
        bf16x8 vf; vf[0] = va[0]; vf[1] = va[1]; vf[2] = va[2]; vf[3] = va[3]; vf[4] = vb[0]; vf[5] = vb[1]; vf[6] = vb[2]; vf[7] = vb[3];
#pragma unroll
        for (int r = 0; r < 2; ++r) O[df][r] = mfma16(vf, Pf[r], O[df][r]);
      }
    }
    if (MODE == 1) {
#pragma unroll
      for (int kk = 0; kk < 2; ++kk) {
        const int j = cur * 16 + (2 * s2 + kk) * 4 + fq;
        atomicAdd(&impw[fr * 65 + j], g1s[kk]);
        if (j + 1 < 64) atomicAdd(&impw[fr * 65 + j + 1], p3s[kk]);
      }
    }
  }
}

template <int MODE>
__device__ __forceinline__ void nsa_branch(int first, int ntl, u64 U, const bf16_t* kbase, const bf16_t* vbase, size_t stride, int t, int hb, u64 mymask,
                                           const bf16x8 (&Qf)[2][2], f32x4 (&O)[4][2], float (&m)[2], float (&l)[2], const float (&inv)[2], float* impw, char* lds) {
  KVRegs kr;
  int nxt, left = ntl;
  u64 rem = U;
  if (MODE == 2) { nxt = rem ? (int)__builtin_ctzll(rem) : -1; if (rem) rem &= rem - 1; }
  else { nxt = ntl > 0 ? first : -1; }
  if (nxt >= 0) { kv_gload(kr, kbase + (size_t)nxt * 64 * stride, vbase + (size_t)nxt * 64 * stride, stride); kv_lwrite(kr, lds, 0); }
  __syncthreads();
  int buf = 0;
  while (nxt >= 0) {
    const int cur = nxt;
    if (MODE == 2) { nxt = rem ? (int)__builtin_ctzll(rem) : -1; if (rem) rem &= rem - 1; }
    else { --left; nxt = left > 0 ? cur + 1 : -1; }
    if (nxt >= 0) kv_gload(kr, kbase + (size_t)nxt * 64 * stride, vbase + (size_t)nxt * 64 * stride, stride);
    nsa_compute<MODE>(cur, buf, t, hb, mymask, Qf, O, m, l, inv, impw, lds);
    if (nxt >= 0) kv_lwrite(kr, lds, buf ^ 1);
    __syncthreads();
    buf ^= 1;
  }
}

#define NSA_RESET()                                                                         \
  _Pragma("unroll") for (int r = 0; r < 2; ++r) { m[r] = -1e30f; l[r] = 0.f; }               \
  _Pragma("unroll") for (int df = 0; df < 4; ++df) _Pragma("unroll") for (int r = 0; r < 2; ++r) O[df][r] = (f32x4){0.f, 0.f, 0.f, 0.f};
#define NSA_LOADQ(hp)                                                                       \
  _Pragma("unroll") for (int r = 0; r < 2; ++r) _Pragma("unroll") for (int ks = 0; ks < 2; ++ks)  \
      Qf[r][ks] = *(const bf16x8*)(zq + ZC_Q + g * 256 + ((hp) * 2 + r) * 64 + ks * 32 + 8 * fq);

__device__ __forceinline__ void nsa_item(const Params& P, int b, int g, int c, const bf16_t* z, const bf16_t* kcv, bf16_t* y, char* lds) {
  const int tid = TIDX, lane = tid & 63, w = tid >> 6, fr = lane & 15, fq = lane >> 4;
  const size_t tokb = (size_t)b * SEQ;
  const int t = c * 64 + 16 * w + fr;
  const bf16_t* zq = z + (tokb + t) * LDZ;
  bf16x8 Qf[2][2];
  float* impw = (float*)(lds + NSA_IMP) + w * (16 * 65);
  for (int i = lane; i < 16 * 65; i += 64) impw[i] = 0.f;
  f32x4 O[4][2];
  float m[2], l[2], inv[2];
  bf16_t* yo = y + (tokb + t) * 1024 + 512 + g * 256 + 4 * fq;
  const bf16_t* kc = kcv + (size_t)((0 * 8 + b) * 2 + g) * 256 * 64;
  const bf16_t* vc = kcv + (size_t)((1 * 8 + b) * 2 + g) * 256 * 64;
  const int nct = ((4 * c + 2) >> 6) + 1;
  for (int hp = 0; hp < 2; ++hp) {
    NSA_LOADQ(hp);
    NSA_RESET();
    inv[0] = 0.f; inv[1] = 0.f;
    nsa_branch<0>(0, nct, 0ull, kc, vc, 64, t, g * 4 + hp * 2, 0ull, Qf, O, m, l, inv, impw, lds);
#pragma unroll
    for (int r = 0; r < 2; ++r) { float lt = l[r]; lt += __shfl_xor(lt, 16); lt += __shfl_xor(lt, 32); inv[r] = lt > 0.f ? 1.f / lt : 0.f; }
    nsa_branch<1>(0, nct, 0ull, kc, vc, 64, t, g * 4 + hp * 2, 0ull, Qf, O, m, l, inv, impw, lds);
#pragma unroll
    for (int r = 0; r < 2; ++r) {
      const float gt = sigm(bf2f(zq[ZC_GC + g * 4 + hp * 2 + r]));
#pragma unroll
      for (int df = 0; df < 4; ++df) { u32x2 o; o.x = pk2(O[df][r][0] * gt, O[df][r][1] * gt); o.y = pk2(O[df][r][2] * gt, O[df][r][3] * gt); *(u32x2*)(yo + (hp * 2 + r) * 64 + df * 16) = o; }
    }
  }
  __syncthreads();
  u64 mymask = 0ull, wU = 0ull;
  for (int qq = 0; qq < 16; ++qq) {
    const float s = impw[qq * 65 + lane];
    const int j = lane;
    const bool forced = (j == 0) | (j == c) | (j == c - 1);
    const float sc = (j <= c) ? (forced ? 1e4f : s) : -1.0f;
    int rank = 0;
#pragma unroll 16
    for (int k = 0; k < 64; ++k) { const float sk = __int_as_float(__builtin_amdgcn_readlane(__float_as_int(sc), k)); rank += ((sk > sc) || (sk == sc && k < j)) ? 1 : 0; }
    const bool sel = (rank < 16) && (sc >= 0.f);
    const u64 mk = __ballot(sel);
    if (fr == qq) mymask = mk;
    wU |= mk;
  }
  u64* WU = (u64*)(lds + NSA_WU);
  if (lane == 0) WU[w] = wU;
  __syncthreads();
  const u64 U = WU[0] | WU[1] | WU[2] | WU[3];
  for (int br = 0; br < 2; ++br) {
    for (int hp = 0; hp < 2; ++hp) {
      NSA_LOADQ(hp);
      NSA_RESET();
      int zg;
      if (br == 0) {
        nsa_branch<2>(0, 0, U, z + tokb * LDZ + ZC_KS + g * 64, z + tokb * LDZ + ZC_VS + g * 64, LDZ, t, g * 4 + hp * 2, mymask, Qf, O, m, l, inv, impw, lds);
        zg = ZC_GS;
      } else {
        const int kt0 = c > 8 ? c - 8 : 0;
        nsa_branch<3>(kt0, c - kt0 + 1, 0ull, z + tokb * LDZ + ZC_KW + g * 64, z + tokb * LDZ + ZC_VW + g * 64, LDZ, t, g * 4 + hp * 2, 0ull, Qf, O, m, l, inv, impw, lds);
        zg = ZC_GW;
      }
#pragma unroll
      for (int r = 0; r < 2; ++r) {
        float lt = l[r]; lt += __shfl_xor(lt, 16); lt += __shfl_xor(lt, 32);
        const float gt = sigm(bf2f(zq[zg + g * 4 + hp * 2 + r])) * (lt > 0.f ? 1.f / lt : 0.f);
#pragma unroll
        for (int df = 0; df < 4; ++df) {
          bf16_t* yp = yo + (hp * 2 + r) * 64 + df * 16;
          const u32x2 pr = *(const u32x2*)yp;
          u32x2 o; o.x = pk2(__uint_as_float(pr.x << 16) + O[df][r][0] * gt, __uint_as_float(pr.x & 0xffff0000u) + O[df][r][1] * gt);
          o.y = pk2(__uint_as_float(pr.y << 16) + O[df][r][2] * gt, __uint_as_float(pr.y & 0xffff0000u) + O[df][r][3] * gt);
          *(u32x2*)yp = o;
        }
      }
    }
  }
  __syncthreads();
}

__device__ __forceinline__ void run_phase(const Params& P, int ph, char* lds) {
  char* ws = P.ws;
  bf16_t* abuf = (bf16_t*)(ws + OFF_A);
  bf16_t* big = (bf16_t*)(ws + OFF_BIG);
  float* fbuf = (float*)(ws + OFF_F);
  float* hsl = fbuf; float* Pc = fbuf + (size_t)M_TOK * 256;
  bf16_t* kcv = (bf16_t*)(ws + OFF_KC);
  float* carryP = (float*)(ws + OFF_CARRY); float* carryH = carryP + 8 * 4 * 64 * 64;
  if (ph == 0) { prep_phase(P, lds); return; }
  const int layer = (ph - 1) / 13, sp = (ph - 1) % 13;
  const float* ng = P.norm_g + (size_t)layer * 8 * 1024;
#ifdef ONLY_SP
  if (sp != ONLY_SP) return;
#endif
  switch (sp) {
    case 0: case 8: {
      const int lj = layer * 2 + (sp == 8);
      gemm_up_phase(abuf, (const bf16_t*)(ws + OFF_WGU + lj * SZ_WGU), big, lds);
    } break;
    case 1: case 9: {
      const int lj = layer * 2 + (sp == 9);
      gemm_f32_phase(big, DFF, (const bf16_t*)(ws + OFF_WD + lj * SZ_WD), DFF, fbuf, lds);
    } break;
    case 2: resnorm_phase(P.out, P.out, fbuf, 0.5f, ng + 1 * 1024, ng + 2 * 1024, abuf); break;
    case 3: gemm_in_phase(abuf, (const bf16_t*)(ws + OFF_WIN + layer * SZ_WIN), big, lds); break;
    case 4:
      for (int it = blockIdx.x; it < 256 + 1024 + 2048; it += gridDim.x) {
        if (it < 256) compress_item(P, layer, it, big, kcv, lds);
        else if (it < 1280) mixA_item(P, layer, it - 256, big, abuf, lds);
        else mixB1_item(P, layer, it - 1280, big, hsl, Pc, carryP, carryH, lds);
      }
      break;
    case 5:
      nsa_tables(P, lds);
      for (int it = blockIdx.x; it < 1024 + 2048; it += gridDim.x) {
        if (it < 1024) { const int c = it < 512 ? 63 - (it >> 4) : ((it - 512) >> 4); const int bg = it & 15; nsa_item(P, bg >> 1, bg & 1, c, big, kcv, abuf, lds); }
        else mixB2_item(it - 1024, big, hsl, Pc, carryP, carryH, abuf);
      }
      break;
    case 6: gemm_f32_phase(abuf, 1024, (const bf16_t*)(ws + OFF_WOUT + layer * SZ_SQ), 1024, fbuf, lds); break;
    case 7: resnorm_phase(P.out, P.out, fbuf, 1.0f, ng + 3 * 1024, ng + 4 * 1024, abuf); break;
    case 10: resnorm_phase(P.out, P.out, fbuf, 0.5f, ng + 5 * 1024, ng + 6 * 1024, abuf); break;
    case 11:
      gemm_ple_phase(abuf, (const bf16_t*)(ws + OFF_WPG + layer * SZ_SQ), (const bf16_t*)(ws + OFF_PBF) + (size_t)layer * M_TOK * 256,
                     (const bf16_t*)(ws + OFF_WPP + layer * SZ_WPP), fbuf, lds);
      break;
    case 12: resnorm_phase(P.out, P.out, fbuf, 1.0f, ng + 7 * 1024, layer == 0 ? P.norm_g + 8 * 1024 : nullptr, layer == 0 ? abuf : nullptr); break;
  }
}

__global__ void __launch_bounds__(256, 2) fwd_megakernel(Params P) {
  __shared__ __attribute__((aligned(16))) char lds[65536];
  cg::grid_group grid = cg::this_grid();
  for (int ph = 0; ph < NPHASE; ++ph) {
    run_phase(P, ph, lds);
    if (ph + 1 < NPHASE) grid.sync();
  }
}

__global__ void __launch_bounds__(256, 2) phase_kernel(Params P, int ph) {
  __shared__ __attribute__((aligned(16))) char lds[65536];
  run_phase(P, ph, lds);
}

extern "C" void kernel_launch(void* const* d_in, const int* in_sizes, int n_in, void* d_out, int out_size, void* d_ws, size_t ws_size, hipStream_t stream) {
  Params P{};
  const float** pp = (const float**)&P;
  for (int i = 0; i < 26; ++i) pp[i] = (const float*)d_in[i];
  P.out = (float*)d_out;
  P.ws = (char*)d_ws;
  if (ws_size < WS_NEED) { fprintf(stderr, "workspace too small: %zu < %zu\n", ws_size, (size_t)WS_NEED); return; }
#if MK_FUSED
  static int grid_blocks = 0;
  if (!grid_blocks) {
    int dev = 0, cus = 0, per_cu = 0;
    hipGetDevice(&dev);
    hipDeviceGetAttribute(&cus, hipDeviceAttributeMultiprocessorCount, dev);
    hipOccupancyMaxActiveBlocksPerMultiprocessor(&per_cu, fwd_megakernel, 256, 0);
    if (per_cu > 2) per_cu = 2;
    if (per_cu < 1) per_cu = 1;
    grid_blocks = cus * per_cu;
  }
  void* args[] = {&P};
  hipError_t e = hipLaunchCooperativeKernel((void*)fwd_megakernel, dim3(grid_blocks), dim3(256), args, 0, stream);
  if (e != hipSuccess) fprintf(stderr, "cooperative launch failed: %s (grid %d)\n", hipGetErrorString(e), grid_blocks);
#else
  for (int ph = 0; ph < NPHASE; ++ph) phase_kernel<<<512, 256, 0, stream>>>(P, ph);
#endif
}
```

```cpp
#include <hip/hip_runtime.h>
#include <hip/hip_cooperative_groups.h>
#include <cstdint>
#include <cstdio>
namespace cg = cooperative_groups;

#ifndef MK_FUSED
#define MK_FUSED 1
#endif

typedef unsigned short bf16_t;
typedef short bf16x8 __attribute__((ext_vector_type(8)));
typedef short bf16x4 __attribute__((ext_vector_type(4)));
typedef float f32x4 __attribute__((ext_vector_type(4)));
typedef unsigned long long u64;
typedef unsigned u32x4 __attribute__((ext_vector_type(4)));
typedef unsigned u32x2 __attribute__((ext_vector_type(2)));

constexpr int M_TOK = 32768, DM = 1024, DFF = 2816, NGU = 5632, NIN = 2328, LDZ = 2432, SEQ = 4096;
constexpr int NPHASE = 27;
constexpr int ZC_AU = 0, ZC_AV = 256, ZC_BX = 512, ZC_BG = 768, ZC_Q = 1024, ZC_KC = 1536, ZC_VC = 1664, ZC_KS = 1792, ZC_VS = 1920,
              ZC_KW = 2048, ZC_VW = 2176, ZC_GC = 2304, ZC_GS = 2312, ZC_GW = 2320;

constexpr size_t SZ_WGU = (size_t)NGU * 1024 * 2, SZ_WD = (size_t)1024 * DFF * 2, SZ_WIN = (size_t)LDZ * 1024 * 2, SZ_SQ = (size_t)1024 * 1024 * 2,
                 SZ_WPP = (size_t)1024 * 256 * 2, SZ_CW1 = (size_t)128 * 2048 * 2;
constexpr size_t OFF_WGU = 0;
constexpr size_t OFF_WD = OFF_WGU + 4 * SZ_WGU;
constexpr size_t OFF_WIN = OFF_WD + 4 * SZ_WD;
constexpr size_t OFF_WOUT = OFF_WIN + 2 * SZ_WIN;
constexpr size_t OFF_WPG = OFF_WOUT + 2 * SZ_SQ;
constexpr size_t OFF_WPP = OFF_WPG + 2 * SZ_SQ;
constexpr size_t OFF_CW1 = OFF_WPP + 2 * SZ_WPP;
constexpr size_t OFF_CB1 = OFF_CW1 + 4 * SZ_CW1;
constexpr size_t OFF_SGUW = OFF_CB1 + 4096;
constexpr size_t OFF_WAT = OFF_SGUW + 2 * 4 * 128 * 128 * 2;
constexpr size_t OFF_WXT = OFF_WAT + 2 * 4 * 64 * 64 * 2;
constexpr size_t OFF_PBF = OFF_WXT + 2 * 4 * 64 * 64 * 2;
constexpr size_t OFF_A = OFF_PBF + (size_t)2 * M_TOK * 256 * 2;
constexpr size_t OFF_BIG = OFF_A + (size_t)M_TOK * 1024 * 2;
constexpr size_t OFF_F = OFF_BIG + (size_t)M_TOK * DFF * 2;
constexpr size_t OFF_KC = OFF_F + (size_t)M_TOK * 1024 * 4;
constexpr size_t OFF_CARRY = OFF_KC + (size_t)2 * 8 * 2 * 256 * 64 * 2;
constexpr size_t OFF_BAR = OFF_CARRY + (size_t)2 * 8 * 4 * 64 * 64 * 4;
constexpr size_t WS_NEED = OFF_BAR + 16384;

struct Params {
  const float *x, *p, *rel_bias, *norm_g, *ffn_wg, *ffn_wu, *ffn_wd, *w_in, *w_out, *sgu_ng, *sgu_w, *sgu_b, *conv_w, *conv_b,
      *lru_wa, *lru_ba, *lru_wx, *lru_bx, *lru_lam, *cmp_pos, *cmp_w1, *cmp_b1, *cmp_w2, *cmp_b2, *ple_wg, *ple_wp;
  float* out;
  char* ws;
};

__device__ __forceinline__ int opaque_tid() { int t; asm volatile("v_mov_b32 %0, %1" : "=v"(t) : "v"(threadIdx.x)); return t; }
#define TIDX opaque_tid()
__device__ __forceinline__ float bf2f(bf16_t v) { return __uint_as_float(((unsigned)v) << 16); }
__device__ __forceinline__ bf16_t f2bf(float f) { unsigned u = __float_as_uint(f); u += 0x7fffu + ((u >> 16) & 1u); return (bf16_t)(u >> 16); }
__device__ __forceinline__ unsigned pk2(float lo, float hi) { return (unsigned)f2bf(lo) | ((unsigned)f2bf(hi) << 16); }
__device__ __forceinline__ float sigm(float x) { return 1.f / (1.f + __expf(-x)); }
__device__ __forceinline__ float gelu_t(float x) { float u = 0.7978845608028654f * (x + 0.044715f * x * x * x); return x / (1.f + __expf(-2.f * u)); }
__device__ __forceinline__ float silu_f(float x) { return x / (1.f + __expf(-x)); }
__device__ __forceinline__ f32x4 mfma16(bf16x8 a, bf16x8 b, f32x4 c) { return __builtin_amdgcn_mfma_f32_16x16x32_bf16(a, b, c, 0, 0, 0); }
__device__ __forceinline__ void glds16(const void* g, void* l) {
  __builtin_amdgcn_global_load_lds((const __attribute__((address_space(1))) unsigned*)g, (__attribute__((address_space(3))) unsigned*)l, 16, 0, 0);
}
__device__ __forceinline__ float wave_sum(float v) {
#pragma unroll
  for (int o = 32; o > 0; o >>= 1) v += __shfl_xor(v, o);
  return v;
}
__device__ __forceinline__ void unpack8(const u32x4 u, float* f) {
  f[0] = __uint_as_float(u.x << 16); f[1] = __uint_as_float(u.x & 0xffff0000u);
  f[2] = __uint_as_float(u.y << 16); f[3] = __uint_as_float(u.y & 0xffff0000u);
  f[4] = __uint_as_float(u.z << 16); f[5] = __uint_as_float(u.z & 0xffff0000u);
  f[6] = __uint_as_float(u.w << 16); f[7] = __uint_as_float(u.w & 0xffff0000u);
}

__device__ __forceinline__ void tr_cvt_tile(const float* __restrict__ src, int N, int K, bf16_t* __restrict__ dst, int ldd, int rs, int ro, int tile, float* lds) {
  const int ntn = (N + 63) >> 6, tk = tile / ntn, tn = tile - tk * ntn, k0 = tk * 64, n0 = tn * 64, tid = TIDX;
#pragma unroll
  for (int ps = 0; ps < 4; ++ps) {
    const int i = ps * 16 + (tid >> 4), j = (tid & 15) * 4;
    float4 v = make_float4(0.f, 0.f, 0.f, 0.f);
    if (n0 + j < N) v = *(const float4*)(src + (size_t)(k0 + i) * N + n0 + j);
    float* d = lds + i * 65 + j; d[0] = v.x; d[1] = v.y; d[2] = v.z; d[3] = v.w;
  }
  __syncthreads();
  const int j = tid >> 2, kq = tid & 3, n = n0 + j;
  if (n < N) {
    unsigned w[8];
#pragma unroll
    for (int q = 0; q < 8; ++q) w[q] = pk2(lds[(kq * 16 + 2 * q) * 65 + j], lds[(kq * 16 + 2 * q + 1) * 65 + j]);
    bf16_t* o = dst + (size_t)((n >> 4) * rs + (n & 15) + ro) * ldd + k0 + kq * 16;
    *(uint4*)o = make_uint4(w[0], w[1], w[2], w[3]);
    *(uint4*)(o + 8) = make_uint4(w[4], w[5], w[6], w[7]);
  }
  __syncthreads();
}
__device__ __forceinline__ void tr_cvt(const float* src, int N, int K, bf16_t* dst, int ldd, int rs, int ro, float* lds) {
  const int nt = ((N + 63) >> 6) * (K >> 6);
  for (int t = blockIdx.x; t < nt; t += gridDim.x) tr_cvt_tile(src, N, K, dst, ldd, rs, ro, t, lds);
}

__device__ __forceinline__ void resnorm_phase(const float* hin, float* hout, const float* f, float scale, const float* gpost, const float* gpre, bf16_t* a) {
  const int lane = TIDX & 63;
  for (int row = blockIdx.x * 4 + (TIDX >> 6); row < M_TOK; row += gridDim.x * 4) {
    float4 hv[4];
#pragma unroll
    for (int i = 0; i < 4; ++i) hv[i] = *(const float4*)(hin + (size_t)row * 1024 + i * 256 + lane * 4);
    if (f) {
      float4 fv[4]; float ss = 0.f;
#pragma unroll
      for (int i = 0; i < 4; ++i) { fv[i] = *(const float4*)(f + (size_t)row * 1024 + i * 256 + lane * 4); ss += fv[i].x * fv[i].x + fv[i].y * fv[i].y + fv[i].z * fv[i].z + fv[i].w * fv[i].w; }
      ss = wave_sum(ss);
      const float r = rsqrtf(ss * (1.f / 1024.f) + 1e-6f) * scale;
#pragma unroll
      for (int i = 0; i < 4; ++i) { const float4 g = *(const float4*)(gpost + i * 256 + lane * 4);
        hv[i].x += fv[i].x * r * g.x; hv[i].y += fv[i].y * r * g.y; hv[i].z += fv[i].z * r * g.z; hv[i].w += fv[i].w * r * g.w; }
    }
#pragma unroll
    for (int i = 0; i < 4; ++i) *(float4*)(hout + (size_t)row * 1024 + i * 256 + lane * 4) = hv[i];
    if (a) {
      float ss = 0.f;
#pragma unroll
      for (int i = 0; i < 4; ++i) ss += hv[i].x * hv[i].x + hv[i].y * hv[i].y + hv[i].z * hv[i].z + hv[i].w * hv[i].w;
      ss = wave_sum(ss);
      const float r = rsqrtf(ss * (1.f / 1024.f) + 1e-6f);
#pragma unroll
      for (int i = 0; i < 4; ++i) { const float4 g = *(const float4*)(gpre + i * 256 + lane * 4);
        uint2 o; o.x = pk2(hv[i].x * r * g.x, hv[i].y * r * g.y); o.y = pk2(hv[i].z * r * g.z, hv[i].w * r * g.w);
        *(uint2*)(a + (size_t)row * 1024 + i * 256 + lane * 4) = o; }
    }
  }
}

__device__ __forceinline__ void prep_phase(const Params& P, char* ldsc) {
  float* lds = (float*)ldsc;
  char* ws = P.ws;
  for (int l = 0; l < 2; ++l) {
    for (int j = 0; j < 2; ++j) {
      const int lj = l * 2 + j;
      bf16_t* wgu = (bf16_t*)(ws + OFF_WGU + lj * SZ_WGU);
      tr_cvt(P.ffn_wg + (size_t)lj * 1024 * DFF, DFF, 1024, wgu, 1024, 32, 0, lds);
      tr_cvt(P.ffn_wu + (size_t)lj * 1024 * DFF, DFF, 1024, wgu, 1024, 32, 16, lds);
      tr_cvt(P.ffn_wd + (size_t)lj * DFF * 1024, 1024, DFF, (bf16_t*)(ws + OFF_WD + lj * SZ_WD), DFF, 16, 0, lds);
      tr_cvt(P.cmp_w1 + (size_t)lj * 2048 * 128, 128, 2048, (bf16_t*)(ws + OFF_CW1 + lj * SZ_CW1), 2048, 16, 0, lds);
    }
    tr_cvt(P.w_in + (size_t)l * 1024 * NIN, NIN, 1024, (bf16_t*)(ws + OFF_WIN + l * SZ_WIN), 1024, 16, 0, lds);
    tr_cvt(P.w_out + (size_t)l * 1024 * 1024, 1024, 1024, (bf16_t*)(ws + OFF_WOUT + l * SZ_SQ), 1024, 16, 0, lds);
    tr_cvt(P.ple_wg + (size_t)l * 1024 * 1024, 1024, 1024, (bf16_t*)(ws + OFF_WPG + l * SZ_SQ), 1024, 16, 0, lds);
    tr_cvt(P.ple_wp + (size_t)l * 256 * 1024, 1024, 256, (bf16_t*)(ws + OFF_WPP + l * SZ_WPP), 256, 16, 0, lds);
    for (int g = 0; g < 4; ++g) {
      tr_cvt(P.lru_wa + (size_t)(l * 4 + g) * 4096, 64, 64, (bf16_t*)(ws + OFF_WAT) + (l * 4 + g) * 4096, 64, 16, 0, lds);
      tr_cvt(P.lru_wx + (size_t)(l * 4 + g) * 4096, 64, 64, (bf16_t*)(ws + OFF_WXT) + (l * 4 + g) * 4096, 64, 16, 0, lds);
    }
  }
  const int gtid = blockIdx.x * 256 + TIDX, gn = gridDim.x * 256;
  for (int i = gtid; i < 2 * (LDZ - NIN) * 1024 / 8; i += gn) {
    const int l = i / ((LDZ - NIN) * 128), r = i - l * ((LDZ - NIN) * 128);
    *(uint4*)((bf16_t*)(ws + OFF_WIN + l * SZ_WIN) + (size_t)NIN * 1024 + (size_t)r * 8) = make_uint4(0, 0, 0, 0);
  }
  for (int i = gtid; i < 2 * 4 * 128 * 128; i += gn) { const int t = (i >> 7) & 127, s = i & 127; ((bf16_t*)(ws + OFF_SGUW))[i] = (s <= t) ? f2bf(P.sgu_w[i]) : (bf16_t)0; }
  for (int i = gtid; i < 2 * M_TOK * 256 / 4; i += gn) { const float4 v = ((const float4*)P.p)[i]; uint2 o; o.x = pk2(v.x, v.y); o.y = pk2(v.z, v.w); ((uint2*)(ws + OFF_PBF))[i] = o; }
  for (int u = blockIdx.x; u < 4; u += gridDim.x) {
    const int tid = TIDX, kq = tid >> 5, jq = tid & 31;
    const float* w1 = P.cmp_w1 + (size_t)u * 2048 * 128; const float* pos = P.cmp_pos + (size_t)u * 2048;
    float4 s = make_float4(0.f, 0.f, 0.f, 0.f);
    for (int k = kq * 256; k < kq * 256 + 256; ++k) { const float pv = pos[k]; const float4 w = *(const float4*)(w1 + (size_t)k * 128 + jq * 4); s.x += pv * w.x; s.y += pv * w.y; s.z += pv * w.z; s.w += pv * w.w; }
    __syncthreads();
    lds[kq * 128 + jq * 4 + 0] = s.x; lds[kq * 128 + jq * 4 + 1] = s.y; lds[kq * 128 + jq * 4 + 2] = s.z; lds[kq * 128 + jq * 4 + 3] = s.w;
    __syncthreads();
    if (tid < 128) { float t = P.cmp_b1[u * 128 + tid]; for (int q = 0; q < 8; ++q) t += lds[q * 128 + tid]; ((float*)(ws + OFF_CB1))[u * 128 + tid] = t; }
    __syncthreads();
  }
  resnorm_phase(P.x, P.out, nullptr, 0.f, nullptr, P.norm_g, (bf16_t*)(ws + OFF_A));
}

__device__ __forceinline__ void gemm_core(f32x4 (&acc)[4][4], const bf16_t* __restrict__ A, int lda, const bf16_t* __restrict__ Bt, int ldb, int K, char* lds) {
  const int tid = TIDX, lane = tid & 63, wid = tid >> 6, wr = wid >> 1, wc = wid & 1, fr = lane & 15, fq = lane >> 4;
  const int nk = K >> 6;
  const int rb = tid >> 3, csw = ((tid & 7) ^ (rb & 7)) * 8;
  const bf16_t* ga = A + (size_t)rb * lda + csw;
  const bf16_t* gb = Bt + (size_t)rb * ldb + csw;
  char* lw = lds + tid * 16;
#define GEMM_STAGE(kt, b)                                                                                              \
  {                                                                                                                    \
    _Pragma("unroll") for (int i = 0; i < 4; ++i) {                                                                    \
      glds16(ga + (size_t)(i * 32) * lda + (kt) * 64, lw + (b) * 32768 + i * 4096);                                    \
      glds16(gb + (size_t)(i * 32) * ldb + (kt) * 64, lw + (b) * 32768 + 16384 + i * 4096);                            \
    }                                                                                                                  \
  }
  GEMM_STAGE(0, 0);
#pragma nounroll
  for (int kt = 0; kt < nk; ++kt) {
    asm volatile("s_waitcnt vmcnt(0)" ::: "memory");
    __syncthreads();
    if (kt + 1 < nk) GEMM_STAGE(kt + 1, (kt + 1) & 1);
    const char* la = lds + (kt & 1) * 32768 + (wr * 64 + fr) * 128;
    const char* lb = lds + (kt & 1) * 32768 + 16384 + (wc * 64 + fr) * 128;
#pragma unroll
    for (int ks = 0; ks < 2; ++ks) {
      const int ch = ((ks * 4 + fq) ^ (fr & 7)) * 16;
      bf16x8 af[4], bfr[4];
#pragma unroll
      for (int m = 0; m < 4; ++m) af[m] = *(const bf16x8*)(la + m * 2048 + ch);
#pragma unroll
      for (int n = 0; n < 4; ++n) bfr[n] = *(const bf16x8*)(lb + n * 2048 + ch);
#pragma unroll
      for (int m = 0; m < 4; ++m)
#pragma unroll
        for (int n = 0; n < 4; ++n) acc[m][n] = mfma16(bfr[n], af[m], acc[m][n]);
    }
  }
  __syncthreads();
#undef GEMM_STAGE
}

template <class F> __device__ __forceinline__ void gemm_sched(int TN, F&& f) {
  const int npc = (TN + 3) >> 2, npatch = 16 * npc, xcd = blockIdx.x & 7, slot = blockIdx.x >> 3, nslot = gridDim.x >> 3;
  for (int pid = xcd; pid < npatch; pid += 8) {
    const int pr = pid / npc, pc = pid - pr * npc;
    for (int s = slot; s < 64; s += nslot) {
      const int tm = pr * 16 + (s & 15), tn = pc * 4 + (s >> 4);
      if (tn < TN) f(tm, tn);
    }
  }
}

#define GEMM_LANE const int lane_ = TIDX & 63, wid_ = TIDX >> 6, wr = wid_ >> 1, wc = wid_ & 1, fr = lane_ & 15, fq = lane_ >> 4

__device__ __forceinline__ void gemm_up_phase(const bf16_t* a, const bf16_t* wgu, bf16_t* act, char* lds) {
  gemm_sched(NGU / 128, [&](int tm, int tn) {
    f32x4 acc[4][4] = {};
    gemm_core(acc, a + (size_t)tm * 128 * 1024, 1024, wgu + (size_t)tn * 128 * 1024, 1024, 1024, lds);
    GEMM_LANE;
#pragma unroll
    for (int m = 0; m < 4; ++m) {
      const int row = tm * 128 + wr * 64 + m * 16 + fr;
#pragma unroll
      for (int i = 0; i < 2; ++i) {
        const int col = tn * 64 + wc * 32 + i * 16 + 4 * fq;
        const f32x4 g = acc[m][2 * i], u = acc[m][2 * i + 1];
        uint2 o; o.x = pk2(silu_f(g[0]) * u[0], silu_f(g[1]) * u[1]); o.y = pk2(silu_f(g[2]) * u[2], silu_f(g[3]) * u[3]);
        *(uint2*)(act + (size_t)row * DFF + col) = o;
      }
    }
  });
}

__device__ __forceinline__ void gemm_f32_phase(const bf16_t* A, int lda, const bf16_t* Bt, int K, float* out, char* lds) {
  gemm_sched(8, [&](int tm, int tn) {
    f32x4 acc[4][4] = {};
    gemm_core(acc, A + (size_t)tm * 128 * lda, lda, Bt + (size_t)tn * 128 * K, K, K, lds);
    GEMM_LANE;
#pragma unroll
    for (int m = 0; m < 4; ++m) {
      const int row = tm * 128 + wr * 64 + m * 16 + fr;
#pragma unroll
      for (int n = 0; n < 4; ++n) *(f32x4*)(out + (size_t)row * 1024 + tn * 128 + wc * 64 + n * 16 + 4 * fq) = acc[m][n];
    }
  });
}

__device__ __forceinline__ void gemm_in_phase(const bf16_t* a, const bf16_t* wint, bf16_t* z, char* lds) {
  gemm_sched(LDZ / 128, [&](int tm, int tn) {
    f32x4 acc[4][4] = {};
    gemm_core(acc, a + (size_t)tm * 128 * 1024, 1024, wint + (size_t)tn * 128 * 1024, 1024, 1024, lds);
    GEMM_LANE;
#pragma unroll
    for (int m = 0; m < 4; ++m) {
      const int row = tm * 128 + wr * 64 + m * 16 + fr;
#pragma unroll
      for (int n = 0; n < 4; ++n) {
        uint2 o; o.x = pk2(acc[m][n][0], acc[m][n][1]); o.y = pk2(acc[m][n][2], acc[m][n][3]);
        *(uint2*)(z + (size_t)row * LDZ + tn * 128 + wc * 64 + n * 16 + 4 * fq) = o;
      }
    }
  });
}

__device__ __forceinline__ void gemm_ple_phase(const bf16_t* a, const bf16_t* wpg, const bf16_t* pbf, const bf16_t* wpp, float* out, char* lds) {
  gemm_sched(8, [&](int tm, int tn) {
    f32x4 acc[4][4] = {};
    gemm_core(acc, pbf + (size_t)tm * 128 * 256, 256, wpp + (size_t)tn * 128 * 256, 256, 256, lds);
    u32x2 pp[4][4];
#pragma unroll
    for (int m = 0; m < 4; ++m)
#pragma unroll
      for (int n = 0; n < 4; ++n) { pp[m][n].x = pk2(acc[m][n][0], acc[m][n][1]); pp[m][n].y = pk2(acc[m][n][2], acc[m][n][3]); acc[m][n] = (f32x4){0.f, 0.f, 0.f, 0.f}; }
    gemm_core(acc, a + (size_t)tm * 128 * 1024, 1024, wpg + (size_t)tn * 128 * 1024, 1024, 1024, lds);
    GEMM_LANE;
#pragma unroll
    for (int m = 0; m < 4; ++m) {
      const int row = tm * 128 + wr * 64 + m * 16 + fr;
#pragma unroll
      for (int n = 0; n < 4; ++n) {
        f32x4 o;
        o[0] = sigm(acc[m][n][0]) * __uint_as_float(pp[m][n].x << 16); o[1] = sigm(acc[m][n][1]) * __uint_as_float(pp[m][n].x & 0xffff0000u);
        o[2] = sigm(acc[m][n][2]) * __uint_as_float(pp[m][n].y << 16); o[3] = sigm(acc[m][n][3]) * __uint_as_float(pp[m][n].y & 0xffff0000u);
        *(f32x4*)(out + (size_t)row * 1024 + tn * 128 + wc * 64 + n * 16 + 4 * fq) = o;
      }
    }
  });
}

__device__ __forceinline__ void mixA_item(const Params& P, int layer, int idx, const bf16_t* z, bf16_t* y, char* lds) {
  const int g = idx & 3, bc = idx >> 2, tok0 = bc * 128;
  const int tid = TIDX, lane = tid & 63, w = tid >> 6, fr = lane & 15, fq = lane >> 4;
  bf16_t* vT = (bf16_t*)lds;
  const float* ng = P.sgu_ng + layer * 256;
  {
    const int s = tid >> 1, half = tid & 1;
    const bf16_t* zr = z + (size_t)(tok0 + s) * LDZ + ZC_AV;
    float ss = 0.f;
#pragma unroll 4
    for (int i = 0; i < 16; ++i) { float v[8]; unpack8(*(const u32x4*)(zr + half * 128 + i * 8), v);
#pragma unroll
      for (int e = 0; e < 8; ++e) { const float t = gelu_t(v[e]); ss += t * t; } }
    ss += __shfl_xor(ss, 1);
    const float rs = rsqrtf(ss * (1.f / 256.f) + 1e-6f);
#pragma unroll
    for (int i = 0; i < 4; ++i) { float v[8]; unpack8(*(const u32x4*)(zr + g * 64 + half * 32 + i * 8), v);
#pragma unroll
      for (int e = 0; e < 8; ++e) { const int d = half * 32 + i * 8 + e; vT[d * 136 + s] = f2bf(gelu_t(v[e]) * rs * ng[g * 64 + d]); } }
  }
  __syncthreads();
  const bf16_t* W = (const bf16_t*)(P.ws + OFF_SGUW) + (size_t)((layer * 4 + g) * 128) * 128;
  f32x4 acc[2][4] = {};
  for (int ks = 0; ks <= w; ++ks) {
    bf16x8 wf[2], vf[4];
#pragma unroll
    for (int tm = 0; tm < 2; ++tm) wf[tm] = *(const bf16x8*)(W + (size_t)(32 * w + tm * 16 + fr) * 128 + ks * 32 + 8 * fq);
#pragma unroll
    for (int dn = 0; dn < 4; ++dn) vf[dn] = *(const bf16x8*)(vT + (dn * 16 + fr) * 136 + ks * 32 + 8 * fq);
#pragma unroll
    for (int tm = 0; tm < 2; ++tm)
#pragma unroll
      for (int dn = 0; dn < 4; ++dn) acc[tm][dn] = mfma16(vf[dn], wf[tm], acc[tm][dn]);
  }
#pragma unroll
  for (int tm = 0; tm < 2; ++tm) {
    const int t = 32 * w + tm * 16 + fr;
    const float bias = P.sgu_b[(layer * 4 + g) * 128 + t];
#pragma unroll
    for (int dn = 0; dn < 4; ++dn) {
      const int d = dn * 16 + 4 * fq;
      const uint2 uu = *(const uint2*)(z + (size_t)(tok0 + t) * LDZ + ZC_AU + g * 64 + d);
      const float u0 = gelu_t(__uint_as_float(uu.x << 16)), u1 = gelu_t(__uint_as_float(uu.x & 0xffff0000u)),
                  u2 = gelu_t(__uint_as_float(uu.y << 16)), u3 = gelu_t(__uint_as_float(uu.y & 0xffff0000u));
      uint2 o; o.x = pk2(u0 * (acc[tm][dn][0] + bias), u1 * (acc[tm][dn][1] + bias)); o.y = pk2(u2 * (acc[tm][dn][2] + bias), u3 * (acc[tm][dn][3] + bias));
      *(uint2*)(y + (size_t)(tok0 + t) * 1024 + g * 64 + d) = o;
    }
  }
  __syncthreads();
}

__device__ __forceinline__ void mixB1_item(const Params& P, int layer, int idx, const bf16_t* z, float* hsl, float* Pc, float* carryP, float* carryH, char* lds) {
  const int c = idx & 63, g = (idx >> 6) & 3, b = idx >> 8;
  const int tid = TIDX, lane = tid & 63, w = tid >> 6, fr = lane & 15, fq = lane >> 4;
  bf16_t* xcb = (bf16_t*)lds;
  float* xcf = (float*)(lds + 9216);
  float* aA = (float*)(lds + 9216 + 16384);
  float* bB = (float*)(lds + 9216 + 32768);
  float* sm = (float*)(lds + 9216 + 49152);
  const size_t tokb = (size_t)b * SEQ;
  {
    const int t = tid >> 2, q = tid & 3;
    float accv[16];
#pragma unroll
    for (int i = 0; i < 16; ++i) accv[i] = P.conv_b[layer * 256 + g * 64 + q * 16 + i];
#pragma unroll
    for (int k = 0; k < 4; ++k) {
      const int pos = c * 64 + t - 3 + k;
      if (pos >= 0) {
        const bf16_t* zr = z + (tokb + pos) * LDZ + ZC_BX + g * 64 + q * 16;
        float v[16]; unpack8(*(const u32x4*)zr, v); unpack8(*(const u32x4*)(zr + 8), v + 8);
        const float* cw = P.conv_w + (size_t)(layer * 4 + k) * 256 + g * 64 + q * 16;
#pragma unroll
        for (int i = 0; i < 16; ++i) accv[i] += v[i] * cw[i];
      }
    }
#pragma unroll
    for (int i = 0; i < 16; ++i) { xcf[t * 64 + q * 16 + i] = accv[i]; xcb[t * 72 + q * 16 + i] = f2bf(accv[i]); }
  }
  __syncthreads();
  {
    const bf16_t* wa = (const bf16_t*)(P.ws + OFF_WAT) + (layer * 4 + g) * 4096;
    const bf16_t* wx = (const bf16_t*)(P.ws + OFF_WXT) + (layer * 4 + g) * 4096;
    f32x4 ar[4] = {}, ai[4] = {};
#pragma unroll
    for (int ks = 0; ks < 2; ++ks) {
      const bf16x8 xf = *(const bf16x8*)(xcb + (16 * w + fr) * 72 + ks * 32 + 8 * fq);
#pragma unroll
      for (int jn = 0; jn < 4; ++jn) {
        const bf16x8 fa = *(const bf16x8*)(wa + (jn * 16 + fr) * 64 + ks * 32 + 8 * fq);
        const bf16x8 fx = *(const bf16x8*)(wx + (jn * 16 + fr) * 64 + ks * 32 + 8 * fq);
        ar[jn] = mfma16(fa, xf, ar[jn]); ai[jn] = mfma16(fx, xf, ai[jn]);
      }
    }
    const int t = 16 * w + fr;
#pragma unroll
    for (int jn = 0; jn < 4; ++jn)
#pragma unroll
      for (int e = 0; e < 4; ++e) {
        const int j = jn * 16 + 4 * fq + e, ch = layer * 256 + g * 64 + j;
        const float r = sigm(ar[jn][e] + P.lru_ba[ch]), ig = sigm(ai[jn][e] + P.lru_bx[ch]);
        const float lam = P.lru_lam[ch];
        const float la = -8.f * r * log1pf(__expf(-lam));
        const float av = __expf(la);
        const float bv = sqrtf(-expm1f(2.f * la)) * (ig * xcf[t * 64 + j]);
        aA[t * 64 + j] = av; bB[t * 64 + j] = bv;
      }
  }
  __syncthreads();
  {
    const int q = tid >> 6, j = tid & 63;
    float Pq = 1.f, hq = 0.f;
#pragma unroll
    for (int i = 0; i < 16; ++i) { const int t = q * 16 + i; const float av = aA[t * 64 + j], bv = bB[t * 64 + j]; hq = av * hq + bv; Pq *= av; aA[t * 64 + j] = Pq; bB[t * 64 + j] = hq; }
    sm[q * 64 + j] = Pq; sm[256 + q * 64 + j] = hq;
    __syncthreads();
    float Pin = 1.f, Hin = 0.f;
    for (int qq = 0; qq < q; ++qq) { const float pp = sm[qq * 64 + j], hh = sm[256 + qq * 64 + j]; Hin = pp * Hin + hh; Pin *= pp; }
    float hl = 0.f, pl = 1.f;
#pragma unroll
    for (int i = 0; i < 16; ++i) { const int t = q * 16 + i; hl = bB[t * 64 + j] + aA[t * 64 + j] * Hin; pl = aA[t * 64 + j] * Pin;
      const size_t o = (tokb + c * 64 + t) * 256 + g * 64 + j; hsl[o] = hl; Pc[o] = pl; }
    if (q == 3) { const int o = ((b * 4 + g) * 64 + c) * 64 + j; carryP[o] = pl; carryH[o] = hl; }
  }
  __syncthreads();
}

__device__ __forceinline__ void mixB2_item(int idx, const bf16_t* z, const float* hsl, const float* Pc, const float* carryP, const float* carryH, bf16_t* y) {
  const int c = idx & 63, g = (idx >> 6) & 3, b = idx >> 8;
  const int q = TIDX >> 6, j = TIDX & 63;
  const float* cp = carryP + (size_t)((b * 4 + g) * 64) * 64 + j;
  const float* chh = carryH + (size_t)((b * 4 + g) * 64) * 64 + j;
  float H = 0.f;
  for (int c0 = 0; c0 < c; c0 += 8) {
    float pv[8], hv[8];
#pragma unroll
    for (int i = 0; i < 8; ++i) { const bool ok = c0 + i < c; pv[i] = ok ? cp[(c0 + i) * 64] : 1.f; hv[i] = ok ? chh[(c0 + i) * 64] : 0.f; }
#pragma unroll
    for (int i = 0; i < 8; ++i) H = pv[i] * H + hv[i];
  }
  const size_t tokb = (size_t)b * SEQ + c * 64 + q * 16;
#pragma unroll 4
  for (int i = 0; i < 16; ++i) {
    const size_t o = (tokb + i) * 256 + g * 64 + j;
    const float h = hsl[o] + Pc[o] * H;
    const float gt = bf2f(z[(tokb + i) * LDZ + ZC_BG + g * 64 + j]);
    y[(tokb + i) * 1024 + 256 + g * 64 + j] = f2bf(h * gelu_t(gt));
  }
}

__device__ __forceinline__ void compress_item(const Params& P, int layer, int idx, const bf16_t* z, bf16_t* kcv, char* lds) {
  const int nb = idx & 7, g = (idx >> 3) & 1, b = (idx >> 4) & 7, kv = idx >> 7;
  const int tid = TIDX, lane = tid & 63, w = tid >> 6, fr = lane & 15, fq = lane >> 4;
  const int n0 = nb * 32, col = (kv ? ZC_VC : ZC_KC) + g * 64;
  const bf16_t* w1t = (const bf16_t*)(P.ws + OFF_CW1 + (size_t)(layer * 2 + kv) * SZ_CW1);
  float* hid = (float*)lds;
  f32x4 acc[2][2] = {};
  const bf16_t* zb[2]; const bf16_t* wb[2];
#pragma unroll
  for (int nf = 0; nf < 2; ++nf) { int n = n0 + nf * 16 + fr; if (n > 254) n = 254; zb[nf] = z + ((size_t)b * SEQ + 16 * n) * LDZ + col + 8 * fq; }
#pragma unroll
  for (int jf = 0; jf < 2; ++jf) wb[jf] = w1t + (size_t)(32 * w + jf * 16 + fr) * 2048 + 8 * fq;
#pragma unroll 4
  for (int ks = 0; ks < 64; ++ks) {
    const int l = ks >> 1, d0 = (ks & 1) * 32;
    bf16x8 xf[2], wf[2];
#pragma unroll
    for (int nf = 0; nf < 2; ++nf) xf[nf] = *(const bf16x8*)(zb[nf] + (size_t)l * LDZ + d0);
#pragma unroll
    for (int jf = 0; jf < 2; ++jf) wf[jf] = *(const bf16x8*)(wb[jf] + ks * 32);
#pragma unroll
    for (int jf = 0; jf < 2; ++jf)
#pragma unroll
      for (int nf = 0; nf < 2; ++nf) acc[jf][nf] = mfma16(wf[jf], xf[nf], acc[jf][nf]);
  }
  const float* cb1 = (const float*)(P.ws + OFF_CB1) + (layer * 2 + kv) * 128;
#pragma unroll
  for (int jf = 0; jf < 2; ++jf)
#pragma unroll
    for (int nf = 0; nf < 2; ++nf)
#pragma unroll
      for (int e = 0; e < 4; ++e) { const int j = 32 * w + jf * 16 + 4 * fq + e; hid[(nf * 16 + fr) * 129 + j] = gelu_t(acc[jf][nf][e] + cb1[j]); }
  __syncthreads();
  {
    const int n = tid >> 3, d0 = (tid & 7) * 8;
    const float* w2 = P.cmp_w2 + (size_t)(layer * 2 + kv) * 128 * 64 + d0;
    const float* b2 = P.cmp_b2 + (layer * 2 + kv) * 64 + d0;
    float o[8];
#pragma unroll
    for (int e = 0; e < 8; ++e) o[e] = b2[e];
    for (int j = 0; j < 128; ++j) {
      const float hv = hid[n * 129 + j]; const float4 wa = *(const float4*)(w2 + j * 64), wb2 = *(const float4*)(w2 + j * 64 + 4);
      o[0] += hv * wa.x; o[1] += hv * wa.y; o[2] += hv * wa.z; o[3] += hv * wa.w; o[4] += hv * wb2.x; o[5] += hv * wb2.y; o[6] += hv * wb2.z; o[7] += hv * wb2.w;
    }
    const bool valid = (n0 + n) < 255;
    uint4 ov = valid ? make_uint4(pk2(o[0], o[1]), pk2(o[2], o[3]), pk2(o[4], o[5]), pk2(o[6], o[7])) : make_uint4(0, 0, 0, 0);
    *(uint4*)(kcv + ((size_t)((kv * 8 + b) * 2 + g) * 256 + n0 + n) * 64 + d0) = ov;
  }
  __syncthreads();
}

constexpr int NSA_KT = 0, NSA_VT = 16384, NSA_BKT = 33792, NSA_RB = 37888, NSA_IMP = 38976, NSA_WU = 55616;

__device__ __forceinline__ void nsa_tables(const Params& P, char* lds) {
  unsigned char* bkt = (unsigned char*)(lds + NSA_BKT);
  float* rb = (float*)(lds + NSA_RB);
  for (int n = TIDX; n < 4096; n += 256) {
    int bk = n;
    if (n >= 16) bk = 16 + (n >= 21) + (n >= 27) + (n >= 35) + (n >= 46) + (n >= 59) + (n >= 77) + (n >= 99) + (n >= 128) + (n >= 166) + (n >= 216) + (n >= 280) + (n >= 363) + (n >= 470) + (n >= 609) + (n >= 790);
    bkt[n] = (unsigned char)bk;
  }
  rb[TIDX] = P.rel_bias[TIDX];
  if (TIDX < 8) rb[256 + TIDX] = -__builtin_inff();
  __syncthreads();
}

struct KVRegs { u32x4 k0, k1, v0, v1; };
__device__ __forceinline__ void kv_gload(KVRegs& r, const bf16_t* kb, const bf16_t* vb, size_t stride) {
  const int row = TIDX >> 2, cq = TIDX & 3;
  const bf16_t* kp = kb + row * stride + cq * 16; const bf16_t* vp = vb + row * stride + cq * 16;
  r.k0 = *(const u32x4*)kp; r.k1 = *(const u32x4*)(kp + 8); r.v0 = *(const u32x4*)vp; r.v1 = *(const u32x4*)(vp + 8);
}
__device__ __forceinline__ void kv_lwrite(const KVRegs& r, char* lds, int buf) {
  const int row = TIDX >> 2, cq = TIDX & 3;
  char* kt = lds + NSA_KT + buf * 8192 + row * 128;
  *(u32x4*)(kt + (((2 * cq) ^ (row & 7)) << 4)) = r.k0;
  *(u32x4*)(kt + (((2 * cq + 1) ^ (row & 7)) << 4)) = r.k1;
  bf16_t* vt = (bf16_t*)(lds + NSA_VT + buf * 8704) + (cq * 16) * 68 + row;
#pragma unroll
  for (int i = 0; i < 4; ++i) { vt[(2 * i) * 68] = (bf16_t)(r.v0[i] & 0xffffu); vt[(2 * i + 1) * 68] = (bf16_t)(r.v0[i] >> 16); }
#pragma unroll
  for (int i = 0; i < 4; ++i) { vt[(8 + 2 * i) * 68] = (bf16_t)(r.v1[i] & 0xffffu); vt[(8 + 2 * i + 1) * 68] = (bf16_t)(r.v1[i] >> 16); }
}

template <int MODE>
__device__ __forceinline__ void nsa_compute(int cur, int buf, int t, int hb, u64 mymask, const bf16x8 (&Qf)[2][2], f32x4 (&O)[4][2], float (&m)[2], float (&l)[2],
                                            const float (&inv)[2], float* impw, char* lds) {
  const int lane = TIDX & 63, fr = lane & 15, fq = lane >> 4;
  const unsigned char* bkt = (const unsigned char*)(lds + NSA_BKT);
  const float* rb = (const float*)(lds + NSA_RB);
  const char* kt = lds + NSA_KT + buf * 8192;
  const bf16_t* vt = (const bf16_t*)(lds + NSA_VT + buf * 8704);
  const bool selok = (MODE == 2) ? (((mymask >> cur) & 1ull) != 0ull) : true;
#pragma unroll
  for (int s2 = 0; s2 < 2; ++s2) {
    f32x4 S[2][2] = {};
#pragma unroll
    for (int ks = 0; ks < 2; ++ks)
#pragma unroll
      for (int kk = 0; kk < 2; ++kk) {
        const bf16x8 kf = *(const bf16x8*)(kt + (32 * s2 + 16 * kk + fr) * 128 + (((ks * 4 + fq) ^ (fr & 7)) << 4));
#pragma unroll
        for (int r = 0; r < 2; ++r) S[kk][r] = mfma16(kf, Qf[r][ks], S[kk][r]);
      }
    int bo[2][4];
#pragma unroll
    for (int kk = 0; kk < 2; ++kk)
#pragma unroll
      for (int e = 0; e < 4; ++e) {
        const int kl = cur * 64 + 32 * s2 + 16 * kk + 4 * fq + e;
        int dd; bool o;
        if (MODE <= 1) { dd = t - (16 * kl + 31); o = dd >= 0; }
        else if (MODE == 2) { dd = t - kl; o = (dd >= 0) && selok; }
        else { dd = t - kl; o = (dd >= 0) && (dd < 512); }
        bo[kk][e] = (o ? (int)bkt[dd] : 32) * 8 + hb;
      }
    bf16x8 Pf[2];
    float g1s[2] = {0.f, 0.f}, p3s[2] = {0.f, 0.f};
#pragma unroll
    for (int r = 0; r < 2; ++r) {
      float sv[2][4];
#pragma unroll
      for (int kk = 0; kk < 2; ++kk)
#pragma unroll
        for (int e = 0; e < 4; ++e) sv[kk][e] = S[kk][r][e] * 0.125f + rb[bo[kk][e] + r];
      float pv[2][4];
      if (MODE == 1) {
#pragma unroll
        for (int kk = 0; kk < 2; ++kk)
#pragma unroll
          for (int e = 0; e < 4; ++e) pv[kk][e] = __expf(sv[kk][e] - m[r]) * inv[r];
#pragma unroll
        for (int kk = 0; kk < 2; ++kk) { g1s[kk] += pv[kk][0] + pv[kk][1] + pv[kk][2] + 0.5f * pv[kk][3]; p3s[kk] += 0.5f * pv[kk][3]; }
      } else {
        float mx = fmaxf(fmaxf(fmaxf(sv[0][0], sv[0][1]), fmaxf(sv[0][2], sv[0][3])), fmaxf(fmaxf(sv[1][0], sv[1][1]), fmaxf(sv[1][2], sv[1][3])));
        mx = fmaxf(mx, __shfl_xor(mx, 16)); mx = fmaxf(mx, __shfl_xor(mx, 32));
        const float mn = fmaxf(m[r], mx), al = __expf(m[r] - mn);
        m[r] = mn;
        float ps = 0.f;
#pragma unroll
        for (int kk = 0; kk < 2; ++kk)
#pragma unroll
          for (int e = 0; e < 4; ++e) { pv[kk][e] = __expf(sv[kk][e] - mn); ps += pv[kk][e]; }
        l[r] = l[r] * al + ps;
        if (MODE != 0) {
#pragma unroll
          for (int df = 0; df < 4; ++df) O[df][r] *= al;
        }
      }
      if (MODE != 0) {
        const unsigned w0 = pk2(pv[0][0], pv[0][1]), w1 = pk2(pv[0][2], pv[0][3]), w2 = pk2(pv[1][0], pv[1][1]), w3 = pk2(pv[1][2], pv[1][3]);
        Pf[r][0] = (short)(w0 & 0xffff); Pf[r][1] = (short)(w0 >> 16); Pf[r][2] = (short)(w1 & 0xffff); Pf[r][3] = (short)(w1 >> 16);
        Pf[r][4] = (short)(w2 & 0xffff); Pf[r][5] = (short)(w2 >> 16); Pf[r][6] = (short)(w3 & 0xffff); Pf[r][7] = (short)(w3 >> 16);
      }
    }
    if (MODE != 0) {
#pragma unroll
      for (int df = 0; df < 4; ++df) {
        const bf16x4 va = *(const bf16x4*)(vt + (df * 16 + fr) * 68 + 32 * s2 + 4 * fq);
        const bf16x4 vb = *(const bf16x4*)(vt + (df * 16 + fr) * 68 + 32 * s2 + 16 + 4 * fq);
        bf16x8 vf; vf[0] = va[0]; vf[1] = va[1]; vf[2] = va[2]; vf[3] = va[3]; vf[4] = vb[0]; vf[5] = vb[1]; vf[6] = vb[2]; vf[7] = vb[3];
#pragma unroll
        for (int r = 0; r < 2; ++r) O[df][r] = mfma16(vf, Pf[r], O[df][r]);
      }
    }
    if (MODE == 1) {
#pragma unroll
      for (int kk = 0; kk < 2; ++kk) {
        const int j = cur * 16 + (2 * s2 + kk) * 4 + fq;
        atomicAdd(&impw[fr * 65 + j], g1s[kk]);
        if (j + 1 < 64) atomicAdd(&impw[fr * 65 + j + 1], p3s[kk]);
      }
    }
  }
}

template <int MODE>
__device__ __forceinline__ void nsa_branch(int first, int ntl, u64 U, const bf16_t* kbase, const bf16_t* vbase, size_t stride, int t, int hb, u64 mymask,
                                           const bf16x8 (&Qf)[2][2], f32x4 (&O)[4][2], float (&m)[2], float (&l)[2], const float (&inv)[2], float* impw, char* lds) {
  KVRegs kr;
  int nxt, left = ntl;
  u64 rem = U;
  if (MODE == 2) { nxt = rem ? (int)__builtin_ctzll(rem) : -1; if (rem) rem &= rem - 1; }
  else { nxt = ntl > 0 ? first : -1; }
  if (nxt >= 0) { kv_gload(kr, kbase + (size_t)nxt * 64 * stride, vbase + (size_t)nxt * 64 * stride, stride); kv_lwrite(kr, lds, 0); }
  __syncthreads();
  int buf = 0;
  while (nxt >= 0) {
    const int cur = nxt;
    if (MODE == 2) { nxt = rem ? (int)__builtin_ctzll(rem) : -1; if (rem) rem &= rem - 1; }
    else { --left; nxt = left > 0 ? cur + 1 : -1; }
    if (nxt >= 0) kv_gload(kr, kbase + (size_t)nxt * 64 * stride, vbase + (size_t)nxt * 64 * stride, stride);
    nsa_compute<MODE>(cur, buf, t, hb, mymask, Qf, O, m, l, inv, impw, lds);
    if (nxt >= 0) kv_lwrite(kr, lds, buf ^ 1);
    __syncthreads();
    buf ^= 1;
  }
}

#define NSA_RESET()                                                                         \
  _Pragma("unroll") for (int r = 0; r < 2; ++r) { m[r] = -1e30f; l[r] = 0.f; }               \
  _Pragma("unroll") for (int df = 0; df < 4; ++df) _Pragma("unroll") for (int r = 0; r < 2; ++r) O[df][r] = (f32x4){0.f, 0.f, 0.f, 0.f};
#define NSA_LOADQ(hp)                                                                       \
  _Pragma("unroll") for (int r = 0; r < 2; ++r) _Pragma("unroll") for (int ks = 0; ks < 2; ++ks)  \
      Qf[r][ks] = *(const bf16x8*)(zq + ZC_Q + g * 256 + ((hp) * 2 + r) * 64 + ks * 32 + 8 * fq);

__device__ __forceinline__ void nsa_item(const Params& P, int b, int g, int c, const bf16_t* z, const bf16_t* kcv, bf16_t* y, char* lds) {
  const int tid = TIDX, lane = tid & 63, w = tid >> 6, fr = lane & 15, fq = lane >> 4;
  const size_t tokb = (size_t)b * SEQ;
  const int t = c * 64 + 16 * w + fr;
  const bf16_t* zq = z + (tokb + t) * LDZ;
  bf16x8 Qf[2][2];
  float* impw = (float*)(lds + NSA_IMP) + w * (16 * 65);
  for (int i = lane; i < 16 * 65; i += 64) impw[i] = 0.f;
  f32x4 O[4][2];
  float m[2], l[2], inv[2];
  bf16_t* yo = y + (tokb + t) * 1024 + 512 + g * 256 + 4 * fq;
  const bf16_t* kc = kcv + (size_t)((0 * 8 + b) * 2 + g) * 256 * 64;
  const bf16_t* vc = kcv + (size_t)((1 * 8 + b) * 2 + g) * 256 * 64;
  const int nct = ((4 * c + 2) >> 6) + 1;
  for (int hp = 0; hp < 2; ++hp) {
    NSA_LOADQ(hp);
    NSA_RESET();
    inv[0] = 0.f; inv[1] = 0.f;
    nsa_branch<0>(0, nct, 0ull, kc, vc, 64, t, g * 4 + hp * 2, 0ull, Qf, O, m, l, inv, impw, lds);
#pragma unroll
    for (int r = 0; r < 2; ++r) { float lt = l[r]; lt += __shfl_xor(lt, 16); lt += __shfl_xor(lt, 32); inv[r] = lt > 0.f ? 1.f / lt : 0.f; }
    nsa_branch<1>(0, nct, 0ull, kc, vc, 64, t, g * 4 + hp * 2, 0ull, Qf, O, m, l, inv, impw, lds);
#pragma unroll
    for (int r = 0; r < 2; ++r) {
      const float gt = sigm(bf2f(zq[ZC_GC + g * 4 + hp * 2 + r]));
#pragma unroll
      for (int df = 0; df < 4; ++df) { u32x2 o; o.x = pk2(O[df][r][0] * gt, O[df][r][1] * gt); o.y = pk2(O[df][r][2] * gt, O[df][r][3] * gt); *(u32x2*)(yo + (hp * 2 + r) * 64 + df * 16) = o; }
    }
  }
  __syncthreads();
  u64 mymask = 0ull, wU = 0ull;
  for (int qq = 0; qq < 16; ++qq) {
    const float s = impw[qq * 65 + lane];
    const int j = lane;
    const bool forced = (j == 0) | (j == c) | (j == c - 1);
    const float sc = (j <= c) ? (forced ? 1e4f : s) : -1.0f;
    int rank = 0;
#pragma unroll 16
    for (int k = 0; k < 64; ++k) { const float sk = __int_as_float(__builtin_amdgcn_readlane(__float_as_int(sc), k)); rank += ((sk > sc) || (sk == sc && k < j)) ? 1 : 0; }
    const bool sel = (rank < 16) && (sc >= 0.f);
    const u64 mk = __ballot(sel);
    if (fr == qq) mymask = mk;
    wU |= mk;
  }
  u64* WU = (u64*)(lds + NSA_WU);
  if (lane == 0) WU[w] = wU;
  __syncthreads();
  const u64 U = WU[0] | WU[1] | WU[2] | WU[3];
  for (int br = 0; br < 2; ++br) {
    for (int hp = 0; hp < 2; ++hp) {
      NSA_LOADQ(hp);
      NSA_RESET();
      int zg;
      if (br == 0) {
        nsa_branch<2>(0, 0, U, z + tokb * LDZ + ZC_KS + g * 64, z + tokb * LDZ + ZC_VS + g * 64, LDZ, t, g * 4 + hp * 2, mymask, Qf, O, m, l, inv, impw, lds);
        zg = ZC_GS;
      } else {
        const int kt0 = c > 8 ? c - 8 : 0;
        nsa_branch<3>(kt0, c - kt0 + 1, 0ull, z + tokb * LDZ + ZC_KW + g * 64, z + tokb * LDZ + ZC_VW + g * 64, LDZ, t, g * 4 + hp * 2, 0ull, Qf, O, m, l, inv, impw, lds);
        zg = ZC_GW;
      }
#pragma unroll
      for (int r = 0; r < 2; ++r) {
        float lt = l[r]; lt += __shfl_xor(lt, 16); lt += __shfl_xor(lt, 32);
        const float gt = sigm(bf2f(zq[zg + g * 4 + hp * 2 + r])) * (lt > 0.f ? 1.f / lt : 0.f);
#pragma unroll
        for (int df = 0; df < 4; ++df) {
          bf16_t* yp = yo + (hp * 2 + r) * 64 + df * 16;
          const u32x2 pr = *(const u32x2*)yp;
          u32x2 o; o.x = pk2(__uint_as_float(pr.x << 16) + O[df][r][0] * gt, __uint_as_float(pr.x & 0xffff0000u) + O[df][r][1] * gt);
          o.y = pk2(__uint_as_float(pr.y << 16) + O[df][r][2] * gt, __uint_as_float(pr.y & 0xffff0000u) + O[df][r][3] * gt);
          *(u32x2*)yp = o;
        }
      }
    }
  }
  __syncthreads();
}

__device__ __forceinline__ void run_phase(const Params& P, int ph, char* lds) {
  char* ws = P.ws;
  bf16_t* abuf = (bf16_t*)(ws + OFF_A);
  bf16_t* big = (bf16_t*)(ws + OFF_BIG);
  float* fbuf = (float*)(ws + OFF_F);
  float* hsl = fbuf; float* Pc = fbuf + (size_t)M_TOK * 256;
  bf16_t* kcv = (bf16_t*)(ws + OFF_KC);
  float* carryP = (float*)(ws + OFF_CARRY); float* carryH = carryP + 8 * 4 * 64 * 64;
  if (ph == 0) { prep_phase(P, lds); return; }
  const int layer = (ph - 1) / 13, sp = (ph - 1) % 13;
  const float* ng = P.norm_g + (size_t)layer * 8 * 1024;
#ifdef ONLY_SP
  if (sp != ONLY_SP) return;
#endif
  switch (sp) {
    case 0: case 8: {
      const int lj = layer * 2 + (sp == 8);
      gemm_up_phase(abuf, (const bf16_t*)(ws + OFF_WGU + lj * SZ_WGU), big, lds);
    } break;
    case 1: case 9: {
      const int lj = layer * 2 + (sp == 9);
      gemm_f32_phase(big, DFF, (const bf16_t*)(ws + OFF_WD + lj * SZ_WD), DFF, fbuf, lds);
    } break;
    case 2: resnorm_phase(P.out, P.out, fbuf, 0.5f, ng + 1 * 1024, ng + 2 * 1024, abuf); break;
    case 3: gemm_in_phase(abuf, (const bf16_t*)(ws + OFF_WIN + layer * SZ_WIN), big, lds); break;
    case 4:
      for (int it = blockIdx.x; it < 256 + 1024 + 2048; it += gridDim.x) {
        if (it < 256) compress_item(P, layer, it, big, kcv, lds);
        else if (it < 1280) mixA_item(P, layer, it - 256, big, abuf, lds);
        else mixB1_item(P, layer, it - 1280, big, hsl, Pc, carryP, carryH, lds);
      }
      break;
    case 5:
      nsa_tables(P, lds);
      for (int it = blockIdx.x; it < 1024 + 2048; it += gridDim.x) {
        if (it < 1024) { const int c = it < 512 ? 63 - (it >> 4) : ((it - 512) >> 4); const int bg = it & 15; nsa_item(P, bg >> 1, bg & 1, c, big, kcv, abuf, lds); }
        else mixB2_item(it - 1024, big, hsl, Pc, carryP, carryH, abuf);
      }
      break;
    case 6: gemm_f32_phase(abuf, 1024, (const bf16_t*)(ws + OFF_WOUT + layer * SZ_SQ), 1024, fbuf, lds); break;
    case 7: resnorm_phase(P.out, P.out, fbuf, 1.0f, ng + 3 * 1024, ng + 4 * 1024, abuf); break;
    case 10: resnorm_phase(P.out, P.out, fbuf, 0.5f, ng + 5 * 1024, ng + 6 * 1024, abuf); break;
    case 11:
      gemm_ple_phase(abuf, (const bf16_t*)(ws + OFF_WPG + layer * SZ_SQ), (const bf16_t*)(ws + OFF_PBF) + (size_t)layer * M_TOK * 256,
                     (const bf16_t*)(ws + OFF_WPP + layer * SZ_WPP), fbuf, lds);
      break;
    case 12: resnorm_phase(P.out, P.out, fbuf, 1.0f, ng + 7 * 1024, layer == 0 ? P.norm_g + 8 * 1024 : nullptr, layer == 0 ? abuf : nullptr); break;
  }
}


#define XB_TMO      128
#define XB_XCNT(j)  (256  + 64 * (j))
#define XB_XSUB(j)  (1280 + 64 * (j))
#define XB_XGEN(j)  (2304 + 64 * (j))
#define XB_TOP      3328
#define XB_TOPGEN   3392
#define XCD_BAR_WORDS 3456
#define XB_SPIN_CAP (1u << 20)
#define LAS __attribute__((address_space(3)))
__device__ __forceinline__ unsigned xb_ld(unsigned* p)              { return __hip_atomic_load(p, __ATOMIC_RELAXED, __HIP_MEMORY_SCOPE_AGENT); }
__device__ __forceinline__ unsigned xb_add(unsigned* p, unsigned v) { return __hip_atomic_fetch_add(p, v, __ATOMIC_RELAXED, __HIP_MEMORY_SCOPE_AGENT); }
__device__ __forceinline__ unsigned xb_xcc_id() { return (unsigned)__builtin_amdgcn_s_getreg((3 << 11) | 20) & 0xFu; }
#define XB_SPIN(cond, bar) do { unsigned _sp = 0; while (cond) { __builtin_amdgcn_s_sleep(1); \
    if ((++_sp & 255u) == 0u) { if (xb_ld(&(bar)[XB_TMO])) break; if (_sp > XB_SPIN_CAP) { atomicAdd(&(bar)[XB_TMO], 1u); break; } } } } while (0)
struct XcdBarrier { unsigned* bar; unsigned x; volatile LAS unsigned* st; };
__device__ __forceinline__ XcdBarrier xcd_barrier_post(unsigned* bar, volatile LAS unsigned* st) {
    XcdBarrier b; b.bar = bar; b.x = xb_xcc_id(); b.st = st;
    if (threadIdx.x == 0) (void)xb_add(&bar[XB_XCNT(b.x)], 1u);
    return b;
}
__device__ __forceinline__ void xcd_barrier_complete(unsigned* bar, unsigned x, unsigned& nloc, unsigned& nx) {
    const unsigned G = gridDim.x * gridDim.y * gridDim.z;
    unsigned sum, cnt, mine, sp = 0u;
    for (;;) {
        sum = 0u; cnt = 0u; mine = 0u;
#pragma unroll
        for (unsigned j = 0; j < 16; ++j) { const unsigned c = xb_ld(&bar[XB_XCNT(j)]); sum += c; cnt += (c > 0u) ? 1u : 0u; mine = (j == x) ? c : mine; }
        if (sum == G) break;
        __builtin_amdgcn_s_sleep(1);
        if ((++sp & 255u) == 0u) { if (xb_ld(&bar[XB_TMO])) break; if (sp > XB_SPIN_CAP) { atomicAdd(&bar[XB_TMO], 1u); break; } }
    }
    nloc = mine > 0u ? mine : 1u; nx = cnt > 0u ? cnt : 1u;
}
__device__ __forceinline__ void xcd_barrier(const XcdBarrier& b) {
    asm volatile("s_waitcnt vmcnt(0)" ::: "memory");
    __syncthreads();
    if (threadIdx.x == 0) {
        unsigned* bar = b.bar;
        __builtin_amdgcn_s_waitcnt(0);
        unsigned nloc = b.st[0], nx = b.st[1];
        if (nloc == 0u) { xcd_barrier_complete(bar, b.x, nloc, nx); b.st[0] = nloc; b.st[1] = nx; }
        const unsigned old = xb_add(&bar[XB_XSUB(b.x)], 1u);
        const unsigned gen = old / nloc;
        if (old + 1u == (gen + 1u) * nloc) {
            __builtin_amdgcn_fence(__ATOMIC_RELEASE, "agent");
            asm volatile("s_waitcnt vmcnt(0)" ::: "memory");
            const unsigned og = xb_add(&bar[XB_TOP], 1u);
            const unsigned tg = og / nx;
            if (og + 1u == (tg + 1u) * nx) xb_add(&bar[XB_TOPGEN], 1u);
            else XB_SPIN(xb_ld(&bar[XB_TOPGEN]) == tg, bar);
            __builtin_amdgcn_fence(__ATOMIC_ACQUIRE, "agent");
            xb_add(&bar[XB_XGEN(b.x)], 1u);
            asm volatile("s_waitcnt vmcnt(0)" ::: "memory");
        } else {
            XB_SPIN(xb_ld(&bar[XB_XGEN(b.x)]) == gen, bar);
            __builtin_amdgcn_fence(__ATOMIC_ACQUIRE, "agent");
            asm volatile("s_waitcnt vmcnt(0)" ::: "memory");
        }
    }
    __syncthreads();
}

__global__ void __launch_bounds__(256, 2) fwd_megakernel(Params P) {
  __shared__ __attribute__((aligned(16))) char lds[65536 + 16];
  cg::grid_group grid = cg::this_grid();
  volatile LAS unsigned* st = (volatile LAS unsigned*)(lds + 65536);
  if (threadIdx.x == 0) { st[0] = 0u; st[1] = 0u; }
  __syncthreads();
  XcdBarrier xb = xcd_barrier_post((unsigned*)(P.ws + OFF_BAR), st);
  if (P.ws == nullptr) grid.sync();
  for (int ph = 0; ph < NPHASE; ++ph) {
    run_phase(P, ph, lds);
    if (ph + 1 < NPHASE) xcd_barrier(xb);
  }
}

__global__ void __launch_bounds__(256, 2) phase_kernel(Params P, int ph) {
  __shared__ __attribute__((aligned(16))) char lds[65536];
  run_phase(P, ph, lds);
}

extern "C" void kernel_launch(void* const* d_in, const int* in_sizes, int n_in, void* d_out, int out_size, void* d_ws, size_t ws_size, hipStream_t stream) {
  Params P{};
  const float** pp = (const float**)&P;
  for (int i = 0; i < 26; ++i) pp[i] = (const float*)d_in[i];
  P.out = (float*)d_out;
  P.ws = (char*)d_ws;
  if (ws_size < WS_NEED) { fprintf(stderr, "workspace too small: %zu < %zu\n", ws_size, (size_t)WS_NEED); return; }
#if MK_FUSED
  static int grid_blocks = 0;
  if (!grid_blocks) {
    int dev = 0, cus = 0, per_cu = 0;
    (void)hipGetDevice(&dev);
    (void)hipDeviceGetAttribute(&cus, hipDeviceAttributeMultiprocessorCount, dev);
    (void)hipOccupancyMaxActiveBlocksPerMultiprocessor(&per_cu, fwd_megakernel, 256, 0);
    if (per_cu > 2) per_cu = 2;
    if (per_cu < 1) per_cu = 1;
    grid_blocks = cus * per_cu;
  }
  (void)hipMemsetAsync((char*)d_ws + OFF_BAR, 0, XCD_BAR_WORDS * 4, stream);
  void* args[] = {&P};
  hipError_t e = hipLaunchCooperativeKernel((void*)fwd_megakernel, dim3(grid_blocks), dim3(256), args, 0, stream);
  if (e != hipSuccess) fprintf(stderr, "cooperative launch failed: %s (grid %d)\n", hipGetErrorString(e), grid_blocks);
#else
  for (int ph = 0; ph < NPHASE; ++ph) phase_kernel<<<512, 256, 0, stream>>>(P, ph);
#endif
}
```

```cpp
#include <hip/hip_runtime.h>
#include <hip/hip_cooperative_groups.h>
#include <cstdint>
#include <cstdio>
namespace cg = cooperative_groups;

#ifndef MK_FUSED
#define MK_FUSED 1
#endif

typedef unsigned short bf16_t;
typedef short bf16x8 __attribute__((ext_vector_type(8)));
typedef short bf16x4 __attribute__((ext_vector_type(4)));
typedef float f32x4 __attribute__((ext_vector_type(4)));
typedef unsigned long long u64;
typedef unsigned u32x4 __attribute__((ext_vector_type(4)));
typedef unsigned u32x2 __attribute__((ext_vector_type(2)));

constexpr int M_TOK = 32768, DM = 1024, DFF = 2816, NGU = 5632, NIN = 2328, LDZ = 2560, SEQ = 4096;
constexpr int NPHASE = 27;
constexpr int ZC_AU = 0, ZC_AV = 256, ZC_BX = 512, ZC_BG = 768, ZC_Q = 1024, ZC_KC = 1536, ZC_VC = 1664, ZC_KS = 1792, ZC_VS = 1920,
              ZC_KW = 2048, ZC_VW = 2176, ZC_GC = 2304, ZC_GS = 2312, ZC_GW = 2320;

constexpr size_t SZ_WGU = (size_t)NGU * 1024 * 2, SZ_WD = (size_t)1024 * DFF * 2, SZ_WIN = (size_t)LDZ * 1024 * 2, SZ_SQ = (size_t)1024 * 1024 * 2,
                 SZ_WPP = (size_t)1024 * 256 * 2, SZ_CW1 = (size_t)128 * 2048 * 2;
constexpr size_t OFF_WGU = 0;
constexpr size_t OFF_WD = OFF_WGU + 4 * SZ_WGU;
constexpr size_t OFF_WIN = OFF_WD + 4 * SZ_WD;
constexpr size_t OFF_WOUT = OFF_WIN + 2 * SZ_WIN;
constexpr size_t OFF_WPG = OFF_WOUT + 2 * SZ_SQ;
constexpr size_t OFF_WPP = OFF_WPG + 2 * SZ_SQ;
constexpr size_t OFF_CW1 = OFF_WPP + 2 * SZ_WPP;
constexpr size_t OFF_CB1 = OFF_CW1 + 4 * SZ_CW1;
constexpr size_t OFF_SGUW = OFF_CB1 + 4096;
constexpr size_t OFF_WAT = OFF_SGUW + 2 * 4 * 128 * 128 * 2;
constexpr size_t OFF_WXT = OFF_WAT + 2 * 4 * 64 * 64 * 2;
constexpr size_t OFF_PBF = OFF_WXT + 2 * 4 * 64 * 64 * 2;
constexpr size_t OFF_A = OFF_PBF + (size_t)2 * M_TOK * 256 * 2;
constexpr size_t OFF_BIG = OFF_A + (size_t)M_TOK * 1024 * 2;
constexpr size_t OFF_F = OFF_BIG + (size_t)M_TOK * DFF * 2;
constexpr size_t OFF_KC = OFF_F + (size_t)M_TOK * 1024 * 4;
constexpr size_t OFF_CARRY = OFF_KC + (size_t)2 * 8 * 2 * 256 * 64 * 2;
constexpr size_t OFF_BAR = OFF_CARRY + (size_t)2 * 8 * 4 * 64 * 64 * 4;
constexpr size_t WS_NEED = OFF_BAR + 16384;

struct Params {
  const float *x, *p, *rel_bias, *norm_g, *ffn_wg, *ffn_wu, *ffn_wd, *w_in, *w_out, *sgu_ng, *sgu_w, *sgu_b, *conv_w, *conv_b,
      *lru_wa, *lru_ba, *lru_wx, *lru_bx, *lru_lam, *cmp_pos, *cmp_w1, *cmp_b1, *cmp_w2, *cmp_b2, *ple_wg, *ple_wp;
  float* out;
  char* ws;
};

__device__ __forceinline__ int opaque_tid() { int t; asm volatile("v_mov_b32 %0, %1" : "=v"(t) : "v"(threadIdx.x)); return t; }
#define TIDX opaque_tid()
#define HTID (opaque_tid() & 255)
#define HBLK (opaque_tid() >> 8)
__device__ __forceinline__ float bf2f(bf16_t v) { return __uint_as_float(((unsigned)v) << 16); }
__device__ __forceinline__ bf16_t f2bf(float f) { unsigned u = __float_as_uint(f); u += 0x7fffu + ((u >> 16) & 1u); return (bf16_t)(u >> 16); }
__device__ __forceinline__ unsigned pk2(float lo, float hi) { return (unsigned)f2bf(lo) | ((unsigned)f2bf(hi) << 16); }
__device__ __forceinline__ float sigm(float x) { return __builtin_amdgcn_rcpf(1.f + __expf(-x)); }
__device__ __forceinline__ float gelu_t(float x) { float u = 0.7978845608028654f * (x + 0.044715f * x * x * x); return x * __builtin_amdgcn_rcpf(1.f + __expf(-2.f * u)); }
__device__ __forceinline__ float silu_f(float x) { return x * __builtin_amdgcn_rcpf(1.f + __expf(-x)); }
__device__ __forceinline__ f32x4 mfma16(bf16x8 a, bf16x8 b, f32x4 c) { return __builtin_amdgcn_mfma_f32_16x16x32_bf16(a, b, c, 0, 0, 0); }
__device__ __forceinline__ void glds16(const void* g, void* l) {
  __builtin_amdgcn_global_load_lds((const __attribute__((address_space(1))) unsigned*)g, (__attribute__((address_space(3))) unsigned*)l, 16, 0, 0);
}
__device__ __forceinline__ float wave_sum(float v) {
#pragma unroll
  for (int o = 32; o > 0; o >>= 1) v += __shfl_xor(v, o);
  return v;
}
__device__ __forceinline__ void unpack8(const u32x4 u, float* f) {
  f[0] = __uint_as_float(u.x << 16); f[1] = __uint_as_float(u.x & 0xffff0000u);
  f[2] = __uint_as_float(u.y << 16); f[3] = __uint_as_float(u.y & 0xffff0000u);
  f[4] = __uint_as_float(u.z << 16); f[5] = __uint_as_float(u.z & 0xffff0000u);
  f[6] = __uint_as_float(u.w << 16); f[7] = __uint_as_float(u.w & 0xffff0000u);
}

__device__ __forceinline__ void tr_cvt_tile(const float* __restrict__ src, int N, int K, bf16_t* __restrict__ dst, int ldd, int rs, int ro, int tile, bool active, float* lds) {
  const int ntn = (N + 63) >> 6, tk = tile / ntn, tn = tile - tk * ntn, k0 = tk * 64, n0 = tn * 64, tid = HTID;
#pragma unroll
  for (int ps = 0; ps < 4; ++ps) {
    const int i = ps * 16 + (tid >> 4), j = (tid & 15) * 4;
    float4 v = make_float4(0.f, 0.f, 0.f, 0.f);
    if (active && n0 + j < N) v = *(const float4*)(src + (size_t)(k0 + i) * N + n0 + j);
    float* d = lds + i * 65 + j; d[0] = v.x; d[1] = v.y; d[2] = v.z; d[3] = v.w;
  }
  __syncthreads();
  const int j = tid >> 2, kq = tid & 3, n = n0 + j;
  if (active && n < N) {
    unsigned w[8];
#pragma unroll
    for (int q = 0; q < 8; ++q) w[q] = pk2(lds[(kq * 16 + 2 * q) * 65 + j], lds[(kq * 16 + 2 * q + 1) * 65 + j]);
    bf16_t* o = dst + (size_t)((n >> 4) * rs + (n & 15) + ro) * ldd + k0 + kq * 16;
    *(uint4*)o = make_uint4(w[0], w[1], w[2], w[3]);
    *(uint4*)(o + 8) = make_uint4(w[4], w[5], w[6], w[7]);
  }
  __syncthreads();
}
__device__ __forceinline__ void tr_cvt(const float* src, int N, int K, bf16_t* dst, int ldd, int rs, int ro, char* ldsc) {
  const int nt = ((N + 63) >> 6) * (K >> 6), hb = HBLK;
  float* lds = (float*)(ldsc + hb * 65536);
  for (int t0 = blockIdx.x * 2; t0 < nt; t0 += gridDim.x * 2) tr_cvt_tile(src, N, K, dst, ldd, rs, ro, t0 + hb, t0 + hb < nt, lds);
}

__device__ __forceinline__ void resnorm_phase(const float* hin, float* hout, const float* f, float scale, const float* gpost, const float* gpre, bf16_t* a) {
  const int tid = TIDX, lane = tid & 63;
  for (int row = blockIdx.x * 8 + (tid >> 6); row < M_TOK; row += gridDim.x * 8) {
    float4 hv[4];
#pragma unroll
    for (int i = 0; i < 4; ++i) hv[i] = *(const float4*)(hin + (size_t)row * 1024 + i * 256 + lane * 4);
    if (f) {
      float4 fv[4]; float ss = 0.f;
#pragma unroll
      for (int i = 0; i < 4; ++i) { fv[i] = *(const float4*)(f + (size_t)row * 1024 + i * 256 + lane * 4); ss += fv[i].x * fv[i].x + fv[i].y * fv[i].y + fv[i].z * fv[i].z + fv[i].w * fv[i].w; }
      ss = wave_sum(ss);
      const float r = rsqrtf(ss * (1.f / 1024.f) + 1e-6f) * scale;
#pragma unroll
      for (int i = 0; i < 4; ++i) { const float4 g = *(const float4*)(gpost + i * 256 + lane * 4);
        hv[i].x += fv[i].x * r * g.x; hv[i].y += fv[i].y * r * g.y; hv[i].z += fv[i].z * r * g.z; hv[i].w += fv[i].w * r * g.w; }
    }
#pragma unroll
    for (int i = 0; i < 4; ++i) *(float4*)(hout + (size_t)row * 1024 + i * 256 + lane * 4) = hv[i];
    if (a) {
      float ss = 0.f;
#pragma unroll
      for (int i = 0; i < 4; ++i) ss += hv[i].x * hv[i].x + hv[i].y * hv[i].y + hv[i].z * hv[i].z + hv[i].w * hv[i].w;
      ss = wave_sum(ss);
      const float r = rsqrtf(ss * (1.f / 1024.f) + 1e-6f);
#pragma unroll
      for (int i = 0; i < 4; ++i) { const float4 g = *(const float4*)(gpre + i * 256 + lane * 4);
        uint2 o; o.x = pk2(hv[i].x * r * g.x, hv[i].y * r * g.y); o.y = pk2(hv[i].z * r * g.z, hv[i].w * r * g.w);
        *(uint2*)(a + (size_t)row * 1024 + i * 256 + lane * 4) = o; }
    }
  }
}

__device__ __forceinline__ void prep_phase(const Params& P, char* ldsc) {
  char* ws = P.ws;
  for (int l = 0; l < 2; ++l) {
    for (int j = 0; j < 2; ++j) {
      const int lj = l * 2 + j;
      bf16_t* wgu = (bf16_t*)(ws + OFF_WGU + lj * SZ_WGU);
      tr_cvt(P.ffn_wg + (size_t)lj * 1024 * DFF, DFF, 1024, wgu, 1024, 32, 0, ldsc);
      tr_cvt(P.ffn_wu + (size_t)lj * 1024 * DFF, DFF, 1024, wgu, 1024, 32, 16, ldsc);
      tr_cvt(P.ffn_wd + (size_t)lj * DFF * 1024, 1024, DFF, (bf16_t*)(ws + OFF_WD + lj * SZ_WD), DFF, 16, 0, ldsc);
      tr_cvt(P.cmp_w1 + (size_t)lj * 2048 * 128, 128, 2048, (bf16_t*)(ws + OFF_CW1 + lj * SZ_CW1), 2048, 16, 0, ldsc);
    }
    tr_cvt(P.w_in + (size_t)l * 1024 * NIN, NIN, 1024, (bf16_t*)(ws + OFF_WIN + l * SZ_WIN), 1024, 16, 0, ldsc);
    tr_cvt(P.w_out + (size_t)l * 1024 * 1024, 1024, 1024, (bf16_t*)(ws + OFF_WOUT + l * SZ_SQ), 1024, 16, 0, ldsc);
    tr_cvt(P.ple_wg + (size_t)l * 1024 * 1024, 1024, 1024, (bf16_t*)(ws + OFF_WPG + l * SZ_SQ), 1024, 16, 0, ldsc);
    tr_cvt(P.ple_wp + (size_t)l * 256 * 1024, 1024, 256, (bf16_t*)(ws + OFF_WPP + l * SZ_WPP), 256, 16, 0, ldsc);
    for (int g = 0; g < 4; ++g) {
      tr_cvt(P.lru_wa + (size_t)(l * 4 + g) * 4096, 64, 64, (bf16_t*)(ws + OFF_WAT) + (l * 4 + g) * 4096, 64, 16, 0, ldsc);
      tr_cvt(P.lru_wx + (size_t)(l * 4 + g) * 4096, 64, 64, (bf16_t*)(ws + OFF_WXT) + (l * 4 + g) * 4096, 64, 16, 0, ldsc);
    }
  }
  const int tid = TIDX, gtid = blockIdx.x * 512 + tid, gn = gridDim.x * 512;
  for (int i = gtid; i < 2 * (LDZ - NIN) * 1024 / 8; i += gn) {
    const int l = i / ((LDZ - NIN) * 128), r = i - l * ((LDZ - NIN) * 128);
    *(uint4*)((bf16_t*)(ws + OFF_WIN + l * SZ_WIN) + (size_t)NIN * 1024 + (size_t)r * 8) = make_uint4(0, 0, 0, 0);
  }
  for (int i = gtid; i < 2 * 4 * 128 * 128; i += gn) { const int t = (i >> 7) & 127, s2 = i & 127; ((bf16_t*)(ws + OFF_SGUW))[i] = (s2 <= t) ? f2bf(P.sgu_w[i]) : (bf16_t)0; }
  for (int i = gtid; i < 2 * M_TOK * 256 / 4; i += gn) { const float4 v = ((const float4*)P.p)[i]; uint2 o; o.x = pk2(v.x, v.y); o.y = pk2(v.z, v.w); ((uint2*)(ws + OFF_PBF))[i] = o; }
  {
    float* lds = (float*)(ldsc + HBLK * 65536);
    for (int u = blockIdx.x; u < 4; u += gridDim.x) {
      const int t2 = HTID, kq = t2 >> 5, jq = t2 & 31;
      const float* w1 = P.cmp_w1 + (size_t)u * 2048 * 128; const float* pos = P.cmp_pos + (size_t)u * 2048;
      float4 sacc = make_float4(0.f, 0.f, 0.f, 0.f);
      for (int k = kq * 256; k < kq * 256 + 256; ++k) { const float pv = pos[k]; const float4 w = *(const float4*)(w1 + (size_t)k * 128 + jq * 4); sacc.x += pv * w.x; sacc.y += pv * w.y; sacc.z += pv * w.z; sacc.w += pv * w.w; }
      __syncthreads();
      lds[kq * 128 + jq * 4 + 0] = sacc.x; lds[kq * 128 + jq * 4 + 1] = sacc.y; lds[kq * 128 + jq * 4 + 2] = sacc.z; lds[kq * 128 + jq * 4 + 3] = sacc.w;
      __syncthreads();
      if (t2 < 128) { float t = P.cmp_b1[u * 128 + t2]; for (int q = 0; q < 8; ++q) t += lds[q * 128 + t2]; ((float*)(ws + OFF_CB1))[u * 128 + t2] = t; }
      __syncthreads();
    }
  }
  resnorm_phase(P.x, P.out, nullptr, 0.f, nullptr, P.norm_g, (bf16_t*)(ws + OFF_A));
}

__device__ __forceinline__ void gemm_core(f32x4 (&acc)[8][4], const bf16_t* __restrict__ A, int lda, const bf16_t* __restrict__ Bt, int ldb, int K, char* lds) {
  const int tid = TIDX, lane = tid & 63, wid = tid >> 6, wr = wid >> 2, wc = wid & 3, fr = lane & 15, fq = lane >> 4;
  const int nk = K >> 6;
  const int rb = tid >> 3, csw = ((tid & 7) ^ (rb & 7)) * 8;
  const bf16_t* ga = A + (size_t)rb * lda + csw;
  const bf16_t* gb = Bt + (size_t)rb * ldb + csw;
  char* lw = lds + tid * 16;
#define GEMM_STAGE(kt, b)                                                                                              \
  {                                                                                                                    \
    _Pragma("unroll") for (int i = 0; i < 4; ++i) {                                                                    \
      glds16(ga + (size_t)(i * 64) * lda + (kt) * 64, lw + (b) * 65536 + i * 8192);                                    \
      glds16(gb + (size_t)(i * 64) * ldb + (kt) * 64, lw + (b) * 65536 + 32768 + i * 8192);                            \
    }                                                                                                                  \
  }
  GEMM_STAGE(0, 0);
#pragma nounroll
  for (int kt = 0; kt < nk; ++kt) {
    asm volatile("s_waitcnt vmcnt(0)" ::: "memory");
    __syncthreads();
    if (kt + 1 < nk) GEMM_STAGE(kt + 1, (kt + 1) & 1);
    const char* la = lds + (kt & 1) * 65536 + (wr * 128 + fr) * 128;
    const char* lb = lds + (kt & 1) * 65536 + 32768 + (wc * 64 + fr) * 128;
#pragma unroll
    for (int ks = 0; ks < 2; ++ks) {
      const int ch = ((ks * 4 + fq) ^ (fr & 7)) * 16;
      bf16x8 af[8], bfr[4];
#pragma unroll
      for (int n = 0; n < 4; ++n) bfr[n] = *(const bf16x8*)(lb + n * 2048 + ch);
#pragma unroll
      for (int m = 0; m < 8; ++m) af[m] = *(const bf16x8*)(la + m * 2048 + ch);
#pragma unroll
      for (int m = 0; m < 8; ++m)
#pragma unroll
        for (int n = 0; n < 4; ++n) acc[m][n] = mfma16(bfr[n], af[m], acc[m][n]);
    }
  }
  __syncthreads();
#undef GEMM_STAGE
}

template <class F> __device__ __forceinline__ void gemm_sched(int TN, F&& f) {
  const int npc = (TN + 1) >> 1, npatch = 8 * npc, xcd = blockIdx.x & 7, slot = blockIdx.x >> 3, nslot = gridDim.x >> 3;
  for (int pid = xcd; pid < npatch; pid += 8) {
    const int pr = pid / npc, pc = pid - pr * npc;
    for (int s = slot; s < 32; s += nslot) {
      const int tm = pr * 16 + (s & 15), tn = pc * 2 + (s >> 4);
      if (tn < TN) f(tm, tn);
    }
  }
}

#define GEMM_LANE const int tid_ = TIDX, lane_ = tid_ & 63, wid_ = tid_ >> 6, wr = wid_ >> 2, wc = wid_ & 3, fr = lane_ & 15, fq = lane_ >> 4

__device__ __forceinline__ void gemm_up_phase(const bf16_t* a, const bf16_t* wgu, bf16_t* act, char* lds) {
  gemm_sched(NGU / 256, [&](int tm, int tn) {
    f32x4 acc[8][4] = {};
    gemm_core(acc, a + (size_t)tm * 256 * 1024, 1024, wgu + (size_t)tn * 256 * 1024, 1024, 1024, lds);
    GEMM_LANE;
#pragma unroll
    for (int m = 0; m < 8; ++m) {
      const int row = tm * 256 + wr * 128 + m * 16 + fr;
#pragma unroll
      for (int i = 0; i < 2; ++i) {
        const int col = tn * 128 + wc * 32 + i * 16 + 4 * fq;
        const f32x4 g = acc[m][2 * i], u = acc[m][2 * i + 1];
        uint2 o; o.x = pk2(silu_f(g[0]) * u[0], silu_f(g[1]) * u[1]); o.y = pk2(silu_f(g[2]) * u[2], silu_f(g[3]) * u[3]);
        *(uint2*)(act + (size_t)row * DFF + col) = o;
      }
    }
  });
}

__device__ __forceinline__ void gemm_f32_phase(const bf16_t* A, int lda, const bf16_t* Bt, int K, float* out, char* lds) {
  gemm_sched(4, [&](int tm, int tn) {
    f32x4 acc[8][4] = {};
    gemm_core(acc, A + (size_t)tm * 256 * lda, lda, Bt + (size_t)tn * 256 * K, K, K, lds);
    GEMM_LANE;
#pragma unroll
    for (int m = 0; m < 8; ++m) {
      const int row = tm * 256 + wr * 128 + m * 16 + fr;
#pragma unroll
      for (int n = 0; n < 4; ++n) *(f32x4*)(out + (size_t)row * 1024 + tn * 256 + wc * 64 + n * 16 + 4 * fq) = acc[m][n];
    }
  });
}

__device__ __forceinline__ void gemm_bf16_phase(const bf16_t* A, int lda, const bf16_t* Bt, int K, int TN, bf16_t* out, int ldo, char* lds) {
  gemm_sched(TN, [&](int tm, int tn) {
    f32x4 acc[8][4] = {};
    gemm_core(acc, A + (size_t)tm * 256 * lda, lda, Bt + (size_t)tn * 256 * K, K, K, lds);
    GEMM_LANE;
#pragma unroll
    for (int m = 0; m < 8; ++m) {
      const int row = tm * 256 + wr * 128 + m * 16 + fr;
#pragma unroll
      for (int n = 0; n < 4; ++n) {
        uint2 o; o.x = pk2(acc[m][n][0], acc[m][n][1]); o.y = pk2(acc[m][n][2], acc[m][n][3]);
        *(uint2*)(out + (size_t)row * ldo + tn * 256 + wc * 64 + n * 16 + 4 * fq) = o;
      }
    }
  });
}

__device__ __forceinline__ void gemm_ple_phase(const bf16_t* a, const bf16_t* wpg, const bf16_t* pp, float* out, char* lds) {
  gemm_sched(4, [&](int tm, int tn) {
    f32x4 acc[8][4] = {};
    gemm_core(acc, a + (size_t)tm * 256 * 1024, 1024, wpg + (size_t)tn * 256 * 1024, 1024, 1024, lds);
    GEMM_LANE;
#pragma unroll
    for (int m = 0; m < 8; ++m) {
      const int row = tm * 256 + wr * 128 + m * 16 + fr;
#pragma unroll
      for (int n = 0; n < 4; ++n) {
        const int col = tn * 256 + wc * 64 + n * 16 + 4 * fq;
        const u32x2 pv = *(const u32x2*)(pp + (size_t)row * 1024 + col);
        f32x4 o;
        o[0] = sigm(acc[m][n][0]) * __uint_as_float(pv.x << 16); o[1] = sigm(acc[m][n][1]) * __uint_as_float(pv.x & 0xffff0000u);
        o[2] = sigm(acc[m][n][2]) * __uint_as_float(pv.y << 16); o[3] = sigm(acc[m][n][3]) * __uint_as_float(pv.y & 0xffff0000u);
        *(f32x4*)(out + (size_t)row * 1024 + col) = o;
      }
    }
  });
}

__device__ __forceinline__ void mixA_item(const Params& P, int layer, int idx, const bf16_t* z, bf16_t* y, char* lds) {
  const int g = idx & 3, bc = idx >> 2, tok0 = bc * 128;
  const int tid = HTID, lane = tid & 63, w = tid >> 6, fr = lane & 15, fq = lane >> 4;
  bf16_t* vT = (bf16_t*)lds;
  const float* ng = P.sgu_ng + layer * 256;
  {
    const int s = tid >> 1, half = tid & 1;
    const bf16_t* zr = z + (size_t)(tok0 + s) * LDZ + ZC_AV;
    float ss = 0.f;
#pragma unroll 4
    for (int i = 0; i < 16; ++i) { float v[8]; unpack8(*(const u32x4*)(zr + half * 128 + i * 8), v);
#pragma unroll
      for (int e = 0; e < 8; ++e) { const float t = gelu_t(v[e]); ss += t * t; } }
    ss += __shfl_xor(ss, 1);
    const float rs = rsqrtf(ss * (1.f / 256.f) + 1e-6f);
#pragma unroll
    for (int i = 0; i < 4; ++i) { float v[8]; unpack8(*(const u32x4*)(zr + g * 64 + half * 32 + i * 8), v);
#pragma unroll
      for (int e = 0; e < 8; ++e) { const int d = half * 32 + i * 8 + e; vT[d * 136 + s] = f2bf(gelu_t(v[e]) * rs * ng[g * 64 + d]); } }
  }
  __syncthreads();
  const bf16_t* W = (const bf16_t*)(P.ws + OFF_SGUW) + (size_t)((layer * 4 + g) * 128) * 128;
  f32x4 acc[2][4] = {};
  for (int ks = 0; ks <= w; ++ks) {
    bf16x8 wf[2], vf[4];
#pragma unroll
    for (int tm = 0; tm < 2; ++tm) wf[tm] = *(const bf16x8*)(W + (size_t)(32 * w + tm * 16 + fr) * 128 + ks * 32 + 8 * fq);
#pragma unroll
    for (int dn = 0; dn < 4; ++dn) vf[dn] = *(const bf16x8*)(vT + (dn * 16 + fr) * 136 + ks * 32 + 8 * fq);
#pragma unroll
    for (int tm = 0; tm < 2; ++tm)
#pragma unroll
      for (int dn = 0; dn < 4; ++dn) acc[tm][dn] = mfma16(vf[dn], wf[tm], acc[tm][dn]);
  }
#pragma unroll
  for (int tm = 0; tm < 2; ++tm) {
    const int t = 32 * w + tm * 16 + fr;
    const float bias = P.sgu_b[(layer * 4 + g) * 128 + t];
#pragma unroll
    for (int dn = 0; dn < 4; ++dn) {
      const int d = dn * 16 + 4 * fq;
      const uint2 uu = *(const uint2*)(z + (size_t)(tok0 + t) * LDZ + ZC_AU + g * 64 + d);
      const float u0 = gelu_t(__uint_as_float(uu.x << 16)), u1 = gelu_t(__uint_as_float(uu.x & 0xffff0000u)),
                  u2 = gelu_t(__uint_as_float(uu.y << 16)), u3 = gelu_t(__uint_as_float(uu.y & 0xffff0000u));
      uint2 o; o.x = pk2(u0 * (acc[tm][dn][0] + bias), u1 * (acc[tm][dn][1] + bias)); o.y = pk2(u2 * (acc[tm][dn][2] + bias), u3 * (acc[tm][dn][3] + bias));
      *(uint2*)(y + (size_t)(tok0 + t) * 1024 + g * 64 + d) = o;
    }
  }
  __syncthreads();
}

__device__ __forceinline__ void mixB1_item(const Params& P, int layer, int idx, const bf16_t* z, float* hsl, float* Pc, float* carryP, float* carryH, char* lds) {
  const int c = idx & 63, g = (idx >> 6) & 3, b = idx >> 8;
  const int tid = HTID, lane = tid & 63, w = tid >> 6, fr = lane & 15, fq = lane >> 4;
  bf16_t* xcb = (bf16_t*)lds;
  float* xcf = (float*)(lds + 9216);
  float* aA = (float*)(lds + 9216 + 16384);
  float* bB = (float*)(lds + 9216 + 32768);
  float* sm = (float*)(lds + 9216 + 49152);
  const size_t tokb = (size_t)b * SEQ;
  {
    const int t = tid >> 2, q = tid & 3;
    float accv[16];
#pragma unroll
    for (int i = 0; i < 16; ++i) accv[i] = P.conv_b[layer * 256 + g * 64 + q * 16 + i];
#pragma unroll
    for (int k = 0; k < 4; ++k) {
      const int pos = c * 64 + t - 3 + k;
      if (pos >= 0) {
        const bf16_t* zr = z + (tokb + pos) * LDZ + ZC_BX + g * 64 + q * 16;
        float v[16]; unpack8(*(const u32x4*)zr, v); unpack8(*(const u32x4*)(zr + 8), v + 8);
        const float* cw = P.conv_w + (size_t)(layer * 4 + k) * 256 + g * 64 + q * 16;
#pragma unroll
        for (int i = 0; i < 16; ++i) accv[i] += v[i] * cw[i];
      }
    }
#pragma unroll
    for (int i = 0; i < 16; ++i) { xcf[t * 64 + q * 16 + i] = accv[i]; xcb[t * 72 + q * 16 + i] = f2bf(accv[i]); }
  }
  __syncthreads();
  {
    const bf16_t* wa = (const bf16_t*)(P.ws + OFF_WAT) + (layer * 4 + g) * 4096;
    const bf16_t* wx = (const bf16_t*)(P.ws + OFF_WXT) + (layer * 4 + g) * 4096;
    f32x4 ar[4] = {}, ai[4] = {};
#pragma unroll
    for (int ks = 0; ks < 2; ++ks) {
      const bf16x8 xf = *(const bf16x8*)(xcb + (16 * w + fr) * 72 + ks * 32 + 8 * fq);
#pragma unroll
      for (int jn = 0; jn < 4; ++jn) {
        const bf16x8 fa = *(const bf16x8*)(wa + (jn * 16 + fr) * 64 + ks * 32 + 8 * fq);
        const bf16x8 fx = *(const bf16x8*)(wx + (jn * 16 + fr) * 64 + ks * 32 + 8 * fq);
        ar[jn] = mfma16(fa, xf, ar[jn]); ai[jn] = mfma16(fx, xf, ai[jn]);
      }
    }
    const int t = 16 * w + fr;
#pragma unroll
    for (int jn = 0; jn < 4; ++jn)
#pragma unroll
      for (int e = 0; e < 4; ++e) {
        const int j = jn * 16 + 4 * fq + e, ch = layer * 256 + g * 64 + j;
        const float r = sigm(ar[jn][e] + P.lru_ba[ch]), ig = sigm(ai[jn][e] + P.lru_bx[ch]);
        const float lam = P.lru_lam[ch];
        const float la = -8.f * r * log1pf(__expf(-lam));
        const float av = __expf(la);
        const float bv = sqrtf(-expm1f(2.f * la)) * (ig * xcf[t * 64 + j]);
        aA[t * 64 + j] = av; bB[t * 64 + j] = bv;
      }
  }
  __syncthreads();
  {
    const int q = tid >> 6, j = tid & 63;
    float Pq = 1.f, hq = 0.f;
#pragma unroll
    for (int i = 0; i < 16; ++i) { const int t = q * 16 + i; const float av = aA[t * 64 + j], bv = bB[t * 64 + j]; hq = av * hq + bv; Pq *= av; aA[t * 64 + j] = Pq; bB[t * 64 + j] = hq; }
    sm[q * 64 + j] = Pq; sm[256 + q * 64 + j] = hq;
    __syncthreads();
    float Pin = 1.f, Hin = 0.f;
    for (int qq = 0; qq < q; ++qq) { const float pp = sm[qq * 64 + j], hh = sm[256 + qq * 64 + j]; Hin = pp * Hin + hh; Pin *= pp; }
    float hl = 0.f, pl = 1.f;
#pragma unroll
    for (int i = 0; i < 16; ++i) { const int t = q * 16 + i; hl = bB[t * 64 + j] + aA[t * 64 + j] * Hin; pl = aA[t * 64 + j] * Pin;
      const size_t o = (tokb + c * 64 + t) * 256 + g * 64 + j; hsl[o] = hl; Pc[o] = pl; }
    if (q == 3) { const int o = ((b * 4 + g) * 64 + c) * 64 + j; carryP[o] = pl; carryH[o] = hl; }
  }
  __syncthreads();
}

__device__ __forceinline__ void mixB2_item(int idx, const bf16_t* z, const float* hsl, const float* Pc, const float* carryP, const float* carryH, bf16_t* y) {
  const int c = idx & 63, g = (idx >> 6) & 3, b = idx >> 8;
  const int q = HTID >> 6, j = HTID & 63;
  const float* cp = carryP + (size_t)((b * 4 + g) * 64) * 64 + j;
  const float* chh = carryH + (size_t)((b * 4 + g) * 64) * 64 + j;
  float H = 0.f;
  for (int c0 = 0; c0 < c; c0 += 8) {
    float pv[8], hv[8];
#pragma unroll
    for (int i = 0; i < 8; ++i) { const bool ok = c0 + i < c; pv[i] = ok ? cp[(c0 + i) * 64] : 1.f; hv[i] = ok ? chh[(c0 + i) * 64] : 0.f; }
#pragma unroll
    for (int i = 0; i < 8; ++i) H = pv[i] * H + hv[i];
  }
  const size_t tokb = (size_t)b * SEQ + c * 64 + q * 16;
#pragma unroll 4
  for (int i = 0; i < 16; ++i) {
    const size_t o = (tokb + i) * 256 + g * 64 + j;
    const float h = hsl[o] + Pc[o] * H;
    const float gt = bf2f(z[(tokb + i) * LDZ + ZC_BG + g * 64 + j]);
    y[(tokb + i) * 1024 + 256 + g * 64 + j] = f2bf(h * gelu_t(gt));
  }
}

__device__ __forceinline__ void compress_item(const Params& P, int layer, int idx, const bf16_t* z, bf16_t* kcv, char* lds) {
  const int nb = idx & 7, g = (idx >> 3) & 1, b = (idx >> 4) & 7, kv = idx >> 7;
  const int tid = HTID, lane = tid & 63, w = tid >> 6, fr = lane & 15, fq = lane >> 4;
  const int n0 = nb * 32, col = (kv ? ZC_VC : ZC_KC) + g * 64;
  const bf16_t* w1t = (const bf16_t*)(P.ws + OFF_CW1 + (size_t)(layer * 2 + kv) * SZ_CW1);
  float* hid = (float*)lds;
  f32x4 acc[2][2] = {};
  const bf16_t* zb[2]; const bf16_t* wb[2];
#pragma unroll
  for (int nf = 0; nf < 2; ++nf) { int n = n0 + nf * 16 + fr; if (n > 254) n = 254; zb[nf] = z + ((size_t)b * SEQ + 16 * n) * LDZ + col + 8 * fq; }
#pragma unroll
  for (int jf = 0; jf < 2; ++jf) wb[jf] = w1t + (size_t)(32 * w + jf * 16 + fr) * 2048 + 8 * fq;
#pragma unroll 4
  for (int ks = 0; ks < 64; ++ks) {
    const int l = ks >> 1, d0 = (ks & 1) * 32;
    bf16x8 xf[2], wf[2];
#pragma unroll
    for (int nf = 0; nf < 2; ++nf) xf[nf] = *(const bf16x8*)(zb[nf] + (size_t)l * LDZ + d0);
#pragma unroll
    for (int jf = 0; jf < 2; ++jf) wf[jf] = *(const bf16x8*)(wb[jf] + ks * 32);
#pragma unroll
    for (int jf = 0; jf < 2; ++jf)
#pragma unroll
      for (int nf = 0; nf < 2; ++nf) acc[jf][nf] = mfma16(wf[jf], xf[nf], acc[jf][nf]);
  }
  const float* cb1 = (const float*)(P.ws + OFF_CB1) + (layer * 2 + kv) * 128;
#pragma unroll
  for (int jf = 0; jf < 2; ++jf)
#pragma unroll
    for (int nf = 0; nf < 2; ++nf)
#pragma unroll
      for (int e = 0; e < 4; ++e) { const int j = 32 * w + jf * 16 + 4 * fq + e; hid[(nf * 16 + fr) * 129 + j] = gelu_t(acc[jf][nf][e] + cb1[j]); }
  __syncthreads();
  {
    const int n = tid >> 3, d0 = (tid & 7) * 8;
    const float* w2 = P.cmp_w2 + (size_t)(layer * 2 + kv) * 128 * 64 + d0;
    const float* b2 = P.cmp_b2 + (layer * 2 + kv) * 64 + d0;
    float o[8];
#pragma unroll
    for (int e = 0; e < 8; ++e) o[e] = b2[e];
    for (int j = 0; j < 128; ++j) {
      const float hv = hid[n * 129 + j]; const float4 wa = *(const float4*)(w2 + j * 64), wb2 = *(const float4*)(w2 + j * 64 + 4);
      o[0] += hv * wa.x; o[1] += hv * wa.y; o[2] += hv * wa.z; o[3] += hv * wa.w; o[4] += hv * wb2.x; o[5] += hv * wb2.y; o[6] += hv * wb2.z; o[7] += hv * wb2.w;
    }
    const bool valid = (n0 + n) < 255;
    uint4 ov = valid ? make_uint4(pk2(o[0], o[1]), pk2(o[2], o[3]), pk2(o[4], o[5]), pk2(o[6], o[7])) : make_uint4(0, 0, 0, 0);
    *(uint4*)(kcv + ((size_t)((kv * 8 + b) * 2 + g) * 256 + n0 + n) * 64 + d0) = ov;
  }
  __syncthreads();
}

constexpr int NSA_KT = 0, NSA_VT = 16384, NSA_BKT = 33792, NSA_RB = 37888, NSA_IMP = 38976, NSA_WU = 38976 + 2 * 16640;

__device__ __forceinline__ void nsa_tables(const Params& P, char* lds) {
  unsigned char* bkt = (unsigned char*)(lds + NSA_BKT);
  float* rb = (float*)(lds + NSA_RB);
  const int tid = TIDX;
  for (int n = tid; n < 4096; n += 512) {
    int bk = n;
    if (n >= 16) bk = 16 + (n >= 21) + (n >= 27) + (n >= 35) + (n >= 46) + (n >= 59) + (n >= 77) + (n >= 99) + (n >= 128) + (n >= 166) + (n >= 216) + (n >= 280) + (n >= 363) + (n >= 470) + (n >= 609) + (n >= 790);
    bkt[n] = (unsigned char)bk;
  }
  if (tid < 256) rb[tid] = P.rel_bias[tid];
  if (tid < 8) rb[256 + tid] = -__builtin_inff();
  __syncthreads();
}

struct KVRegs { u32x4 k0, v0; };
__device__ __forceinline__ void kv_gload(KVRegs& r, const bf16_t* kb, const bf16_t* vb, size_t stride) {
  const int tid = TIDX, row = tid >> 3, cq = tid & 7;
  r.k0 = *(const u32x4*)(kb + row * stride + cq * 8); r.v0 = *(const u32x4*)(vb + row * stride + cq * 8);
}
__device__ __forceinline__ void kv_lwrite(const KVRegs& r, char* lds, int buf) {
  const int tid = TIDX, row = tid >> 3, cq = tid & 7;
  char* kt = lds + NSA_KT + buf * 8192 + row * 128;
  *(u32x4*)(kt + ((cq ^ (row & 7)) << 4)) = r.k0;
  bf16_t* vt = (bf16_t*)(lds + NSA_VT + buf * 8704) + (cq * 8) * 68 + row;
#pragma unroll
  for (int i = 0; i < 4; ++i) { vt[(2 * i) * 68] = (bf16_t)(r.v0[i] & 0xffffu); vt[(2 * i + 1) * 68] = (bf16_t)(r.v0[i] >> 16); }
}

template <int MODE>
__device__ __forceinline__ void nsa_compute(int cur, int buf, int t, int hb, u64 mymask, const bf16x8 (&Qf)[2][2], f32x4 (&O)[4][2], float (&m)[2], float (&l)[2],
                                            const float (&inv)[2], float* impw, char* lds) {
  const int lane = TIDX & 63, fr = lane & 15, fq = lane >> 4;
  const unsigned char* bkt = (const unsigned char*)(lds + NSA_BKT);
  const float* rb = (const float*)(lds + NSA_RB);
  const char* kt = lds + NSA_KT + buf * 8192;
  const bf16_t* vt = (const bf16_t*)(lds + NSA_VT + buf * 8704);
  const bool selok = (MODE == 2) ? (((mymask >> cur) & 1ull) != 0ull) : true;
#pragma unroll
  for (int s2 = 0; s2 < 2; ++s2) {
    f32x4 S[2][2] = {};
#pragma unroll
    for (int ks = 0; ks < 2; ++ks)
#pragma unroll
      for (int kk = 0; kk < 2; ++kk) {
        const bf16x8 kf = *(const bf16x8*)(kt + (32 * s2 + 16 * kk + fr) * 128 + (((ks * 4 + fq) ^ (fr & 7)) << 4));
#pragma unroll
        for (int r = 0; r < 2; ++r) S[kk][r] = mfma16(kf, Qf[r][ks], S[kk][r]);
      }
    int bo[2][4];
#pragma unroll
    for (int kk = 0; kk < 2; ++kk)
#pragma unroll
      for (int e = 0; e < 4; ++e) {
        const int kl = cur * 64 + 32 * s2 + 16 * kk + 4 * fq + e;
        int dd; bool o;
        if (MODE <= 1) { dd = t - (16 * kl + 31); o = dd >= 0; }
        else if (MODE == 2) { dd = t - kl; o = (dd >= 0) && selok; }
        else { dd = t - kl; o = (dd >= 0) && (dd < 512); }
        bo[kk][e] = (o ? (int)bkt[dd] : 32) * 8 + hb;
      }
    bf16x8 Pf[2];
    float g1s[2] = {0.f, 0.f}, p3s[2] = {0.f, 0.f};
#pragma unroll
    for (int r = 0; r < 2; ++r) {
      float sv[2][4];
#pragma unroll
      for (int kk = 0; kk < 2; ++kk)
#pragma unroll
        for (int e = 0; e < 4; ++e) sv[kk][e] = S[kk][r][e] * 0.125f + rb[bo[kk][e] + r];
      float pv[2][4];
      if (MODE == 1) {
#pragma unroll
        for (int kk = 0; kk < 2; ++kk)
#pragma unroll
          for (int e = 0; e < 4; ++e) pv[kk][e] = __expf(sv[kk][e] - m[r]) * inv[r];
#pragma unroll
        for (int kk = 0; kk < 2; ++kk) { g1s[kk] += pv[kk][0] + pv[kk][1] + pv[kk][2] + 0.5f * pv[kk][3]; p3s[kk] += 0.5f * pv[kk][3]; }
      } else {
        float mx = fmaxf(fmaxf(fmaxf(sv[0][0], sv[0][1]), fmaxf(sv[0][2], sv[0][3])), fmaxf(fmaxf(sv[1][0], sv[1][1]), fmaxf(sv[1][2], sv[1][3])));
        mx = fmaxf(mx, __shfl_xor(mx, 16)); mx = fmaxf(mx, __shfl_xor(mx, 32));
        const float mn = fmaxf(m[r], mx), al = __expf(m[r] - mn);
        m[r] = mn;
        float ps = 0.f;
#pragma unroll
        for (int kk = 0; kk < 2; ++kk)
#pragma unroll
          for (int e = 0; e < 4; ++e) { pv[kk][e] = __expf(sv[kk][e] - mn); ps += pv[kk][e]; }
        l[r] = l[r] * al + ps;
        if (MODE != 0) {
#pragma unroll
          for (int df = 0; df < 4; ++df) O[df][r] *= al;
        }
      }
      if (MODE != 0) {
        const unsigned w0 = pk2(pv[0][0], pv[0][1]), w1 = pk2(pv[0][2], pv[0][3]), w2 = pk2(pv[1][0], pv[1][1]), w3 = pk2(pv[1][2], pv[1][3]);
        Pf[r][0] = (short)(w0 & 0xffff); Pf[r][1] = (short)(w0 >> 16); Pf[r][2] = (short)(w1 & 0xffff); Pf[r][3] = (short)(w1 >> 16);
        Pf[r][4] = (short)(w2 & 0xffff); Pf[r][5] = (short)(w2 >> 16); Pf[r][6] = (short)(w3 & 0xffff); Pf[r][7] = (short)(w3 >> 16);
      }
    }
    if (MODE != 0) {
#pragma unroll
      for (int df = 0; df < 4; ++df) {
        const bf16x4 va = *(const bf16x4*)(vt + (df * 16 + fr) * 68 + 32 * s2 + 4 * fq);
        const bf16x4 vb = *(const bf16x4*)(vt + (df * 16 + fr) * 68 + 32 * s2 + 16 + 4 * fq);
        bf16x8 vf; vf[0] = va[0]; vf[1] = va[1]; vf[2] = va[2]; vf[3] = va[3]; vf[4] = vb[0]; vf[5] = vb[1]; vf[6] = vb[2]; vf[7] = vb[3];
#pragma unroll
        for (int r = 0; r < 2; ++r) O[df][r] = mfma16(vf, Pf[r], O[df][r]);
      }
    }
    if (MODE == 1) {
#pragma unroll
      for (int kk = 0; kk < 2; ++kk) {
        const int j = cur * 16 + (2 * s2 + kk) * 4 + fq;
        atomicAdd(&impw[fr * 65 + j], g1s[kk]);
        if (j + 1 < 64) atomicAdd(&impw[fr * 65 + j + 1], p3s[kk]);
      }
    }
  }
}

template <int MODE>
__device__ __forceinline__ void nsa_branch(int first, int ntl, u64 U, const bf16_t* kbase, const bf16_t* vbase, size_t stride, int t, int hb, u64 mymask,
                                           const bf16x8 (&Qf)[2][2], f32x4 (&O)[4][2], float (&m)[2], float (&l)[2], const float (&inv)[2], float* impw, char* lds) {
  KVRegs kr;
  int nxt, left = ntl;
  u64 rem = U;
  if (MODE == 2) { nxt = rem ? (int)__builtin_ctzll(rem) : -1; if (rem) rem &= rem - 1; }
  else { nxt = ntl > 0 ? first : -1; }
  if (nxt >= 0) { kv_gload(kr, kbase + (size_t)nxt * 64 * stride, vbase + (size_t)nxt * 64 * stride, stride); kv_lwrite(kr, lds, 0); }
  __syncthreads();
  int buf = 0;
  while (nxt >= 0) {
    const int cur = nxt;
    if (MODE == 2) { nxt = rem ? (int)__builtin_ctzll(rem) : -1; if (rem) rem &= rem - 1; }
    else { --left; nxt = left > 0 ? cur + 1 : -1; }
    if (nxt >= 0) kv_gload(kr, kbase + (size_t)nxt * 64 * stride, vbase + (size_t)nxt * 64 * stride, stride);
    nsa_compute<MODE>(cur, buf, t, hb, mymask, Qf, O, m, l, inv, impw, lds);
    if (nxt >= 0) kv_lwrite(kr, lds, buf ^ 1);
    __syncthreads();
    buf ^= 1;
  }
}

#define NSA_RESET()                                                                         \
  _Pragma("unroll") for (int r = 0; r < 2; ++r) { m[r] = -1e30f; l[r] = 0.f; }               \
  _Pragma("unroll") for (int df = 0; df < 4; ++df) _Pragma("unroll") for (int r = 0; r < 2; ++r) O[df][r] = (f32x4){0.f, 0.f, 0.f, 0.f};

__device__ __forceinline__ void nsa_item(const Params& P, int b, int g, int c, const bf16_t* z, const bf16_t* kcv, bf16_t* y, char* lds) {
  const int tid = TIDX, lane = tid & 63, w8 = tid >> 6, qg = w8 & 3, hp = w8 >> 2, fr = lane & 15, fq = lane >> 4;
  const size_t tokb = (size_t)b * SEQ;
  const int t = c * 64 + 16 * qg + fr;
  const bf16_t* zq = z + (tokb + t) * LDZ;
  const int hb = g * 4 + hp * 2;
  bf16x8 Qf[2][2];
#pragma unroll
  for (int r = 0; r < 2; ++r)
#pragma unroll
    for (int ks = 0; ks < 2; ++ks) Qf[r][ks] = *(const bf16x8*)(zq + ZC_Q + g * 256 + (hp * 2 + r) * 64 + ks * 32 + 8 * fq);
  float* impw = (float*)(lds + NSA_IMP) + (hp * 4 + qg) * (16 * 65);
  for (int i = lane; i < 16 * 65; i += 64) impw[i] = 0.f;
  f32x4 O[4][2];
  float m[2], l[2], inv[2];
  bf16_t* yo = y + (tokb + t) * 1024 + 512 + g * 256 + hp * 128 + 4 * fq;
  const bf16_t* kc = kcv + (size_t)((0 * 8 + b) * 2 + g) * 256 * 64;
  const bf16_t* vc = kcv + (size_t)((1 * 8 + b) * 2 + g) * 256 * 64;
  const int nct = ((4 * c + 2) >> 6) + 1;
  NSA_RESET();
  inv[0] = 0.f; inv[1] = 0.f;
  nsa_branch<0>(0, nct, 0ull, kc, vc, 64, t, hb, 0ull, Qf, O, m, l, inv, impw, lds);
#pragma unroll
  for (int r = 0; r < 2; ++r) { float lt = l[r]; lt += __shfl_xor(lt, 16); lt += __shfl_xor(lt, 32); inv[r] = lt > 0.f ? 1.f / lt : 0.f; }
  nsa_branch<1>(0, nct, 0ull, kc, vc, 64, t, hb, 0ull, Qf, O, m, l, inv, impw, lds);
#pragma unroll
  for (int r = 0; r < 2; ++r) {
    const float gt = sigm(bf2f(zq[ZC_GC + hb + r]));
#pragma unroll
    for (int df = 0; df < 4; ++df) { u32x2 o; o.x = pk2(O[df][r][0] * gt, O[df][r][1] * gt); o.y = pk2(O[df][r][2] * gt, O[df][r][3] * gt); *(u32x2*)(yo + r * 64 + df * 16) = o; }
  }
  __syncthreads();
  u64 mymask = 0ull, wU = 0ull;
  const float* imp0 = (const float*)(lds + NSA_IMP) + qg * (16 * 65);
  const float* imp1 = imp0 + 4 * (16 * 65);
  for (int qq = 0; qq < 16; ++qq) {
    const float sv = imp0[qq * 65 + lane] + imp1[qq * 65 + lane];
    const int j = lane;
    const bool forced = (j == 0) | (j == c) | (j == c - 1);
    const float sc = (j <= c) ? (forced ? 1e4f : sv) : -1.0f;
    int rank = 0;
#pragma unroll 16
    for (int k = 0; k < 64; ++k) { const float sk = __int_as_float(__builtin_amdgcn_readlane(__float_as_int(sc), k)); rank += ((sk > sc) || (sk == sc && k < j)) ? 1 : 0; }
    const bool sel = (rank < 16) && (sc >= 0.f);
    const u64 mk = __ballot(sel);
    if (fr == qq) mymask = mk;
    wU |= mk;
  }
  u64* WU = (u64*)(lds + NSA_WU);
  if (lane == 0) WU[w8] = wU;
  __syncthreads();
  const u64 U = WU[0] | WU[1] | WU[2] | WU[3];
  for (int br = 0; br < 2; ++br) {
    NSA_RESET();
    int zg;
    if (br == 0) {
      nsa_branch<2>(0, 0, U, z + tokb * LDZ + ZC_KS + g * 64, z + tokb * LDZ + ZC_VS + g * 64, LDZ, t, hb, mymask, Qf, O, m, l, inv, impw, lds);
      zg = ZC_GS;
    } else {
      const int kt0 = c > 8 ? c - 8 : 0;
      nsa_branch<3>(kt0, c - kt0 + 1, 0ull, z + tokb * LDZ + ZC_KW + g * 64, z + tokb * LDZ + ZC_VW + g * 64, LDZ, t, hb, 0ull, Qf, O, m, l, inv, impw, lds);
      zg = ZC_GW;
    }
#pragma unroll
    for (int r = 0; r < 2; ++r) {
      float lt = l[r]; lt += __shfl_xor(lt, 16); lt += __shfl_xor(lt, 32);
      const float gt = sigm(bf2f(zq[zg + hb + r])) * (lt > 0.f ? 1.f / lt : 0.f);
#pragma unroll
      for (int df = 0; df < 4; ++df) {
        bf16_t* yp = yo + r * 64 + df * 16;
        const u32x2 pr = *(const u32x2*)yp;
        u32x2 o; o.x = pk2(__uint_as_float(pr.x << 16) + O[df][r][0] * gt, __uint_as_float(pr.x & 0xffff0000u) + O[df][r][1] * gt);
        o.y = pk2(__uint_as_float(pr.y << 16) + O[df][r][2] * gt, __uint_as_float(pr.y & 0xffff0000u) + O[df][r][3] * gt);
        *(u32x2*)yp = o;
      }
    }
  }
  __syncthreads();
}

__device__ __forceinline__ void run_phase(const Params& P, int ph, char* lds) {
  char* ws = P.ws;
  bf16_t* abuf = (bf16_t*)(ws + OFF_A);
  bf16_t* big = (bf16_t*)(ws + OFF_BIG);
  float* fbuf = (float*)(ws + OFF_F);
  float* hsl = fbuf; float* Pc = fbuf + (size_t)M_TOK * 256;
  bf16_t* kcv = (bf16_t*)(ws + OFF_KC);
  float* carryP = (float*)(ws + OFF_CARRY); float* carryH = carryP + 8 * 4 * 64 * 64;
  if (ph == 0) { prep_phase(P, lds); return; }
  const int layer = (ph - 1) / 13, sp = (ph - 1) % 13;
  const float* ng = P.norm_g + (size_t)layer * 8 * 1024;
#ifdef ONLY_SP
  if (sp != ONLY_SP) return;
#endif
  switch (sp) {
    case 0: case 8: {
      const int lj = layer * 2 + (sp == 8);
      gemm_up_phase(abuf, (const bf16_t*)(ws + OFF_WGU + lj * SZ_WGU), big, lds);
    } break;
    case 1: case 9: {
      const int lj = layer * 2 + (sp == 9);
      gemm_f32_phase(big, DFF, (const bf16_t*)(ws + OFF_WD + lj * SZ_WD), DFF, fbuf, lds);
    } break;
    case 2: resnorm_phase(P.out, P.out, fbuf, 0.5f, ng + 1 * 1024, ng + 2 * 1024, abuf); break;
    case 3: gemm_bf16_phase(abuf, 1024, (const bf16_t*)(ws + OFF_WIN + layer * SZ_WIN), 1024, LDZ / 256, big, LDZ, lds); break;
    case 4: {
      const int hb = HBLK; char* hl = lds + hb * 65536;
      for (int it = blockIdx.x * 2 + hb; it < 256; it += gridDim.x * 2) compress_item(P, layer, it, big, kcv, hl);
      for (int it = blockIdx.x * 2 + hb; it < 1024; it += gridDim.x * 2) mixA_item(P, layer, it, big, abuf, hl);
      for (int it = blockIdx.x * 2 + hb; it < 2048; it += gridDim.x * 2) mixB1_item(P, layer, it, big, hsl, Pc, carryP, carryH, hl);
    } break;
    case 5: {
      nsa_tables(P, lds);
      for (int it = blockIdx.x; it < 1024; it += gridDim.x) {
        const int rnd = it / 256, pos = it % 256;
        const int c = (rnd & 1) ? (rnd >> 1) * 16 + (pos >> 4) : 63 - (rnd >> 1) * 16 - (pos >> 4);
        const int bg = pos & 15;
        nsa_item(P, bg >> 1, bg & 1, c, big, kcv, abuf, lds);
      }
      const int hb = HBLK;
      for (int it = blockIdx.x * 2 + hb; it < 2048; it += gridDim.x * 2) mixB2_item(it, big, hsl, Pc, carryP, carryH, abuf);
    } break;
    case 6: gemm_f32_phase(abuf, 1024, (const bf16_t*)(ws + OFF_WOUT + layer * SZ_SQ), 1024, fbuf, lds); break;
    case 7: resnorm_phase(P.out, P.out, fbuf, 1.0f, ng + 3 * 1024, ng + 4 * 1024, abuf); break;
    case 10:
      gemm_bf16_phase((const bf16_t*)(ws + OFF_PBF) + (size_t)layer * M_TOK * 256, 256, (const bf16_t*)(ws + OFF_WPP + layer * SZ_WPP), 256, 4, big, 1024, lds);
      resnorm_phase(P.out, P.out, fbuf, 0.5f, ng + 5 * 1024, ng + 6 * 1024, abuf);
      break;
    case 11: gemm_ple_phase(abuf, (const bf16_t*)(ws + OFF_WPG + layer * SZ_SQ), big, fbuf, lds); break;
    case 12: resnorm_phase(P.out, P.out, fbuf, 1.0f, ng + 7 * 1024, layer == 0 ? P.norm_g + 8 * 1024 : nullptr, layer == 0 ? abuf : nullptr); break;
  }
}

#define XB_TMO      128
#define XB_XCNT(j)  (256  + 64 * (j))
#define XB_XSUB(j)  (1280 + 64 * (j))
#define XB_XGEN(j)  (2304 + 64 * (j))
#define XB_TOP      3328
#define XB_TOPGEN   3392
#define XCD_BAR_WORDS 3456
#define XB_SPIN_CAP (1u << 20)
#define LAS __attribute__((address_space(3)))
__device__ __forceinline__ unsigned xb_ld(unsigned* p)              { return __hip_atomic_load(p, __ATOMIC_RELAXED, __HIP_MEMORY_SCOPE_AGENT); }
__device__ __forceinline__ unsigned xb_add(unsigned* p, unsigned v) { return __hip_atomic_fetch_add(p, v, __ATOMIC_RELAXED, __HIP_MEMORY_SCOPE_AGENT); }
__device__ __forceinline__ unsigned xb_xcc_id() { return (unsigned)__builtin_amdgcn_s_getreg((3 << 11) | 20) & 0xFu; }
#define XB_SPIN(cond, bar) do { unsigned _sp = 0; while (cond) { __builtin_amdgcn_s_sleep(1); \
    if ((++_sp & 255u) == 0u) { if (xb_ld(&(bar)[XB_TMO])) break; if (_sp > XB_SPIN_CAP) { atomicAdd(&(bar)[XB_TMO], 1u); break; } } } } while (0)
struct XcdBarrier { unsigned* bar; unsigned x; volatile LAS unsigned* st; };
__device__ __forceinline__ XcdBarrier xcd_barrier_post(unsigned* bar, volatile LAS unsigned* st) {
    XcdBarrier b; b.bar = bar; b.x = xb_xcc_id(); b.st = st;
    if (threadIdx.x == 0) (void)xb_add(&bar[XB_XCNT(b.x)], 1u);
    return b;
}
__device__ __forceinline__ void xcd_barrier_complete(unsigned* bar, unsigned x, unsigned& nloc, unsigned& nx) {
    const unsigned G = gridDim.x * gridDim.y * gridDim.z;
    unsigned sum, cnt, mine, sp = 0u;
    for (;;) {
        sum = 0u; cnt = 0u; mine = 0u;
#pragma unroll
        for (unsigned j = 0; j < 16; ++j) { const unsigned c = xb_ld(&bar[XB_XCNT(j)]); sum += c; cnt += (c > 0u) ? 1u : 0u; mine = (j == x) ? c : mine; }
        if (sum == G) break;
        __builtin_amdgcn_s_sleep(1);
        if ((++sp & 255u) == 0u) { if (xb_ld(&bar[XB_TMO])) break; if (sp > XB_SPIN_CAP) { atomicAdd(&bar[XB_TMO], 1u); break; } }
    }
    nloc = mine > 0u ? mine : 1u; nx = cnt > 0u ? cnt : 1u;
}
__device__ __forceinline__ void xcd_barrier(const XcdBarrier& b) {
    asm volatile("s_waitcnt vmcnt(0)" ::: "memory");
    __syncthreads();
    if (threadIdx.x == 0) {
        unsigned* bar = b.bar;
        __builtin_amdgcn_s_waitcnt(0);
        unsigned nloc = b.st[0], nx = b.st[1];
        if (nloc == 0u) { xcd_barrier_complete(bar, b.x, nloc, nx); b.st[0] = nloc; b.st[1] = nx; }
        const unsigned old = xb_add(&bar[XB_XSUB(b.x)], 1u);
        const unsigned gen = old / nloc;
        if (old + 1u == (gen + 1u) * nloc) {
            __builtin_amdgcn_fence(__ATOMIC_RELEASE, "agent");
            asm volatile("s_waitcnt vmcnt(0)" ::: "memory");
            const unsigned og = xb_add(&bar[XB_TOP], 1u);
            const unsigned tg = og / nx;
            if (og + 1u == (tg + 1u) * nx) xb_add(&bar[XB_TOPGEN], 1u);
            else XB_SPIN(xb_ld(&bar[XB_TOPGEN]) == tg, bar);
            __builtin_amdgcn_fence(__ATOMIC_ACQUIRE, "agent");
            xb_add(&bar[XB_XGEN(b.x)], 1u);
            asm volatile("s_waitcnt vmcnt(0)" ::: "memory");
        } else {
            XB_SPIN(xb_ld(&bar[XB_XGEN(b.x)]) == gen, bar);
            __builtin_amdgcn_fence(__ATOMIC_ACQUIRE, "agent");
            asm volatile("s_waitcnt vmcnt(0)" ::: "memory");
        }
    }
    __syncthreads();
}

constexpr int LDS_BYTES = 131072 + 16;
__global__ void __launch_bounds__(512, 2) fwd_megakernel(Params P) {
  __shared__ __attribute__((aligned(16))) char lds[LDS_BYTES];
  cg::grid_group grid = cg::this_grid();
  volatile LAS unsigned* st = (volatile LAS unsigned*)(lds + 131072);
  if (threadIdx.x == 0) { st[0] = 0u; st[1] = 0u; }
  __syncthreads();
  XcdBarrier xb = xcd_barrier_post((unsigned*)(P.ws + OFF_BAR), st);
  if (P.ws == nullptr) grid.sync();
  for (int ph = 0; ph < NPHASE; ++ph) {
    run_phase(P, ph, lds);
    if (ph + 1 < NPHASE) xcd_barrier(xb);
  }
}

__global__ void __launch_bounds__(512, 2) phase_kernel(Params P, int ph) {
  __shared__ __attribute__((aligned(16))) char lds[LDS_BYTES];
  run_phase(P, ph, lds);
}

extern "C" void kernel_launch(void* const* d_in, const int* in_sizes, int n_in, void* d_out, int out_size, void* d_ws, size_t ws_size, hipStream_t stream) {
  Params P{};
  const float** pp = (const float**)&P;
  for (int i = 0; i < 26; ++i) pp[i] = (const float*)d_in[i];
  P.out = (float*)d_out;
  P.ws = (char*)d_ws;
  if (ws_size < WS_NEED) { fprintf(stderr, "workspace too small: %zu < %zu\n", ws_size, (size_t)WS_NEED); return; }
#if MK_FUSED
  static int grid_blocks = 0;
  if (!grid_blocks) {
    int dev = 0, cus = 0, per_cu = 0;
    (void)hipGetDevice(&dev);
    (void)hipDeviceGetAttribute(&cus, hipDeviceAttributeMultiprocessorCount, dev);
    (void)hipOccupancyMaxActiveBlocksPerMultiprocessor(&per_cu, fwd_megakernel, 512, 0);
    if (per_cu > 1) per_cu = 1;
    if (per_cu < 1) per_cu = 1;
    grid_blocks = cus * per_cu;
  }
  (void)hipMemsetAsync((char*)d_ws + OFF_BAR, 0, XCD_BAR_WORDS * 4, stream);
  void* args[] = {&P};
  hipError_t e = hipLaunchCooperativeKernel((void*)fwd_megakernel, dim3(grid_blocks), dim3(512), args, 0, stream);
  if (e != hipSuccess) fprintf(stderr, "cooperative launch failed: %s (grid %d)\n", hipGetErrorString(e), grid_blocks);
#else
  for (int ph = 0; ph < NPHASE; ++ph) phase_kernel<<<256, 512, 0, stream>>>(P, ph);
#endif
}
```

```cpp
#include <hip/hip_runtime.h>
#include <hip/hip_cooperative_groups.h>
#include <cstdint>
#include <cstdio>
namespace cg = cooperative_groups;

#ifndef MK_FUSED
#define MK_FUSED 1
#endif

typedef unsigned short bf16_t;
typedef short bf16x8 __attribute__((ext_vector_type(8)));
typedef short bf16x4 __attribute__((ext_vector_type(4)));
typedef float f32x4 __attribute__((ext_vector_type(4)));
typedef unsigned long long u64;
typedef unsigned u32x4 __attribute__((ext_vector_type(4)));
typedef unsigned u32x2 __attribute__((ext_vector_type(2)));

constexpr int M_TOK = 32768, DM = 1024, DFF = 2816, NGU = 5632, NIN = 2328, LDZ = 2560, SEQ = 4096;
constexpr int NPHASE = 27;
constexpr int ZC_AU = 0, ZC_AV = 256, ZC_BX = 512, ZC_BG = 768, ZC_Q = 1024, ZC_KC = 1536, ZC_VC = 1664, ZC_KS = 1792, ZC_VS = 1920,
              ZC_KW = 2048, ZC_VW = 2176, ZC_GC = 2304, ZC_GS = 2312, ZC_GW = 2320;

constexpr size_t SZ_WGU = (size_t)NGU * 1024 * 2, SZ_WD = (size_t)1024 * DFF * 2, SZ_WIN = (size_t)LDZ * 1024 * 2, SZ_SQ = (size_t)1024 * 1024 * 2,
                 SZ_WPP = (size_t)1024 * 256 * 2, SZ_CW1 = (size_t)128 * 2048 * 2;
constexpr size_t OFF_WGU = 0;
constexpr size_t OFF_WD = OFF_WGU + 4 * SZ_WGU;
constexpr size_t OFF_WIN = OFF_WD + 4 * SZ_WD;
constexpr size_t OFF_WOUT = OFF_WIN + 2 * SZ_WIN;
constexpr size_t OFF_WPG = OFF_WOUT + 2 * SZ_SQ;
constexpr size_t OFF_WPP = OFF_WPG + 2 * SZ_SQ;
constexpr size_t OFF_CW1 = OFF_WPP + 2 * SZ_WPP;
constexpr size_t OFF_CB1 = OFF_CW1 + 4 * SZ_CW1;
constexpr size_t OFF_SGUW = OFF_CB1 + 4096;
constexpr size_t OFF_WAT = OFF_SGUW + 2 * 4 * 128 * 128 * 2;
constexpr size_t OFF_WXT = OFF_WAT + 2 * 4 * 64 * 64 * 2;
constexpr size_t OFF_PBF = OFF_WXT + 2 * 4 * 64 * 64 * 2;
constexpr size_t OFF_A = OFF_PBF + (size_t)2 * M_TOK * 256 * 2;
constexpr size_t OFF_BIG = OFF_A + (size_t)M_TOK * 1024 * 2;
constexpr size_t OFF_F = OFF_BIG + (size_t)M_TOK * DFF * 2;
constexpr size_t OFF_KC = OFF_F + (size_t)M_TOK * 1024 * 4;
constexpr size_t OFF_CARRY = OFF_KC + (size_t)2 * 8 * 2 * 256 * 64 * 2;
constexpr size_t OFF_BAR = OFF_CARRY + (size_t)2 * 8 * 4 * 64 * 64 * 4;
constexpr size_t WS_NEED = OFF_BAR + 16384;

struct Params {
  const float *x, *p, *rel_bias, *norm_g, *ffn_wg, *ffn_wu, *ffn_wd, *w_in, *w_out, *sgu_ng, *sgu_w, *sgu_b, *conv_w, *conv_b,
      *lru_wa, *lru_ba, *lru_wx, *lru_bx, *lru_lam, *cmp_pos, *cmp_w1, *cmp_b1, *cmp_w2, *cmp_b2, *ple_wg, *ple_wp;
  float* out;
  char* ws;
};

__device__ __forceinline__ int opaque_tid() { int t; asm volatile("v_mov_b32 %0, %1" : "=v"(t) : "v"(threadIdx.x)); return t; }
#define TIDX opaque_tid()
#define HTID (opaque_tid() & 255)
#define HBLK (opaque_tid() >> 8)
__device__ __forceinline__ float bf2f(bf16_t v) { return __uint_as_float(((unsigned)v) << 16); }
__device__ __forceinline__ bf16_t f2bf(float f) { unsigned u = __float_as_uint(f); u += 0x7fffu + ((u >> 16) & 1u); return (bf16_t)(u >> 16); }
__device__ __forceinline__ unsigned pk2(float lo, float hi) { unsigned r; asm("v_cvt_pk_bf16_f32 %0, %1, %2" : "=v"(r) : "v"(lo), "v"(hi)); return r; }
__device__ __forceinline__ float sigm(float x) { return __builtin_amdgcn_rcpf(1.f + __expf(-x)); }
__device__ __forceinline__ float gelu_t(float x) { float u = 0.7978845608028654f * (x + 0.044715f * x * x * x); return x * __builtin_amdgcn_rcpf(1.f + __expf(-2.f * u)); }
__device__ __forceinline__ float silu_f(float x) { return x * __builtin_amdgcn_rcpf(1.f + __expf(-x)); }
__device__ __forceinline__ f32x4 mfma16(bf16x8 a, bf16x8 b, f32x4 c) { return __builtin_amdgcn_mfma_f32_16x16x32_bf16(a, b, c, 0, 0, 0); }
__device__ __forceinline__ void glds16(const void* g, void* l) {
  __builtin_amdgcn_global_load_lds((const __attribute__((address_space(1))) unsigned*)g, (__attribute__((address_space(3))) unsigned*)l, 16, 0, 0);
}
__device__ __forceinline__ f32x4 zero4() { f32x4 z; asm volatile("v_mov_b32 %0, 0\n\tv_mov_b32 %1, 0\n\tv_mov_b32 %2, 0\n\tv_mov_b32 %3, 0" : "=v"(z[0]), "=v"(z[1]), "=v"(z[2]), "=v"(z[3])); return z; }
__device__ __forceinline__ float wave_sum(float v) {
#pragma unroll
  for (int o = 32; o > 0; o >>= 1) v += __shfl_xor(v, o);
  return v;
}
__device__ __forceinline__ void unpack8(const u32x4 u, float* f) {
  f[0] = __uint_as_float(u.x << 16); f[1] = __uint_as_float(u.x & 0xffff0000u);
  f[2] = __uint_as_float(u.y << 16); f[3] = __uint_as_float(u.y & 0xffff0000u);
  f[4] = __uint_as_float(u.z << 16); f[5] = __uint_as_float(u.z & 0xffff0000u);
  f[6] = __uint_as_float(u.w << 16); f[7] = __uint_as_float(u.w & 0xffff0000u);
}

__device__ __forceinline__ void tr_cvt_tile(const float* __restrict__ src, int N, int K, bf16_t* __restrict__ dst, int ldd, int rs, int ro, int tile, bool active, float* lds) {
  const int ntn = (N + 63) >> 6, tk = tile / ntn, tn = tile - tk * ntn, k0 = tk * 64, n0 = tn * 64, tid = HTID;
#pragma unroll
  for (int ps = 0; ps < 4; ++ps) {
    const int i = ps * 16 + (tid >> 4), j = (tid & 15) * 4;
    float4 v = make_float4(0.f, 0.f, 0.f, 0.f);
    if (active && n0 + j < N) v = *(const float4*)(src + (size_t)(k0 + i) * N + n0 + j);
    float* d = lds + i * 65 + j; d[0] = v.x; d[1] = v.y; d[2] = v.z; d[3] = v.w;
  }
  __syncthreads();
  const int j = tid >> 2, kq = tid & 3, n = n0 + j;
  if (active && n < N) {
    unsigned w[8];
#pragma unroll
    for (int q = 0; q < 8; ++q) w[q] = pk2(lds[(kq * 16 + 2 * q) * 65 + j], lds[(kq * 16 + 2 * q + 1) * 65 + j]);
    bf16_t* o = dst + (size_t)((n >> 4) * rs + (n & 15) + ro) * ldd + k0 + kq * 16;
    *(uint4*)o = make_uint4(w[0], w[1], w[2], w[3]);
    *(uint4*)(o + 8) = make_uint4(w[4], w[5], w[6], w[7]);
  }
  __syncthreads();
}
__device__ __forceinline__ void tr_cvt(const float* src, int N, int K, bf16_t* dst, int ldd, int rs, int ro, char* ldsc) {
  const int nt = ((N + 63) >> 6) * (K >> 6), hb = HBLK;
  float* lds = (float*)(ldsc + hb * 65536);
  for (int t0 = blockIdx.x * 2; t0 < nt; t0 += gridDim.x * 2) tr_cvt_tile(src, N, K, dst, ldd, rs, ro, t0 + hb, t0 + hb < nt, lds);
}

__device__ __forceinline__ void resnorm_phase(const float* hin, float* hout, const float* f, float scale, const float* gpost, const float* gpre, bf16_t* a) {
  const int tid = TIDX, lane = tid & 63;
  for (int row = blockIdx.x * 8 + (tid >> 6); row < M_TOK; row += gridDim.x * 8) {
    float4 hv[4];
#pragma unroll
    for (int i = 0; i < 4; ++i) hv[i] = *(const float4*)(hin + (size_t)row * 1024 + i * 256 + lane * 4);
    if (f) {
      float4 fv[4]; float ss = 0.f;
#pragma unroll
      for (int i = 0; i < 4; ++i) { fv[i] = *(const float4*)(f + (size_t)row * 1024 + i * 256 + lane * 4); ss += fv[i].x * fv[i].x + fv[i].y * fv[i].y + fv[i].z * fv[i].z + fv[i].w * fv[i].w; }
      ss = wave_sum(ss);
      const float r = rsqrtf(ss * (1.f / 1024.f) + 1e-6f) * scale;
#pragma unroll
      for (int i = 0; i < 4; ++i) { const float4 g = *(const float4*)(gpost + i * 256 + lane * 4);
        hv[i].x += fv[i].x * r * g.x; hv[i].y += fv[i].y * r * g.y; hv[i].z += fv[i].z * r * g.z; hv[i].w += fv[i].w * r * g.w; }
    }
#pragma unroll
    for (int i = 0; i < 4; ++i) *(float4*)(hout + (size_t)row * 1024 + i * 256 + lane * 4) = hv[i];
    if (a) {
      float ss = 0.f;
#pragma unroll
      for (int i = 0; i < 4; ++i) ss += hv[i].x * hv[i].x + hv[i].y * hv[i].y + hv[i].z * hv[i].z + hv[i].w * hv[i].w;
      ss = wave_sum(ss);
      const float r = rsqrtf(ss * (1.f / 1024.f) + 1e-6f);
#pragma unroll
      for (int i = 0; i < 4; ++i) { const float4 g = *(const float4*)(gpre + i * 256 + lane * 4);
        uint2 o; o.x = pk2(hv[i].x * r * g.x, hv[i].y * r * g.y); o.y = pk2(hv[i].z * r * g.z, hv[i].w * r * g.w);
        *(uint2*)(a + (size_t)row * 1024 + i * 256 + lane * 4) = o; }
    }
  }
}

__device__ __forceinline__ void prep_phase(const Params& P, char* ldsc) {
  char* ws = P.ws;
  for (int l = 0; l < 2; ++l) {
    for (int j = 0; j < 2; ++j) {
      const int lj = l * 2 + j;
      bf16_t* wgu = (bf16_t*)(ws + OFF_WGU + lj * SZ_WGU);
      tr_cvt(P.ffn_wg + (size_t)lj * 1024 * DFF, DFF, 1024, wgu, 1024, 32, 0, ldsc);
      tr_cvt(P.ffn_wu + (size_t)lj * 1024 * DFF, DFF, 1024, wgu, 1024, 32, 16, ldsc);
      tr_cvt(P.ffn_wd + (size_t)lj * DFF * 1024, 1024, DFF, (bf16_t*)(ws + OFF_WD + lj * SZ_WD), DFF, 16, 0, ldsc);
      tr_cvt(P.cmp_w1 + (size_t)lj * 2048 * 128, 128, 2048, (bf16_t*)(ws + OFF_CW1 + lj * SZ_CW1), 2048, 16, 0, ldsc);
    }
    tr_cvt(P.w_in + (size_t)l * 1024 * NIN, NIN, 1024, (bf16_t*)(ws + OFF_WIN + l * SZ_WIN), 1024, 16, 0, ldsc);
    tr_cvt(P.w_out + (size_t)l * 1024 * 1024, 1024, 1024, (bf16_t*)(ws + OFF_WOUT + l * SZ_SQ), 1024, 16, 0, ldsc);
    tr_cvt(P.ple_wg + (size_t)l * 1024 * 1024, 1024, 1024, (bf16_t*)(ws + OFF_WPG + l * SZ_SQ), 1024, 16, 0, ldsc);
    tr_cvt(P.ple_wp + (size_t)l * 256 * 1024, 1024, 256, (bf16_t*)(ws + OFF_WPP + l * SZ_WPP), 256, 16, 0, ldsc);
    for (int g = 0; g < 4; ++g) {
      tr_cvt(P.lru_wa + (size_t)(l * 4 + g) * 4096, 64, 64, (bf16_t*)(ws + OFF_WAT) + (l * 4 + g) * 4096, 64, 16, 0, ldsc);
      tr_cvt(P.lru_wx + (size_t)(l * 4 + g) * 4096, 64, 64, (bf16_t*)(ws + OFF_WXT) + (l * 4 + g) * 4096, 64, 16, 0, ldsc);
    }
  }
  const int tid = TIDX, gtid = blockIdx.x * 512 + tid, gn = gridDim.x * 512;
  for (int i = gtid; i < 2 * (LDZ - NIN) * 1024 / 8; i += gn) {
    const int l = i / ((LDZ - NIN) * 128), r = i - l * ((LDZ - NIN) * 128);
    *(uint4*)((bf16_t*)(ws + OFF_WIN + l * SZ_WIN) + (size_t)NIN * 1024 + (size_t)r * 8) = make_uint4(0, 0, 0, 0);
  }
  for (int i = gtid; i < 2 * 4 * 128 * 128; i += gn) { const int t = (i >> 7) & 127, s2 = i & 127; ((bf16_t*)(ws + OFF_SGUW))[i] = (s2 <= t) ? f2bf(P.sgu_w[i]) : (bf16_t)0; }
  for (int i = gtid; i < 2 * M_TOK * 256 / 4; i += gn) { const float4 v = ((const float4*)P.p)[i]; uint2 o; o.x = pk2(v.x, v.y); o.y = pk2(v.z, v.w); ((uint2*)(ws + OFF_PBF))[i] = o; }
  {
    float* lds = (float*)(ldsc + HBLK * 65536);
    for (int u = blockIdx.x; u < 4; u += gridDim.x) {
      const int t2 = HTID, kq = t2 >> 5, jq = t2 & 31;
      const float* w1 = P.cmp_w1 + (size_t)u * 2048 * 128; const float* pos = P.cmp_pos + (size_t)u * 2048;
      float4 sacc = make_float4(0.f, 0.f, 0.f, 0.f);
      for (int k = kq * 256; k < kq * 256 + 256; ++k) { const float pv = pos[k]; const float4 w = *(const float4*)(w1 + (size_t)k * 128 + jq * 4); sacc.x += pv * w.x; sacc.y += pv * w.y; sacc.z += pv * w.z; sacc.w += pv * w.w; }
      __syncthreads();
      lds[kq * 128 + jq * 4 + 0] = sacc.x; lds[kq * 128 + jq * 4 + 1] = sacc.y; lds[kq * 128 + jq * 4 + 2] = sacc.z; lds[kq * 128 + jq * 4 + 3] = sacc.w;
      __syncthreads();
      if (t2 < 128) { float t = P.cmp_b1[u * 128 + t2]; for (int q = 0; q < 8; ++q) t += lds[q * 128 + t2]; ((float*)(ws + OFF_CB1))[u * 128 + t2] = t; }
      __syncthreads();
    }
  }
  resnorm_phase(P.x, P.out, nullptr, 0.f, nullptr, P.norm_g, (bf16_t*)(ws + OFF_A));
}

constexpr int G8_HT = 128 * 64;
__device__ __forceinline__ int g8_lds_byte(int r, int c) { const int st = (r >> 4) * 2 + (c >> 5), rr = r & 15, cc = c & 31, ob = rr * 64 + cc * 2; return st * 1024 + (ob ^ (((ob >> 9) & 1) << 5)); }
__device__ __forceinline__ void g8_stage_rc(int b, int& R, int& C) { const int st = b / 1024, sb = b % 1024, swz = sb ^ (((sb >> 9) & 1) << 5); R = (st >> 1) * 16 + swz / 64; C = (st & 1) * 32 + (swz % 64) / 2; }

__device__ __forceinline__ void gemm_core(f32x4 (&acc)[2][2][4][2], const bf16_t* __restrict__ A, int lda, const bf16_t* __restrict__ Bt, int ldb, int K, char* ldsc) {
  bf16_t* shm = (bf16_t*)ldsc;
  const int tid = TIDX, wid = tid >> 6, lane = tid & 63, wr = wid >> 2, wc = wid & 3, fr = lane & 15, fq = lane >> 4;
  int sr0, sc0;
  g8_stage_rc(tid * 16, sr0, sc0);
  const bf16_t* gA0 = A + (size_t)sr0 * lda + sc0;
  const bf16_t* gB0 = Bt + (size_t)sr0 * ldb + sc0;
  const size_t a64 = (size_t)64 * lda, b64 = (size_t)64 * ldb;
  const int lane_off = (fr * 64 + fq * 16) ^ ((((fr * 64 + fq * 16) >> 9) & 1) << 5);
  const char* ldA = ldsc + wr * 8192 + lane_off;
  const char* ldB = ldsc + 65536 + wc * 4096 + lane_off;
#define SA(b, h) (shm + ((b) * 2 + (h)) * G8_HT)
#define SB(b, h) (shm + (4 + (b) * 2 + (h)) * G8_HT)
#define STAGE_A(P, h, kt) { const bf16_t* g_ = gA0 + (size_t)(h) * 2 * a64 + (kt) * 64; glds16(g_, (char*)(P) + tid * 16); glds16(g_ + a64, (char*)(P) + tid * 16 + 8192); }
#define STAGE_B(P, h, kt) { const bf16_t* g_ = gB0 + (size_t)(h) * 2 * b64 + (kt) * 64; glds16(g_, (char*)(P) + tid * 16); glds16(g_ + b64, (char*)(P) + tid * 16 + 8192); }
#define LDA(dst, b, h) _Pragma("unroll") for (int m = 0; m < 4; ++m) _Pragma("unroll") for (int k = 0; k < 2; ++k) \
    dst[m][k] = *reinterpret_cast<const bf16x8*>(ldA + ((b) * 2 + (h)) * 16384 + (m * 2 + k) * 1024)
#define LDB(dst, b, h) _Pragma("unroll") for (int n = 0; n < 2; ++n) _Pragma("unroll") for (int k = 0; k < 2; ++k) \
    dst[n][k] = *reinterpret_cast<const bf16x8*>(ldB + ((b) * 2 + (h)) * 16384 + (n * 2 + k) * 1024)
#define MMA(ai, bj, At_, Bt_) do { __builtin_amdgcn_s_setprio(1); \
    _Pragma("unroll") for (int m = 0; m < 4; ++m) _Pragma("unroll") for (int n = 0; n < 2; ++n) _Pragma("unroll") for (int k = 0; k < 2; ++k) \
      acc[ai][bj][m][n] = mfma16(Bt_[n][k], At_[m][k], acc[ai][bj][m][n]); \
    __builtin_amdgcn_s_setprio(0); } while (0)
#define WAIT_V(n) asm volatile("s_waitcnt vmcnt(" #n ")" ::: "memory")
#define WAIT_L(n) asm volatile("s_waitcnt lgkmcnt(" #n ")" ::: "memory")
#define BAR __builtin_amdgcn_s_barrier()
#define SCHED __builtin_amdgcn_sched_barrier(0)
  bf16x8 At[4][2], B0[2][2], B1[2][2];
  const int nt = K >> 6;
  STAGE_B(SB(0, 0), 0, 0); STAGE_A(SA(0, 0), 0, 0);
  STAGE_B(SB(0, 1), 1, 0); STAGE_A(SA(0, 1), 1, 0);
  if (wr == 1) BAR;
  WAIT_V(4); BAR;
  STAGE_B(SB(1, 0), 0, 1); STAGE_A(SA(1, 0), 0, 1); STAGE_B(SB(1, 1), 1, 1);
  WAIT_V(6); BAR;
#pragma nounroll
  for (int t = 0; t < nt - 2; t += 2) {
    LDB(B0, 0, 0); SCHED; LDA(At, 0, 0); STAGE_A(SA(1, 1), 1, t + 1);
    WAIT_L(8); BAR; WAIT_L(0); MMA(0, 0, At, B0); BAR; SCHED;
    LDB(B1, 0, 1); STAGE_B(SB(0, 0), 0, t + 2);
    BAR; WAIT_L(0); MMA(0, 1, At, B1); BAR;
    LDA(At, 0, 1); STAGE_A(SA(0, 0), 0, t + 2);
    BAR; WAIT_L(0); MMA(1, 0, At, B0); BAR; SCHED;
    STAGE_B(SB(0, 1), 1, t + 2);
    WAIT_V(6); BAR; MMA(1, 1, At, B1); BAR;
    LDB(B0, 1, 0); SCHED; LDA(At, 1, 0); STAGE_A(SA(0, 1), 1, t + 2);
    WAIT_L(8); BAR; WAIT_L(0); MMA(0, 0, At, B0); BAR; SCHED;
    LDB(B1, 1, 1); STAGE_B(SB(1, 0), 0, t + 3);
    BAR; WAIT_L(0); MMA(0, 1, At, B1); BAR;
    LDA(At, 1, 1); STAGE_A(SA(1, 0), 0, t + 3);
    BAR; WAIT_L(0); MMA(1, 0, At, B0); BAR; SCHED;
    STAGE_B(SB(1, 1), 1, t + 3);
    WAIT_V(6); BAR; MMA(1, 1, At, B1); BAR;
  }
  { LDB(B0, 0, 0); LDA(At, 0, 0); STAGE_A(SA(1, 1), 1, nt - 1);
    BAR; WAIT_L(0); MMA(0, 0, At, B0); BAR;
    LDB(B1, 0, 1); BAR; WAIT_L(0); MMA(0, 1, At, B1); BAR;
    LDA(At, 0, 1); WAIT_V(4); BAR; WAIT_L(0); MMA(1, 0, At, B0); MMA(1, 1, At, B1); BAR; }
  { LDB(B0, 1, 0); LDA(At, 1, 0); WAIT_V(2); BAR; WAIT_L(0); MMA(0, 0, At, B0); BAR;
    LDB(B1, 1, 1); WAIT_V(0); BAR; WAIT_L(0); MMA(0, 1, At, B1); BAR;
    LDA(At, 1, 1); BAR; WAIT_L(0); MMA(1, 0, At, B0); MMA(1, 1, At, B1); BAR; }
  if (wr == 0) BAR;
  BAR;
#undef SA
#undef SB
#undef STAGE_A
#undef STAGE_B
#undef LDA
#undef LDB
#undef MMA
#undef WAIT_V
#undef WAIT_L
#undef BAR
#undef SCHED
}

template <class F> __device__ __forceinline__ void gemm_sched(int TN, F&& f) {
  const int npc = (TN + 1) >> 1, npatch = 8 * npc, xcd = blockIdx.x & 7, slot = blockIdx.x >> 3, nslot = gridDim.x >> 3;
  for (int pid = xcd; pid < npatch; pid += 8) {
    const int pr = pid / npc, pc = pid - pr * npc;
    for (int s = slot; s < 32; s += nslot) {
      const int tm = pr * 16 + (s & 15), tn = pc * 2 + (s >> 4);
      if (tn < TN) f(tm, tn);
    }
  }
}

#define GEMM_LANE const int tid_ = TIDX, lane_ = tid_ & 63, wid_ = tid_ >> 6, wr = wid_ >> 2, wc = wid_ & 3, fr = lane_ & 15, fq = lane_ >> 4
#define GEMM_EPI_LOOP _Pragma("unroll") for (int ai = 0; ai < 2; ++ai) _Pragma("unroll") for (int m = 0; m < 4; ++m) _Pragma("unroll") for (int bj = 0; bj < 2; ++bj)

__device__ __forceinline__ void gemm_up_phase(const bf16_t* a, const bf16_t* wgu, bf16_t* act, char* lds) {
  gemm_sched(NGU / 256, [&](int tm, int tn) {
    f32x4 acc[2][2][4][2];
    _Pragma("unroll") for (int i0 = 0; i0 < 2; ++i0) _Pragma("unroll") for (int i1 = 0; i1 < 2; ++i1) _Pragma("unroll") for (int i2 = 0; i2 < 4; ++i2) _Pragma("unroll") for (int i3 = 0; i3 < 2; ++i3) acc[i0][i1][i2][i3] = zero4();
    gemm_core(acc, a + (size_t)tm * 256 * 1024, 1024, wgu + (size_t)tn * 256 * 1024, 1024, 1024, lds);
    GEMM_LANE;
    GEMM_EPI_LOOP {
      const int row = tm * 256 + ai * 128 + wr * 64 + m * 16 + fr;
      const int col = tn * 128 + bj * 64 + wc * 16 + 4 * fq;
      const f32x4 g = acc[ai][bj][m][0], u = acc[ai][bj][m][1];
      uint2 o; o.x = pk2(silu_f(g[0]) * u[0], silu_f(g[1]) * u[1]); o.y = pk2(silu_f(g[2]) * u[2], silu_f(g[3]) * u[3]);
      *(uint2*)(act + (size_t)row * DFF + col) = o;
    }
  });
}

__device__ __forceinline__ void gemm_f32_phase(const bf16_t* A, int lda, const bf16_t* Bt, int K, float* out, char* lds) {
  gemm_sched(4, [&](int tm, int tn) {
    f32x4 acc[2][2][4][2];
    _Pragma("unroll") for (int i0 = 0; i0 < 2; ++i0) _Pragma("unroll") for (int i1 = 0; i1 < 2; ++i1) _Pragma("unroll") for (int i2 = 0; i2 < 4; ++i2) _Pragma("unroll") for (int i3 = 0; i3 < 2; ++i3) acc[i0][i1][i2][i3] = zero4();
    gemm_core(acc, A + (size_t)tm * 256 * lda, lda, Bt + (size_t)tn * 256 * K, K, K, lds);
    GEMM_LANE;
    GEMM_EPI_LOOP {
      const int row = tm * 256 + ai * 128 + wr * 64 + m * 16 + fr;
#pragma unroll
      for (int n = 0; n < 2; ++n) *(f32x4*)(out + (size_t)row * 1024 + tn * 256 + bj * 128 + wc * 32 + n * 16 + 4 * fq) = acc[ai][bj][m][n];
    }
  });
}

__device__ __forceinline__ void gemm_bf16_phase(const bf16_t* A, int lda, const bf16_t* Bt, int K, int TN, bf16_t* out, int ldo, char* lds) {
  gemm_sched(TN, [&](int tm, int tn) {
    f32x4 acc[2][2][4][2];
    _Pragma("unroll") for (int i0 = 0; i0 < 2; ++i0) _Pragma("unroll") for (int i1 = 0; i1 < 2; ++i1) _Pragma("unroll") for (int i2 = 0; i2 < 4; ++i2) _Pragma("unroll") for (int i3 = 0; i3 < 2; ++i3) acc[i0][i1][i2][i3] = zero4();
    gemm_core(acc, A + (size_t)tm * 256 * lda, lda, Bt + (size_t)tn * 256 * K, K, K, lds);
    GEMM_LANE;
    GEMM_EPI_LOOP {
      const int row = tm * 256 + ai * 128 + wr * 64 + m * 16 + fr;
#pragma unroll
      for (int n = 0; n < 2; ++n) {
        uint2 o; o.x = pk2(acc[ai][bj][m][n][0], acc[ai][bj][m][n][1]); o.y = pk2(acc[ai][bj][m][n][2], acc[ai][bj][m][n][3]);
        *(uint2*)(out + (size_t)row * ldo + tn * 256 + bj * 128 + wc * 32 + n * 16 + 4 * fq) = o;
      }
    }
  });
}

__device__ __forceinline__ void gemm_ple_phase(const bf16_t* a, const bf16_t* wpg, const bf16_t* pp, float* out, char* lds) {
  gemm_sched(4, [&](int tm, int tn) {
    f32x4 acc[2][2][4][2];
    _Pragma("unroll") for (int i0 = 0; i0 < 2; ++i0) _Pragma("unroll") for (int i1 = 0; i1 < 2; ++i1) _Pragma("unroll") for (int i2 = 0; i2 < 4; ++i2) _Pragma("unroll") for (int i3 = 0; i3 < 2; ++i3) acc[i0][i1][i2][i3] = zero4();
    gemm_core(acc, a + (size_t)tm * 256 * 1024, 1024, wpg + (size_t)tn * 256 * 1024, 1024, 1024, lds);
    GEMM_LANE;
    GEMM_EPI_LOOP {
      const int row = tm * 256 + ai * 128 + wr * 64 + m * 16 + fr;
#pragma unroll
      for (int n = 0; n < 2; ++n) {
        const int col = tn * 256 + bj * 128 + wc * 32 + n * 16 + 4 * fq;
        const u32x2 pv = *(const u32x2*)(pp + (size_t)row * 1024 + col);
        const f32x4 av = acc[ai][bj][m][n];
        f32x4 o;
        o[0] = sigm(av[0]) * __uint_as_float(pv.x << 16); o[1] = sigm(av[1]) * __uint_as_float(pv.x & 0xffff0000u);
        o[2] = sigm(av[2]) * __uint_as_float(pv.y << 16); o[3] = sigm(av[3]) * __uint_as_float(pv.y & 0xffff0000u);
        *(f32x4*)(out + (size_t)row * 1024 + col) = o;
      }
    }
  });
}

__device__ __forceinline__ void mixA_item(const Params& P, int layer, int idx, const bf16_t* z, bf16_t* y, char* lds) {
  const int g = idx & 3, bc = idx >> 2, tok0 = bc * 128;
  const int tid = HTID, lane = tid & 63, w = tid >> 6, fr = lane & 15, fq = lane >> 4;
  bf16_t* vT = (bf16_t*)lds;
  const float* ng = P.sgu_ng + layer * 256;
  {
    const int s = tid >> 1, half = tid & 1;
    const bf16_t* zr = z + (size_t)(tok0 + s) * LDZ + ZC_AV;
    float ss = 0.f;
#pragma unroll 4
    for (int i = 0; i < 16; ++i) { float v[8]; unpack8(*(const u32x4*)(zr + half * 128 + i * 8), v);
#pragma unroll
      for (int e = 0; e < 8; ++e) { const float t = gelu_t(v[e]); ss += t * t; } }
    ss += __shfl_xor(ss, 1);
    const float rs = rsqrtf(ss * (1.f / 256.f) + 1e-6f);
#pragma unroll
    for (int i = 0; i < 4; ++i) { float v[8]; unpack8(*(const u32x4*)(zr + g * 64 + half * 32 + i * 8), v);
#pragma unroll
      for (int e = 0; e < 8; ++e) { const int d = half * 32 + i * 8 + e; vT[d * 136 + s] = f2bf(gelu_t(v[e]) * rs * ng[g * 64 + d]); } }
  }
  __syncthreads();
  const bf16_t* W = (const bf16_t*)(P.ws + OFF_SGUW) + (size_t)((layer * 4 + g) * 128) * 128;
  f32x4 acc[2][4] = {};
  for (int ks = 0; ks <= w; ++ks) {
    bf16x8 wf[2], vf[4];
#pragma unroll
    for (int tm = 0; tm < 2; ++tm) wf[tm] = *(const bf16x8*)(W + (size_t)(32 * w + tm * 16 + fr) * 128 + ks * 32 + 8 * fq);
#pragma unroll
    for (int dn = 0; dn < 4; ++dn) vf[dn] = *(const bf16x8*)(vT + (dn * 16 + fr) * 136 + ks * 32 + 8 * fq);
#pragma unroll
    for (int tm = 0; tm < 2; ++tm)
#pragma unroll
      for (int dn = 0; dn < 4; ++dn) acc[tm][dn] = mfma16(vf[dn], wf[tm], acc[tm][dn]);
  }
#pragma unroll
  for (int tm = 0; tm < 2; ++tm) {
    const int t = 32 * w + tm * 16 + fr;
    const float bias = P.sgu_b[(layer * 4 + g) * 128 + t];
#pragma unroll
    for (int dn = 0; dn < 4; ++dn) {
      const int d = dn * 16 + 4 * fq;
      const uint2 uu = *(const uint2*)(z + (size_t)(tok0 + t) * LDZ + ZC_AU + g * 64 + d);
      const float u0 = gelu_t(__uint_as_float(uu.x << 16)), u1 = gelu_t(__uint_as_float(uu.x & 0xffff0000u)),
                  u2 = gelu_t(__uint_as_float(uu.y << 16)), u3 = gelu_t(__uint_as_float(uu.y & 0xffff0000u));
      uint2 o; o.x = pk2(u0 * (acc[tm][dn][0] + bias), u1 * (acc[tm][dn][1] + bias)); o.y = pk2(u2 * (acc[tm][dn][2] + bias), u3 * (acc[tm][dn][3] + bias));
      *(uint2*)(y + (size_t)(tok0 + t) * 1024 + g * 64 + d) = o;
    }
  }
  __syncthreads();
}

__device__ __forceinline__ void mixB1_item(const Params& P, int layer, int idx, const bf16_t* z, float* hsl, float* Pc, float* carryP, float* carryH, char* lds) {
  const int c = idx & 63, g = (idx >> 6) & 3, b = idx >> 8;
  const int tid = HTID, lane = tid & 63, w = tid >> 6, fr = lane & 15, fq = lane >> 4;
  bf16_t* xcb = (bf16_t*)lds;
  float* xcf = (float*)(lds + 9216);
  float* aA = (float*)(lds + 9216 + 16384);
  float* bB = (float*)(lds + 9216 + 32768);
  float* sm = (float*)(lds + 9216 + 49152);
  const size_t tokb = (size_t)b * SEQ;
  {
    const int t = tid >> 2, q = tid & 3;
    float accv[16];
#pragma unroll
    for (int i = 0; i < 16; ++i) accv[i] = P.conv_b[layer * 256 + g * 64 + q * 16 + i];
#pragma unroll
    for (int k = 0; k < 4; ++k) {
      const int pos = c * 64 + t - 3 + k;
      if (pos >= 0) {
        const bf16_t* zr = z + (tokb + pos) * LDZ + ZC_BX + g * 64 + q * 16;
        float v[16]; unpack8(*(const u32x4*)zr, v); unpack8(*(const u32x4*)(zr + 8), v + 8);
        const float* cw = P.conv_w + (size_t)(layer * 4 + k) * 256 + g * 64 + q * 16;
#pragma unroll
        for (int i = 0; i < 16; ++i) accv[i] += v[i] * cw[i];
      }
    }
#pragma unroll
    for (int i = 0; i < 16; ++i) { xcf[t * 64 + q * 16 + i] = accv[i]; xcb[t * 72 + q * 16 + i] = f2bf(accv[i]); }
  }
  __syncthreads();
  {
    const bf16_t* wa = (const bf16_t*)(P.ws + OFF_WAT) + (layer * 4 + g) * 4096;
    const bf16_t* wx = (const bf16_t*)(P.ws + OFF_WXT) + (layer * 4 + g) * 4096;
    f32x4 ar[4] = {}, ai[4] = {};
#pragma unroll
    for (int ks = 0; ks < 2; ++ks) {
      const bf16x8 xf = *(const bf16x8*)(xcb + (16 * w + fr) * 72 + ks * 32 + 8 * fq);
#pragma unroll
      for (int jn = 0; jn < 4; ++jn) {
        const bf16x8 fa = *(const bf16x8*)(wa + (jn * 16 + fr) * 64 + ks * 32 + 8 * fq);
        const bf16x8 fx = *(const bf16x8*)(wx + (jn * 16 + fr) * 64 + ks * 32 + 8 * fq);
        ar[jn] = mfma16(fa, xf, ar[jn]); ai[jn] = mfma16(fx, xf, ai[jn]);
      }
    }
    const int t = 16 * w + fr;
#pragma unroll
    for (int jn = 0; jn < 4; ++jn)
#pragma unroll
      for (int e = 0; e < 4; ++e) {
        const int j = jn * 16 + 4 * fq + e, ch = layer * 256 + g * 64 + j;
        const float r = sigm(ar[jn][e] + P.lru_ba[ch]), ig = sigm(ai[jn][e] + P.lru_bx[ch]);
        const float lam = P.lru_lam[ch];
        const float xe = __expf(-lam);
        float m8; asm volatile("v_mov_b32 %0, 0xc1000000" : "=v"(m8));
        const float la = m8 * r * (xe * (1.f - xe * (0.5f - xe * (1.f / 3.f))));
        const float av = __expf(la);
        const float y2 = 2.f * la;
        const float om = -y2 * (1.f + y2 * (0.5f + y2 * ((1.f / 6.f) + y2 * ((1.f / 24.f) + y2 * ((1.f / 120.f) + y2 * (1.f / 720.f))))));
        const float bv = sqrtf(om) * (ig * xcf[t * 64 + j]);
        aA[t * 64 + j] = av; bB[t * 64 + j] = bv;
      }
  }
  __syncthreads();
  {
    const int q = tid >> 6, j = tid & 63;
    float Pq = 1.f, hq = 0.f;
#pragma unroll
    for (int i = 0; i < 16; ++i) { const int t = q * 16 + i; const float av = aA[t * 64 + j], bv = bB[t * 64 + j]; hq = av * hq + bv; Pq *= av; aA[t * 64 + j] = Pq; bB[t * 64 + j] = hq; }
    sm[q * 64 + j] = Pq; sm[256 + q * 64 + j] = hq;
    __syncthreads();
    float Pin = 1.f, Hin = 0.f;
    for (int qq = 0; qq < q; ++qq) { const float pp = sm[qq * 64 + j], hh = sm[256 + qq * 64 + j]; Hin = pp * Hin + hh; Pin *= pp; }
    float hl = 0.f, pl = 1.f;
#pragma unroll
    for (int i = 0; i < 16; ++i) { const int t = q * 16 + i; hl = bB[t * 64 + j] + aA[t * 64 + j] * Hin; pl = aA[t * 64 + j] * Pin;
      const size_t o = (tokb + c * 64 + t) * 256 + g * 64 + j; hsl[o] = hl; Pc[o] = pl; }
    if (q == 3) { const int o = ((b * 4 + g) * 64 + c) * 64 + j; carryP[o] = pl; carryH[o] = hl; }
  }
  __syncthreads();
}

__device__ __forceinline__ void mixB2_item(int idx, const bf16_t* z, const float* hsl, const float* Pc, const float* carryP, const float* carryH, bf16_t* y) {
  const int c = idx & 63, g = (idx >> 6) & 3, b = idx >> 8;
  const int q = HTID >> 6, j = HTID & 63;
  const float* cp = carryP + (size_t)((b * 4 + g) * 64) * 64 + j;
  const float* chh = carryH + (size_t)((b * 4 + g) * 64) * 64 + j;
  float H = 0.f;
  for (int c0 = 0; c0 < c; c0 += 8) {
    float pv[8], hv[8];
#pragma unroll
    for (int i = 0; i < 8; ++i) { const bool ok = c0 + i < c; pv[i] = ok ? cp[(c0 + i) * 64] : 1.f; hv[i] = ok ? chh[(c0 + i) * 64] : 0.f; }
#pragma unroll
    for (int i = 0; i < 8; ++i) H = pv[i] * H + hv[i];
  }
  const size_t tokb = (size_t)b * SEQ + c * 64 + q * 16;
#pragma unroll 4
  for (int i = 0; i < 16; ++i) {
    const size_t o = (tokb + i) * 256 + g * 64 + j;
    const float h = hsl[o] + Pc[o] * H;
    const float gt = bf2f(z[(tokb + i) * LDZ + ZC_BG + g * 64 + j]);
    y[(tokb + i) * 1024 + 256 + g * 64 + j] = f2bf(h * gelu_t(gt));
  }
}

__device__ __forceinline__ void compress_item(const Params& P, int layer, int idx, const bf16_t* z, bf16_t* kcv, char* lds) {
  const int nb = idx & 7, g = (idx >> 3) & 1, b = (idx >> 4) & 7, kv = idx >> 7;
  const int tid = HTID, lane = tid & 63, w = tid >> 6, fr = lane & 15, fq = lane >> 4;
  const int n0 = nb * 32, col = (kv ? ZC_VC : ZC_KC) + g * 64;
  const bf16_t* w1t = (const bf16_t*)(P.ws + OFF_CW1 + (size_t)(layer * 2 + kv) * SZ_CW1);
  float* hid = (float*)lds;
  f32x4 acc[2][2] = {};
  const bf16_t* zb[2]; const bf16_t* wb[2];
#pragma unroll
  for (int nf = 0; nf < 2; ++nf) { int n = n0 + nf * 16 + fr; if (n > 254) n = 254; zb[nf] = z + ((size_t)b * SEQ + 16 * n) * LDZ + col + 8 * fq; }
#pragma unroll
  for (int jf = 0; jf < 2; ++jf) wb[jf] = w1t + (size_t)(32 * w + jf * 16 + fr) * 2048 + 8 * fq;
#pragma unroll 4
  for (int ks = 0; ks < 64; ++ks) {
    const int l = ks >> 1, d0 = (ks & 1) * 32;
    bf16x8 xf[2], wf[2];
#pragma unroll
    for (int nf = 0; nf < 2; ++nf) xf[nf] = *(const bf16x8*)(zb[nf] + (size_t)l * LDZ + d0);
#pragma unroll
    for (int jf = 0; jf < 2; ++jf) wf[jf] = *(const bf16x8*)(wb[jf] + ks * 32);
#pragma unroll
    for (int jf = 0; jf < 2; ++jf)
#pragma unroll
      for (int nf = 0; nf < 2; ++nf) acc[jf][nf] = mfma16(wf[jf], xf[nf], acc[jf][nf]);
  }
  const float* cb1 = (const float*)(P.ws + OFF_CB1) + (layer * 2 + kv) * 128;
#pragma unroll
  for (int jf = 0; jf < 2; ++jf)
#pragma unroll
    for (int nf = 0; nf < 2; ++nf)
#pragma unroll
      for (int e = 0; e < 4; ++e) { const int j = 32 * w + jf * 16 + 4 * fq + e; hid[(nf * 16 + fr) * 129 + j] = gelu_t(acc[jf][nf][e] + cb1[j]); }
  __syncthreads();
  {
    const int n = tid >> 3, d0 = (tid & 7) * 8;
    const float* w2 = P.cmp_w2 + (size_t)(layer * 2 + kv) * 128 * 64 + d0;
    const float* b2 = P.cmp_b2 + (layer * 2 + kv) * 64 + d0;
    float o[8];
#pragma unroll
    for (int e = 0; e < 8; ++e) o[e] = b2[e];
    for (int j = 0; j < 128; ++j) {
      const float hv = hid[n * 129 + j]; const float4 wa = *(const float4*)(w2 + j * 64), wb2 = *(const float4*)(w2 + j * 64 + 4);
      o[0] += hv * wa.x; o[1] += hv * wa.y; o[2] += hv * wa.z; o[3] += hv * wa.w; o[4] += hv * wb2.x; o[5] += hv * wb2.y; o[6] += hv * wb2.z; o[7] += hv * wb2.w;
    }
    const bool valid = (n0 + n) < 255;
    uint4 ov = valid ? make_uint4(pk2(o[0], o[1]), pk2(o[2], o[3]), pk2(o[4], o[5]), pk2(o[6], o[7])) : make_uint4(0, 0, 0, 0);
    *(uint4*)(kcv + ((size_t)((kv * 8 + b) * 2 + g) * 256 + n0 + n) * 64 + d0) = ov;
  }
  __syncthreads();
}

constexpr int NSA_KT = 0, NSA_VT = 16384, NSA_T = 33792, NSA_TW = NSA_T + 4 * 4160 * 4, NSA_IMP = NSA_TW + 4 * 640 * 4, NSA_WU = NSA_IMP + 2 * 16640;
constexpr int LDS_ST = 147456;
constexpr float LOG2E = 1.4426950408889634f;

__device__ __forceinline__ void nsa_tables(const Params& P, int g, char* lds) {
  float* T = (float*)(lds + NSA_T);
  float* TW = (float*)(lds + NSA_TW);
  const int tid = TIDX;
  for (int i = tid; i < 4160; i += 512) {
    const int n = i - 64;
    int bk = n;
    if (n >= 16) bk = 16 + (n >= 21) + (n >= 27) + (n >= 35) + (n >= 46) + (n >= 59) + (n >= 77) + (n >= 99) + (n >= 128) + (n >= 166) + (n >= 216) + (n >= 280) + (n >= 363) + (n >= 470) + (n >= 609) + (n >= 790);
#pragma unroll
    for (int r = 0; r < 4; ++r) {
      const float v = n >= 0 ? P.rel_bias[bk * 8 + g * 4 + r] * LOG2E : -__builtin_inff();
      T[r * 4160 + i] = v;
      if (i < 640) TW[r * 640 + i] = (n < 512) ? v : -__builtin_inff();
    }
  }
  __syncthreads();
}

struct KVRegs { u32x4 k0, v0; };
__device__ __forceinline__ void kv_gload(KVRegs& r, const bf16_t* kb, const bf16_t* vb, size_t stride) {
  const int tid = TIDX, row = tid >> 3, cq = tid & 7;
  r.k0 = *(const u32x4*)(kb + row * stride + cq * 8); r.v0 = *(const u32x4*)(vb + row * stride + cq * 8);
}
__device__ __forceinline__ void kv_lwrite(const KVRegs& r, char* lds, int buf) {
  const int tid = TIDX, row = tid >> 3, cq = tid & 7;
  char* kt = lds + NSA_KT + buf * 8192 + row * 128;
  *(u32x4*)(kt + ((cq ^ (row & 7)) << 4)) = r.k0;
  bf16_t* vt = (bf16_t*)(lds + NSA_VT + buf * 8704) + (cq * 8) * 68 + row;
#pragma unroll
  for (int i = 0; i < 4; ++i) { vt[(2 * i) * 68] = (bf16_t)(r.v0[i] & 0xffffu); vt[(2 * i + 1) * 68] = (bf16_t)(r.v0[i] >> 16); }
}

template <int MODE>
__device__ __forceinline__ void nsa_compute(int cur, int buf, int t, int hl, u64 mymask, const bf16x8 (&Qf)[2][2], f32x4 (&O)[4][2], float (&m)[2], float (&l)[2],
                                            const float (&inv)[2], float* impw, char* lds) {
  const int lane = TIDX & 63, fr = lane & 15, fq = lane >> 4;
  const char* kt = lds + NSA_KT + buf * 8192;
  const bf16_t* vt = (const bf16_t*)(lds + NSA_VT + buf * 8704);
  const bool selok = (MODE == 2) ? (((mymask >> cur) & 1ull) != 0ull) : true;
  const float* tb = (MODE == 3) ? (const float*)(lds + NSA_TW) + hl * 640 : (const float*)(lds + NSA_T) + hl * 4160;
  constexpr int TS = (MODE == 3) ? 640 : 4160;
  const int base = (MODE <= 1) ? (t - 31 - 16 * (cur * 64 + 4 * fq) + 64) : (t - cur * 64 - 4 * fq + 64);
#pragma unroll
  for (int s2 = 0; s2 < 2; ++s2) {
    f32x4 S[2][2];
    S[0][0] = zero4(); S[0][1] = zero4(); S[1][0] = zero4(); S[1][1] = zero4();
#pragma unroll
    for (int ks = 0; ks < 2; ++ks)
#pragma unroll
      for (int kk = 0; kk < 2; ++kk) {
        const bf16x8 kf = *(const bf16x8*)(kt + (32 * s2 + 16 * kk + fr) * 128 + (((ks * 4 + fq) ^ (fr & 7)) << 4));
#pragma unroll
        for (int r = 0; r < 2; ++r) S[kk][r] = mfma16(kf, Qf[r][ks], S[kk][r]);
      }
    bf16x8 Pf[2];
    float g1s[2] = {0.f, 0.f}, p3s[2] = {0.f, 0.f};
#pragma unroll
    for (int r = 0; r < 2; ++r) {
      float sv[2][4];
#pragma unroll
      for (int kk = 0; kk < 2; ++kk)
#pragma unroll
        for (int e = 0; e < 4; ++e) {
          const int off = 32 * s2 + 16 * kk + e;
          int idx;
          if (MODE <= 1) { idx = base - 16 * off; idx = idx > 0 ? idx : 0; } else idx = base - off;
          sv[kk][e] = S[kk][r][e] * (0.125f * LOG2E) + tb[r * TS + idx];
        }
      float pv[2][4];
      if (MODE == 1) {
#pragma unroll
        for (int kk = 0; kk < 2; ++kk)
#pragma unroll
          for (int e = 0; e < 4; ++e) pv[kk][e] = __builtin_amdgcn_exp2f(sv[kk][e] - m[r]) * inv[r];
#pragma unroll
        for (int kk = 0; kk < 2; ++kk) { g1s[kk] += pv[kk][0] + pv[kk][1] + pv[kk][2] + 0.5f * pv[kk][3]; p3s[kk] += 0.5f * pv[kk][3]; }
      } else {
        float mx = fmaxf(fmaxf(fmaxf(sv[0][0], sv[0][1]), fmaxf(sv[0][2], sv[0][3])), fmaxf(fmaxf(sv[1][0], sv[1][1]), fmaxf(sv[1][2], sv[1][3])));
        if (MODE == 2) mx = selok ? mx : -__builtin_inff();
        if (__any(mx > m[r] + 8.0f)) {
          mx = fmaxf(mx, __shfl_xor(mx, 16)); mx = fmaxf(mx, __shfl_xor(mx, 32));
          const float mn = fmaxf(m[r], mx), al = __builtin_amdgcn_exp2f(m[r] - mn);
          m[r] = mn; l[r] *= al;
          if (MODE != 0) {
#pragma unroll
            for (int df = 0; df < 4; ++df) O[df][r] *= al;
          }
        }
        const float me = (MODE == 2) ? (selok ? m[r] : __builtin_inff()) : m[r];
        float ps = 0.f;
#pragma unroll
        for (int kk = 0; kk < 2; ++kk)
#pragma unroll
          for (int e = 0; e < 4; ++e) { pv[kk][e] = __builtin_amdgcn_exp2f(sv[kk][e] - me); ps += pv[kk][e]; }
        l[r] += ps;
      }
      if (MODE != 0) {
        const unsigned w0 = pk2(pv[0][0], pv[0][1]), w1 = pk2(pv[0][2], pv[0][3]), w2 = pk2(pv[1][0], pv[1][1]), w3 = pk2(pv[1][2], pv[1][3]);
        u32x4 pw; pw.x = w0; pw.y = w1; pw.z = w2; pw.w = w3;
        Pf[r] = __builtin_bit_cast(bf16x8, pw);
      }
    }
    if (MODE != 0) {
#pragma unroll
      for (int df = 0; df < 4; ++df) {
        const bf16x4 va = *(const bf16x4*)(vt + (df * 16 + fr) * 68 + 32 * s2 + 4 * fq);
        const bf16x4 vb = *(const bf16x4*)(vt + (df * 16 + fr) * 68 + 32 * s2 + 16 + 4 * fq);
        bf16x8 vf; vf[0] = va[0]; vf[1] = va[1]; vf[2] = va[2]; vf[3] = va[3]; vf[4] = vb[0]; vf[5] = vb[1]; vf[6] = vb[2]; vf[7] = vb[3];
#pragma unroll
        for (int r = 0; r < 2; ++r) O[df][r] = mfma16(vf, Pf[r], O[df][r]);
      }
    }
    if (MODE == 1) {
#pragma unroll
      for (int kk = 0; kk < 2; ++kk) {
        const int j = cur * 16 + (2 * s2 + kk) * 4 + fq;
        atomicAdd(&impw[fr * 65 + j], g1s[kk]);
        if (j + 1 < 64) atomicAdd(&impw[fr * 65 + j + 1], p3s[kk]);
      }
    }
  }
}

template <int MODE>
__device__ __forceinline__ void nsa_branch(int first, int ntl, u64 U, const bf16_t* kbase, const bf16_t* vbase, size_t stride, int t, int hl, u64 mymask,
                                           const bf16x8 (&Qf)[2][2], f32x4 (&O)[4][2], float (&m)[2], float (&l)[2], const float (&inv)[2], float* impw, char* lds) {
  KVRegs R0, R1, R2;
  u64 rem = U;
  int seq = first, left = ntl;
#define NSA_NEXT(dst)                                                                                     \
  { if (MODE == 2) { dst = rem ? (int)__builtin_ctzll(rem) : -1; if (rem) rem &= rem - 1; }              \
    else { dst = left > 0 ? seq : -1; ++seq; --left; } }
#define NSA_GLOAD(R, ti) kv_gload(R, kbase + (size_t)(ti) * 64 * stride, vbase + (size_t)(ti) * 64 * stride, stride)
  int tcur, t1, t2, t3;
  NSA_NEXT(tcur); NSA_NEXT(t1); NSA_NEXT(t2);
  if (tcur >= 0) NSA_GLOAD(R0, tcur);
  if (t1 >= 0) NSA_GLOAD(R1, t1);
  if (t2 >= 0) NSA_GLOAD(R2, t2);
  if (tcur >= 0) kv_lwrite(R0, lds, 0);
  __syncthreads();
  NSA_NEXT(t3);
  if (t3 >= 0) NSA_GLOAD(R0, t3);
  int buf = 0;
#define NSA_STEP(RW)                                                                                      \
  if (tcur < 0) break;                                                                                    \
  nsa_compute<MODE>(tcur, buf, t, hl, mymask, Qf, O, m, l, inv, impw, lds);                               \
  if (t1 >= 0) kv_lwrite(RW, lds, buf ^ 1);                                                               \
  __syncthreads();                                                                                        \
  buf ^= 1; tcur = t1; t1 = t2; t2 = t3;                                                                  \
  NSA_NEXT(t3);                                                                                           \
  if (t3 >= 0) NSA_GLOAD(RW, t3);
  for (;;) {
    NSA_STEP(R1)
    NSA_STEP(R2)
    NSA_STEP(R0)
  }
#undef NSA_STEP
#undef NSA_GLOAD
#undef NSA_NEXT
}

#define NSA_RESET()                                                                         \
  _Pragma("unroll") for (int r = 0; r < 2; ++r) { asm volatile("v_mov_b32 %0, 0xf149f2ca" : "=v"(m[r])); l[r] = 0.f; }               \
  _Pragma("unroll") for (int df = 0; df < 4; ++df) _Pragma("unroll") for (int r = 0; r < 2; ++r) O[df][r] = zero4();

__device__ __forceinline__ void nsa_item(const Params& P, int b, int g, int c, const bf16_t* z, const bf16_t* kcv, bf16_t* y, char* lds) {
  const int tid = TIDX, lane = tid & 63, w8 = tid >> 6, qg = w8 & 3, hp = w8 >> 2, fr = lane & 15, fq = lane >> 4;
  const size_t tokb = (size_t)b * SEQ;
  const int t = c * 64 + 16 * qg + fr;
  const bf16_t* zq = z + (tokb + t) * LDZ;
  const int hb = g * 4 + hp * 2;
  bf16x8 Qf[2][2];
#pragma unroll
  for (int r = 0; r < 2; ++r)
#pragma unroll
    for (int ks = 0; ks < 2; ++ks) Qf[r][ks] = *(const bf16x8*)(zq + ZC_Q + g * 256 + (hp * 2 + r) * 64 + ks * 32 + 8 * fq);
  float* impw = (float*)(lds + NSA_IMP) + (hp * 4 + qg) * (16 * 65);
  for (int i = lane; i < 16 * 65; i += 64) impw[i] = 0.f;
  f32x4 O[4][2];
  float m[2], l[2], inv[2];
  bf16_t* yo = y + (tokb + t) * 1024 + 512 + g * 256 + hp * 128 + 4 * fq;
  const bf16_t* kc = kcv + (size_t)((0 * 8 + b) * 2 + g) * 256 * 64;
  const bf16_t* vc = kcv + (size_t)((1 * 8 + b) * 2 + g) * 256 * 64;
  const int nct = ((4 * c + 2) >> 6) + 1;
  NSA_RESET();
  inv[0] = 0.f; inv[1] = 0.f;
  nsa_branch<0>(0, nct, 0ull, kc, vc, 64, t, hp * 2, 0ull, Qf, O, m, l, inv, impw, lds);
#pragma unroll
  for (int r = 0; r < 2; ++r) { float lt = l[r]; lt += __shfl_xor(lt, 16); lt += __shfl_xor(lt, 32); inv[r] = lt > 0.f ? 1.f / lt : 0.f; }
  nsa_branch<1>(0, nct, 0ull, kc, vc, 64, t, hp * 2, 0ull, Qf, O, m, l, inv, impw, lds);
#pragma unroll
  for (int r = 0; r < 2; ++r) {
    const float gt = sigm(bf2f(zq[ZC_GC + hb + r]));
#pragma unroll
    for (int df = 0; df < 4; ++df) { u32x2 o; o.x = pk2(O[df][r][0] * gt, O[df][r][1] * gt); o.y = pk2(O[df][r][2] * gt, O[df][r][3] * gt); *(u32x2*)(yo + r * 64 + df * 16) = o; }
  }
  __syncthreads();
  u64 mymask = 0ull, wU = 0ull;
  const float* imp0 = (const float*)(lds + NSA_IMP) + qg * (16 * 65);
  const float* imp1 = imp0 + 4 * (16 * 65);
  for (int qq = 0; qq < 16; ++qq) {
    const float sv = imp0[qq * 65 + lane] + imp1[qq * 65 + lane];
    const int j = lane;
    const bool forced = (j == 0) | (j == c) | (j == c - 1);
    const float sc = (j <= c) ? (forced ? 1e4f : sv) : -1.0f;
    int rank = 0;
#pragma unroll 16
    for (int k = 0; k < 64; ++k) { const float sk = __int_as_float(__builtin_amdgcn_readlane(__float_as_int(sc), k)); rank += ((sk > sc) || (sk == sc && k < j)) ? 1 : 0; }
    const bool sel = (rank < 16) && (sc >= 0.f);
    const u64 mk = __ballot(sel);
    if (fr == qq) mymask = mk;
    wU |= mk;
  }
  u64* WU = (u64*)(lds + NSA_WU);
  if (lane == 0) WU[w8] = wU;
  __syncthreads();
  const u64 U = WU[0] | WU[1] | WU[2] | WU[3];
  for (int br = 0; br < 2; ++br) {
    NSA_RESET();
    int zg;
    if (br == 0) {
      nsa_branch<2>(0, 0, U, z + tokb * LDZ + ZC_KS + g * 64, z + tokb * LDZ + ZC_VS + g * 64, LDZ, t, hp * 2, mymask, Qf, O, m, l, inv, impw, lds);
      zg = ZC_GS;
    } else {
      const int kt0 = c > 8 ? c - 8 : 0;
      nsa_branch<3>(kt0, c - kt0 + 1, 0ull, z + tokb * LDZ + ZC_KW + g * 64, z + tokb * LDZ + ZC_VW + g * 64, LDZ, t, hp * 2, 0ull, Qf, O, m, l, inv, impw, lds);
      zg = ZC_GW;
    }
#pragma unroll
    for (int r = 0; r < 2; ++r) {
      float lt = l[r]; lt += __shfl_xor(lt, 16); lt += __shfl_xor(lt, 32);
      const float gt = sigm(bf2f(zq[zg + hb + r])) * (lt > 0.f ? 1.f / lt : 0.f);
#pragma unroll
      for (int df = 0; df < 4; ++df) {
        bf16_t* yp = yo + r * 64 + df * 16;
        const u32x2 pr = *(const u32x2*)yp;
        u32x2 o; o.x = pk2(__uint_as_float(pr.x << 16) + O[df][r][0] * gt, __uint_as_float(pr.x & 0xffff0000u) + O[df][r][1] * gt);
        o.y = pk2(__uint_as_float(pr.y << 16) + O[df][r][2] * gt, __uint_as_float(pr.y & 0xffff0000u) + O[df][r][3] * gt);
        *(u32x2*)yp = o;
      }
    }
  }
  __syncthreads();
}

__device__ __forceinline__ void run_phase(const Params& P, int ph, char* lds) {
  char* ws = P.ws;
  asm volatile("" : "+s"(ws));
  bf16_t* abuf = (bf16_t*)(ws + OFF_A);
  bf16_t* big = (bf16_t*)(ws + OFF_BIG);
  float* fbuf = (float*)(ws + OFF_F);
  float* hsl = fbuf; float* Pc = fbuf + (size_t)M_TOK * 256;
  bf16_t* kcv = (bf16_t*)(ws + OFF_KC);
  float* carryP = (float*)(ws + OFF_CARRY); float* carryH = carryP + 8 * 4 * 64 * 64;
  if (ph == 0) { prep_phase(P, lds); return; }
  const int layer = (ph - 1) / 13, sp = (ph - 1) % 13;
  const float* ng = P.norm_g + (size_t)layer * 8 * 1024;
#ifdef ONLY_SP
  if (sp != ONLY_SP) return;
#endif
  switch (sp) {
    case 0: case 8: {
      const int lj = layer * 2 + (sp == 8);
      gemm_up_phase(abuf, (const bf16_t*)(ws + OFF_WGU + lj * SZ_WGU), big, lds);
    } break;
    case 1: case 9: {
      const int lj = layer * 2 + (sp == 9);
      gemm_f32_phase(big, DFF, (const bf16_t*)(ws + OFF_WD + lj * SZ_WD), DFF, fbuf, lds);
    } break;
    case 2: resnorm_phase(P.out, P.out, fbuf, 0.5f, ng + 1 * 1024, ng + 2 * 1024, abuf); break;
    case 3: gemm_bf16_phase(abuf, 1024, (const bf16_t*)(ws + OFF_WIN + layer * SZ_WIN), 1024, LDZ / 256, big, LDZ, lds); break;
    case 4: {
      const int hb = HBLK; char* hl = lds + hb * 65536;
      for (int it = blockIdx.x * 2 + hb; it < 256; it += gridDim.x * 2) compress_item(P, layer, it, big, kcv, hl);
      for (int it = blockIdx.x * 2 + hb; it < 1024; it += gridDim.x * 2) mixA_item(P, layer, it, big, abuf, hl);
      for (int it = blockIdx.x * 2 + hb; it < 2048; it += gridDim.x * 2) mixB1_item(P, layer, it, big, hsl, Pc, carryP, carryH, hl);
    } break;
    case 5: {
      nsa_tables(P, blockIdx.x & 1, lds);
      for (int it = blockIdx.x; it < 1024; it += gridDim.x) {
        const int rnd = it / 256, pos = it % 256;
        const int c = (rnd & 1) ? (rnd >> 1) * 16 + (pos >> 4) : 63 - (rnd >> 1) * 16 - (pos >> 4);
        const int bg = pos & 15;
        nsa_item(P, bg >> 1, bg & 1, c, big, kcv, abuf, lds);
      }
      const int hb = HBLK;
      for (int it = blockIdx.x * 2 + hb; it < 2048; it += gridDim.x * 2) mixB2_item(it, big, hsl, Pc, carryP, carryH, abuf);
    } break;
    case 6: gemm_f32_phase(abuf, 1024, (const bf16_t*)(ws + OFF_WOUT + layer * SZ_SQ), 1024, fbuf, lds); break;
    case 7: resnorm_phase(P.out, P.out, fbuf, 1.0f, ng + 3 * 1024, ng + 4 * 1024, abuf); break;
    case 10:
      gemm_bf16_phase((const bf16_t*)(ws + OFF_PBF) + (size_t)layer * M_TOK * 256, 256, (const bf16_t*)(ws + OFF_WPP + layer * SZ_WPP), 256, 4, big, 1024, lds);
      resnorm_phase(P.out, P.out, fbuf, 0.5f, ng + 5 * 1024, ng + 6 * 1024, abuf);
      break;
    case 11: gemm_ple_phase(abuf, (const bf16_t*)(ws + OFF_WPG + layer * SZ_SQ), big, fbuf, lds); break;
    case 12: resnorm_phase(P.out, P.out, fbuf, 1.0f, ng + 7 * 1024, layer == 0 ? P.norm_g + 8 * 1024 : nullptr, layer == 0 ? abuf : nullptr); break;
  }
}

#define XB_TMO      128
#define XB_XCNT(j)  (256  + 64 * (j))
#define XB_XSUB(j)  (1280 + 64 * (j))
#define XB_XGEN(j)  (2304 + 64 * (j))
#define XB_TOP      3328
#define XB_TOPGEN   3392
#define XCD_BAR_WORDS 3456
#define XB_SPIN_CAP (1u << 20)
#define LAS __attribute__((address_space(3)))
__device__ __forceinline__ unsigned xb_ld(unsigned* p)              { return __hip_atomic_load(p, __ATOMIC_RELAXED, __HIP_MEMORY_SCOPE_AGENT); }
__device__ __forceinline__ unsigned xb_add(unsigned* p, unsigned v) { return __hip_atomic_fetch_add(p, v, __ATOMIC_RELAXED, __HIP_MEMORY_SCOPE_AGENT); }
__device__ __forceinline__ unsigned xb_xcc_id() { return (unsigned)__builtin_amdgcn_s_getreg((3 << 11) | 20) & 0xFu; }
#define XB_SPIN(cond, bar) do { unsigned _sp = 0; while (cond) { __builtin_amdgcn_s_sleep(1); \
    if ((++_sp & 255u) == 0u) { if (xb_ld(&(bar)[XB_TMO])) break; if (_sp > XB_SPIN_CAP) { atomicAdd(&(bar)[XB_TMO], 1u); break; } } } } while (0)
struct XcdBarrier { unsigned* bar; unsigned x; volatile LAS unsigned* st; };
__device__ __forceinline__ XcdBarrier xcd_barrier_post(unsigned* bar, volatile LAS unsigned* st) {
    XcdBarrier b; b.bar = bar; b.x = xb_xcc_id(); b.st = st;
    if (threadIdx.x == 0) (void)xb_add(&bar[XB_XCNT(b.x)], 1u);
    return b;
}
__device__ __forceinline__ void xcd_barrier_complete(unsigned* bar, unsigned x, unsigned& nloc, unsigned& nx) {
    const unsigned G = gridDim.x * gridDim.y * gridDim.z;
    unsigned sum, cnt, mine, sp = 0u;
    for (;;) {
        sum = 0u; cnt = 0u; mine = 0u;
#pragma unroll
        for (unsigned j = 0; j < 16; ++j) { const unsigned c = xb_ld(&bar[XB_XCNT(j)]); sum += c; cnt += (c > 0u) ? 1u : 0u; mine = (j == x) ? c : mine; }
        if (sum == G) break;
        __builtin_amdgcn_s_sleep(1);
        if ((++sp & 255u) == 0u) { if (xb_ld(&bar[XB_TMO])) break; if (sp > XB_SPIN_CAP) { atomicAdd(&bar[XB_TMO], 1u); break; } }
    }
    nloc = mine > 0u ? mine : 1u; nx = cnt > 0u ? cnt : 1u;
}
__device__ __forceinline__ void xcd_barrier(const XcdBarrier& b) {
    asm volatile("s_waitcnt vmcnt(0)" ::: "memory");
    __syncthreads();
    if (threadIdx.x == 0) {
        unsigned* bar = b.bar;
        __builtin_amdgcn_s_waitcnt(0);
        unsigned nloc = b.st[0], nx = b.st[1];
        if (nloc == 0u) { xcd_barrier_complete(bar, b.x, nloc, nx); b.st[0] = nloc; b.st[1] = nx; }
        const unsigned old = xb_add(&bar[XB_XSUB(b.x)], 1u);
        const unsigned gen = old / nloc;
        if (old + 1u == (gen + 1u) * nloc) {
            __builtin_amdgcn_fence(__ATOMIC_RELEASE, "agent");
            asm volatile("s_waitcnt vmcnt(0)" ::: "memory");
            const unsigned og = xb_add(&bar[XB_TOP], 1u);
            const unsigned tg = og / nx;
            if (og + 1u == (tg + 1u) * nx) xb_add(&bar[XB_TOPGEN], 1u);
            else XB_SPIN(xb_ld(&bar[XB_TOPGEN]) == tg, bar);
            __builtin_amdgcn_fence(__ATOMIC_ACQUIRE, "agent");
            xb_add(&bar[XB_XGEN(b.x)], 1u);
            asm volatile("s_waitcnt vmcnt(0)" ::: "memory");
        } else {
            XB_SPIN(xb_ld(&bar[XB_XGEN(b.x)]) == gen, bar);
            __builtin_amdgcn_fence(__ATOMIC_ACQUIRE, "agent");
            asm volatile("s_waitcnt vmcnt(0)" ::: "memory");
        }
    }
    __syncthreads();
}

constexpr int LDS_BYTES = LDS_ST + 16;
__global__ void __launch_bounds__(512, 2) fwd_megakernel(Params P) {
  __shared__ __attribute__((aligned(16))) char lds[LDS_BYTES];
  cg::grid_group grid = cg::this_grid();
  volatile LAS unsigned* st = (volatile LAS unsigned*)(lds + LDS_ST);
  if (threadIdx.x == 0) { st[0] = 0u; st[1] = 0u; }
  __syncthreads();
  XcdBarrier xb = xcd_barrier_post((unsigned*)(P.ws + OFF_BAR), st);
  if (P.ws == nullptr) grid.sync();
  for (int ph = 0; ph < NPHASE; ++ph) {
    run_phase(P, ph, lds);
    if (ph + 1 < NPHASE) xcd_barrier(xb);
  }
}

__global__ void __launch_bounds__(512, 2) phase_kernel(Params P, int ph) {
  __shared__ __attribute__((aligned(16))) char lds[LDS_BYTES];
  run_phase(P, ph, lds);
}

extern "C" void kernel_launch(void* const* d_in, const int* in_sizes, int n_in, void* d_out, int out_size, void* d_ws, size_t ws_size, hipStream_t stream) {
  Params P{};
  const float** pp = (const float**)&P;
  for (int i = 0; i < 26; ++i) pp[i] = (const float*)d_in[i];
  P.out = (float*)d_out;
  P.ws = (char*)d_ws;
  if (ws_size < WS_NEED) { fprintf(stderr, "workspace too small: %zu < %zu\n", ws_size, (size_t)WS_NEED); return; }
#if MK_FUSED
  static int grid_blocks = 0;
  if (!grid_blocks) {
    int dev = 0, cus = 0, per_cu = 0;
    (void)hipGetDevice(&dev);
    (void)hipDeviceGetAttribute(&cus, hipDeviceAttributeMultiprocessorCount, dev);
    (void)hipOccupancyMaxActiveBlocksPerMultiprocessor(&per_cu, fwd_megakernel, 512, 0);
    if (per_cu > 1) per_cu = 1;
    if (per_cu < 1) per_cu = 1;
    grid_blocks = cus * per_cu;
  }
  (void)hipMemsetAsync((char*)d_ws + OFF_BAR, 0, XCD_BAR_WORDS * 4, stream);
  void* args[] = {&P};
  hipError_t e = hipLaunchCooperativeKernel((void*)fwd_megakernel, dim3(grid_blocks), dim3(512), args, 0, stream);
  if (e != hipSuccess) fprintf(stderr, "cooperative launch failed: %s (grid %d)\n", hipGetErrorString(e), grid_blocks);
#else
  for (int ph = 0; ph < NPHASE; ++ph) phase_kernel<<<256, 512, 0, stream>>>(P, ph);
#endif
}
```

```cpp
#include <hip/hip_runtime.h>
#include <hip/hip_cooperative_groups.h>
#include <cstdint>
#include <cstdio>
namespace cg = cooperative_groups;

#ifndef MK_FUSED
#define MK_FUSED 1
#endif

typedef unsigned short bf16_t;
typedef short bf16x8 __attribute__((ext_vector_type(8)));
typedef short bf16x4 __attribute__((ext_vector_type(4)));
typedef float f32x4 __attribute__((ext_vector_type(4)));
typedef unsigned long long u64;
typedef unsigned u32x4 __attribute__((ext_vector_type(4)));
typedef unsigned u32x2 __attribute__((ext_vector_type(2)));

constexpr int M_TOK = 32768, DM = 1024, DFF = 2816, NGU = 5632, NIN = 2328, LDZ = 2560, SEQ = 4096;
constexpr int NPHASE = 27;
constexpr int ZC_AU = 0, ZC_AV = 256, ZC_BX = 512, ZC_BG = 768, ZC_Q = 1024, ZC_KC = 1536, ZC_VC = 1664, ZC_KS = 1792, ZC_VS = 1920,
              ZC_KW = 2048, ZC_VW = 2176, ZC_GC = 2304, ZC_GS = 2312, ZC_GW = 2320;

constexpr size_t SZ_WGU = (size_t)NGU * 1024 * 2, SZ_WD = (size_t)1024 * DFF * 2, SZ_WIN = (size_t)LDZ * 1024 * 2, SZ_SQ = (size_t)1024 * 1024 * 2,
                 SZ_WPP = (size_t)1024 * 256 * 2, SZ_CW1 = (size_t)128 * 2048 * 2;
constexpr size_t OFF_WGU = 0;
constexpr size_t OFF_WD = OFF_WGU + 4 * SZ_WGU;
constexpr size_t OFF_WIN = OFF_WD + 4 * SZ_WD;
constexpr size_t OFF_WOUT = OFF_WIN + 2 * SZ_WIN;
constexpr size_t OFF_WPG = OFF_WOUT + 2 * SZ_SQ;
constexpr size_t OFF_WPP = OFF_WPG + 2 * SZ_SQ;
constexpr size_t OFF_CW1 = OFF_WPP + 2 * SZ_WPP;
constexpr size_t OFF_CB1 = OFF_CW1 + 4 * SZ_CW1;
constexpr size_t OFF_SGUW = OFF_CB1 + 4096;
constexpr size_t OFF_WAT = OFF_SGUW + 2 * 4 * 128 * 128 * 2;
constexpr size_t OFF_WXT = OFF_WAT + 2 * 4 * 64 * 64 * 2;
constexpr size_t OFF_PBF = OFF_WXT + 2 * 4 * 64 * 64 * 2;
constexpr size_t OFF_A = OFF_PBF + (size_t)2 * M_TOK * 256 * 2;
constexpr size_t OFF_BIG = OFF_A + (size_t)M_TOK * 1024 * 2;
constexpr size_t OFF_F = OFF_BIG + (size_t)M_TOK * DFF * 2;
constexpr size_t OFF_KC = OFF_F + (size_t)M_TOK * 1024 * 4;
constexpr size_t OFF_CARRY = OFF_KC + (size_t)2 * 8 * 2 * 256 * 64 * 2;
constexpr size_t OFF_BAR = OFF_CARRY + (size_t)2 * 8 * 4 * 64 * 64 * 4;
constexpr size_t WS_NEED = OFF_BAR + 16384;

struct Params {
  const float *x, *p, *rel_bias, *norm_g, *ffn_wg, *ffn_wu, *ffn_wd, *w_in, *w_out, *sgu_ng, *sgu_w, *sgu_b, *conv_w, *conv_b,
      *lru_wa, *lru_ba, *lru_wx, *lru_bx, *lru_lam, *cmp_pos, *cmp_w1, *cmp_b1, *cmp_w2, *cmp_b2, *ple_wg, *ple_wp;
  float* out;
  char* ws;
};

__device__ __forceinline__ int opaque_tid() { int t; asm volatile("v_mov_b32 %0, %1" : "=v"(t) : "v"(threadIdx.x)); return t; }
#define TIDX opaque_tid()
#define HTID (opaque_tid() & 255)
#define HBLK (opaque_tid() >> 8)
__device__ __forceinline__ float bf2f(bf16_t v) { return __uint_as_float(((unsigned)v) << 16); }
__device__ __forceinline__ bf16_t f2bf(float f) { unsigned u = __float_as_uint(f); u += 0x7fffu + ((u >> 16) & 1u); return (bf16_t)(u >> 16); }
__device__ __forceinline__ unsigned pk2(float lo, float hi) { unsigned r; asm("v_cvt_pk_bf16_f32 %0, %1, %2" : "=v"(r) : "v"(lo), "v"(hi)); return r; }
__device__ __forceinline__ float sigm(float x) { return __builtin_amdgcn_rcpf(1.f + __expf(-x)); }
__device__ __forceinline__ float gelu_t(float x) { float u = 0.7978845608028654f * (x + 0.044715f * x * x * x); return x * __builtin_amdgcn_rcpf(1.f + __expf(-2.f * u)); }
__device__ __forceinline__ float silu_f(float x) { return x * __builtin_amdgcn_rcpf(1.f + __expf(-x)); }
__device__ __forceinline__ f32x4 mfma16(bf16x8 a, bf16x8 b, f32x4 c) { return __builtin_amdgcn_mfma_f32_16x16x32_bf16(a, b, c, 0, 0, 0); }
__device__ __forceinline__ void glds16(const void* g, void* l) {
  __builtin_amdgcn_global_load_lds((const __attribute__((address_space(1))) unsigned*)g, (__attribute__((address_space(3))) unsigned*)l, 16, 0, 0);
}
__device__ __forceinline__ f32x4 zero4() { f32x4 z; asm volatile("v_mov_b32 %0, 0\n\tv_mov_b32 %1, 0\n\tv_mov_b32 %2, 0\n\tv_mov_b32 %3, 0" : "=v"(z[0]), "=v"(z[1]), "=v"(z[2]), "=v"(z[3])); return z; }
__device__ __forceinline__ float wave_sum(float v) {
#pragma unroll
  for (int o = 32; o > 0; o >>= 1) v += __shfl_xor(v, o);
  return v;
}
__device__ __forceinline__ void unpack8(const u32x4 u, float* f) {
  f[0] = __uint_as_float(u.x << 16); f[1] = __uint_as_float(u.x & 0xffff0000u);
  f[2] = __uint_as_float(u.y << 16); f[3] = __uint_as_float(u.y & 0xffff0000u);
  f[4] = __uint_as_float(u.z << 16); f[5] = __uint_as_float(u.z & 0xffff0000u);
  f[6] = __uint_as_float(u.w << 16); f[7] = __uint_as_float(u.w & 0xffff0000u);
}

__device__ __forceinline__ void tr_cvt_tile(const float* __restrict__ src, int N, int K, bf16_t* __restrict__ dst, int ldd, int rs, int ro, int tile, bool active, float* lds) {
  const int ntn = (N + 63) >> 6, tk = tile / ntn, tn = tile - tk * ntn, k0 = tk * 64, n0 = tn * 64, tid = HTID;
#pragma unroll
  for (int ps = 0; ps < 4; ++ps) {
    const int i = ps * 16 + (tid >> 4), j = (tid & 15) * 4;
    float4 v = make_float4(0.f, 0.f, 0.f, 0.f);
    if (active && n0 + j < N) v = *(const float4*)(src + (size_t)(k0 + i) * N + n0 + j);
    float* d = lds + i * 65 + j; d[0] = v.x; d[1] = v.y; d[2] = v.z; d[3] = v.w;
  }
  __syncthreads();
  const int j = tid >> 2, kq = tid & 3, n = n0 + j;
  if (active && n < N) {
    unsigned w[8];
#pragma unroll
    for (int q = 0; q < 8; ++q) w[q] = pk2(lds[(kq * 16 + 2 * q) * 65 + j], lds[(kq * 16 + 2 * q + 1) * 65 + j]);
    bf16_t* o = dst + (size_t)((n >> 4) * rs + (n & 15) + ro) * ldd + k0 + kq * 16;
    *(uint4*)o = make_uint4(w[0], w[1], w[2], w[3]);
    *(uint4*)(o + 8) = make_uint4(w[4], w[5], w[6], w[7]);
  }
  __syncthreads();
}
__device__ __forceinline__ void tr_cvt(const float* src, int N, int K, bf16_t* dst, int ldd, int rs, int ro, char* ldsc) {
  const int nt = ((N + 63) >> 6) * (K >> 6), hb = HBLK;
  float* lds = (float*)(ldsc + hb * 65536);
  for (int t0 = blockIdx.x * 2; t0 < nt; t0 += gridDim.x * 2) tr_cvt_tile(src, N, K, dst, ldd, rs, ro, t0 + hb, t0 + hb < nt, lds);
}

struct RowRegs { float4 h[4]; u32x2 f[4]; };
__device__ __forceinline__ void rn_load(RowRegs& R, const float* hin, const bf16_t* f, int row, int lane) {
#pragma unroll
  for (int i = 0; i < 4; ++i) R.h[i] = *(const float4*)(hin + (size_t)row * 1024 + i * 256 + lane * 4);
  if (f) {
#pragma unroll
    for (int i = 0; i < 4; ++i) R.f[i] = *(const u32x2*)(f + (size_t)row * 1024 + i * 256 + lane * 4);
  }
}
__device__ __forceinline__ void rn_proc(RowRegs& R, float* hout, bool has_f, float scale, const float* gpost, const float* gpre, bf16_t* a, int row, int lane) {
  if (has_f) {
    float fv[4][4]; float ss = 0.f;
#pragma unroll
    for (int i = 0; i < 4; ++i) {
      fv[i][0] = __uint_as_float(R.f[i].x << 16); fv[i][1] = __uint_as_float(R.f[i].x & 0xffff0000u);
      fv[i][2] = __uint_as_float(R.f[i].y << 16); fv[i][3] = __uint_as_float(R.f[i].y & 0xffff0000u);
      ss += fv[i][0] * fv[i][0] + fv[i][1] * fv[i][1] + fv[i][2] * fv[i][2] + fv[i][3] * fv[i][3];
    }
    ss = wave_sum(ss);
    const float r = rsqrtf(ss * (1.f / 1024.f) + 1e-6f) * scale;
#pragma unroll
    for (int i = 0; i < 4; ++i) { const float4 g = *(const float4*)(gpost + i * 256 + lane * 4);
      R.h[i].x += fv[i][0] * r * g.x; R.h[i].y += fv[i][1] * r * g.y; R.h[i].z += fv[i][2] * r * g.z; R.h[i].w += fv[i][3] * r * g.w; }
  }
  if (hout) {
#pragma unroll
    for (int i = 0; i < 4; ++i) *(float4*)(hout + (size_t)row * 1024 + i * 256 + lane * 4) = R.h[i];
  }
  if (a) {
    float ss = 0.f;
#pragma unroll
    for (int i = 0; i < 4; ++i) ss += R.h[i].x * R.h[i].x + R.h[i].y * R.h[i].y + R.h[i].z * R.h[i].z + R.h[i].w * R.h[i].w;
    ss = wave_sum(ss);
    const float r = rsqrtf(ss * (1.f / 1024.f) + 1e-6f);
#pragma unroll
    for (int i = 0; i < 4; ++i) { const float4 g = *(const float4*)(gpre + i * 256 + lane * 4);
      u32x2 o; o.x = pk2(R.h[i].x * r * g.x, R.h[i].y * r * g.y); o.y = pk2(R.h[i].z * r * g.z, R.h[i].w * r * g.w);
      *(u32x2*)(a + (size_t)row * 1024 + i * 256 + lane * 4) = o; }
  }
}
__device__ __forceinline__ void resnorm_phase(const float* hin, float* hout, const bf16_t* f, float scale, const float* gpost, const float* gpre, bf16_t* a) {
  const int tid = TIDX, lane = tid & 63, stride = gridDim.x * 8;
  int r0 = blockIdx.x * 8 + (tid >> 6), r1 = r0 + stride;
  RowRegs A, B;
  if (r0 < M_TOK) rn_load(A, hin, f, r0, lane);
  for (;;) {
    if (r0 >= M_TOK) break;
    if (r1 < M_TOK) rn_load(B, hin, f, r1, lane);
    rn_proc(A, hout, f != nullptr, scale, gpost, gpre, a, r0, lane);
    r0 += 2 * stride;
    if (r1 >= M_TOK) break;
    if (r0 < M_TOK) rn_load(A, hin, f, r0, lane);
    rn_proc(B, hout, f != nullptr, scale, gpost, gpre, a, r1, lane);
    r1 += 2 * stride;
  }
}

__device__ __forceinline__ void prep_phase(const Params& P, char* ldsc) {
  char* ws = P.ws;
  for (int l = 0; l < 2; ++l) {
    for (int j = 0; j < 2; ++j) {
      const int lj = l * 2 + j;
      bf16_t* wgu = (bf16_t*)(ws + OFF_WGU + lj * SZ_WGU);
      tr_cvt(P.ffn_wg + (size_t)lj * 1024 * DFF, DFF, 1024, wgu, 1024, 32, 0, ldsc);
      tr_cvt(P.ffn_wu + (size_t)lj * 1024 * DFF, DFF, 1024, wgu, 1024, 32, 16, ldsc);
      tr_cvt(P.ffn_wd + (size_t)lj * DFF * 1024, 1024, DFF, (bf16_t*)(ws + OFF_WD + lj * SZ_WD), DFF, 16, 0, ldsc);
      tr_cvt(P.cmp_w1 + (size_t)lj * 2048 * 128, 128, 2048, (bf16_t*)(ws + OFF_CW1 + lj * SZ_CW1), 2048, 16, 0, ldsc);
    }
    tr_cvt(P.w_in + (size_t)l * 1024 * NIN, NIN, 1024, (bf16_t*)(ws + OFF_WIN + l * SZ_WIN), 1024, 16, 0, ldsc);
    tr_cvt(P.w_out + (size_t)l * 1024 * 1024, 1024, 1024, (bf16_t*)(ws + OFF_WOUT + l * SZ_SQ), 1024, 16, 0, ldsc);
    tr_cvt(P.ple_wg + (size_t)l * 1024 * 1024, 1024, 1024, (bf16_t*)(ws + OFF_WPG + l * SZ_SQ), 1024, 16, 0, ldsc);
    tr_cvt(P.ple_wp + (size_t)l * 256 * 1024, 1024, 256, (bf16_t*)(ws + OFF_WPP + l * SZ_WPP), 256, 16, 0, ldsc);
    for (int g = 0; g < 4; ++g) {
      tr_cvt(P.lru_wa + (size_t)(l * 4 + g) * 4096, 64, 64, (bf16_t*)(ws + OFF_WAT) + (l * 4 + g) * 4096, 64, 16, 0, ldsc);
      tr_cvt(P.lru_wx + (size_t)(l * 4 + g) * 4096, 64, 64, (bf16_t*)(ws + OFF_WXT) + (l * 4 + g) * 4096, 64, 16, 0, ldsc);
    }
  }
  const int tid = TIDX, gtid = blockIdx.x * 512 + tid, gn = gridDim.x * 512;
  for (int i = gtid; i < 2 * (LDZ - NIN) * 1024 / 8; i += gn) {
    const int l = i / ((LDZ - NIN) * 128), r = i - l * ((LDZ - NIN) * 128);
    *(f32x4*)((bf16_t*)(ws + OFF_WIN + l * SZ_WIN) + (size_t)NIN * 1024 + (size_t)r * 8) = zero4();
  }
  for (int i = gtid; i < 2 * 4 * 128 * 128; i += gn) { const int t = (i >> 7) & 127, s2 = i & 127; ((bf16_t*)(ws + OFF_SGUW))[i] = (s2 <= t) ? f2bf(P.sgu_w[i]) : (bf16_t)0; }
  for (int i = gtid; i < 2 * M_TOK * 256 / 4; i += gn) { const float4 v = ((const float4*)P.p)[i]; uint2 o; o.x = pk2(v.x, v.y); o.y = pk2(v.z, v.w); ((uint2*)(ws + OFF_PBF))[i] = o; }
  {
    float* lds = (float*)(ldsc + HBLK * 65536);
    for (int u = blockIdx.x; u < 4; u += gridDim.x) {
      const int t2 = HTID, kq = t2 >> 5, jq = t2 & 31;
      const float* w1 = P.cmp_w1 + (size_t)u * 2048 * 128; const float* pos = P.cmp_pos + (size_t)u * 2048;
      float4 sacc = make_float4(0.f, 0.f, 0.f, 0.f);
      for (int k = kq * 256; k < kq * 256 + 256; ++k) { const float pv = pos[k]; const float4 w = *(const float4*)(w1 + (size_t)k * 128 + jq * 4); sacc.x += pv * w.x; sacc.y += pv * w.y; sacc.z += pv * w.z; sacc.w += pv * w.w; }
      __syncthreads();
      lds[kq * 128 + jq * 4 + 0] = sacc.x; lds[kq * 128 + jq * 4 + 1] = sacc.y; lds[kq * 128 + jq * 4 + 2] = sacc.z; lds[kq * 128 + jq * 4 + 3] = sacc.w;
      __syncthreads();
      if (t2 < 128) { float t = P.cmp_b1[u * 128 + t2]; for (int q = 0; q < 8; ++q) t += lds[q * 128 + t2]; ((float*)(ws + OFF_CB1))[u * 128 + t2] = t; }
      __syncthreads();
    }
  }
  resnorm_phase(P.x, nullptr, nullptr, 0.f, nullptr, P.norm_g, (bf16_t*)(ws + OFF_A));
}

constexpr int G8_HT = 128 * 64;
__device__ __forceinline__ int g8_lds_byte(int r, int c) { const int st = (r >> 4) * 2 + (c >> 5), rr = r & 15, cc = c & 31, ob = rr * 64 + cc * 2; return st * 1024 + (ob ^ (((ob >> 9) & 1) << 5)); }
__device__ __forceinline__ void g8_stage_rc(int b, int& R, int& C) { const int st = b / 1024, sb = b % 1024, swz = sb ^ (((sb >> 9) & 1) << 5); R = (st >> 1) * 16 + swz / 64; C = (st & 1) * 32 + (swz % 64) / 2; }

__device__ __forceinline__ void gemm_core(f32x4 (&acc)[2][2][4][2], const bf16_t* __restrict__ A, int lda, const bf16_t* __restrict__ Bt, int ldb, int K, char* ldsc) {
  bf16_t* shm = (bf16_t*)ldsc;
  const int tid = TIDX, wid = tid >> 6, lane = tid & 63, wr = wid >> 2, wc = wid & 3, fr = lane & 15, fq = lane >> 4;
  int sr0, sc0;
  g8_stage_rc(tid * 16, sr0, sc0);
  const bf16_t* gA0 = A + (size_t)sr0 * lda + sc0;
  const bf16_t* gB0 = Bt + (size_t)sr0 * ldb + sc0;
  const size_t a64 = (size_t)64 * lda, b64 = (size_t)64 * ldb;
  const int lane_off = (fr * 64 + fq * 16) ^ ((((fr * 64 + fq * 16) >> 9) & 1) << 5);
  const char* ldA = ldsc + wr * 8192 + lane_off;
  const char* ldB = ldsc + 65536 + wc * 4096 + lane_off;
#define SA(b, h) (shm + ((b) * 2 + (h)) * G8_HT)
#define SB(b, h) (shm + (4 + (b) * 2 + (h)) * G8_HT)
#define STAGE_A(P, h, kt) { const bf16_t* g_ = gA0 + (size_t)(h) * 2 * a64 + (kt) * 64; glds16(g_, (char*)(P) + tid * 16); glds16(g_ + a64, (char*)(P) + tid * 16 + 8192); }
#define STAGE_B(P, h, kt) { const bf16_t* g_ = gB0 + (size_t)(h) * 2 * b64 + (kt) * 64; glds16(g_, (char*)(P) + tid * 16); glds16(g_ + b64, (char*)(P) + tid * 16 + 8192); }
#define LDA(dst, b, h) _Pragma("unroll") for (int m = 0; m < 4; ++m) _Pragma("unroll") for (int k = 0; k < 2; ++k) \
    dst[m][k] = *reinterpret_cast<const bf16x8*>(ldA + ((b) * 2 + (h)) * 16384 + (m * 2 + k) * 1024)
#define LDB(dst, b, h) _Pragma("unroll") for (int n = 0; n < 2; ++n) _Pragma("unroll") for (int k = 0; k < 2; ++k) \
    dst[n][k] = *reinterpret_cast<const bf16x8*>(ldB + ((b) * 2 + (h)) * 16384 + (n * 2 + k) * 1024)
#define MMA(ai, bj, At_, Bt_) do { __builtin_amdgcn_s_setprio(1); \
    _Pragma("unroll") for (int m = 0; m < 4; ++m) _Pragma("unroll") for (int n = 0; n < 2; ++n) _Pragma("unroll") for (int k = 0; k < 2; ++k) \
      acc[ai][bj][m][n] = mfma16(Bt_[n][k], At_[m][k], acc[ai][bj][m][n]); \
    __builtin_amdgcn_s_setprio(0); } while (0)
#define WAIT_V(n) asm volatile("s_waitcnt vmcnt(" #n ")" ::: "memory")
#define WAIT_L(n) asm volatile("s_waitcnt lgkmcnt(" #n ")" ::: "memory")
#define BAR __builtin_amdgcn_s_barrier()
#define SCHED __builtin_amdgcn_sched_barrier(0)
  bf16x8 At[4][2], B0[2][2], B1[2][2];
  const int nt = K >> 6;
  STAGE_B(SB(0, 0), 0, 0); STAGE_A(SA(0, 0), 0, 0);
  STAGE_B(SB(0, 1), 1, 0); STAGE_A(SA(0, 1), 1, 0);
  if (wr == 1) BAR;
  WAIT_V(4); BAR;
  STAGE_B(SB(1, 0), 0, 1); STAGE_A(SA(1, 0), 0, 1); STAGE_B(SB(1, 1), 1, 1);
  WAIT_V(6); BAR;
#pragma nounroll
  for (int t = 0; t < nt - 2; t += 2) {
    LDB(B0, 0, 0); SCHED; LDA(At, 0, 0); STAGE_A(SA(1, 1), 1, t + 1);
    WAIT_L(8); BAR; WAIT_L(0); MMA(0, 0, At, B0); BAR; SCHED;
    LDB(B1, 0, 1); STAGE_B(SB(0, 0), 0, t + 2);
    BAR; WAIT_L(0); MMA(0, 1, At, B1); BAR;
    LDA(At, 0, 1); STAGE_A(SA(0, 0), 0, t + 2);
    BAR; WAIT_L(0); MMA(1, 0, At, B0); BAR; SCHED;
    STAGE_B(SB(0, 1), 1, t + 2);
    WAIT_V(6); BAR; MMA(1, 1, At, B1); BAR;
    LDB(B0, 1, 0); SCHED; LDA(At, 1, 0); STAGE_A(SA(0, 1), 1, t + 2);
    WAIT_L(8); BAR; WAIT_L(0); MMA(0, 0, At, B0); BAR; SCHED;
    LDB(B1, 1, 1); STAGE_B(SB(1, 0), 0, t + 3);
    BAR; WAIT_L(0); MMA(0, 1, At, B1); BAR;
    LDA(At, 1, 1); STAGE_A(SA(1, 0), 0, t + 3);
    BAR; WAIT_L(0); MMA(1, 0, At, B0); BAR; SCHED;
    STAGE_B(SB(1, 1), 1, t + 3);
    WAIT_V(6); BAR; MMA(1, 1, At, B1); BAR;
  }
  { LDB(B0, 0, 0); LDA(At, 0, 0); STAGE_A(SA(1, 1), 1, nt - 1);
    BAR; WAIT_L(0); MMA(0, 0, At, B0); BAR;
    LDB(B1, 0, 1); BAR; WAIT_L(0); MMA(0, 1, At, B1); BAR;
    LDA(At, 0, 1); WAIT_V(4); BAR; WAIT_L(0); MMA(1, 0, At, B0); MMA(1, 1, At, B1); BAR; }
  { LDB(B0, 1, 0); LDA(At, 1, 0); WAIT_V(2); BAR; WAIT_L(0); MMA(0, 0, At, B0); BAR;
    LDB(B1, 1, 1); WAIT_V(0); BAR; WAIT_L(0); MMA(0, 1, At, B1); BAR;
    LDA(At, 1, 1); BAR; WAIT_L(0); MMA(1, 0, At, B0); MMA(1, 1, At, B1); BAR; }
  if (wr == 0) BAR;
  BAR;
#undef SA
#undef SB
#undef STAGE_A
#undef STAGE_B
#undef LDA
#undef LDB
#undef MMA
#undef WAIT_V
#undef WAIT_L
#undef BAR
#undef SCHED
}

template <class F> __device__ __forceinline__ void gemm_sched(int TN, F&& f) {
  const int npc = (TN + 1) >> 1, npatch = 8 * npc, xcd = blockIdx.x & 7, slot = blockIdx.x >> 3, nslot = gridDim.x >> 3;
  for (int pid = xcd; pid < npatch; pid += 8) {
    const int pr = pid / npc, pc = pid - pr * npc;
    for (int s = slot; s < 32; s += nslot) {
      const int tm = pr * 16 + (s & 15), tn = pc * 2 + (s >> 4);
      if (tn < TN) f(tm, tn);
    }
  }
}

#define GEMM_LANE const int tid_ = TIDX, lane_ = tid_ & 63, wid_ = tid_ >> 6, wr = wid_ >> 2, wc = wid_ & 3, fr = lane_ & 15, fq = lane_ >> 4
#define GEMM_EPI_LOOP _Pragma("unroll") for (int ai = 0; ai < 2; ++ai) _Pragma("unroll") for (int m = 0; m < 4; ++m) _Pragma("unroll") for (int bj = 0; bj < 2; ++bj)

__device__ __forceinline__ void gemm_up_phase(const bf16_t* a, const bf16_t* wgu, bf16_t* act, char* lds) {
  gemm_sched(NGU / 256, [&](int tm, int tn) {
    f32x4 acc[2][2][4][2];
    _Pragma("unroll") for (int i0 = 0; i0 < 2; ++i0) _Pragma("unroll") for (int i1 = 0; i1 < 2; ++i1) _Pragma("unroll") for (int i2 = 0; i2 < 4; ++i2) _Pragma("unroll") for (int i3 = 0; i3 < 2; ++i3) acc[i0][i1][i2][i3] = zero4();
    gemm_core(acc, a + (size_t)tm * 256 * 1024, 1024, wgu + (size_t)tn * 256 * 1024, 1024, 1024, lds);
    GEMM_LANE;
    GEMM_EPI_LOOP {
      const int row = tm * 256 + ai * 128 + wr * 64 + m * 16 + fr;
      const int col = tn * 128 + bj * 64 + wc * 16 + 4 * fq;
      const f32x4 g = acc[ai][bj][m][0], u = acc[ai][bj][m][1];
      uint2 o; o.x = pk2(silu_f(g[0]) * u[0], silu_f(g[1]) * u[1]); o.y = pk2(silu_f(g[2]) * u[2], silu_f(g[3]) * u[3]);
      *(uint2*)(act + (size_t)row * DFF + col) = o;
    }
  });
}

__device__ __forceinline__ void gemm_f32_phase(const bf16_t* A, int lda, const bf16_t* Bt, int K, float* out, char* lds) {
  gemm_sched(4, [&](int tm, int tn) {
    f32x4 acc[2][2][4][2];
    _Pragma("unroll") for (int i0 = 0; i0 < 2; ++i0) _Pragma("unroll") for (int i1 = 0; i1 < 2; ++i1) _Pragma("unroll") for (int i2 = 0; i2 < 4; ++i2) _Pragma("unroll") for (int i3 = 0; i3 < 2; ++i3) acc[i0][i1][i2][i3] = zero4();
    gemm_core(acc, A + (size_t)tm * 256 * lda, lda, Bt + (size_t)tn * 256 * K, K, K, lds);
    GEMM_LANE;
    GEMM_EPI_LOOP {
      const int row = tm * 256 + ai * 128 + wr * 64 + m * 16 + fr;
#pragma unroll
      for (int n = 0; n < 2; ++n) *(f32x4*)(out + (size_t)row * 1024 + tn * 256 + bj * 128 + wc * 32 + n * 16 + 4 * fq) = acc[ai][bj][m][n];
    }
  });
}

__device__ __forceinline__ void gemm_bf16_phase(const bf16_t* A, int lda, const bf16_t* Bt, int K, int TN, bf16_t* out, int ldo, char* lds) {
  gemm_sched(TN, [&](int tm, int tn) {
    f32x4 acc[2][2][4][2];
    _Pragma("unroll") for (int i0 = 0; i0 < 2; ++i0) _Pragma("unroll") for (int i1 = 0; i1 < 2; ++i1) _Pragma("unroll") for (int i2 = 0; i2 < 4; ++i2) _Pragma("unroll") for (int i3 = 0; i3 < 2; ++i3) acc[i0][i1][i2][i3] = zero4();
    gemm_core(acc, A + (size_t)tm * 256 * lda, lda, Bt + (size_t)tn * 256 * K, K, K, lds);
    GEMM_LANE;
    GEMM_EPI_LOOP {
      const int row = tm * 256 + ai * 128 + wr * 64 + m * 16 + fr;
#pragma unroll
      for (int n = 0; n < 2; ++n) {
        uint2 o; o.x = pk2(acc[ai][bj][m][n][0], acc[ai][bj][m][n][1]); o.y = pk2(acc[ai][bj][m][n][2], acc[ai][bj][m][n][3]);
        *(uint2*)(out + (size_t)row * ldo + tn * 256 + bj * 128 + wc * 32 + n * 16 + 4 * fq) = o;
      }
    }
  });
}

__device__ __forceinline__ void gemm_ple_phase(const bf16_t* a, const bf16_t* wpg, const bf16_t* pp, bf16_t* out, char* lds) {
  gemm_sched(4, [&](int tm, int tn) {
    f32x4 acc[2][2][4][2];
    _Pragma("unroll") for (int i0 = 0; i0 < 2; ++i0) _Pragma("unroll") for (int i1 = 0; i1 < 2; ++i1) _Pragma("unroll") for (int i2 = 0; i2 < 4; ++i2) _Pragma("unroll") for (int i3 = 0; i3 < 2; ++i3) acc[i0][i1][i2][i3] = zero4();
    gemm_core(acc, a + (size_t)tm * 256 * 1024, 1024, wpg + (size_t)tn * 256 * 1024, 1024, 1024, lds);
    GEMM_LANE;
    GEMM_EPI_LOOP {
      const int row = tm * 256 + ai * 128 + wr * 64 + m * 16 + fr;
#pragma unroll
      for (int n = 0; n < 2; ++n) {
        const int col = tn * 256 + bj * 128 + wc * 32 + n * 16 + 4 * fq;
        const u32x2 pv = *(const u32x2*)(pp + (size_t)row * 1024 + col);
        const f32x4 av = acc[ai][bj][m][n];
        u32x2 o;
        o.x = pk2(sigm(av[0]) * __uint_as_float(pv.x << 16), sigm(av[1]) * __uint_as_float(pv.x & 0xffff0000u));
        o.y = pk2(sigm(av[2]) * __uint_as_float(pv.y << 16), sigm(av[3]) * __uint_as_float(pv.y & 0xffff0000u));
        *(u32x2*)(out + (size_t)row * 1024 + col) = o;
      }
    }
  });
}

__device__ __forceinline__ void mixA_item(const Params& P, int layer, int idx, const bf16_t* z, bf16_t* y, char* lds) {
  const int g = idx & 3, bc = idx >> 2, tok0 = bc * 128;
  const int tid = HTID, lane = tid & 63, w = tid >> 6, fr = lane & 15, fq = lane >> 4;
  bf16_t* vT = (bf16_t*)lds;
  const float* ng = P.sgu_ng + layer * 256;
  {
    const int s = tid >> 1, half = tid & 1;
    const bf16_t* zr = z + (size_t)(tok0 + s) * LDZ + ZC_AV;
    float ss = 0.f;
#pragma unroll 4
    for (int i = 0; i < 16; ++i) { float v[8]; unpack8(*(const u32x4*)(zr + half * 128 + i * 8), v);
#pragma unroll
      for (int e = 0; e < 8; ++e) { const float t = gelu_t(v[e]); ss += t * t; } }
    ss += __shfl_xor(ss, 1);
    const float rs = rsqrtf(ss * (1.f / 256.f) + 1e-6f);
#pragma unroll
    for (int i = 0; i < 4; ++i) { float v[8]; unpack8(*(const u32x4*)(zr + g * 64 + half * 32 + i * 8), v);
#pragma unroll
      for (int e = 0; e < 8; ++e) { const int d = half * 32 + i * 8 + e; vT[d * 136 + s] = f2bf(gelu_t(v[e]) * rs * ng[g * 64 + d]); } }
  }
  __syncthreads();
  const bf16_t* W = (const bf16_t*)(P.ws + OFF_SGUW) + (size_t)((layer * 4 + g) * 128) * 128;
  f32x4 acc[2][4] = {};
  for (int ks = 0; ks <= w; ++ks) {
    bf16x8 wf[2], vf[4];
#pragma unroll
    for (int tm = 0; tm < 2; ++tm) wf[tm] = *(const bf16x8*)(W + (size_t)(32 * w + tm * 16 + fr) * 128 + ks * 32 + 8 * fq);
#pragma unroll
    for (int dn = 0; dn < 4; ++dn) vf[dn] = *(const bf16x8*)(vT + (dn * 16 + fr) * 136 + ks * 32 + 8 * fq);
#pragma unroll
    for (int tm = 0; tm < 2; ++tm)
#pragma unroll
      for (int dn = 0; dn < 4; ++dn) acc[tm][dn] = mfma16(vf[dn], wf[tm], acc[tm][dn]);
  }
#pragma unroll
  for (int tm = 0; tm < 2; ++tm) {
    const int t = 32 * w + tm * 16 + fr;
    const float bias = P.sgu_b[(layer * 4 + g) * 128 + t];
#pragma unroll
    for (int dn = 0; dn < 4; ++dn) {
      const int d = dn * 16 + 4 * fq;
      const uint2 uu = *(const uint2*)(z + (size_t)(tok0 + t) * LDZ + ZC_AU + g * 64 + d);
      const float u0 = gelu_t(__uint_as_float(uu.x << 16)), u1 = gelu_t(__uint_as_float(uu.x & 0xffff0000u)),
                  u2 = gelu_t(__uint_as_float(uu.y << 16)), u3 = gelu_t(__uint_as_float(uu.y & 0xffff0000u));
      uint2 o; o.x = pk2(u0 * (acc[tm][dn][0] + bias), u1 * (acc[tm][dn][1] + bias)); o.y = pk2(u2 * (acc[tm][dn][2] + bias), u3 * (acc[tm][dn][3] + bias));
      *(uint2*)(y + (size_t)(tok0 + t) * 1024 + g * 64 + d) = o;
    }
  }
  __syncthreads();
}

__device__ __forceinline__ void mixB1_item(const Params& P, int layer, int idx, const bf16_t* z, float* hsl, float* Pc, float* carryP, float* carryH, char* lds) {
  const int c = idx & 63, g = (idx >> 6) & 3, b = idx >> 8;
  const int tid = HTID, lane = tid & 63, w = tid >> 6, fr = lane & 15, fq = lane >> 4;
  bf16_t* xcb = (bf16_t*)lds;
  float* xcf = (float*)(lds + 9216);
  float* aA = (float*)(lds + 9216 + 16384);
  float* bB = (float*)(lds + 9216 + 32768);
  float* sm = (float*)(lds + 9216 + 49152);
  const size_t tokb = (size_t)b * SEQ;
  {
    const int t = tid >> 2, q = tid & 3;
    float accv[16];
#pragma unroll
    for (int i = 0; i < 16; ++i) accv[i] = P.conv_b[layer * 256 + g * 64 + q * 16 + i];
#pragma unroll
    for (int k = 0; k < 4; ++k) {
      const int pos = c * 64 + t - 3 + k;
      if (pos >= 0) {
        const bf16_t* zr = z + (tokb + pos) * LDZ + ZC_BX + g * 64 + q * 16;
        float v[16]; unpack8(*(const u32x4*)zr, v); unpack8(*(const u32x4*)(zr + 8), v + 8);
        const float* cw = P.conv_w + (size_t)(layer * 4 + k) * 256 + g * 64 + q * 16;
#pragma unroll
        for (int i = 0; i < 16; ++i) accv[i] += v[i] * cw[i];
      }
    }
#pragma unroll
    for (int i = 0; i < 16; ++i) { xcf[t * 64 + q * 16 + i] = accv[i]; xcb[t * 72 + q * 16 + i] = f2bf(accv[i]); }
  }
  __syncthreads();
  {
    const bf16_t* wa = (const bf16_t*)(P.ws + OFF_WAT) + (layer * 4 + g) * 4096;
    const bf16_t* wx = (const bf16_t*)(P.ws + OFF_WXT) + (layer * 4 + g) * 4096;
    f32x4 ar[4] = {}, ai[4] = {};
#pragma unroll
    for (int ks = 0; ks < 2; ++ks) {
      const bf16x8 xf = *(const bf16x8*)(xcb + (16 * w + fr) * 72 + ks * 32 + 8 * fq);
#pragma unroll
      for (int jn = 0; jn < 4; ++jn) {
        const bf16x8 fa = *(const bf16x8*)(wa + (jn * 16 + fr) * 64 + ks * 32 + 8 * fq);
        const bf16x8 fx = *(const bf16x8*)(wx + (jn * 16 + fr) * 64 + ks * 32 + 8 * fq);
        ar[jn] = mfma16(fa, xf, ar[jn]); ai[jn] = mfma16(fx, xf, ai[jn]);
      }
    }
    const int t = 16 * w + fr;
#pragma unroll
    for (int jn = 0; jn < 4; ++jn)
#pragma unroll
      for (int e = 0; e < 4; ++e) {
        const int j = jn * 16 + 4 * fq + e, ch = layer * 256 + g * 64 + j;
        const float r = sigm(ar[jn][e] + P.lru_ba[ch]), ig = sigm(ai[jn][e] + P.lru_bx[ch]);
        const float lam = P.lru_lam[ch];
        const float xe = __expf(-lam);
        float m8; asm volatile("v_mov_b32 %0, 0xc1000000" : "=v"(m8));
        const float la = m8 * r * (xe * (1.f - xe * (0.5f - xe * (1.f / 3.f))));
        const float av = __expf(la);
        const float y2 = 2.f * la;
        const float om = -y2 * (1.f + y2 * (0.5f + y2 * ((1.f / 6.f) + y2 * ((1.f / 24.f) + y2 * ((1.f / 120.f) + y2 * (1.f / 720.f))))));
        const float bv = sqrtf(om) * (ig * xcf[t * 64 + j]);
        aA[t * 64 + j] = av; bB[t * 64 + j] = bv;
      }
  }
  __syncthreads();
  {
    const int q = tid >> 6, j = tid & 63;
    float Pq = 1.f, hq = 0.f;
#pragma unroll
    for (int i = 0; i < 16; ++i) { const int t = q * 16 + i; const float av = aA[t * 64 + j], bv = bB[t * 64 + j]; hq = av * hq + bv; Pq *= av; aA[t * 64 + j] = Pq; bB[t * 64 + j] = hq; }
    sm[q * 64 + j] = Pq; sm[256 + q * 64 + j] = hq;
    __syncthreads();
    float Pin = 1.f, Hin = 0.f;
    for (int qq = 0; qq < q; ++qq) { const float pp = sm[qq * 64 + j], hh = sm[256 + qq * 64 + j]; Hin = pp * Hin + hh; Pin *= pp; }
    float hl = 0.f, pl = 1.f;
#pragma unroll
    for (int i = 0; i < 16; ++i) { const int t = q * 16 + i; hl = bB[t * 64 + j] + aA[t * 64 + j] * Hin; pl = aA[t * 64 + j] * Pin;
      const size_t o = (tokb + c * 64 + t) * 256 + g * 64 + j; hsl[o] = hl; Pc[o] = pl; }
    if (q == 3) { const int o = ((b * 4 + g) * 64 + c) * 64 + j; carryP[o] = pl; carryH[o] = hl; }
  }
  __syncthreads();
}

__device__ __forceinline__ void mixB2_item(int idx, const bf16_t* z, const float* hsl, const float* Pc, const float* carryP, const float* carryH, bf16_t* y) {
  const int c = idx & 63, g = (idx >> 6) & 3, b = idx >> 8;
  const int q = HTID >> 6, j = HTID & 63;
  const float* cp = carryP + (size_t)((b * 4 + g) * 64) * 64 + j;
  const float* chh = carryH + (size_t)((b * 4 + g) * 64) * 64 + j;
  float H = 0.f;
  for (int c0 = 0; c0 < c; c0 += 8) {
    float pv[8], hv[8];
#pragma unroll
    for (int i = 0; i < 8; ++i) { const bool ok = c0 + i < c; pv[i] = ok ? cp[(c0 + i) * 64] : 1.f; hv[i] = ok ? chh[(c0 + i) * 64] : 0.f; }
#pragma unroll
    for (int i = 0; i < 8; ++i) H = pv[i] * H + hv[i];
  }
  const size_t tokb = (size_t)b * SEQ + c * 64 + q * 16;
#pragma unroll 4
  for (int i = 0; i < 16; ++i) {
    const size_t o = (tokb + i) * 256 + g * 64 + j;
    const float h = hsl[o] + Pc[o] * H;
    const float gt = bf2f(z[(tokb + i) * LDZ + ZC_BG + g * 64 + j]);
    y[(tokb + i) * 1024 + 256 + g * 64 + j] = f2bf(h * gelu_t(gt));
  }
}

__device__ __forceinline__ void compress_item(const Params& P, int layer, int idx, const bf16_t* z, bf16_t* kcv, char* lds) {
  const int nb = idx & 7, g = (idx >> 3) & 1, b = (idx >> 4) & 7, kv = idx >> 7;
  const int tid = HTID, lane = tid & 63, w = tid >> 6, fr = lane & 15, fq = lane >> 4;
  const int n0 = nb * 32, col = (kv ? ZC_VC : ZC_KC) + g * 64;
  const bf16_t* w1t = (const bf16_t*)(P.ws + OFF_CW1 + (size_t)(layer * 2 + kv) * SZ_CW1);
  float* hid = (float*)lds;
  f32x4 acc[2][2] = {};
  const bf16_t* zb[2]; const bf16_t* wb[2];
#pragma unroll
  for (int nf = 0; nf < 2; ++nf) { int n = n0 + nf * 16 + fr; if (n > 254) n = 254; zb[nf] = z + ((size_t)b * SEQ + 16 * n) * LDZ + col + 8 * fq; }
#pragma unroll
  for (int jf = 0; jf < 2; ++jf) wb[jf] = w1t + (size_t)(32 * w + jf * 16 + fr) * 2048 + 8 * fq;
#pragma unroll 4
  for (int ks = 0; ks < 64; ++ks) {
    const int l = ks >> 1, d0 = (ks & 1) * 32;
    bf16x8 xf[2], wf[2];
#pragma unroll
    for (int nf = 0; nf < 2; ++nf) xf[nf] = *(const bf16x8*)(zb[nf] + (size_t)l * LDZ + d0);
#pragma unroll
    for (int jf = 0; jf < 2; ++jf) wf[jf] = *(const bf16x8*)(wb[jf] + ks * 32);
#pragma unroll
    for (int jf = 0; jf < 2; ++jf)
#pragma unroll
      for (int nf = 0; nf < 2; ++nf) acc[jf][nf] = mfma16(wf[jf], xf[nf], acc[jf][nf]);
  }
  const float* cb1 = (const float*)(P.ws + OFF_CB1) + (layer * 2 + kv) * 128;
#pragma unroll
  for (int jf = 0; jf < 2; ++jf)
#pragma unroll
    for (int nf = 0; nf < 2; ++nf)
#pragma unroll
      for (int e = 0; e < 4; ++e) { const int j = 32 * w + jf * 16 + 4 * fq + e; hid[(nf * 16 + fr) * 129 + j] = gelu_t(acc[jf][nf][e] + cb1[j]); }
  __syncthreads();
  {
    const int n = tid >> 3, d0 = (tid & 7) * 8;
    const float* w2 = P.cmp_w2 + (size_t)(layer * 2 + kv) * 128 * 64 + d0;
    const float* b2 = P.cmp_b2 + (layer * 2 + kv) * 64 + d0;
    float o[8];
#pragma unroll
    for (int e = 0; e < 8; ++e) o[e] = b2[e];
    for (int j = 0; j < 128; ++j) {
      const float hv = hid[n * 129 + j]; const float4 wa = *(const float4*)(w2 + j * 64), wb2 = *(const float4*)(w2 + j * 64 + 4);
      o[0] += hv * wa.x; o[1] += hv * wa.y; o[2] += hv * wa.z; o[3] += hv * wa.w; o[4] += hv * wb2.x; o[5] += hv * wb2.y; o[6] += hv * wb2.z; o[7] += hv * wb2.w;
    }
    const bool valid = (n0 + n) < 255;
    uint4 ov = make_uint4(pk2(o[0], o[1]), pk2(o[2], o[3]), pk2(o[4], o[5]), pk2(o[6], o[7]));
    if (!valid) { ov.x = 0u; ov.y = 0u; ov.z = 0u; ov.w = 0u; }
    *(uint4*)(kcv + ((size_t)((kv * 8 + b) * 2 + g) * 256 + n0 + n) * 64 + d0) = ov;
  }
  __syncthreads();
}

constexpr int NSA_KT = 0, NSA_VT = 16384, NSA_T = 33792, NSA_TW = NSA_T + 4 * 4160 * 4, NSA_IMP = NSA_TW + 4 * 640 * 4, NSA_WU = NSA_IMP + 2 * 16640;
constexpr int LDS_ST = 147456;
constexpr float LOG2E = 1.4426950408889634f;

__device__ __forceinline__ void nsa_tables(const Params& P, int g, char* lds) {
  float* T = (float*)(lds + NSA_T);
  float* TW = (float*)(lds + NSA_TW);
  const int tid = TIDX;
  for (int i = tid; i < 4160; i += 512) {
    const int n = i - 64;
    int bk = n;
    if (n >= 16) bk = 16 + (n >= 21) + (n >= 27) + (n >= 35) + (n >= 46) + (n >= 59) + (n >= 77) + (n >= 99) + (n >= 128) + (n >= 166) + (n >= 216) + (n >= 280) + (n >= 363) + (n >= 470) + (n >= 609) + (n >= 790);
#pragma unroll
    for (int r = 0; r < 4; ++r) {
      const float v = n >= 0 ? P.rel_bias[bk * 8 + g * 4 + r] * LOG2E : -__builtin_inff();
      T[r * 4160 + i] = v;
      if (i < 640) TW[r * 640 + i] = (n < 512) ? v : -__builtin_inff();
    }
  }
  __syncthreads();
}

struct KVRegs { u32x4 k0, v0; };
__device__ __forceinline__ void kv_gload(KVRegs& r, const bf16_t* kb, const bf16_t* vb, size_t stride) {
  const int tid = TIDX, row = tid >> 3, cq = tid & 7;
  r.k0 = *(const u32x4*)(kb + row * stride + cq * 8); r.v0 = *(const u32x4*)(vb + row * stride + cq * 8);
}
__device__ __forceinline__ void kv_lwrite(const KVRegs& r, char* lds, int buf) {
  const int tid = TIDX, row = tid >> 3, cq = tid & 7;
  char* kt = lds + NSA_KT + buf * 8192 + row * 128;
  *(u32x4*)(kt + ((cq ^ (row & 7)) << 4)) = r.k0;
  bf16_t* vt = (bf16_t*)(lds + NSA_VT + buf * 8704) + (cq * 8) * 68 + row;
#pragma unroll
  for (int i = 0; i < 4; ++i) { vt[(2 * i) * 68] = (bf16_t)(r.v0[i] & 0xffffu); vt[(2 * i + 1) * 68] = (bf16_t)(r.v0[i] >> 16); }
}

template <int MODE>
__device__ __forceinline__ void nsa_compute(int cur, int buf, int t, int hl, u64 mymask, const bf16x8 (&Qf)[2][2], f32x4 (&O)[4][2], float (&m)[2], float (&l)[2],
                                            const float (&inv)[2], float* impw, char* lds) {
  const int lane = TIDX & 63, fr = lane & 15, fq = lane >> 4;
  const char* kt = lds + NSA_KT + buf * 8192;
  const bf16_t* vt = (const bf16_t*)(lds + NSA_VT + buf * 8704);
  const bool selok = (MODE == 2) ? (((mymask >> cur) & 1ull) != 0ull) : true;
  const float* tb = (MODE == 3) ? (const float*)(lds + NSA_TW) + hl * 640 : (const float*)(lds + NSA_T) + hl * 4160;
  constexpr int TS = (MODE == 3) ? 640 : 4160;
  const int base = (MODE <= 1) ? (t - 31 - 16 * (cur * 64 + 4 * fq) + 64) : (t - cur * 64 - 4 * fq + 64);
#pragma unroll
  for (int s2 = 0; s2 < 2; ++s2) {
    f32x4 S[2][2];
    S[0][0] = zero4(); S[0][1] = zero4(); S[1][0] = zero4(); S[1][1] = zero4();
#pragma unroll
    for (int ks = 0; ks < 2; ++ks)
#pragma unroll
      for (int kk = 0; kk < 2; ++kk) {
        const bf16x8 kf = *(const bf16x8*)(kt + (32 * s2 + 16 * kk + fr) * 128 + (((ks * 4 + fq) ^ (fr & 7)) << 4));
#pragma unroll
        for (int r = 0; r < 2; ++r) S[kk][r] = mfma16(kf, Qf[r][ks], S[kk][r]);
      }
    bf16x8 Pf[2];
    float g1s[2] = {0.f, 0.f}, p3s[2] = {0.f, 0.f};
#pragma unroll
    for (int r = 0; r < 2; ++r) {
      float sv[2][4];
#pragma unroll
      for (int kk = 0; kk < 2; ++kk)
#pragma unroll
        for (int e = 0; e < 4; ++e) {
          const int off = 32 * s2 + 16 * kk + e;
          int idx;
          if (MODE <= 1) { idx = base - 16 * off; idx = idx > 0 ? idx : 0; } else idx = base - off;
          sv[kk][e] = S[kk][r][e] * (0.125f * LOG2E) + tb[r * TS + idx];
        }
      float pv[2][4];
      if (MODE == 1) {
#pragma unroll
        for (int kk = 0; kk < 2; ++kk)
#pragma unroll
          for (int e = 0; e < 4; ++e) pv[kk][e] = __builtin_amdgcn_exp2f(sv[kk][e] - m[r]) * inv[r];
#pragma unroll
        for (int kk = 0; kk < 2; ++kk) { g1s[kk] += pv[kk][0] + pv[kk][1] + pv[kk][2] + 0.5f * pv[kk][3]; p3s[kk] += 0.5f * pv[kk][3]; }
      } else {
        float mx = fmaxf(fmaxf(fmaxf(sv[0][0], sv[0][1]), fmaxf(sv[0][2], sv[0][3])), fmaxf(fmaxf(sv[1][0], sv[1][1]), fmaxf(sv[1][2], sv[1][3])));
        if (MODE == 2) mx = selok ? mx : -__builtin_inff();
        if (__any(mx > m[r] + 8.0f)) {
          mx = fmaxf(mx, __shfl_xor(mx, 16)); mx = fmaxf(mx, __shfl_xor(mx, 32));
          const float mn = fmaxf(m[r], mx), al = __builtin_amdgcn_exp2f(m[r] - mn);
          m[r] = mn; l[r] *= al;
          if (MODE != 0) {
#pragma unroll
            for (int df = 0; df < 4; ++df) O[df][r] *= al;
          }
        }
        const float me = (MODE == 2) ? (selok ? m[r] : __builtin_inff()) : m[r];
        float ps = 0.f;
#pragma unroll
        for (int kk = 0; kk < 2; ++kk)
#pragma unroll
          for (int e = 0; e < 4; ++e) { pv[kk][e] = __builtin_amdgcn_exp2f(sv[kk][e] - me); ps += pv[kk][e]; }
        l[r] += ps;
      }
      if (MODE != 0) {
        const unsigned w0 = pk2(pv[0][0], pv[0][1]), w1 = pk2(pv[0][2], pv[0][3]), w2 = pk2(pv[1][0], pv[1][1]), w3 = pk2(pv[1][2], pv[1][3]);
        u32x4 pw; pw.x = w0; pw.y = w1; pw.z = w2; pw.w = w3;
        Pf[r] = __builtin_bit_cast(bf16x8, pw);
      }
    }
    if (MODE != 0) {
#pragma unroll
      for (int df = 0; df < 4; ++df) {
        const bf16x4 va = *(const bf16x4*)(vt + (df * 16 + fr) * 68 + 32 * s2 + 4 * fq);
        const bf16x4 vb = *(const bf16x4*)(vt + (df * 16 + fr) * 68 + 32 * s2 + 16 + 4 * fq);
        bf16x8 vf; vf[0] = va[0]; vf[1] = va[1]; vf[2] = va[2]; vf[3] = va[3]; vf[4] = vb[0]; vf[5] = vb[1]; vf[6] = vb[2]; vf[7] = vb[3];
#pragma unroll
        for (int r = 0; r < 2; ++r) O[df][r] = mfma16(vf, Pf[r], O[df][r]);
      }
    }
    if (MODE == 1) {
#pragma unroll
      for (int kk = 0; kk < 2; ++kk) {
        const int j = cur * 16 + (2 * s2 + kk) * 4 + fq;
        atomicAdd(&impw[fr * 65 + j], g1s[kk]);
        if (j + 1 < 64) atomicAdd(&impw[fr * 65 + j + 1], p3s[kk]);
      }
    }
  }
}

template <int MODE>
__device__ __forceinline__ void nsa_branch(int first, int ntl, u64 U, const bf16_t* kbase, const bf16_t* vbase, size_t stride, int t, int hl, u64 mymask,
                                           const bf16x8 (&Qf)[2][2], f32x4 (&O)[4][2], float (&m)[2], float (&l)[2], const float (&inv)[2], float* impw, char* lds) {
  KVRegs R0, R1, R2;
  u64 rem = U;
  int seq = first, left = ntl;
#define NSA_NEXT(dst)                                                                                     \
  { if (MODE == 2) { dst = rem ? (int)__builtin_ctzll(rem) : -1; if (rem) rem &= rem - 1; }              \
    else { dst = left > 0 ? seq : -1; ++seq; --left; } }
#define NSA_GLOAD(R, ti) kv_gload(R, kbase + (size_t)(ti) * 64 * stride, vbase + (size_t)(ti) * 64 * stride, stride)
  int tcur, t1, t2, t3;
  NSA_NEXT(tcur); NSA_NEXT(t1); NSA_NEXT(t2);
  if (tcur >= 0) NSA_GLOAD(R0, tcur);
  if (t1 >= 0) NSA_GLOAD(R1, t1);
  if (t2 >= 0) NSA_GLOAD(R2, t2);
  if (tcur >= 0) kv_lwrite(R0, lds, 0);
  __syncthreads();
  NSA_NEXT(t3);
  if (t3 >= 0) NSA_GLOAD(R0, t3);
  int buf = 0;
#define NSA_STEP(RW)                                                                                      \
  if (tcur < 0) break;                                                                                    \
  nsa_compute<MODE>(tcur, buf, t, hl, mymask, Qf, O, m, l, inv, impw, lds);                               \
  if (t1 >= 0) kv_lwrite(RW, lds, buf ^ 1);                                                               \
  __syncthreads();                                                                                        \
  buf ^= 1; tcur = t1; t1 = t2; t2 = t3;                                                                  \
  NSA_NEXT(t3);                                                                                           \
  if (t3 >= 0) NSA_GLOAD(RW, t3);
  for (;;) {
    NSA_STEP(R1)
    NSA_STEP(R2)
    NSA_STEP(R0)
  }
#undef NSA_STEP
#undef NSA_GLOAD
#undef NSA_NEXT
}

#define NSA_RESET()                                                                         \
  _Pragma("unroll") for (int r = 0; r < 2; ++r) { asm volatile("v_mov_b32 %0, 0xf149f2ca" : "=v"(m[r])); l[r] = 0.f; }               \
  _Pragma("unroll") for (int df = 0; df < 4; ++df) _Pragma("unroll") for (int r = 0; r < 2; ++r) O[df][r] = zero4();

__device__ __forceinline__ void nsa_item(const Params& P, int b, int g, int c, const bf16_t* z, const bf16_t* kcv, bf16_t* y, char* lds) {
  const int tid = TIDX, lane = tid & 63, w8 = tid >> 6, qg = w8 & 3, hp = w8 >> 2, fr = lane & 15, fq = lane >> 4;
  const size_t tokb = (size_t)b * SEQ;
  const int t = c * 64 + 16 * qg + fr;
  const bf16_t* zq = z + (tokb + t) * LDZ;
  const int hb = g * 4 + hp * 2;
  bf16x8 Qf[2][2];
#pragma unroll
  for (int r = 0; r < 2; ++r)
#pragma unroll
    for (int ks = 0; ks < 2; ++ks) Qf[r][ks] = *(const bf16x8*)(zq + ZC_Q + g * 256 + (hp * 2 + r) * 64 + ks * 32 + 8 * fq);
  float* impw = (float*)(lds + NSA_IMP) + (hp * 4 + qg) * (16 * 65);
  for (int i = lane; i < 16 * 65; i += 64) impw[i] = 0.f;
  f32x4 O[4][2];
  float m[2], l[2], inv[2];
  bf16_t* yo = y + (tokb + t) * 1024 + 512 + g * 256 + hp * 128 + 4 * fq;
  const bf16_t* kc = kcv + (size_t)((0 * 8 + b) * 2 + g) * 256 * 64;
  const bf16_t* vc = kcv + (size_t)((1 * 8 + b) * 2 + g) * 256 * 64;
  const int nct = ((4 * c + 2) >> 6) + 1;
  NSA_RESET();
  inv[0] = 0.f; inv[1] = 0.f;
  nsa_branch<0>(0, nct, 0ull, kc, vc, 64, t, hp * 2, 0ull, Qf, O, m, l, inv, impw, lds);
#pragma unroll
  for (int r = 0; r < 2; ++r) { float lt = l[r]; lt += __shfl_xor(lt, 16); lt += __shfl_xor(lt, 32); inv[r] = lt > 0.f ? 1.f / lt : 0.f; }
  nsa_branch<1>(0, nct, 0ull, kc, vc, 64, t, hp * 2, 0ull, Qf, O, m, l, inv, impw, lds);
#pragma unroll
  for (int r = 0; r < 2; ++r) {
    const float gt = sigm(bf2f(zq[ZC_GC + hb + r]));
#pragma unroll
    for (int df = 0; df < 4; ++df) { u32x2 o; o.x = pk2(O[df][r][0] * gt, O[df][r][1] * gt); o.y = pk2(O[df][r][2] * gt, O[df][r][3] * gt); *(u32x2*)(yo + r * 64 + df * 16) = o; }
  }
  __syncthreads();
  u64 mymask = 0ull, wU = 0ull;
  const float* imp0 = (const float*)(lds + NSA_IMP) + qg * (16 * 65);
  const float* imp1 = imp0 + 4 * (16 * 65);
  for (int qq = 0; qq < 16; ++qq) {
    const float sv = imp0[qq * 65 + lane] + imp1[qq * 65 + lane];
    const int j = lane;
    const bool forced = (j == 0) | (j == c) | (j == c - 1);
    const float sc = (j <= c) ? (forced ? 1e4f : sv) : -1.0f;
    int rank = 0;
#pragma unroll 16
    for (int k = 0; k < 64; ++k) { const float sk = __int_as_float(__builtin_amdgcn_readlane(__float_as_int(sc), k)); rank += ((sk > sc) || (sk == sc && k < j)) ? 1 : 0; }
    const bool sel = (rank < 16) && (sc >= 0.f);
    const u64 mk = __ballot(sel);
    if (fr == qq) mymask = mk;
    wU |= mk;
  }
  u64* WU = (u64*)(lds + NSA_WU);
  if (lane == 0) WU[w8] = wU;
  __syncthreads();
  const u64 U = WU[0] | WU[1] | WU[2] | WU[3];
  for (int br = 0; br < 2; ++br) {
    NSA_RESET();
    int zg;
    if (br == 0) {
      nsa_branch<2>(0, 0, U, z + tokb * LDZ + ZC_KS + g * 64, z + tokb * LDZ + ZC_VS + g * 64, LDZ, t, hp * 2, mymask, Qf, O, m, l, inv, impw, lds);
      zg = ZC_GS;
    } else {
      const int kt0 = c > 8 ? c - 8 : 0;
      nsa_branch<3>(kt0, c - kt0 + 1, 0ull, z + tokb * LDZ + ZC_KW + g * 64, z + tokb * LDZ + ZC_VW + g * 64, LDZ, t, hp * 2, 0ull, Qf, O, m, l, inv, impw, lds);
      zg = ZC_GW;
    }
#pragma unroll
    for (int r = 0; r < 2; ++r) {
      float lt = l[r]; lt += __shfl_xor(lt, 16); lt += __shfl_xor(lt, 32);
      const float gt = sigm(bf2f(zq[zg + hb + r])) * (lt > 0.f ? 1.f / lt : 0.f);
#pragma unroll
      for (int df = 0; df < 4; ++df) {
        bf16_t* yp = yo + r * 64 + df * 16;
        const u32x2 pr = *(const u32x2*)yp;
        u32x2 o; o.x = pk2(__uint_as_float(pr.x << 16) + O[df][r][0] * gt, __uint_as_float(pr.x & 0xffff0000u) + O[df][r][1] * gt);
        o.y = pk2(__uint_as_float(pr.y << 16) + O[df][r][2] * gt, __uint_as_float(pr.y & 0xffff0000u) + O[df][r][3] * gt);
        *(u32x2*)yp = o;
      }
    }
  }
  __syncthreads();
}

__device__ __forceinline__ void run_phase(const Params& P, int ph, char* lds) {
  char* ws = P.ws;
  asm volatile("" : "+s"(ws));
  bf16_t* abuf = (bf16_t*)(ws + OFF_A);
  bf16_t* big = (bf16_t*)(ws + OFF_BIG);
  bf16_t* fbuf = (bf16_t*)(ws + OFF_F);
  float* hsl = (float*)(ws + OFF_F); float* Pc = hsl + (size_t)M_TOK * 256;
  bf16_t* kcv = (bf16_t*)(ws + OFF_KC);
  float* carryP = (float*)(ws + OFF_CARRY); float* carryH = carryP + 8 * 4 * 64 * 64;
  if (ph == 0) { prep_phase(P, lds); return; }
  const int layer = (ph - 1) / 13, sp = (ph - 1) % 13;
  const float* ng = P.norm_g + (size_t)layer * 8 * 1024;
#ifdef ONLY_SP
  if (sp != ONLY_SP) return;
#endif
  switch (sp) {
    case 0: case 8: {
      const int lj = layer * 2 + (sp == 8);
      gemm_up_phase(abuf, (const bf16_t*)(ws + OFF_WGU + lj * SZ_WGU), big, lds);
    } break;
    case 1: case 9: {
      const int lj = layer * 2 + (sp == 9);
      gemm_bf16_phase(big, DFF, (const bf16_t*)(ws + OFF_WD + lj * SZ_WD), DFF, 4, fbuf, 1024, lds);
    } break;
    case 2: resnorm_phase(layer == 0 ? P.x : P.out, P.out, fbuf, 0.5f, ng + 1 * 1024, ng + 2 * 1024, abuf); break;
    case 3: gemm_bf16_phase(abuf, 1024, (const bf16_t*)(ws + OFF_WIN + layer * SZ_WIN), 1024, LDZ / 256, big, LDZ, lds); break;
    case 4: {
      const int hb = HBLK; char* hl = lds + hb * 65536;
      for (int it = blockIdx.x * 2 + hb; it < 256; it += gridDim.x * 2) compress_item(P, layer, it, big, kcv, hl);
      for (int it = blockIdx.x * 2 + hb; it < 1024; it += gridDim.x * 2) mixA_item(P, layer, it, big, abuf, hl);
      for (int it = blockIdx.x * 2 + hb; it < 2048; it += gridDim.x * 2) mixB1_item(P, layer, it, big, hsl, Pc, carryP, carryH, hl);
    } break;
    case 5: {
      nsa_tables(P, blockIdx.x & 1, lds);
      for (int it = blockIdx.x; it < 1024; it += gridDim.x) {
        const int rnd = it / 256, pos = it % 256;
        const int c = (rnd & 1) ? (rnd >> 1) * 16 + (pos >> 4) : 63 - (rnd >> 1) * 16 - (pos >> 4);
        const int bg = pos & 15;
        nsa_item(P, bg >> 1, bg & 1, c, big, kcv, abuf, lds);
      }
      const int hb = HBLK;
      for (int it = blockIdx.x * 2 + hb; it < 2048; it += gridDim.x * 2) mixB2_item(it, big, hsl, Pc, carryP, carryH, abuf);
    } break;
    case 6: gemm_bf16_phase(abuf, 1024, (const bf16_t*)(ws + OFF_WOUT + layer * SZ_SQ), 1024, 4, fbuf, 1024, lds); break;
    case 7: resnorm_phase(P.out, P.out, fbuf, 1.0f, ng + 3 * 1024, ng + 4 * 1024, abuf); break;
    case 10:
      gemm_bf16_phase((const bf16_t*)(ws + OFF_PBF) + (size_t)layer * M_TOK * 256, 256, (const bf16_t*)(ws + OFF_WPP + layer * SZ_WPP), 256, 4, big, 1024, lds);
      resnorm_phase(P.out, P.out, fbuf, 0.5f, ng + 5 * 1024, ng + 6 * 1024, abuf);
      break;
    case 11: gemm_ple_phase(abuf, (const bf16_t*)(ws + OFF_WPG + layer * SZ_SQ), big, fbuf, lds); break;
    case 12: resnorm_phase(P.out, P.out, fbuf, 1.0f, ng + 7 * 1024, layer == 0 ? P.norm_g + 8 * 1024 : nullptr, layer == 0 ? abuf : nullptr); break;
  }
}

#define XB_TMO      128
#define XB_XCNT(j)  (256  + 64 * (j))
#define XB_XSUB(j)  (1280 + 64 * (j))
#define XB_XGEN(j)  (2304 + 64 * (j))
#define XB_TOP      3328
#define XB_TOPGEN   3392
#define XCD_BAR_WORDS 3456
#define XB_SPIN_CAP (1u << 20)
#define LAS __attribute__((address_space(3)))
__device__ __forceinline__ unsigned xb_ld(unsigned* p)              { return __hip_atomic_load(p, __ATOMIC_RELAXED, __HIP_MEMORY_SCOPE_AGENT); }
__device__ __forceinline__ unsigned xb_add(unsigned* p, unsigned v) { return __hip_atomic_fetch_add(p, v, __ATOMIC_RELAXED, __HIP_MEMORY_SCOPE_AGENT); }
__device__ __forceinline__ unsigned xb_xcc_id() { return (unsigned)__builtin_amdgcn_s_getreg((3 << 11) | 20) & 0xFu; }
#define XB_SPIN(cond, bar) do { unsigned _sp = 0; while (cond) { __builtin_amdgcn_s_sleep(1); \
    if ((++_sp & 255u) == 0u) { if (xb_ld(&(bar)[XB_TMO])) break; if (_sp > XB_SPIN_CAP) { atomicAdd(&(bar)[XB_TMO], 1u); break; } } } } while (0)
struct XcdBarrier { unsigned* bar; unsigned x; volatile LAS unsigned* st; };
__device__ __forceinline__ XcdBarrier xcd_barrier_post(unsigned* bar, volatile LAS unsigned* st) {
    XcdBarrier b; b.bar = bar; b.x = xb_xcc_id(); b.st = st;
    if (threadIdx.x == 0) (void)xb_add(&bar[XB_XCNT(b.x)], 1u);
    return b;
}
__device__ __forceinline__ void xcd_barrier_complete(unsigned* bar, unsigned x, unsigned& nloc, unsigned& nx) {
    const unsigned G = gridDim.x * gridDim.y * gridDim.z;
    unsigned sum, cnt, mine, sp = 0u;
    for (;;) {
        sum = 0u; cnt = 0u; mine = 0u;
#pragma unroll
        for (unsigned j = 0; j < 16; ++j) { const unsigned c = xb_ld(&bar[XB_XCNT(j)]); sum += c; cnt += (c > 0u) ? 1u : 0u; mine = (j == x) ? c : mine; }
        if (sum == G) break;
        __builtin_amdgcn_s_sleep(1);
        if ((++sp & 255u) == 0u) { if (xb_ld(&bar[XB_TMO])) break; if (sp > XB_SPIN_CAP) { atomicAdd(&bar[XB_TMO], 1u); break; } }
    }
    nloc = mine > 0u ? mine : 1u; nx = cnt > 0u ? cnt : 1u;
}
__device__ __forceinline__ void xcd_barrier(const XcdBarrier& b) {
    asm volatile("s_waitcnt vmcnt(0)" ::: "memory");
    __syncthreads();
    if (threadIdx.x == 0) {
        unsigned* bar = b.bar;
        __builtin_amdgcn_s_waitcnt(0);
        unsigned nloc = b.st[0], nx = b.st[1];
        if (nloc == 0u) { xcd_barrier_complete(bar, b.x, nloc, nx); b.st[0] = nloc; b.st[1] = nx; }
        const unsigned old = xb_add(&bar[XB_XSUB(b.x)], 1u);
        const unsigned gen = old / nloc;
        if (old + 1u == (gen + 1u) * nloc) {
            __builtin_amdgcn_fence(__ATOMIC_RELEASE, "agent");
            asm volatile("s_waitcnt vmcnt(0)" ::: "memory");
            const unsigned og = xb_add(&bar[XB_TOP], 1u);
            const unsigned tg = og / nx;
            if (og + 1u == (tg + 1u) * nx) xb_add(&bar[XB_TOPGEN], 1u);
            else XB_SPIN(xb_ld(&bar[XB_TOPGEN]) == tg, bar);
            __builtin_amdgcn_fence(__ATOMIC_ACQUIRE, "agent");
            xb_add(&bar[XB_XGEN(b.x)], 1u);
            asm volatile("s_waitcnt vmcnt(0)" ::: "memory");
        } else {
            XB_SPIN(xb_ld(&bar[XB_XGEN(b.x)]) == gen, bar);
            __builtin_amdgcn_fence(__ATOMIC_ACQUIRE, "agent");
            asm volatile("s_waitcnt vmcnt(0)" ::: "memory");
        }
    }
    __syncthreads();
}

constexpr int LDS_BYTES = LDS_ST + 16;
__global__ void __launch_bounds__(512, 2) fwd_megakernel(Params P) {
  __shared__ __attribute__((aligned(16))) char lds[LDS_BYTES];
  cg::grid_group grid = cg::this_grid();
  volatile LAS unsigned* st = (volatile LAS unsigned*)(lds + LDS_ST);
  if (threadIdx.x == 0) { st[0] = 0u; st[1] = 0u; }
  __syncthreads();
  XcdBarrier xb = xcd_barrier_post((unsigned*)(P.ws + OFF_BAR), st);
  if (P.ws == nullptr) grid.sync();
  for (int ph = 0; ph < NPHASE; ++ph) {
    run_phase(P, ph, lds);
    if (ph + 1 < NPHASE) xcd_barrier(xb);
  }
}

__global__ void __launch_bounds__(512, 2) phase_kernel(Params P, int ph) {
  __shared__ __attribute__((aligned(16))) char lds[LDS_BYTES];
  run_phase(P, ph, lds);
}

extern "C" void kernel_launch(void* const* d_in, const int* in_sizes, int n_in, void* d_out, int out_size, void* d_ws, size_t ws_size, hipStream_t stream) {
  Params P{};
  const float** pp = (const float**)&P;
  for (int i = 0; i < 26; ++i) pp[i] = (const float*)d_in[i];
  P.out = (float*)d_out;
  P.ws = (char*)d_ws;
  if (ws_size < WS_NEED) { fprintf(stderr, "workspace too small: %zu < %zu\n", ws_size, (size_t)WS_NEED); return; }
#if MK_FUSED
  static int grid_blocks = 0;
  if (!grid_blocks) {
    int dev = 0, cus = 0, per_cu = 0;
    (void)hipGetDevice(&dev);
    (void)hipDeviceGetAttribute(&cus, hipDeviceAttributeMultiprocessorCount, dev);
    (void)hipOccupancyMaxActiveBlocksPerMultiprocessor(&per_cu, fwd_megakernel, 512, 0);
    if (per_cu > 1) per_cu = 1;
    if (per_cu < 1) per_cu = 1;
    grid_blocks = cus * per_cu;
  }
  (void)hipMemsetAsync((char*)d_ws + OFF_BAR, 0, XCD_BAR_WORDS * 4, stream);
  void* args[] = {&P};
  hipError_t e = hipLaunchCooperativeKernel((void*)fwd_megakernel, dim3(grid_blocks), dim3(512), args, 0, stream);
  if (e != hipSuccess) fprintf(stderr, "cooperative launch failed: %s (grid %d)\n", hipGetErrorString(e), grid_blocks);
#else
  for (int ph = 0; ph < NPHASE; ++ph) phase_kernel<<<256, 512, 0, stream>>>(P, ph);
#endif
}
```

```cpp
#include <hip/hip_runtime.h>
#include <hip/hip_cooperative_groups.h>
#include <cstdint>
#include <cstdio>
namespace cg = cooperative_groups;

#ifndef MK_FUSED
#define MK_FUSED 1
#endif

typedef unsigned short bf16_t;
typedef short bf16x8 __attribute__((ext_vector_type(8)));
typedef short bf16x4 __attribute__((ext_vector_type(4)));
typedef float f32x4 __attribute__((ext_vector_type(4)));
typedef unsigned long long u64;
typedef unsigned u32x4 __attribute__((ext_vector_type(4)));
typedef unsigned u32x2 __attribute__((ext_vector_type(2)));

constexpr int M_TOK = 32768, DM = 1024, DFF = 2816, NGU = 5632, NIN = 2328, LDZ = 2560, SEQ = 4096;
constexpr int NPHASE = 27;
constexpr int ZC_AU = 0, ZC_AV = 256, ZC_BX = 512, ZC_BG = 768, ZC_Q = 1024, ZC_KC = 1536, ZC_VC = 1664, ZC_KS = 1792, ZC_VS = 1920,
              ZC_KW = 2048, ZC_VW = 2176, ZC_GC = 2304, ZC_GS = 2312, ZC_GW = 2320;

constexpr size_t SZ_WGU = (size_t)NGU * 1024 * 2, SZ_WD = (size_t)1024 * DFF * 2, SZ_WIN = (size_t)LDZ * 1024 * 2, SZ_SQ = (size_t)1024 * 1024 * 2,
                 SZ_WPP = (size_t)1024 * 256 * 2, SZ_CW1 = (size_t)128 * 2048 * 2;
constexpr size_t OFF_WGU = 0;
constexpr size_t OFF_WD = OFF_WGU + 4 * SZ_WGU;
constexpr size_t OFF_WIN = OFF_WD + 4 * SZ_WD;
constexpr size_t OFF_WOUT = OFF_WIN + 2 * SZ_WIN;
constexpr size_t OFF_WPG = OFF_WOUT + 2 * SZ_SQ;
constexpr size_t OFF_WPP = OFF_WPG + 2 * SZ_SQ;
constexpr size_t OFF_CW1 = OFF_WPP + 2 * SZ_WPP;
constexpr size_t OFF_CB1 = OFF_CW1 + 4 * SZ_CW1;
constexpr size_t OFF_SGUW = OFF_CB1 + 4096;
constexpr size_t OFF_WAT = OFF_SGUW + 2 * 4 * 128 * 128 * 2;
constexpr size_t OFF_WXT = OFF_WAT + 2 * 4 * 64 * 64 * 2;
constexpr size_t OFF_PBF = OFF_WXT + 2 * 4 * 64 * 64 * 2;
constexpr size_t OFF_A = OFF_PBF + (size_t)2 * M_TOK * 256 * 2;
constexpr size_t OFF_BIG = OFF_A + (size_t)M_TOK * 1024 * 2;
constexpr size_t OFF_F = OFF_BIG + (size_t)M_TOK * DFF * 2;
constexpr size_t OFF_KC = OFF_F + (size_t)M_TOK * 1024 * 4;
constexpr size_t OFF_CARRY = OFF_KC + (size_t)2 * 8 * 2 * 256 * 64 * 2;
constexpr size_t OFF_BAR = OFF_CARRY + (size_t)2 * 8 * 4 * 64 * 64 * 4;
constexpr size_t WS_NEED = OFF_BAR + 16384;

struct Params {
  const float *x, *p, *rel_bias, *norm_g, *ffn_wg, *ffn_wu, *ffn_wd, *w_in, *w_out, *sgu_ng, *sgu_w, *sgu_b, *conv_w, *conv_b,
      *lru_wa, *lru_ba, *lru_wx, *lru_bx, *lru_lam, *cmp_pos, *cmp_w1, *cmp_b1, *cmp_w2, *cmp_b2, *ple_wg, *ple_wp;
  float* out;
  char* ws;
};

__device__ __forceinline__ int opaque_tid() { int t; asm volatile("v_mov_b32 %0, %1" : "=v"(t) : "v"(threadIdx.x)); return t; }
#define TIDX opaque_tid()
#define HTID (opaque_tid() & 255)
#define HBLK (opaque_tid() >> 8)
__device__ __forceinline__ float bf2f(bf16_t v) { return __uint_as_float(((unsigned)v) << 16); }
__device__ __forceinline__ bf16_t f2bf(float f) { unsigned u = __float_as_uint(f); u += 0x7fffu + ((u >> 16) & 1u); return (bf16_t)(u >> 16); }
__device__ __forceinline__ unsigned pk2(float lo, float hi) { unsigned r; asm("v_cvt_pk_bf16_f32 %0, %1, %2" : "=v"(r) : "v"(lo), "v"(hi)); return r; }
__device__ __forceinline__ float sigm(float x) { return __builtin_amdgcn_rcpf(1.f + __expf(-x)); }
__device__ __forceinline__ float gelu_t(float x) { float u = 0.7978845608028654f * (x + 0.044715f * x * x * x); return x * __builtin_amdgcn_rcpf(1.f + __expf(-2.f * u)); }
__device__ __forceinline__ float silu_f(float x) { return x * __builtin_amdgcn_rcpf(1.f + __expf(-x)); }
__device__ __forceinline__ f32x4 mfma16(bf16x8 a, bf16x8 b, f32x4 c) { return __builtin_amdgcn_mfma_f32_16x16x32_bf16(a, b, c, 0, 0, 0); }
__device__ __forceinline__ void glds16(const void* g, void* l) {
  __builtin_amdgcn_global_load_lds((const __attribute__((address_space(1))) unsigned*)g, (__attribute__((address_space(3))) unsigned*)l, 16, 0, 0);
}
__device__ __forceinline__ f32x4 zero4() { f32x4 z; asm volatile("v_mov_b32 %0, 0\n\tv_mov_b32 %1, 0\n\tv_mov_b32 %2, 0\n\tv_mov_b32 %3, 0" : "=v"(z[0]), "=v"(z[1]), "=v"(z[2]), "=v"(z[3])); return z; }
__device__ __forceinline__ float wave_sum(float v) {
#pragma unroll
  for (int o = 32; o > 0; o >>= 1) v += __shfl_xor(v, o);
  return v;
}
__device__ __forceinline__ void unpack8(const u32x4 u, float* f) {
  f[0] = __uint_as_float(u.x << 16); f[1] = __uint_as_float(u.x & 0xffff0000u);
  f[2] = __uint_as_float(u.y << 16); f[3] = __uint_as_float(u.y & 0xffff0000u);
  f[4] = __uint_as_float(u.z << 16); f[5] = __uint_as_float(u.z & 0xffff0000u);
  f[6] = __uint_as_float(u.w << 16); f[7] = __uint_as_float(u.w & 0xffff0000u);
}

__device__ __forceinline__ void tr_cvt_tile(const float* __restrict__ src, int N, int K, bf16_t* __restrict__ dst, int ldd, int rs, int ro, int tile, bool active, float* lds) {
  const int ntn = (N + 63) >> 6, tk = tile / ntn, tn = tile - tk * ntn, k0 = tk * 64, n0 = tn * 64, tid = HTID;
#pragma unroll
  for (int ps = 0; ps < 4; ++ps) {
    const int i = ps * 16 + (tid >> 4), j = (tid & 15) * 4;
    float4 v = make_float4(0.f, 0.f, 0.f, 0.f);
    if (active && n0 + j < N) v = *(const float4*)(src + (size_t)(k0 + i) * N + n0 + j);
    float* d = lds + i * 65 + j; d[0] = v.x; d[1] = v.y; d[2] = v.z; d[3] = v.w;
  }
  __syncthreads();
  const int j = tid >> 2, kq = tid & 3, n = n0 + j;
  if (active && n < N) {
    unsigned w[8];
#pragma unroll
    for (int q = 0; q < 8; ++q) w[q] = pk2(lds[(kq * 16 + 2 * q) * 65 + j], lds[(kq * 16 + 2 * q + 1) * 65 + j]);
    bf16_t* o = dst + (size_t)((n >> 4) * rs + (n & 15) + ro) * ldd + k0 + kq * 16;
    *(uint4*)o = make_uint4(w[0], w[1], w[2], w[3]);
    *(uint4*)(o + 8) = make_uint4(w[4], w[5], w[6], w[7]);
  }
  __syncthreads();
}
__device__ __forceinline__ void tr_cvt(const float* src, int N, int K, bf16_t* dst, int ldd, int rs, int ro, char* ldsc) {
  const int nt = ((N + 63) >> 6) * (K >> 6), hb = HBLK;
  float* lds = (float*)(ldsc + hb * 65536);
  for (int t0 = blockIdx.x * 2; t0 < nt; t0 += gridDim.x * 2) tr_cvt_tile(src, N, K, dst, ldd, rs, ro, t0 + hb, t0 + hb < nt, lds);
}

struct RowRegs { float4 h[4]; u32x2 f[4]; };
__device__ __forceinline__ void rn_load(RowRegs& R, const float* hin, const bf16_t* f, int row, int lane) {
#pragma unroll
  for (int i = 0; i < 4; ++i) R.h[i] = *(const float4*)(hin + (size_t)row * 1024 + i * 256 + lane * 4);
  if (f) {
#pragma unroll
    for (int i = 0; i < 4; ++i) R.f[i] = *(const u32x2*)(f + (size_t)row * 1024 + i * 256 + lane * 4);
  }
}
__device__ __forceinline__ void rn_proc(RowRegs& R, float* hout, bool has_f, float scale, const float* gpost, const float* gpre, bf16_t* a, int row, int lane) {
  if (has_f) {
    float fv[4][4]; float ss = 0.f;
#pragma unroll
    for (int i = 0; i < 4; ++i) {
      fv[i][0] = __uint_as_float(R.f[i].x << 16); fv[i][1] = __uint_as_float(R.f[i].x & 0xffff0000u);
      fv[i][2] = __uint_as_float(R.f[i].y << 16); fv[i][3] = __uint_as_float(R.f[i].y & 0xffff0000u);
      ss += fv[i][0] * fv[i][0] + fv[i][1] * fv[i][1] + fv[i][2] * fv[i][2] + fv[i][3] * fv[i][3];
    }
    ss = wave_sum(ss);
    const float r = rsqrtf(ss * (1.f / 1024.f) + 1e-6f) * scale;
#pragma unroll
    for (int i = 0; i < 4; ++i) { const float4 g = *(const float4*)(gpost + i * 256 + lane * 4);
      R.h[i].x += fv[i][0] * r * g.x; R.h[i].y += fv[i][1] * r * g.y; R.h[i].z += fv[i][2] * r * g.z; R.h[i].w += fv[i][3] * r * g.w; }
  }
  if (hout) {
#pragma unroll
    for (int i = 0; i < 4; ++i) *(float4*)(hout + (size_t)row * 1024 + i * 256 + lane * 4) = R.h[i];
  }
  if (a) {
    float ss = 0.f;
#pragma unroll
    for (int i = 0; i < 4; ++i) ss += R.h[i].x * R.h[i].x + R.h[i].y * R.h[i].y + R.h[i].z * R.h[i].z + R.h[i].w * R.h[i].w;
    ss = wave_sum(ss);
    const float r = rsqrtf(ss * (1.f / 1024.f) + 1e-6f);
#pragma unroll
    for (int i = 0; i < 4; ++i) { const float4 g = *(const float4*)(gpre + i * 256 + lane * 4);
      u32x2 o; o.x = pk2(R.h[i].x * r * g.x, R.h[i].y * r * g.y); o.y = pk2(R.h[i].z * r * g.z, R.h[i].w * r * g.w);
      *(u32x2*)(a + (size_t)row * 1024 + i * 256 + lane * 4) = o; }
  }
}
__device__ __forceinline__ void resnorm_phase(const float* hin, float* hout, const bf16_t* f, float scale, const float* gpost, const float* gpre, bf16_t* a) {
  const int tid = TIDX, lane = tid & 63, stride = gridDim.x * 8;
  int r0 = blockIdx.x * 8 + (tid >> 6), r1 = r0 + stride;
  RowRegs A, B;
  if (r0 < M_TOK) rn_load(A, hin, f, r0, lane);
  for (;;) {
    if (r0 >= M_TOK) break;
    if (r1 < M_TOK) rn_load(B, hin, f, r1, lane);
    rn_proc(A, hout, f != nullptr, scale, gpost, gpre, a, r0, lane);
    r0 += 2 * stride;
    if (r1 >= M_TOK) break;
    if (r0 < M_TOK) rn_load(A, hin, f, r0, lane);
    rn_proc(B, hout, f != nullptr, scale, gpost, gpre, a, r1, lane);
    r1 += 2 * stride;
  }
}

__device__ __forceinline__ void prep_phase(const Params& P, char* ldsc) {
  char* ws = P.ws;
  for (int l = 0; l < 2; ++l) {
    for (int j = 0; j < 2; ++j) {
      const int lj = l * 2 + j;
      bf16_t* wgu = (bf16_t*)(ws + OFF_WGU + lj * SZ_WGU);
      tr_cvt(P.ffn_wg + (size_t)lj * 1024 * DFF, DFF, 1024, wgu, 1024, 32, 0, ldsc);
      tr_cvt(P.ffn_wu + (size_t)lj * 1024 * DFF, DFF, 1024, wgu, 1024, 32, 16, ldsc);
      tr_cvt(P.ffn_wd + (size_t)lj * DFF * 1024, 1024, DFF, (bf16_t*)(ws + OFF_WD + lj * SZ_WD), DFF, 16, 0, ldsc);
      tr_cvt(P.cmp_w1 + (size_t)lj * 2048 * 128, 128, 2048, (bf16_t*)(ws + OFF_CW1 + lj * SZ_CW1), 2048, 16, 0, ldsc);
    }
    tr_cvt(P.w_in + (size_t)l * 1024 * NIN, NIN, 1024, (bf16_t*)(ws + OFF_WIN + l * SZ_WIN), 1024, 16, 0, ldsc);
    tr_cvt(P.w_out + (size_t)l * 1024 * 1024, 1024, 1024, (bf16_t*)(ws + OFF_WOUT + l * SZ_SQ), 1024, 16, 0, ldsc);
    tr_cvt(P.ple_wg + (size_t)l * 1024 * 1024, 1024, 1024, (bf16_t*)(ws + OFF_WPG + l * SZ_SQ), 1024, 16, 0, ldsc);
    tr_cvt(P.ple_wp + (size_t)l * 256 * 1024, 1024, 256, (bf16_t*)(ws + OFF_WPP + l * SZ_WPP), 256, 16, 0, ldsc);
    for (int g = 0; g < 4; ++g) {
      tr_cvt(P.lru_wa + (size_t)(l * 4 + g) * 4096, 64, 64, (bf16_t*)(ws + OFF_WAT) + (l * 4 + g) * 4096, 64, 16, 0, ldsc);
      tr_cvt(P.lru_wx + (size_t)(l * 4 + g) * 4096, 64, 64, (bf16_t*)(ws + OFF_WXT) + (l * 4 + g) * 4096, 64, 16, 0, ldsc);
    }
  }
  const int tid = TIDX, gtid = blockIdx.x * 512 + tid, gn = gridDim.x * 512;
  for (int i = gtid; i < 2 * (LDZ - NIN) * 1024 / 8; i += gn) {
    const int l = i / ((LDZ - NIN) * 128), r = i - l * ((LDZ - NIN) * 128);
    *(f32x4*)((bf16_t*)(ws + OFF_WIN + l * SZ_WIN) + (size_t)NIN * 1024 + (size_t)r * 8) = zero4();
  }
  for (int i = gtid; i < 2 * 4 * 128 * 128; i += gn) { const int t = (i >> 7) & 127, s2 = i & 127; ((bf16_t*)(ws + OFF_SGUW))[i] = (s2 <= t) ? f2bf(P.sgu_w[i]) : (bf16_t)0; }
  for (int i = gtid; i < 2 * M_TOK * 256 / 4; i += gn) { const float4 v = ((const float4*)P.p)[i]; uint2 o; o.x = pk2(v.x, v.y); o.y = pk2(v.z, v.w); ((uint2*)(ws + OFF_PBF))[i] = o; }
  {
    float* lds = (float*)(ldsc + HBLK * 65536);
    for (int u = blockIdx.x; u < 4; u += gridDim.x) {
      const int t2 = HTID, kq = t2 >> 5, jq = t2 & 31;
      const float* w1 = P.cmp_w1 + (size_t)u * 2048 * 128; const float* pos = P.cmp_pos + (size_t)u * 2048;
      float4 sacc = make_float4(0.f, 0.f, 0.f, 0.f);
      for (int k = kq * 256; k < kq * 256 + 256; ++k) { const float pv = pos[k]; const float4 w = *(const float4*)(w1 + (size_t)k * 128 + jq * 4); sacc.x += pv * w.x; sacc.y += pv * w.y; sacc.z += pv * w.z; sacc.w += pv * w.w; }
      __syncthreads();
      lds[kq * 128 + jq * 4 + 0] = sacc.x; lds[kq * 128 + jq * 4 + 1] = sacc.y; lds[kq * 128 + jq * 4 + 2] = sacc.z; lds[kq * 128 + jq * 4 + 3] = sacc.w;
      __syncthreads();
      if (t2 < 128) { float t = P.cmp_b1[u * 128 + t2]; for (int q = 0; q < 8; ++q) t += lds[q * 128 + t2]; ((float*)(ws + OFF_CB1))[u * 128 + t2] = t; }
      __syncthreads();
    }
  }
  resnorm_phase(P.x, nullptr, nullptr, 0.f, nullptr, P.norm_g, (bf16_t*)(ws + OFF_A));
}

constexpr int G8_HT = 128 * 64;
__device__ __forceinline__ int g8_lds_byte(int r, int c) { const int st = (r >> 4) * 2 + (c >> 5), rr = r & 15, cc = c & 31, ob = rr * 64 + cc * 2; return st * 1024 + (ob ^ (((ob >> 9) & 1) << 5)); }
__device__ __forceinline__ void g8_stage_rc(int b, int& R, int& C) { const int st = b / 1024, sb = b % 1024, swz = sb ^ (((sb >> 9) & 1) << 5); R = (st >> 1) * 16 + swz / 64; C = (st & 1) * 32 + (swz % 64) / 2; }

__device__ __forceinline__ void gemm_core(f32x4 (&acc)[2][2][4][2], const bf16_t* __restrict__ A, int lda, const bf16_t* __restrict__ Bt, int ldb, int K, char* ldsc) {
  bf16_t* shm = (bf16_t*)ldsc;
  const int tid = TIDX, wid = tid >> 6, lane = tid & 63, wr = wid >> 2, wc = wid & 3, fr = lane & 15, fq = lane >> 4;
  int sr0, sc0;
  g8_stage_rc(tid * 16, sr0, sc0);
  const bf16_t* gA0 = A + (size_t)sr0 * lda + sc0;
  const bf16_t* gB0 = Bt + (size_t)sr0 * ldb + sc0;
  const size_t a64 = (size_t)64 * lda, b64 = (size_t)64 * ldb;
  const int lane_off = (fr * 64 + fq * 16) ^ ((((fr * 64 + fq * 16) >> 9) & 1) << 5);
  const char* ldA = ldsc + wr * 8192 + lane_off;
  const char* ldB = ldsc + 65536 + wc * 4096 + lane_off;
#define SA(b, h) (shm + ((b) * 2 + (h)) * G8_HT)
#define SB(b, h) (shm + (4 + (b) * 2 + (h)) * G8_HT)
#define STAGE_A(P, h, kt) { const bf16_t* g_ = gA0 + (size_t)(h) * 2 * a64 + (kt) * 64; glds16(g_, (char*)(P) + tid * 16); glds16(g_ + a64, (char*)(P) + tid * 16 + 8192); }
#define STAGE_B(P, h, kt) { const bf16_t* g_ = gB0 + (size_t)(h) * 2 * b64 + (kt) * 64; glds16(g_, (char*)(P) + tid * 16); glds16(g_ + b64, (char*)(P) + tid * 16 + 8192); }
#define LDA(dst, b, h) _Pragma("unroll") for (int m = 0; m < 4; ++m) _Pragma("unroll") for (int k = 0; k < 2; ++k) \
    dst[m][k] = *reinterpret_cast<const bf16x8*>(ldA + ((b) * 2 + (h)) * 16384 + (m * 2 + k) * 1024)
#define LDB(dst, b, h) _Pragma("unroll") for (int n = 0; n < 2; ++n) _Pragma("unroll") for (int k = 0; k < 2; ++k) \
    dst[n][k] = *reinterpret_cast<const bf16x8*>(ldB + ((b) * 2 + (h)) * 16384 + (n * 2 + k) * 1024)
#define MMA(ai, bj, At_, Bt_) do { __builtin_amdgcn_s_setprio(1); \
    _Pragma("unroll") for (int m = 0; m < 4; ++m) _Pragma("unroll") for (int n = 0; n < 2; ++n) _Pragma("unroll") for (int k = 0; k < 2; ++k) \
      acc[ai][bj][m][n] = mfma16(Bt_[n][k], At_[m][k], acc[ai][bj][m][n]); \
    __builtin_amdgcn_s_setprio(0); } while (0)
#define WAIT_V(n) asm volatile("s_waitcnt vmcnt(" #n ")" ::: "memory")
#define WAIT_L(n) asm volatile("s_waitcnt lgkmcnt(" #n ")" ::: "memory")
#define BAR __builtin_amdgcn_s_barrier()
#define SCHED __builtin_amdgcn_sched_barrier(0)
  bf16x8 At[4][2], B0[2][2], B1[2][2];
  const int nt = K >> 6;
  STAGE_B(SB(0, 0), 0, 0); STAGE_A(SA(0, 0), 0, 0);
  STAGE_B(SB(0, 1), 1, 0); STAGE_A(SA(0, 1), 1, 0);
  if (wr == 1) BAR;
  WAIT_V(4); BAR;
  STAGE_B(SB(1, 0), 0, 1); STAGE_A(SA(1, 0), 0, 1); STAGE_B(SB(1, 1), 1, 1);
  WAIT_V(6); BAR;
#pragma nounroll
  for (int t = 0; t < nt - 2; t += 2) {
    LDB(B0, 0, 0); SCHED; LDA(At, 0, 0); STAGE_A(SA(1, 1), 1, t + 1);
    WAIT_L(8); BAR; WAIT_L(0); MMA(0, 0, At, B0); BAR; SCHED;
    LDB(B1, 0, 1); STAGE_B(SB(0, 0), 0, t + 2);
    BAR; WAIT_L(0); MMA(0, 1, At, B1); BAR;
    LDA(At, 0, 1); STAGE_A(SA(0, 0), 0, t + 2);
    BAR; WAIT_L(0); MMA(1, 0, At, B0); BAR; SCHED;
    STAGE_B(SB(0, 1), 1, t + 2);
    WAIT_V(6); BAR; MMA(1, 1, At, B1); BAR;
    LDB(B0, 1, 0); SCHED; LDA(At, 1, 0); STAGE_A(SA(0, 1), 1, t + 2);
    WAIT_L(8); BAR; WAIT_L(0); MMA(0, 0, At, B0); BAR; SCHED;
    LDB(B1, 1, 1); STAGE_B(SB(1, 0), 0, t + 3);
    BAR; WAIT_L(0); MMA(0, 1, At, B1); BAR;
    LDA(At, 1, 1); STAGE_A(SA(1, 0), 0, t + 3);
    BAR; WAIT_L(0); MMA(1, 0, At, B0); BAR; SCHED;
    STAGE_B(SB(1, 1), 1, t + 3);
    WAIT_V(6); BAR; MMA(1, 1, At, B1); BAR;
  }
  { LDB(B0, 0, 0); LDA(At, 0, 0); STAGE_A(SA(1, 1), 1, nt - 1);
    BAR; WAIT_L(0); MMA(0, 0, At, B0); BAR;
    LDB(B1, 0, 1); BAR; WAIT_L(0); MMA(0, 1, At, B1); BAR;
    LDA(At, 0, 1); WAIT_V(4); BAR; WAIT_L(0); MMA(1, 0, At, B0); MMA(1, 1, At, B1); BAR; }
  { LDB(B0, 1, 0); LDA(At, 1, 0); WAIT_V(2); BAR; WAIT_L(0); MMA(0, 0, At, B0); BAR;
    LDB(B1, 1, 1); WAIT_V(0); BAR; WAIT_L(0); MMA(0, 1, At, B1); BAR;
    LDA(At, 1, 1); BAR; WAIT_L(0); MMA(1, 0, At, B0); MMA(1, 1, At, B1); BAR; }
  if (wr == 0) BAR;
  BAR;
#undef SA
#undef SB
#undef STAGE_A
#undef STAGE_B
#undef LDA
#undef LDB
#undef MMA
#undef WAIT_V
#undef WAIT_L
#undef BAR
#undef SCHED
}

template <class F> __device__ __forceinline__ void gemm_sched(int TN, F&& f) {
  const int npc = (TN + 1) >> 1, npatch = 8 * npc, xcd = blockIdx.x & 7, slot = blockIdx.x >> 3, nslot = gridDim.x >> 3;
  for (int pid = xcd; pid < npatch; pid += 8) {
    const int pr = pid / npc, pc = pid - pr * npc;
    for (int s = slot; s < 32; s += nslot) {
      const int tm = pr * 16 + (s & 15), tn = pc * 2 + (s >> 4);
      if (tn < TN) f(tm, tn);
    }
  }
}

#define GEMM_LANE const int tid_ = TIDX, lane_ = tid_ & 63, wid_ = tid_ >> 6, wr = wid_ >> 2, wc = wid_ & 3, fr = lane_ & 15, fq = lane_ >> 4
#define GEMM_EPI_LOOP _Pragma("unroll") for (int ai = 0; ai < 2; ++ai) _Pragma("unroll") for (int m = 0; m < 4; ++m) _Pragma("unroll") for (int bj = 0; bj < 2; ++bj)

__device__ __forceinline__ void gemm_up_phase(const bf16_t* a, const bf16_t* wgu, bf16_t* act, char* lds) {
  gemm_sched(NGU / 256, [&](int tm, int tn) {
    f32x4 acc[2][2][4][2];
    _Pragma("unroll") for (int i0 = 0; i0 < 2; ++i0) _Pragma("unroll") for (int i1 = 0; i1 < 2; ++i1) _Pragma("unroll") for (int i2 = 0; i2 < 4; ++i2) _Pragma("unroll") for (int i3 = 0; i3 < 2; ++i3) acc[i0][i1][i2][i3] = zero4();
    gemm_core(acc, a + (size_t)tm * 256 * 1024, 1024, wgu + (size_t)tn * 256 * 1024, 1024, 1024, lds);
    GEMM_LANE;
    GEMM_EPI_LOOP {
      const int row = tm * 256 + ai * 128 + wr * 64 + m * 16 + fr;
      const int col = tn * 128 + bj * 64 + wc * 16 + 4 * fq;
      const f32x4 g = acc[ai][bj][m][0], u = acc[ai][bj][m][1];
      uint2 o; o.x = pk2(silu_f(g[0]) * u[0], silu_f(g[1]) * u[1]); o.y = pk2(silu_f(g[2]) * u[2], silu_f(g[3]) * u[3]);
      *(uint2*)(act + (size_t)row * DFF + col) = o;
    }
  });
}

__device__ __forceinline__ void gemm_f32_phase(const bf16_t* A, int lda, const bf16_t* Bt, int K, float* out, char* lds) {
  gemm_sched(4, [&](int tm, int tn) {
    f32x4 acc[2][2][4][2];
    _Pragma("unroll") for (int i0 = 0; i0 < 2; ++i0) _Pragma("unroll") for (int i1 = 0; i1 < 2; ++i1) _Pragma("unroll") for (int i2 = 0; i2 < 4; ++i2) _Pragma("unroll") for (int i3 = 0; i3 < 2; ++i3) acc[i0][i1][i2][i3] = zero4();
    gemm_core(acc, A + (size_t)tm * 256 * lda, lda, Bt + (size_t)tn * 256 * K, K, K, lds);
    GEMM_LANE;
    GEMM_EPI_LOOP {
      const int row = tm * 256 + ai * 128 + wr * 64 + m * 16 + fr;
#pragma unroll
      for (int n = 0; n < 2; ++n) *(f32x4*)(out + (size_t)row * 1024 + tn * 256 + bj * 128 + wc * 32 + n * 16 + 4 * fq) = acc[ai][bj][m][n];
    }
  });
}

__device__ __forceinline__ void gemm_bf16_phase(const bf16_t* A, int lda, const bf16_t* Bt, int K, int TN, bf16_t* out, int ldo, char* lds) {
  gemm_sched(TN, [&](int tm, int tn) {
    f32x4 acc[2][2][4][2];
    _Pragma("unroll") for (int i0 = 0; i0 < 2; ++i0) _Pragma("unroll") for (int i1 = 0; i1 < 2; ++i1) _Pragma("unroll") for (int i2 = 0; i2 < 4; ++i2) _Pragma("unroll") for (int i3 = 0; i3 < 2; ++i3) acc[i0][i1][i2][i3] = zero4();
    gemm_core(acc, A + (size_t)tm * 256 * lda, lda, Bt + (size_t)tn * 256 * K, K, K, lds);
    GEMM_LANE;
    GEMM_EPI_LOOP {
      const int row = tm * 256 + ai * 128 + wr * 64 + m * 16 + fr;
#pragma unroll
      for (int n = 0; n < 2; ++n) {
        uint2 o; o.x = pk2(acc[ai][bj][m][n][0], acc[ai][bj][m][n][1]); o.y = pk2(acc[ai][bj][m][n][2], acc[ai][bj][m][n][3]);
        *(uint2*)(out + (size_t)row * ldo + tn * 256 + bj * 128 + wc * 32 + n * 16 + 4 * fq) = o;
      }
    }
  });
}

__device__ __forceinline__ void gemm_ple_phase(const bf16_t* a, const bf16_t* wpg, const bf16_t* pp, bf16_t* out, char* lds) {
  gemm_sched(4, [&](int tm, int tn) {
    f32x4 acc[2][2][4][2];
    _Pragma("unroll") for (int i0 = 0; i0 < 2; ++i0) _Pragma("unroll") for (int i1 = 0; i1 < 2; ++i1) _Pragma("unroll") for (int i2 = 0; i2 < 4; ++i2) _Pragma("unroll") for (int i3 = 0; i3 < 2; ++i3) acc[i0][i1][i2][i3] = zero4();
    gemm_core(acc, a + (size_t)tm * 256 * 1024, 1024, wpg + (size_t)tn * 256 * 1024, 1024, 1024, lds);
    GEMM_LANE;
    GEMM_EPI_LOOP {
      const int row = tm * 256 + ai * 128 + wr * 64 + m * 16 + fr;
#pragma unroll
      for (int n = 0; n < 2; ++n) {
        const int col = tn * 256 + bj * 128 + wc * 32 + n * 16 + 4 * fq;
        const u32x2 pv = *(const u32x2*)(pp + (size_t)row * 1024 + col);
        const f32x4 av = acc[ai][bj][m][n];
        u32x2 o;
        o.x = pk2(sigm(av[0]) * __uint_as_float(pv.x << 16), sigm(av[1]) * __uint_as_float(pv.x & 0xffff0000u));
        o.y = pk2(sigm(av[2]) * __uint_as_float(pv.y << 16), sigm(av[3]) * __uint_as_float(pv.y & 0xffff0000u));
        *(u32x2*)(out + (size_t)row * 1024 + col) = o;
      }
    }
  });
}

__device__ __forceinline__ void mixA_item(const Params& P, int layer, int idx, const bf16_t* z, bf16_t* y, char* lds) {
  const int g = idx & 3, bc = idx >> 2, tok0 = bc * 128;
  const int tid = HTID, lane = tid & 63, w = tid >> 6, fr = lane & 15, fq = lane >> 4;
  bf16_t* vT = (bf16_t*)lds;
  const float* ng = P.sgu_ng + layer * 256;
  {
    const int s = tid >> 1, half = tid & 1;
    const bf16_t* zr = z + (size_t)(tok0 + s) * LDZ + ZC_AV;
    float ss = 0.f;
#pragma unroll 4
    for (int i = 0; i < 16; ++i) { float v[8]; unpack8(*(const u32x4*)(zr + half * 128 + i * 8), v);
#pragma unroll
      for (int e = 0; e < 8; ++e) { const float t = gelu_t(v[e]); ss += t * t; } }
    ss += __shfl_xor(ss, 1);
    const float rs = rsqrtf(ss * (1.f / 256.f) + 1e-6f);
#pragma unroll
    for (int i = 0; i < 4; ++i) { float v[8]; unpack8(*(const u32x4*)(zr + g * 64 + half * 32 + i * 8), v);
#pragma unroll
      for (int e = 0; e < 8; ++e) { const int d = half * 32 + i * 8 + e; vT[d * 136 + s] = f2bf(gelu_t(v[e]) * rs * ng[g * 64 + d]); } }
  }
  __syncthreads();
  const bf16_t* W = (const bf16_t*)(P.ws + OFF_SGUW) + (size_t)((layer * 4 + g) * 128) * 128;
  f32x4 acc[2][4] = {};
  for (int ks = 0; ks <= w; ++ks) {
    bf16x8 wf[2], vf[4];
#pragma unroll
    for (int tm = 0; tm < 2; ++tm) wf[tm] = *(const bf16x8*)(W + (size_t)(32 * w + tm * 16 + fr) * 128 + ks * 32 + 8 * fq);
#pragma unroll
    for (int dn = 0; dn < 4; ++dn) vf[dn] = *(const bf16x8*)(vT + (dn * 16 + fr) * 136 + ks * 32 + 8 * fq);
#pragma unroll
    for (int tm = 0; tm < 2; ++tm)
#pragma unroll
      for (int dn = 0; dn < 4; ++dn) acc[tm][dn] = mfma16(vf[dn], wf[tm], acc[tm][dn]);
  }
#pragma unroll
  for (int tm = 0; tm < 2; ++tm) {
    const int t = 32 * w + tm * 16 + fr;
    const float bias = P.sgu_b[(layer * 4 + g) * 128 + t];
#pragma unroll
    for (int dn = 0; dn < 4; ++dn) {
      const int d = dn * 16 + 4 * fq;
      const uint2 uu = *(const uint2*)(z + (size_t)(tok0 + t) * LDZ + ZC_AU + g * 64 + d);
      const float u0 = gelu_t(__uint_as_float(uu.x << 16)), u1 = gelu_t(__uint_as_float(uu.x & 0xffff0000u)),
                  u2 = gelu_t(__uint_as_float(uu.y << 16)), u3 = gelu_t(__uint_as_float(uu.y & 0xffff0000u));
      uint2 o; o.x = pk2(u0 * (acc[tm][dn][0] + bias), u1 * (acc[tm][dn][1] + bias)); o.y = pk2(u2 * (acc[tm][dn][2] + bias), u3 * (acc[tm][dn][3] + bias));
      *(uint2*)(y + (size_t)(tok0 + t) * 1024 + g * 64 + d) = o;
    }
  }
  __syncthreads();
}

__device__ __forceinline__ void mixB1_item(const Params& P, int layer, int idx, const bf16_t* z, float* hsl, float* Pc, float* carryP, float* carryH, char* lds) {
  const int c = idx & 63, g = (idx >> 6) & 3, b = idx >> 8;
  const int tid = HTID, lane = tid & 63, w = tid >> 6, fr = lane & 15, fq = lane >> 4;
  bf16_t* xcb = (bf16_t*)lds;
  float* xcf = (float*)(lds + 9216);
  float* aA = (float*)(lds + 9216 + 16384);
  float* bB = (float*)(lds + 9216 + 32768);
  float* sm = (float*)(lds + 9216 + 49152);
  const size_t tokb = (size_t)b * SEQ;
  {
    const int t = tid >> 2, q = tid & 3;
    float accv[16];
#pragma unroll
    for (int i = 0; i < 16; ++i) accv[i] = P.conv_b[layer * 256 + g * 64 + q * 16 + i];
#pragma unroll
    for (int k = 0; k < 4; ++k) {
      const int pos = c * 64 + t - 3 + k;
      if (pos >= 0) {
        const bf16_t* zr = z + (tokb + pos) * LDZ + ZC_BX + g * 64 + q * 16;
        float v[16]; unpack8(*(const u32x4*)zr, v); unpack8(*(const u32x4*)(zr + 8), v + 8);
        const float* cw = P.conv_w + (size_t)(layer * 4 + k) * 256 + g * 64 + q * 16;
#pragma unroll
        for (int i = 0; i < 16; ++i) accv[i] += v[i] * cw[i];
      }
    }
#pragma unroll
    for (int i = 0; i < 16; ++i) { xcf[t * 64 + q * 16 + i] = accv[i]; xcb[t * 72 + q * 16 + i] = f2bf(accv[i]); }
  }
  __syncthreads();
  {
    const bf16_t* wa = (const bf16_t*)(P.ws + OFF_WAT) + (layer * 4 + g) * 4096;
    const bf16_t* wx = (const bf16_t*)(P.ws + OFF_WXT) + (layer * 4 + g) * 4096;
    f32x4 ar[4] = {}, ai[4] = {};
#pragma unroll
    for (int ks = 0; ks < 2; ++ks) {
      const bf16x8 xf = *(const bf16x8*)(xcb + (16 * w + fr) * 72 + ks * 32 + 8 * fq);
#pragma unroll
      for (int jn = 0; jn < 4; ++jn) {
        const bf16x8 fa = *(const bf16x8*)(wa + (jn * 16 + fr) * 64 + ks * 32 + 8 * fq);
        const bf16x8 fx = *(const bf16x8*)(wx + (jn * 16 + fr) * 64 + ks * 32 + 8 * fq);
        ar[jn] = mfma16(fa, xf, ar[jn]); ai[jn] = mfma16(fx, xf, ai[jn]);
      }
    }
    const int t = 16 * w + fr;
#pragma unroll
    for (int jn = 0; jn < 4; ++jn)
#pragma unroll
      for (int e = 0; e < 4; ++e) {
        const int j = jn * 16 + 4 * fq + e, ch = layer * 256 + g * 64 + j;
        const float r = sigm(ar[jn][e] + P.lru_ba[ch]), ig = sigm(ai[jn][e] + P.lru_bx[ch]);
        const float lam = P.lru_lam[ch];
        const float xe = __expf(-lam);
        float m8; asm volatile("v_mov_b32 %0, 0xc1000000" : "=v"(m8));
        const float la = m8 * r * (xe * (1.f - xe * (0.5f - xe * (1.f / 3.f))));
        const float av = __expf(la);
        const float y2 = 2.f * la;
        const float om = -y2 * (1.f + y2 * (0.5f + y2 * ((1.f / 6.f) + y2 * ((1.f / 24.f) + y2 * ((1.f / 120.f) + y2 * (1.f / 720.f))))));
        const float bv = sqrtf(om) * (ig * xcf[t * 64 + j]);
        aA[t * 64 + j] = av; bB[t * 64 + j] = bv;
      }
  }
  __syncthreads();
  {
    const int q = tid >> 6, j = tid & 63;
    float Pq = 1.f, hq = 0.f;
#pragma unroll
    for (int i = 0; i < 16; ++i) { const int t = q * 16 + i; const float av = aA[t * 64 + j], bv = bB[t * 64 + j]; hq = av * hq + bv; Pq *= av; aA[t * 64 + j] = Pq; bB[t * 64 + j] = hq; }
    sm[q * 64 + j] = Pq; sm[256 + q * 64 + j] = hq;
    __syncthreads();
    float Pin = 1.f, Hin = 0.f;
    for (int qq = 0; qq < q; ++qq) { const float pp = sm[qq * 64 + j], hh = sm[256 + qq * 64 + j]; Hin = pp * Hin + hh; Pin *= pp; }
    float hl = 0.f, pl = 1.f;
#pragma unroll
    for (int i = 0; i < 16; ++i) { const int t = q * 16 + i; hl = bB[t * 64 + j] + aA[t * 64 + j] * Hin; pl = aA[t * 64 + j] * Pin;
      const size_t o = (tokb + c * 64 + t) * 256 + g * 64 + j; hsl[o] = hl; Pc[o] = pl; }
    if (q == 3) { const int o = ((b * 4 + g) * 64 + c) * 64 + j; carryP[o] = pl; carryH[o] = hl; }
  }
  __syncthreads();
}

__device__ __forceinline__ void mixB2_item(int idx, const bf16_t* z, const float* hsl, const float* Pc, const float* carryP, const float* carryH, bf16_t* y) {
  const int c = idx & 63, g = (idx >> 6) & 3, b = idx >> 8;
  const int q = HTID >> 6, j = HTID & 63;
  const float* cp = carryP + (size_t)((b * 4 + g) * 64) * 64 + j;
  const float* chh = carryH + (size_t)((b * 4 + g) * 64) * 64 + j;
  float H = 0.f;
  for (int c0 = 0; c0 < c; c0 += 8) {
    float pv[8], hv[8];
#pragma unroll
    for (int i = 0; i < 8; ++i) { const bool ok = c0 + i < c; pv[i] = ok ? cp[(c0 + i) * 64] : 1.f; hv[i] = ok ? chh[(c0 + i) * 64] : 0.f; }
#pragma unroll
    for (int i = 0; i < 8; ++i) H = pv[i] * H + hv[i];
  }
  const size_t tokb = (size_t)b * SEQ + c * 64 + q * 16;
#pragma unroll 4
  for (int i = 0; i < 16; ++i) {
    const size_t o = (tokb + i) * 256 + g * 64 + j;
    const float h = hsl[o] + Pc[o] * H;
    const float gt = bf2f(z[(tokb + i) * LDZ + ZC_BG + g * 64 + j]);
    y[(tokb + i) * 1024 + 256 + g * 64 + j] = f2bf(h * gelu_t(gt));
  }
}

__device__ __forceinline__ void compress_item(const Params& P, int layer, int idx, const bf16_t* z, bf16_t* kcv, char* lds) {
  const int nb = idx & 7, g = (idx >> 3) & 1, b = (idx >> 4) & 7, kv = idx >> 7;
  const int tid = HTID, lane = tid & 63, w = tid >> 6, fr = lane & 15, fq = lane >> 4;
  const int n0 = nb * 32, col = (kv ? ZC_VC : ZC_KC) + g * 64;
  const bf16_t* w1t = (const bf16_t*)(P.ws + OFF_CW1 + (size_t)(layer * 2 + kv) * SZ_CW1);
  float* hid = (float*)lds;
  f32x4 acc[2][2] = {};
  const bf16_t* zb[2]; const bf16_t* wb[2];
#pragma unroll
  for (int nf = 0; nf < 2; ++nf) { int n = n0 + nf * 16 + fr; if (n > 254) n = 254; zb[nf] = z + ((size_t)b * SEQ + 16 * n) * LDZ + col + 8 * fq; }
#pragma unroll
  for (int jf = 0; jf < 2; ++jf) wb[jf] = w1t + (size_t)(32 * w + jf * 16 + fr) * 2048 + 8 * fq;
#pragma unroll 4
  for (int ks = 0; ks < 64; ++ks) {
    const int l = ks >> 1, d0 = (ks & 1) * 32;
    bf16x8 xf[2], wf[2];
#pragma unroll
    for (int nf = 0; nf < 2; ++nf) xf[nf] = *(const bf16x8*)(zb[nf] + (size_t)l * LDZ + d0);
#pragma unroll
    for (int jf = 0; jf < 2; ++jf) wf[jf] = *(const bf16x8*)(wb[jf] + ks * 32);
#pragma unroll
    for (int jf = 0; jf < 2; ++jf)
#pragma unroll
      for (int nf = 0; nf < 2; ++nf) acc[jf][nf] = mfma16(wf[jf], xf[nf], acc[jf][nf]);
  }
  const float* cb1 = (const float*)(P.ws + OFF_CB1) + (layer * 2 + kv) * 128;
#pragma unroll
  for (int jf = 0; jf < 2; ++jf)
#pragma unroll
    for (int nf = 0; nf < 2; ++nf)
#pragma unroll
      for (int e = 0; e < 4; ++e) { const int j = 32 * w + jf * 16 + 4 * fq + e; hid[(nf * 16 + fr) * 129 + j] = gelu_t(acc[jf][nf][e] + cb1[j]); }
  __syncthreads();
  {
    const int n = tid >> 3, d0 = (tid & 7) * 8;
    const float* w2 = P.cmp_w2 + (size_t)(layer * 2 + kv) * 128 * 64 + d0;
    const float* b2 = P.cmp_b2 + (layer * 2 + kv) * 64 + d0;
    float o[8];
#pragma unroll
    for (int e = 0; e < 8; ++e) o[e] = b2[e];
    for (int j = 0; j < 128; ++j) {
      const float hv = hid[n * 129 + j]; const float4 wa = *(const float4*)(w2 + j * 64), wb2 = *(const float4*)(w2 + j * 64 + 4);
      o[0] += hv * wa.x; o[1] += hv * wa.y; o[2] += hv * wa.z; o[3] += hv * wa.w; o[4] += hv * wb2.x; o[5] += hv * wb2.y; o[6] += hv * wb2.z; o[7] += hv * wb2.w;
    }
    const bool valid = (n0 + n) < 255;
    uint4 ov = make_uint4(pk2(o[0], o[1]), pk2(o[2], o[3]), pk2(o[4], o[5]), pk2(o[6], o[7]));
    if (!valid) { ov.x = 0u; ov.y = 0u; ov.z = 0u; ov.w = 0u; }
    *(uint4*)(kcv + ((size_t)((kv * 8 + b) * 2 + g) * 256 + n0 + n) * 64 + d0) = ov;
  }
  __syncthreads();
}

constexpr int NSA_KT = 0, NSA_VT = 16384, NSA_T = 33792, NSA_TW = NSA_T + 4 * 4160 * 4, NSA_IMP = NSA_TW + 4 * 640 * 4, NSA_WU = NSA_IMP + 2 * 16640;
constexpr int LDS_ST = 147456;
constexpr float LOG2E = 1.4426950408889634f;

__device__ __forceinline__ void nsa_tables(const Params& P, int g, char* lds) {
  float* T = (float*)(lds + NSA_T);
  float* TW = (float*)(lds + NSA_TW);
  const int tid = TIDX;
  for (int i = tid; i < 4160; i += 512) {
    const int n = i - 64;
    int bk = n;
    if (n >= 16) bk = 16 + (n >= 21) + (n >= 27) + (n >= 35) + (n >= 46) + (n >= 59) + (n >= 77) + (n >= 99) + (n >= 128) + (n >= 166) + (n >= 216) + (n >= 280) + (n >= 363) + (n >= 470) + (n >= 609) + (n >= 790);
#pragma unroll
    for (int r = 0; r < 4; ++r) {
      const float v = n >= 0 ? P.rel_bias[bk * 8 + g * 4 + r] * LOG2E : -__builtin_inff();
      T[r * 4160 + i] = v;
      if (i < 640) TW[r * 640 + i] = (n < 512) ? v : -__builtin_inff();
    }
  }
  __syncthreads();
}

struct KVRegs { u32x4 k0, v0; };
__device__ __forceinline__ void kv_gload(KVRegs& r, const bf16_t* kb, const bf16_t* vb, size_t stride) {
  const int tid = TIDX, row = tid >> 3, cq = tid & 7;
  r.k0 = *(const u32x4*)(kb + row * stride + cq * 8); r.v0 = *(const u32x4*)(vb + row * stride + cq * 8);
}
__device__ __forceinline__ void kv_lwrite(const KVRegs& r, char* lds, int buf) {
  const int tid = TIDX, row = tid >> 3, cq = tid & 7;
  char* kt = lds + NSA_KT + buf * 8192 + row * 128;
  *(u32x4*)(kt + ((cq ^ (row & 7)) << 4)) = r.k0;
  bf16_t* vt = (bf16_t*)(lds + NSA_VT + buf * 8704) + (cq * 8) * 68 + row;
#pragma unroll
  for (int i = 0; i < 4; ++i) { vt[(2 * i) * 68] = (bf16_t)(r.v0[i] & 0xffffu); vt[(2 * i + 1) * 68] = (bf16_t)(r.v0[i] >> 16); }
}

template <int MODE>
__device__ __forceinline__ void nsa_compute(int cur, int buf, int t, int hl, u64 mymask, const bf16x8 (&Qf)[2][2], f32x4 (&O)[4][2], float (&m)[2], float (&l)[2],
                                            const float (&inv)[2], float* impw, char* lds) {
  const int lane = TIDX & 63, fr = lane & 15, fq = lane >> 4;
  const char* kt = lds + NSA_KT + buf * 8192;
  const bf16_t* vt = (const bf16_t*)(lds + NSA_VT + buf * 8704);
  const bool selok = (MODE == 2) ? (((mymask >> cur) & 1ull) != 0ull) : true;
  const float* tb = (MODE == 3) ? (const float*)(lds + NSA_TW) + hl * 640 : (const float*)(lds + NSA_T) + hl * 4160;
  constexpr int TS = (MODE == 3) ? 640 : 4160;
  const int base = (MODE <= 1) ? (t - 31 - 16 * (cur * 64 + 4 * fq) + 64) : (t - cur * 64 - 4 * fq + 64);
#pragma unroll
  for (int s2 = 0; s2 < 2; ++s2) {
    f32x4 S[2][2];
    S[0][0] = zero4(); S[0][1] = zero4(); S[1][0] = zero4(); S[1][1] = zero4();
#pragma unroll
    for (int ks = 0; ks < 2; ++ks)
#pragma unroll
      for (int kk = 0; kk < 2; ++kk) {
        const bf16x8 kf = *(const bf16x8*)(kt + (32 * s2 + 16 * kk + fr) * 128 + (((ks * 4 + fq) ^ (fr & 7)) << 4));
#pragma unroll
        for (int r = 0; r < 2; ++r) S[kk][r] = mfma16(kf, Qf[r][ks], S[kk][r]);
      }
    bf16x8 Pf[2];
    float g1s[2] = {0.f, 0.f}, p3s[2] = {0.f, 0.f};
#pragma unroll
    for (int r = 0; r < 2; ++r) {
      float sv[2][4];
#pragma unroll
      for (int kk = 0; kk < 2; ++kk)
#pragma unroll
        for (int e = 0; e < 4; ++e) {
          const int off = 32 * s2 + 16 * kk + e;
          int idx;
          if (MODE <= 1) { idx = base - 16 * off; idx = idx > 0 ? idx : 0; } else idx = base - off;
          sv[kk][e] = S[kk][r][e] * (0.125f * LOG2E) + tb[r * TS + idx];
        }
      float pv[2][4];
      if (MODE == 1) {
#pragma unroll
        for (int kk = 0; kk < 2; ++kk)
#pragma unroll
          for (int e = 0; e < 4; ++e) pv[kk][e] = __builtin_amdgcn_exp2f(sv[kk][e] - m[r]) * inv[r];
#pragma unroll
        for (int kk = 0; kk < 2; ++kk) { g1s[kk] += pv[kk][0] + pv[kk][1] + pv[kk][2] + 0.5f * pv[kk][3]; p3s[kk] += 0.5f * pv[kk][3]; }
      } else {
        float mx = fmaxf(fmaxf(fmaxf(sv[0][0], sv[0][1]), fmaxf(sv[0][2], sv[0][3])), fmaxf(fmaxf(sv[1][0], sv[1][1]), fmaxf(sv[1][2], sv[1][3])));
        if (MODE == 2) mx = selok ? mx : -__builtin_inff();
        if (__any(mx > m[r] + 8.0f)) {
          mx = fmaxf(mx, __shfl_xor(mx, 16)); mx = fmaxf(mx, __shfl_xor(mx, 32));
          const float mn = fmaxf(m[r], mx), al = __builtin_amdgcn_exp2f(m[r] - mn);
          m[r] = mn; l[r] *= al;
          if (MODE != 0) {
#pragma unroll
            for (int df = 0; df < 4; ++df) O[df][r] *= al;
          }
        }
        const float me = (MODE == 2) ? (selok ? m[r] : __builtin_inff()) : m[r];
        float ps = 0.f;
#pragma unroll
        for (int kk = 0; kk < 2; ++kk)
#pragma unroll
          for (int e = 0; e < 4; ++e) { pv[kk][e] = __builtin_amdgcn_exp2f(sv[kk][e] - me); ps += pv[kk][e]; }
        l[r] += ps;
      }
      if (MODE != 0) {
        const unsigned w0 = pk2(pv[0][0], pv[0][1]), w1 = pk2(pv[0][2], pv[0][3]), w2 = pk2(pv[1][0], pv[1][1]), w3 = pk2(pv[1][2], pv[1][3]);
        u32x4 pw; pw.x = w0; pw.y = w1; pw.z = w2; pw.w = w3;
        Pf[r] = __builtin_bit_cast(bf16x8, pw);
      }
    }
    if (MODE != 0) {
#pragma unroll
      for (int df = 0; df < 4; ++df) {
        const bf16x4 va = *(const bf16x4*)(vt + (df * 16 + fr) * 68 + 32 * s2 + 4 * fq);
        const bf16x4 vb = *(const bf16x4*)(vt + (df * 16 + fr) * 68 + 32 * s2 + 16 + 4 * fq);
        bf16x8 vf; vf[0] = va[0]; vf[1] = va[1]; vf[2] = va[2]; vf[3] = va[3]; vf[4] = vb[0]; vf[5] = vb[1]; vf[6] = vb[2]; vf[7] = vb[3];
#pragma unroll
        for (int r = 0; r < 2; ++r) O[df][r] = mfma16(vf, Pf[r], O[df][r]);
      }
    }
    if (MODE == 1) {
#pragma unroll
      for (int kk = 0; kk < 2; ++kk) {
        const int j = cur * 16 + (2 * s2 + kk) * 4 + fq;
        atomicAdd(&impw[fr * 65 + j], g1s[kk]);
        if (j + 1 < 64) atomicAdd(&impw[fr * 65 + j + 1], p3s[kk]);
      }
    }
  }
}

template <int MODE>
__device__ __forceinline__ void nsa_branch(int first, int ntl, u64 U, const bf16_t* kbase, const bf16_t* vbase, size_t stride, int t, int hl, u64 mymask,
                                           const bf16x8 (&Qf)[2][2], f32x4 (&O)[4][2], float (&m)[2], float (&l)[2], const float (&inv)[2], float* impw, char* lds) {
  KVRegs R0, R1, R2;
  u64 rem = U;
  int seq = first, left = ntl;
#define NSA_NEXT(dst)                                                                                     \
  { if (MODE == 2) { dst = rem ? (int)__builtin_ctzll(rem) : -1; if (rem) rem &= rem - 1; }              \
    else { dst = left > 0 ? seq : -1; ++seq; --left; } }
#define NSA_GLOAD(R, ti) kv_gload(R, kbase + (size_t)(ti) * 64 * stride, vbase + (size_t)(ti) * 64 * stride, stride)
  int tcur, t1, t2, t3;
  NSA_NEXT(tcur); NSA_NEXT(t1); NSA_NEXT(t2);
  if (tcur >= 0) NSA_GLOAD(R0, tcur);
  if (t1 >= 0) NSA_GLOAD(R1, t1);
  if (t2 >= 0) NSA_GLOAD(R2, t2);
  if (tcur >= 0) kv_lwrite(R0, lds, 0);
  __syncthreads();
  NSA_NEXT(t3);
  if (t3 >= 0) NSA_GLOAD(R0, t3);
  int buf = 0;
#define NSA_STEP(RW)                                                                                      \
  if (tcur < 0) break;                                                                                    \
  nsa_compute<MODE>(tcur, buf, t, hl, mymask, Qf, O, m, l, inv, impw, lds);                               \
  if (t1 >= 0) kv_lwrite(RW, lds, buf ^ 1);                                                               \
  __syncthreads();                                                                                        \
  buf ^= 1; tcur = t1; t1 = t2; t2 = t3;                                                                  \
  NSA_NEXT(t3);                                                                                           \
  if (t3 >= 0) NSA_GLOAD(RW, t3);
  for (;;) {
    NSA_STEP(R1)
    NSA_STEP(R2)
    NSA_STEP(R0)
  }
#undef NSA_STEP
#undef NSA_GLOAD
#undef NSA_NEXT
}

#define NSA_RESET()                                                                         \
  _Pragma("unroll") for (int r = 0; r < 2; ++r) { asm volatile("v_mov_b32 %0, 0xf149f2ca" : "=v"(m[r])); l[r] = 0.f; }               \
  _Pragma("unroll") for (int df = 0; df < 4; ++df) _Pragma("unroll") for (int r = 0; r < 2; ++r) O[df][r] = zero4();

__device__ __forceinline__ void nsa_item(const Params& P, int b, int g, int c, const bf16_t* z, const bf16_t* kcv, bf16_t* y, char* lds) {
  const int tid = TIDX, lane = tid & 63, w8 = tid >> 6, qg = w8 & 3, hp = w8 >> 2, fr = lane & 15, fq = lane >> 4;
  const size_t tokb = (size_t)b * SEQ;
  const int t = c * 64 + 16 * qg + fr;
  const bf16_t* zq = z + (tokb + t) * LDZ;
  const int hb = g * 4 + hp * 2;
  bf16x8 Qf[2][2];
#pragma unroll
  for (int r = 0; r < 2; ++r)
#pragma unroll
    for (int ks = 0; ks < 2; ++ks) Qf[r][ks] = *(const bf16x8*)(zq + ZC_Q + g * 256 + (hp * 2 + r) * 64 + ks * 32 + 8 * fq);
  float* impw = (float*)(lds + NSA_IMP) + (hp * 4 + qg) * (16 * 65);
  for (int i = lane; i < 16 * 65; i += 64) impw[i] = 0.f;
  f32x4 O[4][2];
  float m[2], l[2], inv[2];
  bf16_t* yo = y + (tokb + t) * 1024 + 512 + g * 256 + hp * 128 + 4 * fq;
  const bf16_t* kc = kcv + (size_t)((0 * 8 + b) * 2 + g) * 256 * 64;
  const bf16_t* vc = kcv + (size_t)((1 * 8 + b) * 2 + g) * 256 * 64;
  const int nct = ((4 * c + 2) >> 6) + 1;
  NSA_RESET();
  inv[0] = 0.f; inv[1] = 0.f;
  nsa_branch<0>(0, nct, 0ull, kc, vc, 64, t, hp * 2, 0ull, Qf, O, m, l, inv, impw, lds);
#pragma unroll
  for (int r = 0; r < 2; ++r) { float lt = l[r]; lt += __shfl_xor(lt, 16); lt += __shfl_xor(lt, 32); inv[r] = lt > 0.f ? 1.f / lt : 0.f; }
  nsa_branch<1>(0, nct, 0ull, kc, vc, 64, t, hp * 2, 0ull, Qf, O, m, l, inv, impw, lds);
#pragma unroll
  for (int r = 0; r < 2; ++r) {
    const float gt = sigm(bf2f(zq[ZC_GC + hb + r]));
#pragma unroll
    for (int df = 0; df < 4; ++df) { u32x2 o; o.x = pk2(O[df][r][0] * gt, O[df][r][1] * gt); o.y = pk2(O[df][r][2] * gt, O[df][r][3] * gt); *(u32x2*)(yo + r * 64 + df * 16) = o; }
  }
  __syncthreads();
  u64 wU = 0ull;
  {
    const float* imp0 = (const float*)(lds + NSA_IMP) + qg * (16 * 65);
    const float* imp1 = imp0 + 4 * (16 * 65);
    u64* MK = (u64*)(lds + NSA_WU) + 8;
    const u64 V = (c >= 63) ? ~0ull : ((1ull << (c + 1)) - 1ull);
    const bool forced = (lane == 0) | (lane == c) | (lane == c - 1);
    for (int q8 = 0; q8 < 8; ++q8) {
      const int qq = hp * 8 + q8;
      const float sv = imp0[qq * 65 + lane] + imp1[qq * 65 + lane];
      const unsigned u = __float_as_uint(forced ? 1e4f : sv);
      u64 mk = V;
      if (c + 1 > 16) {
        unsigned thr = 0u;
        for (int bb = 30; bb >= 0; --bb) { const unsigned cand = thr | (1u << bb); const u64 ge = __ballot(u >= cand) & V; if (__popcll(ge) >= 16) thr = cand; }
        const u64 G = __ballot(u > thr) & V, E = __ballot(u == thr) & V;
        const int need = 16 - (int)__popcll(G);
        const int below = (int)__popcll(E & ((1ull << lane) - 1ull));
        const bool se = (((E >> lane) & 1ull) != 0ull) && (below < need);
        mk = G | __ballot(se);
      }
      if (lane == 0) MK[qg * 16 + qq] = mk;
      wU |= mk;
    }
  }
  u64* WU = (u64*)(lds + NSA_WU);
  if (lane == 0) WU[w8] = wU;
  __syncthreads();
  const u64 U = WU[0] | WU[1] | WU[2] | WU[3] | WU[4] | WU[5] | WU[6] | WU[7];
  const u64 mymask = ((const u64*)(lds + NSA_WU) + 8)[qg * 16 + fr];
  for (int br = 0; br < 2; ++br) {
    NSA_RESET();
    int zg;
    if (br == 0) {
      nsa_branch<2>(0, 0, U, z + tokb * LDZ + ZC_KS + g * 64, z + tokb * LDZ + ZC_VS + g * 64, LDZ, t, hp * 2, mymask, Qf, O, m, l, inv, impw, lds);
      zg = ZC_GS;
    } else {
      const int kt0 = c > 8 ? c - 8 : 0;
      nsa_branch<3>(kt0, c - kt0 + 1, 0ull, z + tokb * LDZ + ZC_KW + g * 64, z + tokb * LDZ + ZC_VW + g * 64, LDZ, t, hp * 2, 0ull, Qf, O, m, l, inv, impw, lds);
      zg = ZC_GW;
    }
#pragma unroll
    for (int r = 0; r < 2; ++r) {
      float lt = l[r]; lt += __shfl_xor(lt, 16); lt += __shfl_xor(lt, 32);
      const float gt = sigm(bf2f(zq[zg + hb + r])) * (lt > 0.f ? 1.f / lt : 0.f);
#pragma unroll
      for (int df = 0; df < 4; ++df) {
        bf16_t* yp = yo + r * 64 + df * 16;
        const u32x2 pr = *(const u32x2*)yp;
        u32x2 o; o.x = pk2(__uint_as_float(pr.x << 16) + O[df][r][0] * gt, __uint_as_float(pr.x & 0xffff0000u) + O[df][r][1] * gt);
        o.y = pk2(__uint_as_float(pr.y << 16) + O[df][r][2] * gt, __uint_as_float(pr.y & 0xffff0000u) + O[df][r][3] * gt);
        *(u32x2*)yp = o;
      }
    }
  }
  __syncthreads();
}

__device__ __forceinline__ void run_phase(const Params& P, int ph, char* lds) {
  char* ws = P.ws;
  asm volatile("" : "+s"(ws));
  bf16_t* abuf = (bf16_t*)(ws + OFF_A);
  bf16_t* big = (bf16_t*)(ws + OFF_BIG);
  bf16_t* fbuf = (bf16_t*)(ws + OFF_F);
  float* hsl = (float*)(ws + OFF_F); float* Pc = hsl + (size_t)M_TOK * 256;
  bf16_t* kcv = (bf16_t*)(ws + OFF_KC);
  float* carryP = (float*)(ws + OFF_CARRY); float* carryH = carryP + 8 * 4 * 64 * 64;
  if (ph == 0) { prep_phase(P, lds); return; }
  const int layer = (ph - 1) / 13, sp = (ph - 1) % 13;
  const float* ng = P.norm_g + (size_t)layer * 8 * 1024;
#ifdef ONLY_SP
  if (sp != ONLY_SP) return;
#endif
  switch (sp) {
    case 0: case 8: {
      const int lj = layer * 2 + (sp == 8);
      gemm_up_phase(abuf, (const bf16_t*)(ws + OFF_WGU + lj * SZ_WGU), big, lds);
    } break;
    case 1: case 9: {
      const int lj = layer * 2 + (sp == 9);
      gemm_bf16_phase(big, DFF, (const bf16_t*)(ws + OFF_WD + lj * SZ_WD), DFF, 4, fbuf, 1024, lds);
    } break;
    case 2: resnorm_phase(layer == 0 ? P.x : P.out, P.out, fbuf, 0.5f, ng + 1 * 1024, ng + 2 * 1024, abuf); break;
    case 3: gemm_bf16_phase(abuf, 1024, (const bf16_t*)(ws + OFF_WIN + layer * SZ_WIN), 1024, LDZ / 256, big, LDZ, lds); break;
    case 4: {
      const int hb = HBLK; char* hl = lds + hb * 65536;
      for (int it = blockIdx.x * 2 + hb; it < 256; it += gridDim.x * 2) compress_item(P, layer, it, big, kcv, hl);
      for (int it = blockIdx.x * 2 + hb; it < 1024; it += gridDim.x * 2) mixA_item(P, layer, it, big, abuf, hl);
      for (int it = blockIdx.x * 2 + hb; it < 2048; it += gridDim.x * 2) mixB1_item(P, layer, it, big, hsl, Pc, carryP, carryH, hl);
    } break;
    case 5: {
      nsa_tables(P, blockIdx.x & 1, lds);
      for (int it = blockIdx.x; it < 1024; it += gridDim.x) {
        const int rnd = it / 256, pos = it % 256;
        const int c = (rnd & 1) ? (rnd >> 1) * 16 + (pos >> 4) : 63 - (rnd >> 1) * 16 - (pos >> 4);
        const int bg = pos & 15;
        nsa_item(P, bg >> 1, bg & 1, c, big, kcv, abuf, lds);
      }
      const int hb = HBLK;
      for (int it = blockIdx.x * 2 + hb; it < 2048; it += gridDim.x * 2) mixB2_item(it, big, hsl, Pc, carryP, carryH, abuf);
    } break;
    case 6: gemm_bf16_phase(abuf, 1024, (const bf16_t*)(ws + OFF_WOUT + layer * SZ_SQ), 1024, 4, fbuf, 1024, lds); break;
    case 7: resnorm_phase(P.out, P.out, fbuf, 1.0f, ng + 3 * 1024, ng + 4 * 1024, abuf); break;
    case 10:
      gemm_bf16_phase((const bf16_t*)(ws + OFF_PBF) + (size_t)layer * M_TOK * 256, 256, (const bf16_t*)(ws + OFF_WPP + layer * SZ_WPP), 256, 4, big, 1024, lds);
      resnorm_phase(P.out, P.out, fbuf, 0.5f, ng + 5 * 1024, ng + 6 * 1024, abuf);
      break;
    case 11: gemm_ple_phase(abuf, (const bf16_t*)(ws + OFF_WPG + layer * SZ_SQ), big, fbuf, lds); break;
    case 12: resnorm_phase(P.out, P.out, fbuf, 1.0f, ng + 7 * 1024, layer == 0 ? P.norm_g + 8 * 1024 : nullptr, layer == 0 ? abuf : nullptr); break;
  }
}

#define XB_TMO      128
#define XB_XCNT(j)  (256  + 64 * (j))
#define XB_XSUB(j)  (1280 + 64 * (j))
#define XB_XGEN(j)  (2304 + 64 * (j))
#define XB_TOP      3328
#define XB_TOPGEN   3392
#define XCD_BAR_WORDS 3456
#define XB_SPIN_CAP (1u << 20)
#define LAS __attribute__((address_space(3)))
__device__ __forceinline__ unsigned xb_ld(unsigned* p)              { return __hip_atomic_load(p, __ATOMIC_RELAXED, __HIP_MEMORY_SCOPE_AGENT); }
__device__ __forceinline__ unsigned xb_add(unsigned* p, unsigned v) { return __hip_atomic_fetch_add(p, v, __ATOMIC_RELAXED, __HIP_MEMORY_SCOPE_AGENT); }
__device__ __forceinline__ unsigned xb_xcc_id() { return (unsigned)__builtin_amdgcn_s_getreg((3 << 11) | 20) & 0xFu; }
#define XB_SPIN(cond, bar) do { unsigned _sp = 0; while (cond) { __builtin_amdgcn_s_sleep(1); \
    if ((++_sp & 255u) == 0u) { if (xb_ld(&(bar)[XB_TMO])) break; if (_sp > XB_SPIN_CAP) { atomicAdd(&(bar)[XB_TMO], 1u); break; } } } } while (0)
struct XcdBarrier { unsigned* bar; unsigned x; volatile LAS unsigned* st; };
__device__ __forceinline__ XcdBarrier xcd_barrier_post(unsigned* bar, volatile LAS unsigned* st) {
    XcdBarrier b; b.bar = bar; b.x = xb_xcc_id(); b.st = st;
    if (threadIdx.x == 0) (void)xb_add(&bar[XB_XCNT(b.x)], 1u);
    return b;
}
__device__ __forceinline__ void xcd_barrier_complete(unsigned* bar, unsigned x, unsigned& nloc, unsigned& nx) {
    const unsigned G = gridDim.x * gridDim.y * gridDim.z;
    unsigned sum, cnt, mine, sp = 0u;
    for (;;) {
        sum = 0u; cnt = 0u; mine = 0u;
#pragma unroll
        for (unsigned j = 0; j < 16; ++j) { const unsigned c = xb_ld(&bar[XB_XCNT(j)]); sum += c; cnt += (c > 0u) ? 1u : 0u; mine = (j == x) ? c : mine; }
        if (sum == G) break;
        __builtin_amdgcn_s_sleep(1);
        if ((++sp & 255u) == 0u) { if (xb_ld(&bar[XB_TMO])) break; if (sp > XB_SPIN_CAP) { atomicAdd(&bar[XB_TMO], 1u); break; } }
    }
    nloc = mine > 0u ? mine : 1u; nx = cnt > 0u ? cnt : 1u;
}
__device__ __forceinline__ void xcd_barrier(const XcdBarrier& b) {
    asm volatile("s_waitcnt vmcnt(0)" ::: "memory");
    __syncthreads();
    if (threadIdx.x == 0) {
        unsigned* bar = b.bar;
        __builtin_amdgcn_s_waitcnt(0);
        unsigned nloc = b.st[0], nx = b.st[1];
        if (nloc == 0u) { xcd_barrier_complete(bar, b.x, nloc, nx); b.st[0] = nloc; b.st[1] = nx; }
        const unsigned old = xb_add(&bar[XB_XSUB(b.x)], 1u);
        const unsigned gen = old / nloc;
        if (old + 1u == (gen + 1u) * nloc) {
            __builtin_amdgcn_fence(__ATOMIC_RELEASE, "agent");
            asm volatile("s_waitcnt vmcnt(0)" ::: "memory");
            const unsigned og = xb_add(&bar[XB_TOP], 1u);
            const unsigned tg = og / nx;
            if (og + 1u == (tg + 1u) * nx) xb_add(&bar[XB_TOPGEN], 1u);
            else XB_SPIN(xb_ld(&bar[XB_TOPGEN]) == tg, bar);
            __builtin_amdgcn_fence(__ATOMIC_ACQUIRE, "agent");
            xb_add(&bar[XB_XGEN(b.x)], 1u);
            asm volatile("s_waitcnt vmcnt(0)" ::: "memory");
        } else {
            XB_SPIN(xb_ld(&bar[XB_XGEN(b.x)]) == gen, bar);
            __builtin_amdgcn_fence(__ATOMIC_ACQUIRE, "agent");
            asm volatile("s_waitcnt vmcnt(0)" ::: "memory");
        }
    }
    __syncthreads();
}

constexpr int LDS_BYTES = LDS_ST + 16;
__global__ void __launch_bounds__(512, 2) fwd_megakernel(Params P) {
  __shared__ __attribute__((aligned(16))) char lds[LDS_BYTES];
  cg::grid_group grid = cg::this_grid();
  volatile LAS unsigned* st = (volatile LAS unsigned*)(lds + LDS_ST);
  if (threadIdx.x == 0) { st[0] = 0u; st[1] = 0u; }
  __syncthreads();
  XcdBarrier xb = xcd_barrier_post((unsigned*)(P.ws + OFF_BAR), st);
  if (P.ws == nullptr) grid.sync();
  for (int ph = 0; ph < NPHASE; ++ph) {
    run_phase(P, ph, lds);
    if (ph + 1 < NPHASE) xcd_barrier(xb);
  }
}

__global__ void __launch_bounds__(512, 2) phase_kernel(Params P, int ph) {
  __shared__ __attribute__((aligned(16))) char lds[LDS_BYTES];
  run_phase(P, ph, lds);
}

extern "C" void kernel_launch(void* const* d_in, const int* in_sizes, int n_in, void* d_out, int out_size, void* d_ws, size_t ws_size, hipStream_t stream) {
  Params P{};
  const float** pp = (const float**)&P;
  for (int i = 0; i < 26; ++i) pp[i] = (const float*)d_in[i];
  P.out = (float*)d_out;
  P.ws = (char*)d_ws;
  if (ws_size < WS_NEED) { fprintf(stderr, "workspace too small: %zu < %zu\n", ws_size, (size_t)WS_NEED); return; }
#if MK_FUSED
  static int grid_blocks = 0;
  if (!grid_blocks) {
    int dev = 0, cus = 0, per_cu = 0;
    (void)hipGetDevice(&dev);
    (void)hipDeviceGetAttribute(&cus, hipDeviceAttributeMultiprocessorCount, dev);
    (void)hipOccupancyMaxActiveBlocksPerMultiprocessor(&per_cu, fwd_megakernel, 512, 0);
    if (per_cu > 1) per_cu = 1;
    if (per_cu < 1) per_cu = 1;
    grid_blocks = cus * per_cu;
  }
  (void)hipMemsetAsync((char*)d_ws + OFF_BAR, 0, XCD_BAR_WORDS * 4, stream);
  void* args[] = {&P};
  hipError_t e = hipLaunchCooperativeKernel((void*)fwd_megakernel, dim3(grid_blocks), dim3(512), args, 0, stream);
  if (e != hipSuccess) fprintf(stderr, "cooperative launch failed: %s (grid %d)\n", hipGetErrorString(e), grid_blocks);
#else
  for (int ph = 0; ph < NPHASE; ++ph) phase_kernel<<<256, 512, 0, stream>>>(P, ph);
#endif
}
```

```cpp
#include <hip/hip_runtime.h>
#include <hip/hip_cooperative_groups.h>
#include <cstdint>
#include <cstdio>
namespace cg = cooperative_groups;

#ifndef MK_FUSED
#define MK_FUSED 1
#endif

typedef unsigned short bf16_t;
typedef short bf16x8 __attribute__((ext_vector_type(8)));
typedef short bf16x4 __attribute__((ext_vector_type(4)));
typedef float f32x4 __attribute__((ext_vector_type(4)));
typedef unsigned long long u64;
typedef unsigned u32x4 __attribute__((ext_vector_type(4)));
typedef unsigned u32x2 __attribute__((ext_vector_type(2)));

constexpr int M_TOK = 32768, DM = 1024, DFF = 2816, NGU = 5632, NIN = 2328, LDZ = 2560, SEQ = 4096;
constexpr int NPHASE = 27;
constexpr int ZC_AU = 0, ZC_AV = 256, ZC_BX = 512, ZC_BG = 768, ZC_Q = 1024, ZC_KC = 1536, ZC_VC = 1664, ZC_KS = 1792, ZC_VS = 1920,
              ZC_KW = 2048, ZC_VW = 2176, ZC_GC = 2304, ZC_GS = 2312, ZC_GW = 2320;

constexpr size_t SZ_WGU = (size_t)NGU * 1024 * 2, SZ_WD = (size_t)1024 * DFF * 2, SZ_WIN = (size_t)LDZ * 1024 * 2, SZ_SQ = (size_t)1024 * 1024 * 2,
                 SZ_WPP = (size_t)1024 * 256 * 2, SZ_CW1 = (size_t)128 * 2048 * 2;
constexpr size_t OFF_WGU = 0;
constexpr size_t OFF_WD = OFF_WGU + 4 * SZ_WGU;
constexpr size_t OFF_WIN = OFF_WD + 4 * SZ_WD;
constexpr size_t OFF_WOUT = OFF_WIN + 2 * SZ_WIN;
constexpr size_t OFF_WPG = OFF_WOUT + 2 * SZ_SQ;
constexpr size_t OFF_WPP = OFF_WPG + 2 * SZ_SQ;
constexpr size_t OFF_CW1 = OFF_WPP + 2 * SZ_WPP;
constexpr size_t OFF_CB1 = OFF_CW1 + 4 * SZ_CW1;
constexpr size_t OFF_SGUW = OFF_CB1 + 4096;
constexpr size_t OFF_WAT = OFF_SGUW + 2 * 4 * 128 * 128 * 2;
constexpr size_t OFF_WXT = OFF_WAT + 2 * 4 * 64 * 64 * 2;
constexpr size_t OFF_PBF = OFF_WXT + 2 * 4 * 64 * 64 * 2;
constexpr size_t OFF_A = OFF_PBF + (size_t)2 * M_TOK * 256 * 2;
constexpr size_t OFF_BIG = OFF_A + (size_t)M_TOK * 1024 * 2;
constexpr size_t OFF_F = OFF_BIG + (size_t)M_TOK * DFF * 2;
constexpr size_t OFF_KC = OFF_F + (size_t)M_TOK * 1024 * 4;
constexpr size_t OFF_CARRY = OFF_KC + (size_t)2 * 8 * 2 * 256 * 64 * 2;
constexpr size_t OFF_BAR = OFF_CARRY + (size_t)2 * 8 * 4 * 64 * 64 * 4;
constexpr size_t WS_NEED = OFF_BAR + 16384;

struct Params {
  const float *x, *p, *rel_bias, *norm_g, *ffn_wg, *ffn_wu, *ffn_wd, *w_in, *w_out, *sgu_ng, *sgu_w, *sgu_b, *conv_w, *conv_b,
      *lru_wa, *lru_ba, *lru_wx, *lru_bx, *lru_lam, *cmp_pos, *cmp_w1, *cmp_b1, *cmp_w2, *cmp_b2, *ple_wg, *ple_wp;
  float* out;
  char* ws;
};

__device__ __forceinline__ int opaque_tid() { int t; asm volatile("v_mov_b32 %0, %1" : "=v"(t) : "v"(threadIdx.x)); return t; }
#define TIDX opaque_tid()
#define HTID (opaque_tid() & 255)
#define HBLK (opaque_tid() >> 8)
__device__ __forceinline__ float bf2f(bf16_t v) { return __uint_as_float(((unsigned)v) << 16); }
__device__ __forceinline__ bf16_t f2bf(float f) { unsigned u = __float_as_uint(f); u += 0x7fffu + ((u >> 16) & 1u); return (bf16_t)(u >> 16); }
__device__ __forceinline__ unsigned pk2(float lo, float hi) { unsigned r; asm("v_cvt_pk_bf16_f32 %0, %1, %2" : "=v"(r) : "v"(lo), "v"(hi)); return r; }
__device__ __forceinline__ float sigm(float x) { return __builtin_amdgcn_rcpf(1.f + __expf(-x)); }
__device__ __forceinline__ float gelu_t(float x) { float u = 0.7978845608028654f * (x + 0.044715f * x * x * x); return x * __builtin_amdgcn_rcpf(1.f + __expf(-2.f * u)); }
__device__ __forceinline__ float silu_f(float x) { return x * __builtin_amdgcn_rcpf(1.f + __expf(-x)); }
__device__ __forceinline__ f32x4 mfma16(bf16x8 a, bf16x8 b, f32x4 c) { return __builtin_amdgcn_mfma_f32_16x16x32_bf16(a, b, c, 0, 0, 0); }
__device__ __forceinline__ void glds16(const void* g, void* l) {
  __builtin_amdgcn_global_load_lds((const __attribute__((address_space(1))) unsigned*)g, (__attribute__((address_space(3))) unsigned*)l, 16, 0, 0);
}
__device__ __forceinline__ f32x4 zero4() { f32x4 z; asm volatile("v_mov_b32 %0, 0\n\tv_mov_b32 %1, 0\n\tv_mov_b32 %2, 0\n\tv_mov_b32 %3, 0" : "=v"(z[0]), "=v"(z[1]), "=v"(z[2]), "=v"(z[3])); return z; }
__device__ __forceinline__ float wave_sum(float v) {
#pragma unroll
  for (int o = 32; o > 0; o >>= 1) v += __shfl_xor(v, o);
  return v;
}
__device__ __forceinline__ void unpack8(const u32x4 u, float* f) {
  f[0] = __uint_as_float(u.x << 16); f[1] = __uint_as_float(u.x & 0xffff0000u);
  f[2] = __uint_as_float(u.y << 16); f[3] = __uint_as_float(u.y & 0xffff0000u);
  f[4] = __uint_as_float(u.z << 16); f[5] = __uint_as_float(u.z & 0xffff0000u);
  f[6] = __uint_as_float(u.w << 16); f[7] = __uint_as_float(u.w & 0xffff0000u);
}

__device__ __forceinline__ void tr_cvt(const float* __restrict__ src, int N, int K, bf16_t* __restrict__ dst, int ldd, int rs, int ro, char* ldsc) {
  const int ntn = (N + 63) >> 6, nt = ntn * (K >> 6), hb = HBLK, tid = HTID;
  float* lds = (float*)(ldsc + hb * 65536);
  for (int t0 = blockIdx.x * 6; t0 < nt; t0 += gridDim.x * 6) {
    float4 v[3][4];
#pragma unroll
    for (int u = 0; u < 3; ++u) {
      const int tile = t0 + hb * 3 + u, tk = tile / ntn, tn = tile - tk * ntn, k0 = tk * 64, n0 = tn * 64;
      const bool active = tile < nt;
#pragma unroll
      for (int ps = 0; ps < 4; ++ps) {
        const int i = ps * 16 + (tid >> 4), j = (tid & 15) * 4;
        v[u][ps] = make_float4(0.f, 0.f, 0.f, 0.f);
        if (active && n0 + j < N) v[u][ps] = *(const float4*)(src + (size_t)(k0 + i) * N + n0 + j);
      }
    }
#pragma unroll
    for (int u = 0; u < 3; ++u)
#pragma unroll
      for (int ps = 0; ps < 4; ++ps) {
        const int i = ps * 16 + (tid >> 4), j = (tid & 15) * 4;
        float* d = lds + u * 4160 + i * 65 + j; d[0] = v[u][ps].x; d[1] = v[u][ps].y; d[2] = v[u][ps].z; d[3] = v[u][ps].w;
      }
    __syncthreads();
#pragma unroll
    for (int u = 0; u < 3; ++u) {
      const int tile = t0 + hb * 3 + u, tk = tile / ntn, tn = tile - tk * ntn, k0 = tk * 64, n0 = tn * 64;
      const int j = tid >> 2, kq = tid & 3, n = n0 + j;
      if (tile < nt && n < N) {
        const float* l = lds + u * 4160;
        unsigned w[8];
#pragma unroll
        for (int q = 0; q < 8; ++q) w[q] = pk2(l[(kq * 16 + 2 * q) * 65 + j], l[(kq * 16 + 2 * q + 1) * 65 + j]);
        bf16_t* o = dst + (size_t)((n >> 4) * rs + (n & 15) + ro) * ldd + k0 + kq * 16;
        u32x4 w0, w1; w0.x = w[0]; w0.y = w[1]; w0.z = w[2]; w0.w = w[3]; w1.x = w[4]; w1.y = w[5]; w1.z = w[6]; w1.w = w[7];
        *(u32x4*)o = w0; *(u32x4*)(o + 8) = w1;
      }
    }
    __syncthreads();
  }
}

struct RowRegs { float4 h[4]; u32x2 f[4]; };
__device__ __forceinline__ void rn_load(RowRegs& R, const float* hin, const bf16_t* f, int row, int lane) {
#pragma unroll
  for (int i = 0; i < 4; ++i) R.h[i] = *(const float4*)(hin + (size_t)row * 1024 + i * 256 + lane * 4);
  if (f) {
#pragma unroll
    for (int i = 0; i < 4; ++i) R.f[i] = *(const u32x2*)(f + (size_t)row * 1024 + i * 256 + lane * 4);
  }
}
__device__ __forceinline__ void rn_proc(RowRegs& R, float* hout, bool has_f, float scale, const float* gpost, const float* gpre, bf16_t* a, int row, int lane) {
  if (has_f) {
    float fv[4][4]; float ss = 0.f;
#pragma unroll
    for (int i = 0; i < 4; ++i) {
      fv[i][0] = __uint_as_float(R.f[i].x << 16); fv[i][1] = __uint_as_float(R.f[i].x & 0xffff0000u);
      fv[i][2] = __uint_as_float(R.f[i].y << 16); fv[i][3] = __uint_as_float(R.f[i].y & 0xffff0000u);
      ss += fv[i][0] * fv[i][0] + fv[i][1] * fv[i][1] + fv[i][2] * fv[i][2] + fv[i][3] * fv[i][3];
    }
    ss = wave_sum(ss);
    const float r = rsqrtf(ss * (1.f / 1024.f) + 1e-6f) * scale;
#pragma unroll
    for (int i = 0; i < 4; ++i) { const float4 g = *(const float4*)(gpost + i * 256 + lane * 4);
      R.h[i].x += fv[i][0] * r * g.x; R.h[i].y += fv[i][1] * r * g.y; R.h[i].z += fv[i][2] * r * g.z; R.h[i].w += fv[i][3] * r * g.w; }
  }
  if (hout) {
#pragma unroll
    for (int i = 0; i < 4; ++i) *(float4*)(hout + (size_t)row * 1024 + i * 256 + lane * 4) = R.h[i];
  }
  if (a) {
    float ss = 0.f;
#pragma unroll
    for (int i = 0; i < 4; ++i) ss += R.h[i].x * R.h[i].x + R.h[i].y * R.h[i].y + R.h[i].z * R.h[i].z + R.h[i].w * R.h[i].w;
    ss = wave_sum(ss);
    const float r = rsqrtf(ss * (1.f / 1024.f) + 1e-6f);
#pragma unroll
    for (int i = 0; i < 4; ++i) { const float4 g = *(const float4*)(gpre + i * 256 + lane * 4);
      u32x2 o; o.x = pk2(R.h[i].x * r * g.x, R.h[i].y * r * g.y); o.y = pk2(R.h[i].z * r * g.z, R.h[i].w * r * g.w);
      *(u32x2*)(a + (size_t)row * 1024 + i * 256 + lane * 4) = o; }
  }
}
__device__ __forceinline__ void resnorm_phase(const float* hin, float* hout, const bf16_t* f, float scale, const float* gpost, const float* gpre, bf16_t* a) {
  const int tid = TIDX, lane = tid & 63, stride = gridDim.x * 8;
  int r0 = blockIdx.x * 8 + (tid >> 6), r1 = r0 + stride;
  RowRegs A, B;
  if (r0 < M_TOK) rn_load(A, hin, f, r0, lane);
  for (;;) {
    if (r0 >= M_TOK) break;
    if (r1 < M_TOK) rn_load(B, hin, f, r1, lane);
    rn_proc(A, hout, f != nullptr, scale, gpost, gpre, a, r0, lane);
    r0 += 2 * stride;
    if (r1 >= M_TOK) break;
    if (r0 < M_TOK) rn_load(A, hin, f, r0, lane);
    rn_proc(B, hout, f != nullptr, scale, gpost, gpre, a, r1, lane);
    r1 += 2 * stride;
  }
}

__device__ __forceinline__ void prep_phase(const Params& P, char* ldsc) {
  char* ws = P.ws;
  for (int l = 0; l < 2; ++l) {
    for (int j = 0; j < 2; ++j) {
      const int lj = l * 2 + j;
      bf16_t* wgu = (bf16_t*)(ws + OFF_WGU + lj * SZ_WGU);
      tr_cvt(P.ffn_wg + (size_t)lj * 1024 * DFF, DFF, 1024, wgu, 1024, 32, 0, ldsc);
      tr_cvt(P.ffn_wu + (size_t)lj * 1024 * DFF, DFF, 1024, wgu, 1024, 32, 16, ldsc);
      tr_cvt(P.ffn_wd + (size_t)lj * DFF * 1024, 1024, DFF, (bf16_t*)(ws + OFF_WD + lj * SZ_WD), DFF, 16, 0, ldsc);
      tr_cvt(P.cmp_w1 + (size_t)lj * 2048 * 128, 128, 2048, (bf16_t*)(ws + OFF_CW1 + lj * SZ_CW1), 2048, 16, 0, ldsc);
    }
    tr_cvt(P.w_in + (size_t)l * 1024 * NIN, NIN, 1024, (bf16_t*)(ws + OFF_WIN + l * SZ_WIN), 1024, 16, 0, ldsc);
    tr_cvt(P.w_out + (size_t)l * 1024 * 1024, 1024, 1024, (bf16_t*)(ws + OFF_WOUT + l * SZ_SQ), 1024, 16, 0, ldsc);
    tr_cvt(P.ple_wg + (size_t)l * 1024 * 1024, 1024, 1024, (bf16_t*)(ws + OFF_WPG + l * SZ_SQ), 1024, 16, 0, ldsc);
    tr_cvt(P.ple_wp + (size_t)l * 256 * 1024, 1024, 256, (bf16_t*)(ws + OFF_WPP + l * SZ_WPP), 256, 16, 0, ldsc);
    for (int g = 0; g < 4; ++g) {
      tr_cvt(P.lru_wa + (size_t)(l * 4 + g) * 4096, 64, 64, (bf16_t*)(ws + OFF_WAT) + (l * 4 + g) * 4096, 64, 16, 0, ldsc);
      tr_cvt(P.lru_wx + (size_t)(l * 4 + g) * 4096, 64, 64, (bf16_t*)(ws + OFF_WXT) + (l * 4 + g) * 4096, 64, 16, 0, ldsc);
    }
  }
  const int tid = TIDX, gtid = blockIdx.x * 512 + tid, gn = gridDim.x * 512;
  for (int i = gtid; i < 2 * (LDZ - NIN) * 1024 / 8; i += gn) {
    const int l = i / ((LDZ - NIN) * 128), r = i - l * ((LDZ - NIN) * 128);
    *(f32x4*)((bf16_t*)(ws + OFF_WIN + l * SZ_WIN) + (size_t)NIN * 1024 + (size_t)r * 8) = zero4();
  }
  for (int i = gtid; i < 2 * 4 * 128 * 128; i += gn) { const int t = (i >> 7) & 127, s2 = i & 127; ((bf16_t*)(ws + OFF_SGUW))[i] = (s2 <= t) ? f2bf(P.sgu_w[i]) : (bf16_t)0; }
  for (int i = gtid; i < 2 * M_TOK * 256 / 4; i += gn) { const float4 v = ((const float4*)P.p)[i]; uint2 o; o.x = pk2(v.x, v.y); o.y = pk2(v.z, v.w); ((uint2*)(ws + OFF_PBF))[i] = o; }
  {
    float* lds = (float*)(ldsc + HBLK * 65536);
    for (int u = blockIdx.x; u < 4; u += gridDim.x) {
      const int t2 = HTID, kq = t2 >> 5, jq = t2 & 31;
      const float* w1 = P.cmp_w1 + (size_t)u * 2048 * 128; const float* pos = P.cmp_pos + (size_t)u * 2048;
      float4 sacc = make_float4(0.f, 0.f, 0.f, 0.f);
      for (int k = kq * 256; k < kq * 256 + 256; ++k) { const float pv = pos[k]; const float4 w = *(const float4*)(w1 + (size_t)k * 128 + jq * 4); sacc.x += pv * w.x; sacc.y += pv * w.y; sacc.z += pv * w.z; sacc.w += pv * w.w; }
      __syncthreads();
      lds[kq * 128 + jq * 4 + 0] = sacc.x; lds[kq * 128 + jq * 4 + 1] = sacc.y; lds[kq * 128 + jq * 4 + 2] = sacc.z; lds[kq * 128 + jq * 4 + 3] = sacc.w;
      __syncthreads();
      if (t2 < 128) { float t = P.cmp_b1[u * 128 + t2]; for (int q = 0; q < 8; ++q) t += lds[q * 128 + t2]; ((float*)(ws + OFF_CB1))[u * 128 + t2] = t; }
      __syncthreads();
    }
  }
  resnorm_phase(P.x, nullptr, nullptr, 0.f, nullptr, P.norm_g, (bf16_t*)(ws + OFF_A));
}

constexpr int G8_HT = 128 * 64;
__device__ __forceinline__ int g8_lds_byte(int r, int c) { const int st = (r >> 4) * 2 + (c >> 5), rr = r & 15, cc = c & 31, ob = rr * 64 + cc * 2; return st * 1024 + (ob ^ (((ob >> 9) & 1) << 5)); }
__device__ __forceinline__ void g8_stage_rc(int b, int& R, int& C) { const int st = b / 1024, sb = b % 1024, swz = sb ^ (((sb >> 9) & 1) << 5); R = (st >> 1) * 16 + swz / 64; C = (st & 1) * 32 + (swz % 64) / 2; }

__device__ __forceinline__ void gemm_core(f32x4 (&acc)[2][2][4][2], const bf16_t* __restrict__ A, int lda, const bf16_t* __restrict__ Bt, int ldb, int K, char* ldsc) {
  bf16_t* shm = (bf16_t*)ldsc;
  const int tid = TIDX, wid = tid >> 6, lane = tid & 63, wr = wid >> 2, wc = wid & 3, fr = lane & 15, fq = lane >> 4;
  int sr0, sc0;
  g8_stage_rc(tid * 16, sr0, sc0);
  const bf16_t* gA0 = A + (size_t)sr0 * lda + sc0;
  const bf16_t* gB0 = Bt + (size_t)sr0 * ldb + sc0;
  const size_t a64 = (size_t)64 * lda, b64 = (size_t)64 * ldb;
  const int lane_off = (fr * 64 + fq * 16) ^ ((((fr * 64 + fq * 16) >> 9) & 1) << 5);
  const char* ldA = ldsc + wr * 8192 + lane_off;
  const char* ldB = ldsc + 65536 + wc * 4096 + lane_off;
#define SA(b, h) (shm + ((b) * 2 + (h)) * G8_HT)
#define SB(b, h) (shm + (4 + (b) * 2 + (h)) * G8_HT)
#define STAGE_A(P, h, kt) { const bf16_t* g_ = gA0 + (size_t)(h) * 2 * a64 + (kt) * 64; glds16(g_, (char*)(P) + tid * 16); glds16(g_ + a64, (char*)(P) + tid * 16 + 8192); }
#define STAGE_B(P, h, kt) { const bf16_t* g_ = gB0 + (size_t)(h) * 2 * b64 + (kt) * 64; glds16(g_, (char*)(P) + tid * 16); glds16(g_ + b64, (char*)(P) + tid * 16 + 8192); }
#define LDA(dst, b, h) _Pragma("unroll") for (int m = 0; m < 4; ++m) _Pragma("unroll") for (int k = 0; k < 2; ++k) \
    dst[m][k] = *reinterpret_cast<const bf16x8*>(ldA + ((b) * 2 + (h)) * 16384 + (m * 2 + k) * 1024)
#define LDB(dst, b, h) _Pragma("unroll") for (int n = 0; n < 2; ++n) _Pragma("unroll") for (int k = 0; k < 2; ++k) \
    dst[n][k] = *reinterpret_cast<const bf16x8*>(ldB + ((b) * 2 + (h)) * 16384 + (n * 2 + k) * 1024)
#define MMA(ai, bj, At_, Bt_) do { __builtin_amdgcn_s_setprio(1); \
    _Pragma("unroll") for (int m = 0; m < 4; ++m) _Pragma("unroll") for (int n = 0; n < 2; ++n) _Pragma("unroll") for (int k = 0; k < 2; ++k) \
      acc[ai][bj][m][n] = mfma16(Bt_[n][k], At_[m][k], acc[ai][bj][m][n]); \
    __builtin_amdgcn_s_setprio(0); } while (0)
#define WAIT_V(n) asm volatile("s_waitcnt vmcnt(" #n ")" ::: "memory")
#define WAIT_L(n) asm volatile("s_waitcnt lgkmcnt(" #n ")" ::: "memory")
#define BAR __builtin_amdgcn_s_barrier()
#define SCHED __builtin_amdgcn_sched_barrier(0)
  bf16x8 At[4][2], B0[2][2], B1[2][2];
  const int nt = K >> 6;
  STAGE_B(SB(0, 0), 0, 0); STAGE_A(SA(0, 0), 0, 0);
  STAGE_B(SB(0, 1), 1, 0); STAGE_A(SA(0, 1), 1, 0);
  if (wr == 1) BAR;
  WAIT_V(4); BAR;
  STAGE_B(SB(1, 0), 0, 1); STAGE_A(SA(1, 0), 0, 1); STAGE_B(SB(1, 1), 1, 1);
  WAIT_V(6); BAR;
#pragma nounroll
  for (int t = 0; t < nt - 2; t += 2) {
    LDB(B0, 0, 0); SCHED; LDA(At, 0, 0); STAGE_A(SA(1, 1), 1, t + 1);
    WAIT_L(8); BAR; WAIT_L(0); MMA(0, 0, At, B0); BAR; SCHED;
    LDB(B1, 0, 1); STAGE_B(SB(0, 0), 0, t + 2);
    BAR; WAIT_L(0); MMA(0, 1, At, B1); BAR;
    LDA(At, 0, 1); STAGE_A(SA(0, 0), 0, t + 2);
    BAR; WAIT_L(0); MMA(1, 0, At, B0); BAR; SCHED;
    STAGE_B(SB(0, 1), 1, t + 2);
    WAIT_V(6); BAR; MMA(1, 1, At, B1); BAR;
    LDB(B0, 1, 0); SCHED; LDA(At, 1, 0); STAGE_A(SA(0, 1), 1, t + 2);
    WAIT_L(8); BAR; WAIT_L(0); MMA(0, 0, At, B0); BAR; SCHED;
    LDB(B1, 1, 1); STAGE_B(SB(1, 0), 0, t + 3);
    BAR; WAIT_L(0); MMA(0, 1, At, B1); BAR;
    LDA(At, 1, 1); STAGE_A(SA(1, 0), 0, t + 3);
    BAR; WAIT_L(0); MMA(1, 0, At, B0); BAR; SCHED;
    STAGE_B(SB(1, 1), 1, t + 3);
    WAIT_V(6); BAR; MMA(1, 1, At, B1); BAR;
  }
  { LDB(B0, 0, 0); LDA(At, 0, 0); STAGE_A(SA(1, 1), 1, nt - 1);
    BAR; WAIT_L(0); MMA(0, 0, At, B0); BAR;
    LDB(B1, 0, 1); BAR; WAIT_L(0); MMA(0, 1, At, B1); BAR;
    LDA(At, 0, 1); WAIT_V(4); BAR; WAIT_L(0); MMA(1, 0, At, B0); MMA(1, 1, At, B1); BAR; }
  { LDB(B0, 1, 0); LDA(At, 1, 0); WAIT_V(2); BAR; WAIT_L(0); MMA(0, 0, At, B0); BAR;
    LDB(B1, 1, 1); WAIT_V(0); BAR; WAIT_L(0); MMA(0, 1, At, B1); BAR;
    LDA(At, 1, 1); BAR; WAIT_L(0); MMA(1, 0, At, B0); MMA(1, 1, At, B1); BAR; }
  if (wr == 0) BAR;
  BAR;
#undef SA
#undef SB
#undef STAGE_A
#undef STAGE_B
#undef LDA
#undef LDB
#undef MMA
#undef WAIT_V
#undef WAIT_L
#undef BAR
#undef SCHED
}

template <class F> __device__ __forceinline__ void gemm_sched(int TN, F&& f) {
  const int npc = (TN + 1) >> 1, npatch = 8 * npc, xcd = blockIdx.x & 7, slot = blockIdx.x >> 3, nslot = gridDim.x >> 3;
  for (int pid = xcd; pid < npatch; pid += 8) {
    const int pr = pid / npc, pc = pid - pr * npc;
    for (int s = slot; s < 32; s += nslot) {
      const int tm = pr * 16 + (s & 15), tn = pc * 2 + (s >> 4);
      if (tn < TN) f(tm, tn);
    }
  }
}

#define GEMM_LANE const int tid_ = TIDX, lane_ = tid_ & 63, wid_ = tid_ >> 6, wr = wid_ >> 2, wc = wid_ & 3, fr = lane_ & 15, fq = lane_ >> 4
#define GEMM_EPI_LOOP _Pragma("unroll") for (int ai = 0; ai < 2; ++ai) _Pragma("unroll") for (int m = 0; m < 4; ++m) _Pragma("unroll") for (int bj = 0; bj < 2; ++bj)

__device__ __forceinline__ void gemm_up_phase(const bf16_t* a, const bf16_t* wgu, bf16_t* act, char* lds) {
  gemm_sched(NGU / 256, [&](int tm, int tn) {
    f32x4 acc[2][2][4][2];
    _Pragma("unroll") for (int i0 = 0; i0 < 2; ++i0) _Pragma("unroll") for (int i1 = 0; i1 < 2; ++i1) _Pragma("unroll") for (int i2 = 0; i2 < 4; ++i2) _Pragma("unroll") for (int i3 = 0; i3 < 2; ++i3) acc[i0][i1][i2][i3] = zero4();
    gemm_core(acc, a + (size_t)tm * 256 * 1024, 1024, wgu + (size_t)tn * 256 * 1024, 1024, 1024, lds);
    GEMM_LANE;
    GEMM_EPI_LOOP {
      const int row = tm * 256 + ai * 128 + wr * 64 + m * 16 + fr;
      const int col = tn * 128 + bj * 64 + wc * 16 + 4 * fq;
      const f32x4 g = acc[ai][bj][m][0], u = acc[ai][bj][m][1];
      uint2 o; o.x = pk2(silu_f(g[0]) * u[0], silu_f(g[1]) * u[1]); o.y = pk2(silu_f(g[2]) * u[2], silu_f(g[3]) * u[3]);
      *(uint2*)(act + (size_t)row * DFF + col) = o;
    }
  });
}

__device__ __forceinline__ void gemm_f32_phase(const bf16_t* A, int lda, const bf16_t* Bt, int K, float* out, char* lds) {
  gemm_sched(4, [&](int tm, int tn) {
    f32x4 acc[2][2][4][2];
    _Pragma("unroll") for (int i0 = 0; i0 < 2; ++i0) _Pragma("unroll") for (int i1 = 0; i1 < 2; ++i1) _Pragma("unroll") for (int i2 = 0; i2 < 4; ++i2) _Pragma("unroll") for (int i3 = 0; i3 < 2; ++i3) acc[i0][i1][i2][i3] = zero4();
    gemm_core(acc, A + (size_t)tm * 256 * lda, lda, Bt + (size_t)tn * 256 * K, K, K, lds);
    GEMM_LANE;
    GEMM_EPI_LOOP {
      const int row = tm * 256 + ai * 128 + wr * 64 + m * 16 + fr;
#pragma unroll
      for (int n = 0; n < 2; ++n) *(f32x4*)(out + (size_t)row * 1024 + tn * 256 + bj * 128 + wc * 32 + n * 16 + 4 * fq) = acc[ai][bj][m][n];
    }
  });
}

__device__ __forceinline__ void gemm_bf16_phase(const bf16_t* A, int lda, const bf16_t* Bt, int K, int TN, bf16_t* out, int ldo, char* lds) {
  gemm_sched(TN, [&](int tm, int tn) {
    f32x4 acc[2][2][4][2];
    _Pragma("unroll") for (int i0 = 0; i0 < 2; ++i0) _Pragma("unroll") for (int i1 = 0; i1 < 2; ++i1) _Pragma("unroll") for (int i2 = 0; i2 < 4; ++i2) _Pragma("unroll") for (int i3 = 0; i3 < 2; ++i3) acc[i0][i1][i2][i3] = zero4();
    gemm_core(acc, A + (size_t)tm * 256 * lda, lda, Bt + (size_t)tn * 256 * K, K, K, lds);
    GEMM_LANE;
    GEMM_EPI_LOOP {
      const int row = tm * 256 + ai * 128 + wr * 64 + m * 16 + fr;
#pragma unroll
      for (int n = 0; n < 2; ++n) {
        uint2 o; o.x = pk2(acc[ai][bj][m][n][0], acc[ai][bj][m][n][1]); o.y = pk2(acc[ai][bj][m][n][2], acc[ai][bj][m][n][3]);
        *(uint2*)(out + (size_t)row * ldo + tn * 256 + bj * 128 + wc * 32 + n * 16 + 4 * fq) = o;
      }
    }
  });
}

__device__ __forceinline__ void gemm_ple_phase(const bf16_t* a, const bf16_t* wpg, const bf16_t* pp, bf16_t* out, char* lds) {
  gemm_sched(4, [&](int tm, int tn) {
    f32x4 acc[2][2][4][2];
    _Pragma("unroll") for (int i0 = 0; i0 < 2; ++i0) _Pragma("unroll") for (int i1 = 0; i1 < 2; ++i1) _Pragma("unroll") for (int i2 = 0; i2 < 4; ++i2) _Pragma("unroll") for (int i3 = 0; i3 < 2; ++i3) acc[i0][i1][i2][i3] = zero4();
    gemm_core(acc, a + (size_t)tm * 256 * 1024, 1024, wpg + (size_t)tn * 256 * 1024, 1024, 1024, lds);
    GEMM_LANE;
    GEMM_EPI_LOOP {
      const int row = tm * 256 + ai * 128 + wr * 64 + m * 16 + fr;
#pragma unroll
      for (int n = 0; n < 2; ++n) {
        const int col = tn * 256 + bj * 128 + wc * 32 + n * 16 + 4 * fq;
        const u32x2 pv = *(const u32x2*)(pp + (size_t)row * 1024 + col);
        const f32x4 av = acc[ai][bj][m][n];
        u32x2 o;
        o.x = pk2(sigm(av[0]) * __uint_as_float(pv.x << 16), sigm(av[1]) * __uint_as_float(pv.x & 0xffff0000u));
        o.y = pk2(sigm(av[2]) * __uint_as_float(pv.y << 16), sigm(av[3]) * __uint_as_float(pv.y & 0xffff0000u));
        *(u32x2*)(out + (size_t)row * 1024 + col) = o;
      }
    }
  });
}

__device__ __forceinline__ void mixA_item(const Params& P, int layer, int idx, const bf16_t* z, bf16_t* y, char* lds) {
  const int g = idx & 3, bc = idx >> 2, tok0 = bc * 128;
  const int tid = HTID, lane = tid & 63, w = tid >> 6, fr = lane & 15, fq = lane >> 4;
  bf16_t* vT = (bf16_t*)lds;
  const float* ng = P.sgu_ng + layer * 256;
  {
    const int s = tid >> 1, half = tid & 1;
    const bf16_t* zr = z + (size_t)(tok0 + s) * LDZ + ZC_AV;
    float ss = 0.f;
#pragma unroll 4
    for (int i = 0; i < 16; ++i) { float v[8]; unpack8(*(const u32x4*)(zr + half * 128 + i * 8), v);
#pragma unroll
      for (int e = 0; e < 8; ++e) { const float t = gelu_t(v[e]); ss += t * t; } }
    ss += __shfl_xor(ss, 1);
    const float rs = rsqrtf(ss * (1.f / 256.f) + 1e-6f);
#pragma unroll
    for (int i = 0; i < 4; ++i) { float v[8]; unpack8(*(const u32x4*)(zr + g * 64 + half * 32 + i * 8), v);
#pragma unroll
      for (int e = 0; e < 8; ++e) { const int d = half * 32 + i * 8 + e; vT[d * 136 + s] = f2bf(gelu_t(v[e]) * rs * ng[g * 64 + d]); } }
  }
  __syncthreads();
  const bf16_t* W = (const bf16_t*)(P.ws + OFF_SGUW) + (size_t)((layer * 4 + g) * 128) * 128;
  f32x4 acc[2][4] = {};
  for (int ks = 0; ks <= w; ++ks) {
    bf16x8 wf[2], vf[4];
#pragma unroll
    for (int tm = 0; tm < 2; ++tm) wf[tm] = *(const bf16x8*)(W + (size_t)(32 * w + tm * 16 + fr) * 128 + ks * 32 + 8 * fq);
#pragma unroll
    for (int dn = 0; dn < 4; ++dn) vf[dn] = *(const bf16x8*)(vT + (dn * 16 + fr) * 136 + ks * 32 + 8 * fq);
#pragma unroll
    for (int tm = 0; tm < 2; ++tm)
#pragma unroll
      for (int dn = 0; dn < 4; ++dn) acc[tm][dn] = mfma16(vf[dn], wf[tm], acc[tm][dn]);
  }
#pragma unroll
  for (int tm = 0; tm < 2; ++tm) {
    const int t = 32 * w + tm * 16 + fr;
    const float bias = P.sgu_b[(layer * 4 + g) * 128 + t];
#pragma unroll
    for (int dn = 0; dn < 4; ++dn) {
      const int d = dn * 16 + 4 * fq;
      const uint2 uu = *(const uint2*)(z + (size_t)(tok0 + t) * LDZ + ZC_AU + g * 64 + d);
      const float u0 = gelu_t(__uint_as_float(uu.x << 16)), u1 = gelu_t(__uint_as_float(uu.x & 0xffff0000u)),
                  u2 = gelu_t(__uint_as_float(uu.y << 16)), u3 = gelu_t(__uint_as_float(uu.y & 0xffff0000u));
      uint2 o; o.x = pk2(u0 * (acc[tm][dn][0] + bias), u1 * (acc[tm][dn][1] + bias)); o.y = pk2(u2 * (acc[tm][dn][2] + bias), u3 * (acc[tm][dn][3] + bias));
      *(uint2*)(y + (size_t)(tok0 + t) * 1024 + g * 64 + d) = o;
    }
  }
  __syncthreads();
}

__device__ __forceinline__ void mixB1_item(const Params& P, int layer, int idx, const bf16_t* z, float* hsl, float* Pc, float* carryP, float* carryH, char* lds) {
  const int c = idx & 63, g = (idx >> 6) & 3, b = idx >> 8;
  const int tid = HTID, lane = tid & 63, w = tid >> 6, fr = lane & 15, fq = lane >> 4;
  bf16_t* xcb = (bf16_t*)lds;
  float* xcf = (float*)(lds + 9216);
  float* aA = (float*)(lds + 9216 + 16384);
  float* bB = (float*)(lds + 9216 + 32768);
  float* sm = (float*)(lds + 9216 + 49152);
  const size_t tokb = (size_t)b * SEQ;
  {
    const int t = tid >> 2, q = tid & 3;
    float accv[16];
#pragma unroll
    for (int i = 0; i < 16; ++i) accv[i] = P.conv_b[layer * 256 + g * 64 + q * 16 + i];
#pragma unroll
    for (int k = 0; k < 4; ++k) {
      const int pos = c * 64 + t - 3 + k;
      if (pos >= 0) {
        const bf16_t* zr = z + (tokb + pos) * LDZ + ZC_BX + g * 64 + q * 16;
        float v[16]; unpack8(*(const u32x4*)zr, v); unpack8(*(const u32x4*)(zr + 8), v + 8);
        const float* cw = P.conv_w + (size_t)(layer * 4 + k) * 256 + g * 64 + q * 16;
#pragma unroll
        for (int i = 0; i < 16; ++i) accv[i] += v[i] * cw[i];
      }
    }
#pragma unroll
    for (int i = 0; i < 16; ++i) { xcf[t * 64 + q * 16 + i] = accv[i]; xcb[t * 72 + q * 16 + i] = f2bf(accv[i]); }
  }
  __syncthreads();
  {
    const bf16_t* wa = (const bf16_t*)(P.ws + OFF_WAT) + (layer * 4 + g) * 4096;
    const bf16_t* wx = (const bf16_t*)(P.ws + OFF_WXT) + (layer * 4 + g) * 4096;
    f32x4 ar[4] = {}, ai[4] = {};
#pragma unroll
    for (int ks = 0; ks < 2; ++ks) {
      const bf16x8 xf = *(const bf16x8*)(xcb + (16 * w + fr) * 72 + ks * 32 + 8 * fq);
#pragma unroll
      for (int jn = 0; jn < 4; ++jn) {
        const bf16x8 fa = *(const bf16x8*)(wa + (jn * 16 + fr) * 64 + ks * 32 + 8 * fq);
        const bf16x8 fx = *(const bf16x8*)(wx + (jn * 16 + fr) * 64 + ks * 32 + 8 * fq);
        ar[jn] = mfma16(fa, xf, ar[jn]); ai[jn] = mfma16(fx, xf, ai[jn]);
      }
    }
    const int t = 16 * w + fr;
#pragma unroll
    for (int jn = 0; jn < 4; ++jn)
#pragma unroll
      for (int e = 0; e < 4; ++e) {
        const int j = jn * 16 + 4 * fq + e, ch = layer * 256 + g * 64 + j;
        const float r = sigm(ar[jn][e] + P.lru_ba[ch]), ig = sigm(ai[jn][e] + P.lru_bx[ch]);
        const float lam = P.lru_lam[ch];
        const float xe = __expf(-lam);
        float m8; asm volatile("v_mov_b32 %0, 0xc1000000" : "=v"(m8));
        const float la = m8 * r * (xe * (1.f - xe * (0.5f - xe * (1.f / 3.f))));
        const float av = __expf(la);
        const float y2 = 2.f * la;
        const float om = -y2 * (1.f + y2 * (0.5f + y2 * ((1.f / 6.f) + y2 * ((1.f / 24.f) + y2 * ((1.f / 120.f) + y2 * (1.f / 720.f))))));
        const float bv = sqrtf(om) * (ig * xcf[t * 64 + j]);
        aA[t * 64 + j] = av; bB[t * 64 + j] = bv;
      }
  }
  __syncthreads();
  {
    const int q = tid >> 6, j = tid & 63;
    float Pq = 1.f, hq = 0.f;
#pragma unroll
    for (int i = 0; i < 16; ++i) { const int t = q * 16 + i; const float av = aA[t * 64 + j], bv = bB[t * 64 + j]; hq = av * hq + bv; Pq *= av; aA[t * 64 + j] = Pq; bB[t * 64 + j] = hq; }
    sm[q * 64 + j] = Pq; sm[256 + q * 64 + j] = hq;
    __syncthreads();
    float Pin = 1.f, Hin = 0.f;
    for (int qq = 0; qq < q; ++qq) { const float pp = sm[qq * 64 + j], hh = sm[256 + qq * 64 + j]; Hin = pp * Hin + hh; Pin *= pp; }
    float hl = 0.f, pl = 1.f;
#pragma unroll
    for (int i = 0; i < 16; ++i) { const int t = q * 16 + i; hl = bB[t * 64 + j] + aA[t * 64 + j] * Hin; pl = aA[t * 64 + j] * Pin;
      const size_t o = (tokb + c * 64 + t) * 256 + g * 64 + j; hsl[o] = hl; Pc[o] = pl; }
    if (q == 3) { const int o = ((b * 4 + g) * 64 + c) * 64 + j; carryP[o] = pl; carryH[o] = hl; }
  }
  __syncthreads();
}

__device__ __forceinline__ void mixB2_item(int idx, const bf16_t* z, const float* hsl, const float* Pc, const float* carryP, const float* carryH, bf16_t* y) {
  const int c = idx & 63, g = (idx >> 6) & 3, b = idx >> 8;
  const int q = HTID >> 6, j = HTID & 63;
  const float* cp = carryP + (size_t)((b * 4 + g) * 64) * 64 + j;
  const float* chh = carryH + (size_t)((b * 4 + g) * 64) * 64 + j;
  float H = 0.f;
  for (int c0 = 0; c0 < c; c0 += 8) {
    float pv[8], hv[8];
#pragma unroll
    for (int i = 0; i < 8; ++i) { const bool ok = c0 + i < c; pv[i] = ok ? cp[(c0 + i) * 64] : 1.f; hv[i] = ok ? chh[(c0 + i) * 64] : 0.f; }
#pragma unroll
    for (int i = 0; i < 8; ++i) H = pv[i] * H + hv[i];
  }
  const size_t tokb = (size_t)b * SEQ + c * 64 + q * 16;
#pragma unroll 4
  for (int i = 0; i < 16; ++i) {
    const size_t o = (tokb + i) * 256 + g * 64 + j;
    const float h = hsl[o] + Pc[o] * H;
    const float gt = bf2f(z[(tokb + i) * LDZ + ZC_BG + g * 64 + j]);
    y[(tokb + i) * 1024 + 256 + g * 64 + j] = f2bf(h * gelu_t(gt));
  }
}

__device__ __forceinline__ void compress_item(const Params& P, int layer, int idx, const bf16_t* z, bf16_t* kcv, char* lds) {
  const int nb = idx & 15, g = (idx >> 4) & 1, b = (idx >> 5) & 7, kv = idx >> 8;
  const int tid = HTID, lane = tid & 63, w = tid >> 6, fr = lane & 15, fq = lane >> 4;
  const int n0 = nb * 16, col = (kv ? ZC_VC : ZC_KC) + g * 64;
  const bf16_t* w1t = (const bf16_t*)(P.ws + OFF_CW1 + (size_t)(layer * 2 + kv) * SZ_CW1);
  float* part = (float*)lds;
  float* hid = (float*)(lds + 34816);
  f32x4 acc[8];
#pragma unroll
  for (int jf = 0; jf < 8; ++jf) acc[jf] = zero4();
  int nn = n0 + fr; if (nn > 254) nn = 254;
  const bf16_t* zb = z + ((size_t)b * SEQ + 16 * nn) * LDZ + col + 8 * fq;
  const bf16_t* wb = w1t + (size_t)fr * 2048 + 8 * fq;
#pragma unroll 4
  for (int kk = 0; kk < 16; ++kk) {
    const int ks = 16 * w + kk, l = ks >> 1, d0 = (ks & 1) * 32;
    const bf16x8 xf = *(const bf16x8*)(zb + (size_t)l * LDZ + d0);
#pragma unroll
    for (int jf = 0; jf < 8; ++jf) { const bf16x8 wf = *(const bf16x8*)(wb + (size_t)jf * 16 * 2048 + ks * 32); acc[jf] = mfma16(wf, xf, acc[jf]); }
  }
#pragma unroll
  for (int jf = 0; jf < 8; ++jf)
#pragma unroll
    for (int e = 0; e < 4; ++e) part[(w * 16 + fr) * 132 + jf * 16 + 4 * fq + e] = acc[jf][e];
  __syncthreads();
  const float* cb1 = (const float*)(P.ws + OFF_CB1) + (layer * 2 + kv) * 128;
  {
    const int n = tid >> 4, j0 = (tid & 15) * 8;
#pragma unroll
    for (int e = 0; e < 8; ++e) { const int j = j0 + e; const float v = ((part[(0 * 16 + n) * 132 + j] + part[(1 * 16 + n) * 132 + j]) + part[(2 * 16 + n) * 132 + j]) + part[(3 * 16 + n) * 132 + j];
      hid[n * 129 + j] = gelu_t(v + cb1[j]); }
  }
  __syncthreads();
  {
    const int n = tid >> 4, d0 = (tid & 15) * 4;
    const float* w2 = P.cmp_w2 + (size_t)(layer * 2 + kv) * 128 * 64 + d0;
    const float4 bb = *(const float4*)(P.cmp_b2 + (layer * 2 + kv) * 64 + d0);
    float o0 = bb.x, o1 = bb.y, o2 = bb.z, o3 = bb.w;
#pragma unroll 8
    for (int j = 0; j < 128; ++j) { const float hv = hid[n * 129 + j]; const float4 wa = *(const float4*)(w2 + j * 64); o0 += hv * wa.x; o1 += hv * wa.y; o2 += hv * wa.z; o3 += hv * wa.w; }
    u32x2 ov; ov.x = pk2(o0, o1); ov.y = pk2(o2, o3);
    if ((n0 + n) >= 255) { ov.x = 0u; ov.y = 0u; }
    *(u32x2*)(kcv + ((size_t)((kv * 8 + b) * 2 + g) * 256 + n0 + n) * 64 + d0) = ov;
  }
  __syncthreads();
}

constexpr int NSA_KT = 0, NSA_VT = 16384, NSA_T = 33792, NSA_TW = NSA_T + 4 * 4160 * 4, NSA_IMP = NSA_TW + 4 * 640 * 4, NSA_WU = NSA_IMP + 2 * 16640;
constexpr int LDS_ST = 147456;
constexpr float LOG2E = 1.4426950408889634f;

__device__ __forceinline__ void nsa_tables(const Params& P, int g, char* lds) {
  float* T = (float*)(lds + NSA_T);
  float* TW = (float*)(lds + NSA_TW);
  const int tid = TIDX;
  for (int i = tid; i < 4160; i += 512) {
    const int n = i - 64;
    int bk = n;
    if (n >= 16) bk = 16 + (n >= 21) + (n >= 27) + (n >= 35) + (n >= 46) + (n >= 59) + (n >= 77) + (n >= 99) + (n >= 128) + (n >= 166) + (n >= 216) + (n >= 280) + (n >= 363) + (n >= 470) + (n >= 609) + (n >= 790);
#pragma unroll
    for (int r = 0; r < 4; ++r) {
      const float v = n >= 0 ? P.rel_bias[bk * 8 + g * 4 + r] * LOG2E : -__builtin_inff();
      T[r * 4160 + i] = v;
      if (i < 640) TW[r * 640 + i] = (n < 512) ? v : -__builtin_inff();
    }
  }
  __syncthreads();
}

struct KVRegs { u32x4 k0, v0; };
__device__ __forceinline__ void kv_gload(KVRegs& r, const bf16_t* kb, const bf16_t* vb, size_t stride) {
  const int tid = TIDX, row = tid >> 3, cq = tid & 7;
  r.k0 = *(const u32x4*)(kb + row * stride + cq * 8); r.v0 = *(const u32x4*)(vb + row * stride + cq * 8);
}
__device__ __forceinline__ void kv_lwrite(const KVRegs& r, char* lds, int buf) {
  const int tid = TIDX, row = tid >> 3, cq = tid & 7;
  char* kt = lds + NSA_KT + buf * 8192 + row * 128;
  *(u32x4*)(kt + ((cq ^ (row & 7)) << 4)) = r.k0;
  bf16_t* vt = (bf16_t*)(lds + NSA_VT + buf * 8704) + (cq * 8) * 68 + row;
#pragma unroll
  for (int i = 0; i < 4; ++i) { vt[(2 * i) * 68] = (bf16_t)(r.v0[i] & 0xffffu); vt[(2 * i + 1) * 68] = (bf16_t)(r.v0[i] >> 16); }
}

template <int MODE>
__device__ __forceinline__ void nsa_compute(int cur, int buf, int t, int hl, u64 mymask, const bf16x8 (&Qf)[2][2], f32x4 (&O)[4][2], float (&m)[2], float (&l)[2],
                                            const float (&inv)[2], float* impw, char* lds) {
  const int lane = TIDX & 63, fr = lane & 15, fq = lane >> 4;
  const char* kt = lds + NSA_KT + buf * 8192;
  const bf16_t* vt = (const bf16_t*)(lds + NSA_VT + buf * 8704);
  const bool selok = (MODE == 2) ? (((mymask >> cur) & 1ull) != 0ull) : true;
  const float* tb = (MODE == 3) ? (const float*)(lds + NSA_TW) + hl * 640 : (const float*)(lds + NSA_T) + hl * 4160;
  constexpr int TS = (MODE == 3) ? 640 : 4160;
  const int base = (MODE <= 1) ? (t - 31 - 16 * (cur * 64 + 4 * fq) + 64) : (t - cur * 64 - 4 * fq + 64);
#pragma unroll
  for (int s2 = 0; s2 < 2; ++s2) {
    f32x4 S[2][2];
    S[0][0] = zero4(); S[0][1] = zero4(); S[1][0] = zero4(); S[1][1] = zero4();
#pragma unroll
    for (int ks = 0; ks < 2; ++ks)
#pragma unroll
      for (int kk = 0; kk < 2; ++kk) {
        const bf16x8 kf = *(const bf16x8*)(kt + (32 * s2 + 16 * kk + fr) * 128 + (((ks * 4 + fq) ^ (fr & 7)) << 4));
#pragma unroll
        for (int r = 0; r < 2; ++r) S[kk][r] = mfma16(kf, Qf[r][ks], S[kk][r]);
      }
    bf16x8 Pf[2];
    float g1s[2] = {0.f, 0.f}, p3s[2] = {0.f, 0.f};
#pragma unroll
    for (int r = 0; r < 2; ++r) {
      float sv[2][4];
#pragma unroll
      for (int kk = 0; kk < 2; ++kk)
#pragma unroll
        for (int e = 0; e < 4; ++e) {
          const int off = 32 * s2 + 16 * kk + e;
          int idx;
          if (MODE <= 1) { idx = base - 16 * off; idx = idx > 0 ? idx : 0; } else idx = base - off;
          sv[kk][e] = S[kk][r][e] * (0.125f * LOG2E) + tb[r * TS + idx];
        }
      float pv[2][4];
      if (MODE == 1) {
#pragma unroll
        for (int kk = 0; kk < 2; ++kk)
#pragma unroll
          for (int e = 0; e < 4; ++e) pv[kk][e] = __builtin_amdgcn_exp2f(sv[kk][e] - m[r]) * inv[r];
#pragma unroll
        for (int kk = 0; kk < 2; ++kk) { g1s[kk] += pv[kk][0] + pv[kk][1] + pv[kk][2] + 0.5f * pv[kk][3]; p3s[kk] += 0.5f * pv[kk][3]; }
      } else {
        float mx = fmaxf(fmaxf(fmaxf(sv[0][0], sv[0][1]), fmaxf(sv[0][2], sv[0][3])), fmaxf(fmaxf(sv[1][0], sv[1][1]), fmaxf(sv[1][2], sv[1][3])));
        if (MODE == 2) mx = selok ? mx : -__builtin_inff();
        if (__any(mx > m[r] + 8.0f)) {
          mx = fmaxf(mx, __shfl_xor(mx, 16)); mx = fmaxf(mx, __shfl_xor(mx, 32));
          const float mn = fmaxf(m[r], mx), al = __builtin_amdgcn_exp2f(m[r] - mn);
          m[r] = mn; l[r] *= al;
          if (MODE != 0) {
#pragma unroll
            for (int df = 0; df < 4; ++df) O[df][r] *= al;
          }
        }
        const float me = (MODE == 2) ? (selok ? m[r] : __builtin_inff()) : m[r];
        float ps = 0.f;
#pragma unroll
        for (int kk = 0; kk < 2; ++kk)
#pragma unroll
          for (int e = 0; e < 4; ++e) { pv[kk][e] = __builtin_amdgcn_exp2f(sv[kk][e] - me); ps += pv[kk][e]; }
        l[r] += ps;
      }
      if (MODE != 0) {
        const unsigned w0 = pk2(pv[0][0], pv[0][1]), w1 = pk2(pv[0][2], pv[0][3]), w2 = pk2(pv[1][0], pv[1][1]), w3 = pk2(pv[1][2], pv[1][3]);
        u32x4 pw; pw.x = w0; pw.y = w1; pw.z = w2; pw.w = w3;
        Pf[r] = __builtin_bit_cast(bf16x8, pw);
      }
    }
    if (MODE != 0) {
#pragma unroll
      for (int df = 0; df < 4; ++df) {
        const bf16x4 va = *(const bf16x4*)(vt + (df * 16 + fr) * 68 + 32 * s2 + 4 * fq);
        const bf16x4 vb = *(const bf16x4*)(vt + (df * 16 + fr) * 68 + 32 * s2 + 16 + 4 * fq);
        bf16x8 vf; vf[0] = va[0]; vf[1] = va[1]; vf[2] = va[2]; vf[3] = va[3]; vf[4] = vb[0]; vf[5] = vb[1]; vf[6] = vb[2]; vf[7] = vb[3];
#pragma unroll
        for (int r = 0; r < 2; ++r) O[df][r] = mfma16(vf, Pf[r], O[df][r]);
      }
    }
    if (MODE == 1) {
#pragma unroll
      for (int kk = 0; kk < 2; ++kk) {
        const int j = cur * 16 + (2 * s2 + kk) * 4 + fq;
        atomicAdd(&impw[fr * 65 + j], g1s[kk]);
        if (j + 1 < 64) atomicAdd(&impw[fr * 65 + j + 1], p3s[kk]);
      }
    }
  }
}

template <int MODE>
__device__ __forceinline__ void nsa_branch(int first, int ntl, u64 U, const bf16_t* kbase, const bf16_t* vbase, size_t stride, int t, int hl, u64 mymask,
                                           const bf16x8 (&Qf)[2][2], f32x4 (&O)[4][2], float (&m)[2], float (&l)[2], const float (&inv)[2], float* impw, char* lds) {
  KVRegs R0, R1, R2;
  u64 rem = U;
  int seq = first, left = ntl;
#define NSA_NEXT(dst)                                                                                     \
  { if (MODE == 2) { dst = rem ? (int)__builtin_ctzll(rem) : -1; if (rem) rem &= rem - 1; }              \
    else { dst = left > 0 ? seq : -1; ++seq; --left; } }
#define NSA_GLOAD(R, ti) kv_gload(R, kbase + (size_t)(ti) * 64 * stride, vbase + (size_t)(ti) * 64 * stride, stride)
  int tcur, t1, t2, t3;
  NSA_NEXT(tcur); NSA_NEXT(t1); NSA_NEXT(t2);
  if (tcur >= 0) NSA_GLOAD(R0, tcur);
  if (t1 >= 0) NSA_GLOAD(R1, t1);
  if (t2 >= 0) NSA_GLOAD(R2, t2);
  if (tcur >= 0) kv_lwrite(R0, lds, 0);
  __syncthreads();
  NSA_NEXT(t3);
  if (t3 >= 0) NSA_GLOAD(R0, t3);
  int buf = 0;
#define NSA_STEP(RW)                                                                                      \
  if (tcur < 0) break;                                                                                    \
  nsa_compute<MODE>(tcur, buf, t, hl, mymask, Qf, O, m, l, inv, impw, lds);                               \
  if (t1 >= 0) kv_lwrite(RW, lds, buf ^ 1);                                                               \
  __syncthreads();                                                                                        \
  buf ^= 1; tcur = t1; t1 = t2; t2 = t3;                                                                  \
  NSA_NEXT(t3);                                                                                           \
  if (t3 >= 0) NSA_GLOAD(RW, t3);
  for (;;) {
    NSA_STEP(R1)
    NSA_STEP(R2)
    NSA_STEP(R0)
  }
#undef NSA_STEP
#undef NSA_GLOAD
#undef NSA_NEXT
}

#define NSA_RESET()                                                                         \
  _Pragma("unroll") for (int r = 0; r < 2; ++r) { asm volatile("v_mov_b32 %0, 0xf149f2ca" : "=v"(m[r])); l[r] = 0.f; }               \
  _Pragma("unroll") for (int df = 0; df < 4; ++df) _Pragma("unroll") for (int r = 0; r < 2; ++r) O[df][r] = zero4();

__device__ __forceinline__ void nsa_item(const Params& P, int b, int g, int c, const bf16_t* z, const bf16_t* kcv, bf16_t* y, char* lds) {
  const int tid = TIDX, lane = tid & 63, w8 = tid >> 6, qg = w8 & 3, hp = w8 >> 2, fr = lane & 15, fq = lane >> 4;
  const size_t tokb = (size_t)b * SEQ;
  const int t = c * 64 + 16 * qg + fr;
  const bf16_t* zq = z + (tokb + t) * LDZ;
  const int hb = g * 4 + hp * 2;
  bf16x8 Qf[2][2];
#pragma unroll
  for (int r = 0; r < 2; ++r)
#pragma unroll
    for (int ks = 0; ks < 2; ++ks) Qf[r][ks] = *(const bf16x8*)(zq + ZC_Q + g * 256 + (hp * 2 + r) * 64 + ks * 32 + 8 * fq);
  float* impw = (float*)(lds + NSA_IMP) + (hp * 4 + qg) * (16 * 65);
  for (int i = lane; i < 16 * 65; i += 64) impw[i] = 0.f;
  f32x4 O[4][2];
  float m[2], l[2], inv[2];
  bf16_t* yo = y + (tokb + t) * 1024 + 512 + g * 256 + hp * 128 + 4 * fq;
  const bf16_t* kc = kcv + (size_t)((0 * 8 + b) * 2 + g) * 256 * 64;
  const bf16_t* vc = kcv + (size_t)((1 * 8 + b) * 2 + g) * 256 * 64;
  const int nct = ((4 * c + 2) >> 6) + 1;
  NSA_RESET();
  inv[0] = 0.f; inv[1] = 0.f;
  nsa_branch<0>(0, nct, 0ull, kc, vc, 64, t, hp * 2, 0ull, Qf, O, m, l, inv, impw, lds);
#pragma unroll
  for (int r = 0; r < 2; ++r) { float lt = l[r]; lt += __shfl_xor(lt, 16); lt += __shfl_xor(lt, 32); inv[r] = lt > 0.f ? 1.f / lt : 0.f; }
  nsa_branch<1>(0, nct, 0ull, kc, vc, 64, t, hp * 2, 0ull, Qf, O, m, l, inv, impw, lds);
#pragma unroll
  for (int r = 0; r < 2; ++r) {
    const float gt = sigm(bf2f(zq[ZC_GC + hb + r]));
#pragma unroll
    for (int df = 0; df < 4; ++df) { u32x2 o; o.x = pk2(O[df][r][0] * gt, O[df][r][1] * gt); o.y = pk2(O[df][r][2] * gt, O[df][r][3] * gt); *(u32x2*)(yo + r * 64 + df * 16) = o; }
  }
  __syncthreads();
  u64 wU = 0ull;
  {
    const float* imp0 = (const float*)(lds + NSA_IMP) + qg * (16 * 65);
    const float* imp1 = imp0 + 4 * (16 * 65);
    u64* MK = (u64*)(lds + NSA_WU) + 8;
    const u64 V = (c >= 63) ? ~0ull : ((1ull << (c + 1)) - 1ull);
    const bool forced = (lane == 0) | (lane == c) | (lane == c - 1);
    for (int q8 = 0; q8 < 8; ++q8) {
      const int qq = hp * 8 + q8;
      const float sv = imp0[qq * 65 + lane] + imp1[qq * 65 + lane];
      const unsigned u = __float_as_uint(forced ? 1e4f : sv);
      u64 mk = V;
      if (c + 1 > 16) {
        unsigned thr = 0u;
        for (int bb = 30; bb >= 0; --bb) { const unsigned cand = thr | (1u << bb); const u64 ge = __ballot(u >= cand) & V; if (__popcll(ge) >= 16) thr = cand; }
        const u64 G = __ballot(u > thr) & V, E = __ballot(u == thr) & V;
        const int need = 16 - (int)__popcll(G);
        const int below = (int)__popcll(E & ((1ull << lane) - 1ull));
        const bool se = (((E >> lane) & 1ull) != 0ull) && (below < need);
        mk = G | __ballot(se);
      }
      if (lane == 0) MK[qg * 16 + qq] = mk;
      wU |= mk;
    }
  }
  u64* WU = (u64*)(lds + NSA_WU);
  if (lane == 0) WU[w8] = wU;
  __syncthreads();
  const u64 U = WU[0] | WU[1] | WU[2] | WU[3] | WU[4] | WU[5] | WU[6] | WU[7];
  const u64 mymask = ((const u64*)(lds + NSA_WU) + 8)[qg * 16 + fr];
  for (int br = 0; br < 2; ++br) {
    NSA_RESET();
    int zg;
    if (br == 0) {
      nsa_branch<2>(0, 0, U, z + tokb * LDZ + ZC_KS + g * 64, z + tokb * LDZ + ZC_VS + g * 64, LDZ, t, hp * 2, mymask, Qf, O, m, l, inv, impw, lds);
      zg = ZC_GS;
    } else {
      const int kt0 = c > 8 ? c - 8 : 0;
      nsa_branch<3>(kt0, c - kt0 + 1, 0ull, z + tokb * LDZ + ZC_KW + g * 64, z + tokb * LDZ + ZC_VW + g * 64, LDZ, t, hp * 2, 0ull, Qf, O, m, l, inv, impw, lds);
      zg = ZC_GW;
    }
#pragma unroll
    for (int r = 0; r < 2; ++r) {
      float lt = l[r]; lt += __shfl_xor(lt, 16); lt += __shfl_xor(lt, 32);
      const float gt = sigm(bf2f(zq[zg + hb + r])) * (lt > 0.f ? 1.f / lt : 0.f);
#pragma unroll
      for (int df = 0; df < 4; ++df) {
        bf16_t* yp = yo + r * 64 + df * 16;
        const u32x2 pr = *(const u32x2*)yp;
        u32x2 o; o.x = pk2(__uint_as_float(pr.x << 16) + O[df][r][0] * gt, __uint_as_float(pr.x & 0xffff0000u) + O[df][r][1] * gt);
        o.y = pk2(__uint_as_float(pr.y << 16) + O[df][r][2] * gt, __uint_as_float(pr.y & 0xffff0000u) + O[df][r][3] * gt);
        *(u32x2*)yp = o;
      }
    }
  }
  __syncthreads();
}

__device__ __forceinline__ void run_phase(const Params& P, int ph, char* lds) {
  char* ws = P.ws;
  asm volatile("" : "+s"(ws));
  bf16_t* abuf = (bf16_t*)(ws + OFF_A);
  bf16_t* big = (bf16_t*)(ws + OFF_BIG);
  bf16_t* fbuf = (bf16_t*)(ws + OFF_F);
  float* hsl = (float*)(ws + OFF_F); float* Pc = hsl + (size_t)M_TOK * 256;
  bf16_t* kcv = (bf16_t*)(ws + OFF_KC);
  float* carryP = (float*)(ws + OFF_CARRY); float* carryH = carryP + 8 * 4 * 64 * 64;
  if (ph == 0) { prep_phase(P, lds); return; }
  const int layer = (ph - 1) / 13, sp = (ph - 1) % 13;
  const float* ng = P.norm_g + (size_t)layer * 8 * 1024;
#ifdef ONLY_SP
  if (sp != ONLY_SP) return;
#endif
  switch (sp) {
    case 0: case 8: {
      const int lj = layer * 2 + (sp == 8);
      gemm_up_phase(abuf, (const bf16_t*)(ws + OFF_WGU + lj * SZ_WGU), big, lds);
    } break;
    case 1: case 9: {
      const int lj = layer * 2 + (sp == 9);
      gemm_bf16_phase(big, DFF, (const bf16_t*)(ws + OFF_WD + lj * SZ_WD), DFF, 4, fbuf, 1024, lds);
    } break;
    case 2: resnorm_phase(layer == 0 ? P.x : P.out, P.out, fbuf, 0.5f, ng + 1 * 1024, ng + 2 * 1024, abuf); break;
    case 3: gemm_bf16_phase(abuf, 1024, (const bf16_t*)(ws + OFF_WIN + layer * SZ_WIN), 1024, LDZ / 256, big, LDZ, lds); break;
    case 4: {
      const int hb = HBLK; char* hl = lds + hb * 65536;
      for (int it = blockIdx.x * 2 + hb; it < 512; it += gridDim.x * 2) compress_item(P, layer, it, big, kcv, hl);
      for (int it = blockIdx.x * 2 + hb; it < 1024; it += gridDim.x * 2) mixA_item(P, layer, it, big, abuf, hl);
      for (int it = blockIdx.x * 2 + hb; it < 2048; it += gridDim.x * 2) mixB1_item(P, layer, it, big, hsl, Pc, carryP, carryH, hl);
    } break;
    case 5: {
      nsa_tables(P, blockIdx.x & 1, lds);
      for (int it = blockIdx.x; it < 1024; it += gridDim.x) {
        const int rnd = it / 256, pos = it % 256;
        const int c = (rnd & 1) ? (rnd >> 1) * 16 + (pos >> 4) : 63 - (rnd >> 1) * 16 - (pos >> 4);
        const int bg = pos & 15;
        nsa_item(P, bg >> 1, bg & 1, c, big, kcv, abuf, lds);
      }
      const int hb = HBLK;
      for (int it = blockIdx.x * 2 + hb; it < 2048; it += gridDim.x * 2) mixB2_item(it, big, hsl, Pc, carryP, carryH, abuf);
    } break;
    case 6: gemm_bf16_phase(abuf, 1024, (const bf16_t*)(ws + OFF_WOUT + layer * SZ_SQ), 1024, 4, fbuf, 1024, lds); break;
    case 7: resnorm_phase(P.out, P.out, fbuf, 1.0f, ng + 3 * 1024, ng + 4 * 1024, abuf); break;
    case 10:
      gemm_bf16_phase((const bf16_t*)(ws + OFF_PBF) + (size_t)layer * M_TOK * 256, 256, (const bf16_t*)(ws + OFF_WPP + layer * SZ_WPP), 256, 4, big, 1024, lds);
      resnorm_phase(P.out, P.out, fbuf, 0.5f, ng + 5 * 1024, ng + 6 * 1024, abuf);
      break;
    case 11: gemm_ple_phase(abuf, (const bf16_t*)(ws + OFF_WPG + layer * SZ_SQ), big, fbuf, lds); break;
    case 12: resnorm_phase(P.out, P.out, fbuf, 1.0f, ng + 7 * 1024, layer == 0 ? P.norm_g + 8 * 1024 : nullptr, layer == 0 ? abuf : nullptr); break;
  }
}

#define XB_TMO      128
#define XB_XCNT(j)  (256  + 64 * (j))
#define XB_XSUB(j)  (1280 + 64 * (j))
#define XB_XGEN(j)  (2304 + 64 * (j))
#define XB_TOP      3328
#define XB_TOPGEN   3392
#define XCD_BAR_WORDS 3456
#define XB_SPIN_CAP (1u << 20)
#define LAS __attribute__((address_space(3)))
__device__ __forceinline__ unsigned xb_ld(unsigned* p)              { return __hip_atomic_load(p, __ATOMIC_RELAXED, __HIP_MEMORY_SCOPE_AGENT); }
__device__ __forceinline__ unsigned xb_add(unsigned* p, unsigned v) { return __hip_atomic_fetch_add(p, v, __ATOMIC_RELAXED, __HIP_MEMORY_SCOPE_AGENT); }
__device__ __forceinline__ unsigned xb_xcc_id() { return (unsigned)__builtin_amdgcn_s_getreg((3 << 11) | 20) & 0xFu; }
#define XB_SPIN(cond, bar) do { unsigned _sp = 0; while (cond) { __builtin_amdgcn_s_sleep(1); \
    if ((++_sp & 255u) == 0u) { if (xb_ld(&(bar)[XB_TMO])) break; if (_sp > XB_SPIN_CAP) { atomicAdd(&(bar)[XB_TMO], 1u); break; } } } } while (0)
struct XcdBarrier { unsigned* bar; unsigned x; volatile LAS unsigned* st; };
__device__ __forceinline__ XcdBarrier xcd_barrier_post(unsigned* bar, volatile LAS unsigned* st) {
    XcdBarrier b; b.bar = bar; b.x = xb_xcc_id(); b.st = st;
    if (threadIdx.x == 0) (void)xb_add(&bar[XB_XCNT(b.x)], 1u);
    return b;
}
__device__ __forceinline__ void xcd_barrier_complete(unsigned* bar, unsigned x, unsigned& nloc, unsigned& nx) {
    const unsigned G = gridDim.x * gridDim.y * gridDim.z;
    unsigned sum, cnt, mine, sp = 0u;
    for (;;) {
        sum = 0u; cnt = 0u; mine = 0u;
#pragma unroll
        for (unsigned j = 0; j < 16; ++j) { const unsigned c = xb_ld(&bar[XB_XCNT(j)]); sum += c; cnt += (c > 0u) ? 1u : 0u; mine = (j == x) ? c : mine; }
        if (sum == G) break;
        __builtin_amdgcn_s_sleep(1);
        if ((++sp & 255u) == 0u) { if (xb_ld(&bar[XB_TMO])) break; if (sp > XB_SPIN_CAP) { atomicAdd(&bar[XB_TMO], 1u); break; } }
    }
    nloc = mine > 0u ? mine : 1u; nx = cnt > 0u ? cnt : 1u;
}
__device__ __forceinline__ void xcd_barrier(const XcdBarrier& b) {
    asm volatile("s_waitcnt vmcnt(0)" ::: "memory");
    __syncthreads();
    if (threadIdx.x == 0) {
        unsigned* bar = b.bar;
        __builtin_amdgcn_s_waitcnt(0);
        unsigned nloc = b.st[0], nx = b.st[1];
        if (nloc == 0u) { xcd_barrier_complete(bar, b.x, nloc, nx); b.st[0] = nloc; b.st[1] = nx; }
        const unsigned old = xb_add(&bar[XB_XSUB(b.x)], 1u);
        const unsigned gen = old / nloc;
        if (old + 1u == (gen + 1u) * nloc) {
            __builtin_amdgcn_fence(__ATOMIC_RELEASE, "agent");
            asm volatile("s_waitcnt vmcnt(0)" ::: "memory");
            const unsigned og = xb_add(&bar[XB_TOP], 1u);
            const unsigned tg = og / nx;
            if (og + 1u == (tg + 1u) * nx) xb_add(&bar[XB_TOPGEN], 1u);
            else XB_SPIN(xb_ld(&bar[XB_TOPGEN]) == tg, bar);
            __builtin_amdgcn_fence(__ATOMIC_ACQUIRE, "agent");
            xb_add(&bar[XB_XGEN(b.x)], 1u);
            asm volatile("s_waitcnt vmcnt(0)" ::: "memory");
        } else {
            XB_SPIN(xb_ld(&bar[XB_XGEN(b.x)]) == gen, bar);
            __builtin_amdgcn_fence(__ATOMIC_ACQUIRE, "agent");
            asm volatile("s_waitcnt vmcnt(0)" ::: "memory");
        }
    }
    __syncthreads();
}

constexpr int LDS_BYTES = LDS_ST + 16;
__global__ void __launch_bounds__(512, 2) fwd_megakernel(Params P) {
  __shared__ __attribute__((aligned(16))) char lds[LDS_BYTES];
  cg::grid_group grid = cg::this_grid();
  volatile LAS unsigned* st = (volatile LAS unsigned*)(lds + LDS_ST);
  if (threadIdx.x == 0) { st[0] = 0u; st[1] = 0u; }
  __syncthreads();
  XcdBarrier xb = xcd_barrier_post((unsigned*)(P.ws + OFF_BAR), st);
  if (P.ws == nullptr) grid.sync();
  for (int ph = 0; ph < NPHASE; ++ph) {
    run_phase(P, ph, lds);
    if (ph + 1 < NPHASE) xcd_barrier(xb);
  }
}

__global__ void __launch_bounds__(512, 2) phase_kernel(Params P, int ph) {
  __shared__ __attribute__((aligned(16))) char lds[LDS_BYTES];
  run_phase(P, ph, lds);
}

extern "C" void kernel_launch(void* const* d_in, const int* in_sizes, int n_in, void* d_out, int out_size, void* d_ws, size_t ws_size, hipStream_t stream) {
  Params P{};
  const float** pp = (const float**)&P;
  for (int i = 0; i < 26; ++i) pp[i] = (const float*)d_in[i];
  P.out = (float*)d_out;
  P.ws = (char*)d_ws;
  if (ws_size < WS_NEED) { fprintf(stderr, "workspace too small: %zu < %zu\n", ws_size, (size_t)WS_NEED); return; }
#if MK_FUSED
  static int grid_blocks = 0;
  if (!grid_blocks) {
    int dev = 0, cus = 0, per_cu = 0;
    (void)hipGetDevice(&dev);
    (void)hipDeviceGetAttribute(&cus, hipDeviceAttributeMultiprocessorCount, dev);
    (void)hipOccupancyMaxActiveBlocksPerMultiprocessor(&per_cu, fwd_megakernel, 512, 0);
    if (per_cu > 1) per_cu = 1;
    if (per_cu < 1) per_cu = 1;
    grid_blocks = cus * per_cu;
  }
  (void)hipMemsetAsync((char*)d_ws + OFF_BAR, 0, XCD_BAR_WORDS * 4, stream);
  void* args[] = {&P};
  hipError_t e = hipLaunchCooperativeKernel((void*)fwd_megakernel, dim3(grid_blocks), dim3(512), args, 0, stream);
  if (e != hipSuccess) fprintf(stderr, "cooperative launch failed: %s (grid %d)\n", hipGetErrorString(e), grid_blocks);
#else
  for (int ph = 0; ph < NPHASE; ++ph) phase_kernel<<<256, 512, 0, stream>>>(P, ph);
#endif
}
```

```cpp
#include <hip/hip_runtime.h>
#include <hip/hip_cooperative_groups.h>
#include <cstdint>
#include <cstdio>
namespace cg = cooperative_groups;

#ifndef MK_FUSED
#define MK_FUSED 1
#endif

typedef unsigned short bf16_t;
typedef short bf16x8 __attribute__((ext_vector_type(8)));
typedef short bf16x4 __attribute__((ext_vector_type(4)));
typedef float f32x4 __attribute__((ext_vector_type(4)));
typedef unsigned long long u64;
typedef unsigned u32x4 __attribute__((ext_vector_type(4)));
typedef unsigned u32x2 __attribute__((ext_vector_type(2)));

constexpr int M_TOK = 32768, DM = 1024, DFF = 2816, NGU = 5632, NIN = 2328, LDZ = 2560, SEQ = 4096;
constexpr int NPHASE = 27;
constexpr int ZC_AU = 0, ZC_AV = 256, ZC_BX = 512, ZC_BG = 768, ZC_Q = 1024, ZC_KC = 1536, ZC_VC = 1664, ZC_KS = 1792, ZC_VS = 1920,
              ZC_KW = 2048, ZC_VW = 2176, ZC_GC = 2304, ZC_GS = 2312, ZC_GW = 2320;

constexpr size_t SZ_WGU = (size_t)NGU * 1024 * 2, SZ_WD = (size_t)1024 * DFF * 2, SZ_WIN = (size_t)LDZ * 1024 * 2, SZ_SQ = (size_t)1024 * 1024 * 2,
                 SZ_WPP = (size_t)1024 * 256 * 2, SZ_CW1 = (size_t)128 * 2048 * 2;
constexpr size_t OFF_WGU = 0;
constexpr size_t OFF_WD = OFF_WGU + 4 * SZ_WGU;
constexpr size_t OFF_WIN = OFF_WD + 4 * SZ_WD;
constexpr size_t OFF_WOUT = OFF_WIN + 2 * SZ_WIN;
constexpr size_t OFF_WPG = OFF_WOUT + 2 * SZ_SQ;
constexpr size_t OFF_WPP = OFF_WPG + 2 * SZ_SQ;
constexpr size_t OFF_CW1 = OFF_WPP + 2 * SZ_WPP;
constexpr size_t OFF_CB1 = OFF_CW1 + 4 * SZ_CW1;
constexpr size_t OFF_SGUW = OFF_CB1 + 4096;
constexpr size_t OFF_WAT = OFF_SGUW + 2 * 4 * 128 * 128 * 2;
constexpr size_t OFF_WXT = OFF_WAT + 2 * 4 * 64 * 64 * 2;
constexpr size_t OFF_PBF = OFF_WXT + 2 * 4 * 64 * 64 * 2;
constexpr size_t OFF_A = OFF_PBF + (size_t)2 * M_TOK * 256 * 2;
constexpr size_t OFF_BIG = OFF_A + (size_t)M_TOK * 1024 * 2;
constexpr size_t OFF_F = OFF_BIG + (size_t)M_TOK * DFF * 2;
constexpr size_t OFF_KC = OFF_F + (size_t)M_TOK * 1024 * 4;
constexpr size_t OFF_CARRY = OFF_KC + (size_t)2 * 8 * 2 * 256 * 64 * 2;
constexpr size_t OFF_BAR = OFF_CARRY + (size_t)2 * 8 * 4 * 64 * 64 * 4;
constexpr size_t WS_NEED = OFF_BAR + 16384;

struct Params {
  const float *x, *p, *rel_bias, *norm_g, *ffn_wg, *ffn_wu, *ffn_wd, *w_in, *w_out, *sgu_ng, *sgu_w, *sgu_b, *conv_w, *conv_b,
      *lru_wa, *lru_ba, *lru_wx, *lru_bx, *lru_lam, *cmp_pos, *cmp_w1, *cmp_b1, *cmp_w2, *cmp_b2, *ple_wg, *ple_wp;
  float* out;
  char* ws;
};

__device__ __forceinline__ int opaque_tid() { int t; asm volatile("v_mov_b32 %0, %1" : "=v"(t) : "v"(threadIdx.x)); return t; }
#define TIDX opaque_tid()
#define HTID (opaque_tid() & 255)
#define HBLK (opaque_tid() >> 8)
__device__ __forceinline__ float bf2f(bf16_t v) { return __uint_as_float(((unsigned)v) << 16); }
__device__ __forceinline__ bf16_t f2bf(float f) { unsigned u = __float_as_uint(f); u += 0x7fffu + ((u >> 16) & 1u); return (bf16_t)(u >> 16); }
__device__ __forceinline__ unsigned pk2(float lo, float hi) { unsigned r; asm("v_cvt_pk_bf16_f32 %0, %1, %2" : "=v"(r) : "v"(lo), "v"(hi)); return r; }
__device__ __forceinline__ float sigm(float x) { return __builtin_amdgcn_rcpf(1.f + __expf(-x)); }
__device__ __forceinline__ float gelu_t(float x) { float u = 0.7978845608028654f * (x + 0.044715f * x * x * x); return x * __builtin_amdgcn_rcpf(1.f + __expf(-2.f * u)); }
__device__ __forceinline__ float silu_f(float x) { return x * __builtin_amdgcn_rcpf(1.f + __expf(-x)); }
__device__ __forceinline__ f32x4 mfma16(bf16x8 a, bf16x8 b, f32x4 c) { return __builtin_amdgcn_mfma_f32_16x16x32_bf16(a, b, c, 0, 0, 0); }
__device__ __forceinline__ void glds16(const void* g, void* l) {
  __builtin_amdgcn_global_load_lds((const __attribute__((address_space(1))) unsigned*)g, (__attribute__((address_space(3))) unsigned*)l, 16, 0, 0);
}
__device__ __forceinline__ f32x4 zero4() { f32x4 z; asm volatile("v_mov_b32 %0, 0\n\tv_mov_b32 %1, 0\n\tv_mov_b32 %2, 0\n\tv_mov_b32 %3, 0" : "=v"(z[0]), "=v"(z[1]), "=v"(z[2]), "=v"(z[3])); return z; }
__device__ __forceinline__ float wave_sum(float v) {
#pragma unroll
  for (int o = 32; o > 0; o >>= 1) v += __shfl_xor(v, o);
  return v;
}
__device__ __forceinline__ void unpack8(const u32x4 u, float* f) {
  f[0] = __uint_as_float(u.x << 16); f[1] = __uint_as_float(u.x & 0xffff0000u);
  f[2] = __uint_as_float(u.y << 16); f[3] = __uint_as_float(u.y & 0xffff0000u);
  f[4] = __uint_as_float(u.z << 16); f[5] = __uint_as_float(u.z & 0xffff0000u);
  f[6] = __uint_as_float(u.w << 16); f[7] = __uint_as_float(u.w & 0xffff0000u);
}

__device__ __forceinline__ void tr_cvt(const float* __restrict__ src, int N, int K, bf16_t* __restrict__ dst, int ldd, int rs, int ro, char* ldsc) {
  const int ntn = (N + 63) >> 6, nt = ntn * (K >> 6), hb = HBLK, tid = HTID;
  float* lds = (float*)(ldsc + hb * 65536);
  for (int t0 = blockIdx.x * 6; t0 < nt; t0 += gridDim.x * 6) {
    float4 v[3][4];
#pragma unroll
    for (int u = 0; u < 3; ++u) {
      const int tile = t0 + hb * 3 + u, tk = tile / ntn, tn = tile - tk * ntn, k0 = tk * 64, n0 = tn * 64;
      const bool active = tile < nt;
#pragma unroll
      for (int ps = 0; ps < 4; ++ps) {
        const int i = ps * 16 + (tid >> 4), j = (tid & 15) * 4;
        v[u][ps] = make_float4(0.f, 0.f, 0.f, 0.f);
        if (active && n0 + j < N) v[u][ps] = *(const float4*)(src + (size_t)(k0 + i) * N + n0 + j);
      }
    }
#pragma unroll
    for (int u = 0; u < 3; ++u)
#pragma unroll
      for (int ps = 0; ps < 4; ++ps) {
        const int i = ps * 16 + (tid >> 4), j = (tid & 15) * 4;
        float* d = lds + u * 4160 + i * 65 + j; d[0] = v[u][ps].x; d[1] = v[u][ps].y; d[2] = v[u][ps].z; d[3] = v[u][ps].w;
      }
    __syncthreads();
#pragma unroll
    for (int u = 0; u < 3; ++u) {
      const int tile = t0 + hb * 3 + u, tk = tile / ntn, tn = tile - tk * ntn, k0 = tk * 64, n0 = tn * 64;
      const int j = tid >> 2, kq = tid & 3, n = n0 + j;
      if (tile < nt && n < N) {
        const float* l = lds + u * 4160;
        unsigned w[8];
#pragma unroll
        for (int q = 0; q < 8; ++q) w[q] = pk2(l[(kq * 16 + 2 * q) * 65 + j], l[(kq * 16 + 2 * q + 1) * 65 + j]);
        bf16_t* o = dst + (size_t)((n >> 4) * rs + (n & 15) + ro) * ldd + k0 + kq * 16;
        u32x4 w0, w1; w0.x = w[0]; w0.y = w[1]; w0.z = w[2]; w0.w = w[3]; w1.x = w[4]; w1.y = w[5]; w1.z = w[6]; w1.w = w[7];
        *(u32x4*)o = w0; *(u32x4*)(o + 8) = w1;
      }
    }
    __syncthreads();
  }
}

struct RowRegs { float4 h[4]; u32x2 f[4]; };
__device__ __forceinline__ void rn_load(RowRegs& R, const float* hin32, const bf16_t* hin16, const bf16_t* f, int row, int lane) {
  if (hin32) {
#pragma unroll
    for (int i = 0; i < 4; ++i) R.h[i] = *(const float4*)(hin32 + (size_t)row * 1024 + i * 256 + lane * 4);
  } else {
#pragma unroll
    for (int i = 0; i < 4; ++i) { const u32x2 v = *(const u32x2*)(hin16 + (size_t)row * 1024 + i * 256 + lane * 4);
      R.h[i].x = __uint_as_float(v.x << 16); R.h[i].y = __uint_as_float(v.x & 0xffff0000u); R.h[i].z = __uint_as_float(v.y << 16); R.h[i].w = __uint_as_float(v.y & 0xffff0000u); }
  }
  if (f) {
#pragma unroll
    for (int i = 0; i < 4; ++i) R.f[i] = *(const u32x2*)(f + (size_t)row * 1024 + i * 256 + lane * 4);
  }
}
__device__ __forceinline__ void rn_proc(RowRegs& R, float* hout32, bf16_t* hout16, bool has_f, float scale, const float* gpost, const float* gpre, bf16_t* a, int row, int lane) {
  if (has_f) {
    float fv[4][4]; float ss = 0.f;
#pragma unroll
    for (int i = 0; i < 4; ++i) {
      fv[i][0] = __uint_as_float(R.f[i].x << 16); fv[i][1] = __uint_as_float(R.f[i].x & 0xffff0000u);
      fv[i][2] = __uint_as_float(R.f[i].y << 16); fv[i][3] = __uint_as_float(R.f[i].y & 0xffff0000u);
      ss += fv[i][0] * fv[i][0] + fv[i][1] * fv[i][1] + fv[i][2] * fv[i][2] + fv[i][3] * fv[i][3];
    }
    ss = wave_sum(ss);
    const float r = rsqrtf(ss * (1.f / 1024.f) + 1e-6f) * scale;
#pragma unroll
    for (int i = 0; i < 4; ++i) { const float4 g = *(const float4*)(gpost + i * 256 + lane * 4);
      R.h[i].x += fv[i][0] * r * g.x; R.h[i].y += fv[i][1] * r * g.y; R.h[i].z += fv[i][2] * r * g.z; R.h[i].w += fv[i][3] * r * g.w; }
  }
  if (hout32) {
#pragma unroll
    for (int i = 0; i < 4; ++i) *(float4*)(hout32 + (size_t)row * 1024 + i * 256 + lane * 4) = R.h[i];
  }
  if (hout16) {
#pragma unroll
    for (int i = 0; i < 4; ++i) { u32x2 o; o.x = pk2(R.h[i].x, R.h[i].y); o.y = pk2(R.h[i].z, R.h[i].w); *(u32x2*)(hout16 + (size_t)row * 1024 + i * 256 + lane * 4) = o; }
  }
  if (a) {
    float ss = 0.f;
#pragma unroll
    for (int i = 0; i < 4; ++i) ss += R.h[i].x * R.h[i].x + R.h[i].y * R.h[i].y + R.h[i].z * R.h[i].z + R.h[i].w * R.h[i].w;
    ss = wave_sum(ss);
    const float r = rsqrtf(ss * (1.f / 1024.f) + 1e-6f);
#pragma unroll
    for (int i = 0; i < 4; ++i) { const float4 g = *(const float4*)(gpre + i * 256 + lane * 4);
      u32x2 o; o.x = pk2(R.h[i].x * r * g.x, R.h[i].y * r * g.y); o.y = pk2(R.h[i].z * r * g.z, R.h[i].w * r * g.w);
      *(u32x2*)(a + (size_t)row * 1024 + i * 256 + lane * 4) = o; }
  }
}
__device__ __forceinline__ void resnorm_phase(const float* hin32, const bf16_t* hin16, float* hout32, bf16_t* hout16, const bf16_t* f, float scale, const float* gpost, const float* gpre, bf16_t* a) {
  const int tid = TIDX, lane = tid & 63, stride = gridDim.x * 8;
  int r0 = blockIdx.x * 8 + (tid >> 6), r1 = r0 + stride;
  RowRegs A, B;
  if (r0 < M_TOK) rn_load(A, hin32, hin16, f, r0, lane);
  for (;;) {
    if (r0 >= M_TOK) break;
    if (r1 < M_TOK) rn_load(B, hin32, hin16, f, r1, lane);
    rn_proc(A, hout32, hout16, f != nullptr, scale, gpost, gpre, a, r0, lane);
    r0 += 2 * stride;
    if (r1 >= M_TOK) break;
    if (r0 < M_TOK) rn_load(A, hin32, hin16, f, r0, lane);
    rn_proc(B, hout32, hout16, f != nullptr, scale, gpost, gpre, a, r1, lane);
    r1 += 2 * stride;
  }
}

__device__ __forceinline__ void prep_phase(const Params& P, char* ldsc) {
  char* ws = P.ws;
  for (int l = 0; l < 2; ++l) {
    for (int j = 0; j < 2; ++j) {
      const int lj = l * 2 + j;
      bf16_t* wgu = (bf16_t*)(ws + OFF_WGU + lj * SZ_WGU);
      tr_cvt(P.ffn_wg + (size_t)lj * 1024 * DFF, DFF, 1024, wgu, 1024, 32, 0, ldsc);
      tr_cvt(P.ffn_wu + (size_t)lj * 1024 * DFF, DFF, 1024, wgu, 1024, 32, 16, ldsc);
      tr_cvt(P.ffn_wd + (size_t)lj * DFF * 1024, 1024, DFF, (bf16_t*)(ws + OFF_WD + lj * SZ_WD), DFF, 16, 0, ldsc);
      tr_cvt(P.cmp_w1 + (size_t)lj * 2048 * 128, 128, 2048, (bf16_t*)(ws + OFF_CW1 + lj * SZ_CW1), 2048, 16, 0, ldsc);
    }
    tr_cvt(P.w_in + (size_t)l * 1024 * NIN, NIN, 1024, (bf16_t*)(ws + OFF_WIN + l * SZ_WIN), 1024, 16, 0, ldsc);
    tr_cvt(P.w_out + (size_t)l * 1024 * 1024, 1024, 1024, (bf16_t*)(ws + OFF_WOUT + l * SZ_SQ), 1024, 16, 0, ldsc);
    tr_cvt(P.ple_wg + (size_t)l * 1024 * 1024, 1024, 1024, (bf16_t*)(ws + OFF_WPG + l * SZ_SQ), 1024, 16, 0, ldsc);
    tr_cvt(P.ple_wp + (size_t)l * 256 * 1024, 1024, 256, (bf16_t*)(ws + OFF_WPP + l * SZ_WPP), 256, 16, 0, ldsc);
    for (int g = 0; g < 4; ++g) {
      tr_cvt(P.lru_wa + (size_t)(l * 4 + g) * 4096, 64, 64, (bf16_t*)(ws + OFF_WAT) + (l * 4 + g) * 4096, 64, 16, 0, ldsc);
      tr_cvt(P.lru_wx + (size_t)(l * 4 + g) * 4096, 64, 64, (bf16_t*)(ws + OFF_WXT) + (l * 4 + g) * 4096, 64, 16, 0, ldsc);
    }
  }
  const int tid = TIDX, gtid = blockIdx.x * 512 + tid, gn = gridDim.x * 512;
  for (int i = gtid; i < 2 * (LDZ - NIN) * 1024 / 8; i += gn) {
    const int l = i / ((LDZ - NIN) * 128), r = i - l * ((LDZ - NIN) * 128);
    *(f32x4*)((bf16_t*)(ws + OFF_WIN + l * SZ_WIN) + (size_t)NIN * 1024 + (size_t)r * 8) = zero4();
  }
  for (int i = gtid; i < 2 * 4 * 128 * 128; i += gn) { const int t = (i >> 7) & 127, s2 = i & 127; ((bf16_t*)(ws + OFF_SGUW))[i] = (s2 <= t) ? f2bf(P.sgu_w[i]) : (bf16_t)0; }
  for (int i = gtid; i < 2 * M_TOK * 256 / 4; i += gn) { const float4 v = ((const float4*)P.p)[i]; uint2 o; o.x = pk2(v.x, v.y); o.y = pk2(v.z, v.w); ((uint2*)(ws + OFF_PBF))[i] = o; }
  {
    float* lds = (float*)(ldsc + HBLK * 65536);
    for (int u = blockIdx.x; u < 4; u += gridDim.x) {
      const int t2 = HTID, kq = t2 >> 5, jq = t2 & 31;
      const float* w1 = P.cmp_w1 + (size_t)u * 2048 * 128; const float* pos = P.cmp_pos + (size_t)u * 2048;
      float4 sacc = make_float4(0.f, 0.f, 0.f, 0.f);
      for (int k = kq * 256; k < kq * 256 + 256; ++k) { const float pv = pos[k]; const float4 w = *(const float4*)(w1 + (size_t)k * 128 + jq * 4); sacc.x += pv * w.x; sacc.y += pv * w.y; sacc.z += pv * w.z; sacc.w += pv * w.w; }
      __syncthreads();
      lds[kq * 128 + jq * 4 + 0] = sacc.x; lds[kq * 128 + jq * 4 + 1] = sacc.y; lds[kq * 128 + jq * 4 + 2] = sacc.z; lds[kq * 128 + jq * 4 + 3] = sacc.w;
      __syncthreads();
      if (t2 < 128) { float t = P.cmp_b1[u * 128 + t2]; for (int q = 0; q < 8; ++q) t += lds[q * 128 + t2]; ((float*)(ws + OFF_CB1))[u * 128 + t2] = t; }
      __syncthreads();
    }
  }
  resnorm_phase(P.x, nullptr, nullptr, nullptr, nullptr, 0.f, nullptr, P.norm_g, (bf16_t*)(ws + OFF_A));
}

constexpr int G8_HT = 128 * 64;
__device__ __forceinline__ int g8_lds_byte(int r, int c) { const int st = (r >> 4) * 2 + (c >> 5), rr = r & 15, cc = c & 31, ob = rr * 64 + cc * 2; return st * 1024 + (ob ^ (((ob >> 9) & 1) << 5)); }
__device__ __forceinline__ void g8_stage_rc(int b, int& R, int& C) { const int st = b / 1024, sb = b % 1024, swz = sb ^ (((sb >> 9) & 1) << 5); R = (st >> 1) * 16 + swz / 64; C = (st & 1) * 32 + (swz % 64) / 2; }

template <bool ISSUE_ONLY, bool PRE_ISSUED>
__device__ __forceinline__ void gemm_core(f32x4 (&acc)[2][2][4][2], const bf16_t* __restrict__ A, int lda, const bf16_t* __restrict__ Bt, int ldb, int K, char* ldsc) {
  bf16_t* shm = (bf16_t*)ldsc;
  const int tid = TIDX, wid = tid >> 6, lane = tid & 63, wr = wid >> 2, wc = wid & 3, fr = lane & 15, fq = lane >> 4;
  int sr0, sc0;
  g8_stage_rc(tid * 16, sr0, sc0);
  const bf16_t* gA0 = A + (size_t)sr0 * lda + sc0;
  const bf16_t* gB0 = Bt + (size_t)sr0 * ldb + sc0;
  const size_t a64 = (size_t)64 * lda, b64 = (size_t)64 * ldb;
  const int lane_off = (fr * 64 + fq * 16) ^ ((((fr * 64 + fq * 16) >> 9) & 1) << 5);
  const char* ldA = ldsc + wr * 8192 + lane_off;
  const char* ldB = ldsc + 65536 + wc * 4096 + lane_off;
#define SA(b, h) (shm + ((b) * 2 + (h)) * G8_HT)
#define SB(b, h) (shm + (4 + (b) * 2 + (h)) * G8_HT)
#define STAGE_A(P, h, kt) { const bf16_t* g_ = gA0 + (size_t)(h) * 2 * a64 + (kt) * 64; glds16(g_, (char*)(P) + tid * 16); glds16(g_ + a64, (char*)(P) + tid * 16 + 8192); }
#define STAGE_B(P, h, kt) { const bf16_t* g_ = gB0 + (size_t)(h) * 2 * b64 + (kt) * 64; glds16(g_, (char*)(P) + tid * 16); glds16(g_ + b64, (char*)(P) + tid * 16 + 8192); }
#define LDA(dst, b, h) _Pragma("unroll") for (int m = 0; m < 4; ++m) _Pragma("unroll") for (int k = 0; k < 2; ++k) \
    dst[m][k] = *reinterpret_cast<const bf16x8*>(ldA + ((b) * 2 + (h)) * 16384 + (m * 2 + k) * 1024)
#define LDB(dst, b, h) _Pragma("unroll") for (int n = 0; n < 2; ++n) _Pragma("unroll") for (int k = 0; k < 2; ++k) \
    dst[n][k] = *reinterpret_cast<const bf16x8*>(ldB + ((b) * 2 + (h)) * 16384 + (n * 2 + k) * 1024)
#define MMA(ai, bj, At_, Bt_) do { __builtin_amdgcn_s_setprio(1); \
    _Pragma("unroll") for (int m = 0; m < 4; ++m) _Pragma("unroll") for (int n = 0; n < 2; ++n) _Pragma("unroll") for (int k = 0; k < 2; ++k) \
      acc[ai][bj][m][n] = mfma16(Bt_[n][k], At_[m][k], acc[ai][bj][m][n]); \
    __builtin_amdgcn_s_setprio(0); } while (0)
#define WAIT_V(n) asm volatile("s_waitcnt vmcnt(" #n ")" ::: "memory")
#define WAIT_L(n) asm volatile("s_waitcnt lgkmcnt(" #n ")" ::: "memory")
#define BAR __builtin_amdgcn_s_barrier()
#define SCHED __builtin_amdgcn_sched_barrier(0)
  bf16x8 At[4][2], B0[2][2], B1[2][2];
  const int nt = K >> 6;
  if (!PRE_ISSUED) {
    STAGE_B(SB(0, 0), 0, 0); STAGE_A(SA(0, 0), 0, 0);
    STAGE_B(SB(0, 1), 1, 0); STAGE_A(SA(0, 1), 1, 0);
  }
  if (ISSUE_ONLY) return;
  if (wr == 1) BAR;
  if (PRE_ISSUED) { WAIT_V(0); } else { WAIT_V(4); }
  BAR;
  STAGE_B(SB(1, 0), 0, 1); STAGE_A(SA(1, 0), 0, 1); STAGE_B(SB(1, 1), 1, 1);
  WAIT_V(6); BAR;
#pragma nounroll
  for (int t = 0; t < nt - 2; t += 2) {
    LDB(B0, 0, 0); SCHED; LDA(At, 0, 0); STAGE_A(SA(1, 1), 1, t + 1);
    WAIT_L(8); BAR; WAIT_L(0); MMA(0, 0, At, B0); BAR; SCHED;
    LDB(B1, 0, 1); STAGE_B(SB(0, 0), 0, t + 2);
    BAR; WAIT_L(0); MMA(0, 1, At, B1); BAR;
    LDA(At, 0, 1); STAGE_A(SA(0, 0), 0, t + 2);
    BAR; WAIT_L(0); MMA(1, 0, At, B0); BAR; SCHED;
    STAGE_B(SB(0, 1), 1, t + 2);
    WAIT_V(6); BAR; MMA(1, 1, At, B1); BAR;
    LDB(B0, 1, 0); SCHED; LDA(At, 1, 0); STAGE_A(SA(0, 1), 1, t + 2);
    WAIT_L(8); BAR; WAIT_L(0); MMA(0, 0, At, B0); BAR; SCHED;
    LDB(B1, 1, 1); STAGE_B(SB(1, 0), 0, t + 3);
    BAR; WAIT_L(0); MMA(0, 1, At, B1); BAR;
    LDA(At, 1, 1); STAGE_A(SA(1, 0), 0, t + 3);
    BAR; WAIT_L(0); MMA(1, 0, At, B0); BAR; SCHED;
    STAGE_B(SB(1, 1), 1, t + 3);
    WAIT_V(6); BAR; MMA(1, 1, At, B1); BAR;
  }
  { LDB(B0, 0, 0); LDA(At, 0, 0); STAGE_A(SA(1, 1), 1, nt - 1);
    BAR; WAIT_L(0); MMA(0, 0, At, B0); BAR;
    LDB(B1, 0, 1); BAR; WAIT_L(0); MMA(0, 1, At, B1); BAR;
    LDA(At, 0, 1); WAIT_V(4); BAR; WAIT_L(0); MMA(1, 0, At, B0); MMA(1, 1, At, B1); BAR; }
  { LDB(B0, 1, 0); LDA(At, 1, 0); WAIT_V(2); BAR; WAIT_L(0); MMA(0, 0, At, B0); BAR;
    LDB(B1, 1, 1); WAIT_V(0); BAR; WAIT_L(0); MMA(0, 1, At, B1); BAR;
    LDA(At, 1, 1); BAR; WAIT_L(0); MMA(1, 0, At, B0); MMA(1, 1, At, B1); BAR; }
  if (wr == 0) BAR;
  BAR;
#undef SA
#undef SB
#undef STAGE_A
#undef STAGE_B
#undef LDA
#undef LDB
#undef MMA
#undef WAIT_V
#undef WAIT_L
#undef BAR
#undef SCHED
}

struct TileIt {
  int TN, npc, npatch, slot, nslot, pid, s, tm, tn;
  __device__ __forceinline__ void init(int TN_) { TN = TN_; npc = (TN + 1) >> 1; npatch = 8 * npc; slot = blockIdx.x >> 3; nslot = gridDim.x >> 3; pid = blockIdx.x & 7; s = slot - nslot; }
  __device__ __forceinline__ bool next() {
    for (;;) {
      s += nslot;
      if (s >= 32) { s = slot; pid += 8; }
      if (pid >= npatch) return false;
      const int pr = pid / npc, pc = pid - pr * npc;
      tm = pr * 16 + (s & 15); tn = pc * 2 + (s >> 4);
      if (tn < TN) return true;
    }
  }
};

#define GEMM_LANE const int tid_ = TIDX, lane_ = tid_ & 63, wid_ = tid_ >> 6, wr = wid_ >> 2, wc = wid_ & 3, fr = lane_ & 15, fq = lane_ >> 4
#define GEMM_EPI_LOOP _Pragma("unroll") for (int ai = 0; ai < 2; ++ai) _Pragma("unroll") for (int m = 0; m < 4; ++m) _Pragma("unroll") for (int bj = 0; bj < 2; ++bj)

template <class Epi> __device__ __forceinline__ void gemm_phase(const bf16_t* A, int lda, const bf16_t* Bt, int ldb, int K, int TN, char* lds, Epi&& epi) {
  TileIt it; it.init(TN);
  bool have = it.next();
  f32x4 acc[2][2][4][2];
  if (have) gemm_core<true, false>(acc, A + (size_t)it.tm * 256 * lda, lda, Bt + (size_t)it.tn * 256 * ldb, ldb, K, lds);
  while (have) {
    const int tm = it.tm, tn = it.tn;
#pragma unroll
    for (int i0 = 0; i0 < 2; ++i0)
#pragma unroll
      for (int i1 = 0; i1 < 2; ++i1)
#pragma unroll
        for (int i2 = 0; i2 < 4; ++i2)
#pragma unroll
          for (int i3 = 0; i3 < 2; ++i3) acc[i0][i1][i2][i3] = zero4();
    gemm_core<false, true>(acc, A + (size_t)tm * 256 * lda, lda, Bt + (size_t)tn * 256 * ldb, ldb, K, lds);
    have = it.next();
    if (have) { f32x4 dummy[2][2][4][2]; gemm_core<true, false>(dummy, A + (size_t)it.tm * 256 * lda, lda, Bt + (size_t)it.tn * 256 * ldb, ldb, K, lds); }
    epi(acc, tm, tn);
  }
  asm volatile("s_waitcnt vmcnt(0)" ::: "memory");
}

__device__ __forceinline__ void gemm_up_phase(const bf16_t* a, const bf16_t* wgu, bf16_t* act, char* lds) {
  gemm_phase(a, 1024, wgu, 1024, 1024, NGU / 256, lds, [&](f32x4 (&acc)[2][2][4][2], int tm, int tn) {
    GEMM_LANE;
    GEMM_EPI_LOOP {
      const int row = tm * 256 + ai * 128 + wr * 64 + m * 16 + fr;
      const int col = tn * 128 + bj * 64 + wc * 16 + 4 * fq;
      const f32x4 g = acc[ai][bj][m][0], u = acc[ai][bj][m][1];
      u32x2 o; o.x = pk2(silu_f(g[0]) * u[0], silu_f(g[1]) * u[1]); o.y = pk2(silu_f(g[2]) * u[2], silu_f(g[3]) * u[3]);
      *(u32x2*)(act + (size_t)row * DFF + col) = o;
    }
  });
}

__device__ __forceinline__ void gemm_bf16_phase(const bf16_t* A, int lda, const bf16_t* Bt, int K, int TN, bf16_t* out, int ldo, char* lds) {
  gemm_phase(A, lda, Bt, K, K, TN, lds, [&](f32x4 (&acc)[2][2][4][2], int tm, int tn) {
    GEMM_LANE;
    GEMM_EPI_LOOP {
      const int row = tm * 256 + ai * 128 + wr * 64 + m * 16 + fr;
#pragma unroll
      for (int n = 0; n < 2; ++n) {
        u32x2 o; o.x = pk2(acc[ai][bj][m][n][0], acc[ai][bj][m][n][1]); o.y = pk2(acc[ai][bj][m][n][2], acc[ai][bj][m][n][3]);
        *(u32x2*)(out + (size_t)row * ldo + tn * 256 + bj * 128 + wc * 32 + n * 16 + 4 * fq) = o;
      }
    }
  });
}

__device__ __forceinline__ void gemm_ple_phase(const bf16_t* a, const bf16_t* wpg, const bf16_t* pp, bf16_t* out, char* lds) {
  gemm_phase(a, 1024, wpg, 1024, 1024, 4, lds, [&](f32x4 (&acc)[2][2][4][2], int tm, int tn) {
    GEMM_LANE;
    GEMM_EPI_LOOP {
      const int row = tm * 256 + ai * 128 + wr * 64 + m * 16 + fr;
#pragma unroll
      for (int n = 0; n < 2; ++n) {
        const int col = tn * 256 + bj * 128 + wc * 32 + n * 16 + 4 * fq;
        const u32x2 pv = *(const u32x2*)(pp + (size_t)row * 1024 + col);
        const f32x4 av = acc[ai][bj][m][n];
        u32x2 o;
        o.x = pk2(sigm(av[0]) * __uint_as_float(pv.x << 16), sigm(av[1]) * __uint_as_float(pv.x & 0xffff0000u));
        o.y = pk2(sigm(av[2]) * __uint_as_float(pv.y << 16), sigm(av[3]) * __uint_as_float(pv.y & 0xffff0000u));
        *(u32x2*)(out + (size_t)row * 1024 + col) = o;
      }
    }
  });
}

__device__ __forceinline__ void mixA_item(const Params& P, int layer, int idx, const bf16_t* z, bf16_t* y, char* lds) {
  const int g = idx & 3, bc = idx >> 2, tok0 = bc * 128;
  const int tid = HTID, lane = tid & 63, w = tid >> 6, fr = lane & 15, fq = lane >> 4;
  bf16_t* vT = (bf16_t*)lds;
  const float* ng = P.sgu_ng + layer * 256;
  {
    const int s = tid >> 1, half = tid & 1;
    const bf16_t* zr = z + (size_t)(tok0 + s) * LDZ + ZC_AV;
    float ss = 0.f;
#pragma unroll 4
    for (int i = 0; i < 16; ++i) { float v[8]; unpack8(*(const u32x4*)(zr + half * 128 + i * 8), v);
#pragma unroll
      for (int e = 0; e < 8; ++e) { const float t = gelu_t(v[e]); ss += t * t; } }
    ss += __shfl_xor(ss, 1);
    const float rs = rsqrtf(ss * (1.f / 256.f) + 1e-6f);
#pragma unroll
    for (int i = 0; i < 4; ++i) { float v[8]; unpack8(*(const u32x4*)(zr + g * 64 + half * 32 + i * 8), v);
#pragma unroll
      for (int e = 0; e < 8; ++e) { const int d = half * 32 + i * 8 + e; vT[d * 136 + s] = f2bf(gelu_t(v[e]) * rs * ng[g * 64 + d]); } }
  }
  __syncthreads();
  const bf16_t* W = (const bf16_t*)(P.ws + OFF_SGUW) + (size_t)((layer * 4 + g) * 128) * 128;
  f32x4 acc[2][4] = {};
  for (int ks = 0; ks <= w; ++ks) {
    bf16x8 wf[2], vf[4];
#pragma unroll
    for (int tm = 0; tm < 2; ++tm) wf[tm] = *(const bf16x8*)(W + (size_t)(32 * w + tm * 16 + fr) * 128 + ks * 32 + 8 * fq);
#pragma unroll
    for (int dn = 0; dn < 4; ++dn) vf[dn] = *(const bf16x8*)(vT + (dn * 16 + fr) * 136 + ks * 32 + 8 * fq);
#pragma unroll
    for (int tm = 0; tm < 2; ++tm)
#pragma unroll
      for (int dn = 0; dn < 4; ++dn) acc[tm][dn] = mfma16(vf[dn], wf[tm], acc[tm][dn]);
  }
#pragma unroll
  for (int tm = 0; tm < 2; ++tm) {
    const int t = 32 * w + tm * 16 + fr;
    const float bias = P.sgu_b[(layer * 4 + g) * 128 + t];
#pragma unroll
    for (int dn = 0; dn < 4; ++dn) {
      const int d = dn * 16 + 4 * fq;
      const uint2 uu = *(const uint2*)(z + (size_t)(tok0 + t) * LDZ + ZC_AU + g * 64 + d);
      const float u0 = gelu_t(__uint_as_float(uu.x << 16)), u1 = gelu_t(__uint_as_float(uu.x & 0xffff0000u)),
                  u2 = gelu_t(__uint_as_float(uu.y << 16)), u3 = gelu_t(__uint_as_float(uu.y & 0xffff0000u));
      uint2 o; o.x = pk2(u0 * (acc[tm][dn][0] + bias), u1 * (acc[tm][dn][1] + bias)); o.y = pk2(u2 * (acc[tm][dn][2] + bias), u3 * (acc[tm][dn][3] + bias));
      *(uint2*)(y + (size_t)(tok0 + t) * 1024 + g * 64 + d) = o;
    }
  }
  __syncthreads();
}

__device__ __forceinline__ void mixB1_item(const Params& P, int layer, int idx, const bf16_t* z, float* hsl, float* Pc, float* carryP, float* carryH, char* lds) {
  const int c = idx & 63, g = (idx >> 6) & 3, b = idx >> 8;
  const int tid = HTID, lane = tid & 63, w = tid >> 6, fr = lane & 15, fq = lane >> 4;
  bf16_t* xcb = (bf16_t*)lds;
  float* xcf = (float*)(lds + 9216);
  float* aA = (float*)(lds + 9216 + 16384);
  float* bB = (float*)(lds + 9216 + 32768);
  float* sm = (float*)(lds + 9216 + 49152);
  const size_t tokb = (size_t)b * SEQ;
  {
    const int t = tid >> 2, q = tid & 3;
    float accv[16];
#pragma unroll
    for (int i = 0; i < 16; ++i) accv[i] = P.conv_b[layer * 256 + g * 64 + q * 16 + i];
#pragma unroll
    for (int k = 0; k < 4; ++k) {
      const int pos = c * 64 + t - 3 + k;
      if (pos >= 0) {
        const bf16_t* zr = z + (tokb + pos) * LDZ + ZC_BX + g * 64 + q * 16;
        float v[16]; unpack8(*(const u32x4*)zr, v); unpack8(*(const u32x4*)(zr + 8), v + 8);
        const float* cw = P.conv_w + (size_t)(layer * 4 + k) * 256 + g * 64 + q * 16;
#pragma unroll
        for (int i = 0; i < 16; ++i) accv[i] += v[i] * cw[i];
      }
    }
#pragma unroll
    for (int i = 0; i < 16; ++i) { xcf[t * 64 + q * 16 + i] = accv[i]; xcb[t * 72 + q * 16 + i] = f2bf(accv[i]); }
  }
  __syncthreads();
  {
    const bf16_t* wa = (const bf16_t*)(P.ws + OFF_WAT) + (layer * 4 + g) * 4096;
    const bf16_t* wx = (const bf16_t*)(P.ws + OFF_WXT) + (layer * 4 + g) * 4096;
    f32x4 ar[4] = {}, ai[4] = {};
#pragma unroll
    for (int ks = 0; ks < 2; ++ks) {
      const bf16x8 xf = *(const bf16x8*)(xcb + (16 * w + fr) * 72 + ks * 32 + 8 * fq);
#pragma unroll
      for (int jn = 0; jn < 4; ++jn) {
        const bf16x8 fa = *(const bf16x8*)(wa + (jn * 16 + fr) * 64 + ks * 32 + 8 * fq);
        const bf16x8 fx = *(const bf16x8*)(wx + (jn * 16 + fr) * 64 + ks * 32 + 8 * fq);
        ar[jn] = mfma16(fa, xf, ar[jn]); ai[jn] = mfma16(fx, xf, ai[jn]);
      }
    }
    const int t = 16 * w + fr;
#pragma unroll
    for (int jn = 0; jn < 4; ++jn)
#pragma unroll
      for (int e = 0; e < 4; ++e) {
        const int j = jn * 16 + 4 * fq + e, ch = layer * 256 + g * 64 + j;
        const float r = sigm(ar[jn][e] + P.lru_ba[ch]), ig = sigm(ai[jn][e] + P.lru_bx[ch]);
        const float lam = P.lru_lam[ch];
        const float xe = __expf(-lam);
        float m8; asm volatile("v_mov_b32 %0, 0xc1000000" : "=v"(m8));
        const float la = m8 * r * (xe * (1.f - xe * (0.5f - xe * (1.f / 3.f))));
        const float av = __expf(la);
        const float y2 = 2.f * la;
        const float om = -y2 * (1.f + y2 * (0.5f + y2 * ((1.f / 6.f) + y2 * ((1.f / 24.f) + y2 * ((1.f / 120.f) + y2 * (1.f / 720.f))))));
        const float bv = sqrtf(om) * (ig * xcf[t * 64 + j]);
        aA[t * 64 + j] = av; bB[t * 64 + j] = bv;
      }
  }
  __syncthreads();
  {
    const int q = tid >> 6, j = tid & 63;
    float Pq = 1.f, hq = 0.f;
#pragma unroll
    for (int i = 0; i < 16; ++i) { const int t = q * 16 + i; const float av = aA[t * 64 + j], bv = bB[t * 64 + j]; hq = av * hq + bv; Pq *= av; aA[t * 64 + j] = Pq; bB[t * 64 + j] = hq; }
    sm[q * 64 + j] = Pq; sm[256 + q * 64 + j] = hq;
    __syncthreads();
    float Pin = 1.f, Hin = 0.f;
    for (int qq = 0; qq < q; ++qq) { const float pp = sm[qq * 64 + j], hh = sm[256 + qq * 64 + j]; Hin = pp * Hin + hh; Pin *= pp; }
    float hl = 0.f, pl = 1.f;
#pragma unroll
    for (int i = 0; i < 16; ++i) { const int t = q * 16 + i; hl = bB[t * 64 + j] + aA[t * 64 + j] * Hin; pl = aA[t * 64 + j] * Pin;
      const size_t o = (tokb + c * 64 + t) * 256 + g * 64 + j; hsl[o] = hl; Pc[o] = pl; }
    if (q == 3) { const int o = ((b * 4 + g) * 64 + c) * 64 + j; carryP[o] = pl; carryH[o] = hl; }
  }
  __syncthreads();
}

__device__ __forceinline__ void mixB2_item(int idx, const bf16_t* z, const float* hsl, const float* Pc, const float* carryP, const float* carryH, bf16_t* y) {
  const int c = idx & 63, g = (idx >> 6) & 3, b = idx >> 8;
  const int q = HTID >> 6, j = HTID & 63;
  const float* cp = carryP + (size_t)((b * 4 + g) * 64) * 64 + j;
  const float* chh = carryH + (size_t)((b * 4 + g) * 64) * 64 + j;
  float H = 0.f;
  for (int c0 = 0; c0 < c; c0 += 8) {
    float pv[8], hv[8];
#pragma unroll
    for (int i = 0; i < 8; ++i) { const bool ok = c0 + i < c; pv[i] = ok ? cp[(c0 + i) * 64] : 1.f; hv[i] = ok ? chh[(c0 + i) * 64] : 0.f; }
#pragma unroll
    for (int i = 0; i < 8; ++i) H = pv[i] * H + hv[i];
  }
  const size_t tokb = (size_t)b * SEQ + c * 64 + q * 16;
#pragma unroll 4
  for (int i = 0; i < 16; ++i) {
    const size_t o = (tokb + i) * 256 + g * 64 + j;
    const float h = hsl[o] + Pc[o] * H;
    const float gt = bf2f(z[(tokb + i) * LDZ + ZC_BG + g * 64 + j]);
    y[(tokb + i) * 1024 + 256 + g * 64 + j] = f2bf(h * gelu_t(gt));
  }
}

__device__ __forceinline__ void compress_item(const Params& P, int layer, int idx, const bf16_t* z, bf16_t* kcv, char* lds) {
  const int nb = idx & 15, g = (idx >> 4) & 1, b = (idx >> 5) & 7, kv = idx >> 8;
  const int tid = HTID, lane = tid & 63, w = tid >> 6, fr = lane & 15, fq = lane >> 4;
  const int n0 = nb * 16, col = (kv ? ZC_VC : ZC_KC) + g * 64;
  const bf16_t* w1t = (const bf16_t*)(P.ws + OFF_CW1 + (size_t)(layer * 2 + kv) * SZ_CW1);
  float* part = (float*)lds;
  float* hid = (float*)(lds + 34816);
  f32x4 acc[8];
#pragma unroll
  for (int jf = 0; jf < 8; ++jf) acc[jf] = zero4();
  int nn = n0 + fr; if (nn > 254) nn = 254;
  const bf16_t* zb = z + ((size_t)b * SEQ + 16 * nn) * LDZ + col + 8 * fq;
  const bf16_t* wb = w1t + (size_t)fr * 2048 + 8 * fq;
#pragma unroll 4
  for (int kk = 0; kk < 16; ++kk) {
    const int ks = 16 * w + kk, l = ks >> 1, d0 = (ks & 1) * 32;
    const bf16x8 xf = *(const bf16x8*)(zb + (size_t)l * LDZ + d0);
#pragma unroll
    for (int jf = 0; jf < 8; ++jf) { const bf16x8 wf = *(const bf16x8*)(wb + (size_t)jf * 16 * 2048 + ks * 32); acc[jf] = mfma16(wf, xf, acc[jf]); }
  }
#pragma unroll
  for (int jf = 0; jf < 8; ++jf)
#pragma unroll
    for (int e = 0; e < 4; ++e) part[(w * 16 + fr) * 132 + jf * 16 + 4 * fq + e] = acc[jf][e];
  __syncthreads();
  const float* cb1 = (const float*)(P.ws + OFF_CB1) + (layer * 2 + kv) * 128;
  {
    const int n = tid >> 4, j0 = (tid & 15) * 8;
#pragma unroll
    for (int e = 0; e < 8; ++e) { const int j = j0 + e; const float v = ((part[(0 * 16 + n) * 132 + j] + part[(1 * 16 + n) * 132 + j]) + part[(2 * 16 + n) * 132 + j]) + part[(3 * 16 + n) * 132 + j];
      hid[n * 129 + j] = gelu_t(v + cb1[j]); }
  }
  __syncthreads();
  {
    const int n = tid >> 4, d0 = (tid & 15) * 4;
    const float* w2 = P.cmp_w2 + (size_t)(layer * 2 + kv) * 128 * 64 + d0;
    const float4 bb = *(const float4*)(P.cmp_b2 + (layer * 2 + kv) * 64 + d0);
    float o0 = bb.x, o1 = bb.y, o2 = bb.z, o3 = bb.w;
#pragma unroll 8
    for (int j = 0; j < 128; ++j) { const float hv = hid[n * 129 + j]; const float4 wa = *(const float4*)(w2 + j * 64); o0 += hv * wa.x; o1 += hv * wa.y; o2 += hv * wa.z; o3 += hv * wa.w; }
    u32x2 ov; ov.x = pk2(o0, o1); ov.y = pk2(o2, o3);
    if ((n0 + n) >= 255) { ov.x = 0u; ov.y = 0u; }
    *(u32x2*)(kcv + ((size_t)((kv * 8 + b) * 2 + g) * 256 + n0 + n) * 64 + d0) = ov;
  }
  __syncthreads();
}

constexpr int NSA_KT = 0, NSA_VT = 16384, NSA_T = 33792, NSA_TW = NSA_T + 4 * 4160 * 4, NSA_IMP = NSA_TW + 4 * 640 * 4, NSA_WU = NSA_IMP + 2 * 16640;
constexpr int LDS_ST = 147456;
constexpr float LOG2E = 1.4426950408889634f;

__device__ __forceinline__ void nsa_tables(const Params& P, int g, char* lds) {
  float* T = (float*)(lds + NSA_T);
  float* TW = (float*)(lds + NSA_TW);
  const int tid = TIDX;
  for (int i = tid; i < 4160; i += 512) {
    const int n = i - 64;
    int bk = n;
    if (n >= 16) bk = 16 + (n >= 21) + (n >= 27) + (n >= 35) + (n >= 46) + (n >= 59) + (n >= 77) + (n >= 99) + (n >= 128) + (n >= 166) + (n >= 216) + (n >= 280) + (n >= 363) + (n >= 470) + (n >= 609) + (n >= 790);
#pragma unroll
    for (int r = 0; r < 4; ++r) {
      const float v = n >= 0 ? P.rel_bias[bk * 8 + g * 4 + r] * LOG2E : -__builtin_inff();
      T[r * 4160 + i] = v;
      if (i < 640) TW[r * 640 + i] = (n < 512) ? v : -__builtin_inff();
    }
  }
  __syncthreads();
}

struct KVRegs { u32x4 k0, v0; };
__device__ __forceinline__ void kv_gload(KVRegs& r, const bf16_t* kb, const bf16_t* vb, size_t stride) {
  const int tid = TIDX, row = tid >> 3, cq = tid & 7;
  r.k0 = *(const u32x4*)(kb + row * stride + cq * 8); r.v0 = *(const u32x4*)(vb + row * stride + cq * 8);
}
__device__ __forceinline__ void kv_lwrite(const KVRegs& r, char* lds, int buf) {
  const int tid = TIDX, row = tid >> 3, cq = tid & 7;
  char* kt = lds + NSA_KT + buf * 8192 + row * 128;
  *(u32x4*)(kt + ((cq ^ (row & 7)) << 4)) = r.k0;
  bf16_t* vt = (bf16_t*)(lds + NSA_VT + buf * 8704) + (cq * 8) * 68 + row;
#pragma unroll
  for (int i = 0; i < 4; ++i) { vt[(2 * i) * 68] = (bf16_t)(r.v0[i] & 0xffffu); vt[(2 * i + 1) * 68] = (bf16_t)(r.v0[i] >> 16); }
}

template <int MODE>
__device__ __forceinline__ void nsa_compute(int cur, int buf, int t, int hl, u64 mymask, const bf16x8 (&Qf)[2][2], f32x4 (&O)[4][2], float (&m)[2], float (&l)[2],
                                            const float (&inv)[2], float* impw, char* lds) {
  const int lane = TIDX & 63, fr = lane & 15, fq = lane >> 4;
  const char* kt = lds + NSA_KT + buf * 8192;
  const bf16_t* vt = (const bf16_t*)(lds + NSA_VT + buf * 8704);
  const bool selok = (MODE == 2) ? (((mymask >> cur) & 1ull) != 0ull) : true;
  const float* tb = (MODE == 3) ? (const float*)(lds + NSA_TW) + hl * 640 : (const float*)(lds + NSA_T) + hl * 4160;
  constexpr int TS = (MODE == 3) ? 640 : 4160;
  const int base = (MODE <= 1) ? (t - 31 - 16 * (cur * 64 + 4 * fq) + 64) : (t - cur * 64 - 4 * fq + 64);
#pragma unroll
  for (int s2 = 0; s2 < 2; ++s2) {
    f32x4 S[2][2];
    S[0][0] = zero4(); S[0][1] = zero4(); S[1][0] = zero4(); S[1][1] = zero4();
#pragma unroll
    for (int ks = 0; ks < 2; ++ks)
#pragma unroll
      for (int kk = 0; kk < 2; ++kk) {
        const bf16x8 kf = *(const bf16x8*)(kt + (32 * s2 + 16 * kk + fr) * 128 + (((ks * 4 + fq) ^ (fr & 7)) << 4));
#pragma unroll
        for (int r = 0; r < 2; ++r) S[kk][r] = mfma16(kf, Qf[r][ks], S[kk][r]);
      }
    bf16x8 Pf[2];
    float g1s[2] = {0.f, 0.f}, p3s[2] = {0.f, 0.f};
#pragma unroll
    for (int r = 0; r < 2; ++r) {
      float sv[2][4];
#pragma unroll
      for (int kk = 0; kk < 2; ++kk)
#pragma unroll
        for (int e = 0; e < 4; ++e) {
          const int off = 32 * s2 + 16 * kk + e;
          int idx;
          if (MODE <= 1) { idx = base - 16 * off; idx = idx > 0 ? idx : 0; } else idx = base - off;
          sv[kk][e] = S[kk][r][e] * (0.125f * LOG2E) + tb[r * TS + idx];
        }
      float pv[2][4];
      if (MODE == 1) {
#pragma unroll
        for (int kk = 0; kk < 2; ++kk)
#pragma unroll
          for (int e = 0; e < 4; ++e) pv[kk][e] = __builtin_amdgcn_exp2f(sv[kk][e] - m[r]) * inv[r];
#pragma unroll
        for (int kk = 0; kk < 2; ++kk) { g1s[kk] += pv[kk][0] + pv[kk][1] + pv[kk][2] + 0.5f * pv[kk][3]; p3s[kk] += 0.5f * pv[kk][3]; }
      } else {
        float mx = fmaxf(fmaxf(fmaxf(sv[0][0], sv[0][1]), fmaxf(sv[0][2], sv[0][3])), fmaxf(fmaxf(sv[1][0], sv[1][1]), fmaxf(sv[1][2], sv[1][3])));
        if (MODE == 2) mx = selok ? mx : -__builtin_inff();
        if (__any(mx > m[r] + 8.0f)) {
          mx = fmaxf(mx, __shfl_xor(mx, 16)); mx = fmaxf(mx, __shfl_xor(mx, 32));
          const float mn = fmaxf(m[r], mx), al = __builtin_amdgcn_exp2f(m[r] - mn);
          m[r] = mn; l[r] *= al;
          if (MODE != 0) {
#pragma unroll
            for (int df = 0; df < 4; ++df) O[df][r] *= al;
          }
        }
        const float me = (MODE == 2) ? (selok ? m[r] : __builtin_inff()) : m[r];
        float ps = 0.f;
#pragma unroll
        for (int kk = 0; kk < 2; ++kk)
#pragma unroll
          for (int e = 0; e < 4; ++e) { pv[kk][e] = __builtin_amdgcn_exp2f(sv[kk][e] - me); ps += pv[kk][e]; }
        l[r] += ps;
      }
      if (MODE != 0) {
        const unsigned w0 = pk2(pv[0][0], pv[0][1]), w1 = pk2(pv[0][2], pv[0][3]), w2 = pk2(pv[1][0], pv[1][1]), w3 = pk2(pv[1][2], pv[1][3]);
        u32x4 pw; pw.x = w0; pw.y = w1; pw.z = w2; pw.w = w3;
        Pf[r] = __builtin_bit_cast(bf16x8, pw);
      }
    }
    if (MODE != 0) {
#pragma unroll
      for (int df = 0; df < 4; ++df) {
        const bf16x4 va = *(const bf16x4*)(vt + (df * 16 + fr) * 68 + 32 * s2 + 4 * fq);
        const bf16x4 vb = *(const bf16x4*)(vt + (df * 16 + fr) * 68 + 32 * s2 + 16 + 4 * fq);
        bf16x8 vf; vf[0] = va[0]; vf[1] = va[1]; vf[2] = va[2]; vf[3] = va[3]; vf[4] = vb[0]; vf[5] = vb[1]; vf[6] = vb[2]; vf[7] = vb[3];
#pragma unroll
        for (int r = 0; r < 2; ++r) O[df][r] = mfma16(vf, Pf[r], O[df][r]);
      }
    }
    if (MODE == 1) {
#pragma unroll
      for (int kk = 0; kk < 2; ++kk) {
        const int j = cur * 16 + (2 * s2 + kk) * 4 + fq;
        atomicAdd(&impw[fr * 65 + j], g1s[kk]);
        if (j + 1 < 64) atomicAdd(&impw[fr * 65 + j + 1], p3s[kk]);
      }
    }
  }
}

template <int MODE>
__device__ __forceinline__ void nsa_branch(int first, int ntl, u64 U, const bf16_t* kbase, const bf16_t* vbase, size_t stride, int t, int hl, u64 mymask,
                                           const bf16x8 (&Qf)[2][2], f32x4 (&O)[4][2], float (&m)[2], float (&l)[2], const float (&inv)[2], float* impw, char* lds) {
  KVRegs R0, R1, R2;
  u64 rem = U;
  int seq = first, left = ntl;
#define NSA_NEXT(dst)                                                                                     \
  { if (MODE == 2) { dst = rem ? (int)__builtin_ctzll(rem) : -1; if (rem) rem &= rem - 1; }              \
    else { dst = left > 0 ? seq : -1; ++seq; --left; } }
#define NSA_GLOAD(R, ti) kv_gload(R, kbase + (size_t)(ti) * 64 * stride, vbase + (size_t)(ti) * 64 * stride, stride)
  int tcur, t1, t2, t3;
  NSA_NEXT(tcur); NSA_NEXT(t1); NSA_NEXT(t2);
  if (tcur >= 0) NSA_GLOAD(R0, tcur);
  if (t1 >= 0) NSA_GLOAD(R1, t1);
  if (t2 >= 0) NSA_GLOAD(R2, t2);
  if (tcur >= 0) kv_lwrite(R0, lds, 0);
  __syncthreads();
  NSA_NEXT(t3);
  if (t3 >= 0) NSA_GLOAD(R0, t3);
  int buf = 0;
#define NSA_STEP(RW)                                                                                      \
  if (tcur < 0) break;                                                                                    \
  nsa_compute<MODE>(tcur, buf, t, hl, mymask, Qf, O, m, l, inv, impw, lds);                               \
  if (t1 >= 0) kv_lwrite(RW, lds, buf ^ 1);                                                               \
  __syncthreads();                                                                                        \
  buf ^= 1; tcur = t1; t1 = t2; t2 = t3;                                                                  \
  NSA_NEXT(t3);                                                                                           \
  if (t3 >= 0) NSA_GLOAD(RW, t3);
  for (;;) {
    NSA_STEP(R1)
    NSA_STEP(R2)
    NSA_STEP(R0)
  }
#undef NSA_STEP
#undef NSA_GLOAD
#undef NSA_NEXT
}

#define NSA_RESET()                                                                         \
  _Pragma("unroll") for (int r = 0; r < 2; ++r) { asm volatile("v_mov_b32 %0, 0xf149f2ca" : "=v"(m[r])); l[r] = 0.f; }               \
  _Pragma("unroll") for (int df = 0; df < 4; ++df) _Pragma("unroll") for (int r = 0; r < 2; ++r) O[df][r] = zero4();

__device__ __forceinline__ void nsa_item(const Params& P, int b, int g, int c, const bf16_t* z, const bf16_t* kcv, bf16_t* y, char* lds) {
  const int tid = TIDX, lane = tid & 63, w8 = tid >> 6, qg = w8 & 3, hp = w8 >> 2, fr = lane & 15, fq = lane >> 4;
  const size_t tokb = (size_t)b * SEQ;
  const int t = c * 64 + 16 * qg + fr;
  const bf16_t* zq = z + (tokb + t) * LDZ;
  const int hb = g * 4 + hp * 2;
  bf16x8 Qf[2][2];
#pragma unroll
  for (int r = 0; r < 2; ++r)
#pragma unroll
    for (int ks = 0; ks < 2; ++ks) Qf[r][ks] = *(const bf16x8*)(zq + ZC_Q + g * 256 + (hp * 2 + r) * 64 + ks * 32 + 8 * fq);
  float* impw = (float*)(lds + NSA_IMP) + (hp * 4 + qg) * (16 * 65);
  for (int i = lane; i < 16 * 65; i += 64) impw[i] = 0.f;
  f32x4 O[4][2];
  float m[2], l[2], inv[2];
  bf16_t* yo = y + (tokb + t) * 1024 + 512 + g * 256 + hp * 128 + 4 * fq;
  const bf16_t* kc = kcv + (size_t)((0 * 8 + b) * 2 + g) * 256 * 64;
  const bf16_t* vc = kcv + (size_t)((1 * 8 + b) * 2 + g) * 256 * 64;
  const int nct = ((4 * c + 2) >> 6) + 1;
  NSA_RESET();
  inv[0] = 0.f; inv[1] = 0.f;
  nsa_branch<0>(0, nct, 0ull, kc, vc, 64, t, hp * 2, 0ull, Qf, O, m, l, inv, impw, lds);
#pragma unroll
  for (int r = 0; r < 2; ++r) { float lt = l[r]; lt += __shfl_xor(lt, 16); lt += __shfl_xor(lt, 32); inv[r] = lt > 0.f ? 1.f / lt : 0.f; }
  nsa_branch<1>(0, nct, 0ull, kc, vc, 64, t, hp * 2, 0ull, Qf, O, m, l, inv, impw, lds);
#pragma unroll
  for (int r = 0; r < 2; ++r) {
    const float gt = sigm(bf2f(zq[ZC_GC + hb + r]));
#pragma unroll
    for (int df = 0; df < 4; ++df) { u32x2 o; o.x = pk2(O[df][r][0] * gt, O[df][r][1] * gt); o.y = pk2(O[df][r][2] * gt, O[df][r][3] * gt); *(u32x2*)(yo + r * 64 + df * 16) = o; }
  }
  __syncthreads();
  u64 wU = 0ull;
  {
    const float* imp0 = (const float*)(lds + NSA_IMP) + qg * (16 * 65);
    const float* imp1 = imp0 + 4 * (16 * 65);
    u64* MK = (u64*)(lds + NSA_WU) + 8;
    const u64 V = (c >= 63) ? ~0ull : ((1ull << (c + 1)) - 1ull);
    const bool forced = (lane == 0) | (lane == c) | (lane == c - 1);
    for (int q8 = 0; q8 < 8; ++q8) {
      const int qq = hp * 8 + q8;
      const float sv = imp0[qq * 65 + lane] + imp1[qq * 65 + lane];
      const unsigned u = __float_as_uint(forced ? 1e4f : sv);
      u64 mk = V;
      if (c + 1 > 16) {
        unsigned thr = 0u;
        for (int bb = 30; bb >= 0; --bb) { const unsigned cand = thr | (1u << bb); const u64 ge = __ballot(u >= cand) & V; if (__popcll(ge) >= 16) thr = cand; }
        const u64 G = __ballot(u > thr) & V, E = __ballot(u == thr) & V;
        const int need = 16 - (int)__popcll(G);
        const int below = (int)__popcll(E & ((1ull << lane) - 1ull));
        const bool se = (((E >> lane) & 1ull) != 0ull) && (below < need);
        mk = G | __ballot(se);
      }
      if (lane == 0) MK[qg * 16 + qq] = mk;
      wU |= mk;
    }
  }
  u64* WU = (u64*)(lds + NSA_WU);
  if (lane == 0) WU[w8] = wU;
  __syncthreads();
  const u64 U = WU[0] | WU[1] | WU[2] | WU[3] | WU[4] | WU[5] | WU[6] | WU[7];
  const u64 mymask = ((const u64*)(lds + NSA_WU) + 8)[qg * 16 + fr];
  for (int br = 0; br < 2; ++br) {
    NSA_RESET();
    int zg;
    if (br == 0) {
      nsa_branch<2>(0, 0, U, z + tokb * LDZ + ZC_KS + g * 64, z + tokb * LDZ + ZC_VS + g * 64, LDZ, t, hp * 2, mymask, Qf, O, m, l, inv, impw, lds);
      zg = ZC_GS;
    } else {
      const int kt0 = c > 8 ? c - 8 : 0;
      nsa_branch<3>(kt0, c - kt0 + 1, 0ull, z + tokb * LDZ + ZC_KW + g * 64, z + tokb * LDZ + ZC_VW + g * 64, LDZ, t, hp * 2, 0ull, Qf, O, m, l, inv, impw, lds);
      zg = ZC_GW;
    }
#pragma unroll
    for (int r = 0; r < 2; ++r) {
      float lt = l[r]; lt += __shfl_xor(lt, 16); lt += __shfl_xor(lt, 32);
      const float gt = sigm(bf2f(zq[zg + hb + r])) * (lt > 0.f ? 1.f / lt : 0.f);
#pragma unroll
      for (int df = 0; df < 4; ++df) {
        bf16_t* yp = yo + r * 64 + df * 16;
        const u32x2 pr = *(const u32x2*)yp;
        u32x2 o; o.x = pk2(__uint_as_float(pr.x << 16) + O[df][r][0] * gt, __uint_as_float(pr.x & 0xffff0000u) + O[df][r][1] * gt);
        o.y = pk2(__uint_as_float(pr.y << 16) + O[df][r][2] * gt, __uint_as_float(pr.y & 0xffff0000u) + O[df][r][3] * gt);
        *(u32x2*)yp = o;
      }
    }
  }
  __syncthreads();
}

__device__ __forceinline__ void run_phase(const Params& P, int ph, char* lds) {
  char* ws = P.ws;
  asm volatile("" : "+s"(ws));
  bf16_t* abuf = (bf16_t*)(ws + OFF_A);
  bf16_t* big = (bf16_t*)(ws + OFF_BIG);
  bf16_t* fbuf = (bf16_t*)(ws + OFF_F);
  bf16_t* h16 = (bf16_t*)(ws + OFF_F + (size_t)M_TOK * 1024 * 2);
  float* hsl = (float*)(ws + OFF_F); float* Pc = hsl + (size_t)M_TOK * 256;
  bf16_t* kcv = (bf16_t*)(ws + OFF_KC);
  float* carryP = (float*)(ws + OFF_CARRY); float* carryH = carryP + 8 * 4 * 64 * 64;
  if (ph == 0) { prep_phase(P, lds); return; }
  const int layer = (ph - 1) / 13, sp = (ph - 1) % 13;
  const float* ng = P.norm_g + (size_t)layer * 8 * 1024;
#ifdef ONLY_SP
  if (sp != ONLY_SP) return;
#endif
  switch (sp) {
    case 0: case 8: {
      const int lj = layer * 2 + (sp == 8);
      gemm_up_phase(abuf, (const bf16_t*)(ws + OFF_WGU + lj * SZ_WGU), big, lds);
    } break;
    case 1: case 9: {
      const int lj = layer * 2 + (sp == 9);
      gemm_bf16_phase(big, DFF, (const bf16_t*)(ws + OFF_WD + lj * SZ_WD), DFF, 4, fbuf, 1024, lds);
    } break;
    case 2: resnorm_phase(layer == 0 ? P.x : nullptr, h16, nullptr, h16, fbuf, 0.5f, ng + 1 * 1024, ng + 2 * 1024, abuf); break;
    case 3: gemm_bf16_phase(abuf, 1024, (const bf16_t*)(ws + OFF_WIN + layer * SZ_WIN), 1024, LDZ / 256, big, LDZ, lds); break;
    case 4: {
      const int hb = HBLK; char* hl = lds + hb * 65536;
      for (int it = blockIdx.x * 2 + hb; it < 512; it += gridDim.x * 2) compress_item(P, layer, it, big, kcv, hl);
      for (int it = blockIdx.x * 2 + hb; it < 1024; it += gridDim.x * 2) mixA_item(P, layer, it, big, abuf, hl);
      for (int it = blockIdx.x * 2 + hb; it < 2048; it += gridDim.x * 2) mixB1_item(P, layer, it, big, hsl, Pc, carryP, carryH, hl);
    } break;
    case 5: {
      nsa_tables(P, blockIdx.x & 1, lds);
      for (int it = blockIdx.x; it < 1024; it += gridDim.x) {
        const int rnd = it / 256, pos = it % 256;
        const int c = (rnd & 1) ? (rnd >> 1) * 16 + (pos >> 4) : 63 - (rnd >> 1) * 16 - (pos >> 4);
        const int bg = pos & 15;
        nsa_item(P, bg >> 1, bg & 1, c, big, kcv, abuf, lds);
      }
      const int hb = HBLK;
      for (int it = blockIdx.x * 2 + hb; it < 2048; it += gridDim.x * 2) mixB2_item(it, big, hsl, Pc, carryP, carryH, abuf);
    } break;
    case 6: gemm_bf16_phase(abuf, 1024, (const bf16_t*)(ws + OFF_WOUT + layer * SZ_SQ), 1024, 4, fbuf, 1024, lds); break;
    case 7: resnorm_phase(nullptr, h16, nullptr, h16, fbuf, 1.0f, ng + 3 * 1024, ng + 4 * 1024, abuf); break;
    case 10:
      gemm_bf16_phase((const bf16_t*)(ws + OFF_PBF) + (size_t)layer * M_TOK * 256, 256, (const bf16_t*)(ws + OFF_WPP + layer * SZ_WPP), 256, 4, big, 1024, lds);
      resnorm_phase(nullptr, h16, nullptr, h16, fbuf, 0.5f, ng + 5 * 1024, ng + 6 * 1024, abuf);
      break;
    case 11: gemm_ple_phase(abuf, (const bf16_t*)(ws + OFF_WPG + layer * SZ_SQ), big, fbuf, lds); break;
    case 12: resnorm_phase(nullptr, h16, layer == 0 ? nullptr : P.out, layer == 0 ? h16 : nullptr, fbuf, 1.0f, ng + 7 * 1024, layer == 0 ? P.norm_g + 8 * 1024 : nullptr, layer == 0 ? abuf : nullptr); break;
  }
}

#define XB_TMO      128
#define XB_XCNT(j)  (256  + 64 * (j))
#define XB_XSUB(j)  (1280 + 64 * (j))
#define XB_XGEN(j)  (2304 + 64 * (j))
#define XB_TOP      3328
#define XB_TOPGEN   3392
#define XCD_BAR_WORDS 3456
#define XB_SPIN_CAP (1u << 20)
#define LAS __attribute__((address_space(3)))
__device__ __forceinline__ unsigned xb_ld(unsigned* p)              { return __hip_atomic_load(p, __ATOMIC_RELAXED, __HIP_MEMORY_SCOPE_AGENT); }
__device__ __forceinline__ unsigned xb_add(unsigned* p, unsigned v) { return __hip_atomic_fetch_add(p, v, __ATOMIC_RELAXED, __HIP_MEMORY_SCOPE_AGENT); }
__device__ __forceinline__ unsigned xb_xcc_id() { return (unsigned)__builtin_amdgcn_s_getreg((3 << 11) | 20) & 0xFu; }
#define XB_SPIN(cond, bar) do { unsigned _sp = 0; while (cond) { __builtin_amdgcn_s_sleep(1); \
    if ((++_sp & 255u) == 0u) { if (xb_ld(&(bar)[XB_TMO])) break; if (_sp > XB_SPIN_CAP) { atomicAdd(&(bar)[XB_TMO], 1u); break; } } } } while (0)
struct XcdBarrier { unsigned* bar; unsigned x; volatile LAS unsigned* st; };
__device__ __forceinline__ XcdBarrier xcd_barrier_post(unsigned* bar, volatile LAS unsigned* st) {
    XcdBarrier b; b.bar = bar; b.x = xb_xcc_id(); b.st = st;
    if (threadIdx.x == 0) (void)xb_add(&bar[XB_XCNT(b.x)], 1u);
    return b;
}
__device__ __forceinline__ void xcd_barrier_complete(unsigned* bar, unsigned x, unsigned& nloc, unsigned& nx) {
    const unsigned G = gridDim.x * gridDim.y * gridDim.z;
    unsigned sum, cnt, mine, sp = 0u;
    for (;;) {
        sum = 0u; cnt = 0u; mine = 0u;
#pragma unroll
        for (unsigned j = 0; j < 16; ++j) { const unsigned c = xb_ld(&bar[XB_XCNT(j)]); sum += c; cnt += (c > 0u) ? 1u : 0u; mine = (j == x) ? c : mine; }
        if (sum == G) break;
        __builtin_amdgcn_s_sleep(1);
        if ((++sp & 255u) == 0u) { if (xb_ld(&bar[XB_TMO])) break; if (sp > XB_SPIN_CAP) { atomicAdd(&bar[XB_TMO], 1u); break; } }
    }
    nloc = mine > 0u ? mine : 1u; nx = cnt > 0u ? cnt : 1u;
}
__device__ __forceinline__ void xcd_barrier(const XcdBarrier& b) {
    asm volatile("s_waitcnt vmcnt(0)" ::: "memory");
    __syncthreads();
    if (threadIdx.x == 0) {
        unsigned* bar = b.bar;
        __builtin_amdgcn_s_waitcnt(0);
        unsigned nloc = b.st[0], nx = b.st[1];
        if (nloc == 0u) { xcd_barrier_complete(bar, b.x, nloc, nx); b.st[0] = nloc; b.st[1] = nx; }
        const unsigned old = xb_add(&bar[XB_XSUB(b.x)], 1u);
        const unsigned gen = old / nloc;
        if (old + 1u == (gen + 1u) * nloc) {
            __builtin_amdgcn_fence(__ATOMIC_RELEASE, "agent");
            asm volatile("s_waitcnt vmcnt(0)" ::: "memory");
            const unsigned og = xb_add(&bar[XB_TOP], 1u);
            const unsigned tg = og / nx;
            if (og + 1u == (tg + 1u) * nx) xb_add(&bar[XB_TOPGEN], 1u);
            else XB_SPIN(xb_ld(&bar[XB_TOPGEN]) == tg, bar);
            __builtin_amdgcn_fence(__ATOMIC_ACQUIRE, "agent");
            xb_add(&bar[XB_XGEN(b.x)], 1u);
            asm volatile("s_waitcnt vmcnt(0)" ::: "memory");
        } else {
            XB_SPIN(xb_ld(&bar[XB_XGEN(b.x)]) == gen, bar);
            __builtin_amdgcn_fence(__ATOMIC_ACQUIRE, "agent");
            asm volatile("s_waitcnt vmcnt(0)" ::: "memory");
        }
    }
    __syncthreads();
}

constexpr int LDS_BYTES = LDS_ST + 16;
__global__ void __launch_bounds__(512, 2) fwd_megakernel(Params P) {
  __shared__ __attribute__((aligned(16))) char lds[LDS_BYTES];
  cg::grid_group grid = cg::this_grid();
  volatile LAS unsigned* st = (volatile LAS unsigned*)(lds + LDS_ST);
  if (threadIdx.x == 0) { st[0] = 0u; st[1] = 0u; }
  __syncthreads();
  XcdBarrier xb = xcd_barrier_post((unsigned*)(P.ws + OFF_BAR), st);
  if (P.ws == nullptr) grid.sync();
  for (int ph = 0; ph < NPHASE; ++ph) {
    run_phase(P, ph, lds);
    if (ph + 1 < NPHASE) xcd_barrier(xb);
  }
}

__global__ void __launch_bounds__(512, 2) phase_kernel(Params P, int ph) {
  __shared__ __attribute__((aligned(16))) char lds[LDS_BYTES];
  run_phase(P, ph, lds);
}

extern "C" void kernel_launch(void* const* d_in, const int* in_sizes, int n_in, void* d_out, int out_size, void* d_ws, size_t ws_size, hipStream_t stream) {
  Params P{};
  const float** pp = (const float**)&P;
  for (int i = 0; i < 26; ++i) pp[i] = (const float*)d_in[i];
  P.out = (float*)d_out;
  P.ws = (char*)d_ws;
  if (ws_size < WS_NEED) { fprintf(stderr, "workspace too small: %zu < %zu\n", ws_size, (size_t)WS_NEED); return; }
#if MK_FUSED
  static int grid_blocks = 0;
  if (!grid_blocks) {
    int dev = 0, cus = 0, per_cu = 0;
    (void)hipGetDevice(&dev);
    (void)hipDeviceGetAttribute(&cus, hipDeviceAttributeMultiprocessorCount, dev);
    (void)hipOccupancyMaxActiveBlocksPerMultiprocessor(&per_cu, fwd_megakernel, 512, 0);
    if (per_cu > 1) per_cu = 1;
    if (per_cu < 1) per_cu = 1;
    grid_blocks = cus * per_cu;
  }
  (void)hipMemsetAsync((char*)d_ws + OFF_BAR, 0, XCD_BAR_WORDS * 4, stream);
  void* args[] = {&P};
  hipError_t e = hipLaunchCooperativeKernel((void*)fwd_megakernel, dim3(grid_blocks), dim3(512), args, 0, stream);
  if (e != hipSuccess) fprintf(stderr, "cooperative launch failed: %s (grid %d)\n", hipGetErrorString(e), grid_blocks);
#else
  for (int ph = 0; ph < NPHASE; ++ph) phase_kernel<<<256, 512, 0, stream>>>(P, ph);
#endif
}
```

```cpp
#include <hip/hip_runtime.h>
#include <hip/hip_cooperative_groups.h>
#include <cstdint>
#include <cstdio>
namespace cg = cooperative_groups;

#ifndef MK_FUSED
#define MK_FUSED 1
#endif

typedef unsigned short bf16_t;
typedef short bf16x8 __attribute__((ext_vector_type(8)));
typedef short bf16x4 __attribute__((ext_vector_type(4)));
typedef float f32x4 __attribute__((ext_vector_type(4)));
typedef unsigned long long u64;
typedef unsigned u32x4 __attribute__((ext_vector_type(4)));
typedef unsigned u32x2 __attribute__((ext_vector_type(2)));

constexpr int M_TOK = 32768, DM = 1024, DFF = 2816, NGU = 5632, NIN = 2328, LDZ = 2560, SEQ = 4096;
constexpr int NPHASE = 27;
constexpr int ZC_AU = 0, ZC_AV = 256, ZC_BX = 512, ZC_BG = 768, ZC_Q = 1024, ZC_KC = 1536, ZC_VC = 1664, ZC_KS = 1792, ZC_VS = 1920,
              ZC_KW = 2048, ZC_VW = 2176, ZC_GC = 2304, ZC_GS = 2312, ZC_GW = 2320;

constexpr size_t SZ_WGU = (size_t)NGU * 1024 * 2, SZ_WD = (size_t)1024 * DFF * 2, SZ_WIN = (size_t)LDZ * 1024 * 2, SZ_SQ = (size_t)1024 * 1024 * 2,
                 SZ_WPP = (size_t)1024 * 256 * 2, SZ_CW1 = (size_t)128 * 2048 * 2;
constexpr size_t OFF_WGU = 0;
constexpr size_t OFF_WD = OFF_WGU + 4 * SZ_WGU;
constexpr size_t OFF_WIN = OFF_WD + 4 * SZ_WD;
constexpr size_t OFF_WOUT = OFF_WIN + 2 * SZ_WIN;
constexpr size_t OFF_WPG = OFF_WOUT + 2 * SZ_SQ;
constexpr size_t OFF_WPP = OFF_WPG + 2 * SZ_SQ;
constexpr size_t OFF_CW1 = OFF_WPP + 2 * SZ_WPP;
constexpr size_t OFF_CB1 = OFF_CW1 + 4 * SZ_CW1;
constexpr size_t OFF_SGUW = OFF_CB1 + 4096;
constexpr size_t OFF_WAT = OFF_SGUW + 2 * 4 * 128 * 128 * 2;
constexpr size_t OFF_WXT = OFF_WAT + 2 * 4 * 64 * 64 * 2;
constexpr size_t OFF_PBF = OFF_WXT + 2 * 4 * 64 * 64 * 2;
constexpr size_t OFF_A = OFF_PBF + (size_t)2 * M_TOK * 256 * 2;
constexpr size_t OFF_BIG = OFF_A + (size_t)M_TOK * 1024 * 2;
constexpr size_t OFF_F = OFF_BIG + (size_t)M_TOK * DFF * 2;
constexpr size_t OFF_KC = OFF_F + (size_t)M_TOK * 1024 * 4;
constexpr size_t OFF_CARRY = OFF_KC + (size_t)2 * 8 * 2 * 256 * 64 * 2;
constexpr size_t OFF_BAR = OFF_CARRY + (size_t)2 * 8 * 4 * 64 * 64 * 4;
constexpr size_t WS_NEED = OFF_BAR + 16384;

struct Params {
  const float *x, *p, *rel_bias, *norm_g, *ffn_wg, *ffn_wu, *ffn_wd, *w_in, *w_out, *sgu_ng, *sgu_w, *sgu_b, *conv_w, *conv_b,
      *lru_wa, *lru_ba, *lru_wx, *lru_bx, *lru_lam, *cmp_pos, *cmp_w1, *cmp_b1, *cmp_w2, *cmp_b2, *ple_wg, *ple_wp;
  float* out;
  char* ws;
};

__device__ __forceinline__ int opaque_tid() { int t; asm volatile("v_mov_b32 %0, %1" : "=v"(t) : "v"(threadIdx.x)); return t; }
#define TIDX opaque_tid()
#define HTID (opaque_tid() & 255)
#define HBLK (opaque_tid() >> 8)
__device__ __forceinline__ float bf2f(bf16_t v) { return __uint_as_float(((unsigned)v) << 16); }
__device__ __forceinline__ bf16_t f2bf(float f) { unsigned u = __float_as_uint(f); u += 0x7fffu + ((u >> 16) & 1u); return (bf16_t)(u >> 16); }
__device__ __forceinline__ unsigned pk2(float lo, float hi) { unsigned r; asm("v_cvt_pk_bf16_f32 %0, %1, %2" : "=v"(r) : "v"(lo), "v"(hi)); return r; }
__device__ __forceinline__ float sigm(float x) { return __builtin_amdgcn_rcpf(1.f + __expf(-x)); }
__device__ __forceinline__ float gelu_t(float x) { float u = 0.7978845608028654f * (x + 0.044715f * x * x * x); return x * __builtin_amdgcn_rcpf(1.f + __expf(-2.f * u)); }
__device__ __forceinline__ float silu_f(float x) { return x * __builtin_amdgcn_rcpf(1.f + __expf(-x)); }
__device__ __forceinline__ f32x4 mfma16(bf16x8 a, bf16x8 b, f32x4 c) { return __builtin_amdgcn_mfma_f32_16x16x32_bf16(a, b, c, 0, 0, 0); }
__device__ __forceinline__ void glds16(const void* g, void* l) {
  __builtin_amdgcn_global_load_lds((const __attribute__((address_space(1))) unsigned*)g, (__attribute__((address_space(3))) unsigned*)l, 16, 0, 0);
}
__device__ __forceinline__ f32x4 zero4() { f32x4 z; asm volatile("v_mov_b32 %0, 0\n\tv_mov_b32 %1, 0\n\tv_mov_b32 %2, 0\n\tv_mov_b32 %3, 0" : "=v"(z[0]), "=v"(z[1]), "=v"(z[2]), "=v"(z[3])); return z; }
__device__ __forceinline__ float wave_sum(float v) {
#pragma unroll
  for (int o = 32; o > 0; o >>= 1) v += __shfl_xor(v, o);
  return v;
}
__device__ __forceinline__ void unpack8(const u32x4 u, float* f) {
  f[0] = __uint_as_float(u.x << 16); f[1] = __uint_as_float(u.x & 0xffff0000u);
  f[2] = __uint_as_float(u.y << 16); f[3] = __uint_as_float(u.y & 0xffff0000u);
  f[4] = __uint_as_float(u.z << 16); f[5] = __uint_as_float(u.z & 0xffff0000u);
  f[6] = __uint_as_float(u.w << 16); f[7] = __uint_as_float(u.w & 0xffff0000u);
}

__device__ __forceinline__ void tr_cvt(const float* __restrict__ src, int N, int K, bf16_t* __restrict__ dst, int ldd, int rs, int ro, char* ldsc) {
  const int ntn = (N + 63) >> 6, nt = ntn * (K >> 6), hb = HBLK, tid = HTID;
  float* lds = (float*)(ldsc + hb * 65536);
  for (int t0 = blockIdx.x * 6; t0 < nt; t0 += gridDim.x * 6) {
    float4 v[3][4];
#pragma unroll
    for (int u = 0; u < 3; ++u) {
      const int tile = t0 + hb * 3 + u, tk = tile / ntn, tn = tile - tk * ntn, k0 = tk * 64, n0 = tn * 64;
      const bool active = tile < nt;
#pragma unroll
      for (int ps = 0; ps < 4; ++ps) {
        const int i = ps * 16 + (tid >> 4), j = (tid & 15) * 4;
        v[u][ps] = make_float4(0.f, 0.f, 0.f, 0.f);
        if (active && n0 + j < N) v[u][ps] = *(const float4*)(src + (size_t)(k0 + i) * N + n0 + j);
      }
    }
#pragma unroll
    for (int u = 0; u < 3; ++u)
#pragma unroll
      for (int ps = 0; ps < 4; ++ps) {
        const int i = ps * 16 + (tid >> 4), j = (tid & 15) * 4;
        float* d = lds + u * 4160 + i * 65 + j; d[0] = v[u][ps].x; d[1] = v[u][ps].y; d[2] = v[u][ps].z; d[3] = v[u][ps].w;
      }
    __syncthreads();
#pragma unroll
    for (int u = 0; u < 3; ++u) {
      const int tile = t0 + hb * 3 + u, tk = tile / ntn, tn = tile - tk * ntn, k0 = tk * 64, n0 = tn * 64;
      const int j = tid >> 2, kq = tid & 3, n = n0 + j;
      if (tile < nt && n < N) {
        const float* l = lds + u * 4160;
        unsigned w[8];
#pragma unroll
        for (int q = 0; q < 8; ++q) w[q] = pk2(l[(kq * 16 + 2 * q) * 65 + j], l[(kq * 16 + 2 * q + 1) * 65 + j]);
        bf16_t* o = dst + (size_t)((n >> 4) * rs + (n & 15) + ro) * ldd + k0 + kq * 16;
        u32x4 w0, w1; w0.x = w[0]; w0.y = w[1]; w0.z = w[2]; w0.w = w[3]; w1.x = w[4]; w1.y = w[5]; w1.z = w[6]; w1.w = w[7];
        *(u32x4*)o = w0; *(u32x4*)(o + 8) = w1;
      }
    }
    __syncthreads();
  }
}

struct RowRegs { float4 h[4]; u32x2 f[4]; };
__device__ __forceinline__ void rn_load(RowRegs& R, const float* hin32, const bf16_t* hin16, const bf16_t* f, int row, int lane) {
  if (hin32) {
#pragma unroll
    for (int i = 0; i < 4; ++i) R.h[i] = *(const float4*)(hin32 + (size_t)row * 1024 + i * 256 + lane * 4);
  } else {
#pragma unroll
    for (int i = 0; i < 4; ++i) { const u32x2 v = *(const u32x2*)(hin16 + (size_t)row * 1024 + i * 256 + lane * 4);
      R.h[i].x = __uint_as_float(v.x << 16); R.h[i].y = __uint_as_float(v.x & 0xffff0000u); R.h[i].z = __uint_as_float(v.y << 16); R.h[i].w = __uint_as_float(v.y & 0xffff0000u); }
  }
  if (f) {
#pragma unroll
    for (int i = 0; i < 4; ++i) R.f[i] = *(const u32x2*)(f + (size_t)row * 1024 + i * 256 + lane * 4);
  }
}
__device__ __forceinline__ void rn_proc(RowRegs& R, float* hout32, bf16_t* hout16, bool has_f, float scale, const float4 (&gpo)[4], const float4 (&gpr)[4], bf16_t* a, int row, int lane) {
  if (has_f) {
    float fv[4][4]; float ss = 0.f;
#pragma unroll
    for (int i = 0; i < 4; ++i) {
      fv[i][0] = __uint_as_float(R.f[i].x << 16); fv[i][1] = __uint_as_float(R.f[i].x & 0xffff0000u);
      fv[i][2] = __uint_as_float(R.f[i].y << 16); fv[i][3] = __uint_as_float(R.f[i].y & 0xffff0000u);
      ss += fv[i][0] * fv[i][0] + fv[i][1] * fv[i][1] + fv[i][2] * fv[i][2] + fv[i][3] * fv[i][3];
    }
    ss = wave_sum(ss);
    const float r = rsqrtf(ss * (1.f / 1024.f) + 1e-6f) * scale;
#pragma unroll
    for (int i = 0; i < 4; ++i) { const float4 g = gpo[i];
      R.h[i].x += fv[i][0] * r * g.x; R.h[i].y += fv[i][1] * r * g.y; R.h[i].z += fv[i][2] * r * g.z; R.h[i].w += fv[i][3] * r * g.w; }
  }
  if (hout32) {
#pragma unroll
    for (int i = 0; i < 4; ++i) *(float4*)(hout32 + (size_t)row * 1024 + i * 256 + lane * 4) = R.h[i];
  }
  if (hout16) {
#pragma unroll
    for (int i = 0; i < 4; ++i) { u32x2 o; o.x = pk2(R.h[i].x, R.h[i].y); o.y = pk2(R.h[i].z, R.h[i].w); *(u32x2*)(hout16 + (size_t)row * 1024 + i * 256 + lane * 4) = o; }
  }
  if (a) {
    float ss = 0.f;
#pragma unroll
    for (int i = 0; i < 4; ++i) ss += R.h[i].x * R.h[i].x + R.h[i].y * R.h[i].y + R.h[i].z * R.h[i].z + R.h[i].w * R.h[i].w;
    ss = wave_sum(ss);
    const float r = rsqrtf(ss * (1.f / 1024.f) + 1e-6f);
#pragma unroll
    for (int i = 0; i < 4; ++i) { const float4 g = gpr[i];
      u32x2 o; o.x = pk2(R.h[i].x * r * g.x, R.h[i].y * r * g.y); o.y = pk2(R.h[i].z * r * g.z, R.h[i].w * r * g.w);
      *(u32x2*)(a + (size_t)row * 1024 + i * 256 + lane * 4) = o; }
  }
}
__device__ __forceinline__ void resnorm_phase(const float* hin32, const bf16_t* hin16, float* hout32, bf16_t* hout16, const bf16_t* f, float scale, const float* gpost, const float* gpre, bf16_t* a) {
  const int tid = TIDX, lane = tid & 63, stride = gridDim.x * 8;
  int r0 = blockIdx.x * 8 + (tid >> 6), r1 = r0 + stride;
  RowRegs A, B;
  float4 gpo[4], gpr[4];
#pragma unroll
  for (int i = 0; i < 4; ++i) { gpo[i] = f ? *(const float4*)(gpost + i * 256 + lane * 4) : make_float4(0.f, 0.f, 0.f, 0.f); gpr[i] = a ? *(const float4*)(gpre + i * 256 + lane * 4) : make_float4(0.f, 0.f, 0.f, 0.f); }
  if (r0 < M_TOK) rn_load(A, hin32, hin16, f, r0, lane);
  for (;;) {
    if (r0 >= M_TOK) break;
    if (r1 < M_TOK) rn_load(B, hin32, hin16, f, r1, lane);
    rn_proc(A, hout32, hout16, f != nullptr, scale, gpo, gpr, a, r0, lane);
    r0 += 2 * stride;
    if (r1 >= M_TOK) break;
    if (r0 < M_TOK) rn_load(A, hin32, hin16, f, r0, lane);
    rn_proc(B, hout32, hout16, f != nullptr, scale, gpo, gpr, a, r1, lane);
    r1 += 2 * stride;
  }
}

__device__ __forceinline__ void prep_phase(const Params& P, char* ldsc) {
  char* ws = P.ws;
  for (int l = 0; l < 2; ++l) {
    for (int j = 0; j < 2; ++j) {
      const int lj = l * 2 + j;
      bf16_t* wgu = (bf16_t*)(ws + OFF_WGU + lj * SZ_WGU);
      tr_cvt(P.ffn_wg + (size_t)lj * 1024 * DFF, DFF, 1024, wgu, 1024, 32, 0, ldsc);
      tr_cvt(P.ffn_wu + (size_t)lj * 1024 * DFF, DFF, 1024, wgu, 1024, 32, 16, ldsc);
      tr_cvt(P.ffn_wd + (size_t)lj * DFF * 1024, 1024, DFF, (bf16_t*)(ws + OFF_WD + lj * SZ_WD), DFF, 16, 0, ldsc);
      tr_cvt(P.cmp_w1 + (size_t)lj * 2048 * 128, 128, 2048, (bf16_t*)(ws + OFF_CW1 + lj * SZ_CW1), 2048, 16, 0, ldsc);
    }
    tr_cvt(P.w_in + (size_t)l * 1024 * NIN, NIN, 1024, (bf16_t*)(ws + OFF_WIN + l * SZ_WIN), 1024, 16, 0, ldsc);
    tr_cvt(P.w_out + (size_t)l * 1024 * 1024, 1024, 1024, (bf16_t*)(ws + OFF_WOUT + l * SZ_SQ), 1024, 16, 0, ldsc);
    tr_cvt(P.ple_wg + (size_t)l * 1024 * 1024, 1024, 1024, (bf16_t*)(ws + OFF_WPG + l * SZ_SQ), 1024, 16, 0, ldsc);
    tr_cvt(P.ple_wp + (size_t)l * 256 * 1024, 1024, 256, (bf16_t*)(ws + OFF_WPP + l * SZ_WPP), 256, 16, 0, ldsc);
    for (int g = 0; g < 4; ++g) {
      tr_cvt(P.lru_wa + (size_t)(l * 4 + g) * 4096, 64, 64, (bf16_t*)(ws + OFF_WAT) + (l * 4 + g) * 4096, 64, 16, 0, ldsc);
      tr_cvt(P.lru_wx + (size_t)(l * 4 + g) * 4096, 64, 64, (bf16_t*)(ws + OFF_WXT) + (l * 4 + g) * 4096, 64, 16, 0, ldsc);
    }
  }
  const int tid = TIDX, gtid = blockIdx.x * 512 + tid, gn = gridDim.x * 512;
  for (int i = gtid; i < 2 * (LDZ - NIN) * 1024 / 8; i += gn) {
    const int l = i / ((LDZ - NIN) * 128), r = i - l * ((LDZ - NIN) * 128);
    *(f32x4*)((bf16_t*)(ws + OFF_WIN + l * SZ_WIN) + (size_t)NIN * 1024 + (size_t)r * 8) = zero4();
  }
  for (int i = gtid; i < 2 * 4 * 128 * 128; i += gn) { const int t = (i >> 7) & 127, s2 = i & 127; ((bf16_t*)(ws + OFF_SGUW))[i] = (s2 <= t) ? f2bf(P.sgu_w[i]) : (bf16_t)0; }
  for (int i = gtid; i < 2 * M_TOK * 256 / 4; i += gn) { const float4 v = ((const float4*)P.p)[i]; uint2 o; o.x = pk2(v.x, v.y); o.y = pk2(v.z, v.w); ((uint2*)(ws + OFF_PBF))[i] = o; }
  {
    float* lds = (float*)(ldsc + HBLK * 65536);
    for (int u = blockIdx.x; u < 4; u += gridDim.x) {
      const int t2 = HTID, kq = t2 >> 5, jq = t2 & 31;
      const float* w1 = P.cmp_w1 + (size_t)u * 2048 * 128; const float* pos = P.cmp_pos + (size_t)u * 2048;
      float4 sacc = make_float4(0.f, 0.f, 0.f, 0.f);
      for (int k = kq * 256; k < kq * 256 + 256; ++k) { const float pv = pos[k]; const float4 w = *(const float4*)(w1 + (size_t)k * 128 + jq * 4); sacc.x += pv * w.x; sacc.y += pv * w.y; sacc.z += pv * w.z; sacc.w += pv * w.w; }
      __syncthreads();
      lds[kq * 128 + jq * 4 + 0] = sacc.x; lds[kq * 128 + jq * 4 + 1] = sacc.y; lds[kq * 128 + jq * 4 + 2] = sacc.z; lds[kq * 128 + jq * 4 + 3] = sacc.w;
      __syncthreads();
      if (t2 < 128) { float t = P.cmp_b1[u * 128 + t2]; for (int q = 0; q < 8; ++q) t += lds[q * 128 + t2]; ((float*)(ws + OFF_CB1))[u * 128 + t2] = t; }
      __syncthreads();
    }
  }
  resnorm_phase(P.x, nullptr, nullptr, nullptr, nullptr, 0.f, nullptr, P.norm_g, (bf16_t*)(ws + OFF_A));
}

constexpr int G8_HT = 128 * 64;
__device__ __forceinline__ int g8_lds_byte(int r, int c) { const int st = (r >> 4) * 2 + (c >> 5), rr = r & 15, cc = c & 31, ob = rr * 64 + cc * 2; return st * 1024 + (ob ^ (((ob >> 9) & 1) << 5)); }
__device__ __forceinline__ void g8_stage_rc(int b, int& R, int& C) { const int st = b / 1024, sb = b % 1024, swz = sb ^ (((sb >> 9) & 1) << 5); R = (st >> 1) * 16 + swz / 64; C = (st & 1) * 32 + (swz % 64) / 2; }

template <bool ISSUE_ONLY, bool PRE_ISSUED>
__device__ __forceinline__ void gemm_core(f32x4 (&acc)[2][2][4][2], const bf16_t* __restrict__ A, int lda, const bf16_t* __restrict__ Bt, int ldb, int K, char* ldsc) {
  bf16_t* shm = (bf16_t*)ldsc;
  const int tid = TIDX, wid = tid >> 6, lane = tid & 63, wr = wid >> 2, wc = wid & 3, fr = lane & 15, fq = lane >> 4;
  int sr0, sc0;
  g8_stage_rc(tid * 16, sr0, sc0);
  const bf16_t* gA0 = A + (size_t)sr0 * lda + sc0;
  const bf16_t* gB0 = Bt + (size_t)sr0 * ldb + sc0;
  const size_t a64 = (size_t)64 * lda, b64 = (size_t)64 * ldb;
  const int lane_off = (fr * 64 + fq * 16) ^ ((((fr * 64 + fq * 16) >> 9) & 1) << 5);
  const char* ldA = ldsc + wr * 8192 + lane_off;
  const char* ldB = ldsc + 65536 + wc * 4096 + lane_off;
#define SA(b, h) (shm + ((b) * 2 + (h)) * G8_HT)
#define SB(b, h) (shm + (4 + (b) * 2 + (h)) * G8_HT)
#define STAGE_A(P, h, kt) { const bf16_t* g_ = gA0 + (size_t)(h) * 2 * a64 + (kt) * 64; glds16(g_, (char*)(P) + tid * 16); glds16(g_ + a64, (char*)(P) + tid * 16 + 8192); }
#define STAGE_B(P, h, kt) { const bf16_t* g_ = gB0 + (size_t)(h) * 2 * b64 + (kt) * 64; glds16(g_, (char*)(P) + tid * 16); glds16(g_ + b64, (char*)(P) + tid * 16 + 8192); }
#define LDA(dst, b, h) _Pragma("unroll") for (int m = 0; m < 4; ++m) _Pragma("unroll") for (int k = 0; k < 2; ++k) \
    dst[m][k] = *reinterpret_cast<const bf16x8*>(ldA + ((b) * 2 + (h)) * 16384 + (m * 2 + k) * 1024)
#define LDB(dst, b, h) _Pragma("unroll") for (int n = 0; n < 2; ++n) _Pragma("unroll") for (int k = 0; k < 2; ++k) \
    dst[n][k] = *reinterpret_cast<const bf16x8*>(ldB + ((b) * 2 + (h)) * 16384 + (n * 2 + k) * 1024)
#define MMA(ai, bj, At_, Bt_) do { __builtin_amdgcn_s_setprio(1); \
    _Pragma("unroll") for (int m = 0; m < 4; ++m) _Pragma("unroll") for (int n = 0; n < 2; ++n) _Pragma("unroll") for (int k = 0; k < 2; ++k) \
      acc[ai][bj][m][n] = mfma16(Bt_[n][k], At_[m][k], acc[ai][bj][m][n]); \
    __builtin_amdgcn_s_setprio(0); } while (0)
#define WAIT_V(n) asm volatile("s_waitcnt vmcnt(" #n ")" ::: "memory")
#define WAIT_L(n) asm volatile("s_waitcnt lgkmcnt(" #n ")" ::: "memory")
#define BAR __builtin_amdgcn_s_barrier()
#define SCHED __builtin_amdgcn_sched_barrier(0)
  bf16x8 At[4][2], B0[2][2], B1[2][2];
  const int nt = K >> 6;
  if (!PRE_ISSUED) {
    STAGE_B(SB(0, 0), 0, 0); STAGE_A(SA(0, 0), 0, 0);
    STAGE_B(SB(0, 1), 1, 0); STAGE_A(SA(0, 1), 1, 0);
  }
  if (ISSUE_ONLY) return;
  if (wr == 1) BAR;
  if (PRE_ISSUED) { WAIT_V(0); } else { WAIT_V(4); }
  BAR;
  STAGE_B(SB(1, 0), 0, 1); STAGE_A(SA(1, 0), 0, 1); STAGE_B(SB(1, 1), 1, 1);
  WAIT_V(6); BAR;
#pragma nounroll
  for (int t = 0; t < nt - 2; t += 2) {
    LDB(B0, 0, 0); SCHED; LDA(At, 0, 0); STAGE_A(SA(1, 1), 1, t + 1);
    WAIT_L(8); BAR; WAIT_L(0); MMA(0, 0, At, B0); BAR; SCHED;
    LDB(B1, 0, 1); STAGE_B(SB(0, 0), 0, t + 2);
    BAR; WAIT_L(0); MMA(0, 1, At, B1); BAR;
    LDA(At, 0, 1); STAGE_A(SA(0, 0), 0, t + 2);
    BAR; WAIT_L(0); MMA(1, 0, At, B0); BAR; SCHED;
    STAGE_B(SB(0, 1), 1, t + 2);
    WAIT_V(6); BAR; MMA(1, 1, At, B1); BAR;
    LDB(B0, 1, 0); SCHED; LDA(At, 1, 0); STAGE_A(SA(0, 1), 1, t + 2);
    WAIT_L(8); BAR; WAIT_L(0); MMA(0, 0, At, B0); BAR; SCHED;
    LDB(B1, 1, 1); STAGE_B(SB(1, 0), 0, t + 3);
    BAR; WAIT_L(0); MMA(0, 1, At, B1); BAR;
    LDA(At, 1, 1); STAGE_A(SA(1, 0), 0, t + 3);
    BAR; WAIT_L(0); MMA(1, 0, At, B0); BAR; SCHED;
    STAGE_B(SB(1, 1), 1, t + 3);
    WAIT_V(6); BAR; MMA(1, 1, At, B1); BAR;
  }
  { LDB(B0, 0, 0); LDA(At, 0, 0); STAGE_A(SA(1, 1), 1, nt - 1);
    BAR; WAIT_L(0); MMA(0, 0, At, B0); BAR;
    LDB(B1, 0, 1); BAR; WAIT_L(0); MMA(0, 1, At, B1); BAR;
    LDA(At, 0, 1); WAIT_V(4); BAR; WAIT_L(0); MMA(1, 0, At, B0); MMA(1, 1, At, B1); BAR; }
  { LDB(B0, 1, 0); LDA(At, 1, 0); WAIT_V(2); BAR; WAIT_L(0); MMA(0, 0, At, B0); BAR;
    LDB(B1, 1, 1); WAIT_V(0); BAR; WAIT_L(0); MMA(0, 1, At, B1); BAR;
    LDA(At, 1, 1); BAR; WAIT_L(0); MMA(1, 0, At, B0); MMA(1, 1, At, B1); BAR; }
  if (wr == 0) BAR;
  BAR;
#undef SA
#undef SB
#undef STAGE_A
#undef STAGE_B
#undef LDA
#undef LDB
#undef MMA
#undef WAIT_V
#undef WAIT_L
#undef BAR
#undef SCHED
}

struct TileIt {
  int TN, npc, npatch, slot, nslot, pid, s, tm, tn;
  __device__ __forceinline__ void init(int TN_) { TN = TN_; npc = (TN + 1) >> 1; npatch = 8 * npc; slot = blockIdx.x >> 3; nslot = gridDim.x >> 3; pid = blockIdx.x & 7; s = slot - nslot; }
  __device__ __forceinline__ bool next() {
    for (;;) {
      s += nslot;
      if (s >= 32) { s = slot; pid += 8; }
      if (pid >= npatch) return false;
      const int pr = pid / npc, pc = pid - pr * npc;
      tm = pr * 16 + (s & 15); tn = pc * 2 + (s >> 4);
      if (tn < TN) return true;
    }
  }
};

#define GEMM_LANE const int tid_ = TIDX, lane_ = tid_ & 63, wid_ = tid_ >> 6, wr = wid_ >> 2, wc = wid_ & 3, fr = lane_ & 15, fq = lane_ >> 4
#define GEMM_EPI_LOOP _Pragma("unroll") for (int ai = 0; ai < 2; ++ai) _Pragma("unroll") for (int m = 0; m < 4; ++m) _Pragma("unroll") for (int bj = 0; bj < 2; ++bj)

template <class Epi> __device__ __forceinline__ void gemm_phase(const bf16_t* A, int lda, const bf16_t* Bt, int ldb, int K, int TN, char* lds, Epi&& epi) {
  TileIt it; it.init(TN);
  bool have = it.next();
  f32x4 acc[2][2][4][2];
  if (have) gemm_core<true, false>(acc, A + (size_t)it.tm * 256 * lda, lda, Bt + (size_t)it.tn * 256 * ldb, ldb, K, lds);
  while (have) {
    const int tm = it.tm, tn = it.tn;
#pragma unroll
    for (int i0 = 0; i0 < 2; ++i0)
#pragma unroll
      for (int i1 = 0; i1 < 2; ++i1)
#pragma unroll
        for (int i2 = 0; i2 < 4; ++i2)
#pragma unroll
          for (int i3 = 0; i3 < 2; ++i3) acc[i0][i1][i2][i3] = zero4();
    gemm_core<false, true>(acc, A + (size_t)tm * 256 * lda, lda, Bt + (size_t)tn * 256 * ldb, ldb, K, lds);
    have = it.next();
    if (have) { f32x4 dummy[2][2][4][2]; gemm_core<true, false>(dummy, A + (size_t)it.tm * 256 * lda, lda, Bt + (size_t)it.tn * 256 * ldb, ldb, K, lds); }
    epi(acc, tm, tn);
  }
  asm volatile("s_waitcnt vmcnt(0)" ::: "memory");
}

__device__ __forceinline__ void gemm_up_phase(const bf16_t* a, const bf16_t* wgu, bf16_t* act, char* lds) {
  gemm_phase(a, 1024, wgu, 1024, 1024, NGU / 256, lds, [&](f32x4 (&acc)[2][2][4][2], int tm, int tn) {
    GEMM_LANE;
    GEMM_EPI_LOOP {
      const int row = tm * 256 + ai * 128 + wr * 64 + m * 16 + fr;
      const int col = tn * 128 + bj * 64 + wc * 16 + 4 * fq;
      const f32x4 g = acc[ai][bj][m][0], u = acc[ai][bj][m][1];
      u32x2 o; o.x = pk2(silu_f(g[0]) * u[0], silu_f(g[1]) * u[1]); o.y = pk2(silu_f(g[2]) * u[2], silu_f(g[3]) * u[3]);
      *(u32x2*)(act + (size_t)row * DFF + col) = o;
    }
  });
}

__device__ __forceinline__ void gemm_bf16_phase(const bf16_t* A, int lda, const bf16_t* Bt, int K, int TN, bf16_t* out, int ldo, char* lds) {
  gemm_phase(A, lda, Bt, K, K, TN, lds, [&](f32x4 (&acc)[2][2][4][2], int tm, int tn) {
    GEMM_LANE;
    GEMM_EPI_LOOP {
      const int row = tm * 256 + ai * 128 + wr * 64 + m * 16 + fr;
#pragma unroll
      for (int n = 0; n < 2; ++n) {
        u32x2 o; o.x = pk2(acc[ai][bj][m][n][0], acc[ai][bj][m][n][1]); o.y = pk2(acc[ai][bj][m][n][2], acc[ai][bj][m][n][3]);
        *(u32x2*)(out + (size_t)row * ldo + tn * 256 + bj * 128 + wc * 32 + n * 16 + 4 * fq) = o;
      }
    }
  });
}

__device__ __forceinline__ void gemm_ple_phase(const bf16_t* a, const bf16_t* wpg, const bf16_t* pp, bf16_t* out, char* lds) {
  gemm_phase(a, 1024, wpg, 1024, 1024, 4, lds, [&](f32x4 (&acc)[2][2][4][2], int tm, int tn) {
    GEMM_LANE;
    GEMM_EPI_LOOP {
      const int row = tm * 256 + ai * 128 + wr * 64 + m * 16 + fr;
#pragma unroll
      for (int n = 0; n < 2; ++n) {
        const int col = tn * 256 + bj * 128 + wc * 32 + n * 16 + 4 * fq;
        const u32x2 pv = *(const u32x2*)(pp + (size_t)row * 1024 + col);
        const f32x4 av = acc[ai][bj][m][n];
        u32x2 o;
        o.x = pk2(sigm(av[0]) * __uint_as_float(pv.x << 16), sigm(av[1]) * __uint_as_float(pv.x & 0xffff0000u));
        o.y = pk2(sigm(av[2]) * __uint_as_float(pv.y << 16), sigm(av[3]) * __uint_as_float(pv.y & 0xffff0000u));
        *(u32x2*)(out + (size_t)row * 1024 + col) = o;
      }
    }
  });
}

__device__ __forceinline__ void mixA_item(const Params& P, int layer, int idx, const bf16_t* z, bf16_t* y, char* lds) {
  const int g = idx & 3, bc = idx >> 2, tok0 = bc * 128;
  const int tid = HTID, lane = tid & 63, w = tid >> 6, fr = lane & 15, fq = lane >> 4;
  bf16_t* vT = (bf16_t*)lds;
  const float* ng = P.sgu_ng + layer * 256;
  {
    const int s = tid >> 1, half = tid & 1;
    const bf16_t* zr = z + (size_t)(tok0 + s) * LDZ + ZC_AV;
    float ss = 0.f;
#pragma unroll 4
    for (int i = 0; i < 16; ++i) { float v[8]; unpack8(*(const u32x4*)(zr + half * 128 + i * 8), v);
#pragma unroll
      for (int e = 0; e < 8; ++e) { const float t = gelu_t(v[e]); ss += t * t; } }
    ss += __shfl_xor(ss, 1);
    const float rs = rsqrtf(ss * (1.f / 256.f) + 1e-6f);
#pragma unroll
    for (int i = 0; i < 4; ++i) { float v[8]; unpack8(*(const u32x4*)(zr + g * 64 + half * 32 + i * 8), v);
#pragma unroll
      for (int e = 0; e < 8; ++e) { const int d = half * 32 + i * 8 + e; vT[d * 136 + s] = f2bf(gelu_t(v[e]) * rs * ng[g * 64 + d]); } }
  }
  __syncthreads();
  const bf16_t* W = (const bf16_t*)(P.ws + OFF_SGUW) + (size_t)((layer * 4 + g) * 128) * 128;
  f32x4 acc[2][4] = {};
  for (int ks = 0; ks <= w; ++ks) {
    bf16x8 wf[2], vf[4];
#pragma unroll
    for (int tm = 0; tm < 2; ++tm) wf[tm] = *(const bf16x8*)(W + (size_t)(32 * w + tm * 16 + fr) * 128 + ks * 32 + 8 * fq);
#pragma unroll
    for (int dn = 0; dn < 4; ++dn) vf[dn] = *(const bf16x8*)(vT + (dn * 16 + fr) * 136 + ks * 32 + 8 * fq);
#pragma unroll
    for (int tm = 0; tm < 2; ++tm)
#pragma unroll
      for (int dn = 0; dn < 4; ++dn) acc[tm][dn] = mfma16(vf[dn], wf[tm], acc[tm][dn]);
  }
#pragma unroll
  for (int tm = 0; tm < 2; ++tm) {
    const int t = 32 * w + tm * 16 + fr;
    const float bias = P.sgu_b[(layer * 4 + g) * 128 + t];
#pragma unroll
    for (int dn = 0; dn < 4; ++dn) {
      const int d = dn * 16 + 4 * fq;
      const uint2 uu = *(const uint2*)(z + (size_t)(tok0 + t) * LDZ + ZC_AU + g * 64 + d);
      const float u0 = gelu_t(__uint_as_float(uu.x << 16)), u1 = gelu_t(__uint_as_float(uu.x & 0xffff0000u)),
                  u2 = gelu_t(__uint_as_float(uu.y << 16)), u3 = gelu_t(__uint_as_float(uu.y & 0xffff0000u));
      uint2 o; o.x = pk2(u0 * (acc[tm][dn][0] + bias), u1 * (acc[tm][dn][1] + bias)); o.y = pk2(u2 * (acc[tm][dn][2] + bias), u3 * (acc[tm][dn][3] + bias));
      *(uint2*)(y + (size_t)(tok0 + t) * 1024 + g * 64 + d) = o;
    }
  }
  __syncthreads();
}

__device__ __forceinline__ void mixB1_item(const Params& P, int layer, int idx, const bf16_t* z, float* hsl, float* Pc, float* carryP, float* carryH, char* lds) {
  const int c = idx & 63, g = (idx >> 6) & 3, b = idx >> 8;
  const int tid = HTID, lane = tid & 63, w = tid >> 6, fr = lane & 15, fq = lane >> 4;
  bf16_t* xcb = (bf16_t*)lds;
  float* xcf = (float*)(lds + 9216);
  float* aA = (float*)(lds + 9216 + 16384);
  float* bB = (float*)(lds + 9216 + 32768);
  float* sm = (float*)(lds + 9216 + 49152);
  const size_t tokb = (size_t)b * SEQ;
  {
    const int t = tid >> 2, q = tid & 3;
    float accv[16];
#pragma unroll
    for (int i = 0; i < 16; ++i) accv[i] = P.conv_b[layer * 256 + g * 64 + q * 16 + i];
#pragma unroll
    for (int k = 0; k < 4; ++k) {
      const int pos = c * 64 + t - 3 + k;
      if (pos >= 0) {
        const bf16_t* zr = z + (tokb + pos) * LDZ + ZC_BX + g * 64 + q * 16;
        float v[16]; unpack8(*(const u32x4*)zr, v); unpack8(*(const u32x4*)(zr + 8), v + 8);
        const float* cw = P.conv_w + (size_t)(layer * 4 + k) * 256 + g * 64 + q * 16;
#pragma unroll
        for (int i = 0; i < 16; ++i) accv[i] += v[i] * cw[i];
      }
    }
#pragma unroll
    for (int i = 0; i < 16; ++i) { xcf[t * 64 + q * 16 + i] = accv[i]; xcb[t * 72 + q * 16 + i] = f2bf(accv[i]); }
  }
  __syncthreads();
  {
    const bf16_t* wa = (const bf16_t*)(P.ws + OFF_WAT) + (layer * 4 + g) * 4096;
    const bf16_t* wx = (const bf16_t*)(P.ws + OFF_WXT) + (layer * 4 + g) * 4096;
    f32x4 ar[4] = {}, ai[4] = {};
#pragma unroll
    for (int ks = 0; ks < 2; ++ks) {
      const bf16x8 xf = *(const bf16x8*)(xcb + (16 * w + fr) * 72 + ks * 32 + 8 * fq);
#pragma unroll
      for (int jn = 0; jn < 4; ++jn) {
        const bf16x8 fa = *(const bf16x8*)(wa + (jn * 16 + fr) * 64 + ks * 32 + 8 * fq);
        const bf16x8 fx = *(const bf16x8*)(wx + (jn * 16 + fr) * 64 + ks * 32 + 8 * fq);
        ar[jn] = mfma16(fa, xf, ar[jn]); ai[jn] = mfma16(fx, xf, ai[jn]);
      }
    }
    const int t = 16 * w + fr;
#pragma unroll
    for (int jn = 0; jn < 4; ++jn)
#pragma unroll
      for (int e = 0; e < 4; ++e) {
        const int j = jn * 16 + 4 * fq + e, ch = layer * 256 + g * 64 + j;
        const float r = sigm(ar[jn][e] + P.lru_ba[ch]), ig = sigm(ai[jn][e] + P.lru_bx[ch]);
        const float lam = P.lru_lam[ch];
        const float xe = __expf(-lam);
        float m8; asm volatile("v_mov_b32 %0, 0xc1000000" : "=v"(m8));
        const float la = m8 * r * (xe * (1.f - xe * (0.5f - xe * (1.f / 3.f))));
        const float av = __expf(la);
        const float y2 = 2.f * la;
        const float om = -y2 * (1.f + y2 * (0.5f + y2 * ((1.f / 6.f) + y2 * ((1.f / 24.f) + y2 * ((1.f / 120.f) + y2 * (1.f / 720.f))))));
        const float bv = sqrtf(om) * (ig * xcf[t * 64 + j]);
        aA[t * 64 + j] = av; bB[t * 64 + j] = bv;
      }
  }
  __syncthreads();
  {
    const int q = tid >> 6, j = tid & 63;
    float Pq = 1.f, hq = 0.f;
#pragma unroll
    for (int i = 0; i < 16; ++i) { const int t = q * 16 + i; const float av = aA[t * 64 + j], bv = bB[t * 64 + j]; hq = av * hq + bv; Pq *= av; aA[t * 64 + j] = Pq; bB[t * 64 + j] = hq; }
    sm[q * 64 + j] = Pq; sm[256 + q * 64 + j] = hq;
    __syncthreads();
    float Pin = 1.f, Hin = 0.f;
    for (int qq = 0; qq < q; ++qq) { const float pp = sm[qq * 64 + j], hh = sm[256 + qq * 64 + j]; Hin = pp * Hin + hh; Pin *= pp; }
    float hl = 0.f, pl = 1.f;
#pragma unroll
    for (int i = 0; i < 16; ++i) { const int t = q * 16 + i; hl = bB[t * 64 + j] + aA[t * 64 + j] * Hin; pl = aA[t * 64 + j] * Pin;
      const size_t o = (tokb + c * 64 + t) * 256 + g * 64 + j; hsl[o] = hl; Pc[o] = pl; }
    if (q == 3) { const int o = ((b * 4 + g) * 64 + c) * 64 + j; carryP[o] = pl; carryH[o] = hl; }
  }
  __syncthreads();
}

__device__ __forceinline__ void mixB2_item(int idx, const bf16_t* z, const float* hsl, const float* Pc, const float* carryP, const float* carryH, bf16_t* y) {
  const int c = idx & 63, g = (idx >> 6) & 3, b = idx >> 8;
  const int q = HTID >> 6, j = HTID & 63;
  const float* cp = carryP + (size_t)((b * 4 + g) * 64) * 64 + j;
  const float* chh = carryH + (size_t)((b * 4 + g) * 64) * 64 + j;
  float H = 0.f;
  for (int c0 = 0; c0 < c; c0 += 8) {
    float pv[8], hv[8];
#pragma unroll
    for (int i = 0; i < 8; ++i) { const bool ok = c0 + i < c; pv[i] = ok ? cp[(c0 + i) * 64] : 1.f; hv[i] = ok ? chh[(c0 + i) * 64] : 0.f; }
#pragma unroll
    for (int i = 0; i < 8; ++i) H = pv[i] * H + hv[i];
  }
  const size_t tokb = (size_t)b * SEQ + c * 64 + q * 16;
#pragma unroll 4
  for (int i = 0; i < 16; ++i) {
    const size_t o = (tokb + i) * 256 + g * 64 + j;
    const float h = hsl[o] + Pc[o] * H;
    const float gt = bf2f(z[(tokb + i) * LDZ + ZC_BG + g * 64 + j]);
    y[(tokb + i) * 1024 + 256 + g * 64 + j] = f2bf(h * gelu_t(gt));
  }
}

__device__ __forceinline__ void compress_item(const Params& P, int layer, int idx, const bf16_t* z, bf16_t* kcv, char* lds) {
  const int nb = idx & 15, g = (idx >> 4) & 1, b = (idx >> 5) & 7, kv = idx >> 8;
  const int tid = HTID, lane = tid & 63, w = tid >> 6, fr = lane & 15, fq = lane >> 4;
  const int n0 = nb * 16, col = (kv ? ZC_VC : ZC_KC) + g * 64;
  const bf16_t* w1t = (const bf16_t*)(P.ws + OFF_CW1 + (size_t)(layer * 2 + kv) * SZ_CW1);
  float* part = (float*)lds;
  float* hid = (float*)(lds + 34816);
  f32x4 acc[8];
#pragma unroll
  for (int jf = 0; jf < 8; ++jf) acc[jf] = zero4();
  int nn = n0 + fr; if (nn > 254) nn = 254;
  const bf16_t* zb = z + ((size_t)b * SEQ + 16 * nn) * LDZ + col + 8 * fq;
  const bf16_t* wb = w1t + (size_t)fr * 2048 + 8 * fq;
#pragma unroll 4
  for (int kk = 0; kk < 16; ++kk) {
    const int ks = 16 * w + kk, l = ks >> 1, d0 = (ks & 1) * 32;
    const bf16x8 xf = *(const bf16x8*)(zb + (size_t)l * LDZ + d0);
#pragma unroll
    for (int jf = 0; jf < 8; ++jf) { const bf16x8 wf = *(const bf16x8*)(wb + (size_t)jf * 16 * 2048 + ks * 32); acc[jf] = mfma16(wf, xf, acc[jf]); }
  }
#pragma unroll
  for (int jf = 0; jf < 8; ++jf)
#pragma unroll
    for (int e = 0; e < 4; ++e) part[(w * 16 + fr) * 132 + jf * 16 + 4 * fq + e] = acc[jf][e];
  __syncthreads();
  const float* cb1 = (const float*)(P.ws + OFF_CB1) + (layer * 2 + kv) * 128;
  {
    const int n = tid >> 4, j0 = (tid & 15) * 8;
#pragma unroll
    for (int e = 0; e < 8; ++e) { const int j = j0 + e; const float v = ((part[(0 * 16 + n) * 132 + j] + part[(1 * 16 + n) * 132 + j]) + part[(2 * 16 + n) * 132 + j]) + part[(3 * 16 + n) * 132 + j];
      hid[n * 129 + j] = gelu_t(v + cb1[j]); }
  }
  __syncthreads();
  {
    const int n = tid >> 4, d0 = (tid & 15) * 4;
    const float* w2 = P.cmp_w2 + (size_t)(layer * 2 + kv) * 128 * 64 + d0;
    const float4 bb = *(const float4*)(P.cmp_b2 + (layer * 2 + kv) * 64 + d0);
    float o0 = bb.x, o1 = bb.y, o2 = bb.z, o3 = bb.w;
#pragma unroll 8
    for (int j = 0; j < 128; ++j) { const float hv = hid[n * 129 + j]; const float4 wa = *(const float4*)(w2 + j * 64); o0 += hv * wa.x; o1 += hv * wa.y; o2 += hv * wa.z; o3 += hv * wa.w; }
    u32x2 ov; ov.x = pk2(o0, o1); ov.y = pk2(o2, o3);
    if ((n0 + n) >= 255) { ov.x = 0u; ov.y = 0u; }
    *(u32x2*)(kcv + ((size_t)((kv * 8 + b) * 2 + g) * 256 + n0 + n) * 64 + d0) = ov;
  }
  __syncthreads();
}

constexpr int NSA_KT = 0, NSA_VT = 16384, NSA_T = 33792, NSA_TW = NSA_T + 4 * 4160 * 4, NSA_IMP = NSA_TW + 4 * 640 * 4, NSA_WU = NSA_IMP + 2 * 16640;
constexpr int LDS_ST = 147456;
constexpr float LOG2E = 1.4426950408889634f;

__device__ __forceinline__ void nsa_tables(const Params& P, int g, char* lds) {
  float* T = (float*)(lds + NSA_T);
  float* TW = (float*)(lds + NSA_TW);
  const int tid = TIDX;
  for (int i = tid; i < 4160; i += 512) {
    const int n = i - 64;
    int bk = n;
    if (n >= 16) bk = 16 + (n >= 21) + (n >= 27) + (n >= 35) + (n >= 46) + (n >= 59) + (n >= 77) + (n >= 99) + (n >= 128) + (n >= 166) + (n >= 216) + (n >= 280) + (n >= 363) + (n >= 470) + (n >= 609) + (n >= 790);
#pragma unroll
    for (int r = 0; r < 4; ++r) {
      const float v = n >= 0 ? P.rel_bias[bk * 8 + g * 4 + r] * LOG2E : -__builtin_inff();
      T[r * 4160 + i] = v;
      if (i < 640) TW[r * 640 + i] = (n < 512) ? v : -__builtin_inff();
    }
  }
  __syncthreads();
}

struct KVRegs { u32x4 k0, v0; };
__device__ __forceinline__ void kv_gload(KVRegs& r, const bf16_t* kb, const bf16_t* vb, size_t stride) {
  const int tid = TIDX, row = tid >> 3, cq = tid & 7;
  r.k0 = *(const u32x4*)(kb + row * stride + cq * 8); r.v0 = *(const u32x4*)(vb + row * stride + cq * 8);
}
__device__ __forceinline__ void kv_lwrite(const KVRegs& r, char* lds, int buf) {
  const int tid = TIDX, row = tid >> 3, cq = tid & 7;
  char* kt = lds + NSA_KT + buf * 8192 + row * 128;
  *(u32x4*)(kt + ((cq ^ (row & 7)) << 4)) = r.k0;
  bf16_t* vt = (bf16_t*)(lds + NSA_VT + buf * 8704) + (cq * 8) * 68 + row;
#pragma unroll
  for (int i = 0; i < 4; ++i) { vt[(2 * i) * 68] = (bf16_t)(r.v0[i] & 0xffffu); vt[(2 * i + 1) * 68] = (bf16_t)(r.v0[i] >> 16); }
}

template <int MODE>
__device__ __forceinline__ void nsa_compute(int cur, int buf, int t, int hl, u64 mymask, const bf16x8 (&Qf)[2][2], f32x4 (&O)[4][2], float (&m)[2], float (&l)[2],
                                            const float (&inv)[2], float* impw, char* lds) {
  const int lane = TIDX & 63, fr = lane & 15, fq = lane >> 4;
  const char* kt = lds + NSA_KT + buf * 8192;
  const bf16_t* vt = (const bf16_t*)(lds + NSA_VT + buf * 8704);
  const bool selok = (MODE == 2) ? (((mymask >> cur) & 1ull) != 0ull) : true;
  const float* tb = (MODE == 3) ? (const float*)(lds + NSA_TW) + hl * 640 : (const float*)(lds + NSA_T) + hl * 4160;
  constexpr int TS = (MODE == 3) ? 640 : 4160;
  const int base = (MODE <= 1) ? (t - 31 - 16 * (cur * 64 + 4 * fq) + 64) : (t - cur * 64 - 4 * fq + 64);
#pragma unroll
  for (int s2 = 0; s2 < 2; ++s2) {
    f32x4 S[2][2];
    S[0][0] = zero4(); S[0][1] = zero4(); S[1][0] = zero4(); S[1][1] = zero4();
#pragma unroll
    for (int ks = 0; ks < 2; ++ks)
#pragma unroll
      for (int kk = 0; kk < 2; ++kk) {
        const bf16x8 kf = *(const bf16x8*)(kt + (32 * s2 + 16 * kk + fr) * 128 + (((ks * 4 + fq) ^ (fr & 7)) << 4));
#pragma unroll
        for (int r = 0; r < 2; ++r) S[kk][r] = mfma16(kf, Qf[r][ks], S[kk][r]);
      }
    bf16x8 Pf[2];
    float g1s[2] = {0.f, 0.f}, p3s[2] = {0.f, 0.f};
#pragma unroll
    for (int r = 0; r < 2; ++r) {
      float sv[2][4];
#pragma unroll
      for (int kk = 0; kk < 2; ++kk)
#pragma unroll
        for (int e = 0; e < 4; ++e) {
          const int off = 32 * s2 + 16 * kk + e;
          int idx;
          if (MODE <= 1) { idx = base - 16 * off; idx = idx > 0 ? idx : 0; } else idx = base - off;
          sv[kk][e] = S[kk][r][e] * (0.125f * LOG2E) + tb[r * TS + idx];
        }
      float pv[2][4];
      if (MODE == 1) {
#pragma unroll
        for (int kk = 0; kk < 2; ++kk)
#pragma unroll
          for (int e = 0; e < 4; ++e) pv[kk][e] = __builtin_amdgcn_exp2f(sv[kk][e] - m[r]) * inv[r];
#pragma unroll
        for (int kk = 0; kk < 2; ++kk) { g1s[kk] += pv[kk][0] + pv[kk][1] + pv[kk][2] + 0.5f * pv[kk][3]; p3s[kk] += 0.5f * pv[kk][3]; }
      } else {
        float mx = fmaxf(fmaxf(fmaxf(sv[0][0], sv[0][1]), fmaxf(sv[0][2], sv[0][3])), fmaxf(fmaxf(sv[1][0], sv[1][1]), fmaxf(sv[1][2], sv[1][3])));
        if (MODE == 2) mx = selok ? mx : -__builtin_inff();
        if (__any(mx > m[r] + 8.0f)) {
          mx = fmaxf(mx, __shfl_xor(mx, 16)); mx = fmaxf(mx, __shfl_xor(mx, 32));
          const float mn = fmaxf(m[r], mx), al = __builtin_amdgcn_exp2f(m[r] - mn);
          m[r] = mn; l[r] *= al;
          if (MODE != 0) {
#pragma unroll
            for (int df = 0; df < 4; ++df) O[df][r] *= al;
          }
        }
        const float me = (MODE == 2) ? (selok ? m[r] : __builtin_inff()) : m[r];
        float ps = 0.f;
#pragma unroll
        for (int kk = 0; kk < 2; ++kk)
#pragma unroll
          for (int e = 0; e < 4; ++e) { pv[kk][e] = __builtin_amdgcn_exp2f(sv[kk][e] - me); ps += pv[kk][e]; }
        l[r] += ps;
      }
      if (MODE != 0) {
        const unsigned w0 = pk2(pv[0][0], pv[0][1]), w1 = pk2(pv[0][2], pv[0][3]), w2 = pk2(pv[1][0], pv[1][1]), w3 = pk2(pv[1][2], pv[1][3]);
        u32x4 pw; pw.x = w0; pw.y = w1; pw.z = w2; pw.w = w3;
        Pf[r] = __builtin_bit_cast(bf16x8, pw);
      }
    }
    if (MODE != 0) {
#pragma unroll
      for (int df = 0; df < 4; ++df) {
        const bf16x4 va = *(const bf16x4*)(vt + (df * 16 + fr) * 68 + 32 * s2 + 4 * fq);
        const bf16x4 vb = *(const bf16x4*)(vt + (df * 16 + fr) * 68 + 32 * s2 + 16 + 4 * fq);
        bf16x8 vf; vf[0] = va[0]; vf[1] = va[1]; vf[2] = va[2]; vf[3] = va[3]; vf[4] = vb[0]; vf[5] = vb[1]; vf[6] = vb[2]; vf[7] = vb[3];
#pragma unroll
        for (int r = 0; r < 2; ++r) O[df][r] = mfma16(vf, Pf[r], O[df][r]);
      }
    }
    if (MODE == 1) {
#pragma unroll
      for (int kk = 0; kk < 2; ++kk) {
        const int j = cur * 16 + (2 * s2 + kk) * 4 + fq;
        atomicAdd(&impw[fr * 65 + j], g1s[kk]);
        if (j + 1 < 64) atomicAdd(&impw[fr * 65 + j + 1], p3s[kk]);
      }
    }
  }
}

template <int MODE>
__device__ __forceinline__ void nsa_branch(int first, int ntl, u64 U, const bf16_t* kbase, const bf16_t* vbase, size_t stride, int t, int hl, u64 mymask,
                                           const bf16x8 (&Qf)[2][2], f32x4 (&O)[4][2], float (&m)[2], float (&l)[2], const float (&inv)[2], float* impw, char* lds) {
  KVRegs R0, R1, R2;
  u64 rem = U;
  int seq = first, left = ntl;
#define NSA_NEXT(dst)                                                                                     \
  { if (MODE == 2) { dst = rem ? (int)__builtin_ctzll(rem) : -1; if (rem) rem &= rem - 1; }              \
    else { dst = left > 0 ? seq : -1; ++seq; --left; } }
#define NSA_GLOAD(R, ti) kv_gload(R, kbase + (size_t)(ti) * 64 * stride, vbase + (size_t)(ti) * 64 * stride, stride)
  int tcur, t1, t2, t3;
  NSA_NEXT(tcur); NSA_NEXT(t1); NSA_NEXT(t2);
  if (tcur >= 0) NSA_GLOAD(R0, tcur);
  if (t1 >= 0) NSA_GLOAD(R1, t1);
  if (t2 >= 0) NSA_GLOAD(R2, t2);
  if (tcur >= 0) kv_lwrite(R0, lds, 0);
  __syncthreads();
  NSA_NEXT(t3);
  if (t3 >= 0) NSA_GLOAD(R0, t3);
  int buf = 0;
#define NSA_STEP(RW)                                                                                      \
  if (tcur < 0) break;                                                                                    \
  nsa_compute<MODE>(tcur, buf, t, hl, mymask, Qf, O, m, l, inv, impw, lds);                               \
  if (t1 >= 0) kv_lwrite(RW, lds, buf ^ 1);                                                               \
  __syncthreads();                                                                                        \
  buf ^= 1; tcur = t1; t1 = t2; t2 = t3;                                                                  \
  NSA_NEXT(t3);                                                                                           \
  if (t3 >= 0) NSA_GLOAD(RW, t3);
  for (;;) {
    NSA_STEP(R1)
    NSA_STEP(R2)
    NSA_STEP(R0)
  }
#undef NSA_STEP
#undef NSA_GLOAD
#undef NSA_NEXT
}

#define NSA_RESET()                                                                         \
  _Pragma("unroll") for (int r = 0; r < 2; ++r) { asm volatile("v_mov_b32 %0, 0xf149f2ca" : "=v"(m[r])); l[r] = 0.f; }               \
  _Pragma("unroll") for (int df = 0; df < 4; ++df) _Pragma("unroll") for (int r = 0; r < 2; ++r) O[df][r] = zero4();

__device__ __forceinline__ void nsa_item(const Params& P, int b, int g, int c, const bf16_t* z, const bf16_t* kcv, bf16_t* y, char* lds) {
  const int tid = TIDX, lane = tid & 63, w8 = tid >> 6, qg = w8 & 3, hp = w8 >> 2, fr = lane & 15, fq = lane >> 4;
  const size_t tokb = (size_t)b * SEQ;
  const int t = c * 64 + 16 * qg + fr;
  const bf16_t* zq = z + (tokb + t) * LDZ;
  const int hb = g * 4 + hp * 2;
  bf16x8 Qf[2][2];
#pragma unroll
  for (int r = 0; r < 2; ++r)
#pragma unroll
    for (int ks = 0; ks < 2; ++ks) Qf[r][ks] = *(const bf16x8*)(zq + ZC_Q + g * 256 + (hp * 2 + r) * 64 + ks * 32 + 8 * fq);
  float* impw = (float*)(lds + NSA_IMP) + (hp * 4 + qg) * (16 * 65);
  for (int i = lane; i < 16 * 65; i += 64) impw[i] = 0.f;
  f32x4 O[4][2];
  float m[2], l[2], inv[2];
  bf16_t* yo = y + (tokb + t) * 1024 + 512 + g * 256 + hp * 128 + 4 * fq;
  const bf16_t* kc = kcv + (size_t)((0 * 8 + b) * 2 + g) * 256 * 64;
  const bf16_t* vc = kcv + (size_t)((1 * 8 + b) * 2 + g) * 256 * 64;
  const int nct = ((4 * c + 2) >> 6) + 1;
  NSA_RESET();
  inv[0] = 0.f; inv[1] = 0.f;
  nsa_branch<0>(0, nct, 0ull, kc, vc, 64, t, hp * 2, 0ull, Qf, O, m, l, inv, impw, lds);
#pragma unroll
  for (int r = 0; r < 2; ++r) { float lt = l[r]; lt += __shfl_xor(lt, 16); lt += __shfl_xor(lt, 32); inv[r] = lt > 0.f ? 1.f / lt : 0.f; }
  nsa_branch<1>(0, nct, 0ull, kc, vc, 64, t, hp * 2, 0ull, Qf, O, m, l, inv, impw, lds);
#pragma unroll
  for (int r = 0; r < 2; ++r) {
    const float gt = sigm(bf2f(zq[ZC_GC + hb + r]));
#pragma unroll
    for (int df = 0; df < 4; ++df) { u32x2 o; o.x = pk2(O[df][r][0] * gt, O[df][r][1] * gt); o.y = pk2(O[df][r][2] * gt, O[df][r][3] * gt); *(u32x2*)(yo + r * 64 + df * 16) = o; }
  }
  __syncthreads();
  u64 wU = 0ull;
  {
    const float* imp0 = (const float*)(lds + NSA_IMP) + qg * (16 * 65);
    const float* imp1 = imp0 + 4 * (16 * 65);
    u64* MK = (u64*)(lds + NSA_WU) + 8;
    const u64 V = (c >= 63) ? ~0ull : ((1ull << (c + 1)) - 1ull);
    const bool forced = (lane == 0) | (lane == c) | (lane == c - 1);
    for (int q8 = 0; q8 < 8; ++q8) {
      const int qq = hp * 8 + q8;
      const float sv = imp0[qq * 65 + lane] + imp1[qq * 65 + lane];
      const unsigned u = __float_as_uint(forced ? 1e4f : sv);
      u64 mk = V;
      if (c + 1 > 16) {
        unsigned thr = 0u;
        for (int bb = 30; bb >= 0; --bb) { const unsigned cand = thr | (1u << bb); const u64 ge = __ballot(u >= cand) & V; if (__popcll(ge) >= 16) thr = cand; }
        const u64 G = __ballot(u > thr) & V, E = __ballot(u == thr) & V;
        const int need = 16 - (int)__popcll(G);
        const int below = (int)__popcll(E & ((1ull << lane) - 1ull));
        const bool se = (((E >> lane) & 1ull) != 0ull) && (below < need);
        mk = G | __ballot(se);
      }
      if (lane == 0) MK[qg * 16 + qq] = mk;
      wU |= mk;
    }
  }
  u64* WU = (u64*)(lds + NSA_WU);
  if (lane == 0) WU[w8] = wU;
  __syncthreads();
  const u64 U = WU[0] | WU[1] | WU[2] | WU[3] | WU[4] | WU[5] | WU[6] | WU[7];
  const u64 mymask = ((const u64*)(lds + NSA_WU) + 8)[qg * 16 + fr];
  for (int br = 0; br < 2; ++br) {
    NSA_RESET();
    int zg;
    if (br == 0) {
      nsa_branch<2>(0, 0, U, z + tokb * LDZ + ZC_KS + g * 64, z + tokb * LDZ + ZC_VS + g * 64, LDZ, t, hp * 2, mymask, Qf, O, m, l, inv, impw, lds);
      zg = ZC_GS;
    } else {
      const int kt0 = c > 8 ? c - 8 : 0;
      nsa_branch<3>(kt0, c - kt0 + 1, 0ull, z + tokb * LDZ + ZC_KW + g * 64, z + tokb * LDZ + ZC_VW + g * 64, LDZ, t, hp * 2, 0ull, Qf, O, m, l, inv, impw, lds);
      zg = ZC_GW;
    }
#pragma unroll
    for (int r = 0; r < 2; ++r) {
      float lt = l[r]; lt += __shfl_xor(lt, 16); lt += __shfl_xor(lt, 32);
      const float gt = sigm(bf2f(zq[zg + hb + r])) * (lt > 0.f ? 1.f / lt : 0.f);
#pragma unroll
      for (int df = 0; df < 4; ++df) {
        bf16_t* yp = yo + r * 64 + df * 16;
        const u32x2 pr = *(const u32x2*)yp;
        u32x2 o; o.x = pk2(__uint_as_float(pr.x << 16) + O[df][r][0] * gt, __uint_as_float(pr.x & 0xffff0000u) + O[df][r][1] * gt);
        o.y = pk2(__uint_as_float(pr.y << 16) + O[df][r][2] * gt, __uint_as_float(pr.y & 0xffff0000u) + O[df][r][3] * gt);
        *(u32x2*)yp = o;
      }
    }
  }
  __syncthreads();
}

__device__ __forceinline__ void run_phase(const Params& P, int ph, char* lds) {
  char* ws = P.ws;
  asm volatile("" : "+s"(ws));
  bf16_t* abuf = (bf16_t*)(ws + OFF_A);
  bf16_t* big = (bf16_t*)(ws + OFF_BIG);
  bf16_t* fbuf = (bf16_t*)(ws + OFF_F);
  bf16_t* h16 = (bf16_t*)(ws + OFF_F + (size_t)M_TOK * 1024 * 2);
  float* hsl = (float*)(ws + OFF_F); float* Pc = hsl + (size_t)M_TOK * 256;
  bf16_t* kcv = (bf16_t*)(ws + OFF_KC);
  float* carryP = (float*)(ws + OFF_CARRY); float* carryH = carryP + 8 * 4 * 64 * 64;
  if (ph == 0) { prep_phase(P, lds); return; }
  const int layer = (ph - 1) / 13, sp = (ph - 1) % 13;
  const float* ng = P.norm_g + (size_t)layer * 8 * 1024;
#ifdef ONLY_SP
  if (sp != ONLY_SP) return;
#endif
  switch (sp) {
    case 0: case 8: {
      const int lj = layer * 2 + (sp == 8);
      gemm_up_phase(abuf, (const bf16_t*)(ws + OFF_WGU + lj * SZ_WGU), big, lds);
    } break;
    case 1: case 9: {
      const int lj = layer * 2 + (sp == 9);
      gemm_bf16_phase(big, DFF, (const bf16_t*)(ws + OFF_WD + lj * SZ_WD), DFF, 4, fbuf, 1024, lds);
    } break;
    case 2: resnorm_phase(layer == 0 ? P.x : nullptr, h16, nullptr, h16, fbuf, 0.5f, ng + 1 * 1024, ng + 2 * 1024, abuf); break;
    case 3: gemm_bf16_phase(abuf, 1024, (const bf16_t*)(ws + OFF_WIN + layer * SZ_WIN), 1024, LDZ / 256, big, LDZ, lds); break;
    case 4: {
      const int hb = HBLK; char* hl = lds + hb * 65536;
      for (int it = blockIdx.x * 2 + hb; it < 512; it += gridDim.x * 2) compress_item(P, layer, it, big, kcv, hl);
      for (int it = blockIdx.x * 2 + hb; it < 1024; it += gridDim.x * 2) mixA_item(P, layer, it, big, abuf, hl);
      for (int it = blockIdx.x * 2 + hb; it < 2048; it += gridDim.x * 2) mixB1_item(P, layer, it, big, hsl, Pc, carryP, carryH, hl);
    } break;
    case 5: {
      nsa_tables(P, blockIdx.x & 1, lds);
      for (int it = blockIdx.x; it < 1024; it += gridDim.x) {
        const int rnd = it / 256, pos = it % 256;
        const int c = (rnd & 1) ? (rnd >> 1) * 16 + (pos >> 4) : 63 - (rnd >> 1) * 16 - (pos >> 4);
        const int bg = pos & 15;
        nsa_item(P, bg >> 1, bg & 1, c, big, kcv, abuf, lds);
      }
      const int hb = HBLK;
      for (int it = blockIdx.x * 2 + hb; it < 2048; it += gridDim.x * 2) mixB2_item(it, big, hsl, Pc, carryP, carryH, abuf);
    } break;
    case 6: gemm_bf16_phase(abuf, 1024, (const bf16_t*)(ws + OFF_WOUT + layer * SZ_SQ), 1024, 4, fbuf, 1024, lds); break;
    case 7: resnorm_phase(nullptr, h16, nullptr, h16, fbuf, 1.0f, ng + 3 * 1024, ng + 4 * 1024, abuf); break;
    case 10:
      gemm_bf16_phase((const bf16_t*)(ws + OFF_PBF) + (size_t)layer * M_TOK * 256, 256, (const bf16_t*)(ws + OFF_WPP + layer * SZ_WPP), 256, 4, big, 1024, lds);
      resnorm_phase(nullptr, h16, nullptr, h16, fbuf, 0.5f, ng + 5 * 1024, ng + 6 * 1024, abuf);
      break;
    case 11: gemm_ple_phase(abuf, (const bf16_t*)(ws + OFF_WPG + layer * SZ_SQ), big, fbuf, lds); break;
    case 12: resnorm_phase(nullptr, h16, layer == 0 ? nullptr : P.out, layer == 0 ? h16 : nullptr, fbuf, 1.0f, ng + 7 * 1024, layer == 0 ? P.norm_g + 8 * 1024 : nullptr, layer == 0 ? abuf : nullptr); break;
  }
}

#define XB_TMO      128
#define XB_XCNT(j)  (256  + 64 * (j))
#define XB_XSUB(j)  (1280 + 64 * (j))
#define XB_XGEN(j)  (2304 + 64 * (j))
#define XB_TOP      3328
#define XB_TOPGEN   3392
#define XCD_BAR_WORDS 3456
#define XB_SPIN_CAP (1u << 20)
#define LAS __attribute__((address_space(3)))
__device__ __forceinline__ unsigned xb_ld(unsigned* p)              { return __hip_atomic_load(p, __ATOMIC_RELAXED, __HIP_MEMORY_SCOPE_AGENT); }
__device__ __forceinline__ unsigned xb_add(unsigned* p, unsigned v) { return __hip_atomic_fetch_add(p, v, __ATOMIC_RELAXED, __HIP_MEMORY_SCOPE_AGENT); }
__device__ __forceinline__ unsigned xb_xcc_id() { return (unsigned)__builtin_amdgcn_s_getreg((3 << 11) | 20) & 0xFu; }
#define XB_SPIN(cond, bar) do { unsigned _sp = 0; while (cond) { __builtin_amdgcn_s_sleep(1); \
    if ((++_sp & 255u) == 0u) { if (xb_ld(&(bar)[XB_TMO])) break; if (_sp > XB_SPIN_CAP) { atomicAdd(&(bar)[XB_TMO], 1u); break; } } } } while (0)
struct XcdBarrier { unsigned* bar; unsigned x; volatile LAS unsigned* st; };
__device__ __forceinline__ XcdBarrier xcd_barrier_post(unsigned* bar, volatile LAS unsigned* st) {
    XcdBarrier b; b.bar = bar; b.x = xb_xcc_id(); b.st = st;
    if (threadIdx.x == 0) (void)xb_add(&bar[XB_XCNT(b.x)], 1u);
    return b;
}
__device__ __forceinline__ void xcd_barrier_complete(unsigned* bar, unsigned x, unsigned& nloc, unsigned& nx) {
    const unsigned G = gridDim.x * gridDim.y * gridDim.z;
    unsigned sum, cnt, mine, sp = 0u;
    for (;;) {
        sum = 0u; cnt = 0u; mine = 0u;
#pragma unroll
        for (unsigned j = 0; j < 16; ++j) { const unsigned c = xb_ld(&bar[XB_XCNT(j)]); sum += c; cnt += (c > 0u) ? 1u : 0u; mine = (j == x) ? c : mine; }
        if (sum == G) break;
        __builtin_amdgcn_s_sleep(1);
        if ((++sp & 255u) == 0u) { if (xb_ld(&bar[XB_TMO])) break; if (sp > XB_SPIN_CAP) { atomicAdd(&bar[XB_TMO], 1u); break; } }
    }
    nloc = mine > 0u ? mine : 1u; nx = cnt > 0u ? cnt : 1u;
}
__device__ __forceinline__ void xcd_barrier(const XcdBarrier& b) {
    asm volatile("s_waitcnt vmcnt(0)" ::: "memory");
    __syncthreads();
    if (threadIdx.x == 0) {
        unsigned* bar = b.bar;
        __builtin_amdgcn_s_waitcnt(0);
        unsigned nloc = b.st[0], nx = b.st[1];
        if (nloc == 0u) { xcd_barrier_complete(bar, b.x, nloc, nx); b.st[0] = nloc; b.st[1] = nx; }
        const unsigned old = xb_add(&bar[XB_XSUB(b.x)], 1u);
        const unsigned gen = old / nloc;
        if (old + 1u == (gen + 1u) * nloc) {
            __builtin_amdgcn_fence(__ATOMIC_RELEASE, "agent");
            asm volatile("s_waitcnt vmcnt(0)" ::: "memory");
            const unsigned og = xb_add(&bar[XB_TOP], 1u);
            const unsigned tg = og / nx;
            if (og + 1u == (tg + 1u) * nx) xb_add(&bar[XB_TOPGEN], 1u);
            else XB_SPIN(xb_ld(&bar[XB_TOPGEN]) == tg, bar);
            __builtin_amdgcn_fence(__ATOMIC_ACQUIRE, "agent");
            xb_add(&bar[XB_XGEN(b.x)], 1u);
            asm volatile("s_waitcnt vmcnt(0)" ::: "memory");
        } else {
            XB_SPIN(xb_ld(&bar[XB_XGEN(b.x)]) == gen, bar);
            __builtin_amdgcn_fence(__ATOMIC_ACQUIRE, "agent");
            asm volatile("s_waitcnt vmcnt(0)" ::: "memory");
        }
    }
    __syncthreads();
}

constexpr int LDS_BYTES = LDS_ST + 16;
__global__ void __launch_bounds__(512, 2) fwd_megakernel(Params P) {
  __shared__ __attribute__((aligned(16))) char lds[LDS_BYTES];
  cg::grid_group grid = cg::this_grid();
  volatile LAS unsigned* st = (volatile LAS unsigned*)(lds + LDS_ST);
  if (threadIdx.x == 0) { st[0] = 0u; st[1] = 0u; }
  __syncthreads();
  XcdBarrier xb = xcd_barrier_post((unsigned*)(P.ws + OFF_BAR), st);
  if (P.ws == nullptr) grid.sync();
  for (int ph = 0; ph < NPHASE; ++ph) {
    run_phase(P, ph, lds);
    if (ph + 1 < NPHASE) xcd_barrier(xb);
  }
}

__global__ void __launch_bounds__(512, 2) phase_kernel(Params P, int ph) {
  __shared__ __attribute__((aligned(16))) char lds[LDS_BYTES];
  run_phase(P, ph, lds);
}

extern "C" void kernel_launch(void* const* d_in, const int* in_sizes, int n_in, void* d_out, int out_size, void* d_ws, size_t ws_size, hipStream_t stream) {
  Params P{};
  const float** pp = (const float**)&P;
  for (int i = 0; i < 26; ++i) pp[i] = (const float*)d_in[i];
  P.out = (float*)d_out;
  P.ws = (char*)d_ws;
  if (ws_size < WS_NEED) { fprintf(stderr, "workspace too small: %zu < %zu\n", ws_size, (size_t)WS_NEED); return; }
#if MK_FUSED
  static int grid_blocks = 0;
  if (!grid_blocks) {
    int dev = 0, cus = 0, per_cu = 0;
    (void)hipGetDevice(&dev);
    (void)hipDeviceGetAttribute(&cus, hipDeviceAttributeMultiprocessorCount, dev);
    (void)hipOccupancyMaxActiveBlocksPerMultiprocessor(&per_cu, fwd_megakernel, 512, 0);
    if (per_cu > 1) per_cu = 1;
    if (per_cu < 1) per_cu = 1;
    grid_blocks = cus * per_cu;
  }
  (void)hipMemsetAsync((char*)d_ws + OFF_BAR, 0, XCD_BAR_WORDS * 4, stream);
  void* args[] = {&P};
  hipError_t e = hipLaunchCooperativeKernel((void*)fwd_megakernel, dim3(grid_blocks), dim3(512), args, 0, stream);
  if (e != hipSuccess) fprintf(stderr, "cooperative launch failed: %s (grid %d)\n", hipGetErrorString(e), grid_blocks);
#else
  for (int ph = 0; ph < NPHASE; ++ph) phase_kernel<<<256, 512, 0, stream>>>(P, ph);
#endif
}
```

```cpp
#include <hip/hip_runtime.h>
#include <hip/hip_cooperative_groups.h>
#include <cstdint>
#include <cstdio>
namespace cg = cooperative_groups;

#ifndef MK_FUSED
#define MK_FUSED 1
#endif

typedef unsigned short bf16_t;
typedef short bf16x8 __attribute__((ext_vector_type(8)));
typedef short bf16x4 __attribute__((ext_vector_type(4)));
typedef float f32x4 __attribute__((ext_vector_type(4)));
typedef unsigned long long u64;
typedef unsigned u32x4 __attribute__((ext_vector_type(4)));
typedef unsigned u32x2 __attribute__((ext_vector_type(2)));

constexpr int M_TOK = 32768, DM = 1024, DFF = 2816, NGU = 5632, NIN = 2328, LDZ = 2560, SEQ = 4096;
constexpr int NPHASE = 27;
constexpr int ZC_AU = 0, ZC_AV = 256, ZC_BX = 512, ZC_BG = 768, ZC_Q = 1024, ZC_KC = 1536, ZC_VC = 1664, ZC_KS = 1792, ZC_VS = 1920,
              ZC_KW = 2048, ZC_VW = 2176, ZC_GC = 2304, ZC_GS = 2312, ZC_GW = 2320;

constexpr size_t SZ_WGU = (size_t)NGU * 1024 * 2, SZ_WD = (size_t)1024 * DFF * 2, SZ_WIN = (size_t)LDZ * 1024 * 2, SZ_SQ = (size_t)1024 * 1024 * 2,
                 SZ_WPP = (size_t)1024 * 256 * 2, SZ_CW1 = (size_t)128 * 2048 * 2;
constexpr size_t OFF_WGU = 0;
constexpr size_t OFF_WD = OFF_WGU + 4 * SZ_WGU;
constexpr size_t OFF_WIN = OFF_WD + 4 * SZ_WD;
constexpr size_t OFF_WOUT = OFF_WIN + 2 * SZ_WIN;
constexpr size_t OFF_WPG = OFF_WOUT + 2 * SZ_SQ;
constexpr size_t OFF_WPP = OFF_WPG + 2 * SZ_SQ;
constexpr size_t OFF_CW1 = OFF_WPP + 2 * SZ_WPP;
constexpr size_t OFF_CB1 = OFF_CW1 + 4 * SZ_CW1;
constexpr size_t OFF_SGUW = OFF_CB1 + 4096;
constexpr size_t OFF_WAT = OFF_SGUW + 2 * 4 * 128 * 128 * 2;
constexpr size_t OFF_WXT = OFF_WAT + 2 * 4 * 64 * 64 * 2;
constexpr size_t OFF_PBF = OFF_WXT + 2 * 4 * 64 * 64 * 2;
constexpr size_t OFF_A = OFF_PBF + (size_t)2 * M_TOK * 256 * 2;
constexpr size_t OFF_BIG = OFF_A + (size_t)M_TOK * 1024 * 2;
constexpr size_t OFF_F = OFF_BIG + (size_t)M_TOK * DFF * 2;
constexpr size_t OFF_KC = OFF_F + (size_t)M_TOK * 1024 * 4;
constexpr size_t OFF_CARRY = OFF_KC + (size_t)2 * 8 * 2 * 256 * 64 * 2;
constexpr size_t OFF_BAR = OFF_CARRY + (size_t)2 * 8 * 4 * 64 * 64 * 4;
constexpr size_t WS_NEED = OFF_BAR + 16384;

struct Params {
  const float *x, *p, *rel_bias, *norm_g, *ffn_wg, *ffn_wu, *ffn_wd, *w_in, *w_out, *sgu_ng, *sgu_w, *sgu_b, *conv_w, *conv_b,
      *lru_wa, *lru_ba, *lru_wx, *lru_bx, *lru_lam, *cmp_pos, *cmp_w1, *cmp_b1, *cmp_w2, *cmp_b2, *ple_wg, *ple_wp;
  float* out;
  char* ws;
};

__device__ __forceinline__ int opaque_tid() { int t; asm volatile("v_mov_b32 %0, %1" : "=v"(t) : "v"(threadIdx.x)); return t; }
#define TIDX opaque_tid()
#define HTID (opaque_tid() & 255)
#define HBLK (opaque_tid() >> 8)
__device__ __forceinline__ float bf2f(bf16_t v) { return __uint_as_float(((unsigned)v) << 16); }
__device__ __forceinline__ bf16_t f2bf(float f) { unsigned u = __float_as_uint(f); u += 0x7fffu + ((u >> 16) & 1u); return (bf16_t)(u >> 16); }
__device__ __forceinline__ unsigned pk2(float lo, float hi) { unsigned r; asm("v_cvt_pk_bf16_f32 %0, %1, %2" : "=v"(r) : "v"(lo), "v"(hi)); return r; }
__device__ __forceinline__ float sigm(float x) { return __builtin_amdgcn_rcpf(1.f + __expf(-x)); }
__device__ __forceinline__ float gelu_t(float x) { float u = 0.7978845608028654f * (x + 0.044715f * x * x * x); return x * __builtin_amdgcn_rcpf(1.f + __expf(-2.f * u)); }
__device__ __forceinline__ float silu_f(float x) { return x * __builtin_amdgcn_rcpf(1.f + __expf(-x)); }
__device__ __forceinline__ f32x4 mfma16(bf16x8 a, bf16x8 b, f32x4 c) { return __builtin_amdgcn_mfma_f32_16x16x32_bf16(a, b, c, 0, 0, 0); }
__device__ __forceinline__ void glds16(const void* g, void* l) {
  __builtin_amdgcn_global_load_lds((const __attribute__((address_space(1))) unsigned*)g, (__attribute__((address_space(3))) unsigned*)l, 16, 0, 0);
}
__device__ __forceinline__ f32x4 zero4() { f32x4 z; asm volatile("v_mov_b32 %0, 0\n\tv_mov_b32 %1, 0\n\tv_mov_b32 %2, 0\n\tv_mov_b32 %3, 0" : "=v"(z[0]), "=v"(z[1]), "=v"(z[2]), "=v"(z[3])); return z; }
__device__ __forceinline__ float wave_sum(float v) {
#pragma unroll
  for (int o = 32; o > 0; o >>= 1) v += __shfl_xor(v, o);
  return v;
}
__device__ __forceinline__ void unpack8(const u32x4 u, float* f) {
  f[0] = __uint_as_float(u.x << 16); f[1] = __uint_as_float(u.x & 0xffff0000u);
  f[2] = __uint_as_float(u.y << 16); f[3] = __uint_as_float(u.y & 0xffff0000u);
  f[4] = __uint_as_float(u.z << 16); f[5] = __uint_as_float(u.z & 0xffff0000u);
  f[6] = __uint_as_float(u.w << 16); f[7] = __uint_as_float(u.w & 0xffff0000u);
}

__device__ __forceinline__ void tr_cvt(const float* __restrict__ src, int N, int K, bf16_t* __restrict__ dst, int ldd, int rs, int ro, char* ldsc) {
  const int ntn = (N + 63) >> 6, nt = ntn * (K >> 6), hb = HBLK, tid = HTID;
  float* lds = (float*)(ldsc + hb * 65536);
  for (int t0 = blockIdx.x * 6; t0 < nt; t0 += gridDim.x * 6) {
    float4 v[3][4];
#pragma unroll
    for (int u = 0; u < 3; ++u) {
      const int tile = t0 + hb * 3 + u, tk = tile / ntn, tn = tile - tk * ntn, k0 = tk * 64, n0 = tn * 64;
      const bool active = tile < nt;
#pragma unroll
      for (int ps = 0; ps < 4; ++ps) {
        const int i = ps * 16 + (tid >> 4), j = (tid & 15) * 4;
        v[u][ps] = make_float4(0.f, 0.f, 0.f, 0.f);
        if (active && n0 + j < N) v[u][ps] = *(const float4*)(src + (size_t)(k0 + i) * N + n0 + j);
      }
    }
#pragma unroll
    for (int u = 0; u < 3; ++u)
#pragma unroll
      for (int ps = 0; ps < 4; ++ps) {
        const int i = ps * 16 + (tid >> 4), j = (tid & 15) * 4;
        float* d = lds + u * 4160 + i * 65 + j; d[0] = v[u][ps].x; d[1] = v[u][ps].y; d[2] = v[u][ps].z; d[3] = v[u][ps].w;
      }
    __syncthreads();
#pragma unroll
    for (int u = 0; u < 3; ++u) {
      const int tile = t0 + hb * 3 + u, tk = tile / ntn, tn = tile - tk * ntn, k0 = tk * 64, n0 = tn * 64;
      const int j = tid >> 2, kq = tid & 3, n = n0 + j;
      if (tile < nt && n < N) {
        const float* l = lds + u * 4160;
        unsigned w[8];
#pragma unroll
        for (int q = 0; q < 8; ++q) w[q] = pk2(l[(kq * 16 + 2 * q) * 65 + j], l[(kq * 16 + 2 * q + 1) * 65 + j]);
        bf16_t* o = dst + (size_t)((n >> 4) * rs + (n & 15) + ro) * ldd + k0 + kq * 16;
        u32x4 w0, w1; w0.x = w[0]; w0.y = w[1]; w0.z = w[2]; w0.w = w[3]; w1.x = w[4]; w1.y = w[5]; w1.z = w[6]; w1.w = w[7];
        *(u32x4*)o = w0; *(u32x4*)(o + 8) = w1;
      }
    }
    __syncthreads();
  }
}

struct RowRegs { float4 h[4]; u32x2 f[4]; };
__device__ __forceinline__ void rn_load(RowRegs& R, const float* hin32, const bf16_t* hin16, const bf16_t* f, int row, int lane) {
  if (hin32) {
#pragma unroll
    for (int i = 0; i < 4; ++i) R.h[i] = *(const float4*)(hin32 + (size_t)row * 1024 + i * 256 + lane * 4);
  } else {
#pragma unroll
    for (int i = 0; i < 4; ++i) { const u32x2 v = *(const u32x2*)(hin16 + (size_t)row * 1024 + i * 256 + lane * 4);
      R.h[i].x = __uint_as_float(v.x << 16); R.h[i].y = __uint_as_float(v.x & 0xffff0000u); R.h[i].z = __uint_as_float(v.y << 16); R.h[i].w = __uint_as_float(v.y & 0xffff0000u); }
  }
  if (f) {
#pragma unroll
    for (int i = 0; i < 4; ++i) R.f[i] = *(const u32x2*)(f + (size_t)row * 1024 + i * 256 + lane * 4);
  }
}
__device__ __forceinline__ void rn_proc(RowRegs& R, float* hout32, bf16_t* hout16, bool has_f, float scale, const float4 (&gpo)[4], const float4 (&gpr)[4], bf16_t* a, int row, int lane) {
  if (has_f) {
    float fv[4][4]; float ss = 0.f;
#pragma unroll
    for (int i = 0; i < 4; ++i) {
      fv[i][0] = __uint_as_float(R.f[i].x << 16); fv[i][1] = __uint_as_float(R.f[i].x & 0xffff0000u);
      fv[i][2] = __uint_as_float(R.f[i].y << 16); fv[i][3] = __uint_as_float(R.f[i].y & 0xffff0000u);
      ss += fv[i][0] * fv[i][0] + fv[i][1] * fv[i][1] + fv[i][2] * fv[i][2] + fv[i][3] * fv[i][3];
    }
    ss = wave_sum(ss);
    const float r = rsqrtf(ss * (1.f / 1024.f) + 1e-6f) * scale;
#pragma unroll
    for (int i = 0; i < 4; ++i) { const float4 g = gpo[i];
      R.h[i].x += fv[i][0] * r * g.x; R.h[i].y += fv[i][1] * r * g.y; R.h[i].z += fv[i][2] * r * g.z; R.h[i].w += fv[i][3] * r * g.w; }
  }
  if (hout32) {
#pragma unroll
    for (int i = 0; i < 4; ++i) *(float4*)(hout32 + (size_t)row * 1024 + i * 256 + lane * 4) = R.h[i];
  }
  if (hout16) {
#pragma unroll
    for (int i = 0; i < 4; ++i) { u32x2 o; o.x = pk2(R.h[i].x, R.h[i].y); o.y = pk2(R.h[i].z, R.h[i].w); *(u32x2*)(hout16 + (size_t)row * 1024 + i * 256 + lane * 4) = o; }
  }
  if (a) {
    float ss = 0.f;
#pragma unroll
    for (int i = 0; i < 4; ++i) ss += R.h[i].x * R.h[i].x + R.h[i].y * R.h[i].y + R.h[i].z * R.h[i].z + R.h[i].w * R.h[i].w;
    ss = wave_sum(ss);
    const float r = rsqrtf(ss * (1.f / 1024.f) + 1e-6f);
#pragma unroll
    for (int i = 0; i < 4; ++i) { const float4 g = gpr[i];
      u32x2 o; o.x = pk2(R.h[i].x * r * g.x, R.h[i].y * r * g.y); o.y = pk2(R.h[i].z * r * g.z, R.h[i].w * r * g.w);
      *(u32x2*)(a + (size_t)row * 1024 + i * 256 + lane * 4) = o; }
  }
}
__device__ __forceinline__ void resnorm_phase(const float* hin32, const bf16_t* hin16, float* hout32, bf16_t* hout16, const bf16_t* f, float scale, const float* gpost, const float* gpre, bf16_t* a) {
  const int tid = TIDX, lane = tid & 63, stride = gridDim.x * 8;
  int r0 = blockIdx.x * 8 + (tid >> 6), r1 = r0 + 2 * stride;
  RowRegs A0, A1, B0, B1;
  float4 gpo[4], gpr[4];
#pragma unroll
  for (int i = 0; i < 4; ++i) { gpo[i] = f ? *(const float4*)(gpost + i * 256 + lane * 4) : make_float4(0.f, 0.f, 0.f, 0.f); gpr[i] = a ? *(const float4*)(gpre + i * 256 + lane * 4) : make_float4(0.f, 0.f, 0.f, 0.f); }
  const bool hf = f != nullptr;
  if (r0 < M_TOK) { rn_load(A0, hin32, hin16, f, r0, lane); rn_load(A1, hin32, hin16, f, r0 + stride, lane); }
  for (;;) {
    if (r0 >= M_TOK) break;
    if (r1 < M_TOK) { rn_load(B0, hin32, hin16, f, r1, lane); rn_load(B1, hin32, hin16, f, r1 + stride, lane); }
    rn_proc(A0, hout32, hout16, hf, scale, gpo, gpr, a, r0, lane); rn_proc(A1, hout32, hout16, hf, scale, gpo, gpr, a, r0 + stride, lane);
    r0 += 4 * stride;
    if (r1 >= M_TOK) break;
    if (r0 < M_TOK) { rn_load(A0, hin32, hin16, f, r0, lane); rn_load(A1, hin32, hin16, f, r0 + stride, lane); }
    rn_proc(B0, hout32, hout16, hf, scale, gpo, gpr, a, r1, lane); rn_proc(B1, hout32, hout16, hf, scale, gpo, gpr, a, r1 + stride, lane);
    r1 += 4 * stride;
  }
}

__device__ __forceinline__ void prep_phase(const Params& P, char* ldsc) {
  char* ws = P.ws;
  for (int l = 0; l < 2; ++l) {
    for (int j = 0; j < 2; ++j) {
      const int lj = l * 2 + j;
      bf16_t* wgu = (bf16_t*)(ws + OFF_WGU + lj * SZ_WGU);
      tr_cvt(P.ffn_wg + (size_t)lj * 1024 * DFF, DFF, 1024, wgu, 1024, 32, 0, ldsc);
      tr_cvt(P.ffn_wu + (size_t)lj * 1024 * DFF, DFF, 1024, wgu, 1024, 32, 16, ldsc);
      tr_cvt(P.ffn_wd + (size_t)lj * DFF * 1024, 1024, DFF, (bf16_t*)(ws + OFF_WD + lj * SZ_WD), DFF, 16, 0, ldsc);
      tr_cvt(P.cmp_w1 + (size_t)lj * 2048 * 128, 128, 2048, (bf16_t*)(ws + OFF_CW1 + lj * SZ_CW1), 2048, 16, 0, ldsc);
    }
    tr_cvt(P.w_in + (size_t)l * 1024 * NIN, NIN, 1024, (bf16_t*)(ws + OFF_WIN + l * SZ_WIN), 1024, 16, 0, ldsc);
    tr_cvt(P.w_out + (size_t)l * 1024 * 1024, 1024, 1024, (bf16_t*)(ws + OFF_WOUT + l * SZ_SQ), 1024, 16, 0, ldsc);
    tr_cvt(P.ple_wg + (size_t)l * 1024 * 1024, 1024, 1024, (bf16_t*)(ws + OFF_WPG + l * SZ_SQ), 1024, 16, 0, ldsc);
    tr_cvt(P.ple_wp + (size_t)l * 256 * 1024, 1024, 256, (bf16_t*)(ws + OFF_WPP + l * SZ_WPP), 256, 16, 0, ldsc);
    for (int g = 0; g < 4; ++g) {
      tr_cvt(P.lru_wa + (size_t)(l * 4 + g) * 4096, 64, 64, (bf16_t*)(ws + OFF_WAT) + (l * 4 + g) * 4096, 64, 16, 0, ldsc);
      tr_cvt(P.lru_wx + (size_t)(l * 4 + g) * 4096, 64, 64, (bf16_t*)(ws + OFF_WXT) + (l * 4 + g) * 4096, 64, 16, 0, ldsc);
    }
  }
  const int tid = TIDX, gtid = blockIdx.x * 512 + tid, gn = gridDim.x * 512;
  for (int i = gtid; i < 2 * (LDZ - NIN) * 1024 / 8; i += gn) {
    const int l = i / ((LDZ - NIN) * 128), r = i - l * ((LDZ - NIN) * 128);
    *(f32x4*)((bf16_t*)(ws + OFF_WIN + l * SZ_WIN) + (size_t)NIN * 1024 + (size_t)r * 8) = zero4();
  }
  for (int i = gtid; i < 2 * 4 * 128 * 128; i += gn) { const int t = (i >> 7) & 127, s2 = i & 127; ((bf16_t*)(ws + OFF_SGUW))[i] = (s2 <= t) ? f2bf(P.sgu_w[i]) : (bf16_t)0; }
  for (int i = gtid; i < 2 * M_TOK * 256 / 4; i += gn) { const float4 v = ((const float4*)P.p)[i]; uint2 o; o.x = pk2(v.x, v.y); o.y = pk2(v.z, v.w); ((uint2*)(ws + OFF_PBF))[i] = o; }
  {
    float* lds = (float*)(ldsc + HBLK * 65536);
    for (int u = blockIdx.x; u < 4; u += gridDim.x) {
      const int t2 = HTID, kq = t2 >> 5, jq = t2 & 31;
      const float* w1 = P.cmp_w1 + (size_t)u * 2048 * 128; const float* pos = P.cmp_pos + (size_t)u * 2048;
      float4 sacc = make_float4(0.f, 0.f, 0.f, 0.f);
      for (int k = kq * 256; k < kq * 256 + 256; ++k) { const float pv = pos[k]; const float4 w = *(const float4*)(w1 + (size_t)k * 128 + jq * 4); sacc.x += pv * w.x; sacc.y += pv * w.y; sacc.z += pv * w.z; sacc.w += pv * w.w; }
      __syncthreads();
      lds[kq * 128 + jq * 4 + 0] = sacc.x; lds[kq * 128 + jq * 4 + 1] = sacc.y; lds[kq * 128 + jq * 4 + 2] = sacc.z; lds[kq * 128 + jq * 4 + 3] = sacc.w;
      __syncthreads();
      if (t2 < 128) { float t = P.cmp_b1[u * 128 + t2]; for (int q = 0; q < 8; ++q) t += lds[q * 128 + t2]; ((float*)(ws + OFF_CB1))[u * 128 + t2] = t; }
      __syncthreads();
    }
  }
  resnorm_phase(P.x, nullptr, nullptr, nullptr, nullptr, 0.f, nullptr, P.norm_g, (bf16_t*)(ws + OFF_A));
}

constexpr int G8_HT = 128 * 64;
__device__ __forceinline__ int g8_lds_byte(int r, int c) { const int st = (r >> 4) * 2 + (c >> 5), rr = r & 15, cc = c & 31, ob = rr * 64 + cc * 2; return st * 1024 + (ob ^ (((ob >> 9) & 1) << 5)); }
__device__ __forceinline__ void g8_stage_rc(int b, int& R, int& C) { const int st = b / 1024, sb = b % 1024, swz = sb ^ (((sb >> 9) & 1) << 5); R = (st >> 1) * 16 + swz / 64; C = (st & 1) * 32 + (swz % 64) / 2; }

template <bool ISSUE_ONLY, bool PRE_ISSUED>
__device__ __forceinline__ void gemm_core(f32x4 (&acc)[2][2][4][2], const bf16_t* __restrict__ A, int lda, const bf16_t* __restrict__ Bt, int ldb, int K, char* ldsc) {
  bf16_t* shm = (bf16_t*)ldsc;
  const int tid = TIDX, wid = tid >> 6, lane = tid & 63, wr = wid >> 2, wc = wid & 3, fr = lane & 15, fq = lane >> 4;
  int sr0, sc0;
  g8_stage_rc(tid * 16, sr0, sc0);
  const bf16_t* gA0 = A + (size_t)sr0 * lda + sc0;
  const bf16_t* gB0 = Bt + (size_t)sr0 * ldb + sc0;
  const size_t a64 = (size_t)64 * lda, b64 = (size_t)64 * ldb;
  const int lane_off = (fr * 64 + fq * 16) ^ ((((fr * 64 + fq * 16) >> 9) & 1) << 5);
  const char* ldA = ldsc + wr * 8192 + lane_off;
  const char* ldB = ldsc + 65536 + wc * 4096 + lane_off;
#define SA(b, h) (shm + ((b) * 2 + (h)) * G8_HT)
#define SB(b, h) (shm + (4 + (b) * 2 + (h)) * G8_HT)
#define STAGE_A(P, h, kt) { const bf16_t* g_ = gA0 + (size_t)(h) * 2 * a64 + (kt) * 64; glds16(g_, (char*)(P) + tid * 16); glds16(g_ + a64, (char*)(P) + tid * 16 + 8192); }
#define STAGE_B(P, h, kt) { const bf16_t* g_ = gB0 + (size_t)(h) * 2 * b64 + (kt) * 64; glds16(g_, (char*)(P) + tid * 16); glds16(g_ + b64, (char*)(P) + tid * 16 + 8192); }
#define LDA(dst, b, h) _Pragma("unroll") for (int m = 0; m < 4; ++m) _Pragma("unroll") for (int k = 0; k < 2; ++k) \
    dst[m][k] = *reinterpret_cast<const bf16x8*>(ldA + ((b) * 2 + (h)) * 16384 + (m * 2 + k) * 1024)
#define LDB(dst, b, h) _Pragma("unroll") for (int n = 0; n < 2; ++n) _Pragma("unroll") for (int k = 0; k < 2; ++k) \
    dst[n][k] = *reinterpret_cast<const bf16x8*>(ldB + ((b) * 2 + (h)) * 16384 + (n * 2 + k) * 1024)
#define MMA(ai, bj, At_, Bt_) do { __builtin_amdgcn_s_setprio(1); \
    _Pragma("unroll") for (int m = 0; m < 4; ++m) _Pragma("unroll") for (int n = 0; n < 2; ++n) _Pragma("unroll") for (int k = 0; k < 2; ++k) \
      acc[ai][bj][m][n] = mfma16(Bt_[n][k], At_[m][k], acc[ai][bj][m][n]); \
    __builtin_amdgcn_s_setprio(0); } while (0)
#define WAIT_V(n) asm volatile("s_waitcnt vmcnt(" #n ")" ::: "memory")
#define WAIT_L(n) asm volatile("s_waitcnt lgkmcnt(" #n ")" ::: "memory")
#define BAR __builtin_amdgcn_s_barrier()
#define SCHED __builtin_amdgcn_sched_barrier(0)
  bf16x8 At[4][2], B0[2][2], B1[2][2];
  const int nt = K >> 6;
  if (!PRE_ISSUED) {
    STAGE_B(SB(0, 0), 0, 0); STAGE_A(SA(0, 0), 0, 0);
    STAGE_B(SB(0, 1), 1, 0); STAGE_A(SA(0, 1), 1, 0);
  }
  if (ISSUE_ONLY) return;
  if (wr == 1) BAR;
  if (PRE_ISSUED) { WAIT_V(0); } else { WAIT_V(4); }
  BAR;
  STAGE_B(SB(1, 0), 0, 1); STAGE_A(SA(1, 0), 0, 1); STAGE_B(SB(1, 1), 1, 1);
  WAIT_V(6); BAR;
#pragma nounroll
  for (int t = 0; t < nt - 2; t += 2) {
    LDB(B0, 0, 0); SCHED; LDA(At, 0, 0); STAGE_A(SA(1, 1), 1, t + 1);
    WAIT_L(8); BAR; WAIT_L(0); MMA(0, 0, At, B0); BAR; SCHED;
    LDB(B1, 0, 1); STAGE_B(SB(0, 0), 0, t + 2);
    BAR; WAIT_L(0); MMA(0, 1, At, B1); BAR;
    LDA(At, 0, 1); STAGE_A(SA(0, 0), 0, t + 2);
    BAR; WAIT_L(0); MMA(1, 0, At, B0); BAR; SCHED;
    STAGE_B(SB(0, 1), 1, t + 2);
    WAIT_V(6); BAR; MMA(1, 1, At, B1); BAR;
    LDB(B0, 1, 0); SCHED; LDA(At, 1, 0); STAGE_A(SA(0, 1), 1, t + 2);
    WAIT_L(8); BAR; WAIT_L(0); MMA(0, 0, At, B0); BAR; SCHED;
    LDB(B1, 1, 1); STAGE_B(SB(1, 0), 0, t + 3);
    BAR; WAIT_L(0); MMA(0, 1, At, B1); BAR;
    LDA(At, 1, 1); STAGE_A(SA(1, 0), 0, t + 3);
    BAR; WAIT_L(0); MMA(1, 0, At, B0); BAR; SCHED;
    STAGE_B(SB(1, 1), 1, t + 3);
    WAIT_V(6); BAR; MMA(1, 1, At, B1); BAR;
  }
  { LDB(B0, 0, 0); LDA(At, 0, 0); STAGE_A(SA(1, 1), 1, nt - 1);
    BAR; WAIT_L(0); MMA(0, 0, At, B0); BAR;
    LDB(B1, 0, 1); BAR; WAIT_L(0); MMA(0, 1, At, B1); BAR;
    LDA(At, 0, 1); WAIT_V(4); BAR; WAIT_L(0); MMA(1, 0, At, B0); MMA(1, 1, At, B1); BAR; }
  { LDB(B0, 1, 0); LDA(At, 1, 0); WAIT_V(2); BAR; WAIT_L(0); MMA(0, 0, At, B0); BAR;
    LDB(B1, 1, 1); WAIT_V(0); BAR; WAIT_L(0); MMA(0, 1, At, B1); BAR;
    LDA(At, 1, 1); BAR; WAIT_L(0); MMA(1, 0, At, B0); MMA(1, 1, At, B1); BAR; }
  if (wr == 0) BAR;
  BAR;
#undef SA
#undef SB
#undef STAGE_A
#undef STAGE_B
#undef LDA
#undef LDB
#undef MMA
#undef WAIT_V
#undef WAIT_L
#undef BAR
#undef SCHED
}

struct TileIt {
  int TN, npc, npatch, slot, nslot, pid, s, tm, tn;
  __device__ __forceinline__ void init(int TN_) { TN = TN_; npc = (TN + 1) >> 1; npatch = 8 * npc; slot = blockIdx.x >> 3; nslot = gridDim.x >> 3; pid = blockIdx.x & 7; s = slot - nslot; }
  __device__ __forceinline__ bool next() {
    for (;;) {
      s += nslot;
      if (s >= 32) { s = slot; pid += 8; }
      if (pid >= npatch) return false;
      const int pr = pid / npc, pc = pid - pr * npc;
      tm = pr * 16 + (s & 15); tn = pc * 2 + (s >> 4);
      if (tn < TN) return true;
    }
  }
};

#define GEMM_LANE const int tid_ = TIDX, lane_ = tid_ & 63, wid_ = tid_ >> 6, wr = wid_ >> 2, wc = wid_ & 3, fr = lane_ & 15, fq = lane_ >> 4
#define GEMM_EPI_LOOP _Pragma("unroll") for (int ai = 0; ai < 2; ++ai) _Pragma("unroll") for (int m = 0; m < 4; ++m) _Pragma("unroll") for (int bj = 0; bj < 2; ++bj)

template <class Epi> __device__ __forceinline__ void gemm_phase(const bf16_t* A, int lda, const bf16_t* Bt, int ldb, int K, int TN, char* lds, Epi&& epi) {
  TileIt it; it.init(TN);
  bool have = it.next();
  f32x4 acc[2][2][4][2];
  if (have) gemm_core<true, false>(acc, A + (size_t)it.tm * 256 * lda, lda, Bt + (size_t)it.tn * 256 * ldb, ldb, K, lds);
  while (have) {
    const int tm = it.tm, tn = it.tn;
#pragma unroll
    for (int i0 = 0; i0 < 2; ++i0)
#pragma unroll
      for (int i1 = 0; i1 < 2; ++i1)
#pragma unroll
        for (int i2 = 0; i2 < 4; ++i2)
#pragma unroll
          for (int i3 = 0; i3 < 2; ++i3) acc[i0][i1][i2][i3] = zero4();
    gemm_core<false, true>(acc, A + (size_t)tm * 256 * lda, lda, Bt + (size_t)tn * 256 * ldb, ldb, K, lds);
    have = it.next();
    if (have) { f32x4 dummy[2][2][4][2]; gemm_core<true, false>(dummy, A + (size_t)it.tm * 256 * lda, lda, Bt + (size_t)it.tn * 256 * ldb, ldb, K, lds); }
    epi(acc, tm, tn);
  }
  asm volatile("s_waitcnt vmcnt(0)" ::: "memory");
}

__device__ __forceinline__ void gemm_up_phase(const bf16_t* a, const bf16_t* wgu, bf16_t* act, char* lds) {
  gemm_phase(a, 1024, wgu, 1024, 1024, NGU / 256, lds, [&](f32x4 (&acc)[2][2][4][2], int tm, int tn) {
    GEMM_LANE;
    GEMM_EPI_LOOP {
      const int row = tm * 256 + ai * 128 + wr * 64 + m * 16 + fr;
      const int col = tn * 128 + bj * 64 + wc * 16 + 4 * fq;
      const f32x4 g = acc[ai][bj][m][0], u = acc[ai][bj][m][1];
      u32x2 o; o.x = pk2(silu_f(g[0]) * u[0], silu_f(g[1]) * u[1]); o.y = pk2(silu_f(g[2]) * u[2], silu_f(g[3]) * u[3]);
      *(u32x2*)(act + (size_t)row * DFF + col) = o;
    }
  });
}

__device__ __forceinline__ void gemm_bf16_phase(const bf16_t* A, int lda, const bf16_t* Bt, int K, int TN, bf16_t* out, int ldo, char* lds) {
  gemm_phase(A, lda, Bt, K, K, TN, lds, [&](f32x4 (&acc)[2][2][4][2], int tm, int tn) {
    GEMM_LANE;
    GEMM_EPI_LOOP {
      const int row = tm * 256 + ai * 128 + wr * 64 + m * 16 + fr;
#pragma unroll
      for (int n = 0; n < 2; ++n) {
        u32x2 o; o.x = pk2(acc[ai][bj][m][n][0], acc[ai][bj][m][n][1]); o.y = pk2(acc[ai][bj][m][n][2], acc[ai][bj][m][n][3]);
        *(u32x2*)(out + (size_t)row * ldo + tn * 256 + bj * 128 + wc * 32 + n * 16 + 4 * fq) = o;
      }
    }
  });
}

__device__ __forceinline__ void gemm_ple_phase(const bf16_t* a, const bf16_t* wpg, const bf16_t* pp, bf16_t* out, char* lds) {
  gemm_phase(a, 1024, wpg, 1024, 1024, 4, lds, [&](f32x4 (&acc)[2][2][4][2], int tm, int tn) {
    GEMM_LANE;
    GEMM_EPI_LOOP {
      const int row = tm * 256 + ai * 128 + wr * 64 + m * 16 + fr;
#pragma unroll
      for (int n = 0; n < 2; ++n) {
        const int col = tn * 256 + bj * 128 + wc * 32 + n * 16 + 4 * fq;
        const u32x2 pv = *(const u32x2*)(pp + (size_t)row * 1024 + col);
        const f32x4 av = acc[ai][bj][m][n];
        u32x2 o;
        o.x = pk2(sigm(av[0]) * __uint_as_float(pv.x << 16), sigm(av[1]) * __uint_as_float(pv.x & 0xffff0000u));
        o.y = pk2(sigm(av[2]) * __uint_as_float(pv.y << 16), sigm(av[3]) * __uint_as_float(pv.y & 0xffff0000u));
        *(u32x2*)(out + (size_t)row * 1024 + col) = o;
      }
    }
  });
}

__device__ __forceinline__ void mixA_item(const Params& P, int layer, int idx, const bf16_t* z, bf16_t* y, char* lds) {
  const int g = idx & 3, bc = idx >> 2, tok0 = bc * 128;
  const int tid = HTID, lane = tid & 63, w = tid >> 6, fr = lane & 15, fq = lane >> 4;
  bf16_t* vT = (bf16_t*)lds;
  const float* ng = P.sgu_ng + layer * 256;
  {
    const int s = tid >> 1, half = tid & 1;
    const bf16_t* zr = z + (size_t)(tok0 + s) * LDZ + ZC_AV;
    float ss = 0.f;
#pragma unroll 4
    for (int i = 0; i < 16; ++i) { float v[8]; unpack8(*(const u32x4*)(zr + half * 128 + i * 8), v);
#pragma unroll
      for (int e = 0; e < 8; ++e) { const float t = gelu_t(v[e]); ss += t * t; } }
    ss += __shfl_xor(ss, 1);
    const float rs = rsqrtf(ss * (1.f / 256.f) + 1e-6f);
#pragma unroll
    for (int i = 0; i < 4; ++i) { float v[8]; unpack8(*(const u32x4*)(zr + g * 64 + half * 32 + i * 8), v);
#pragma unroll
      for (int e = 0; e < 8; ++e) { const int d = half * 32 + i * 8 + e; vT[d * 136 + s] = f2bf(gelu_t(v[e]) * rs * ng[g * 64 + d]); } }
  }
  __syncthreads();
  const bf16_t* W = (const bf16_t*)(P.ws + OFF_SGUW) + (size_t)((layer * 4 + g) * 128) * 128;
  f32x4 acc[2][4] = {};
  for (int ks = 0; ks <= w; ++ks) {
    bf16x8 wf[2], vf[4];
#pragma unroll
    for (int tm = 0; tm < 2; ++tm) wf[tm] = *(const bf16x8*)(W + (size_t)(32 * w + tm * 16 + fr) * 128 + ks * 32 + 8 * fq);
#pragma unroll
    for (int dn = 0; dn < 4; ++dn) vf[dn] = *(const bf16x8*)(vT + (dn * 16 + fr) * 136 + ks * 32 + 8 * fq);
#pragma unroll
    for (int tm = 0; tm < 2; ++tm)
#pragma unroll
      for (int dn = 0; dn < 4; ++dn) acc[tm][dn] = mfma16(vf[dn], wf[tm], acc[tm][dn]);
  }
#pragma unroll
  for (int tm = 0; tm < 2; ++tm) {
    const int t = 32 * w + tm * 16 + fr;
    const float bias = P.sgu_b[(layer * 4 + g) * 128 + t];
#pragma unroll
    for (int dn = 0; dn < 4; ++dn) {
      const int d = dn * 16 + 4 * fq;
      const uint2 uu = *(const uint2*)(z + (size_t)(tok0 + t) * LDZ + ZC_AU + g * 64 + d);
      const float u0 = gelu_t(__uint_as_float(uu.x << 16)), u1 = gelu_t(__uint_as_float(uu.x & 0xffff0000u)),
                  u2 = gelu_t(__uint_as_float(uu.y << 16)), u3 = gelu_t(__uint_as_float(uu.y & 0xffff0000u));
      uint2 o; o.x = pk2(u0 * (acc[tm][dn][0] + bias), u1 * (acc[tm][dn][1] + bias)); o.y = pk2(u2 * (acc[tm][dn][2] + bias), u3 * (acc[tm][dn][3] + bias));
      *(uint2*)(y + (size_t)(tok0 + t) * 1024 + g * 64 + d) = o;
    }
  }
  __syncthreads();
}

__device__ __forceinline__ void mixB1_item(const Params& P, int layer, int idx, const bf16_t* z, float* hsl, float* Pc, float* carryP, float* carryH, char* lds) {
  const int c = idx & 63, g = (idx >> 6) & 3, b = idx >> 8;
  const int tid = HTID, lane = tid & 63, w = tid >> 6, fr = lane & 15, fq = lane >> 4;
  bf16_t* xcb = (bf16_t*)lds;
  float* xcf = (float*)(lds + 9216);
  float* aA = (float*)(lds + 9216 + 16384);
  float* bB = (float*)(lds + 9216 + 32768);
  float* sm = (float*)(lds + 9216 + 49152);
  const size_t tokb = (size_t)b * SEQ;
  {
    const int t = tid >> 2, q = tid & 3;
    float accv[16];
#pragma unroll
    for (int i = 0; i < 16; ++i) accv[i] = P.conv_b[layer * 256 + g * 64 + q * 16 + i];
#pragma unroll
    for (int k = 0; k < 4; ++k) {
      const int pos = c * 64 + t - 3 + k;
      if (pos >= 0) {
        const bf16_t* zr = z + (tokb + pos) * LDZ + ZC_BX + g * 64 + q * 16;
        float v[16]; unpack8(*(const u32x4*)zr, v); unpack8(*(const u32x4*)(zr + 8), v + 8);
        const float* cw = P.conv_w + (size_t)(layer * 4 + k) * 256 + g * 64 + q * 16;
#pragma unroll
        for (int i = 0; i < 16; ++i) accv[i] += v[i] * cw[i];
      }
    }
#pragma unroll
    for (int i = 0; i < 16; ++i) { xcf[t * 64 + q * 16 + i] = accv[i]; xcb[t * 72 + q * 16 + i] = f2bf(accv[i]); }
  }
  __syncthreads();
  {
    const bf16_t* wa = (const bf16_t*)(P.ws + OFF_WAT) + (layer * 4 + g) * 4096;
    const bf16_t* wx = (const bf16_t*)(P.ws + OFF_WXT) + (layer * 4 + g) * 4096;
    f32x4 ar[4] = {}, ai[4] = {};
#pragma unroll
    for (int ks = 0; ks < 2; ++ks) {
      const bf16x8 xf = *(const bf16x8*)(xcb + (16 * w + fr) * 72 + ks * 32 + 8 * fq);
#pragma unroll
      for (int jn = 0; jn < 4; ++jn) {
        const bf16x8 fa = *(const bf16x8*)(wa + (jn * 16 + fr) * 64 + ks * 32 + 8 * fq);
        const bf16x8 fx = *(const bf16x8*)(wx + (jn * 16 + fr) * 64 + ks * 32 + 8 * fq);
        ar[jn] = mfma16(fa, xf, ar[jn]); ai[jn] = mfma16(fx, xf, ai[jn]);
      }
    }
    const int t = 16 * w + fr;
#pragma unroll
    for (int jn = 0; jn < 4; ++jn)
#pragma unroll
      for (int e = 0; e < 4; ++e) {
        const int j = jn * 16 + 4 * fq + e, ch = layer * 256 + g * 64 + j;
        const float r = sigm(ar[jn][e] + P.lru_ba[ch]), ig = sigm(ai[jn][e] + P.lru_bx[ch]);
        const float lam = P.lru_lam[ch];
        const float xe = __expf(-lam);
        float m8; asm volatile("v_mov_b32 %0, 0xc1000000" : "=v"(m8));
        const float la = m8 * r * (xe * (1.f - xe * (0.5f - xe * (1.f / 3.f))));
        const float av = __expf(la);
        const float y2 = 2.f * la;
        const float om = -y2 * (1.f + y2 * (0.5f + y2 * ((1.f / 6.f) + y2 * ((1.f / 24.f) + y2 * ((1.f / 120.f) + y2 * (1.f / 720.f))))));
        const float bv = sqrtf(om) * (ig * xcf[t * 64 + j]);
        aA[t * 64 + j] = av; bB[t * 64 + j] = bv;
      }
  }
  __syncthreads();
  {
    const int q = tid >> 6, j = tid & 63;
    float Pq = 1.f, hq = 0.f;
#pragma unroll
    for (int i = 0; i < 16; ++i) { const int t = q * 16 + i; const float av = aA[t * 64 + j], bv = bB[t * 64 + j]; hq = av * hq + bv; Pq *= av; aA[t * 64 + j] = Pq; bB[t * 64 + j] = hq; }
    sm[q * 64 + j] = Pq; sm[256 + q * 64 + j] = hq;
    __syncthreads();
    float Pin = 1.f, Hin = 0.f;
    for (int qq = 0; qq < q; ++qq) { const float pp = sm[qq * 64 + j], hh = sm[256 + qq * 64 + j]; Hin = pp * Hin + hh; Pin *= pp; }
    float hl = 0.f, pl = 1.f;
#pragma unroll
    for (int i = 0; i < 16; ++i) { const int t = q * 16 + i; hl = bB[t * 64 + j] + aA[t * 64 + j] * Hin; pl = aA[t * 64 + j] * Pin;
      const size_t o = (tokb + c * 64 + t) * 256 + g * 64 + j; hsl[o] = hl; Pc[o] = pl; }
    if (q == 3) { const int o = ((b * 4 + g) * 64 + c) * 64 + j; carryP[o] = pl; carryH[o] = hl; }
  }
  __syncthreads();
}

__device__ __forceinline__ void mixB2_item(int idx, const bf16_t* z, const float* hsl, const float* Pc, const float* carryP, const float* carryH, bf16_t* y) {
  const int c = idx & 63, g = (idx >> 6) & 3, b = idx >> 8;
  const int q = HTID >> 6, j = HTID & 63;
  const float* cp = carryP + (size_t)((b * 4 + g) * 64) * 64 + j;
  const float* chh = carryH + (size_t)((b * 4 + g) * 64) * 64 + j;
  float H = 0.f;
  for (int c0 = 0; c0 < c; c0 += 8) {
    float pv[8], hv[8];
#pragma unroll
    for (int i = 0; i < 8; ++i) { const bool ok = c0 + i < c; pv[i] = ok ? cp[(c0 + i) * 64] : 1.f; hv[i] = ok ? chh[(c0 + i) * 64] : 0.f; }
#pragma unroll
    for (int i = 0; i < 8; ++i) H = pv[i] * H + hv[i];
  }
  const size_t tokb = (size_t)b * SEQ + c * 64 + q * 16;
#pragma unroll 4
  for (int i = 0; i < 16; ++i) {
    const size_t o = (tokb + i) * 256 + g * 64 + j;
    const float h = hsl[o] + Pc[o] * H;
    const float gt = bf2f(z[(tokb + i) * LDZ + ZC_BG + g * 64 + j]);
    y[(tokb + i) * 1024 + 256 + g * 64 + j] = f2bf(h * gelu_t(gt));
  }
}

__device__ __forceinline__ void compress_item(const Params& P, int layer, int idx, const bf16_t* z, bf16_t* kcv, char* lds) {
  const int nb = idx & 15, g = (idx >> 4) & 1, b = (idx >> 5) & 7, kv = idx >> 8;
  const int tid = HTID, lane = tid & 63, w = tid >> 6, fr = lane & 15, fq = lane >> 4;
  const int n0 = nb * 16, col = (kv ? ZC_VC : ZC_KC) + g * 64;
  const bf16_t* w1t = (const bf16_t*)(P.ws + OFF_CW1 + (size_t)(layer * 2 + kv) * SZ_CW1);
  float* part = (float*)lds;
  float* hid = (float*)(lds + 34816);
  f32x4 acc[8];
#pragma unroll
  for (int jf = 0; jf < 8; ++jf) acc[jf] = zero4();
  int nn = n0 + fr; if (nn > 254) nn = 254;
  const bf16_t* zb = z + ((size_t)b * SEQ + 16 * nn) * LDZ + col + 8 * fq;
  const bf16_t* wb = w1t + (size_t)fr * 2048 + 8 * fq;
#pragma unroll 4
  for (int kk = 0; kk < 16; ++kk) {
    const int ks = 16 * w + kk, l = ks >> 1, d0 = (ks & 1) * 32;
    const bf16x8 xf = *(const bf16x8*)(zb + (size_t)l * LDZ + d0);
#pragma unroll
    for (int jf = 0; jf < 8; ++jf) { const bf16x8 wf = *(const bf16x8*)(wb + (size_t)jf * 16 * 2048 + ks * 32); acc[jf] = mfma16(wf, xf, acc[jf]); }
  }
#pragma unroll
  for (int jf = 0; jf < 8; ++jf)
#pragma unroll
    for (int e = 0; e < 4; ++e) part[(w * 16 + fr) * 132 + jf * 16 + 4 * fq + e] = acc[jf][e];
  __syncthreads();
  const float* cb1 = (const float*)(P.ws + OFF_CB1) + (layer * 2 + kv) * 128;
  {
    const int n = tid >> 4, j0 = (tid & 15) * 8;
#pragma unroll
    for (int e = 0; e < 8; ++e) { const int j = j0 + e; const float v = ((part[(0 * 16 + n) * 132 + j] + part[(1 * 16 + n) * 132 + j]) + part[(2 * 16 + n) * 132 + j]) + part[(3 * 16 + n) * 132 + j];
      hid[n * 129 + j] = gelu_t(v + cb1[j]); }
  }
  __syncthreads();
  {
    const int n = tid >> 4, d0 = (tid & 15) * 4;
    const float* w2 = P.cmp_w2 + (size_t)(layer * 2 + kv) * 128 * 64 + d0;
    const float4 bb = *(const float4*)(P.cmp_b2 + (layer * 2 + kv) * 64 + d0);
    float o0 = bb.x, o1 = bb.y, o2 = bb.z, o3 = bb.w;
#pragma unroll 8
    for (int j = 0; j < 128; ++j) { const float hv = hid[n * 129 + j]; const float4 wa = *(const float4*)(w2 + j * 64); o0 += hv * wa.x; o1 += hv * wa.y; o2 += hv * wa.z; o3 += hv * wa.w; }
    u32x2 ov; ov.x = pk2(o0, o1); ov.y = pk2(o2, o3);
    if ((n0 + n) >= 255) { ov.x = 0u; ov.y = 0u; }
    *(u32x2*)(kcv + ((size_t)((kv * 8 + b) * 2 + g) * 256 + n0 + n) * 64 + d0) = ov;
  }
  __syncthreads();
}

constexpr int NSA_KT = 0, NSA_VT = 16384, NSA_T = 33792, NSA_TW = NSA_T + 4 * 4160 * 4, NSA_IMP = NSA_TW + 4 * 640 * 4, NSA_WU = NSA_IMP + 2 * 16640;
constexpr int LDS_ST = 147456;
constexpr float LOG2E = 1.4426950408889634f;

__device__ __forceinline__ void nsa_tables(const Params& P, int g, char* lds) {
  float* T = (float*)(lds + NSA_T);
  float* TW = (float*)(lds + NSA_TW);
  const int tid = TIDX;
  for (int i = tid; i < 4160; i += 512) {
    const int n = i - 64;
    int bk = n;
    if (n >= 16) bk = 16 + (n >= 21) + (n >= 27) + (n >= 35) + (n >= 46) + (n >= 59) + (n >= 77) + (n >= 99) + (n >= 128) + (n >= 166) + (n >= 216) + (n >= 280) + (n >= 363) + (n >= 470) + (n >= 609) + (n >= 790);
#pragma unroll
    for (int r = 0; r < 4; ++r) {
      const float v = n >= 0 ? P.rel_bias[bk * 8 + g * 4 + r] * LOG2E : -__builtin_inff();
      T[r * 4160 + i] = v;
      if (i < 640) TW[r * 640 + i] = (n < 512) ? v : -__builtin_inff();
    }
  }
  __syncthreads();
}

struct KVRegs { u32x4 k0, v0; };
__device__ __forceinline__ void kv_gload(KVRegs& r, const bf16_t* kb, const bf16_t* vb, size_t stride) {
  const int tid = TIDX, row = tid >> 3, cq = tid & 7;
  r.k0 = *(const u32x4*)(kb + row * stride + cq * 8); r.v0 = *(const u32x4*)(vb + row * stride + cq * 8);
}
__device__ __forceinline__ void kv_lwrite(const KVRegs& r, char* lds, int buf) {
  const int tid = TIDX, row = tid >> 3, cq = tid & 7;
  char* kt = lds + NSA_KT + buf * 8192 + row * 128;
  *(u32x4*)(kt + ((cq ^ (row & 7)) << 4)) = r.k0;
  bf16_t* vt = (bf16_t*)(lds + NSA_VT + buf * 8704) + (cq * 8) * 68 + row;
#pragma unroll
  for (int i = 0; i < 4; ++i) { vt[(2 * i) * 68] = (bf16_t)(r.v0[i] & 0xffffu); vt[(2 * i + 1) * 68] = (bf16_t)(r.v0[i] >> 16); }
}

template <int MODE>
__device__ __forceinline__ void nsa_compute(int cur, int buf, int t, int hl, u64 mymask, const bf16x8 (&Qf)[2][2], f32x4 (&O)[4][2], float (&m)[2], float (&l)[2],
                                            const float (&inv)[2], float* impw, char* lds) {
  const int lane = TIDX & 63, fr = lane & 15, fq = lane >> 4;
  const char* kt = lds + NSA_KT + buf * 8192;
  const bf16_t* vt = (const bf16_t*)(lds + NSA_VT + buf * 8704);
  const bool selok = (MODE == 2) ? (((mymask >> cur) & 1ull) != 0ull) : true;
  const float* tb = (MODE == 3) ? (const float*)(lds + NSA_TW) + hl * 640 : (const float*)(lds + NSA_T) + hl * 4160;
  constexpr int TS = (MODE == 3) ? 640 : 4160;
  const int base = (MODE <= 1) ? (t - 31 - 16 * (cur * 64 + 4 * fq) + 64) : (t - cur * 64 - 4 * fq + 64);
#pragma unroll
  for (int s2 = 0; s2 < 2; ++s2) {
    f32x4 S[2][2] = {};
#pragma unroll
    for (int ks = 0; ks < 2; ++ks)
#pragma unroll
      for (int kk = 0; kk < 2; ++kk) {
        const bf16x8 kf = *(const bf16x8*)(kt + (32 * s2 + 16 * kk + fr) * 128 + (((ks * 4 + fq) ^ (fr & 7)) << 4));
#pragma unroll
        for (int r = 0; r < 2; ++r) S[kk][r] = mfma16(kf, Qf[r][ks], S[kk][r]);
      }
    bf16x8 Pf[2];
    float g1s[2] = {0.f, 0.f}, p3s[2] = {0.f, 0.f};
#pragma unroll
    for (int r = 0; r < 2; ++r) {
      float sv[2][4];
#pragma unroll
      for (int kk = 0; kk < 2; ++kk)
#pragma unroll
        for (int e = 0; e < 4; ++e) {
          const int off = 32 * s2 + 16 * kk + e;
          int idx;
          if (MODE <= 1) { idx = base - 16 * off; idx = idx > 0 ? idx : 0; } else idx = base - off;
          sv[kk][e] = S[kk][r][e] * (0.125f * LOG2E) + tb[r * TS + idx];
        }
      float pv[2][4];
      if (MODE == 1) {
#pragma unroll
        for (int kk = 0; kk < 2; ++kk)
#pragma unroll
          for (int e = 0; e < 4; ++e) pv[kk][e] = __builtin_amdgcn_exp2f(sv[kk][e] - m[r]) * inv[r];
#pragma unroll
        for (int kk = 0; kk < 2; ++kk) { g1s[kk] += pv[kk][0] + pv[kk][1] + pv[kk][2] + 0.5f * pv[kk][3]; p3s[kk] += 0.5f * pv[kk][3]; }
      } else {
        float mx = fmaxf(fmaxf(fmaxf(sv[0][0], sv[0][1]), fmaxf(sv[0][2], sv[0][3])), fmaxf(fmaxf(sv[1][0], sv[1][1]), fmaxf(sv[1][2], sv[1][3])));
        if (MODE == 2) mx = selok ? mx : -__builtin_inff();
        if (__any(mx > m[r] + 8.0f)) {
          mx = fmaxf(mx, __shfl_xor(mx, 16)); mx = fmaxf(mx, __shfl_xor(mx, 32));
          const float mn = fmaxf(m[r], mx), al = __builtin_amdgcn_exp2f(m[r] - mn);
          m[r] = mn; l[r] *= al;
          if (MODE != 0) {
#pragma unroll
            for (int df = 0; df < 4; ++df) O[df][r] *= al;
          }
        }
        const float me = (MODE == 2) ? (selok ? m[r] : __builtin_inff()) : m[r];
        float ps = 0.f;
#pragma unroll
        for (int kk = 0; kk < 2; ++kk)
#pragma unroll
          for (int e = 0; e < 4; ++e) { pv[kk][e] = __builtin_amdgcn_exp2f(sv[kk][e] - me); ps += pv[kk][e]; }
        l[r] += ps;
      }
      if (MODE != 0) {
        const unsigned w0 = pk2(pv[0][0], pv[0][1]), w1 = pk2(pv[0][2], pv[0][3]), w2 = pk2(pv[1][0], pv[1][1]), w3 = pk2(pv[1][2], pv[1][3]);
        u32x4 pw; pw.x = w0; pw.y = w1; pw.z = w2; pw.w = w3;
        Pf[r] = __builtin_bit_cast(bf16x8, pw);
      }
    }
    if (MODE != 0) {
#pragma unroll
      for (int df = 0; df < 4; ++df) {
        const bf16x4 va = *(const bf16x4*)(vt + (df * 16 + fr) * 68 + 32 * s2 + 4 * fq);
        const bf16x4 vb = *(const bf16x4*)(vt + (df * 16 + fr) * 68 + 32 * s2 + 16 + 4 * fq);
        bf16x8 vf; vf[0] = va[0]; vf[1] = va[1]; vf[2] = va[2]; vf[3] = va[3]; vf[4] = vb[0]; vf[5] = vb[1]; vf[6] = vb[2]; vf[7] = vb[3];
#pragma unroll
        for (int r = 0; r < 2; ++r) O[df][r] = mfma16(vf, Pf[r], O[df][r]);
      }
    }
    if (MODE == 1) {
#pragma unroll
      for (int kk = 0; kk < 2; ++kk) {
        const int j = cur * 16 + (2 * s2 + kk) * 4 + fq;
        atomicAdd(&impw[fr * 65 + j], g1s[kk]);
        if (j + 1 < 64) atomicAdd(&impw[fr * 65 + j + 1], p3s[kk]);
      }
    }
  }
}

template <int MODE>
__device__ __forceinline__ void nsa_branch(int first, int ntl, u64 U, const bf16_t* kbase, const bf16_t* vbase, size_t stride, int t, int hl, u64 mymask,
                                           const bf16x8 (&Qf)[2][2], f32x4 (&O)[4][2], float (&m)[2], float (&l)[2], const float (&inv)[2], float* impw, char* lds) {
  KVRegs R0, R1, R2;
  u64 rem = U;
  int seq = first, left = ntl;
#define NSA_NEXT(dst)                                                                                     \
  { if (MODE == 2) { dst = rem ? (int)__builtin_ctzll(rem) : -1; if (rem) rem &= rem - 1; }              \
    else { dst = left > 0 ? seq : -1; ++seq; --left; } }
#define NSA_GLOAD(R, ti) kv_gload(R, kbase + (size_t)(ti) * 64 * stride, vbase + (size_t)(ti) * 64 * stride, stride)
  int tcur, t1, t2, t3;
  NSA_NEXT(tcur); NSA_NEXT(t1); NSA_NEXT(t2);
  if (tcur >= 0) NSA_GLOAD(R0, tcur);
  if (t1 >= 0) NSA_GLOAD(R1, t1);
  if (t2 >= 0) NSA_GLOAD(R2, t2);
  if (tcur >= 0) kv_lwrite(R0, lds, 0);
  __syncthreads();
  NSA_NEXT(t3);
  if (t3 >= 0) NSA_GLOAD(R0, t3);
  int buf = 0;
#define NSA_STEP(RW)                                                                                      \
  if (tcur < 0) break;                                                                                    \
  nsa_compute<MODE>(tcur, buf, t, hl, mymask, Qf, O, m, l, inv, impw, lds);                               \
  if (t1 >= 0) kv_lwrite(RW, lds, buf ^ 1);                                                               \
  __syncthreads();                                                                                        \
  buf ^= 1; tcur = t1; t1 = t2; t2 = t3;                                                                  \
  NSA_NEXT(t3);                                                                                           \
  if (t3 >= 0) NSA_GLOAD(RW, t3);
  for (;;) {
    NSA_STEP(R1)
    NSA_STEP(R2)
    NSA_STEP(R0)
  }
#undef NSA_STEP
#undef NSA_GLOAD
#undef NSA_NEXT
}

#define NSA_RESET()                                                                         \
  _Pragma("unroll") for (int r = 0; r < 2; ++r) { asm volatile("v_mov_b32 %0, 0xf149f2ca" : "=v"(m[r])); l[r] = 0.f; }               \
  _Pragma("unroll") for (int df = 0; df < 4; ++df) _Pragma("unroll") for (int r = 0; r < 2; ++r) O[df][r] = zero4();

__device__ __forceinline__ void nsa_item(const Params& P, int b, int g, int c, const bf16_t* z, const bf16_t* kcv, bf16_t* y, char* lds) {
  const int tid = TIDX, lane = tid & 63, w8 = tid >> 6, qg = w8 & 3, hp = w8 >> 2, fr = lane & 15, fq = lane >> 4;
  const size_t tokb = (size_t)b * SEQ;
  const int t = c * 64 + 16 * qg + fr;
  const bf16_t* zq = z + (tokb + t) * LDZ;
  const int hb = g * 4 + hp * 2;
  bf16x8 Qf[2][2];
#pragma unroll
  for (int r = 0; r < 2; ++r)
#pragma unroll
    for (int ks = 0; ks < 2; ++ks) Qf[r][ks] = *(const bf16x8*)(zq + ZC_Q + g * 256 + (hp * 2 + r) * 64 + ks * 32 + 8 * fq);
  float* impw = (float*)(lds + NSA_IMP) + (hp * 4 + qg) * (16 * 65);
  for (int i = lane; i < 16 * 65; i += 64) impw[i] = 0.f;
  f32x4 O[4][2];
  float m[2], l[2], inv[2];
  bf16_t* yo = y + (tokb + t) * 1024 + 512 + g * 256 + hp * 128 + 4 * fq;
  const bf16_t* kc = kcv + (size_t)((0 * 8 + b) * 2 + g) * 256 * 64;
  const bf16_t* vc = kcv + (size_t)((1 * 8 + b) * 2 + g) * 256 * 64;
  const int nct = ((4 * c + 2) >> 6) + 1;
  NSA_RESET();
  inv[0] = 0.f; inv[1] = 0.f;
  nsa_branch<0>(0, nct, 0ull, kc, vc, 64, t, hp * 2, 0ull, Qf, O, m, l, inv, impw, lds);
#pragma unroll
  for (int r = 0; r < 2; ++r) { float lt = l[r]; lt += __shfl_xor(lt, 16); lt += __shfl_xor(lt, 32); inv[r] = lt > 0.f ? 1.f / lt : 0.f; }
  nsa_branch<1>(0, nct, 0ull, kc, vc, 64, t, hp * 2, 0ull, Qf, O, m, l, inv, impw, lds);
#pragma unroll
  for (int r = 0; r < 2; ++r) {
    const float gt = sigm(bf2f(zq[ZC_GC + hb + r]));
#pragma unroll
    for (int df = 0; df < 4; ++df) { u32x2 o; o.x = pk2(O[df][r][0] * gt, O[df][r][1] * gt); o.y = pk2(O[df][r][2] * gt, O[df][r][3] * gt); *(u32x2*)(yo + r * 64 + df * 16) = o; }
  }
  __syncthreads();
  u64 wU = 0ull;
  {
    const float* imp0 = (const float*)(lds + NSA_IMP) + qg * (16 * 65);
    const float* imp1 = imp0 + 4 * (16 * 65);
    u64* MK = (u64*)(lds + NSA_WU) + 8;
    const u64 V = (c >= 63) ? ~0ull : ((1ull << (c + 1)) - 1ull);
    const bool forced = (lane == 0) | (lane == c) | (lane == c - 1);
    for (int q8 = 0; q8 < 8; ++q8) {
      const int qq = hp * 8 + q8;
      const float sv = imp0[qq * 65 + lane] + imp1[qq * 65 + lane];
      const unsigned u = __float_as_uint(forced ? 1e4f : sv);
      u64 mk = V;
      if (c + 1 > 16) {
        unsigned thr = 0u;
        for (int bb = 30; bb >= 0; --bb) { const unsigned cand = thr | (1u << bb); const u64 ge = __ballot(u >= cand) & V; if (__popcll(ge) >= 16) thr = cand; }
        const u64 G = __ballot(u > thr) & V, E = __ballot(u == thr) & V;
        const int need = 16 - (int)__popcll(G);
        const int below = (int)__popcll(E & ((1ull << lane) - 1ull));
        const bool se = (((E >> lane) & 1ull) != 0ull) && (below < need);
        mk = G | __ballot(se);
      }
      if (lane == 0) MK[qg * 16 + qq] = mk;
      wU |= mk;
    }
  }
  u64* WU = (u64*)(lds + NSA_WU);
  if (lane == 0) WU[w8] = wU;
  __syncthreads();
  const u64 U = WU[0] | WU[1] | WU[2] | WU[3] | WU[4] | WU[5] | WU[6] | WU[7];
  const u64 mymask = ((const u64*)(lds + NSA_WU) + 8)[qg * 16 + fr];
  for (int br = 0; br < 2; ++br) {
    NSA_RESET();
    int zg;
    if (br == 0) {
      nsa_branch<2>(0, 0, U, z + tokb * LDZ + ZC_KS + g * 64, z + tokb * LDZ + ZC_VS + g * 64, LDZ, t, hp * 2, mymask, Qf, O, m, l, inv, impw, lds);
      zg = ZC_GS;
    } else {
      const int kt0 = c > 8 ? c - 8 : 0;
      nsa_branch<3>(kt0, c - kt0 + 1, 0ull, z + tokb * LDZ + ZC_KW + g * 64, z + tokb * LDZ + ZC_VW + g * 64, LDZ, t, hp * 2, 0ull, Qf, O, m, l, inv, impw, lds);
      zg = ZC_GW;
    }
#pragma unroll
    for (int r = 0; r < 2; ++r) {
      float lt = l[r]; lt += __shfl_xor(lt, 16); lt += __shfl_xor(lt, 32);
      const float gt = sigm(bf2f(zq[zg + hb + r])) * (lt > 0.f ? 1.f / lt : 0.f);
#pragma unroll
      for (int df = 0; df < 4; ++df) {
        bf16_t* yp = yo + r * 64 + df * 16;
        const u32x2 pr = *(const u32x2*)yp;
        u32x2 o; o.x = pk2(__uint_as_float(pr.x << 16) + O[df][r][0] * gt, __uint_as_float(pr.x & 0xffff0000u) + O[df][r][1] * gt);
        o.y = pk2(__uint_as_float(pr.y << 16) + O[df][r][2] * gt, __uint_as_float(pr.y & 0xffff0000u) + O[df][r][3] * gt);
        *(u32x2*)yp = o;
      }
    }
  }
  __syncthreads();
}

__device__ __forceinline__ void run_phase(const Params& P, int ph, char* lds) {
  char* ws = P.ws;
  asm volatile("" : "+s"(ws));
  bf16_t* abuf = (bf16_t*)(ws + OFF_A);
  bf16_t* big = (bf16_t*)(ws + OFF_BIG);
  bf16_t* fbuf = (bf16_t*)(ws + OFF_F);
  bf16_t* h16 = (bf16_t*)(ws + OFF_F + (size_t)M_TOK * 1024 * 2);
  float* hsl = (float*)(ws + OFF_F); float* Pc = hsl + (size_t)M_TOK * 256;
  bf16_t* kcv = (bf16_t*)(ws + OFF_KC);
  float* carryP = (float*)(ws + OFF_CARRY); float* carryH = carryP + 8 * 4 * 64 * 64;
  if (ph == 0) { prep_phase(P, lds); return; }
  const int layer = (ph - 1) / 13, sp = (ph - 1) % 13;
  const float* ng = P.norm_g + (size_t)layer * 8 * 1024;
#ifdef ONLY_SP
  if (sp != ONLY_SP) return;
#endif
  switch (sp) {
    case 0: case 8: {
      const int lj = layer * 2 + (sp == 8);
      gemm_up_phase(abuf, (const bf16_t*)(ws + OFF_WGU + lj * SZ_WGU), big, lds);
    } break;
    case 1: case 9: {
      const int lj = layer * 2 + (sp == 9);
      gemm_bf16_phase(big, DFF, (const bf16_t*)(ws + OFF_WD + lj * SZ_WD), DFF, 4, fbuf, 1024, lds);
    } break;
    case 2: resnorm_phase(layer == 0 ? P.x : nullptr, h16, nullptr, h16, fbuf, 0.5f, ng + 1 * 1024, ng + 2 * 1024, abuf); break;
    case 3: gemm_bf16_phase(abuf, 1024, (const bf16_t*)(ws + OFF_WIN + layer * SZ_WIN), 1024, LDZ / 256, big, LDZ, lds); break;
    case 4: {
      const int hb = HBLK; char* hl = lds + hb * 65536;
      for (int it = blockIdx.x * 2 + hb; it < 512; it += gridDim.x * 2) compress_item(P, layer, it, big, kcv, hl);
      for (int it = blockIdx.x * 2 + hb; it < 1024; it += gridDim.x * 2) mixA_item(P, layer, it, big, abuf, hl);
      for (int it = blockIdx.x * 2 + hb; it < 2048; it += gridDim.x * 2) mixB1_item(P, layer, it, big, hsl, Pc, carryP, carryH, hl);
    } break;
    case 5: {
      nsa_tables(P, blockIdx.x & 1, lds);
      for (int it = blockIdx.x; it < 1024; it += gridDim.x) {
        const int rnd = it / 256, pos = it % 256;
        const int c = (rnd & 1) ? (rnd >> 1) * 16 + (pos >> 4) : 63 - (rnd >> 1) * 16 - (pos >> 4);
        const int bg = pos & 15;
        nsa_item(P, bg >> 1, bg & 1, c, big, kcv, abuf, lds);
      }
      const int hb = HBLK;
      for (int it = blockIdx.x * 2 + hb; it < 2048; it += gridDim.x * 2) mixB2_item(it, big, hsl, Pc, carryP, carryH, abuf);
    } break;
    case 6: gemm_bf16_phase(abuf, 1024, (const bf16_t*)(ws + OFF_WOUT + layer * SZ_SQ), 1024, 4, fbuf, 1024, lds); break;
    case 7: resnorm_phase(nullptr, h16, nullptr, h16, fbuf, 1.0f, ng + 3 * 1024, ng + 4 * 1024, abuf); break;
    case 10:
      gemm_bf16_phase((const bf16_t*)(ws + OFF_PBF) + (size_t)layer * M_TOK * 256, 256, (const bf16_t*)(ws + OFF_WPP + layer * SZ_WPP), 256, 4, big, 1024, lds);
      resnorm_phase(nullptr, h16, nullptr, h16, fbuf, 0.5f, ng + 5 * 1024, ng + 6 * 1024, abuf);
      break;
    case 11: gemm_ple_phase(abuf, (const bf16_t*)(ws + OFF_WPG + layer * SZ_SQ), big, fbuf, lds); break;
    case 12: resnorm_phase(nullptr, h16, layer == 0 ? nullptr : P.out, layer == 0 ? h16 : nullptr, fbuf, 1.0f, ng + 7 * 1024, layer == 0 ? P.norm_g + 8 * 1024 : nullptr, layer == 0 ? abuf : nullptr); break;
  }
}

#define XB_TMO      128
#define XB_XCNT(j)  (256  + 64 * (j))
#define XB_XSUB(j)  (1280 + 64 * (j))
#define XB_XGEN(j)  (2304 + 64 * (j))
#define XB_TOP      3328
#define XB_TOPGEN   3392
#define XCD_BAR_WORDS 3456
#define XB_SPIN_CAP (1u << 20)
#define LAS __attribute__((address_space(3)))
__device__ __forceinline__ unsigned xb_ld(unsigned* p)              { return __hip_atomic_load(p, __ATOMIC_RELAXED, __HIP_MEMORY_SCOPE_AGENT); }
__device__ __forceinline__ unsigned xb_add(unsigned* p, unsigned v) { return __hip_atomic_fetch_add(p, v, __ATOMIC_RELAXED, __HIP_MEMORY_SCOPE_AGENT); }
__device__ __forceinline__ unsigned xb_xcc_id() { return (unsigned)__builtin_amdgcn_s_getreg((3 << 11) | 20) & 0xFu; }
#define XB_SPIN(cond, bar) do { unsigned _sp = 0; while (cond) { __builtin_amdgcn_s_sleep(1); \
    if ((++_sp & 255u) == 0u) { if (xb_ld(&(bar)[XB_TMO])) break; if (_sp > XB_SPIN_CAP) { atomicAdd(&(bar)[XB_TMO], 1u); break; } } } } while (0)
struct XcdBarrier { unsigned* bar; unsigned x; volatile LAS unsigned* st; };
__device__ __forceinline__ XcdBarrier xcd_barrier_post(unsigned* bar, volatile LAS unsigned* st) {
    XcdBarrier b; b.bar = bar; b.x = xb_xcc_id(); b.st = st;
    if (threadIdx.x == 0) (void)xb_add(&bar[XB_XCNT(b.x)], 1u);
    return b;
}
__device__ __forceinline__ void xcd_barrier_complete(unsigned* bar, unsigned x, unsigned& nloc, unsigned& nx) {
    const unsigned G = gridDim.x * gridDim.y * gridDim.z;
    unsigned sum, cnt, mine, sp = 0u;
    for (;;) {
        sum = 0u; cnt = 0u; mine = 0u;
#pragma unroll
        for (unsigned j = 0; j < 16; ++j) { const unsigned c = xb_ld(&bar[XB_XCNT(j)]); sum += c; cnt += (c > 0u) ? 1u : 0u; mine = (j == x) ? c : mine; }
        if (sum == G) break;
        __builtin_amdgcn_s_sleep(1);
        if ((++sp & 255u) == 0u) { if (xb_ld(&bar[XB_TMO])) break; if (sp > XB_SPIN_CAP) { atomicAdd(&bar[XB_TMO], 1u); break; } }
    }
    nloc = mine > 0u ? mine : 1u; nx = cnt > 0u ? cnt : 1u;
}
__device__ __forceinline__ void xcd_barrier(const XcdBarrier& b) {
    asm volatile("s_waitcnt vmcnt(0)" ::: "memory");
    __syncthreads();
    if (threadIdx.x == 0) {
        unsigned* bar = b.bar;
        __builtin_amdgcn_s_waitcnt(0);
        unsigned nloc = b.st[0], nx = b.st[1];
        if (nloc == 0u) { xcd_barrier_complete(bar, b.x, nloc, nx); b.st[0] = nloc; b.st[1] = nx; }
        const unsigned old = xb_add(&bar[XB_XSUB(b.x)], 1u);
        const unsigned gen = old / nloc;
        if (old + 1u == (gen + 1u) * nloc) {
            __builtin_amdgcn_fence(__ATOMIC_RELEASE, "agent");
            asm volatile("s_waitcnt vmcnt(0)" ::: "memory");
            const unsigned og = xb_add(&bar[XB_TOP], 1u);
            const unsigned tg = og / nx;
            if (og + 1u == (tg + 1u) * nx) xb_add(&bar[XB_TOPGEN], 1u);
            else XB_SPIN(xb_ld(&bar[XB_TOPGEN]) == tg, bar);
            __builtin_amdgcn_fence(__ATOMIC_ACQUIRE, "agent");
            xb_add(&bar[XB_XGEN(b.x)], 1u);
            asm volatile("s_waitcnt vmcnt(0)" ::: "memory");
        } else {
            XB_SPIN(xb_ld(&bar[XB_XGEN(b.x)]) == gen, bar);
            __builtin_amdgcn_fence(__ATOMIC_ACQUIRE, "agent");
            asm volatile("s_waitcnt vmcnt(0)" ::: "memory");
        }
    }
    __syncthreads();
}

constexpr int LDS_BYTES = LDS_ST + 16;
__global__ void __launch_bounds__(512, 2) fwd_megakernel(Params P) {
  __shared__ __attribute__((aligned(16))) char lds[LDS_BYTES];
  cg::grid_group grid = cg::this_grid();
  volatile LAS unsigned* st = (volatile LAS unsigned*)(lds + LDS_ST);
  if (threadIdx.x == 0) { st[0] = 0u; st[1] = 0u; }
  __syncthreads();
  XcdBarrier xb = xcd_barrier_post((unsigned*)(P.ws + OFF_BAR), st);
  if (P.ws == nullptr) grid.sync();
  for (int ph = 0; ph < NPHASE; ++ph) {
    run_phase(P, ph, lds);
    if (ph + 1 < NPHASE) xcd_barrier(xb);
  }
}

__global__ void __launch_bounds__(512, 2) phase_kernel(Params P, int ph) {
  __shared__ __attribute__((aligned(16))) char lds[LDS_BYTES];
  run_phase(P, ph, lds);
}

extern "C" void kernel_launch(void* const* d_in, const int* in_sizes, int n_in, void* d_out, int out_size, void* d_ws, size_t ws_size, hipStream_t stream) {
  Params P{};
  const float** pp = (const float**)&P;
  for (int i = 0; i < 26; ++i) pp[i] = (const float*)d_in[i];
  P.out = (float*)d_out;
  P.ws = (char*)d_ws;
  if (ws_size < WS_NEED) { fprintf(stderr, "workspace too small: %zu < %zu\n", ws_size, (size_t)WS_NEED); return; }
#if MK_FUSED
  static int grid_blocks = 0;
  if (!grid_blocks) {
    int dev = 0, cus = 0, per_cu = 0;
    (void)hipGetDevice(&dev);
    (void)hipDeviceGetAttribute(&cus, hipDeviceAttributeMultiprocessorCount, dev);
    (void)hipOccupancyMaxActiveBlocksPerMultiprocessor(&per_cu, fwd_megakernel, 512, 0);
    if (per_cu > 1) per_cu = 1;
    if (per_cu < 1) per_cu = 1;
    grid_blocks = cus * per_cu;
  }
  (void)hipMemsetAsync((char*)d_ws + OFF_BAR, 0, XCD_BAR_WORDS * 4, stream);
  void* args[] = {&P};
  hipError_t e = hipLaunchCooperativeKernel((void*)fwd_megakernel, dim3(grid_blocks), dim3(512), args, 0, stream);
  if (e != hipSuccess) fprintf(stderr, "cooperative launch failed: %s (grid %d)\n", hipGetErrorString(e), grid_blocks);
#else
  for (int ph = 0; ph < NPHASE; ++ph) phase_kernel<<<256, 512, 0, stream>>>(P, ph);
#endif
}
```

```cpp
#include <hip/hip_runtime.h>
#include <hip/hip_cooperative_groups.h>
#include <cstdint>
#include <cstdio>
namespace cg = cooperative_groups;

#ifndef MK_FUSED
#define MK_FUSED 1
#endif

typedef unsigned short bf16_t;
typedef short bf16x8 __attribute__((ext_vector_type(8)));
typedef short bf16x4 __attribute__((ext_vector_type(4)));
typedef float f32x4 __attribute__((ext_vector_type(4)));
typedef unsigned long long u64;
typedef unsigned u32x4 __attribute__((ext_vector_type(4)));
typedef unsigned u32x2 __attribute__((ext_vector_type(2)));

constexpr int M_TOK = 32768, DM = 1024, DFF = 2816, NGU = 5632, NIN = 2328, LDZ = 2560, SEQ = 4096;
constexpr int NPHASE = 27;
constexpr int ZC_AU = 0, ZC_AV = 256, ZC_BX = 512, ZC_BG = 768, ZC_Q = 1024, ZC_KC = 1536, ZC_VC = 1664, ZC_KS = 1792, ZC_VS = 1920,
              ZC_KW = 2048, ZC_VW = 2176, ZC_GC = 2304, ZC_GS = 2312, ZC_GW = 2320;

constexpr size_t SZ_WGU = (size_t)NGU * 1024 * 2, SZ_WD = (size_t)1024 * DFF * 2, SZ_WIN = (size_t)LDZ * 1024 * 2, SZ_SQ = (size_t)1024 * 1024 * 2,
                 SZ_WPP = (size_t)1024 * 256 * 2, SZ_CW1 = (size_t)128 * 2048 * 2;
constexpr size_t OFF_WGU = 0;
constexpr size_t OFF_WD = OFF_WGU + 4 * SZ_WGU;
constexpr size_t OFF_WIN = OFF_WD + 4 * SZ_WD;
constexpr size_t OFF_WOUT = OFF_WIN + 2 * SZ_WIN;
constexpr size_t OFF_WPG = OFF_WOUT + 2 * SZ_SQ;
constexpr size_t OFF_WPP = OFF_WPG + 2 * SZ_SQ;
constexpr size_t OFF_CW1 = OFF_WPP + 2 * SZ_WPP;
constexpr size_t OFF_CB1 = OFF_CW1 + 4 * SZ_CW1;
constexpr size_t OFF_SGUW = OFF_CB1 + 4096;
constexpr size_t OFF_WAT = OFF_SGUW + 2 * 4 * 128 * 128 * 2;
constexpr size_t OFF_WXT = OFF_WAT + 2 * 4 * 64 * 64 * 2;
constexpr size_t OFF_PBF = OFF_WXT + 2 * 4 * 64 * 64 * 2;
constexpr size_t OFF_A = OFF_PBF + (size_t)2 * M_TOK * 256 * 2;
constexpr size_t OFF_BIG = OFF_A + (size_t)M_TOK * 1024 * 2;
constexpr size_t OFF_F = OFF_BIG + (size_t)M_TOK * DFF * 2;
constexpr size_t OFF_KC = OFF_F + (size_t)M_TOK * 1024 * 4;
constexpr size_t OFF_CARRY = OFF_KC + (size_t)2 * 8 * 2 * 256 * 64 * 2;
constexpr size_t OFF_BAR = OFF_CARRY + (size_t)2 * 8 * 4 * 64 * 64 * 4;
constexpr size_t WS_NEED = OFF_BAR + 16384;

struct Params {
  const float *x, *p, *rel_bias, *norm_g, *ffn_wg, *ffn_wu, *ffn_wd, *w_in, *w_out, *sgu_ng, *sgu_w, *sgu_b, *conv_w, *conv_b,
      *lru_wa, *lru_ba, *lru_wx, *lru_bx, *lru_lam, *cmp_pos, *cmp_w1, *cmp_b1, *cmp_w2, *cmp_b2, *ple_wg, *ple_wp;
  float* out;
  char* ws;
};

__device__ __forceinline__ int opaque_tid() { int t; asm volatile("v_mov_b32 %0, %1" : "=v"(t) : "v"(threadIdx.x)); return t; }
#define TIDX opaque_tid()
#define HTID (opaque_tid() & 255)
#define HBLK (opaque_tid() >> 8)
__device__ __forceinline__ float bf2f(bf16_t v) { return __uint_as_float(((unsigned)v) << 16); }
__device__ __forceinline__ bf16_t f2bf(float f) { unsigned u = __float_as_uint(f); u += 0x7fffu + ((u >> 16) & 1u); return (bf16_t)(u >> 16); }
typedef float f32x2v __attribute__((ext_vector_type(2)));
typedef __bf16 bf16x2v __attribute__((ext_vector_type(2)));
__device__ __forceinline__ unsigned pk2(float lo, float hi) { const f32x2v v = {lo, hi}; const bf16x2v r = __builtin_convertvector(v, bf16x2v); return __builtin_bit_cast(unsigned, r); }
__device__ __forceinline__ float sigm(float x) { return __builtin_amdgcn_rcpf(1.f + __expf(-x)); }
__device__ __forceinline__ float gelu_t(float x) { float u = 0.7978845608028654f * (x + 0.044715f * x * x * x); return x * __builtin_amdgcn_rcpf(1.f + __expf(-2.f * u)); }
__device__ __forceinline__ float silu_f(float x) { return x * __builtin_amdgcn_rcpf(1.f + __expf(-x)); }
__device__ __forceinline__ f32x4 mfma16(bf16x8 a, bf16x8 b, f32x4 c) { return __builtin_amdgcn_mfma_f32_16x16x32_bf16(a, b, c, 0, 0, 0); }
__device__ __forceinline__ void glds16(const void* g, void* l) {
  __builtin_amdgcn_global_load_lds((const __attribute__((address_space(1))) unsigned*)g, (__attribute__((address_space(3))) unsigned*)l, 16, 0, 0);
}
__device__ __forceinline__ f32x4 zero4() { f32x4 z; asm volatile("v_mov_b32 %0, 0\n\tv_mov_b32 %1, 0\n\tv_mov_b32 %2, 0\n\tv_mov_b32 %3, 0" : "=v"(z[0]), "=v"(z[1]), "=v"(z[2]), "=v"(z[3])); return z; }
__device__ __forceinline__ float wave_sum(float v) {
#pragma unroll
  for (int o = 32; o > 0; o >>= 1) v += __shfl_xor(v, o);
  return v;
}
__device__ __forceinline__ void unpack8(const u32x4 u, float* f) {
  f[0] = __uint_as_float(u.x << 16); f[1] = __uint_as_float(u.x & 0xffff0000u);
  f[2] = __uint_as_float(u.y << 16); f[3] = __uint_as_float(u.y & 0xffff0000u);
  f[4] = __uint_as_float(u.z << 16); f[5] = __uint_as_float(u.z & 0xffff0000u);
  f[6] = __uint_as_float(u.w << 16); f[7] = __uint_as_float(u.w & 0xffff0000u);
}

__device__ __forceinline__ void tr_cvt(const float* __restrict__ src, int N, int K, bf16_t* __restrict__ dst, int ldd, int rs, int ro, char* ldsc) {
  const int ntn = (N + 63) >> 6, nt = ntn * (K >> 6), hb = HBLK, tid = HTID;
  float* lds = (float*)(ldsc + hb * 65536);
  for (int t0 = blockIdx.x * 6; t0 < nt; t0 += gridDim.x * 6) {
    float4 v[3][4];
#pragma unroll
    for (int u = 0; u < 3; ++u) {
      const int tile = t0 + hb * 3 + u, tk = tile / ntn, tn = tile - tk * ntn, k0 = tk * 64, n0 = tn * 64;
      const bool active = tile < nt;
#pragma unroll
      for (int ps = 0; ps < 4; ++ps) {
        const int i = ps * 16 + (tid >> 4), j = (tid & 15) * 4;
        v[u][ps] = make_float4(0.f, 0.f, 0.f, 0.f);
        if (active && n0 + j < N) v[u][ps] = *(const float4*)(src + (size_t)(k0 + i) * N + n0 + j);
      }
    }
#pragma unroll
    for (int u = 0; u < 3; ++u)
#pragma unroll
      for (int ps = 0; ps < 4; ++ps) {
        const int i = ps * 16 + (tid >> 4), j = (tid & 15) * 4;
        float* d = lds + u * 4160 + i * 65 + j; d[0] = v[u][ps].x; d[1] = v[u][ps].y; d[2] = v[u][ps].z; d[3] = v[u][ps].w;
      }
    __syncthreads();
#pragma unroll
    for (int u = 0; u < 3; ++u) {
      const int tile = t0 + hb * 3 + u, tk = tile / ntn, tn = tile - tk * ntn, k0 = tk * 64, n0 = tn * 64;
      const int j = tid >> 2, kq = tid & 3, n = n0 + j;
      if (tile < nt && n < N) {
        const float* l = lds + u * 4160;
        unsigned w[8];
#pragma unroll
        for (int q = 0; q < 8; ++q) w[q] = pk2(l[(kq * 16 + 2 * q) * 65 + j], l[(kq * 16 + 2 * q + 1) * 65 + j]);
        bf16_t* o = dst + (size_t)((n >> 4) * rs + (n & 15) + ro) * ldd + k0 + kq * 16;
        u32x4 w0, w1; w0.x = w[0]; w0.y = w[1]; w0.z = w[2]; w0.w = w[3]; w1.x = w[4]; w1.y = w[5]; w1.z = w[6]; w1.w = w[7];
        *(u32x4*)o = w0; *(u32x4*)(o + 8) = w1;
      }
    }
    __syncthreads();
  }
}

struct RowRegs { float4 h[4]; u32x2 f[4]; };
__device__ __forceinline__ void rn_load(RowRegs& R, const float* hin32, const bf16_t* hin16, const bf16_t* f, int row, int lane) {
  if (hin32) {
#pragma unroll
    for (int i = 0; i < 4; ++i) R.h[i] = *(const float4*)(hin32 + (size_t)row * 1024 + i * 256 + lane * 4);
  } else {
#pragma unroll
    for (int i = 0; i < 4; ++i) { const u32x2 v = *(const u32x2*)(hin16 + (size_t)row * 1024 + i * 256 + lane * 4);
      R.h[i].x = __uint_as_float(v.x << 16); R.h[i].y = __uint_as_float(v.x & 0xffff0000u); R.h[i].z = __uint_as_float(v.y << 16); R.h[i].w = __uint_as_float(v.y & 0xffff0000u); }
  }
  if (f) {
#pragma unroll
    for (int i = 0; i < 4; ++i) R.f[i] = *(const u32x2*)(f + (size_t)row * 1024 + i * 256 + lane * 4);
  }
}
__device__ __forceinline__ void rn_proc(RowRegs& R, float* hout32, bf16_t* hout16, bool has_f, float scale, const float4 (&gpo)[4], const float4 (&gpr)[4], bf16_t* a, int row, int lane) {
  if (has_f) {
    float fv[4][4]; float ss = 0.f;
#pragma unroll
    for (int i = 0; i < 4; ++i) {
      fv[i][0] = __uint_as_float(R.f[i].x << 16); fv[i][1] = __uint_as_float(R.f[i].x & 0xffff0000u);
      fv[i][2] = __uint_as_float(R.f[i].y << 16); fv[i][3] = __uint_as_float(R.f[i].y & 0xffff0000u);
      ss += fv[i][0] * fv[i][0] + fv[i][1] * fv[i][1] + fv[i][2] * fv[i][2] + fv[i][3] * fv[i][3];
    }
    ss = wave_sum(ss);
    const float r = rsqrtf(ss * (1.f / 1024.f) + 1e-6f) * scale;
#pragma unroll
    for (int i = 0; i < 4; ++i) { const float4 g = gpo[i];
      R.h[i].x += fv[i][0] * r * g.x; R.h[i].y += fv[i][1] * r * g.y; R.h[i].z += fv[i][2] * r * g.z; R.h[i].w += fv[i][3] * r * g.w; }
  }
  if (hout32) {
#pragma unroll
    for (int i = 0; i < 4; ++i) *(float4*)(hout32 + (size_t)row * 1024 + i * 256 + lane * 4) = R.h[i];
  }
  if (hout16) {
#pragma unroll
    for (int i = 0; i < 4; ++i) { u32x2 o; o.x = pk2(R.h[i].x, R.h[i].y); o.y = pk2(R.h[i].z, R.h[i].w); *(u32x2*)(hout16 + (size_t)row * 1024 + i * 256 + lane * 4) = o; }
  }
  if (a) {
    float ss = 0.f;
#pragma unroll
    for (int i = 0; i < 4; ++i) ss += R.h[i].x * R.h[i].x + R.h[i].y * R.h[i].y + R.h[i].z * R.h[i].z + R.h[i].w * R.h[i].w;
    ss = wave_sum(ss);
    const float r = rsqrtf(ss * (1.f / 1024.f) + 1e-6f);
#pragma unroll
    for (int i = 0; i < 4; ++i) { const float4 g = gpr[i];
      u32x2 o; o.x = pk2(R.h[i].x * r * g.x, R.h[i].y * r * g.y); o.y = pk2(R.h[i].z * r * g.z, R.h[i].w * r * g.w);
      *(u32x2*)(a + (size_t)row * 1024 + i * 256 + lane * 4) = o; }
  }
}
__device__ __forceinline__ void resnorm_phase(const float* hin32, const bf16_t* hin16, float* hout32, bf16_t* hout16, const bf16_t* f, float scale, const float* gpost, const float* gpre, bf16_t* a) {
  const int tid = TIDX, lane = tid & 63, stride = gridDim.x * 8;
  int r0 = blockIdx.x * 8 + (tid >> 6), r1 = r0 + 2 * stride;
  RowRegs A0, A1, B0, B1;
  float4 gpo[4], gpr[4];
#pragma unroll
  for (int i = 0; i < 4; ++i) { gpo[i] = f ? *(const float4*)(gpost + i * 256 + lane * 4) : make_float4(0.f, 0.f, 0.f, 0.f); gpr[i] = a ? *(const float4*)(gpre + i * 256 + lane * 4) : make_float4(0.f, 0.f, 0.f, 0.f); }
  const bool hf = f != nullptr;
  if (r0 < M_TOK) { rn_load(A0, hin32, hin16, f, r0, lane); rn_load(A1, hin32, hin16, f, r0 + stride, lane); }
  for (;;) {
    if (r0 >= M_TOK) break;
    if (r1 < M_TOK) { rn_load(B0, hin32, hin16, f, r1, lane); rn_load(B1, hin32, hin16, f, r1 + stride, lane); }
    rn_proc(A0, hout32, hout16, hf, scale, gpo, gpr, a, r0, lane); rn_proc(A1, hout32, hout16, hf, scale, gpo, gpr, a, r0 + stride, lane);
    r0 += 4 * stride;
    if (r1 >= M_TOK) break;
    if (r0 < M_TOK) { rn_load(A0, hin32, hin16, f, r0, lane); rn_load(A1, hin32, hin16, f, r0 + stride, lane); }
    rn_proc(B0, hout32, hout16, hf, scale, gpo, gpr, a, r1, lane); rn_proc(B1, hout32, hout16, hf, scale, gpo, gpr, a, r1 + stride, lane);
    r1 += 4 * stride;
  }
}

__device__ __forceinline__ void prep_phase(const Params& P, char* ldsc) {
  char* ws = P.ws;
  for (int l = 0; l < 2; ++l) {
    for (int j = 0; j < 2; ++j) {
      const int lj = l * 2 + j;
      bf16_t* wgu = (bf16_t*)(ws + OFF_WGU + lj * SZ_WGU);
      tr_cvt(P.ffn_wg + (size_t)lj * 1024 * DFF, DFF, 1024, wgu, 1024, 32, 0, ldsc);
      tr_cvt(P.ffn_wu + (size_t)lj * 1024 * DFF, DFF, 1024, wgu, 1024, 32, 16, ldsc);
      tr_cvt(P.ffn_wd + (size_t)lj * DFF * 1024, 1024, DFF, (bf16_t*)(ws + OFF_WD + lj * SZ_WD), DFF, 16, 0, ldsc);
      tr_cvt(P.cmp_w1 + (size_t)lj * 2048 * 128, 128, 2048, (bf16_t*)(ws + OFF_CW1 + lj * SZ_CW1), 2048, 16, 0, ldsc);
    }
    tr_cvt(P.w_in + (size_t)l * 1024 * NIN, NIN, 1024, (bf16_t*)(ws + OFF_WIN + l * SZ_WIN), 1024, 16, 0, ldsc);
    tr_cvt(P.w_out + (size_t)l * 1024 * 1024, 1024, 1024, (bf16_t*)(ws + OFF_WOUT + l * SZ_SQ), 1024, 16, 0, ldsc);
    tr_cvt(P.ple_wg + (size_t)l * 1024 * 1024, 1024, 1024, (bf16_t*)(ws + OFF_WPG + l * SZ_SQ), 1024, 16, 0, ldsc);
    tr_cvt(P.ple_wp + (size_t)l * 256 * 1024, 1024, 256, (bf16_t*)(ws + OFF_WPP + l * SZ_WPP), 256, 16, 0, ldsc);
    for (int g = 0; g < 4; ++g) {
      tr_cvt(P.lru_wa + (size_t)(l * 4 + g) * 4096, 64, 64, (bf16_t*)(ws + OFF_WAT) + (l * 4 + g) * 4096, 64, 16, 0, ldsc);
      tr_cvt(P.lru_wx + (size_t)(l * 4 + g) * 4096, 64, 64, (bf16_t*)(ws + OFF_WXT) + (l * 4 + g) * 4096, 64, 16, 0, ldsc);
    }
  }
  const int tid = TIDX, gtid = blockIdx.x * 512 + tid, gn = gridDim.x * 512;
  for (int i = gtid; i < 2 * (LDZ - NIN) * 1024 / 8; i += gn) {
    const int l = i / ((LDZ - NIN) * 128), r = i - l * ((LDZ - NIN) * 128);
    *(f32x4*)((bf16_t*)(ws + OFF_WIN + l * SZ_WIN) + (size_t)NIN * 1024 + (size_t)r * 8) = zero4();
  }
  for (int i = gtid; i < 2 * 4 * 128 * 128; i += gn) { const int t = (i >> 7) & 127, s2 = i & 127; ((bf16_t*)(ws + OFF_SGUW))[i] = (s2 <= t) ? f2bf(P.sgu_w[i]) : (bf16_t)0; }
  for (int i = gtid; i < 2 * M_TOK * 256 / 4; i += gn) { const float4 v = ((const float4*)P.p)[i]; uint2 o; o.x = pk2(v.x, v.y); o.y = pk2(v.z, v.w); ((uint2*)(ws + OFF_PBF))[i] = o; }
  {
    float* lds = (float*)(ldsc + HBLK * 65536);
    for (int u = blockIdx.x; u < 4; u += gridDim.x) {
      const int t2 = HTID, kq = t2 >> 5, jq = t2 & 31;
      const float* w1 = P.cmp_w1 + (size_t)u * 2048 * 128; const float* pos = P.cmp_pos + (size_t)u * 2048;
      float4 sacc = make_float4(0.f, 0.f, 0.f, 0.f);
      for (int k = kq * 256; k < kq * 256 + 256; ++k) { const float pv = pos[k]; const float4 w = *(const float4*)(w1 + (size_t)k * 128 + jq * 4); sacc.x += pv * w.x; sacc.y += pv * w.y; sacc.z += pv * w.z; sacc.w += pv * w.w; }
      __syncthreads();
      lds[kq * 128 + jq * 4 + 0] = sacc.x; lds[kq * 128 + jq * 4 + 1] = sacc.y; lds[kq * 128 + jq * 4 + 2] = sacc.z; lds[kq * 128 + jq * 4 + 3] = sacc.w;
      __syncthreads();
      if (t2 < 128) { float t = P.cmp_b1[u * 128 + t2]; for (int q = 0; q < 8; ++q) t += lds[q * 128 + t2]; ((float*)(ws + OFF_CB1))[u * 128 + t2] = t; }
      __syncthreads();
    }
  }
  resnorm_phase(P.x, nullptr, nullptr, nullptr, nullptr, 0.f, nullptr, P.norm_g, (bf16_t*)(ws + OFF_A));
}

constexpr int G8_HT = 128 * 64;
__device__ __forceinline__ int g8_lds_byte(int r, int c) { const int st = (r >> 4) * 2 + (c >> 5), rr = r & 15, cc = c & 31, ob = rr * 64 + cc * 2; return st * 1024 + (ob ^ (((ob >> 9) & 1) << 5)); }
__device__ __forceinline__ void g8_stage_rc(int b, int& R, int& C) { const int st = b / 1024, sb = b % 1024, swz = sb ^ (((sb >> 9) & 1) << 5); R = (st >> 1) * 16 + swz / 64; C = (st & 1) * 32 + (swz % 64) / 2; }

template <bool ISSUE_ONLY, bool PRE_ISSUED>
__device__ __forceinline__ void gemm_core(f32x4 (&acc)[2][2][4][2], const bf16_t* __restrict__ A, int lda, const bf16_t* __restrict__ Bt, int ldb, int K, char* ldsc) {
  bf16_t* shm = (bf16_t*)ldsc;
  const int tid = TIDX, wid = tid >> 6, lane = tid & 63, wr = wid >> 2, wc = wid & 3, fr = lane & 15, fq = lane >> 4;
  int sr0, sc0;
  g8_stage_rc(tid * 16, sr0, sc0);
  const bf16_t* gA0 = A + (size_t)sr0 * lda + sc0;
  const bf16_t* gB0 = Bt + (size_t)sr0 * ldb + sc0;
  const size_t a64 = (size_t)64 * lda, b64 = (size_t)64 * ldb;
  const int lane_off = (fr * 64 + fq * 16) ^ ((((fr * 64 + fq * 16) >> 9) & 1) << 5);
  const char* ldA = ldsc + wr * 8192 + lane_off;
  const char* ldB = ldsc + 65536 + wc * 4096 + lane_off;
#define SA(b, h) (shm + ((b) * 2 + (h)) * G8_HT)
#define SB(b, h) (shm + (4 + (b) * 2 + (h)) * G8_HT)
#define STAGE_A(P, h, kt) { const bf16_t* g_ = gA0 + (size_t)(h) * 2 * a64 + (kt) * 64; glds16(g_, (char*)(P) + tid * 16); glds16(g_ + a64, (char*)(P) + tid * 16 + 8192); }
#define STAGE_B(P, h, kt) { const bf16_t* g_ = gB0 + (size_t)(h) * 2 * b64 + (kt) * 64; glds16(g_, (char*)(P) + tid * 16); glds16(g_ + b64, (char*)(P) + tid * 16 + 8192); }
#define LDA(dst, b, h) _Pragma("unroll") for (int m = 0; m < 4; ++m) _Pragma("unroll") for (int k = 0; k < 2; ++k) \
    dst[m][k] = *reinterpret_cast<const bf16x8*>(ldA + ((b) * 2 + (h)) * 16384 + (m * 2 + k) * 1024)
#define LDB(dst, b, h) _Pragma("unroll") for (int n = 0; n < 2; ++n) _Pragma("unroll") for (int k = 0; k < 2; ++k) \
    dst[n][k] = *reinterpret_cast<const bf16x8*>(ldB + ((b) * 2 + (h)) * 16384 + (n * 2 + k) * 1024)
#define MMA(ai, bj, At_, Bt_) do { __builtin_amdgcn_s_setprio(1); \
    _Pragma("unroll") for (int m = 0; m < 4; ++m) _Pragma("unroll") for (int n = 0; n < 2; ++n) _Pragma("unroll") for (int k = 0; k < 2; ++k) \
      acc[ai][bj][m][n] = mfma16(Bt_[n][k], At_[m][k], acc[ai][bj][m][n]); \
    __builtin_amdgcn_s_setprio(0); } while (0)
#define WAIT_V(n) asm volatile("s_waitcnt vmcnt(" #n ")" ::: "memory")
#define WAIT_L(n) asm volatile("s_waitcnt lgkmcnt(" #n ")" ::: "memory")
#define BAR __builtin_amdgcn_s_barrier()
#define SCHED __builtin_amdgcn_sched_barrier(0)
  bf16x8 At[4][2], B0[2][2], B1[2][2];
  const int nt = K >> 6;
  if (!PRE_ISSUED) {
    STAGE_B(SB(0, 0), 0, 0); STAGE_A(SA(0, 0), 0, 0);
    STAGE_B(SB(0, 1), 1, 0); STAGE_A(SA(0, 1), 1, 0);
  }
  if (ISSUE_ONLY) return;
  if (wr == 1) BAR;
  if (PRE_ISSUED) { WAIT_V(0); } else { WAIT_V(4); }
  BAR;
  STAGE_B(SB(1, 0), 0, 1); STAGE_A(SA(1, 0), 0, 1); STAGE_B(SB(1, 1), 1, 1);
  WAIT_V(6); BAR;
#pragma nounroll
  for (int t = 0; t < nt - 2; t += 2) {
    LDB(B0, 0, 0); SCHED; LDA(At, 0, 0); STAGE_A(SA(1, 1), 1, t + 1);
    WAIT_L(8); BAR; WAIT_L(0); MMA(0, 0, At, B0); BAR; SCHED;
    LDB(B1, 0, 1); STAGE_B(SB(0, 0), 0, t + 2);
    BAR; WAIT_L(0); MMA(0, 1, At, B1); BAR;
    LDA(At, 0, 1); STAGE_A(SA(0, 0), 0, t + 2);
    BAR; WAIT_L(0); MMA(1, 0, At, B0); BAR; SCHED;
    STAGE_B(SB(0, 1), 1, t + 2);
    WAIT_V(6); BAR; MMA(1, 1, At, B1); BAR;
    LDB(B0, 1, 0); SCHED; LDA(At, 1, 0); STAGE_A(SA(0, 1), 1, t + 2);
    WAIT_L(8); BAR; WAIT_L(0); MMA(0, 0, At, B0); BAR; SCHED;
    LDB(B1, 1, 1); STAGE_B(SB(1, 0), 0, t + 3);
    BAR; WAIT_L(0); MMA(0, 1, At, B1); BAR;
    LDA(At, 1, 1); STAGE_A(SA(1, 0), 0, t + 3);
    BAR; WAIT_L(0); MMA(1, 0, At, B0); BAR; SCHED;
    STAGE_B(SB(1, 1), 1, t + 3);
    WAIT_V(6); BAR; MMA(1, 1, At, B1); BAR;
  }
  { LDB(B0, 0, 0); LDA(At, 0, 0); STAGE_A(SA(1, 1), 1, nt - 1);
    BAR; WAIT_L(0); MMA(0, 0, At, B0); BAR;
    LDB(B1, 0, 1); BAR; WAIT_L(0); MMA(0, 1, At, B1); BAR;
    LDA(At, 0, 1); WAIT_V(4); BAR; WAIT_L(0); MMA(1, 0, At, B0); MMA(1, 1, At, B1); BAR; }
  { LDB(B0, 1, 0); LDA(At, 1, 0); WAIT_V(2); BAR; WAIT_L(0); MMA(0, 0, At, B0); BAR;
    LDB(B1, 1, 1); WAIT_V(0); BAR; WAIT_L(0); MMA(0, 1, At, B1); BAR;
    LDA(At, 1, 1); BAR; WAIT_L(0); MMA(1, 0, At, B0); MMA(1, 1, At, B1); BAR; }
  if (wr == 0) BAR;
  BAR;
#undef SA
#undef SB
#undef STAGE_A
#undef STAGE_B
#undef LDA
#undef LDB
#undef MMA
#undef WAIT_V
#undef WAIT_L
#undef BAR
#undef SCHED
}

struct TileIt {
  int TN, npc, npatch, slot, nslot, pid, s, tm, tn;
  __device__ __forceinline__ void init(int TN_) { TN = TN_; npc = (TN + 1) >> 1; npatch = 8 * npc; slot = blockIdx.x >> 3; nslot = gridDim.x >> 3; pid = blockIdx.x & 7; s = slot - nslot; }
  __device__ __forceinline__ bool next() {
    for (;;) {
      s += nslot;
      if (s >= 32) { s = slot; pid += 8; }
      if (pid >= npatch) return false;
      const int pr = pid / npc, pc = pid - pr * npc;
      tm = pr * 16 + (s & 15); tn = pc * 2 + (s >> 4);
      if (tn < TN) return true;
    }
  }
};

#define GEMM_LANE const int tid_ = TIDX, lane_ = tid_ & 63, wid_ = tid_ >> 6, wr = wid_ >> 2, wc = wid_ & 3, fr = lane_ & 15, fq = lane_ >> 4
#define GEMM_EPI_LOOP _Pragma("unroll") for (int ai = 0; ai < 2; ++ai) _Pragma("unroll") for (int m = 0; m < 4; ++m) _Pragma("unroll") for (int bj = 0; bj < 2; ++bj)

template <class Epi> __device__ __forceinline__ void gemm_phase(const bf16_t* A, int lda, const bf16_t* Bt, int ldb, int K, int TN, char* lds, Epi&& epi) {
  TileIt it; it.init(TN);
  bool have = it.next();
  f32x4 acc[2][2][4][2];
  if (have) gemm_core<true, false>(acc, A + (size_t)it.tm * 256 * lda, lda, Bt + (size_t)it.tn * 256 * ldb, ldb, K, lds);
  while (have) {
    const int tm = it.tm, tn = it.tn;
#pragma unroll
    for (int i0 = 0; i0 < 2; ++i0)
#pragma unroll
      for (int i1 = 0; i1 < 2; ++i1)
#pragma unroll
        for (int i2 = 0; i2 < 4; ++i2)
#pragma unroll
          for (int i3 = 0; i3 < 2; ++i3) acc[i0][i1][i2][i3] = zero4();
    gemm_core<false, true>(acc, A + (size_t)tm * 256 * lda, lda, Bt + (size_t)tn * 256 * ldb, ldb, K, lds);
    have = it.next();
    if (have) { f32x4 dummy[2][2][4][2]; gemm_core<true, false>(dummy, A + (size_t)it.tm * 256 * lda, lda, Bt + (size_t)it.tn * 256 * ldb, ldb, K, lds); }
    epi(acc, tm, tn);
  }
  asm volatile("s_waitcnt vmcnt(0)" ::: "memory");
}

__device__ __forceinline__ void gemm_up_phase(const bf16_t* a, const bf16_t* wgu, bf16_t* act, char* lds) {
  gemm_phase(a, 1024, wgu, 1024, 1024, NGU / 256, lds, [&](f32x4 (&acc)[2][2][4][2], int tm, int tn) {
    GEMM_LANE;
    GEMM_EPI_LOOP {
      const int row = tm * 256 + ai * 128 + wr * 64 + m * 16 + fr;
      const int col = tn * 128 + bj * 64 + wc * 16 + 4 * fq;
      const f32x4 g = acc[ai][bj][m][0], u = acc[ai][bj][m][1];
      u32x2 o; o.x = pk2(silu_f(g[0]) * u[0], silu_f(g[1]) * u[1]); o.y = pk2(silu_f(g[2]) * u[2], silu_f(g[3]) * u[3]);
      *(u32x2*)(act + (size_t)row * DFF + col) = o;
    }
  });
}

__device__ __forceinline__ void gemm_bf16_phase(const bf16_t* A, int lda, const bf16_t* Bt, int K, int TN, bf16_t* out, int ldo, char* lds) {
  gemm_phase(A, lda, Bt, K, K, TN, lds, [&](f32x4 (&acc)[2][2][4][2], int tm, int tn) {
    GEMM_LANE;
    GEMM_EPI_LOOP {
      const int row = tm * 256 + ai * 128 + wr * 64 + m * 16 + fr;
#pragma unroll
      for (int n = 0; n < 2; ++n) {
        u32x2 o; o.x = pk2(acc[ai][bj][m][n][0], acc[ai][bj][m][n][1]); o.y = pk2(acc[ai][bj][m][n][2], acc[ai][bj][m][n][3]);
        *(u32x2*)(out + (size_t)row * ldo + tn * 256 + bj * 128 + wc * 32 + n * 16 + 4 * fq) = o;
      }
    }
  });
}

__device__ __forceinline__ void gemm_ple_phase(const bf16_t* a, const bf16_t* wpg, const bf16_t* pp, bf16_t* out, char* lds) {
  gemm_phase(a, 1024, wpg, 1024, 1024, 4, lds, [&](f32x4 (&acc)[2][2][4][2], int tm, int tn) {
    GEMM_LANE;
    GEMM_EPI_LOOP {
      const int row = tm * 256 + ai * 128 + wr * 64 + m * 16 + fr;
#pragma unroll
      for (int n = 0; n < 2; ++n) {
        const int col = tn * 256 + bj * 128 + wc * 32 + n * 16 + 4 * fq;
        const u32x2 pv = *(const u32x2*)(pp + (size_t)row * 1024 + col);
        const f32x4 av = acc[ai][bj][m][n];
        u32x2 o;
        o.x = pk2(sigm(av[0]) * __uint_as_float(pv.x << 16), sigm(av[1]) * __uint_as_float(pv.x & 0xffff0000u));
        o.y = pk2(sigm(av[2]) * __uint_as_float(pv.y << 16), sigm(av[3]) * __uint_as_float(pv.y & 0xffff0000u));
        *(u32x2*)(out + (size_t)row * 1024 + col) = o;
      }
    }
  });
}

__device__ __forceinline__ void mixA_item(const Params& P, int layer, int idx, const bf16_t* z, bf16_t* y, char* lds) {
  const int g = idx & 3, bc = idx >> 2, tok0 = bc * 128;
  const int tid = HTID, lane = tid & 63, w = tid >> 6, fr = lane & 15, fq = lane >> 4;
  bf16_t* vT = (bf16_t*)lds;
  const float* ng = P.sgu_ng + layer * 256;
  {
    const int s = tid >> 1, half = tid & 1;
    const bf16_t* zr = z + (size_t)(tok0 + s) * LDZ + ZC_AV;
    float ss = 0.f;
#pragma unroll 4
    for (int i = 0; i < 16; ++i) { float v[8]; unpack8(*(const u32x4*)(zr + half * 128 + i * 8), v);
#pragma unroll
      for (int e = 0; e < 8; ++e) { const float t = gelu_t(v[e]); ss += t * t; } }
    ss += __shfl_xor(ss, 1);
    const float rs = rsqrtf(ss * (1.f / 256.f) + 1e-6f);
#pragma unroll
    for (int i = 0; i < 4; ++i) { float v[8]; unpack8(*(const u32x4*)(zr + g * 64 + half * 32 + i * 8), v);
#pragma unroll
      for (int e = 0; e < 8; ++e) { const int d = half * 32 + i * 8 + e; vT[d * 136 + s] = f2bf(gelu_t(v[e]) * rs * ng[g * 64 + d]); } }
  }
  __syncthreads();
  const bf16_t* W = (const bf16_t*)(P.ws + OFF_SGUW) + (size_t)((layer * 4 + g) * 128) * 128;
  f32x4 acc[2][4] = {};
  for (int ks = 0; ks <= w; ++ks) {
    bf16x8 wf[2], vf[4];
#pragma unroll
    for (int tm = 0; tm < 2; ++tm) wf[tm] = *(const bf16x8*)(W + (size_t)(32 * w + tm * 16 + fr) * 128 + ks * 32 + 8 * fq);
#pragma unroll
    for (int dn = 0; dn < 4; ++dn) vf[dn] = *(const bf16x8*)(vT + (dn * 16 + fr) * 136 + ks * 32 + 8 * fq);
#pragma unroll
    for (int tm = 0; tm < 2; ++tm)
#pragma unroll
      for (int dn = 0; dn < 4; ++dn) acc[tm][dn] = mfma16(vf[dn], wf[tm], acc[tm][dn]);
  }
#pragma unroll
  for (int tm = 0; tm < 2; ++tm) {
    const int t = 32 * w + tm * 16 + fr;
    const float bias = P.sgu_b[(layer * 4 + g) * 128 + t];
#pragma unroll
    for (int dn = 0; dn < 4; ++dn) {
      const int d = dn * 16 + 4 * fq;
      const uint2 uu = *(const uint2*)(z + (size_t)(tok0 + t) * LDZ + ZC_AU + g * 64 + d);
      const float u0 = gelu_t(__uint_as_float(uu.x << 16)), u1 = gelu_t(__uint_as_float(uu.x & 0xffff0000u)),
                  u2 = gelu_t(__uint_as_float(uu.y << 16)), u3 = gelu_t(__uint_as_float(uu.y & 0xffff0000u));
      uint2 o; o.x = pk2(u0 * (acc[tm][dn][0] + bias), u1 * (acc[tm][dn][1] + bias)); o.y = pk2(u2 * (acc[tm][dn][2] + bias), u3 * (acc[tm][dn][3] + bias));
      *(uint2*)(y + (size_t)(tok0 + t) * 1024 + g * 64 + d) = o;
    }
  }
  __syncthreads();
}

__device__ __forceinline__ void mixB1_item(const Params& P, int layer, int idx, const bf16_t* z, float* hsl, float* Pc, float* carryP, float* carryH, char* lds) {
  const int c = idx & 63, g = (idx >> 6) & 3, b = idx >> 8;
  const int tid = HTID, lane = tid & 63, w = tid >> 6, fr = lane & 15, fq = lane >> 4;
  bf16_t* xcb = (bf16_t*)lds;
  float* xcf = (float*)(lds + 9216);
  float* aA = (float*)(lds + 9216 + 16384);
  float* bB = (float*)(lds + 9216 + 32768);
  float* sm = (float*)(lds + 9216 + 49152);
  const size_t tokb = (size_t)b * SEQ;
  {
    const int t = tid >> 2, q = tid & 3;
    float accv[16];
#pragma unroll
    for (int i = 0; i < 16; ++i) accv[i] = P.conv_b[layer * 256 + g * 64 + q * 16 + i];
#pragma unroll
    for (int k = 0; k < 4; ++k) {
      const int pos = c * 64 + t - 3 + k;
      if (pos >= 0) {
        const bf16_t* zr = z + (tokb + pos) * LDZ + ZC_BX + g * 64 + q * 16;
        float v[16]; unpack8(*(const u32x4*)zr, v); unpack8(*(const u32x4*)(zr + 8), v + 8);
        const float* cw = P.conv_w + (size_t)(layer * 4 + k) * 256 + g * 64 + q * 16;
#pragma unroll
        for (int i = 0; i < 16; ++i) accv[i] += v[i] * cw[i];
      }
    }
#pragma unroll
    for (int i = 0; i < 16; ++i) { xcf[t * 64 + q * 16 + i] = accv[i]; xcb[t * 72 + q * 16 + i] = f2bf(accv[i]); }
  }
  __syncthreads();
  {
    const bf16_t* wa = (const bf16_t*)(P.ws + OFF_WAT) + (layer * 4 + g) * 4096;
    const bf16_t* wx = (const bf16_t*)(P.ws + OFF_WXT) + (layer * 4 + g) * 4096;
    f32x4 ar[4] = {}, ai[4] = {};
#pragma unroll
    for (int ks = 0; ks < 2; ++ks) {
      const bf16x8 xf = *(const bf16x8*)(xcb + (16 * w + fr) * 72 + ks * 32 + 8 * fq);
#pragma unroll
      for (int jn = 0; jn < 4; ++jn) {
        const bf16x8 fa = *(const bf16x8*)(wa + (jn * 16 + fr) * 64 + ks * 32 + 8 * fq);
        const bf16x8 fx = *(const bf16x8*)(wx + (jn * 16 + fr) * 64 + ks * 32 + 8 * fq);
        ar[jn] = mfma16(fa, xf, ar[jn]); ai[jn] = mfma16(fx, xf, ai[jn]);
      }
    }
    const int t = 16 * w + fr;
#pragma unroll
    for (int jn = 0; jn < 4; ++jn)
#pragma unroll
      for (int e = 0; e < 4; ++e) {
        const int j = jn * 16 + 4 * fq + e, ch = layer * 256 + g * 64 + j;
        const float r = sigm(ar[jn][e] + P.lru_ba[ch]), ig = sigm(ai[jn][e] + P.lru_bx[ch]);
        const float lam = P.lru_lam[ch];
        const float xe = __expf(-lam);
        float m8; asm volatile("v_mov_b32 %0, 0xc1000000" : "=v"(m8));
        const float la = m8 * r * (xe * (1.f - xe * (0.5f - xe * (1.f / 3.f))));
        const float av = __expf(la);
        const float y2 = 2.f * la;
        const float om = -y2 * (1.f + y2 * (0.5f + y2 * ((1.f / 6.f) + y2 * ((1.f / 24.f) + y2 * ((1.f / 120.f) + y2 * (1.f / 720.f))))));
        const float bv = sqrtf(om) * (ig * xcf[t * 64 + j]);
        aA[t * 64 + j] = av; bB[t * 64 + j] = bv;
      }
  }
  __syncthreads();
  {
    const int q = tid >> 6, j = tid & 63;
    float Pq = 1.f, hq = 0.f;
#pragma unroll
    for (int i = 0; i < 16; ++i) { const int t = q * 16 + i; const float av = aA[t * 64 + j], bv = bB[t * 64 + j]; hq = av * hq + bv; Pq *= av; aA[t * 64 + j] = Pq; bB[t * 64 + j] = hq; }
    sm[q * 64 + j] = Pq; sm[256 + q * 64 + j] = hq;
    __syncthreads();
    float Pin = 1.f, Hin = 0.f;
    for (int qq = 0; qq < q; ++qq) { const float pp = sm[qq * 64 + j], hh = sm[256 + qq * 64 + j]; Hin = pp * Hin + hh; Pin *= pp; }
    float hl = 0.f, pl = 1.f;
#pragma unroll
    for (int i = 0; i < 16; ++i) { const int t = q * 16 + i; hl = bB[t * 64 + j] + aA[t * 64 + j] * Hin; pl = aA[t * 64 + j] * Pin;
      const size_t o = (tokb + c * 64 + t) * 256 + g * 64 + j; hsl[o] = hl; Pc[o] = pl; }
    if (q == 3) { const int o = ((b * 4 + g) * 64 + c) * 64 + j; carryP[o] = pl; carryH[o] = hl; }
  }
  __syncthreads();
}

__device__ __forceinline__ void mixB2_item(int idx, const bf16_t* z, const float* hsl, const float* Pc, const float* carryP, const float* carryH, bf16_t* y) {
  const int c = idx & 63, g = (idx >> 6) & 3, b = idx >> 8;
  const int q = HTID >> 6, j = HTID & 63;
  const float* cp = carryP + (size_t)((b * 4 + g) * 64) * 64 + j;
  const float* chh = carryH + (size_t)((b * 4 + g) * 64) * 64 + j;
  float H = 0.f;
  for (int c0 = 0; c0 < c; c0 += 8) {
    float pv[8], hv[8];
#pragma unroll
    for (int i = 0; i < 8; ++i) { const bool ok = c0 + i < c; pv[i] = ok ? cp[(c0 + i) * 64] : 1.f; hv[i] = ok ? chh[(c0 + i) * 64] : 0.f; }
#pragma unroll
    for (int i = 0; i < 8; ++i) H = pv[i] * H + hv[i];
  }
  const size_t tokb = (size_t)b * SEQ + c * 64 + q * 16;
#pragma unroll 4
  for (int i = 0; i < 16; ++i) {
    const size_t o = (tokb + i) * 256 + g * 64 + j;
    const float h = hsl[o] + Pc[o] * H;
    const float gt = bf2f(z[(tokb + i) * LDZ + ZC_BG + g * 64 + j]);
    y[(tokb + i) * 1024 + 256 + g * 64 + j] = f2bf(h * gelu_t(gt));
  }
}

__device__ __forceinline__ void compress_item(const Params& P, int layer, int idx, const bf16_t* z, bf16_t* kcv, char* lds) {
  const int nb = idx & 15, g = (idx >> 4) & 1, b = (idx >> 5) & 7, kv = idx >> 8;
  const int tid = HTID, lane = tid & 63, w = tid >> 6, fr = lane & 15, fq = lane >> 4;
  const int n0 = nb * 16, col = (kv ? ZC_VC : ZC_KC) + g * 64;
  const bf16_t* w1t = (const bf16_t*)(P.ws + OFF_CW1 + (size_t)(layer * 2 + kv) * SZ_CW1);
  float* part = (float*)lds;
  float* hid = (float*)(lds + 34816);
  f32x4 acc[8];
#pragma unroll
  for (int jf = 0; jf < 8; ++jf) acc[jf] = zero4();
  int nn = n0 + fr; if (nn > 254) nn = 254;
  const bf16_t* zb = z + ((size_t)b * SEQ + 16 * nn) * LDZ + col + 8 * fq;
  const bf16_t* wb = w1t + (size_t)fr * 2048 + 8 * fq;
#pragma unroll 4
  for (int kk = 0; kk < 16; ++kk) {
    const int ks = 16 * w + kk, l = ks >> 1, d0 = (ks & 1) * 32;
    const bf16x8 xf = *(const bf16x8*)(zb + (size_t)l * LDZ + d0);
#pragma unroll
    for (int jf = 0; jf < 8; ++jf) { const bf16x8 wf = *(const bf16x8*)(wb + (size_t)jf * 16 * 2048 + ks * 32); acc[jf] = mfma16(wf, xf, acc[jf]); }
  }
#pragma unroll
  for (int jf = 0; jf < 8; ++jf)
#pragma unroll
    for (int e = 0; e < 4; ++e) part[(w * 16 + fr) * 132 + jf * 16 + 4 * fq + e] = acc[jf][e];
  __syncthreads();
  const float* cb1 = (const float*)(P.ws + OFF_CB1) + (layer * 2 + kv) * 128;
  {
    const int n = tid >> 4, j0 = (tid & 15) * 8;
#pragma unroll
    for (int e = 0; e < 8; ++e) { const int j = j0 + e; const float v = ((part[(0 * 16 + n) * 132 + j] + part[(1 * 16 + n) * 132 + j]) + part[(2 * 16 + n) * 132 + j]) + part[(3 * 16 + n) * 132 + j];
      hid[n * 129 + j] = gelu_t(v + cb1[j]); }
  }
  __syncthreads();
  {
    const int n = tid >> 4, d0 = (tid & 15) * 4;
    const float* w2 = P.cmp_w2 + (size_t)(layer * 2 + kv) * 128 * 64 + d0;
    const float4 bb = *(const float4*)(P.cmp_b2 + (layer * 2 + kv) * 64 + d0);
    float o0 = bb.x, o1 = bb.y, o2 = bb.z, o3 = bb.w;
#pragma unroll 8
    for (int j = 0; j < 128; ++j) { const float hv = hid[n * 129 + j]; const float4 wa = *(const float4*)(w2 + j * 64); o0 += hv * wa.x; o1 += hv * wa.y; o2 += hv * wa.z; o3 += hv * wa.w; }
    u32x2 ov; ov.x = pk2(o0, o1); ov.y = pk2(o2, o3);
    if ((n0 + n) >= 255) { ov.x = 0u; ov.y = 0u; }
    *(u32x2*)(kcv + ((size_t)((kv * 8 + b) * 2 + g) * 256 + n0 + n) * 64 + d0) = ov;
  }
  __syncthreads();
}

constexpr int NSA_KT = 0, NSA_VT = 16384, NSA_T = 33792, NSA_TW = NSA_T + 4 * 4160 * 4, NSA_IMP = NSA_TW + 4 * 640 * 4, NSA_WU = NSA_IMP + 2 * 16640;
constexpr int LDS_ST = 147456;
constexpr float LOG2E = 1.4426950408889634f;

__device__ __forceinline__ void nsa_tables(const Params& P, int g, char* lds) {
  float* T = (float*)(lds + NSA_T);
  float* TW = (float*)(lds + NSA_TW);
  const int tid = TIDX;
  for (int i = tid; i < 4160; i += 512) {
    const int n = i - 64;
    int bk = n;
    if (n >= 16) bk = 16 + (n >= 21) + (n >= 27) + (n >= 35) + (n >= 46) + (n >= 59) + (n >= 77) + (n >= 99) + (n >= 128) + (n >= 166) + (n >= 216) + (n >= 280) + (n >= 363) + (n >= 470) + (n >= 609) + (n >= 790);
#pragma unroll
    for (int r = 0; r < 4; ++r) {
      const float v = n >= 0 ? P.rel_bias[bk * 8 + g * 4 + r] * LOG2E : -__builtin_inff();
      T[r * 4160 + i] = v;
      if (i < 640) TW[r * 640 + i] = (n < 512) ? v : -__builtin_inff();
    }
  }
  __syncthreads();
}

struct KVRegs { u32x4 k0, v0; };
__device__ __forceinline__ void kv_gload(KVRegs& r, const bf16_t* kb, const bf16_t* vb, size_t stride) {
  const int tid = TIDX, row = tid >> 3, cq = tid & 7;
  r.k0 = *(const u32x4*)(kb + row * stride + cq * 8); r.v0 = *(const u32x4*)(vb + row * stride + cq * 8);
}
__device__ __forceinline__ void kv_lwrite(const KVRegs& r, char* lds, int buf) {
  const int tid = TIDX, row = tid >> 3, cq = tid & 7;
  char* kt = lds + NSA_KT + buf * 8192 + row * 128;
  *(u32x4*)(kt + ((cq ^ (row & 7)) << 4)) = r.k0;
  bf16_t* vt = (bf16_t*)(lds + NSA_VT + buf * 8704) + (cq * 8) * 68 + row;
#pragma unroll
  for (int i = 0; i < 4; ++i) { vt[(2 * i) * 68] = (bf16_t)(r.v0[i] & 0xffffu); vt[(2 * i + 1) * 68] = (bf16_t)(r.v0[i] >> 16); }
}

template <int MODE>
__device__ __forceinline__ void nsa_compute(int cur, int buf, int t, int hl, u64 mymask, const bf16x8 (&Qf)[2][2], f32x4 (&O)[4][2], float (&m)[2], float (&l)[2],
                                            const float (&inv)[2], float* impw, char* lds) {
  const int lane = TIDX & 63, fr = lane & 15, fq = lane >> 4;
  const char* kt = lds + NSA_KT + buf * 8192;
  const bf16_t* vt = (const bf16_t*)(lds + NSA_VT + buf * 8704);
  const bool selok = (MODE == 2) ? (((mymask >> cur) & 1ull) != 0ull) : true;
  const float* tb = (MODE == 3) ? (const float*)(lds + NSA_TW) + hl * 640 : (const float*)(lds + NSA_T) + hl * 4160;
  constexpr int TS = (MODE == 3) ? 640 : 4160;
  const int base = (MODE <= 1) ? (t - 31 - 16 * (cur * 64 + 4 * fq) + 64) : (t - cur * 64 - 4 * fq + 64);
#pragma unroll
  for (int s2 = 0; s2 < 2; ++s2) {
    f32x4 S[2][2] = {};
#pragma unroll
    for (int ks = 0; ks < 2; ++ks)
#pragma unroll
      for (int kk = 0; kk < 2; ++kk) {
        const bf16x8 kf = *(const bf16x8*)(kt + (32 * s2 + 16 * kk + fr) * 128 + (((ks * 4 + fq) ^ (fr & 7)) << 4));
#pragma unroll
        for (int r = 0; r < 2; ++r) S[kk][r] = mfma16(kf, Qf[r][ks], S[kk][r]);
      }
    bf16x8 Pf[2];
    float g1s[2] = {0.f, 0.f}, p3s[2] = {0.f, 0.f};
#pragma unroll
    for (int r = 0; r < 2; ++r) {
      float sv[2][4];
#pragma unroll
      for (int kk = 0; kk < 2; ++kk)
#pragma unroll
        for (int e = 0; e < 4; ++e) {
          const int off = 32 * s2 + 16 * kk + e;
          int idx;
          if (MODE <= 1) { idx = base - 16 * off; idx = idx > 0 ? idx : 0; } else idx = base - off;
          sv[kk][e] = S[kk][r][e] * (0.125f * LOG2E) + tb[r * TS + idx];
        }
      float pv[2][4];
      if (MODE == 1) {
#pragma unroll
        for (int kk = 0; kk < 2; ++kk)
#pragma unroll
          for (int e = 0; e < 4; ++e) pv[kk][e] = __builtin_amdgcn_exp2f(sv[kk][e] - m[r]) * inv[r];
#pragma unroll
        for (int kk = 0; kk < 2; ++kk) { g1s[kk] += pv[kk][0] + pv[kk][1] + pv[kk][2] + 0.5f * pv[kk][3]; p3s[kk] += 0.5f * pv[kk][3]; }
      } else {
        float mx = fmaxf(fmaxf(fmaxf(sv[0][0], sv[0][1]), fmaxf(sv[0][2], sv[0][3])), fmaxf(fmaxf(sv[1][0], sv[1][1]), fmaxf(sv[1][2], sv[1][3])));
        if (MODE == 2) mx = selok ? mx : -__builtin_inff();
        if (__any(mx > m[r] + 8.0f)) {
          mx = fmaxf(mx, __shfl_xor(mx, 16)); mx = fmaxf(mx, __shfl_xor(mx, 32));
          const float mn = fmaxf(m[r], mx), al = __builtin_amdgcn_exp2f(m[r] - mn);
          m[r] = mn; l[r] *= al;
          if (MODE != 0) {
#pragma unroll
            for (int df = 0; df < 4; ++df) O[df][r] *= al;
          }
        }
        const float me = (MODE == 2) ? (selok ? m[r] : __builtin_inff()) : m[r];
        float ps = 0.f;
#pragma unroll
        for (int kk = 0; kk < 2; ++kk)
#pragma unroll
          for (int e = 0; e < 4; ++e) { pv[kk][e] = __builtin_amdgcn_exp2f(sv[kk][e] - me); ps += pv[kk][e]; }
        l[r] += ps;
      }
      if (MODE != 0) {
        const unsigned w0 = pk2(pv[0][0], pv[0][1]), w1 = pk2(pv[0][2], pv[0][3]), w2 = pk2(pv[1][0], pv[1][1]), w3 = pk2(pv[1][2], pv[1][3]);
        u32x4 pw; pw.x = w0; pw.y = w1; pw.z = w2; pw.w = w3;
        Pf[r] = __builtin_bit_cast(bf16x8, pw);
      }
    }
    if (MODE != 0) {
#pragma unroll
      for (int df = 0; df < 4; ++df) {
        const bf16x4 va = *(const bf16x4*)(vt + (df * 16 + fr) * 68 + 32 * s2 + 4 * fq);
        const bf16x4 vb = *(const bf16x4*)(vt + (df * 16 + fr) * 68 + 32 * s2 + 16 + 4 * fq);
        bf16x8 vf; vf[0] = va[0]; vf[1] = va[1]; vf[2] = va[2]; vf[3] = va[3]; vf[4] = vb[0]; vf[5] = vb[1]; vf[6] = vb[2]; vf[7] = vb[3];
#pragma unroll
        for (int r = 0; r < 2; ++r) O[df][r] = mfma16(vf, Pf[r], O[df][r]);
      }
    }
    if (MODE == 1) {
#pragma unroll
      for (int kk = 0; kk < 2; ++kk) {
        const int j = cur * 16 + (2 * s2 + kk) * 4 + fq;
        atomicAdd(&impw[fr * 65 + j], g1s[kk]);
        if (j + 1 < 64) atomicAdd(&impw[fr * 65 + j + 1], p3s[kk]);
      }
    }
  }
}

template <int MODE>
__device__ __forceinline__ void nsa_branch(int first, int ntl, u64 U, const bf16_t* kbase, const bf16_t* vbase, size_t stride, int t, int hl, u64 mymask,
                                           const bf16x8 (&Qf)[2][2], f32x4 (&O)[4][2], float (&m)[2], float (&l)[2], const float (&inv)[2], float* impw, char* lds) {
  KVRegs R0, R1, R2;
  u64 rem = U;
  int seq = first, left = ntl;
#define NSA_NEXT(dst)                                                                                     \
  { if (MODE == 2) { dst = rem ? (int)__builtin_ctzll(rem) : -1; if (rem) rem &= rem - 1; }              \
    else { dst = left > 0 ? seq : -1; ++seq; --left; } }
#define NSA_GLOAD(R, ti) kv_gload(R, kbase + (size_t)(ti) * 64 * stride, vbase + (size_t)(ti) * 64 * stride, stride)
  int tcur, t1, t2, t3;
  NSA_NEXT(tcur); NSA_NEXT(t1); NSA_NEXT(t2);
  if (tcur >= 0) NSA_GLOAD(R0, tcur);
  if (t1 >= 0) NSA_GLOAD(R1, t1);
  if (t2 >= 0) NSA_GLOAD(R2, t2);
  if (tcur >= 0) kv_lwrite(R0, lds, 0);
  __syncthreads();
  NSA_NEXT(t3);
  if (t3 >= 0) NSA_GLOAD(R0, t3);
  int buf = 0;
#define NSA_STEP(RW)                                                                                      \
  if (tcur < 0) break;                                                                                    \
  nsa_compute<MODE>(tcur, buf, t, hl, mymask, Qf, O, m, l, inv, impw, lds);                               \
  if (t1 >= 0) kv_lwrite(RW, lds, buf ^ 1);                                                               \
  __syncthreads();                                                                                        \
  buf ^= 1; tcur = t1; t1 = t2; t2 = t3;                                                                  \
  NSA_NEXT(t3);                                                                                           \
  if (t3 >= 0) NSA_GLOAD(RW, t3);
  for (;;) {
    NSA_STEP(R1)
    NSA_STEP(R2)
    NSA_STEP(R0)
  }
#undef NSA_STEP
#undef NSA_GLOAD
#undef NSA_NEXT
}

#define NSA_RESET()                                                                         \
  _Pragma("unroll") for (int r = 0; r < 2; ++r) { asm volatile("v_mov_b32 %0, 0xf149f2ca" : "=v"(m[r])); l[r] = 0.f; }               \
  _Pragma("unroll") for (int df = 0; df < 4; ++df) _Pragma("unroll") for (int r = 0; r < 2; ++r) O[df][r] = zero4();

__device__ __forceinline__ void nsa_item(const Params& P, int b, int g, int c, const bf16_t* z, const bf16_t* kcv, bf16_t* y, char* lds) {
  const int tid = TIDX, lane = tid & 63, w8 = tid >> 6, qg = w8 & 3, hp = w8 >> 2, fr = lane & 15, fq = lane >> 4;
  const size_t tokb = (size_t)b * SEQ;
  const int t = c * 64 + 16 * qg + fr;
  const bf16_t* zq = z + (tokb + t) * LDZ;
  const int hb = g * 4 + hp * 2;
  bf16x8 Qf[2][2];
#pragma unroll
  for (int r = 0; r < 2; ++r)
#pragma unroll
    for (int ks = 0; ks < 2; ++ks) Qf[r][ks] = *(const bf16x8*)(zq + ZC_Q + g * 256 + (hp * 2 + r) * 64 + ks * 32 + 8 * fq);
  float* impw = (float*)(lds + NSA_IMP) + (hp * 4 + qg) * (16 * 65);
  for (int i = lane; i < 16 * 65; i += 64) impw[i] = 0.f;
  f32x4 O[4][2];
  float m[2], l[2], inv[2];
  bf16_t* yo = y + (tokb + t) * 1024 + 512 + g * 256 + hp * 128 + 4 * fq;
  const bf16_t* kc = kcv + (size_t)((0 * 8 + b) * 2 + g) * 256 * 64;
  const bf16_t* vc = kcv + (size_t)((1 * 8 + b) * 2 + g) * 256 * 64;
  const int nct = ((4 * c + 2) >> 6) + 1;
  NSA_RESET();
  inv[0] = 0.f; inv[1] = 0.f;
  nsa_branch<0>(0, nct, 0ull, kc, vc, 64, t, hp * 2, 0ull, Qf, O, m, l, inv, impw, lds);
#pragma unroll
  for (int r = 0; r < 2; ++r) { float lt = l[r]; lt += __shfl_xor(lt, 16); lt += __shfl_xor(lt, 32); inv[r] = lt > 0.f ? 1.f / lt : 0.f; }
  nsa_branch<1>(0, nct, 0ull, kc, vc, 64, t, hp * 2, 0ull, Qf, O, m, l, inv, impw, lds);
#pragma unroll
  for (int r = 0; r < 2; ++r) {
    const float gt = sigm(bf2f(zq[ZC_GC + hb + r]));
#pragma unroll
    for (int df = 0; df < 4; ++df) { u32x2 o; o.x = pk2(O[df][r][0] * gt, O[df][r][1] * gt); o.y = pk2(O[df][r][2] * gt, O[df][r][3] * gt); *(u32x2*)(yo + r * 64 + df * 16) = o; }
  }
  __syncthreads();
  u64 wU = 0ull;
  {
    const float* imp0 = (const float*)(lds + NSA_IMP) + qg * (16 * 65);
    const float* imp1 = imp0 + 4 * (16 * 65);
    u64* MK = (u64*)(lds + NSA_WU) + 8;
    const u64 V = (c >= 63) ? ~0ull : ((1ull << (c + 1)) - 1ull);
    const bool forced = (lane == 0) | (lane == c) | (lane == c - 1);
    for (int q8 = 0; q8 < 8; ++q8) {
      const int qq = hp * 8 + q8;
      const float sv = imp0[qq * 65 + lane] + imp1[qq * 65 + lane];
      const unsigned u = __float_as_uint(forced ? 1e4f : sv);
      u64 mk = V;
      if (c + 1 > 16) {
        unsigned thr = 0u;
        for (int bb = 30; bb >= 0; --bb) { const unsigned cand = thr | (1u << bb); const u64 ge = __ballot(u >= cand) & V; if (__popcll(ge) >= 16) thr = cand; }
        const u64 G = __ballot(u > thr) & V, E = __ballot(u == thr) & V;
        const int need = 16 - (int)__popcll(G);
        const int below = (int)__popcll(E & ((1ull << lane) - 1ull));
        const bool se = (((E >> lane) & 1ull) != 0ull) && (below < need);
        mk = G | __ballot(se);
      }
      if (lane == 0) MK[qg * 16 + qq] = mk;
      wU |= mk;
    }
  }
  u64* WU = (u64*)(lds + NSA_WU);
  if (lane == 0) WU[w8] = wU;
  __syncthreads();
  const u64 U = WU[0] | WU[1] | WU[2] | WU[3] | WU[4] | WU[5] | WU[6] | WU[7];
  const u64 mymask = ((const u64*)(lds + NSA_WU) + 8)[qg * 16 + fr];
  for (int br = 0; br < 2; ++br) {
    NSA_RESET();
    int zg;
    if (br == 0) {
      nsa_branch<2>(0, 0, U, z + tokb * LDZ + ZC_KS + g * 64, z + tokb * LDZ + ZC_VS + g * 64, LDZ, t, hp * 2, mymask, Qf, O, m, l, inv, impw, lds);
      zg = ZC_GS;
    } else {
      const int kt0 = c > 8 ? c - 8 : 0;
      nsa_branch<3>(kt0, c - kt0 + 1, 0ull, z + tokb * LDZ + ZC_KW + g * 64, z + tokb * LDZ + ZC_VW + g * 64, LDZ, t, hp * 2, 0ull, Qf, O, m, l, inv, impw, lds);
      zg = ZC_GW;
    }
#pragma unroll
    for (int r = 0; r < 2; ++r) {
      float lt = l[r]; lt += __shfl_xor(lt, 16); lt += __shfl_xor(lt, 32);
      const float gt = sigm(bf2f(zq[zg + hb + r])) * (lt > 0.f ? 1.f / lt : 0.f);
#pragma unroll
      for (int df = 0; df < 4; ++df) {
        bf16_t* yp = yo + r * 64 + df * 16;
        const u32x2 pr = *(const u32x2*)yp;
        u32x2 o; o.x = pk2(__uint_as_float(pr.x << 16) + O[df][r][0] * gt, __uint_as_float(pr.x & 0xffff0000u) + O[df][r][1] * gt);
        o.y = pk2(__uint_as_float(pr.y << 16) + O[df][r][2] * gt, __uint_as_float(pr.y & 0xffff0000u) + O[df][r][3] * gt);
        *(u32x2*)yp = o;
      }
    }
  }
  __syncthreads();
}

__device__ __forceinline__ void run_phase(const Params& P, int ph, char* lds) {
  char* ws = P.ws;
  asm volatile("" : "+s"(ws));
  bf16_t* abuf = (bf16_t*)(ws + OFF_A);
  bf16_t* big = (bf16_t*)(ws + OFF_BIG);
  bf16_t* fbuf = (bf16_t*)(ws + OFF_F);
  bf16_t* h16 = (bf16_t*)(ws + OFF_F + (size_t)M_TOK * 1024 * 2);
  float* hsl = (float*)(ws + OFF_F); float* Pc = hsl + (size_t)M_TOK * 256;
  bf16_t* kcv = (bf16_t*)(ws + OFF_KC);
  float* carryP = (float*)(ws + OFF_CARRY); float* carryH = carryP + 8 * 4 * 64 * 64;
  if (ph == 0) { prep_phase(P, lds); return; }
  const int layer = (ph - 1) / 13, sp = (ph - 1) % 13;
  const float* ng = P.norm_g + (size_t)layer * 8 * 1024;
#ifdef ONLY_SP
  if (sp != ONLY_SP) return;
#endif
  switch (sp) {
    case 0: case 8: {
      const int lj = layer * 2 + (sp == 8);
      gemm_up_phase(abuf, (const bf16_t*)(ws + OFF_WGU + lj * SZ_WGU), big, lds);
    } break;
    case 1: case 9: {
      const int lj = layer * 2 + (sp == 9);
      gemm_bf16_phase(big, DFF, (const bf16_t*)(ws + OFF_WD + lj * SZ_WD), DFF, 4, fbuf, 1024, lds);
    } break;
    case 2: resnorm_phase(layer == 0 ? P.x : nullptr, h16, nullptr, h16, fbuf, 0.5f, ng + 1 * 1024, ng + 2 * 1024, abuf); break;
    case 3: gemm_bf16_phase(abuf, 1024, (const bf16_t*)(ws + OFF_WIN + layer * SZ_WIN), 1024, LDZ / 256, big, LDZ, lds); break;
    case 4: {
      const int hb = HBLK; char* hl = lds + hb * 65536;
      for (int it = blockIdx.x * 2 + hb; it < 512; it += gridDim.x * 2) compress_item(P, layer, it, big, kcv, hl);
      for (int it = blockIdx.x * 2 + hb; it < 1024; it += gridDim.x * 2) mixA_item(P, layer, it, big, abuf, hl);
      for (int it = blockIdx.x * 2 + hb; it < 2048; it += gridDim.x * 2) mixB1_item(P, layer, it, big, hsl, Pc, carryP, carryH, hl);
    } break;
    case 5: {
      nsa_tables(P, blockIdx.x & 1, lds);
      for (int it = blockIdx.x; it < 1024; it += gridDim.x) {
        const int rnd = it / 256, pos = it % 256;
        const int c = (rnd & 1) ? (rnd >> 1) * 16 + (pos >> 4) : 63 - (rnd >> 1) * 16 - (pos >> 4);
        const int bg = pos & 15;
        nsa_item(P, bg >> 1, bg & 1, c, big, kcv, abuf, lds);
      }
      const int hb = HBLK;
      for (int it = blockIdx.x * 2 + hb; it < 2048; it += gridDim.x * 2) mixB2_item(it, big, hsl, Pc, carryP, carryH, abuf);
    } break;
    case 6: gemm_bf16_phase(abuf, 1024, (const bf16_t*)(ws + OFF_WOUT + layer * SZ_SQ), 1024, 4, fbuf, 1024, lds); break;
    case 7: resnorm_phase(nullptr, h16, nullptr, h16, fbuf, 1.0f, ng + 3 * 1024, ng + 4 * 1024, abuf); break;
    case 10:
      gemm_bf16_phase((const bf16_t*)(ws + OFF_PBF) + (size_t)layer * M_TOK * 256, 256, (const bf16_t*)(ws + OFF_WPP + layer * SZ_WPP), 256, 4, big, 1024, lds);
      resnorm_phase(nullptr, h16, nullptr, h16, fbuf, 0.5f, ng + 5 * 1024, ng + 6 * 1024, abuf);
      break;
    case 11: gemm_ple_phase(abuf, (const bf16_t*)(ws + OFF_WPG + layer * SZ_SQ), big, fbuf, lds); break;
    case 12: resnorm_phase(nullptr, h16, layer == 0 ? nullptr : P.out, layer == 0 ? h16 : nullptr, fbuf, 1.0f, ng + 7 * 1024, layer == 0 ? P.norm_g + 8 * 1024 : nullptr, layer == 0 ? abuf : nullptr); break;
  }
}

#define XB_TMO      128
#define XB_XCNT(j)  (256  + 64 * (j))
#define XB_XSUB(j)  (1280 + 64 * (j))
#define XB_XGEN(j)  (2304 + 64 * (j))
#define XB_TOP      3328
#define XB_TOPGEN   3392
#define XCD_BAR_WORDS 3456
#define XB_SPIN_CAP (1u << 20)
#define LAS __attribute__((address_space(3)))
__device__ __forceinline__ unsigned xb_ld(unsigned* p)              { return __hip_atomic_load(p, __ATOMIC_RELAXED, __HIP_MEMORY_SCOPE_AGENT); }
__device__ __forceinline__ unsigned xb_add(unsigned* p, unsigned v) { return __hip_atomic_fetch_add(p, v, __ATOMIC_RELAXED, __HIP_MEMORY_SCOPE_AGENT); }
__device__ __forceinline__ unsigned xb_xcc_id() { return (unsigned)__builtin_amdgcn_s_getreg((3 << 11) | 20) & 0xFu; }
#define XB_SPIN(cond, bar) do { unsigned _sp = 0; while (cond) { __builtin_amdgcn_s_sleep(1); \
    if ((++_sp & 255u) == 0u) { if (xb_ld(&(bar)[XB_TMO])) break; if (_sp > XB_SPIN_CAP) { atomicAdd(&(bar)[XB_TMO], 1u); break; } } } } while (0)
struct XcdBarrier { unsigned* bar; unsigned x; volatile LAS unsigned* st; };
__device__ __forceinline__ XcdBarrier xcd_barrier_post(unsigned* bar, volatile LAS unsigned* st) {
    XcdBarrier b; b.bar = bar; b.x = xb_xcc_id(); b.st = st;
    if (threadIdx.x == 0) (void)xb_add(&bar[XB_XCNT(b.x)], 1u);
    return b;
}
__device__ __forceinline__ void xcd_barrier_complete(unsigned* bar, unsigned x, unsigned& nloc, unsigned& nx) {
    const unsigned G = gridDim.x * gridDim.y * gridDim.z;
    unsigned sum, cnt, mine, sp = 0u;
    for (;;) {
        sum = 0u; cnt = 0u; mine = 0u;
#pragma unroll
        for (unsigned j = 0; j < 16; ++j) { const unsigned c = xb_ld(&bar[XB_XCNT(j)]); sum += c; cnt += (c > 0u) ? 1u : 0u; mine = (j == x) ? c : mine; }
        if (sum == G) break;
        __builtin_amdgcn_s_sleep(1);
        if ((++sp & 255u) == 0u) { if (xb_ld(&bar[XB_TMO])) break; if (sp > XB_SPIN_CAP) { atomicAdd(&bar[XB_TMO], 1u); break; } }
    }
    nloc = mine > 0u ? mine : 1u; nx = cnt > 0u ? cnt : 1u;
}
__device__ __forceinline__ void xcd_barrier(const XcdBarrier& b) {
    asm volatile("s_waitcnt vmcnt(0)" ::: "memory");
    __syncthreads();
    if (threadIdx.x == 0) {
        unsigned* bar = b.bar;
        __builtin_amdgcn_s_waitcnt(0);
        unsigned nloc = b.st[0], nx = b.st[1];
        if (nloc == 0u) { xcd_barrier_complete(bar, b.x, nloc, nx); b.st[0] = nloc; b.st[1] = nx; }
        const unsigned old = xb_add(&bar[XB_XSUB(b.x)], 1u);
        const unsigned gen = old / nloc;
        if (old + 1u == (gen + 1u) * nloc) {
            __builtin_amdgcn_fence(__ATOMIC_RELEASE, "agent");
            asm volatile("s_waitcnt vmcnt(0)" ::: "memory");
            const unsigned og = xb_add(&bar[XB_TOP], 1u);
            const unsigned tg = og / nx;
            if (og + 1u == (tg + 1u) * nx) xb_add(&bar[XB_TOPGEN], 1u);
            else XB_SPIN(xb_ld(&bar[XB_TOPGEN]) == tg, bar);
            __builtin_amdgcn_fence(__ATOMIC_ACQUIRE, "agent");
            xb_add(&bar[XB_XGEN(b.x)], 1u);
            asm volatile("s_waitcnt vmcnt(0)" ::: "memory");
        } else {
            XB_SPIN(xb_ld(&bar[XB_XGEN(b.x)]) == gen, bar);
            __builtin_amdgcn_fence(__ATOMIC_ACQUIRE, "agent");
            asm volatile("s_waitcnt vmcnt(0)" ::: "memory");
        }
    }
    __syncthreads();
}

constexpr int LDS_BYTES = LDS_ST + 16;
__global__ void __launch_bounds__(512, 2) fwd_megakernel(Params P) {
  __shared__ __attribute__((aligned(16))) char lds[LDS_BYTES];
  cg::grid_group grid = cg::this_grid();
  volatile LAS unsigned* st = (volatile LAS unsigned*)(lds + LDS_ST);
  if (threadIdx.x == 0) { st[0] = 0u; st[1] = 0u; }
  __syncthreads();
  XcdBarrier xb = xcd_barrier_post((unsigned*)(P.ws + OFF_BAR), st);
  if (P.ws == nullptr) grid.sync();
  for (int ph = 0; ph < NPHASE; ++ph) {
    run_phase(P, ph, lds);
    if (ph + 1 < NPHASE) xcd_barrier(xb);
  }
}

__global__ void __launch_bounds__(512, 2) phase_kernel(Params P, int ph) {
  __shared__ __attribute__((aligned(16))) char lds[LDS_BYTES];
  run_phase(P, ph, lds);
}

extern "C" void kernel_launch(void* const* d_in, const int* in_sizes, int n_in, void* d_out, int out_size, void* d_ws, size_t ws_size, hipStream_t stream) {
  Params P{};
  const float** pp = (const float**)&P;
  for (int i = 0; i < 26; ++i) pp[i] = (const float*)d_in[i];
  P.out = (float*)d_out;
  P.ws = (char*)d_ws;
  if (ws_size < WS_NEED) { fprintf(stderr, "workspace too small: %zu < %zu\n", ws_size, (size_t)WS_NEED); return; }
#if MK_FUSED
  static int grid_blocks = 0;
  if (!grid_blocks) {
    int dev = 0, cus = 0, per_cu = 0;
    (void)hipGetDevice(&dev);
    (void)hipDeviceGetAttribute(&cus, hipDeviceAttributeMultiprocessorCount, dev);
    (void)hipOccupancyMaxActiveBlocksPerMultiprocessor(&per_cu, fwd_megakernel, 512, 0);
    if (per_cu > 1) per_cu = 1;
    if (per_cu < 1) per_cu = 1;
    grid_blocks = cus * per_cu;
  }
  (void)hipMemsetAsync((char*)d_ws + OFF_BAR, 0, XCD_BAR_WORDS * 4, stream);
  void* args[] = {&P};
  hipError_t e = hipLaunchCooperativeKernel((void*)fwd_megakernel, dim3(grid_blocks), dim3(512), args, 0, stream);
  if (e != hipSuccess) fprintf(stderr, "cooperative launch failed: %s (grid %d)\n", hipGetErrorString(e), grid_blocks);
#else
  for (int ph = 0; ph < NPHASE; ++ph) phase_kernel<<<256, 512, 0, stream>>>(P, ph);
#endif
}
```

```cpp
#include <hip/hip_runtime.h>
#include <hip/hip_cooperative_groups.h>
#include <cstdint>
#include <cstdio>
namespace cg = cooperative_groups;

#ifndef MK_FUSED
#define MK_FUSED 1
#endif

typedef unsigned short bf16_t;
typedef short bf16x8 __attribute__((ext_vector_type(8)));
typedef short bf16x4 __attribute__((ext_vector_type(4)));
typedef float f32x4 __attribute__((ext_vector_type(4)));
typedef unsigned long long u64;
typedef unsigned u32x4 __attribute__((ext_vector_type(4)));
typedef unsigned u32x2 __attribute__((ext_vector_type(2)));

constexpr int M_TOK = 32768, DM = 1024, DFF = 2816, NGU = 5632, NIN = 2328, LDZ = 2560, SEQ = 4096;
constexpr int NPHASE = 27;
constexpr int ZC_AU = 0, ZC_AV = 256, ZC_BX = 512, ZC_BG = 768, ZC_Q = 1024, ZC_KC = 1536, ZC_VC = 1664, ZC_KS = 1792, ZC_VS = 1920,
              ZC_KW = 2048, ZC_VW = 2176, ZC_GC = 2304, ZC_GS = 2312, ZC_GW = 2320;

constexpr size_t SZ_WGU = (size_t)NGU * 1024 * 2, SZ_WD = (size_t)1024 * DFF * 2, SZ_WIN = (size_t)LDZ * 1024 * 2, SZ_SQ = (size_t)1024 * 1024 * 2,
                 SZ_WPP = (size_t)1024 * 256 * 2, SZ_CW1 = (size_t)128 * 2048 * 2;
constexpr size_t OFF_WGU = 0;
constexpr size_t OFF_WD = OFF_WGU + 4 * SZ_WGU;
constexpr size_t OFF_WIN = OFF_WD + 4 * SZ_WD;
constexpr size_t OFF_WOUT = OFF_WIN + 2 * SZ_WIN;
constexpr size_t OFF_WPG = OFF_WOUT + 2 * SZ_SQ;
constexpr size_t OFF_WPP = OFF_WPG + 2 * SZ_SQ;
constexpr size_t OFF_CW1 = OFF_WPP + 2 * SZ_WPP;
constexpr size_t OFF_CB1 = OFF_CW1 + 4 * SZ_CW1;
constexpr size_t OFF_SGUW = OFF_CB1 + 4096;
constexpr size_t OFF_WAT = OFF_SGUW + 2 * 4 * 128 * 128 * 2;
constexpr size_t OFF_WXT = OFF_WAT + 2 * 4 * 64 * 64 * 2;
constexpr size_t OFF_PBF = OFF_WXT + 2 * 4 * 64 * 64 * 2;
constexpr size_t OFF_A = OFF_PBF + (size_t)2 * M_TOK * 256 * 2;
constexpr size_t OFF_BIG = OFF_A + (size_t)M_TOK * 1024 * 2;
constexpr size_t OFF_F = OFF_BIG + (size_t)M_TOK * DFF * 2;
constexpr size_t OFF_KC = OFF_F + (size_t)M_TOK * 1024 * 4;
constexpr size_t OFF_CARRY = OFF_KC + (size_t)2 * 8 * 2 * 256 * 64 * 2;
constexpr size_t OFF_BAR = OFF_CARRY + (size_t)2 * 8 * 4 * 64 * 64 * 4;
constexpr size_t WS_NEED = OFF_BAR + 16384;

struct Params {
  const float *x, *p, *rel_bias, *norm_g, *ffn_wg, *ffn_wu, *ffn_wd, *w_in, *w_out, *sgu_ng, *sgu_w, *sgu_b, *conv_w, *conv_b,
      *lru_wa, *lru_ba, *lru_wx, *lru_bx, *lru_lam, *cmp_pos, *cmp_w1, *cmp_b1, *cmp_w2, *cmp_b2, *ple_wg, *ple_wp;
  float* out;
  char* ws;
};

__device__ __forceinline__ int opaque_tid() { int t; asm volatile("v_mov_b32 %0, %1" : "=v"(t) : "v"(threadIdx.x)); return t; }
#define TIDX opaque_tid()
#define HTID (opaque_tid() & 255)
#define HBLK (opaque_tid() >> 8)
__device__ __forceinline__ float bf2f(bf16_t v) { return __uint_as_float(((unsigned)v) << 16); }
__device__ __forceinline__ bf16_t f2bf(float f) { unsigned u = __float_as_uint(f); u += 0x7fffu + ((u >> 16) & 1u); return (bf16_t)(u >> 16); }
typedef float f32x2v __attribute__((ext_vector_type(2)));
typedef __bf16 bf16x2v __attribute__((ext_vector_type(2)));
__device__ __forceinline__ unsigned pk2(float lo, float hi) { const f32x2v v = {lo, hi}; const bf16x2v r = __builtin_convertvector(v, bf16x2v); return __builtin_bit_cast(unsigned, r); }
__device__ __forceinline__ float sigm(float x) { return __builtin_amdgcn_rcpf(1.f + __expf(-x)); }
__device__ __forceinline__ float gelu_t(float x) { float u = 0.7978845608028654f * (x + 0.044715f * x * x * x); return x * __builtin_amdgcn_rcpf(1.f + __expf(-2.f * u)); }
__device__ __forceinline__ float silu_f(float x) { return x * __builtin_amdgcn_rcpf(1.f + __expf(-x)); }
__device__ __forceinline__ f32x4 mfma16(bf16x8 a, bf16x8 b, f32x4 c) { return __builtin_amdgcn_mfma_f32_16x16x32_bf16(a, b, c, 0, 0, 0); }
__device__ __forceinline__ void glds16(const void* g, void* l) {
  __builtin_amdgcn_global_load_lds((const __attribute__((address_space(1))) unsigned*)g, (__attribute__((address_space(3))) unsigned*)l, 16, 0, 0);
}
__device__ __forceinline__ f32x4 zero4() { f32x4 z; asm volatile("v_mov_b32 %0, 0\n\tv_mov_b32 %1, 0\n\tv_mov_b32 %2, 0\n\tv_mov_b32 %3, 0" : "=v"(z[0]), "=v"(z[1]), "=v"(z[2]), "=v"(z[3])); return z; }
__device__ __forceinline__ float wave_sum(float v) {
#pragma unroll
  for (int o = 32; o > 0; o >>= 1) v += __shfl_xor(v, o);
  return v;
}
__device__ __forceinline__ void unpack8(const u32x4 u, float* f) {
  f[0] = __uint_as_float(u.x << 16); f[1] = __uint_as_float(u.x & 0xffff0000u);
  f[2] = __uint_as_float(u.y << 16); f[3] = __uint_as_float(u.y & 0xffff0000u);
  f[4] = __uint_as_float(u.z << 16); f[5] = __uint_as_float(u.z & 0xffff0000u);
  f[6] = __uint_as_float(u.w << 16); f[7] = __uint_as_float(u.w & 0xffff0000u);
}

__device__ __forceinline__ void tr_cvt(const float* __restrict__ src, int N, int K, bf16_t* __restrict__ dst, int ldd, int rs, int ro, char* ldsc) {
  const int ntn = (N + 63) >> 6, nt = ntn * (K >> 6), hb = HBLK, tid = HTID;
  float* lds = (float*)(ldsc + hb * 65536);
  for (int t0 = blockIdx.x * 6; t0 < nt; t0 += gridDim.x * 6) {
    float4 v[3][4];
#pragma unroll
    for (int u = 0; u < 3; ++u) {
      const int tile = t0 + hb * 3 + u, tk = tile / ntn, tn = tile - tk * ntn, k0 = tk * 64, n0 = tn * 64;
      const bool active = tile < nt;
#pragma unroll
      for (int ps = 0; ps < 4; ++ps) {
        const int i = ps * 16 + (tid >> 4), j = (tid & 15) * 4;
        v[u][ps] = make_float4(0.f, 0.f, 0.f, 0.f);
        if (active && n0 + j < N) v[u][ps] = *(const float4*)(src + (size_t)(k0 + i) * N + n0 + j);
      }
    }
#pragma unroll
    for (int u = 0; u < 3; ++u)
#pragma unroll
      for (int ps = 0; ps < 4; ++ps) {
        const int i = ps * 16 + (tid >> 4), j = (tid & 15) * 4;
        float* d = lds + u * 4160 + i * 65 + j; d[0] = v[u][ps].x; d[1] = v[u][ps].y; d[2] = v[u][ps].z; d[3] = v[u][ps].w;
      }
    __syncthreads();
#pragma unroll
    for (int u = 0; u < 3; ++u) {
      const int tile = t0 + hb * 3 + u, tk = tile / ntn, tn = tile - tk * ntn, k0 = tk * 64, n0 = tn * 64;
      const int j = tid >> 2, kq = tid & 3, n = n0 + j;
      if (tile < nt && n < N) {
        const float* l = lds + u * 4160;
        unsigned w[8];
#pragma unroll
        for (int q = 0; q < 8; ++q) w[q] = pk2(l[(kq * 16 + 2 * q) * 65 + j], l[(kq * 16 + 2 * q + 1) * 65 + j]);
        bf16_t* o = dst + (size_t)((n >> 4) * rs + (n & 15) + ro) * ldd + k0 + kq * 16;
        u32x4 w0, w1; w0.x = w[0]; w0.y = w[1]; w0.z = w[2]; w0.w = w[3]; w1.x = w[4]; w1.y = w[5]; w1.z = w[6]; w1.w = w[7];
        *(u32x4*)o = w0; *(u32x4*)(o + 8) = w1;
      }
    }
    __syncthreads();
  }
}

struct RowRegs { float4 h[4]; u32x2 f[4]; };
__device__ __forceinline__ void rn_load(RowRegs& R, const float* hin32, const bf16_t* hin16, const bf16_t* f, int row, int lane) {
  if (hin32) {
#pragma unroll
    for (int i = 0; i < 4; ++i) R.h[i] = *(const float4*)(hin32 + (size_t)row * 1024 + i * 256 + lane * 4);
  } else {
#pragma unroll
    for (int i = 0; i < 4; ++i) { const u32x2 v = *(const u32x2*)(hin16 + (size_t)row * 1024 + i * 256 + lane * 4);
      R.h[i].x = __uint_as_float(v.x << 16); R.h[i].y = __uint_as_float(v.x & 0xffff0000u); R.h[i].z = __uint_as_float(v.y << 16); R.h[i].w = __uint_as_float(v.y & 0xffff0000u); }
  }
  if (f) {
#pragma unroll
    for (int i = 0; i < 4; ++i) R.f[i] = *(const u32x2*)(f + (size_t)row * 1024 + i * 256 + lane * 4);
  }
}
__device__ __forceinline__ void rn_proc(RowRegs& R, float* hout32, bf16_t* hout16, bool has_f, float scale, const float4 (&gpo)[4], const float4 (&gpr)[4], bf16_t* a, int row, int lane) {
  if (has_f) {
    float fv[4][4]; float ss = 0.f;
#pragma unroll
    for (int i = 0; i < 4; ++i) {
      fv[i][0] = __uint_as_float(R.f[i].x << 16); fv[i][1] = __uint_as_float(R.f[i].x & 0xffff0000u);
      fv[i][2] = __uint_as_float(R.f[i].y << 16); fv[i][3] = __uint_as_float(R.f[i].y & 0xffff0000u);
      ss += fv[i][0] * fv[i][0] + fv[i][1] * fv[i][1] + fv[i][2] * fv[i][2] + fv[i][3] * fv[i][3];
    }
    ss = wave_sum(ss);
    const float r = rsqrtf(ss * (1.f / 1024.f) + 1e-6f) * scale;
#pragma unroll
    for (int i = 0; i < 4; ++i) { const float4 g = gpo[i];
      R.h[i].x += fv[i][0] * r * g.x; R.h[i].y += fv[i][1] * r * g.y; R.h[i].z += fv[i][2] * r * g.z; R.h[i].w += fv[i][3] * r * g.w; }
  }
  if (hout32) {
#pragma unroll
    for (int i = 0; i < 4; ++i) *(float4*)(hout32 + (size_t)row * 1024 + i * 256 + lane * 4) = R.h[i];
  }
  if (hout16) {
#pragma unroll
    for (int i = 0; i < 4; ++i) { u32x2 o; o.x = pk2(R.h[i].x, R.h[i].y); o.y = pk2(R.h[i].z, R.h[i].w); *(u32x2*)(hout16 + (size_t)row * 1024 + i * 256 + lane * 4) = o; }
  }
  if (a) {
    float ss = 0.f;
#pragma unroll
    for (int i = 0; i < 4; ++i) ss += R.h[i].x * R.h[i].x + R.h[i].y * R.h[i].y + R.h[i].z * R.h[i].z + R.h[i].w * R.h[i].w;
    ss = wave_sum(ss);
    const float r = rsqrtf(ss * (1.f / 1024.f) + 1e-6f);
#pragma unroll
    for (int i = 0; i < 4; ++i) { const float4 g = gpr[i];
      u32x2 o; o.x = pk2(R.h[i].x * r * g.x, R.h[i].y * r * g.y); o.y = pk2(R.h[i].z * r * g.z, R.h[i].w * r * g.w);
      *(u32x2*)(a + (size_t)row * 1024 + i * 256 + lane * 4) = o; }
  }
}
__device__ __forceinline__ void resnorm_phase(const float* hin32, const bf16_t* hin16, float* hout32, bf16_t* hout16, const bf16_t* f, float scale, const float* gpost, const float* gpre, bf16_t* a) {
  const int tid = TIDX, lane = tid & 63, stride = gridDim.x * 8;
  int r0 = blockIdx.x * 8 + (tid >> 6), r1 = r0 + 2 * stride;
  RowRegs A0, A1, B0, B1;
  float4 gpo[4], gpr[4];
#pragma unroll
  for (int i = 0; i < 4; ++i) { gpo[i] = f ? *(const float4*)(gpost + i * 256 + lane * 4) : make_float4(0.f, 0.f, 0.f, 0.f); gpr[i] = a ? *(const float4*)(gpre + i * 256 + lane * 4) : make_float4(0.f, 0.f, 0.f, 0.f); }
  const bool hf = f != nullptr;
  if (r0 < M_TOK) { rn_load(A0, hin32, hin16, f, r0, lane); rn_load(A1, hin32, hin16, f, r0 + stride, lane); }
  for (;;) {
    if (r0 >= M_TOK) break;
    if (r1 < M_TOK) { rn_load(B0, hin32, hin16, f, r1, lane); rn_load(B1, hin32, hin16, f, r1 + stride, lane); }
    rn_proc(A0, hout32, hout16, hf, scale, gpo, gpr, a, r0, lane); rn_proc(A1, hout32, hout16, hf, scale, gpo, gpr, a, r0 + stride, lane);
    r0 += 4 * stride;
    if (r1 >= M_TOK) break;
    if (r0 < M_TOK) { rn_load(A0, hin32, hin16, f, r0, lane); rn_load(A1, hin32, hin16, f, r0 + stride, lane); }
    rn_proc(B0, hout32, hout16, hf, scale, gpo, gpr, a, r1, lane); rn_proc(B1, hout32, hout16, hf, scale, gpo, gpr, a, r1 + stride, lane);
    r1 += 4 * stride;
  }
}

__device__ __forceinline__ void prep_phase(const Params& P, char* ldsc) {
  char* ws = P.ws;
  for (int l = 0; l < 2; ++l) {
    for (int j = 0; j < 2; ++j) {
      const int lj = l * 2 + j;
      bf16_t* wgu = (bf16_t*)(ws + OFF_WGU + lj * SZ_WGU);
      tr_cvt(P.ffn_wg + (size_t)lj * 1024 * DFF, DFF, 1024, wgu, 1024, 32, 0, ldsc);
      tr_cvt(P.ffn_wu + (size_t)lj * 1024 * DFF, DFF, 1024, wgu, 1024, 32, 16, ldsc);
      tr_cvt(P.ffn_wd + (size_t)lj * DFF * 1024, 1024, DFF, (bf16_t*)(ws + OFF_WD + lj * SZ_WD), DFF, 16, 0, ldsc);
      tr_cvt(P.cmp_w1 + (size_t)lj * 2048 * 128, 128, 2048, (bf16_t*)(ws + OFF_CW1 + lj * SZ_CW1), 2048, 16, 0, ldsc);
    }
    tr_cvt(P.w_in + (size_t)l * 1024 * NIN, NIN, 1024, (bf16_t*)(ws + OFF_WIN + l * SZ_WIN), 1024, 16, 0, ldsc);
    tr_cvt(P.w_out + (size_t)l * 1024 * 1024, 1024, 1024, (bf16_t*)(ws + OFF_WOUT + l * SZ_SQ), 1024, 16, 0, ldsc);
    tr_cvt(P.ple_wg + (size_t)l * 1024 * 1024, 1024, 1024, (bf16_t*)(ws + OFF_WPG + l * SZ_SQ), 1024, 16, 0, ldsc);
    tr_cvt(P.ple_wp + (size_t)l * 256 * 1024, 1024, 256, (bf16_t*)(ws + OFF_WPP + l * SZ_WPP), 256, 16, 0, ldsc);
    for (int g = 0; g < 4; ++g) {
      tr_cvt(P.lru_wa + (size_t)(l * 4 + g) * 4096, 64, 64, (bf16_t*)(ws + OFF_WAT) + (l * 4 + g) * 4096, 64, 16, 0, ldsc);
      tr_cvt(P.lru_wx + (size_t)(l * 4 + g) * 4096, 64, 64, (bf16_t*)(ws + OFF_WXT) + (l * 4 + g) * 4096, 64, 16, 0, ldsc);
    }
  }
  const int tid = TIDX, gtid = blockIdx.x * 512 + tid, gn = gridDim.x * 512;
  for (int i = gtid; i < 2 * (LDZ - NIN) * 1024 / 8; i += gn) {
    const int l = i / ((LDZ - NIN) * 128), r = i - l * ((LDZ - NIN) * 128);
    *(f32x4*)((bf16_t*)(ws + OFF_WIN + l * SZ_WIN) + (size_t)NIN * 1024 + (size_t)r * 8) = zero4();
  }
  for (int i = gtid; i < 2 * 4 * 128 * 128; i += gn) { const int t = (i >> 7) & 127, s2 = i & 127; ((bf16_t*)(ws + OFF_SGUW))[i] = (s2 <= t) ? f2bf(P.sgu_w[i]) : (bf16_t)0; }
  for (int i = gtid; i < 2 * M_TOK * 256 / 4; i += gn) { const float4 v = ((const float4*)P.p)[i]; uint2 o; o.x = pk2(v.x, v.y); o.y = pk2(v.z, v.w); ((uint2*)(ws + OFF_PBF))[i] = o; }
  {
    float* lds = (float*)(ldsc + HBLK * 65536);
    for (int u = blockIdx.x; u < 4; u += gridDim.x) {
      const int t2 = HTID, kq = t2 >> 5, jq = t2 & 31;
      const float* w1 = P.cmp_w1 + (size_t)u * 2048 * 128; const float* pos = P.cmp_pos + (size_t)u * 2048;
      float4 sacc = make_float4(0.f, 0.f, 0.f, 0.f);
      for (int k = kq * 256; k < kq * 256 + 256; ++k) { const float pv = pos[k]; const float4 w = *(const float4*)(w1 + (size_t)k * 128 + jq * 4); sacc.x += pv * w.x; sacc.y += pv * w.y; sacc.z += pv * w.z; sacc.w += pv * w.w; }
      __syncthreads();
      lds[kq * 128 + jq * 4 + 0] = sacc.x; lds[kq * 128 + jq * 4 + 1] = sacc.y; lds[kq * 128 + jq * 4 + 2] = sacc.z; lds[kq * 128 + jq * 4 + 3] = sacc.w;
      __syncthreads();
      if (t2 < 128) { float t = P.cmp_b1[u * 128 + t2]; for (int q = 0; q < 8; ++q) t += lds[q * 128 + t2]; ((float*)(ws + OFF_CB1))[u * 128 + t2] = t; }
      __syncthreads();
    }
  }
  resnorm_phase(P.x, nullptr, nullptr, nullptr, nullptr, 0.f, nullptr, P.norm_g, (bf16_t*)(ws + OFF_A));
}

constexpr int G8_HT = 128 * 64;
__device__ __forceinline__ int g8_lds_byte(int r, int c) { const int st = (r >> 4) * 2 + (c >> 5), rr = r & 15, cc = c & 31, ob = rr * 64 + cc * 2; return st * 1024 + (ob ^ (((ob >> 9) & 1) << 5)); }
__device__ __forceinline__ void g8_stage_rc(int b, int& R, int& C) { const int st = b / 1024, sb = b % 1024, swz = sb ^ (((sb >> 9) & 1) << 5); R = (st >> 1) * 16 + swz / 64; C = (st & 1) * 32 + (swz % 64) / 2; }

template <bool ISSUE_ONLY, bool PRE_ISSUED>
__device__ __forceinline__ void gemm_core(f32x4 (&acc)[2][2][4][2], const bf16_t* __restrict__ A, int lda, const bf16_t* __restrict__ Bt, int ldb, int K, char* ldsc) {
  bf16_t* shm = (bf16_t*)ldsc;
  const int tid = TIDX, wid = tid >> 6, lane = tid & 63, wr = wid >> 2, wc = wid & 3, fr = lane & 15, fq = lane >> 4;
  int sr0, sc0;
  g8_stage_rc(tid * 16, sr0, sc0);
  const bf16_t* gA0 = A + (size_t)sr0 * lda + sc0;
  const bf16_t* gB0 = Bt + (size_t)sr0 * ldb + sc0;
  const size_t a64 = (size_t)64 * lda, b64 = (size_t)64 * ldb;
  const int lane_off = (fr * 64 + fq * 16) ^ ((((fr * 64 + fq * 16) >> 9) & 1) << 5);
  const char* ldA = ldsc + wr * 8192 + lane_off;
  const char* ldB = ldsc + 65536 + wc * 4096 + lane_off;
#define SA(b, h) (shm + ((b) * 2 + (h)) * G8_HT)
#define SB(b, h) (shm + (4 + (b) * 2 + (h)) * G8_HT)
#define STAGE_A(P, h, kt) { const bf16_t* g_ = gA0 + (size_t)(h) * 2 * a64 + (kt) * 64; glds16(g_, (char*)(P) + tid * 16); glds16(g_ + a64, (char*)(P) + tid * 16 + 8192); }
#define STAGE_B(P, h, kt) { const bf16_t* g_ = gB0 + (size_t)(h) * 2 * b64 + (kt) * 64; glds16(g_, (char*)(P) + tid * 16); glds16(g_ + b64, (char*)(P) + tid * 16 + 8192); }
#define LDA(dst, b, h) _Pragma("unroll") for (int m = 0; m < 4; ++m) _Pragma("unroll") for (int k = 0; k < 2; ++k) \
    dst[m][k] = *reinterpret_cast<const bf16x8*>(ldA + ((b) * 2 + (h)) * 16384 + (m * 2 + k) * 1024)
#define LDB(dst, b, h) _Pragma("unroll") for (int n = 0; n < 2; ++n) _Pragma("unroll") for (int k = 0; k < 2; ++k) \
    dst[n][k] = *reinterpret_cast<const bf16x8*>(ldB + ((b) * 2 + (h)) * 16384 + (n * 2 + k) * 1024)
#define MMA(ai, bj, At_, Bt_) do { __builtin_amdgcn_s_setprio(1); \
    _Pragma("unroll") for (int m = 0; m < 4; ++m) _Pragma("unroll") for (int n = 0; n < 2; ++n) _Pragma("unroll") for (int k = 0; k < 2; ++k) \
      acc[ai][bj][m][n] = mfma16(Bt_[n][k], At_[m][k], acc[ai][bj][m][n]); \
    __builtin_amdgcn_s_setprio(0); } while (0)
#define WAIT_V(n) asm volatile("s_waitcnt vmcnt(" #n ")" ::: "memory")
#define WAIT_L(n) asm volatile("s_waitcnt lgkmcnt(" #n ")" ::: "memory")
#define BAR __builtin_amdgcn_s_barrier()
#define SCHED __builtin_amdgcn_sched_barrier(0)
  bf16x8 At[4][2], B0[2][2], B1[2][2];
  const int nt = K >> 6;
  if (!PRE_ISSUED) {
    STAGE_B(SB(0, 0), 0, 0); STAGE_A(SA(0, 0), 0, 0);
    STAGE_B(SB(0, 1), 1, 0); STAGE_A(SA(0, 1), 1, 0);
  }
  if (ISSUE_ONLY) return;
  if (wr == 1) BAR;
  if (PRE_ISSUED) { WAIT_V(0); } else { WAIT_V(4); }
  BAR;
  STAGE_B(SB(1, 0), 0, 1); STAGE_A(SA(1, 0), 0, 1); STAGE_B(SB(1, 1), 1, 1);
  WAIT_V(6); BAR;
#pragma nounroll
  for (int t = 0; t < nt - 2; t += 2) {
    LDB(B0, 0, 0); SCHED; LDA(At, 0, 0); STAGE_A(SA(1, 1), 1, t + 1);
    WAIT_L(8); BAR; WAIT_L(0); MMA(0, 0, At, B0); BAR; SCHED;
    LDB(B1, 0, 1); STAGE_B(SB(0, 0), 0, t + 2);
    BAR; WAIT_L(0); MMA(0, 1, At, B1); BAR;
    LDA(At, 0, 1); STAGE_A(SA(0, 0), 0, t + 2);
    BAR; WAIT_L(0); MMA(1, 0, At, B0); BAR; SCHED;
    STAGE_B(SB(0, 1), 1, t + 2);
    WAIT_V(6); BAR; MMA(1, 1, At, B1); BAR;
    LDB(B0, 1, 0); SCHED; LDA(At, 1, 0); STAGE_A(SA(0, 1), 1, t + 2);
    WAIT_L(8); BAR; WAIT_L(0); MMA(0, 0, At, B0); BAR; SCHED;
    LDB(B1, 1, 1); STAGE_B(SB(1, 0), 0, t + 3);
    BAR; WAIT_L(0); MMA(0, 1, At, B1); BAR;
    LDA(At, 1, 1); STAGE_A(SA(1, 0), 0, t + 3);
    BAR; WAIT_L(0); MMA(1, 0, At, B0); BAR; SCHED;
    STAGE_B(SB(1, 1), 1, t + 3);
    WAIT_V(6); BAR; MMA(1, 1, At, B1); BAR;
  }
  { LDB(B0, 0, 0); LDA(At, 0, 0); STAGE_A(SA(1, 1), 1, nt - 1);
    BAR; WAIT_L(0); MMA(0, 0, At, B0); BAR;
    LDB(B1, 0, 1); BAR; WAIT_L(0); MMA(0, 1, At, B1); BAR;
    LDA(At, 0, 1); WAIT_V(4); BAR; WAIT_L(0); MMA(1, 0, At, B0); MMA(1, 1, At, B1); BAR; }
  { LDB(B0, 1, 0); LDA(At, 1, 0); WAIT_V(2); BAR; WAIT_L(0); MMA(0, 0, At, B0); BAR;
    LDB(B1, 1, 1); WAIT_V(0); BAR; WAIT_L(0); MMA(0, 1, At, B1); BAR;
    LDA(At, 1, 1); BAR; WAIT_L(0); MMA(1, 0, At, B0); MMA(1, 1, At, B1); BAR; }
  if (wr == 0) BAR;
  BAR;
#undef SA
#undef SB
#undef STAGE_A
#undef STAGE_B
#undef LDA
#undef LDB
#undef MMA
#undef WAIT_V
#undef WAIT_L
#undef BAR
#undef SCHED
}

struct TileIt {
  int TN, npc, npatch, slot, nslot, pid, s, tm, tn;
  __device__ __forceinline__ void init(int TN_) { TN = TN_; npc = (TN + 1) >> 1; npatch = 8 * npc; slot = blockIdx.x >> 3; nslot = gridDim.x >> 3; pid = blockIdx.x & 7; s = slot - nslot; }
  __device__ __forceinline__ bool next() {
    for (;;) {
      s += nslot;
      if (s >= 32) { s = slot; pid += 8; }
      if (pid >= npatch) return false;
      const int pr = pid / npc, pc = pid - pr * npc;
      tm = pr * 16 + (s & 15); tn = pc * 2 + (s >> 4);
      if (tn < TN) return true;
    }
  }
};

#define GEMM_LANE const int tid_ = TIDX, lane_ = tid_ & 63, wid_ = tid_ >> 6, wr = wid_ >> 2, wc = wid_ & 3, fr = lane_ & 15, fq = lane_ >> 4
#define GEMM_EPI_LOOP _Pragma("unroll") for (int ai = 0; ai < 2; ++ai) _Pragma("unroll") for (int m = 0; m < 4; ++m) _Pragma("unroll") for (int bj = 0; bj < 2; ++bj)

template <class Epi> __device__ __forceinline__ void gemm_phase(const bf16_t* A, int lda, const bf16_t* Bt, int ldb, int K, int TN, char* lds, Epi&& epi) {
  TileIt it; it.init(TN);
  bool have = it.next();
  f32x4 acc[2][2][4][2];
  if (have) gemm_core<true, false>(acc, A + (size_t)it.tm * 256 * lda, lda, Bt + (size_t)it.tn * 256 * ldb, ldb, K, lds);
  while (have) {
    const int tm = it.tm, tn = it.tn;
#pragma unroll
    for (int i0 = 0; i0 < 2; ++i0)
#pragma unroll
      for (int i1 = 0; i1 < 2; ++i1)
#pragma unroll
        for (int i2 = 0; i2 < 4; ++i2)
#pragma unroll
          for (int i3 = 0; i3 < 2; ++i3) acc[i0][i1][i2][i3] = zero4();
    gemm_core<false, true>(acc, A + (size_t)tm * 256 * lda, lda, Bt + (size_t)tn * 256 * ldb, ldb, K, lds);
    have = it.next();
    if (have) { f32x4 dummy[2][2][4][2]; gemm_core<true, false>(dummy, A + (size_t)it.tm * 256 * lda, lda, Bt + (size_t)it.tn * 256 * ldb, ldb, K, lds); }
    epi(acc, tm, tn);
  }
  asm volatile("s_waitcnt vmcnt(0)" ::: "memory");
}

__device__ __forceinline__ void gemm_up_phase(const bf16_t* a, const bf16_t* wgu, bf16_t* act, char* lds) {
  gemm_phase(a, 1024, wgu, 1024, 1024, NGU / 256, lds, [&](f32x4 (&acc)[2][2][4][2], int tm, int tn) {
    GEMM_LANE;
    GEMM_EPI_LOOP {
      const int row = tm * 256 + ai * 128 + wr * 64 + m * 16 + fr;
      const int col = tn * 128 + bj * 64 + wc * 16 + 4 * fq;
      const f32x4 g = acc[ai][bj][m][0], u = acc[ai][bj][m][1];
      u32x2 o; o.x = pk2(silu_f(g[0]) * u[0], silu_f(g[1]) * u[1]); o.y = pk2(silu_f(g[2]) * u[2], silu_f(g[3]) * u[3]);
      *(u32x2*)(act + (size_t)row * DFF + col) = o;
    }
  });
}

__device__ __forceinline__ void gemm_bf16_phase(const bf16_t* A, int lda, const bf16_t* Bt, int K, int TN, bf16_t* out, int ldo, char* lds) {
  gemm_phase(A, lda, Bt, K, K, TN, lds, [&](f32x4 (&acc)[2][2][4][2], int tm, int tn) {
    GEMM_LANE;
    GEMM_EPI_LOOP {
      const int row = tm * 256 + ai * 128 + wr * 64 + m * 16 + fr;
#pragma unroll
      for (int n = 0; n < 2; ++n) {
        u32x2 o; o.x = pk2(acc[ai][bj][m][n][0], acc[ai][bj][m][n][1]); o.y = pk2(acc[ai][bj][m][n][2], acc[ai][bj][m][n][3]);
        *(u32x2*)(out + (size_t)row * ldo + tn * 256 + bj * 128 + wc * 32 + n * 16 + 4 * fq) = o;
      }
    }
  });
}

__device__ __forceinline__ void gemm_ple_phase(const bf16_t* a, const bf16_t* wpg, const bf16_t* pp, bf16_t* out, char* lds) {
  gemm_phase(a, 1024, wpg, 1024, 1024, 4, lds, [&](f32x4 (&acc)[2][2][4][2], int tm, int tn) {
    GEMM_LANE;
    GEMM_EPI_LOOP {
      const int row = tm * 256 + ai * 128 + wr * 64 + m * 16 + fr;
#pragma unroll
      for (int n = 0; n < 2; ++n) {
        const int col = tn * 256 + bj * 128 + wc * 32 + n * 16 + 4 * fq;
        const u32x2 pv = *(const u32x2*)(pp + (size_t)row * 1024 + col);
        const f32x4 av = acc[ai][bj][m][n];
        u32x2 o;
        o.x = pk2(sigm(av[0]) * __uint_as_float(pv.x << 16), sigm(av[1]) * __uint_as_float(pv.x & 0xffff0000u));
        o.y = pk2(sigm(av[2]) * __uint_as_float(pv.y << 16), sigm(av[3]) * __uint_as_float(pv.y & 0xffff0000u));
        *(u32x2*)(out + (size_t)row * 1024 + col) = o;
      }
    }
  });
}

__device__ __forceinline__ void mixA_item(const Params& P, int layer, int idx, const bf16_t* z, bf16_t* y, char* lds) {
  const int g = idx & 3, bc = idx >> 2, tok0 = bc * 128;
  const int tid = HTID, lane = tid & 63, w = tid >> 6, fr = lane & 15, fq = lane >> 4;
  bf16_t* vT = (bf16_t*)lds;
  const float* ng = P.sgu_ng + layer * 256;
  {
    const int s = tid >> 1, half = tid & 1;
    const bf16_t* zr = z + (size_t)(tok0 + s) * LDZ + ZC_AV;
    float ss = 0.f;
#pragma unroll 4
    for (int i = 0; i < 16; ++i) { float v[8]; unpack8(*(const u32x4*)(zr + half * 128 + i * 8), v);
#pragma unroll
      for (int e = 0; e < 8; ++e) { const float t = gelu_t(v[e]); ss += t * t; } }
    ss += __shfl_xor(ss, 1);
    const float rs = rsqrtf(ss * (1.f / 256.f) + 1e-6f);
#pragma unroll
    for (int i = 0; i < 4; ++i) { float v[8]; unpack8(*(const u32x4*)(zr + g * 64 + half * 32 + i * 8), v);
#pragma unroll
      for (int e = 0; e < 8; ++e) { const int d = half * 32 + i * 8 + e; vT[d * 136 + s] = f2bf(gelu_t(v[e]) * rs * ng[g * 64 + d]); } }
  }
  __syncthreads();
  const bf16_t* W = (const bf16_t*)(P.ws + OFF_SGUW) + (size_t)((layer * 4 + g) * 128) * 128;
  f32x4 acc[2][4] = {};
  for (int ks = 0; ks <= w; ++ks) {
    bf16x8 wf[2], vf[4];
#pragma unroll
    for (int tm = 0; tm < 2; ++tm) wf[tm] = *(const bf16x8*)(W + (size_t)(32 * w + tm * 16 + fr) * 128 + ks * 32 + 8 * fq);
#pragma unroll
    for (int dn = 0; dn < 4; ++dn) vf[dn] = *(const bf16x8*)(vT + (dn * 16 + fr) * 136 + ks * 32 + 8 * fq);
#pragma unroll
    for (int tm = 0; tm < 2; ++tm)
#pragma unroll
      for (int dn = 0; dn < 4; ++dn) acc[tm][dn] = mfma16(vf[dn], wf[tm], acc[tm][dn]);
  }
#pragma unroll
  for (int tm = 0; tm < 2; ++tm) {
    const int t = 32 * w + tm * 16 + fr;
    const float bias = P.sgu_b[(layer * 4 + g) * 128 + t];
#pragma unroll
    for (int dn = 0; dn < 4; ++dn) {
      const int d = dn * 16 + 4 * fq;
      const uint2 uu = *(const uint2*)(z + (size_t)(tok0 + t) * LDZ + ZC_AU + g * 64 + d);
      const float u0 = gelu_t(__uint_as_float(uu.x << 16)), u1 = gelu_t(__uint_as_float(uu.x & 0xffff0000u)),
                  u2 = gelu_t(__uint_as_float(uu.y << 16)), u3 = gelu_t(__uint_as_float(uu.y & 0xffff0000u));
      uint2 o; o.x = pk2(u0 * (acc[tm][dn][0] + bias), u1 * (acc[tm][dn][1] + bias)); o.y = pk2(u2 * (acc[tm][dn][2] + bias), u3 * (acc[tm][dn][3] + bias));
      *(uint2*)(y + (size_t)(tok0 + t) * 1024 + g * 64 + d) = o;
    }
  }
  __syncthreads();
}

__device__ __forceinline__ void mixB1_item(const Params& P, int layer, int idx, const bf16_t* z, float* hsl, float* Pc, float* carryP, float* carryH, char* lds) {
  const int c = idx & 63, g = (idx >> 6) & 3, b = idx >> 8;
  const int tid = HTID, lane = tid & 63, w = tid >> 6, fr = lane & 15, fq = lane >> 4;
  bf16_t* xcb = (bf16_t*)lds;
  float* xcf = (float*)(lds + 9216);
  float* aA = (float*)(lds + 9216 + 16384);
  float* bB = (float*)(lds + 9216 + 32768);
  float* sm = (float*)(lds + 9216 + 49152);
  const size_t tokb = (size_t)b * SEQ;
  {
    const int t = tid >> 2, q = tid & 3;
    float accv[16];
#pragma unroll
    for (int i = 0; i < 16; ++i) accv[i] = P.conv_b[layer * 256 + g * 64 + q * 16 + i];
#pragma unroll
    for (int k = 0; k < 4; ++k) {
      const int pos = c * 64 + t - 3 + k;
      if (pos >= 0) {
        const bf16_t* zr = z + (tokb + pos) * LDZ + ZC_BX + g * 64 + q * 16;
        float v[16]; unpack8(*(const u32x4*)zr, v); unpack8(*(const u32x4*)(zr + 8), v + 8);
        const float* cw = P.conv_w + (size_t)(layer * 4 + k) * 256 + g * 64 + q * 16;
#pragma unroll
        for (int i = 0; i < 16; ++i) accv[i] += v[i] * cw[i];
      }
    }
#pragma unroll
    for (int i = 0; i < 16; ++i) { xcf[t * 64 + q * 16 + i] = accv[i]; xcb[t * 72 + q * 16 + i] = f2bf(accv[i]); }
  }
  __syncthreads();
  {
    const bf16_t* wa = (const bf16_t*)(P.ws + OFF_WAT) + (layer * 4 + g) * 4096;
    const bf16_t* wx = (const bf16_t*)(P.ws + OFF_WXT) + (layer * 4 + g) * 4096;
    f32x4 ar[4] = {}, ai[4] = {};
#pragma unroll
    for (int ks = 0; ks < 2; ++ks) {
      const bf16x8 xf = *(const bf16x8*)(xcb + (16 * w + fr) * 72 + ks * 32 + 8 * fq);
#pragma unroll
      for (int jn = 0; jn < 4; ++jn) {
        const bf16x8 fa = *(const bf16x8*)(wa + (jn * 16 + fr) * 64 + ks * 32 + 8 * fq);
        const bf16x8 fx = *(const bf16x8*)(wx + (jn * 16 + fr) * 64 + ks * 32 + 8 * fq);
        ar[jn] = mfma16(fa, xf, ar[jn]); ai[jn] = mfma16(fx, xf, ai[jn]);
      }
    }
    const int t = 16 * w + fr;
#pragma unroll
    for (int jn = 0; jn < 4; ++jn)
#pragma unroll
      for (int e = 0; e < 4; ++e) {
        const int j = jn * 16 + 4 * fq + e, ch = layer * 256 + g * 64 + j;
        const float r = sigm(ar[jn][e] + P.lru_ba[ch]), ig = sigm(ai[jn][e] + P.lru_bx[ch]);
        const float lam = P.lru_lam[ch];
        const float xe = __expf(-lam);
        float m8; asm volatile("v_mov_b32 %0, 0xc1000000" : "=v"(m8));
        const float la = m8 * r * (xe * (1.f - xe * (0.5f - xe * (1.f / 3.f))));
        const float av = __expf(la);
        const float y2 = 2.f * la;
        const float om = -y2 * (1.f + y2 * (0.5f + y2 * ((1.f / 6.f) + y2 * ((1.f / 24.f) + y2 * ((1.f / 120.f) + y2 * (1.f / 720.f))))));
        const float bv = sqrtf(om) * (ig * xcf[t * 64 + j]);
        aA[t * 64 + j] = av; bB[t * 64 + j] = bv;
      }
  }
  __syncthreads();
  {
    const int q = tid >> 6, j = tid & 63;
    float Pq = 1.f, hq = 0.f;
#pragma unroll
    for (int i = 0; i < 16; ++i) { const int t = q * 16 + i; const float av = aA[t * 64 + j], bv = bB[t * 64 + j]; hq = av * hq + bv; Pq *= av; aA[t * 64 + j] = Pq; bB[t * 64 + j] = hq; }
    sm[q * 64 + j] = Pq; sm[256 + q * 64 + j] = hq;
    __syncthreads();
    float Pin = 1.f, Hin = 0.f;
    for (int qq = 0; qq < q; ++qq) { const float pp = sm[qq * 64 + j], hh = sm[256 + qq * 64 + j]; Hin = pp * Hin + hh; Pin *= pp; }
    float hl = 0.f, pl = 1.f;
#pragma unroll
    for (int i = 0; i < 16; ++i) { const int t = q * 16 + i; hl = bB[t * 64 + j] + aA[t * 64 + j] * Hin; pl = aA[t * 64 + j] * Pin;
      const size_t o = (tokb + c * 64 + t) * 256 + g * 64 + j; hsl[o] = hl; Pc[o] = pl; }
    if (q == 3) { const int o = ((b * 4 + g) * 64 + c) * 64 + j; carryP[o] = pl; carryH[o] = hl; }
  }
  __syncthreads();
}

__device__ __forceinline__ void mixB2_item(int idx, const bf16_t* z, const float* hsl, const float* Pc, const float* carryP, const float* carryH, bf16_t* y) {
  const int c = idx & 63, g = (idx >> 6) & 3, b = idx >> 8;
  const int q = HTID >> 6, j = HTID & 63;
  const float* cp = carryP + (size_t)((b * 4 + g) * 64) * 64 + j;
  const float* chh = carryH + (size_t)((b * 4 + g) * 64) * 64 + j;
  float H = 0.f;
  for (int c0 = 0; c0 < c; c0 += 8) {
    float pv[8], hv[8];
#pragma unroll
    for (int i = 0; i < 8; ++i) { const bool ok = c0 + i < c; pv[i] = ok ? cp[(c0 + i) * 64] : 1.f; hv[i] = ok ? chh[(c0 + i) * 64] : 0.f; }
#pragma unroll
    for (int i = 0; i < 8; ++i) H = pv[i] * H + hv[i];
  }
  const size_t tokb = (size_t)b * SEQ + c * 64 + q * 16;
#pragma unroll 4
  for (int i = 0; i < 16; ++i) {
    const size_t o = (tokb + i) * 256 + g * 64 + j;
    const float h = hsl[o] + Pc[o] * H;
    const float gt = bf2f(z[(tokb + i) * LDZ + ZC_BG + g * 64 + j]);
    y[(tokb + i) * 1024 + 256 + g * 64 + j] = f2bf(h * gelu_t(gt));
  }
}

__device__ __forceinline__ void compress_item(const Params& P, int layer, int idx, const bf16_t* z, bf16_t* kcv, char* lds) {
  const int nb = idx & 15, g = (idx >> 4) & 1, b = (idx >> 5) & 7, kv = idx >> 8;
  const int tid = HTID, lane = tid & 63, w = tid >> 6, fr = lane & 15, fq = lane >> 4;
  const int n0 = nb * 16, col = (kv ? ZC_VC : ZC_KC) + g * 64;
  const bf16_t* w1t = (const bf16_t*)(P.ws + OFF_CW1 + (size_t)(layer * 2 + kv) * SZ_CW1);
  float* part = (float*)lds;
  float* hid = (float*)(lds + 34816);
  f32x4 acc[8];
#pragma unroll
  for (int jf = 0; jf < 8; ++jf) acc[jf] = zero4();
  int nn = n0 + fr; if (nn > 254) nn = 254;
  const bf16_t* zb = z + ((size_t)b * SEQ + 16 * nn) * LDZ + col + 8 * fq;
  const bf16_t* wb = w1t + (size_t)fr * 2048 + 8 * fq;
#pragma unroll 4
  for (int kk = 0; kk < 16; ++kk) {
    const int ks = 16 * w + kk, l = ks >> 1, d0 = (ks & 1) * 32;
    const bf16x8 xf = *(const bf16x8*)(zb + (size_t)l * LDZ + d0);
#pragma unroll
    for (int jf = 0; jf < 8; ++jf) { const bf16x8 wf = *(const bf16x8*)(wb + (size_t)jf * 16 * 2048 + ks * 32); acc[jf] = mfma16(wf, xf, acc[jf]); }
  }
#pragma unroll
  for (int jf = 0; jf < 8; ++jf)
#pragma unroll
    for (int e = 0; e < 4; ++e) part[(w * 16 + fr) * 132 + jf * 16 + 4 * fq + e] = acc[jf][e];
  __syncthreads();
  const float* cb1 = (const float*)(P.ws + OFF_CB1) + (layer * 2 + kv) * 128;
  {
    const int n = tid >> 4, j0 = (tid & 15) * 8;
#pragma unroll
    for (int e = 0; e < 8; ++e) { const int j = j0 + e; const float v = ((part[(0 * 16 + n) * 132 + j] + part[(1 * 16 + n) * 132 + j]) + part[(2 * 16 + n) * 132 + j]) + part[(3 * 16 + n) * 132 + j];
      hid[n * 129 + j] = gelu_t(v + cb1[j]); }
  }
  __syncthreads();
  {
    const int n = tid >> 4, d0 = (tid & 15) * 4;
    const float* w2 = P.cmp_w2 + (size_t)(layer * 2 + kv) * 128 * 64 + d0;
    const float4 bb = *(const float4*)(P.cmp_b2 + (layer * 2 + kv) * 64 + d0);
    float o0 = bb.x, o1 = bb.y, o2 = bb.z, o3 = bb.w;
#pragma unroll 8
    for (int j = 0; j < 128; ++j) { const float hv = hid[n * 129 + j]; const float4 wa = *(const float4*)(w2 + j * 64); o0 += hv * wa.x; o1 += hv * wa.y; o2 += hv * wa.z; o3 += hv * wa.w; }
    u32x2 ov; ov.x = pk2(o0, o1); ov.y = pk2(o2, o3);
    if ((n0 + n) >= 255) { ov.x = 0u; ov.y = 0u; }
    *(u32x2*)(kcv + ((size_t)((kv * 8 + b) * 2 + g) * 256 + n0 + n) * 64 + d0) = ov;
  }
  __syncthreads();
}

constexpr int NSA_KT = 0, NSA_VT = 16384, NSA_T = 33792, NSA_TW = NSA_T + 4 * 4160 * 4, NSA_IMP = NSA_TW + 4 * 640 * 4, NSA_WU = NSA_IMP + 2 * 16640;
constexpr int LDS_ST = 147456;
constexpr float LOG2E = 1.4426950408889634f;

__device__ __forceinline__ void nsa_tables(const Params& P, int g, char* lds) {
  float* T = (float*)(lds + NSA_T);
  float* TW = (float*)(lds + NSA_TW);
  const int tid = TIDX;
  for (int i = tid; i < 4160; i += 512) {
    const int n = i - 64;
    int bk = n;
    if (n >= 16) bk = 16 + (n >= 21) + (n >= 27) + (n >= 35) + (n >= 46) + (n >= 59) + (n >= 77) + (n >= 99) + (n >= 128) + (n >= 166) + (n >= 216) + (n >= 280) + (n >= 363) + (n >= 470) + (n >= 609) + (n >= 790);
#pragma unroll
    for (int r = 0; r < 4; ++r) {
      const float v = n >= 0 ? P.rel_bias[bk * 8 + g * 4 + r] * LOG2E : -__builtin_inff();
      T[r * 4160 + i] = v;
      if (i < 640) TW[r * 640 + i] = (n < 512) ? v : -__builtin_inff();
    }
  }
  __syncthreads();
}

struct KVRegs { u32x4 k0, v0; };
__device__ __forceinline__ void kv_gload(KVRegs& r, const bf16_t* kb, const bf16_t* vb, size_t stride) {
  const int tid = TIDX, row = tid >> 3, cq = tid & 7;
  r.k0 = *(const u32x4*)(kb + row * stride + cq * 8); r.v0 = *(const u32x4*)(vb + row * stride + cq * 8);
}
__device__ __forceinline__ void kv_lwrite(const KVRegs& r, char* lds, int buf) {
  const int tid = TIDX, row = tid >> 3, cq = tid & 7;
  char* kt = lds + NSA_KT + buf * 8192 + row * 128;
  *(u32x4*)(kt + ((cq ^ (row & 7)) << 4)) = r.k0;
  bf16_t* vt = (bf16_t*)(lds + NSA_VT + buf * 8704) + (cq * 8) * 68 + row;
#pragma unroll
  for (int i = 0; i < 4; ++i) { vt[(2 * i) * 68] = (bf16_t)(r.v0[i] & 0xffffu); vt[(2 * i + 1) * 68] = (bf16_t)(r.v0[i] >> 16); }
}

template <int MODE>
__device__ __forceinline__ void nsa_compute(int cur, int buf, int t, int hl, u64 mymask, const bf16x8 (&Qf)[2][2], f32x4 (&O)[4][2], float (&m)[2], float (&l)[2],
                                            const float (&inv)[2], float* impw, char* lds) {
  const int lane = TIDX & 63, fr = lane & 15, fq = lane >> 4;
  const char* kt = lds + NSA_KT + buf * 8192;
  const bf16_t* vt = (const bf16_t*)(lds + NSA_VT + buf * 8704);
  const bool selok = (MODE == 2) ? (((mymask >> cur) & 1ull) != 0ull) : true;
  const float* tb = (MODE == 3) ? (const float*)(lds + NSA_TW) + hl * 640 : (const float*)(lds + NSA_T) + hl * 4160;
  constexpr int TS = (MODE == 3) ? 640 : 4160;
  const int base = (MODE <= 1) ? (t - 31 - 16 * (cur * 64 + 4 * fq) + 64) : (t - cur * 64 - 4 * fq + 64);
#pragma unroll
  for (int s2 = 0; s2 < 2; ++s2) {
    f32x4 S[2][2] = {};
    bf16x8 kfr[2][2];
#pragma unroll
    for (int ks = 0; ks < 2; ++ks)
#pragma unroll
      for (int kk = 0; kk < 2; ++kk) kfr[ks][kk] = *(const bf16x8*)(kt + (32 * s2 + 16 * kk + fr) * 128 + (((ks * 4 + fq) ^ (fr & 7)) << 4));
    __builtin_amdgcn_s_setprio(1);
#pragma unroll
    for (int ks = 0; ks < 2; ++ks)
#pragma unroll
      for (int kk = 0; kk < 2; ++kk)
#pragma unroll
        for (int r = 0; r < 2; ++r) S[kk][r] = mfma16(kfr[ks][kk], Qf[r][ks], S[kk][r]);
    __builtin_amdgcn_s_setprio(0);
    bf16x8 Pf[2];
    float g1s[2] = {0.f, 0.f}, p3s[2] = {0.f, 0.f};
#pragma unroll
    for (int r = 0; r < 2; ++r) {
      float sv[2][4];
#pragma unroll
      for (int kk = 0; kk < 2; ++kk)
#pragma unroll
        for (int e = 0; e < 4; ++e) {
          const int off = 32 * s2 + 16 * kk + e;
          int idx;
          if (MODE <= 1) { idx = base - 16 * off; idx = idx > 0 ? idx : 0; } else idx = base - off;
          sv[kk][e] = S[kk][r][e] * (0.125f * LOG2E) + tb[r * TS + idx];
        }
      float pv[2][4];
      if (MODE == 1) {
#pragma unroll
        for (int kk = 0; kk < 2; ++kk)
#pragma unroll
          for (int e = 0; e < 4; ++e) pv[kk][e] = __builtin_amdgcn_exp2f(sv[kk][e] - m[r]) * inv[r];
#pragma unroll
        for (int kk = 0; kk < 2; ++kk) { g1s[kk] += pv[kk][0] + pv[kk][1] + pv[kk][2] + 0.5f * pv[kk][3]; p3s[kk] += 0.5f * pv[kk][3]; }
      } else {
        float mx = fmaxf(fmaxf(fmaxf(sv[0][0], sv[0][1]), fmaxf(sv[0][2], sv[0][3])), fmaxf(fmaxf(sv[1][0], sv[1][1]), fmaxf(sv[1][2], sv[1][3])));
        if (MODE == 2) mx = selok ? mx : -__builtin_inff();
        if (__any(mx > m[r] + 8.0f)) {
          mx = fmaxf(mx, __shfl_xor(mx, 16)); mx = fmaxf(mx, __shfl_xor(mx, 32));
          const float mn = fmaxf(m[r], mx), al = __builtin_amdgcn_exp2f(m[r] - mn);
          m[r] = mn; l[r] *= al;
          if (MODE != 0) {
#pragma unroll
            for (int df = 0; df < 4; ++df) O[df][r] *= al;
          }
        }
        const float me = (MODE == 2) ? (selok ? m[r] : __builtin_inff()) : m[r];
        float ps = 0.f;
#pragma unroll
        for (int kk = 0; kk < 2; ++kk)
#pragma unroll
          for (int e = 0; e < 4; ++e) { pv[kk][e] = __builtin_amdgcn_exp2f(sv[kk][e] - me); ps += pv[kk][e]; }
        l[r] += ps;
      }
      if (MODE != 0) {
        const unsigned w0 = pk2(pv[0][0], pv[0][1]), w1 = pk2(pv[0][2], pv[0][3]), w2 = pk2(pv[1][0], pv[1][1]), w3 = pk2(pv[1][2], pv[1][3]);
        u32x4 pw; pw.x = w0; pw.y = w1; pw.z = w2; pw.w = w3;
        Pf[r] = __builtin_bit_cast(bf16x8, pw);
      }
    }
    if (MODE != 0) {
      bf16x8 vfr[4];
#pragma unroll
      for (int df = 0; df < 4; ++df) {
        const bf16x4 va = *(const bf16x4*)(vt + (df * 16 + fr) * 68 + 32 * s2 + 4 * fq);
        const bf16x4 vb = *(const bf16x4*)(vt + (df * 16 + fr) * 68 + 32 * s2 + 16 + 4 * fq);
        bf16x8 vf; vf[0] = va[0]; vf[1] = va[1]; vf[2] = va[2]; vf[3] = va[3]; vf[4] = vb[0]; vf[5] = vb[1]; vf[6] = vb[2]; vf[7] = vb[3];
        vfr[df] = vf;
      }
      __builtin_amdgcn_s_setprio(1);
#pragma unroll
      for (int df = 0; df < 4; ++df)
#pragma unroll
        for (int r = 0; r < 2; ++r) O[df][r] = mfma16(vfr[df], Pf[r], O[df][r]);
      __builtin_amdgcn_s_setprio(0);
    }
    if (MODE == 1) {
#pragma unroll
      for (int kk = 0; kk < 2; ++kk) {
        const int j = cur * 16 + (2 * s2 + kk) * 4 + fq;
        atomicAdd(&impw[fr * 65 + j], g1s[kk]);
        if (j + 1 < 64) atomicAdd(&impw[fr * 65 + j + 1], p3s[kk]);
      }
    }
  }
}

template <int MODE>
__device__ __forceinline__ void nsa_branch(int first, int ntl, u64 U, const bf16_t* kbase, const bf16_t* vbase, size_t stride, int t, int hl, u64 mymask,
                                           const bf16x8 (&Qf)[2][2], f32x4 (&O)[4][2], float (&m)[2], float (&l)[2], const float (&inv)[2], float* impw, char* lds) {
  KVRegs R0, R1, R2;
  u64 rem = U;
  int seq = first, left = ntl;
#define NSA_NEXT(dst)                                                                                     \
  { if (MODE == 2) { dst = rem ? (int)__builtin_ctzll(rem) : -1; if (rem) rem &= rem - 1; }              \
    else { dst = left > 0 ? seq : -1; ++seq; --left; } }
#define NSA_GLOAD(R, ti) kv_gload(R, kbase + (size_t)(ti) * 64 * stride, vbase + (size_t)(ti) * 64 * stride, stride)
  int tcur, t1, t2, t3;
  NSA_NEXT(tcur); NSA_NEXT(t1); NSA_NEXT(t2);
  if (tcur >= 0) NSA_GLOAD(R0, tcur);
  if (t1 >= 0) NSA_GLOAD(R1, t1);
  if (t2 >= 0) NSA_GLOAD(R2, t2);
  if (tcur >= 0) kv_lwrite(R0, lds, 0);
  __syncthreads();
  NSA_NEXT(t3);
  if (t3 >= 0) NSA_GLOAD(R0, t3);
  int buf = 0;
#define NSA_STEP(RW)                                                                                      \
  if (tcur < 0) break;                                                                                    \
  nsa_compute<MODE>(tcur, buf, t, hl, mymask, Qf, O, m, l, inv, impw, lds);                               \
  if (t1 >= 0) kv_lwrite(RW, lds, buf ^ 1);                                                               \
  __syncthreads();                                                                                        \
  buf ^= 1; tcur = t1; t1 = t2; t2 = t3;                                                                  \
  NSA_NEXT(t3);                                                                                           \
  if (t3 >= 0) NSA_GLOAD(RW, t3);
  for (;;) {
    NSA_STEP(R1)
    NSA_STEP(R2)
    NSA_STEP(R0)
  }
#undef NSA_STEP
#undef NSA_GLOAD
#undef NSA_NEXT
}

#define NSA_RESET()                                                                         \
  _Pragma("unroll") for (int r = 0; r < 2; ++r) { asm volatile("v_mov_b32 %0, 0xf149f2ca" : "=v"(m[r])); l[r] = 0.f; }               \
  _Pragma("unroll") for (int df = 0; df < 4; ++df) _Pragma("unroll") for (int r = 0; r < 2; ++r) O[df][r] = zero4();

__device__ __forceinline__ void nsa_item(const Params& P, int b, int g, int c, const bf16_t* z, const bf16_t* kcv, bf16_t* y, char* lds) {
  const int tid = TIDX, lane = tid & 63, w8 = tid >> 6, qg = w8 & 3, hp = w8 >> 2, fr = lane & 15, fq = lane >> 4;
  const size_t tokb = (size_t)b * SEQ;
  const int t = c * 64 + 16 * qg + fr;
  const bf16_t* zq = z + (tokb + t) * LDZ;
  const int hb = g * 4 + hp * 2;
  bf16x8 Qf[2][2];
#pragma unroll
  for (int r = 0; r < 2; ++r)
#pragma unroll
    for (int ks = 0; ks < 2; ++ks) Qf[r][ks] = *(const bf16x8*)(zq + ZC_Q + g * 256 + (hp * 2 + r) * 64 + ks * 32 + 8 * fq);
  float* impw = (float*)(lds + NSA_IMP) + (hp * 4 + qg) * (16 * 65);
  for (int i = lane; i < 16 * 65; i += 64) impw[i] = 0.f;
  f32x4 O[4][2];
  float m[2], l[2], inv[2];
  bf16_t* yo = y + (tokb + t) * 1024 + 512 + g * 256 + hp * 128 + 4 * fq;
  const bf16_t* kc = kcv + (size_t)((0 * 8 + b) * 2 + g) * 256 * 64;
  const bf16_t* vc = kcv + (size_t)((1 * 8 + b) * 2 + g) * 256 * 64;
  const int nct = ((4 * c + 2) >> 6) + 1;
  NSA_RESET();
  inv[0] = 0.f; inv[1] = 0.f;
  nsa_branch<0>(0, nct, 0ull, kc, vc, 64, t, hp * 2, 0ull, Qf, O, m, l, inv, impw, lds);
#pragma unroll
  for (int r = 0; r < 2; ++r) { float lt = l[r]; lt += __shfl_xor(lt, 16); lt += __shfl_xor(lt, 32); inv[r] = lt > 0.f ? 1.f / lt : 0.f; }
  nsa_branch<1>(0, nct, 0ull, kc, vc, 64, t, hp * 2, 0ull, Qf, O, m, l, inv, impw, lds);
#pragma unroll
  for (int r = 0; r < 2; ++r) {
    const float gt = sigm(bf2f(zq[ZC_GC + hb + r]));
#pragma unroll
    for (int df = 0; df < 4; ++df) { u32x2 o; o.x = pk2(O[df][r][0] * gt, O[df][r][1] * gt); o.y = pk2(O[df][r][2] * gt, O[df][r][3] * gt); *(u32x2*)(yo + r * 64 + df * 16) = o; }
  }
  __syncthreads();
  u64 wU = 0ull;
  {
    const float* imp0 = (const float*)(lds + NSA_IMP) + qg * (16 * 65);
    const float* imp1 = imp0 + 4 * (16 * 65);
    u64* MK = (u64*)(lds + NSA_WU) + 8;
    const u64 V = (c >= 63) ? ~0ull : ((1ull << (c + 1)) - 1ull);
    const bool forced = (lane == 0) | (lane == c) | (lane == c - 1);
    for (int q8 = 0; q8 < 8; ++q8) {
      const int qq = hp * 8 + q8;
      const float sv = imp0[qq * 65 + lane] + imp1[qq * 65 + lane];
      const unsigned u = __float_as_uint(forced ? 1e4f : sv);
      u64 mk = V;
      if (c + 1 > 16) {
        unsigned thr = 0u;
        for (int bb = 30; bb >= 0; --bb) { const unsigned cand = thr | (1u << bb); const u64 ge = __ballot(u >= cand) & V; if (__popcll(ge) >= 16) thr = cand; }
        const u64 G = __ballot(u > thr) & V, E = __ballot(u == thr) & V;
        const int need = 16 - (int)__popcll(G);
        const int below = (int)__popcll(E & ((1ull << lane) - 1ull));
        const bool se = (((E >> lane) & 1ull) != 0ull) && (below < need);
        mk = G | __ballot(se);
      }
      if (lane == 0) MK[qg * 16 + qq] = mk;
      wU |= mk;
    }
  }
  u64* WU = (u64*)(lds + NSA_WU);
  if (lane == 0) WU[w8] = wU;
  __syncthreads();
  const u64 U = WU[0] | WU[1] | WU[2] | WU[3] | WU[4] | WU[5] | WU[6] | WU[7];
  const u64 mymask = ((const u64*)(lds + NSA_WU) + 8)[qg * 16 + fr];
  for (int br = 0; br < 2; ++br) {
    NSA_RESET();
    int zg;
    if (br == 0) {
      nsa_branch<2>(0, 0, U, z + tokb * LDZ + ZC_KS + g * 64, z + tokb * LDZ + ZC_VS + g * 64, LDZ, t, hp * 2, mymask, Qf, O, m, l, inv, impw, lds);
      zg = ZC_GS;
    } else {
      const int kt0 = c > 8 ? c - 8 : 0;
      nsa_branch<3>(kt0, c - kt0 + 1, 0ull, z + tokb * LDZ + ZC_KW + g * 64, z + tokb * LDZ + ZC_VW + g * 64, LDZ, t, hp * 2, 0ull, Qf, O, m, l, inv, impw, lds);
      zg = ZC_GW;
    }
#pragma unroll
    for (int r = 0; r < 2; ++r) {
      float lt = l[r]; lt += __shfl_xor(lt, 16); lt += __shfl_xor(lt, 32);
      const float gt = sigm(bf2f(zq[zg + hb + r])) * (lt > 0.f ? 1.f / lt : 0.f);
#pragma unroll
      for (int df = 0; df < 4; ++df) {
        bf16_t* yp = yo + r * 64 + df * 16;
        const u32x2 pr = *(const u32x2*)yp;
        u32x2 o; o.x = pk2(__uint_as_float(pr.x << 16) + O[df][r][0] * gt, __uint_as_float(pr.x & 0xffff0000u) + O[df][r][1] * gt);
        o.y = pk2(__uint_as_float(pr.y << 16) + O[df][r][2] * gt, __uint_as_float(pr.y & 0xffff0000u) + O[df][r][3] * gt);
        *(u32x2*)yp = o;
      }
    }
  }
  __syncthreads();
}

__device__ __forceinline__ void run_phase(const Params& P, int ph, char* lds) {
  char* ws = P.ws;
  asm volatile("" : "+s"(ws));
  bf16_t* abuf = (bf16_t*)(ws + OFF_A);
  bf16_t* big = (bf16_t*)(ws + OFF_BIG);
  bf16_t* fbuf = (bf16_t*)(ws + OFF_F);
  bf16_t* h16 = (bf16_t*)(ws + OFF_F + (size_t)M_TOK * 1024 * 2);
  float* hsl = (float*)(ws + OFF_F); float* Pc = hsl + (size_t)M_TOK * 256;
  bf16_t* kcv = (bf16_t*)(ws + OFF_KC);
  float* carryP = (float*)(ws + OFF_CARRY); float* carryH = carryP + 8 * 4 * 64 * 64;
  if (ph == 0) { prep_phase(P, lds); return; }
  const int layer = (ph - 1) / 13, sp = (ph - 1) % 13;
  const float* ng = P.norm_g + (size_t)layer * 8 * 1024;
#ifdef ONLY_SP
  if (sp != ONLY_SP) return;
#endif
  switch (sp) {
    case 0: case 8: {
      const int lj = layer * 2 + (sp == 8);
      gemm_up_phase(abuf, (const bf16_t*)(ws + OFF_WGU + lj * SZ_WGU), big, lds);
    } break;
    case 1: case 9: {
      const int lj = layer * 2 + (sp == 9);
      gemm_bf16_phase(big, DFF, (const bf16_t*)(ws + OFF_WD + lj * SZ_WD), DFF, 4, fbuf, 1024, lds);
    } break;
    case 2: resnorm_phase(layer == 0 ? P.x : nullptr, h16, nullptr, h16, fbuf, 0.5f, ng + 1 * 1024, ng + 2 * 1024, abuf); break;
    case 3: gemm_bf16_phase(abuf, 1024, (const bf16_t*)(ws + OFF_WIN + layer * SZ_WIN), 1024, LDZ / 256, big, LDZ, lds); break;
    case 4: {
      const int hb = HBLK; char* hl = lds + hb * 65536;
      for (int it = blockIdx.x * 2 + hb; it < 512; it += gridDim.x * 2) compress_item(P, layer, it, big, kcv, hl);
      for (int it = blockIdx.x * 2 + hb; it < 1024; it += gridDim.x * 2) mixA_item(P, layer, it, big, abuf, hl);
      for (int it = blockIdx.x * 2 + hb; it < 2048; it += gridDim.x * 2) mixB1_item(P, layer, it, big, hsl, Pc, carryP, carryH, hl);
    } break;
    case 5: {
      nsa_tables(P, blockIdx.x & 1, lds);
      for (int it = blockIdx.x; it < 1024; it += gridDim.x) {
        const int rnd = it / 256, pos = it % 256;
        const int c = (rnd & 1) ? (rnd >> 1) * 16 + (pos >> 4) : 63 - (rnd >> 1) * 16 - (pos >> 4);
        const int bg = pos & 15;
        nsa_item(P, bg >> 1, bg & 1, c, big, kcv, abuf, lds);
      }
      const int hb = HBLK;
      for (int it = blockIdx.x * 2 + hb; it < 2048; it += gridDim.x * 2) mixB2_item(it, big, hsl, Pc, carryP, carryH, abuf);
    } break;
    case 6: gemm_bf16_phase(abuf, 1024, (const bf16_t*)(ws + OFF_WOUT + layer * SZ_SQ), 1024, 4, fbuf, 1024, lds); break;
    case 7: resnorm_phase(nullptr, h16, nullptr, h16, fbuf, 1.0f, ng + 3 * 1024, ng + 4 * 1024, abuf); break;
    case 10:
      gemm_bf16_phase((const bf16_t*)(ws + OFF_PBF) + (size_t)layer * M_TOK * 256, 256, (const bf16_t*)(ws + OFF_WPP + layer * SZ_WPP), 256, 4, big, 1024, lds);
      resnorm_phase(nullptr, h16, nullptr, h16, fbuf, 0.5f, ng + 5 * 1024, ng + 6 * 1024, abuf);
      break;
    case 11: gemm_ple_phase(abuf, (const bf16_t*)(ws + OFF_WPG + layer * SZ_SQ), big, fbuf, lds); break;
    case 12: resnorm_phase(nullptr, h16, layer == 0 ? nullptr : P.out, layer == 0 ? h16 : nullptr, fbuf, 1.0f, ng + 7 * 1024, layer == 0 ? P.norm_g + 8 * 1024 : nullptr, layer == 0 ? abuf : nullptr); break;
  }
}

#define XB_TMO      128
#define XB_XCNT(j)  (256  + 64 * (j))
#define XB_XSUB(j)  (1280 + 64 * (j))
#define XB_XGEN(j)  (2304 + 64 * (j))
#define XB_TOP      3328
#define XB_TOPGEN   3392
#define XCD_BAR_WORDS 3456
#define XB_SPIN_CAP (1u << 20)
#define LAS __attribute__((address_space(3)))
__device__ __forceinline__ unsigned xb_ld(unsigned* p)              { return __hip_atomic_load(p, __ATOMIC_RELAXED, __HIP_MEMORY_SCOPE_AGENT); }
__device__ __forceinline__ unsigned xb_add(unsigned* p, unsigned v) { return __hip_atomic_fetch_add(p, v, __ATOMIC_RELAXED, __HIP_MEMORY_SCOPE_AGENT); }
__device__ __forceinline__ unsigned xb_xcc_id() { return (unsigned)__builtin_amdgcn_s_getreg((3 << 11) | 20) & 0xFu; }
#define XB_SPIN(cond, bar) do { unsigned _sp = 0; while (cond) { __builtin_amdgcn_s_sleep(1); \
    if ((++_sp & 255u) == 0u) { if (xb_ld(&(bar)[XB_TMO])) break; if (_sp > XB_SPIN_CAP) { atomicAdd(&(bar)[XB_TMO], 1u); break; } } } } while (0)
struct XcdBarrier { unsigned* bar; unsigned x; volatile LAS unsigned* st; };
__device__ __forceinline__ XcdBarrier xcd_barrier_post(unsigned* bar, volatile LAS unsigned* st) {
    XcdBarrier b; b.bar = bar; b.x = xb_xcc_id(); b.st = st;
    if (threadIdx.x == 0) (void)xb_add(&bar[XB_XCNT(b.x)], 1u);
    return b;
}
__device__ __forceinline__ void xcd_barrier_complete(unsigned* bar, unsigned x, unsigned& nloc, unsigned& nx) {
    const unsigned G = gridDim.x * gridDim.y * gridDim.z;
    unsigned sum, cnt, mine, sp = 0u;
    for (;;) {
        sum = 0u; cnt = 0u; mine = 0u;
#pragma unroll
        for (unsigned j = 0; j < 16; ++j) { const unsigned c = xb_ld(&bar[XB_XCNT(j)]); sum += c; cnt += (c > 0u) ? 1u : 0u; mine = (j == x) ? c : mine; }
        if (sum == G) break;
        __builtin_amdgcn_s_sleep(1);
        if ((++sp & 255u) == 0u) { if (xb_ld(&bar[XB_TMO])) break; if (sp > XB_SPIN_CAP) { atomicAdd(&bar[XB_TMO], 1u); break; } }
    }
    nloc = mine > 0u ? mine : 1u; nx = cnt > 0u ? cnt : 1u;
}
__device__ __forceinline__ void xcd_barrier(const XcdBarrier& b) {
    asm volatile("s_waitcnt vmcnt(0)" ::: "memory");
    __syncthreads();
    if (threadIdx.x == 0) {
        unsigned* bar = b.bar;
        __builtin_amdgcn_s_waitcnt(0);
        unsigned nloc = b.st[0], nx = b.st[1];
        if (nloc == 0u) { xcd_barrier_complete(bar, b.x, nloc, nx); b.st[0] = nloc; b.st[1] = nx; }
        const unsigned old = xb_add(&bar[XB_XSUB(b.x)], 1u);
        const unsigned gen = old / nloc;
        if (old + 1u == (gen + 1u) * nloc) {
            __builtin_amdgcn_fence(__ATOMIC_RELEASE, "agent");
            asm volatile("s_waitcnt vmcnt(0)" ::: "memory");
            const unsigned og = xb_add(&bar[XB_TOP], 1u);
            const unsigned tg = og / nx;
            if (og + 1u == (tg + 1u) * nx) xb_add(&bar[XB_TOPGEN], 1u);
            else XB_SPIN(xb_ld(&bar[XB_TOPGEN]) == tg, bar);
            __builtin_amdgcn_fence(__ATOMIC_ACQUIRE, "agent");
            xb_add(&bar[XB_XGEN(b.x)], 1u);
            asm volatile("s_waitcnt vmcnt(0)" ::: "memory");
        } else {
            XB_SPIN(xb_ld(&bar[XB_XGEN(b.x)]) == gen, bar);
            __builtin_amdgcn_fence(__ATOMIC_ACQUIRE, "agent");
            asm volatile("s_waitcnt vmcnt(0)" ::: "memory");
        }
    }
    __syncthreads();
}

constexpr int LDS_BYTES = LDS_ST + 16;
__global__ void __launch_bounds__(512, 2) fwd_megakernel(Params P) {
  __shared__ __attribute__((aligned(16))) char lds[LDS_BYTES];
  cg::grid_group grid = cg::this_grid();
  volatile LAS unsigned* st = (volatile LAS unsigned*)(lds + LDS_ST);
  if (threadIdx.x == 0) { st[0] = 0u; st[1] = 0u; }
  __syncthreads();
  XcdBarrier xb = xcd_barrier_post((unsigned*)(P.ws + OFF_BAR), st);
  if (P.ws == nullptr) grid.sync();
  for (int ph = 0; ph < NPHASE; ++ph) {
    run_phase(P, ph, lds);
    if (ph + 1 < NPHASE) xcd_barrier(xb);
  }
}

__global__ void __launch_bounds__(512, 2) phase_kernel(Params P, int ph) {
  __shared__ __attribute__((aligned(16))) char lds[LDS_BYTES];
  run_phase(P, ph, lds);
}

extern "C" void kernel_launch(void* const* d_in, const int* in_sizes, int n_in, void* d_out, int out_size, void* d_ws, size_t ws_size, hipStream_t stream) {
  Params P{};
  const float** pp = (const float**)&P;
  for (int i = 0; i < 26; ++i) pp[i] = (const float*)d_in[i];
  P.out = (float*)d_out;
  P.ws = (char*)d_ws;
  if (ws_size < WS_NEED) { fprintf(stderr, "workspace too small: %zu < %zu\n", ws_size, (size_t)WS_NEED); return; }
#if MK_FUSED
  static int grid_blocks = 0;
  if (!grid_blocks) {
    int dev = 0, cus = 0, per_cu = 0;
    (void)hipGetDevice(&dev);
    (void)hipDeviceGetAttribute(&cus, hipDeviceAttributeMultiprocessorCount, dev);
    (void)hipOccupancyMaxActiveBlocksPerMultiprocessor(&per_cu, fwd_megakernel, 512, 0);
    if (per_cu > 1) per_cu = 1;
    if (per_cu < 1) per_cu = 1;
    grid_blocks = cus * per_cu;
  }
  (void)hipMemsetAsync((char*)d_ws + OFF_BAR, 0, XCD_BAR_WORDS * 4, stream);
  void* args[] = {&P};
  hipError_t e = hipLaunchCooperativeKernel((void*)fwd_megakernel, dim3(grid_blocks), dim3(512), args, 0, stream);
  if (e != hipSuccess) fprintf(stderr, "cooperative launch failed: %s (grid %d)\n", hipGetErrorString(e), grid_blocks);
#else
  for (int ph = 0; ph < NPHASE; ++ph) phase_kernel<<<256, 512, 0, stream>>>(P, ph);
#endif
}
```

```cpp
#include <hip/hip_runtime.h>
#include <hip/hip_cooperative_groups.h>
#include <cstdint>
#include <cstdio>
namespace cg = cooperative_groups;

#ifndef MK_FUSED
#define MK_FUSED 1
#endif

typedef unsigned short bf16_t;
typedef short bf16x8 __attribute__((ext_vector_type(8)));
typedef short bf16x4 __attribute__((ext_vector_type(4)));
typedef float f32x4 __attribute__((ext_vector_type(4)));
typedef unsigned long long u64;
typedef unsigned u32x4 __attribute__((ext_vector_type(4)));
typedef unsigned u32x2 __attribute__((ext_vector_type(2)));

constexpr int M_TOK = 32768, DM = 1024, DFF = 2816, NGU = 5632, NIN = 2328, LDZ = 2560, SEQ = 4096;
constexpr int NPHASE = 27;
constexpr int ZC_AU = 0, ZC_AV = 256, ZC_BX = 512, ZC_BG = 768, ZC_Q = 1024, ZC_KC = 1536, ZC_VC = 1664, ZC_KS = 1792, ZC_VS = 1920,
              ZC_KW = 2048, ZC_VW = 2176, ZC_GC = 2304, ZC_GS = 2312, ZC_GW = 2320;

constexpr size_t SZ_WGU = (size_t)NGU * 1024 * 2, SZ_WD = (size_t)1024 * DFF * 2, SZ_WIN = (size_t)LDZ * 1024 * 2, SZ_SQ = (size_t)1024 * 1024 * 2,
                 SZ_WPP = (size_t)1024 * 256 * 2, SZ_CW1 = (size_t)128 * 2048 * 2;
constexpr size_t OFF_WGU = 0;
constexpr size_t OFF_WD = OFF_WGU + 4 * SZ_WGU;
constexpr size_t OFF_WIN = OFF_WD + 4 * SZ_WD;
constexpr size_t OFF_WOUT = OFF_WIN + 2 * SZ_WIN;
constexpr size_t OFF_WPG = OFF_WOUT + 2 * SZ_SQ;
constexpr size_t OFF_WPP = OFF_WPG + 2 * SZ_SQ;
constexpr size_t OFF_CW1 = OFF_WPP + 2 * SZ_WPP;
constexpr size_t OFF_CB1 = OFF_CW1 + 4 * SZ_CW1;
constexpr size_t OFF_SGUW = OFF_CB1 + 4096;
constexpr size_t OFF_WAT = OFF_SGUW + 2 * 4 * 128 * 128 * 2;
constexpr size_t OFF_WXT = OFF_WAT + 2 * 4 * 64 * 64 * 2;
constexpr size_t OFF_PBF = OFF_WXT + 2 * 4 * 64 * 64 * 2;
constexpr size_t OFF_A = OFF_PBF + (size_t)2 * M_TOK * 256 * 2;
constexpr size_t OFF_BIG = OFF_A + (size_t)M_TOK * 1024 * 2;
constexpr size_t OFF_F = OFF_BIG + (size_t)M_TOK * DFF * 2;
constexpr size_t OFF_KC = OFF_F + (size_t)M_TOK * 1024 * 4;
constexpr size_t OFF_CARRY = OFF_KC + (size_t)2 * 8 * 2 * 256 * 64 * 2;
constexpr size_t OFF_BAR = OFF_CARRY + (size_t)2 * 8 * 4 * 64 * 64 * 4;
constexpr size_t WS_NEED = OFF_BAR + 16384;

struct Params {
  const float *x, *p, *rel_bias, *norm_g, *ffn_wg, *ffn_wu, *ffn_wd, *w_in, *w_out, *sgu_ng, *sgu_w, *sgu_b, *conv_w, *conv_b,
      *lru_wa, *lru_ba, *lru_wx, *lru_bx, *lru_lam, *cmp_pos, *cmp_w1, *cmp_b1, *cmp_w2, *cmp_b2, *ple_wg, *ple_wp;
  float* out;
  char* ws;
};

__device__ __forceinline__ int opaque_tid() { int t; asm volatile("v_mov_b32 %0, %1" : "=v"(t) : "v"(threadIdx.x)); return t; }
#define TIDX opaque_tid()
#define HTID (opaque_tid() & 255)
#define HBLK (opaque_tid() >> 8)
__device__ __forceinline__ float bf2f(bf16_t v) { return __uint_as_float(((unsigned)v) << 16); }
__device__ __forceinline__ bf16_t f2bf(float f) { unsigned u = __float_as_uint(f); u += 0x7fffu + ((u >> 16) & 1u); return (bf16_t)(u >> 16); }
typedef float f32x2v __attribute__((ext_vector_type(2)));
typedef __bf16 bf16x2v __attribute__((ext_vector_type(2)));
__device__ __forceinline__ unsigned pk2(float lo, float hi) { const f32x2v v = {lo, hi}; const bf16x2v r = __builtin_convertvector(v, bf16x2v); return __builtin_bit_cast(unsigned, r); }
__device__ __forceinline__ float sigm(float x) { return __builtin_amdgcn_rcpf(1.f + __expf(-x)); }
__device__ __forceinline__ float gelu_t(float x) { float u = 0.7978845608028654f * (x + 0.044715f * x * x * x); return x * __builtin_amdgcn_rcpf(1.f + __expf(-2.f * u)); }
__device__ __forceinline__ float silu_f(float x) { return x * __builtin_amdgcn_rcpf(1.f + __expf(-x)); }
__device__ __forceinline__ f32x4 mfma16(bf16x8 a, bf16x8 b, f32x4 c) { return __builtin_amdgcn_mfma_f32_16x16x32_bf16(a, b, c, 0, 0, 0); }
__device__ __forceinline__ void glds16(const void* g, void* l) {
  __builtin_amdgcn_global_load_lds((const __attribute__((address_space(1))) unsigned*)g, (__attribute__((address_space(3))) unsigned*)l, 16, 0, 0);
}
__device__ __forceinline__ f32x4 zero4() { f32x4 z; asm volatile("v_mov_b32 %0, 0\n\tv_mov_b32 %1, 0\n\tv_mov_b32 %2, 0\n\tv_mov_b32 %3, 0" : "=v"(z[0]), "=v"(z[1]), "=v"(z[2]), "=v"(z[3])); return z; }
__device__ __forceinline__ float wave_sum(float v) {
#pragma unroll
  for (int o = 32; o > 0; o >>= 1) v += __shfl_xor(v, o);
  return v;
}
__device__ __forceinline__ void unpack8(const u32x4 u, float* f) {
  f[0] = __uint_as_float(u.x << 16); f[1] = __uint_as_float(u.x & 0xffff0000u);
  f[2] = __uint_as_float(u.y << 16); f[3] = __uint_as_float(u.y & 0xffff0000u);
  f[4] = __uint_as_float(u.z << 16); f[5] = __uint_as_float(u.z & 0xffff0000u);
  f[6] = __uint_as_float(u.w << 16); f[7] = __uint_as_float(u.w & 0xffff0000u);
}

__device__ __forceinline__ void tr_cvt(const float* __restrict__ src, int N, int K, bf16_t* __restrict__ dst, int ldd, int rs, int ro, char* ldsc, int& rot) {
  const int ntn = (N + 63) >> 6, nt = ntn * (K >> 6), hb = HBLK, tid = HTID;
  float* lds = (float*)(ldsc + hb * 65536);
  int vb = (int)blockIdx.x - rot; if (vb < 0) vb += gridDim.x;
  rot = (rot + (nt + 5) / 6) % (int)gridDim.x;
  for (int t0 = vb * 6; t0 < nt; t0 += gridDim.x * 6) {
    float4 v[3][4];
#pragma unroll
    for (int u = 0; u < 3; ++u) {
      const int tile = t0 + hb * 3 + u, tk = tile / ntn, tn = tile - tk * ntn, k0 = tk * 64, n0 = tn * 64;
      const bool active = tile < nt;
#pragma unroll
      for (int ps = 0; ps < 4; ++ps) {
        const int i = ps * 16 + (tid >> 4), j = (tid & 15) * 4;
        v[u][ps] = make_float4(0.f, 0.f, 0.f, 0.f);
        if (active && n0 + j < N) v[u][ps] = *(const float4*)(src + (size_t)(k0 + i) * N + n0 + j);
      }
    }
#pragma unroll
    for (int u = 0; u < 3; ++u)
#pragma unroll
      for (int ps = 0; ps < 4; ++ps) {
        const int i = ps * 16 + (tid >> 4), j = (tid & 15) * 4;
        float* d = lds + u * 4160 + i * 65 + j; d[0] = v[u][ps].x; d[1] = v[u][ps].y; d[2] = v[u][ps].z; d[3] = v[u][ps].w;
      }
    __syncthreads();
#pragma unroll
    for (int u = 0; u < 3; ++u) {
      const int tile = t0 + hb * 3 + u, tk = tile / ntn, tn = tile - tk * ntn, k0 = tk * 64, n0 = tn * 64;
      const int j = tid >> 2, kq = tid & 3, n = n0 + j;
      if (tile < nt && n < N) {
        const float* l = lds + u * 4160;
        unsigned w[8];
#pragma unroll
        for (int q = 0; q < 8; ++q) w[q] = pk2(l[(kq * 16 + 2 * q) * 65 + j], l[(kq * 16 + 2 * q + 1) * 65 + j]);
        bf16_t* o = dst + (size_t)((n >> 4) * rs + (n & 15) + ro) * ldd + k0 + kq * 16;
        u32x4 w0, w1; w0.x = w[0]; w0.y = w[1]; w0.z = w[2]; w0.w = w[3]; w1.x = w[4]; w1.y = w[5]; w1.z = w[6]; w1.w = w[7];
        *(u32x4*)o = w0; *(u32x4*)(o + 8) = w1;
      }
    }
    __syncthreads();
  }
}

struct RowRegs { float4 h[4]; u32x2 f[4]; };
__device__ __forceinline__ void rn_load(RowRegs& R, const float* hin32, const bf16_t* hin16, const bf16_t* f, int row, int lane) {
  if (hin32) {
#pragma unroll
    for (int i = 0; i < 4; ++i) R.h[i] = *(const float4*)(hin32 + (size_t)row * 1024 + i * 256 + lane * 4);
  } else {
#pragma unroll
    for (int i = 0; i < 4; ++i) { const u32x2 v = *(const u32x2*)(hin16 + (size_t)row * 1024 + i * 256 + lane * 4);
      R.h[i].x = __uint_as_float(v.x << 16); R.h[i].y = __uint_as_float(v.x & 0xffff0000u); R.h[i].z = __uint_as_float(v.y << 16); R.h[i].w = __uint_as_float(v.y & 0xffff0000u); }
  }
  if (f) {
#pragma unroll
    for (int i = 0; i < 4; ++i) R.f[i] = *(const u32x2*)(f + (size_t)row * 1024 + i * 256 + lane * 4);
  }
}
__device__ __forceinline__ void rn_proc(RowRegs& R, float* hout32, bf16_t* hout16, bool has_f, float scale, const float4 (&gpo)[4], const float4 (&gpr)[4], bf16_t* a, int row, int lane) {
  if (has_f) {
    float fv[4][4]; float ss = 0.f;
#pragma unroll
    for (int i = 0; i < 4; ++i) {
      fv[i][0] = __uint_as_float(R.f[i].x << 16); fv[i][1] = __uint_as_float(R.f[i].x & 0xffff0000u);
      fv[i][2] = __uint_as_float(R.f[i].y << 16); fv[i][3] = __uint_as_float(R.f[i].y & 0xffff0000u);
      ss += fv[i][0] * fv[i][0] + fv[i][1] * fv[i][1] + fv[i][2] * fv[i][2] + fv[i][3] * fv[i][3];
    }
    ss = wave_sum(ss);
    const float r = rsqrtf(ss * (1.f / 1024.f) + 1e-6f) * scale;
#pragma unroll
    for (int i = 0; i < 4; ++i) { const float4 g = gpo[i];
      R.h[i].x += fv[i][0] * r * g.x; R.h[i].y += fv[i][1] * r * g.y; R.h[i].z += fv[i][2] * r * g.z; R.h[i].w += fv[i][3] * r * g.w; }
  }
  if (hout32) {
#pragma unroll
    for (int i = 0; i < 4; ++i) *(float4*)(hout32 + (size_t)row * 1024 + i * 256 + lane * 4) = R.h[i];
  }
  if (hout16) {
#pragma unroll
    for (int i = 0; i < 4; ++i) { u32x2 o; o.x = pk2(R.h[i].x, R.h[i].y); o.y = pk2(R.h[i].z, R.h[i].w); *(u32x2*)(hout16 + (size_t)row * 1024 + i * 256 + lane * 4) = o; }
  }
  if (a) {
    float ss = 0.f;
#pragma unroll
    for (int i = 0; i < 4; ++i) ss += R.h[i].x * R.h[i].x + R.h[i].y * R.h[i].y + R.h[i].z * R.h[i].z + R.h[i].w * R.h[i].w;
    ss = wave_sum(ss);
    const float r = rsqrtf(ss * (1.f / 1024.f) + 1e-6f);
#pragma unroll
    for (int i = 0; i < 4; ++i) { const float4 g = gpr[i];
      u32x2 o; o.x = pk2(R.h[i].x * r * g.x, R.h[i].y * r * g.y); o.y = pk2(R.h[i].z * r * g.z, R.h[i].w * r * g.w);
      *(u32x2*)(a + (size_t)row * 1024 + i * 256 + lane * 4) = o; }
  }
}
__device__ __forceinline__ void resnorm_phase(const float* hin32, const bf16_t* hin16, float* hout32, bf16_t* hout16, const bf16_t* f, float scale, const float* gpost, const float* gpre, bf16_t* a) {
  const int tid = TIDX, lane = tid & 63, stride = gridDim.x * 8;
  int r0 = blockIdx.x * 8 + (tid >> 6), r1 = r0 + 2 * stride;
  RowRegs A0, A1, B0, B1;
  float4 gpo[4], gpr[4];
#pragma unroll
  for (int i = 0; i < 4; ++i) { gpo[i] = f ? *(const float4*)(gpost + i * 256 + lane * 4) : make_float4(0.f, 0.f, 0.f, 0.f); gpr[i] = a ? *(const float4*)(gpre + i * 256 + lane * 4) : make_float4(0.f, 0.f, 0.f, 0.f); }
  const bool hf = f != nullptr;
  if (r0 < M_TOK) { rn_load(A0, hin32, hin16, f, r0, lane); rn_load(A1, hin32, hin16, f, r0 + stride, lane); }
  for (;;) {
    if (r0 >= M_TOK) break;
    if (r1 < M_TOK) { rn_load(B0, hin32, hin16, f, r1, lane); rn_load(B1, hin32, hin16, f, r1 + stride, lane); }
    rn_proc(A0, hout32, hout16, hf, scale, gpo, gpr, a, r0, lane); rn_proc(A1, hout32, hout16, hf, scale, gpo, gpr, a, r0 + stride, lane);
    r0 += 4 * stride;
    if (r1 >= M_TOK) break;
    if (r0 < M_TOK) { rn_load(A0, hin32, hin16, f, r0, lane); rn_load(A1, hin32, hin16, f, r0 + stride, lane); }
    rn_proc(B0, hout32, hout16, hf, scale, gpo, gpr, a, r1, lane); rn_proc(B1, hout32, hout16, hf, scale, gpo, gpr, a, r1 + stride, lane);
    r1 += 4 * stride;
  }
}

__device__ __forceinline__ void prep_phase(const Params& P, char* ldsc) {
  char* ws = P.ws;
  int rot = 0;
  for (int l = 0; l < 2; ++l) {
    for (int j = 0; j < 2; ++j) {
      const int lj = l * 2 + j;
      bf16_t* wgu = (bf16_t*)(ws + OFF_WGU + lj * SZ_WGU);
      tr_cvt(P.ffn_wg + (size_t)lj * 1024 * DFF, DFF, 1024, wgu, 1024, 32, 0, ldsc, rot);
      tr_cvt(P.ffn_wu + (size_t)lj * 1024 * DFF, DFF, 1024, wgu, 1024, 32, 16, ldsc, rot);
      tr_cvt(P.ffn_wd + (size_t)lj * DFF * 1024, 1024, DFF, (bf16_t*)(ws + OFF_WD + lj * SZ_WD), DFF, 16, 0, ldsc, rot);
      tr_cvt(P.cmp_w1 + (size_t)lj * 2048 * 128, 128, 2048, (bf16_t*)(ws + OFF_CW1 + lj * SZ_CW1), 2048, 16, 0, ldsc, rot);
    }
    tr_cvt(P.w_in + (size_t)l * 1024 * NIN, NIN, 1024, (bf16_t*)(ws + OFF_WIN + l * SZ_WIN), 1024, 16, 0, ldsc, rot);
    tr_cvt(P.w_out + (size_t)l * 1024 * 1024, 1024, 1024, (bf16_t*)(ws + OFF_WOUT + l * SZ_SQ), 1024, 16, 0, ldsc, rot);
    tr_cvt(P.ple_wg + (size_t)l * 1024 * 1024, 1024, 1024, (bf16_t*)(ws + OFF_WPG + l * SZ_SQ), 1024, 16, 0, ldsc, rot);
    tr_cvt(P.ple_wp + (size_t)l * 256 * 1024, 1024, 256, (bf16_t*)(ws + OFF_WPP + l * SZ_WPP), 256, 16, 0, ldsc, rot);
    for (int g = 0; g < 4; ++g) {
      tr_cvt(P.lru_wa + (size_t)(l * 4 + g) * 4096, 64, 64, (bf16_t*)(ws + OFF_WAT) + (l * 4 + g) * 4096, 64, 16, 0, ldsc, rot);
      tr_cvt(P.lru_wx + (size_t)(l * 4 + g) * 4096, 64, 64, (bf16_t*)(ws + OFF_WXT) + (l * 4 + g) * 4096, 64, 16, 0, ldsc, rot);
    }
  }
  const int tid = TIDX, gtid = blockIdx.x * 512 + tid, gn = gridDim.x * 512;
  for (int i = gtid; i < 2 * (LDZ - NIN) * 1024 / 8; i += gn) {
    const int l = i / ((LDZ - NIN) * 128), r = i - l * ((LDZ - NIN) * 128);
    *(f32x4*)((bf16_t*)(ws + OFF_WIN + l * SZ_WIN) + (size_t)NIN * 1024 + (size_t)r * 8) = zero4();
  }
  for (int i = gtid; i < 2 * 4 * 128 * 128; i += gn) { const int t = (i >> 7) & 127, s2 = i & 127; ((bf16_t*)(ws + OFF_SGUW))[i] = (s2 <= t) ? f2bf(P.sgu_w[i]) : (bf16_t)0; }
  for (int i = gtid; i < 2 * M_TOK * 256 / 4; i += gn) { const float4 v = ((const float4*)P.p)[i]; uint2 o; o.x = pk2(v.x, v.y); o.y = pk2(v.z, v.w); ((uint2*)(ws + OFF_PBF))[i] = o; }
  {
    float* lds = (float*)(ldsc + HBLK * 65536);
    for (int u = blockIdx.x; u < 4; u += gridDim.x) {
      const int t2 = HTID, kq = t2 >> 5, jq = t2 & 31;
      const float* w1 = P.cmp_w1 + (size_t)u * 2048 * 128; const float* pos = P.cmp_pos + (size_t)u * 2048;
      float4 sacc = make_float4(0.f, 0.f, 0.f, 0.f);
      for (int k = kq * 256; k < kq * 256 + 256; ++k) { const float pv = pos[k]; const float4 w = *(const float4*)(w1 + (size_t)k * 128 + jq * 4); sacc.x += pv * w.x; sacc.y += pv * w.y; sacc.z += pv * w.z; sacc.w += pv * w.w; }
      __syncthreads();
      lds[kq * 128 + jq * 4 + 0] = sacc.x; lds[kq * 128 + jq * 4 + 1] = sacc.y; lds[kq * 128 + jq * 4 + 2] = sacc.z; lds[kq * 128 + jq * 4 + 3] = sacc.w;
      __syncthreads();
      if (t2 < 128) { float t = P.cmp_b1[u * 128 + t2]; for (int q = 0; q < 8; ++q) t += lds[q * 128 + t2]; ((float*)(ws + OFF_CB1))[u * 128 + t2] = t; }
      __syncthreads();
    }
  }
  resnorm_phase(P.x, nullptr, nullptr, nullptr, nullptr, 0.f, nullptr, P.norm_g, (bf16_t*)(ws + OFF_A));
}

constexpr int G8_HT = 128 * 64;
__device__ __forceinline__ int g8_lds_byte(int r, int c) { const int st = (r >> 4) * 2 + (c >> 5), rr = r & 15, cc = c & 31, ob = rr * 64 + cc * 2; return st * 1024 + (ob ^ (((ob >> 9) & 1) << 5)); }
__device__ __forceinline__ void g8_stage_rc(int b, int& R, int& C) { const int st = b / 1024, sb = b % 1024, swz = sb ^ (((sb >> 9) & 1) << 5); R = (st >> 1) * 16 + swz / 64; C = (st & 1) * 32 + (swz % 64) / 2; }

template <bool ISSUE_ONLY, bool PRE_ISSUED>
__device__ __forceinline__ void gemm_core(f32x4 (&acc)[2][2][4][2], const bf16_t* __restrict__ A, int lda, const bf16_t* __restrict__ Bt, int ldb, int K, char* ldsc) {
  bf16_t* shm = (bf16_t*)ldsc;
  const int tid = TIDX, wid = tid >> 6, lane = tid & 63, wr = wid >> 2, wc = wid & 3, fr = lane & 15, fq = lane >> 4;
  int sr0, sc0;
  g8_stage_rc(tid * 16, sr0, sc0);
  const bf16_t* gA0 = A + (size_t)sr0 * lda + sc0;
  const bf16_t* gB0 = Bt + (size_t)sr0 * ldb + sc0;
  const size_t a64 = (size_t)64 * lda, b64 = (size_t)64 * ldb;
  const int lane_off = (fr * 64 + fq * 16) ^ ((((fr * 64 + fq * 16) >> 9) & 1) << 5);
  const char* ldA = ldsc + wr * 8192 + lane_off;
  const char* ldB = ldsc + 65536 + wc * 4096 + lane_off;
#define SA(b, h) (shm + ((b) * 2 + (h)) * G8_HT)
#define SB(b, h) (shm + (4 + (b) * 2 + (h)) * G8_HT)
#define STAGE_A(P, h, kt) { const bf16_t* g_ = gA0 + (size_t)(h) * 2 * a64 + (kt) * 64; glds16(g_, (char*)(P) + tid * 16); glds16(g_ + a64, (char*)(P) + tid * 16 + 8192); }
#define STAGE_B(P, h, kt) { const bf16_t* g_ = gB0 + (size_t)(h) * 2 * b64 + (kt) * 64; glds16(g_, (char*)(P) + tid * 16); glds16(g_ + b64, (char*)(P) + tid * 16 + 8192); }
#define LDA(dst, b, h) _Pragma("unroll") for (int m = 0; m < 4; ++m) _Pragma("unroll") for (int k = 0; k < 2; ++k) \
    dst[m][k] = *reinterpret_cast<const bf16x8*>(ldA + ((b) * 2 + (h)) * 16384 + (m * 2 + k) * 1024)
#define LDB(dst, b, h) _Pragma("unroll") for (int n = 0; n < 2; ++n) _Pragma("unroll") for (int k = 0; k < 2; ++k) \
    dst[n][k] = *reinterpret_cast<const bf16x8*>(ldB + ((b) * 2 + (h)) * 16384 + (n * 2 + k) * 1024)
#define MMA(ai, bj, At_, Bt_) do { __builtin_amdgcn_s_setprio(1); \
    _Pragma("unroll") for (int m = 0; m < 4; ++m) _Pragma("unroll") for (int n = 0; n < 2; ++n) _Pragma("unroll") for (int k = 0; k < 2; ++k) \
      acc[ai][bj][m][n] = mfma16(Bt_[n][k], At_[m][k], acc[ai][bj][m][n]); \
    __builtin_amdgcn_s_setprio(0); } while (0)
#define WAIT_V(n) asm volatile("s_waitcnt vmcnt(" #n ")" ::: "memory")
#define WAIT_L(n) asm volatile("s_waitcnt lgkmcnt(" #n ")" ::: "memory")
#define BAR __builtin_amdgcn_s_barrier()
#define SCHED __builtin_amdgcn_sched_barrier(0)
  bf16x8 At[4][2], B0[2][2], B1[2][2];
  const int nt = K >> 6;
  if (!PRE_ISSUED) {
    STAGE_B(SB(0, 0), 0, 0); STAGE_A(SA(0, 0), 0, 0);
    STAGE_B(SB(0, 1), 1, 0); STAGE_A(SA(0, 1), 1, 0);
  }
  if (ISSUE_ONLY) return;
  if (wr == 1) BAR;
  if (PRE_ISSUED) { WAIT_V(0); } else { WAIT_V(4); }
  BAR;
  STAGE_B(SB(1, 0), 0, 1); STAGE_A(SA(1, 0), 0, 1); STAGE_B(SB(1, 1), 1, 1);
  WAIT_V(6); BAR;
#pragma nounroll
  for (int t = 0; t < nt - 2; t += 2) {
    LDB(B0, 0, 0); SCHED; LDA(At, 0, 0); STAGE_A(SA(1, 1), 1, t + 1);
    WAIT_L(8); BAR; WAIT_L(0); MMA(0, 0, At, B0); BAR; SCHED;
    LDB(B1, 0, 1); STAGE_B(SB(0, 0), 0, t + 2);
    BAR; WAIT_L(0); MMA(0, 1, At, B1); BAR;
    LDA(At, 0, 1); STAGE_A(SA(0, 0), 0, t + 2);
    BAR; WAIT_L(0); MMA(1, 0, At, B0); BAR; SCHED;
    STAGE_B(SB(0, 1), 1, t + 2);
    WAIT_V(6); BAR; MMA(1, 1, At, B1); BAR;
    LDB(B0, 1, 0); SCHED; LDA(At, 1, 0); STAGE_A(SA(0, 1), 1, t + 2);
    WAIT_L(8); BAR; WAIT_L(0); MMA(0, 0, At, B0); BAR; SCHED;
    LDB(B1, 1, 1); STAGE_B(SB(1, 0), 0, t + 3);
    BAR; WAIT_L(0); MMA(0, 1, At, B1); BAR;
    LDA(At, 1, 1); STAGE_A(SA(1, 0), 0, t + 3);
    BAR; WAIT_L(0); MMA(1, 0, At, B0); BAR; SCHED;
    STAGE_B(SB(1, 1), 1, t + 3);
    WAIT_V(6); BAR; MMA(1, 1, At, B1); BAR;
  }
  { LDB(B0, 0, 0); LDA(At, 0, 0); STAGE_A(SA(1, 1), 1, nt - 1);
    BAR; WAIT_L(0); MMA(0, 0, At, B0); BAR;
    LDB(B1, 0, 1); BAR; WAIT_L(0); MMA(0, 1, At, B1); BAR;
    LDA(At, 0, 1); WAIT_V(4); BAR; WAIT_L(0); MMA(1, 0, At, B0); MMA(1, 1, At, B1); BAR; }
  { LDB(B0, 1, 0); LDA(At, 1, 0); WAIT_V(2); BAR; WAIT_L(0); MMA(0, 0, At, B0); BAR;
    LDB(B1, 1, 1); WAIT_V(0); BAR; WAIT_L(0); MMA(0, 1, At, B1); BAR;
    LDA(At, 1, 1); BAR; WAIT_L(0); MMA(1, 0, At, B0); MMA(1, 1, At, B1); BAR; }
  if (wr == 0) BAR;
  BAR;
#undef SA
#undef SB
#undef STAGE_A
#undef STAGE_B
#undef LDA
#undef LDB
#undef MMA
#undef WAIT_V
#undef WAIT_L
#undef BAR
#undef SCHED
}

struct TileIt {
  int TN, npc, npatch, slot, nslot, pid, s, tm, tn;
  __device__ __forceinline__ void init(int TN_) { TN = TN_; npc = (TN + 1) >> 1; npatch = 8 * npc; slot = blockIdx.x >> 3; nslot = gridDim.x >> 3; pid = blockIdx.x & 7; s = slot - nslot; }
  __device__ __forceinline__ bool next() {
    for (;;) {
      s += nslot;
      if (s >= 32) { s = slot; pid += 8; }
      if (pid >= npatch) return false;
      const int pr = pid / npc, pc = pid - pr * npc;
      tm = pr * 16 + (s & 15); tn = pc * 2 + (s >> 4);
      if (tn < TN) return true;
    }
  }
};

#define GEMM_LANE const int tid_ = TIDX, lane_ = tid_ & 63, wid_ = tid_ >> 6, wr = wid_ >> 2, wc = wid_ & 3, fr = lane_ & 15, fq = lane_ >> 4
#define GEMM_EPI_LOOP _Pragma("unroll") for (int ai = 0; ai < 2; ++ai) _Pragma("unroll") for (int m = 0; m < 4; ++m) _Pragma("unroll") for (int bj = 0; bj < 2; ++bj)

template <class Epi> __device__ __forceinline__ void gemm_phase(const bf16_t* A, int lda, const bf16_t* Bt, int ldb, int K, int TN, char* lds, Epi&& epi) {
  TileIt it; it.init(TN);
  bool have = it.next();
  f32x4 acc[2][2][4][2];
  if (have) gemm_core<true, false>(acc, A + (size_t)it.tm * 256 * lda, lda, Bt + (size_t)it.tn * 256 * ldb, ldb, K, lds);
  while (have) {
    const int tm = it.tm, tn = it.tn;
#pragma unroll
    for (int i0 = 0; i0 < 2; ++i0)
#pragma unroll
      for (int i1 = 0; i1 < 2; ++i1)
#pragma unroll
        for (int i2 = 0; i2 < 4; ++i2)
#pragma unroll
          for (int i3 = 0; i3 < 2; ++i3) acc[i0][i1][i2][i3] = zero4();
    gemm_core<false, true>(acc, A + (size_t)tm * 256 * lda, lda, Bt + (size_t)tn * 256 * ldb, ldb, K, lds);
    have = it.next();
    if (have) { f32x4 dummy[2][2][4][2]; gemm_core<true, false>(dummy, A + (size_t)it.tm * 256 * lda, lda, Bt + (size_t)it.tn * 256 * ldb, ldb, K, lds); }
    epi(acc, tm, tn);
  }
  asm volatile("s_waitcnt vmcnt(0)" ::: "memory");
}

__device__ __forceinline__ void gemm_up_phase(const bf16_t* a, const bf16_t* wgu, bf16_t* act, char* lds) {
  gemm_phase(a, 1024, wgu, 1024, 1024, NGU / 256, lds, [&](f32x4 (&acc)[2][2][4][2], int tm, int tn) {
    GEMM_LANE;
    GEMM_EPI_LOOP {
      const int row = tm * 256 + ai * 128 + wr * 64 + m * 16 + fr;
      const int col = tn * 128 + bj * 64 + wc * 16 + 4 * fq;
      const f32x4 g = acc[ai][bj][m][0], u = acc[ai][bj][m][1];
      u32x2 o; o.x = pk2(silu_f(g[0]) * u[0], silu_f(g[1]) * u[1]); o.y = pk2(silu_f(g[2]) * u[2], silu_f(g[3]) * u[3]);
      *(u32x2*)(act + (size_t)row * DFF + col) = o;
    }
  });
}

__device__ __forceinline__ void gemm_bf16_phase(const bf16_t* A, int lda, const bf16_t* Bt, int K, int TN, bf16_t* out, int ldo, char* lds) {
  gemm_phase(A, lda, Bt, K, K, TN, lds, [&](f32x4 (&acc)[2][2][4][2], int tm, int tn) {
    GEMM_LANE;
    GEMM_EPI_LOOP {
      const int row = tm * 256 + ai * 128 + wr * 64 + m * 16 + fr;
#pragma unroll
      for (int n = 0; n < 2; ++n) {
        u32x2 o; o.x = pk2(acc[ai][bj][m][n][0], acc[ai][bj][m][n][1]); o.y = pk2(acc[ai][bj][m][n][2], acc[ai][bj][m][n][3]);
        *(u32x2*)(out + (size_t)row * ldo + tn * 256 + bj * 128 + wc * 32 + n * 16 + 4 * fq) = o;
      }
    }
  });
}

__device__ __forceinline__ void gemm_ple_phase(const bf16_t* a, const bf16_t* wpg, const bf16_t* pp, bf16_t* out, char* lds) {
  gemm_phase(a, 1024, wpg, 1024, 1024, 4, lds, [&](f32x4 (&acc)[2][2][4][2], int tm, int tn) {
    GEMM_LANE;
    GEMM_EPI_LOOP {
      const int row = tm * 256 + ai * 128 + wr * 64 + m * 16 + fr;
#pragma unroll
      for (int n = 0; n < 2; ++n) {
        const int col = tn * 256 + bj * 128 + wc * 32 + n * 16 + 4 * fq;
        const u32x2 pv = *(const u32x2*)(pp + (size_t)row * 1024 + col);
        const f32x4 av = acc[ai][bj][m][n];
        u32x2 o;
        o.x = pk2(sigm(av[0]) * __uint_as_float(pv.x << 16), sigm(av[1]) * __uint_as_float(pv.x & 0xffff0000u));
        o.y = pk2(sigm(av[2]) * __uint_as_float(pv.y << 16), sigm(av[3]) * __uint_as_float(pv.y & 0xffff0000u));
        *(u32x2*)(out + (size_t)row * 1024 + col) = o;
      }
    }
  });
}

__device__ __forceinline__ void mixA_item(const Params& P, int layer, int idx, const bf16_t* z, bf16_t* y, char* lds) {
  const int g = idx & 3, bc = idx >> 2, tok0 = bc * 128;
  const int tid = HTID, lane = tid & 63, w = tid >> 6, fr = lane & 15, fq = lane >> 4;
  bf16_t* vT = (bf16_t*)lds;
  const float* ng = P.sgu_ng + layer * 256;
  {
    const int s = tid >> 1, half = tid & 1;
    const bf16_t* zr = z + (size_t)(tok0 + s) * LDZ + ZC_AV;
    float ss = 0.f;
#pragma unroll 4
    for (int i = 0; i < 16; ++i) { float v[8]; unpack8(*(const u32x4*)(zr + half * 128 + i * 8), v);
#pragma unroll
      for (int e = 0; e < 8; ++e) { const float t = gelu_t(v[e]); ss += t * t; } }
    ss += __shfl_xor(ss, 1);
    const float rs = rsqrtf(ss * (1.f / 256.f) + 1e-6f);
#pragma unroll
    for (int i = 0; i < 4; ++i) { float v[8]; unpack8(*(const u32x4*)(zr + g * 64 + half * 32 + i * 8), v);
#pragma unroll
      for (int e = 0; e < 8; ++e) { const int d = half * 32 + i * 8 + e; vT[d * 136 + s] = f2bf(gelu_t(v[e]) * rs * ng[g * 64 + d]); } }
  }
  __syncthreads();
  const bf16_t* W = (const bf16_t*)(P.ws + OFF_SGUW) + (size_t)((layer * 4 + g) * 128) * 128;
  f32x4 acc[2][4] = {};
  for (int ks = 0; ks <= w; ++ks) {
    bf16x8 wf[2], vf[4];
#pragma unroll
    for (int tm = 0; tm < 2; ++tm) wf[tm] = *(const bf16x8*)(W + (size_t)(32 * w + tm * 16 + fr) * 128 + ks * 32 + 8 * fq);
#pragma unroll
    for (int dn = 0; dn < 4; ++dn) vf[dn] = *(const bf16x8*)(vT + (dn * 16 + fr) * 136 + ks * 32 + 8 * fq);
#pragma unroll
    for (int tm = 0; tm < 2; ++tm)
#pragma unroll
      for (int dn = 0; dn < 4; ++dn) acc[tm][dn] = mfma16(vf[dn], wf[tm], acc[tm][dn]);
  }
#pragma unroll
  for (int tm = 0; tm < 2; ++tm) {
    const int t = 32 * w + tm * 16 + fr;
    const float bias = P.sgu_b[(layer * 4 + g) * 128 + t];
#pragma unroll
    for (int dn = 0; dn < 4; ++dn) {
      const int d = dn * 16 + 4 * fq;
      const uint2 uu = *(const uint2*)(z + (size_t)(tok0 + t) * LDZ + ZC_AU + g * 64 + d);
      const float u0 = gelu_t(__uint_as_float(uu.x << 16)), u1 = gelu_t(__uint_as_float(uu.x & 0xffff0000u)),
                  u2 = gelu_t(__uint_as_float(uu.y << 16)), u3 = gelu_t(__uint_as_float(uu.y & 0xffff0000u));
      uint2 o; o.x = pk2(u0 * (acc[tm][dn][0] + bias), u1 * (acc[tm][dn][1] + bias)); o.y = pk2(u2 * (acc[tm][dn][2] + bias), u3 * (acc[tm][dn][3] + bias));
      *(uint2*)(y + (size_t)(tok0 + t) * 1024 + g * 64 + d) = o;
    }
  }
  __syncthreads();
}

__device__ __forceinline__ void mixB1_item(const Params& P, int layer, int idx, const bf16_t* z, float* hsl, float* Pc, float* carryP, float* carryH, char* lds) {
  const int c = idx & 63, g = (idx >> 6) & 3, b = idx >> 8;
  const int tid = HTID, lane = tid & 63, w = tid >> 6, fr = lane & 15, fq = lane >> 4;
  bf16_t* xcb = (bf16_t*)lds;
  float* xcf = (float*)(lds + 9216);
  float* aA = (float*)(lds + 9216 + 16384);
  float* bB = (float*)(lds + 9216 + 32768);
  float* sm = (float*)(lds + 9216 + 49152);
  const size_t tokb = (size_t)b * SEQ;
  {
    const int t = tid >> 2, q = tid & 3;
    float accv[16];
#pragma unroll
    for (int i = 0; i < 16; ++i) accv[i] = P.conv_b[layer * 256 + g * 64 + q * 16 + i];
#pragma unroll
    for (int k = 0; k < 4; ++k) {
      const int pos = c * 64 + t - 3 + k;
      if (pos >= 0) {
        const bf16_t* zr = z + (tokb + pos) * LDZ + ZC_BX + g * 64 + q * 16;
        float v[16]; unpack8(*(const u32x4*)zr, v); unpack8(*(const u32x4*)(zr + 8), v + 8);
        const float* cw = P.conv_w + (size_t)(layer * 4 + k) * 256 + g * 64 + q * 16;
#pragma unroll
        for (int i = 0; i < 16; ++i) accv[i] += v[i] * cw[i];
      }
    }
#pragma unroll
    for (int i = 0; i < 16; ++i) { xcf[t * 64 + q * 16 + i] = accv[i]; xcb[t * 72 + q * 16 + i] = f2bf(accv[i]); }
  }
  __syncthreads();
  {
    const bf16_t* wa = (const bf16_t*)(P.ws + OFF_WAT) + (layer * 4 + g) * 4096;
    const bf16_t* wx = (const bf16_t*)(P.ws + OFF_WXT) + (layer * 4 + g) * 4096;
    f32x4 ar[4] = {}, ai[4] = {};
#pragma unroll
    for (int ks = 0; ks < 2; ++ks) {
      const bf16x8 xf = *(const bf16x8*)(xcb + (16 * w + fr) * 72 + ks * 32 + 8 * fq);
#pragma unroll
      for (int jn = 0; jn < 4; ++jn) {
        const bf16x8 fa = *(const bf16x8*)(wa + (jn * 16 + fr) * 64 + ks * 32 + 8 * fq);
        const bf16x8 fx = *(const bf16x8*)(wx + (jn * 16 + fr) * 64 + ks * 32 + 8 * fq);
        ar[jn] = mfma16(fa, xf, ar[jn]); ai[jn] = mfma16(fx, xf, ai[jn]);
      }
    }
    const int t = 16 * w + fr;
#pragma unroll
    for (int jn = 0; jn < 4; ++jn)
#pragma unroll
      for (int e = 0; e < 4; ++e) {
        const int j = jn * 16 + 4 * fq + e, ch = layer * 256 + g * 64 + j;
        const float r = sigm(ar[jn][e] + P.lru_ba[ch]), ig = sigm(ai[jn][e] + P.lru_bx[ch]);
        const float lam = P.lru_lam[ch];
        const float xe = __expf(-lam);
        float m8; asm volatile("v_mov_b32 %0, 0xc1000000" : "=v"(m8));
        const float la = m8 * r * (xe * (1.f - xe * (0.5f - xe * (1.f / 3.f))));
        const float av = __expf(la);
        const float y2 = 2.f * la;
        const float om = -y2 * (1.f + y2 * (0.5f + y2 * ((1.f / 6.f) + y2 * ((1.f / 24.f) + y2 * ((1.f / 120.f) + y2 * (1.f / 720.f))))));
        const float bv = sqrtf(om) * (ig * xcf[t * 64 + j]);
        aA[t * 64 + j] = av; bB[t * 64 + j] = bv;
      }
  }
  __syncthreads();
  {
    const int q = tid >> 6, j = tid & 63;
    float Pq = 1.f, hq = 0.f;
#pragma unroll
    for (int i = 0; i < 16; ++i) { const int t = q * 16 + i; const float av = aA[t * 64 + j], bv = bB[t * 64 + j]; hq = av * hq + bv; Pq *= av; aA[t * 64 + j] = Pq; bB[t * 64 + j] = hq; }
    sm[q * 64 + j] = Pq; sm[256 + q * 64 + j] = hq;
    __syncthreads();
    float Pin = 1.f, Hin = 0.f;
    for (int qq = 0; qq < q; ++qq) { const float pp = sm[qq * 64 + j], hh = sm[256 + qq * 64 + j]; Hin = pp * Hin + hh; Pin *= pp; }
    float hl = 0.f, pl = 1.f;
#pragma unroll
    for (int i = 0; i < 16; ++i) { const int t = q * 16 + i; hl = bB[t * 64 + j] + aA[t * 64 + j] * Hin; pl = aA[t * 64 + j] * Pin;
      const size_t o = (tokb + c * 64 + t) * 256 + g * 64 + j; hsl[o] = hl; Pc[o] = pl; }
    if (q == 3) { const int o = ((b * 4 + g) * 64 + c) * 64 + j; carryP[o] = pl; carryH[o] = hl; }
  }
  __syncthreads();
}

__device__ __forceinline__ void mixB2_item(int idx, const bf16_t* z, const float* hsl, const float* Pc, const float* carryP, const float* carryH, bf16_t* y) {
  const int c = idx & 63, g = (idx >> 6) & 3, b = idx >> 8;
  const int q = HTID >> 6, j = HTID & 63;
  const float* cp = carryP + (size_t)((b * 4 + g) * 64) * 64 + j;
  const float* chh = carryH + (size_t)((b * 4 + g) * 64) * 64 + j;
  float H = 0.f;
  for (int c0 = 0; c0 < c; c0 += 8) {
    float pv[8], hv[8];
#pragma unroll
    for (int i = 0; i < 8; ++i) { const bool ok = c0 + i < c; pv[i] = ok ? cp[(c0 + i) * 64] : 1.f; hv[i] = ok ? chh[(c0 + i) * 64] : 0.f; }
#pragma unroll
    for (int i = 0; i < 8; ++i) H = pv[i] * H + hv[i];
  }
  const size_t tokb = (size_t)b * SEQ + c * 64 + q * 16;
#pragma unroll 4
  for (int i = 0; i < 16; ++i) {
    const size_t o = (tokb + i) * 256 + g * 64 + j;
    const float h = hsl[o] + Pc[o] * H;
    const float gt = bf2f(z[(tokb + i) * LDZ + ZC_BG + g * 64 + j]);
    y[(tokb + i) * 1024 + 256 + g * 64 + j] = f2bf(h * gelu_t(gt));
  }
}

__device__ __forceinline__ void compress_item(const Params& P, int layer, int idx, const bf16_t* z, bf16_t* kcv, char* lds) {
  const int nb = idx & 15, g = (idx >> 4) & 1, b = (idx >> 5) & 7, kv = idx >> 8;
  const int tid = HTID, lane = tid & 63, w = tid >> 6, fr = lane & 15, fq = lane >> 4;
  const int n0 = nb * 16, col = (kv ? ZC_VC : ZC_KC) + g * 64;
  const bf16_t* w1t = (const bf16_t*)(P.ws + OFF_CW1 + (size_t)(layer * 2 + kv) * SZ_CW1);
  float* part = (float*)lds;
  float* hid = (float*)(lds + 34816);
  f32x4 acc[8];
#pragma unroll
  for (int jf = 0; jf < 8; ++jf) acc[jf] = zero4();
  int nn = n0 + fr; if (nn > 254) nn = 254;
  const bf16_t* zb = z + ((size_t)b * SEQ + 16 * nn) * LDZ + col + 8 * fq;
  const bf16_t* wb = w1t + (size_t)fr * 2048 + 8 * fq;
#pragma unroll 4
  for (int kk = 0; kk < 16; ++kk) {
    const int ks = 16 * w + kk, l = ks >> 1, d0 = (ks & 1) * 32;
    const bf16x8 xf = *(const bf16x8*)(zb + (size_t)l * LDZ + d0);
#pragma unroll
    for (int jf = 0; jf < 8; ++jf) { const bf16x8 wf = *(const bf16x8*)(wb + (size_t)jf * 16 * 2048 + ks * 32); acc[jf] = mfma16(wf, xf, acc[jf]); }
  }
#pragma unroll
  for (int jf = 0; jf < 8; ++jf)
#pragma unroll
    for (int e = 0; e < 4; ++e) part[(w * 16 + fr) * 132 + jf * 16 + 4 * fq + e] = acc[jf][e];
  __syncthreads();
  const float* cb1 = (const float*)(P.ws + OFF_CB1) + (layer * 2 + kv) * 128;
  {
    const int n = tid >> 4, j0 = (tid & 15) * 8;
#pragma unroll
    for (int e = 0; e < 8; ++e) { const int j = j0 + e; const float v = ((part[(0 * 16 + n) * 132 + j] + part[(1 * 16 + n) * 132 + j]) + part[(2 * 16 + n) * 132 + j]) + part[(3 * 16 + n) * 132 + j];
      hid[n * 129 + j] = gelu_t(v + cb1[j]); }
  }
  __syncthreads();
  {
    const int n = tid >> 4, d0 = (tid & 15) * 4;
    const float* w2 = P.cmp_w2 + (size_t)(layer * 2 + kv) * 128 * 64 + d0;
    const float4 bb = *(const float4*)(P.cmp_b2 + (layer * 2 + kv) * 64 + d0);
    float o0 = bb.x, o1 = bb.y, o2 = bb.z, o3 = bb.w;
#pragma unroll 8
    for (int j = 0; j < 128; ++j) { const float hv = hid[n * 129 + j]; const float4 wa = *(const float4*)(w2 + j * 64); o0 += hv * wa.x; o1 += hv * wa.y; o2 += hv * wa.z; o3 += hv * wa.w; }
    u32x2 ov; ov.x = pk2(o0, o1); ov.y = pk2(o2, o3);
    if ((n0 + n) >= 255) { ov.x = 0u; ov.y = 0u; }
    *(u32x2*)(kcv + ((size_t)((kv * 8 + b) * 2 + g) * 256 + n0 + n) * 64 + d0) = ov;
  }
  __syncthreads();
}

constexpr int NSA_KT = 0, NSA_VT = 16384, NSA_T = 33792, NSA_TW = NSA_T + 4 * 4160 * 4, NSA_IMP = NSA_TW + 4 * 640 * 4, NSA_WU = NSA_IMP + 2 * 16640;
constexpr int LDS_ST = 147456;
constexpr float LOG2E = 1.4426950408889634f;

__device__ __forceinline__ void nsa_tables(const Params& P, int g, char* lds) {
  float* T = (float*)(lds + NSA_T);
  float* TW = (float*)(lds + NSA_TW);
  const int tid = TIDX;
  for (int i = tid; i < 4160; i += 512) {
    const int n = i - 64;
    int bk = n;
    if (n >= 16) bk = 16 + (n >= 21) + (n >= 27) + (n >= 35) + (n >= 46) + (n >= 59) + (n >= 77) + (n >= 99) + (n >= 128) + (n >= 166) + (n >= 216) + (n >= 280) + (n >= 363) + (n >= 470) + (n >= 609) + (n >= 790);
#pragma unroll
    for (int r = 0; r < 4; ++r) {
      const float v = n >= 0 ? P.rel_bias[bk * 8 + g * 4 + r] * LOG2E : -__builtin_inff();
      T[r * 4160 + i] = v;
      if (i < 640) TW[r * 640 + i] = (n < 512) ? v : -__builtin_inff();
    }
  }
  __syncthreads();
}

struct KVRegs { u32x4 k0, v0; };
__device__ __forceinline__ void kv_gload(KVRegs& r, const bf16_t* kb, const bf16_t* vb, size_t stride) {
  const int tid = TIDX, row = tid >> 3, cq = tid & 7;
  r.k0 = *(const u32x4*)(kb + row * stride + cq * 8); r.v0 = *(const u32x4*)(vb + row * stride + cq * 8);
}
__device__ __forceinline__ void kv_lwrite(const KVRegs& r, char* lds, int buf) {
  const int tid = TIDX, row = tid >> 3, cq = tid & 7;
  char* kt = lds + NSA_KT + buf * 8192 + row * 128;
  *(u32x4*)(kt + ((cq ^ (row & 7)) << 4)) = r.k0;
  bf16_t* vt = (bf16_t*)(lds + NSA_VT + buf * 8704) + (cq * 8) * 68 + row;
#pragma unroll
  for (int i = 0; i < 4; ++i) { vt[(2 * i) * 68] = (bf16_t)(r.v0[i] & 0xffffu); vt[(2 * i + 1) * 68] = (bf16_t)(r.v0[i] >> 16); }
}

template <int MODE>
__device__ __forceinline__ void nsa_compute(int cur, int buf, int t, int hl, u64 mymask, const bf16x8 (&Qf)[2][2], f32x4 (&O)[4][2], float (&m)[2], float (&l)[2],
                                            const float (&inv)[2], float* impw, char* lds) {
  const int lane = TIDX & 63, fr = lane & 15, fq = lane >> 4;
  const char* kt = lds + NSA_KT + buf * 8192;
  const bf16_t* vt = (const bf16_t*)(lds + NSA_VT + buf * 8704);
  const bool selok = (MODE == 2) ? (((mymask >> cur) & 1ull) != 0ull) : true;
  const float* tb = (MODE == 3) ? (const float*)(lds + NSA_TW) + hl * 640 : (const float*)(lds + NSA_T) + hl * 4160;
  constexpr int TS = (MODE == 3) ? 640 : 4160;
  const int base = (MODE <= 1) ? (t - 31 - 16 * (cur * 64 + 4 * fq) + 64) : (t - cur * 64 - 4 * fq + 64);
#pragma unroll
  for (int s2 = 0; s2 < 2; ++s2) {
    f32x4 S[2][2] = {};
    bf16x8 kfr[2][2];
#pragma unroll
    for (int ks = 0; ks < 2; ++ks)
#pragma unroll
      for (int kk = 0; kk < 2; ++kk) kfr[ks][kk] = *(const bf16x8*)(kt + (32 * s2 + 16 * kk + fr) * 128 + (((ks * 4 + fq) ^ (fr & 7)) << 4));
    __builtin_amdgcn_s_setprio(1);
#pragma unroll
    for (int ks = 0; ks < 2; ++ks)
#pragma unroll
      for (int kk = 0; kk < 2; ++kk)
#pragma unroll
        for (int r = 0; r < 2; ++r) S[kk][r] = mfma16(kfr[ks][kk], Qf[r][ks], S[kk][r]);
    __builtin_amdgcn_s_setprio(0);
    bf16x8 Pf[2];
    float g1s[2] = {0.f, 0.f}, p3s[2] = {0.f, 0.f};
#pragma unroll
    for (int r = 0; r < 2; ++r) {
      float sv[2][4];
#pragma unroll
      for (int kk = 0; kk < 2; ++kk)
#pragma unroll
        for (int e = 0; e < 4; ++e) {
          const int off = 32 * s2 + 16 * kk + e;
          int idx;
          if (MODE <= 1) { idx = base - 16 * off; idx = idx > 0 ? idx : 0; } else idx = base - off;
          sv[kk][e] = S[kk][r][e] * (0.125f * LOG2E) + tb[r * TS + idx];
        }
      float pv[2][4];
      if (MODE == 1) {
#pragma unroll
        for (int kk = 0; kk < 2; ++kk)
#pragma unroll
          for (int e = 0; e < 4; ++e) pv[kk][e] = __builtin_amdgcn_exp2f(sv[kk][e] - m[r]) * inv[r];
#pragma unroll
        for (int kk = 0; kk < 2; ++kk) { g1s[kk] += pv[kk][0] + pv[kk][1] + pv[kk][2] + 0.5f * pv[kk][3]; p3s[kk] += 0.5f * pv[kk][3]; }
      } else {
        float mx = fmaxf(fmaxf(fmaxf(sv[0][0], sv[0][1]), fmaxf(sv[0][2], sv[0][3])), fmaxf(fmaxf(sv[1][0], sv[1][1]), fmaxf(sv[1][2], sv[1][3])));
        if (MODE == 2) mx = selok ? mx : -__builtin_inff();
        if (__any(mx > m[r] + 8.0f)) {
          mx = fmaxf(mx, __shfl_xor(mx, 16)); mx = fmaxf(mx, __shfl_xor(mx, 32));
          const float mn = fmaxf(m[r], mx), al = __builtin_amdgcn_exp2f(m[r] - mn);
          m[r] = mn; l[r] *= al;
          if (MODE != 0) {
#pragma unroll
            for (int df = 0; df < 4; ++df) O[df][r] *= al;
          }
        }
        const float me = (MODE == 2) ? (selok ? m[r] : __builtin_inff()) : m[r];
        float ps = 0.f;
#pragma unroll
        for (int kk = 0; kk < 2; ++kk)
#pragma unroll
          for (int e = 0; e < 4; ++e) { pv[kk][e] = __builtin_amdgcn_exp2f(sv[kk][e] - me); ps += pv[kk][e]; }
        l[r] += ps;
      }
      if (MODE != 0) {
        const unsigned w0 = pk2(pv[0][0], pv[0][1]), w1 = pk2(pv[0][2], pv[0][3]), w2 = pk2(pv[1][0], pv[1][1]), w3 = pk2(pv[1][2], pv[1][3]);
        u32x4 pw; pw.x = w0; pw.y = w1; pw.z = w2; pw.w = w3;
        Pf[r] = __builtin_bit_cast(bf16x8, pw);
      }
    }
    if (MODE != 0) {
      bf16x8 vfr[4];
#pragma unroll
      for (int df = 0; df < 4; ++df) {
        const bf16x4 va = *(const bf16x4*)(vt + (df * 16 + fr) * 68 + 32 * s2 + 4 * fq);
        const bf16x4 vb = *(const bf16x4*)(vt + (df * 16 + fr) * 68 + 32 * s2 + 16 + 4 * fq);
        bf16x8 vf; vf[0] = va[0]; vf[1] = va[1]; vf[2] = va[2]; vf[3] = va[3]; vf[4] = vb[0]; vf[5] = vb[1]; vf[6] = vb[2]; vf[7] = vb[3];
        vfr[df] = vf;
      }
      __builtin_amdgcn_s_setprio(1);
#pragma unroll
      for (int df = 0; df < 4; ++df)
#pragma unroll
        for (int r = 0; r < 2; ++r) O[df][r] = mfma16(vfr[df], Pf[r], O[df][r]);
      __builtin_amdgcn_s_setprio(0);
    }
    if (MODE == 1) {
#pragma unroll
      for (int kk = 0; kk < 2; ++kk) {
        const int j = cur * 16 + (2 * s2 + kk) * 4 + fq;
        atomicAdd(&impw[fr * 65 + j], g1s[kk]);
        if (j + 1 < 64) atomicAdd(&impw[fr * 65 + j + 1], p3s[kk]);
      }
    }
  }
}

template <int MODE>
__device__ __forceinline__ void nsa_branch(int first, int ntl, u64 U, const bf16_t* kbase, const bf16_t* vbase, size_t stride, int t, int hl, u64 mymask,
                                           const bf16x8 (&Qf)[2][2], f32x4 (&O)[4][2], float (&m)[2], float (&l)[2], const float (&inv)[2], float* impw, char* lds) {
  KVRegs R0, R1, R2;
  u64 rem = U;
  int seq = first, left = ntl;
#define NSA_NEXT(dst)                                                                                     \
  { if (MODE == 2) { dst = rem ? (int)__builtin_ctzll(rem) : -1; if (rem) rem &= rem - 1; }              \
    else { dst = left > 0 ? seq : -1; ++seq; --left; } }
#define NSA_GLOAD(R, ti) kv_gload(R, kbase + (size_t)(ti) * 64 * stride, vbase + (size_t)(ti) * 64 * stride, stride)
  int tcur, t1, t2, t3;
  NSA_NEXT(tcur); NSA_NEXT(t1); NSA_NEXT(t2);
  if (tcur >= 0) NSA_GLOAD(R0, tcur);
  if (t1 >= 0) NSA_GLOAD(R1, t1);
  if (t2 >= 0) NSA_GLOAD(R2, t2);
  if (tcur >= 0) kv_lwrite(R0, lds, 0);
  __syncthreads();
  NSA_NEXT(t3);
  if (t3 >= 0) NSA_GLOAD(R0, t3);
  int buf = 0;
#define NSA_STEP(RW)                                                                                      \
  if (tcur < 0) break;                                                                                    \
  nsa_compute<MODE>(tcur, buf, t, hl, mymask, Qf, O, m, l, inv, impw, lds);                               \
  if (t1 >= 0) kv_lwrite(RW, lds, buf ^ 1);                                                               \
  __syncthreads();                                                                                        \
  buf ^= 1; tcur = t1; t1 = t2; t2 = t3;                                                                  \
  NSA_NEXT(t3);                                                                                           \
  if (t3 >= 0) NSA_GLOAD(RW, t3);
  for (;;) {
    NSA_STEP(R1)
    NSA_STEP(R2)
    NSA_STEP(R0)
  }
#undef NSA_STEP
#undef NSA_GLOAD
#undef NSA_NEXT
}

#define NSA_RESET()                                                                         \
  _Pragma("unroll") for (int r = 0; r < 2; ++r) { asm volatile("v_mov_b32 %0, 0xf149f2ca" : "=v"(m[r])); l[r] = 0.f; }               \
  _Pragma("unroll") for (int df = 0; df < 4; ++df) _Pragma("unroll") for (int r = 0; r < 2; ++r) O[df][r] = zero4();

__device__ __forceinline__ void nsa_item(const Params& P, int b, int g, int c, const bf16_t* z, const bf16_t* kcv, bf16_t* y, char* lds) {
  const int tid = TIDX, lane = tid & 63, w8 = tid >> 6, qg = w8 & 3, hp = w8 >> 2, fr = lane & 15, fq = lane >> 4;
  const size_t tokb = (size_t)b * SEQ;
  const int t = c * 64 + 16 * qg + fr;
  const bf16_t* zq = z + (tokb + t) * LDZ;
  const int hb = g * 4 + hp * 2;
  bf16x8 Qf[2][2];
#pragma unroll
  for (int r = 0; r < 2; ++r)
#pragma unroll
    for (int ks = 0; ks < 2; ++ks) Qf[r][ks] = *(const bf16x8*)(zq + ZC_Q + g * 256 + (hp * 2 + r) * 64 + ks * 32 + 8 * fq);
  float* impw = (float*)(lds + NSA_IMP) + (hp * 4 + qg) * (16 * 65);
  for (int i = lane; i < 16 * 65; i += 64) impw[i] = 0.f;
  f32x4 O[4][2];
  float m[2], l[2], inv[2];
  bf16_t* yo = y + (tokb + t) * 1024 + 512 + g * 256 + hp * 128 + 4 * fq;
  const bf16_t* kc = kcv + (size_t)((0 * 8 + b) * 2 + g) * 256 * 64;
  const bf16_t* vc = kcv + (size_t)((1 * 8 + b) * 2 + g) * 256 * 64;
  const int nct = ((4 * c + 2) >> 6) + 1;
  NSA_RESET();
  inv[0] = 0.f; inv[1] = 0.f;
  nsa_branch<0>(0, nct, 0ull, kc, vc, 64, t, hp * 2, 0ull, Qf, O, m, l, inv, impw, lds);
#pragma unroll
  for (int r = 0; r < 2; ++r) { float lt = l[r]; lt += __shfl_xor(lt, 16); lt += __shfl_xor(lt, 32); inv[r] = lt > 0.f ? 1.f / lt : 0.f; }
  nsa_branch<1>(0, nct, 0ull, kc, vc, 64, t, hp * 2, 0ull, Qf, O, m, l, inv, impw, lds);
#pragma unroll
  for (int r = 0; r < 2; ++r) {
    const float gt = sigm(bf2f(zq[ZC_GC + hb + r]));
#pragma unroll
    for (int df = 0; df < 4; ++df) { u32x2 o; o.x = pk2(O[df][r][0] * gt, O[df][r][1] * gt); o.y = pk2(O[df][r][2] * gt, O[df][r][3] * gt); *(u32x2*)(yo + r * 64 + df * 16) = o; }
  }
  __syncthreads();
  u64 wU = 0ull;
  {
    const float* imp0 = (const float*)(lds + NSA_IMP) + qg * (16 * 65);
    const float* imp1 = imp0 + 4 * (16 * 65);
    u64* MK = (u64*)(lds + NSA_WU) + 8;
    const u64 V = (c >= 63) ? ~0ull : ((1ull << (c + 1)) - 1ull);
    const bool forced = (lane == 0) | (lane == c) | (lane == c - 1);
    for (int q8 = 0; q8 < 8; ++q8) {
      const int qq = hp * 8 + q8;
      const float sv = imp0[qq * 65 + lane] + imp1[qq * 65 + lane];
      const unsigned u = __float_as_uint(forced ? 1e4f : sv);
      u64 mk = V;
      if (c + 1 > 16) {
        unsigned thr = 0u;
        for (int bb = 30; bb >= 0; --bb) { const unsigned cand = thr | (1u << bb); const u64 ge = __ballot(u >= cand) & V; if (__popcll(ge) >= 16) thr = cand; }
        const u64 G = __ballot(u > thr) & V, E = __ballot(u == thr) & V;
        const int need = 16 - (int)__popcll(G);
        const int below = (int)__popcll(E & ((1ull << lane) - 1ull));
        const bool se = (((E >> lane) & 1ull) != 0ull) && (below < need);
        mk = G | __ballot(se);
      }
      if (lane == 0) MK[qg * 16 + qq] = mk;
      wU |= mk;
    }
  }
  u64* WU = (u64*)(lds + NSA_WU);
  if (lane == 0) WU[w8] = wU;
  __syncthreads();
  const u64 U = WU[0] | WU[1] | WU[2] | WU[3] | WU[4] | WU[5] | WU[6] | WU[7];
  const u64 mymask = ((const u64*)(lds + NSA_WU) + 8)[qg * 16 + fr];
  for (int br = 0; br < 2; ++br) {
    NSA_RESET();
    int zg;
    if (br == 0) {
      nsa_branch<2>(0, 0, U, z + tokb * LDZ + ZC_KS + g * 64, z + tokb * LDZ + ZC_VS + g * 64, LDZ, t, hp * 2, mymask, Qf, O, m, l, inv, impw, lds);
      zg = ZC_GS;
    } else {
      const int kt0 = c > 8 ? c - 8 : 0;
      nsa_branch<3>(kt0, c - kt0 + 1, 0ull, z + tokb * LDZ + ZC_KW + g * 64, z + tokb * LDZ + ZC_VW + g * 64, LDZ, t, hp * 2, 0ull, Qf, O, m, l, inv, impw, lds);
      zg = ZC_GW;
    }
#pragma unroll
    for (int r = 0; r < 2; ++r) {
      float lt = l[r]; lt += __shfl_xor(lt, 16); lt += __shfl_xor(lt, 32);
      const float gt = sigm(bf2f(zq[zg + hb + r])) * (lt > 0.f ? 1.f / lt : 0.f);
#pragma unroll
      for (int df = 0; df < 4; ++df) {
        bf16_t* yp = yo + r * 64 + df * 16;
        const u32x2 pr = *(const u32x2*)yp;
        u32x2 o; o.x = pk2(__uint_as_float(pr.x << 16) + O[df][r][0] * gt, __uint_as_float(pr.x & 0xffff0000u) + O[df][r][1] * gt);
        o.y = pk2(__uint_as_float(pr.y << 16) + O[df][r][2] * gt, __uint_as_float(pr.y & 0xffff0000u) + O[df][r][3] * gt);
        *(u32x2*)yp = o;
      }
    }
  }
  __syncthreads();
}

__device__ __forceinline__ void run_phase(const Params& P, int ph, char* lds) {
  char* ws = P.ws;
  asm volatile("" : "+s"(ws));
  bf16_t* abuf = (bf16_t*)(ws + OFF_A);
  bf16_t* big = (bf16_t*)(ws + OFF_BIG);
  bf16_t* fbuf = (bf16_t*)(ws + OFF_F);
  bf16_t* h16 = (bf16_t*)(ws + OFF_F + (size_t)M_TOK * 1024 * 2);
  float* hsl = (float*)(ws + OFF_F); float* Pc = hsl + (size_t)M_TOK * 256;
  bf16_t* kcv = (bf16_t*)(ws + OFF_KC);
  float* carryP = (float*)(ws + OFF_CARRY); float* carryH = carryP + 8 * 4 * 64 * 64;
  if (ph == 0) { prep_phase(P, lds); return; }
  const int layer = (ph - 1) / 13, sp = (ph - 1) % 13;
  const float* ng = P.norm_g + (size_t)layer * 8 * 1024;
#ifdef ONLY_SP
  if (sp != ONLY_SP) return;
#endif
  switch (sp) {
    case 0: case 8: {
      const int lj = layer * 2 + (sp == 8);
      gemm_up_phase(abuf, (const bf16_t*)(ws + OFF_WGU + lj * SZ_WGU), big, lds);
    } break;
    case 1: case 9: {
      const int lj = layer * 2 + (sp == 9);
      gemm_bf16_phase(big, DFF, (const bf16_t*)(ws + OFF_WD + lj * SZ_WD), DFF, 4, fbuf, 1024, lds);
    } break;
    case 2: resnorm_phase(layer == 0 ? P.x : nullptr, h16, nullptr, h16, fbuf, 0.5f, ng + 1 * 1024, ng + 2 * 1024, abuf); break;
    case 3: gemm_bf16_phase(abuf, 1024, (const bf16_t*)(ws + OFF_WIN + layer * SZ_WIN), 1024, LDZ / 256, big, LDZ, lds); break;
    case 4: {
      const int hb = HBLK; char* hl = lds + hb * 65536;
      for (int it = blockIdx.x * 2 + hb; it < 512; it += gridDim.x * 2) compress_item(P, layer, it, big, kcv, hl);
      for (int it = blockIdx.x * 2 + hb; it < 1024; it += gridDim.x * 2) mixA_item(P, layer, it, big, abuf, hl);
      for (int it = blockIdx.x * 2 + hb; it < 2048; it += gridDim.x * 2) mixB1_item(P, layer, it, big, hsl, Pc, carryP, carryH, hl);
    } break;
    case 5: {
      nsa_tables(P, blockIdx.x & 1, lds);
      for (int it = blockIdx.x; it < 1024; it += gridDim.x) {
        const int rnd = it / 256, pos = it % 256;
        const int c = (rnd & 1) ? (rnd >> 1) * 16 + (pos >> 4) : 63 - (rnd >> 1) * 16 - (pos >> 4);
        const int bg = pos & 15;
        nsa_item(P, bg >> 1, bg & 1, c, big, kcv, abuf, lds);
      }
      const int hb = HBLK;
      for (int it = blockIdx.x * 2 + hb; it < 2048; it += gridDim.x * 2) mixB2_item(it, big, hsl, Pc, carryP, carryH, abuf);
    } break;
    case 6: gemm_bf16_phase(abuf, 1024, (const bf16_t*)(ws + OFF_WOUT + layer * SZ_SQ), 1024, 4, fbuf, 1024, lds); break;
    case 7: resnorm_phase(nullptr, h16, nullptr, h16, fbuf, 1.0f, ng + 3 * 1024, ng + 4 * 1024, abuf); break;
    case 10:
      gemm_bf16_phase((const bf16_t*)(ws + OFF_PBF) + (size_t)layer * M_TOK * 256, 256, (const bf16_t*)(ws + OFF_WPP + layer * SZ_WPP), 256, 4, big, 1024, lds);
      resnorm_phase(nullptr, h16, nullptr, h16, fbuf, 0.5f, ng + 5 * 1024, ng + 6 * 1024, abuf);
      break;
    case 11: gemm_ple_phase(abuf, (const bf16_t*)(ws + OFF_WPG + layer * SZ_SQ), big, fbuf, lds); break;
    case 12: resnorm_phase(nullptr, h16, layer == 0 ? nullptr : P.out, layer == 0 ? h16 : nullptr, fbuf, 1.0f, ng + 7 * 1024, layer == 0 ? P.norm_g + 8 * 1024 : nullptr, layer == 0 ? abuf : nullptr); break;
  }
}

#define XB_TMO      128
#define XB_XCNT(j)  (256  + 64 * (j))
#define XB_XSUB(j)  (1280 + 64 * (j))
#define XB_XGEN(j)  (2304 + 64 * (j))
#define XB_TOP      3328
#define XB_TOPGEN   3392
#define XCD_BAR_WORDS 3456
#define XB_SPIN_CAP (1u << 20)
#define LAS __attribute__((address_space(3)))
__device__ __forceinline__ unsigned xb_ld(unsigned* p)              { return __hip_atomic_load(p, __ATOMIC_RELAXED, __HIP_MEMORY_SCOPE_AGENT); }
__device__ __forceinline__ unsigned xb_add(unsigned* p, unsigned v) { return __hip_atomic_fetch_add(p, v, __ATOMIC_RELAXED, __HIP_MEMORY_SCOPE_AGENT); }
__device__ __forceinline__ unsigned xb_xcc_id() { return (unsigned)__builtin_amdgcn_s_getreg((3 << 11) | 20) & 0xFu; }
#define XB_SPIN(cond, bar) do { unsigned _sp = 0; while (cond) { __builtin_amdgcn_s_sleep(1); \
    if ((++_sp & 255u) == 0u) { if (xb_ld(&(bar)[XB_TMO])) break; if (_sp > XB_SPIN_CAP) { atomicAdd(&(bar)[XB_TMO], 1u); break; } } } } while (0)
struct XcdBarrier { unsigned* bar; unsigned x; volatile LAS unsigned* st; };
__device__ __forceinline__ XcdBarrier xcd_barrier_post(unsigned* bar, volatile LAS unsigned* st) {
    XcdBarrier b; b.bar = bar; b.x = xb_xcc_id(); b.st = st;
    if (threadIdx.x == 0) (void)xb_add(&bar[XB_XCNT(b.x)], 1u);
    return b;
}
__device__ __forceinline__ void xcd_barrier_complete(unsigned* bar, unsigned x, unsigned& nloc, unsigned& nx) {
    const unsigned G = gridDim.x * gridDim.y * gridDim.z;
    unsigned sum, cnt, mine, sp = 0u;
    for (;;) {
        sum = 0u; cnt = 0u; mine = 0u;
#pragma unroll
        for (unsigned j = 0; j < 16; ++j) { const unsigned c = xb_ld(&bar[XB_XCNT(j)]); sum += c; cnt += (c > 0u) ? 1u : 0u; mine = (j == x) ? c : mine; }
        if (sum == G) break;
        __builtin_amdgcn_s_sleep(1);
        if ((++sp & 255u) == 0u) { if (xb_ld(&bar[XB_TMO])) break; if (sp > XB_SPIN_CAP) { atomicAdd(&bar[XB_TMO], 1u); break; } }
    }
    nloc = mine > 0u ? mine : 1u; nx = cnt > 0u ? cnt : 1u;
}
__device__ __forceinline__ void xcd_barrier(const XcdBarrier& b) {
    asm volatile("s_waitcnt vmcnt(0)" ::: "memory");
    __syncthreads();
    if (threadIdx.x == 0) {
        unsigned* bar = b.bar;
        __builtin_amdgcn_s_waitcnt(0);
        unsigned nloc = b.st[0], nx = b.st[1];
        if (nloc == 0u) { xcd_barrier_complete(bar, b.x, nloc, nx); b.st[0] = nloc; b.st[1] = nx; }
        const unsigned old = xb_add(&bar[XB_XSUB(b.x)], 1u);
        const unsigned gen = old / nloc;
        if (old + 1u == (gen + 1u) * nloc) {
            __builtin_amdgcn_fence(__ATOMIC_RELEASE, "agent");
            asm volatile("s_waitcnt vmcnt(0)" ::: "memory");
            const unsigned og = xb_add(&bar[XB_TOP], 1u);
            const unsigned tg = og / nx;
            if (og + 1u == (tg + 1u) * nx) xb_add(&bar[XB_TOPGEN], 1u);
            else XB_SPIN(xb_ld(&bar[XB_TOPGEN]) == tg, bar);
            __builtin_amdgcn_fence(__ATOMIC_ACQUIRE, "agent");
            xb_add(&bar[XB_XGEN(b.x)], 1u);
            asm volatile("s_waitcnt vmcnt(0)" ::: "memory");
        } else {
            XB_SPIN(xb_ld(&bar[XB_XGEN(b.x)]) == gen, bar);
            __builtin_amdgcn_fence(__ATOMIC_ACQUIRE, "agent");
            asm volatile("s_waitcnt vmcnt(0)" ::: "memory");
        }
    }
    __syncthreads();
}

constexpr int LDS_BYTES = LDS_ST + 16;
__global__ void __launch_bounds__(512, 2) fwd_megakernel(Params P) {
  __shared__ __attribute__((aligned(16))) char lds[LDS_BYTES];
  cg::grid_group grid = cg::this_grid();
  volatile LAS unsigned* st = (volatile LAS unsigned*)(lds + LDS_ST);
  if (threadIdx.x == 0) { st[0] = 0u; st[1] = 0u; }
  __syncthreads();
  XcdBarrier xb = xcd_barrier_post((unsigned*)(P.ws + OFF_BAR), st);
  if (P.ws == nullptr) grid.sync();
  for (int ph = 0; ph < NPHASE; ++ph) {
    run_phase(P, ph, lds);
    if (ph + 1 < NPHASE) xcd_barrier(xb);
  }
}

__global__ void __launch_bounds__(512, 2) phase_kernel(Params P, int ph) {
  __shared__ __attribute__((aligned(16))) char lds[LDS_BYTES];
  run_phase(P, ph, lds);
}

extern "C" void kernel_launch(void* const* d_in, const int* in_sizes, int n_in, void* d_out, int out_size, void* d_ws, size_t ws_size, hipStream_t stream) {
  Params P{};
  const float** pp = (const float**)&P;
  for (int i = 0; i < 26; ++i) pp[i] = (const float*)d_in[i];
  P.out = (float*)d_out;
  P.ws = (char*)d_ws;
  if (ws_size < WS_NEED) { fprintf(stderr, "workspace too small: %zu < %zu\n", ws_size, (size_t)WS_NEED); return; }
#if MK_FUSED
  static int grid_blocks = 0;
  if (!grid_blocks) {
    int dev = 0, cus = 0, per_cu = 0;
    (void)hipGetDevice(&dev);
    (void)hipDeviceGetAttribute(&cus, hipDeviceAttributeMultiprocessorCount, dev);
    (void)hipOccupancyMaxActiveBlocksPerMultiprocessor(&per_cu, fwd_megakernel, 512, 0);
    if (per_cu > 1) per_cu = 1;
    if (per_cu < 1) per_cu = 1;
    grid_blocks = cus * per_cu;
  }
  (void)hipMemsetAsync((char*)d_ws + OFF_BAR, 0, XCD_BAR_WORDS * 4, stream);
  void* args[] = {&P};
  hipError_t e = hipLaunchCooperativeKernel((void*)fwd_megakernel, dim3(grid_blocks), dim3(512), args, 0, stream);
  if (e != hipSuccess) fprintf(stderr, "cooperative launch failed: %s (grid %d)\n", hipGetErrorString(e), grid_blocks);
#else
  for (int ph = 0; ph < NPHASE; ++ph) phase_kernel<<<256, 512, 0, stream>>>(P, ph);
#endif
}
```

```cpp
#include <hip/hip_runtime.h>
#include <hip/hip_cooperative_groups.h>
#include <cstdint>
#include <cstdio>
namespace cg = cooperative_groups;

#ifndef MK_FUSED
#define MK_FUSED 1
#endif

typedef unsigned short bf16_t;
typedef short bf16x8 __attribute__((ext_vector_type(8)));
typedef short bf16x4 __attribute__((ext_vector_type(4)));
typedef float f32x4 __attribute__((ext_vector_type(4)));
typedef unsigned long long u64;
typedef unsigned u32x4 __attribute__((ext_vector_type(4)));
typedef unsigned u32x2 __attribute__((ext_vector_type(2)));

constexpr int M_TOK = 32768, DM = 1024, DFF = 2816, NGU = 5632, NIN = 2328, LDZ = 2560, SEQ = 4096;
constexpr int NPHASE = 27;
constexpr int ZC_AU = 0, ZC_AV = 256, ZC_BX = 512, ZC_BG = 768, ZC_Q = 1024, ZC_KC = 1536, ZC_VC = 1664, ZC_KS = 1792, ZC_VS = 1920,
              ZC_KW = 2048, ZC_VW = 2176, ZC_GC = 2304, ZC_GS = 2312, ZC_GW = 2320;

constexpr size_t SZ_WGU = (size_t)NGU * 1024 * 2, SZ_WD = (size_t)1024 * DFF * 2, SZ_WIN = (size_t)LDZ * 1024 * 2, SZ_SQ = (size_t)1024 * 1024 * 2,
                 SZ_WPP = (size_t)1024 * 256 * 2, SZ_CW1 = (size_t)128 * 2048 * 2;
constexpr size_t OFF_WGU = 0;
constexpr size_t OFF_WD = OFF_WGU + 4 * SZ_WGU;
constexpr size_t OFF_WIN = OFF_WD + 4 * SZ_WD;
constexpr size_t OFF_WOUT = OFF_WIN + 2 * SZ_WIN;
constexpr size_t OFF_WPG = OFF_WOUT + 2 * SZ_SQ;
constexpr size_t OFF_WPP = OFF_WPG + 2 * SZ_SQ;
constexpr size_t OFF_CW1 = OFF_WPP + 2 * SZ_WPP;
constexpr size_t OFF_CB1 = OFF_CW1 + 4 * SZ_CW1;
constexpr size_t OFF_SGUW = OFF_CB1 + 4096;
constexpr size_t OFF_WAT = OFF_SGUW + 2 * 4 * 128 * 128 * 2;
constexpr size_t OFF_WXT = OFF_WAT + 2 * 4 * 64 * 64 * 2;
constexpr size_t OFF_PBF = OFF_WXT + 2 * 4 * 64 * 64 * 2;
constexpr size_t OFF_A = OFF_PBF + (size_t)2 * M_TOK * 256 * 2;
constexpr size_t OFF_BIG = OFF_A + (size_t)M_TOK * 1024 * 2;
constexpr size_t OFF_F = OFF_BIG + (size_t)M_TOK * DFF * 2;
constexpr size_t OFF_KC = OFF_F + (size_t)M_TOK * 1024 * 4;
constexpr size_t OFF_CARRY = OFF_KC + (size_t)2 * 8 * 2 * 256 * 64 * 2;
constexpr size_t OFF_BAR = OFF_CARRY + (size_t)2 * 8 * 4 * 64 * 64 * 4;
constexpr size_t OFF_CB1P = OFF_BAR + 16384;
constexpr size_t WS_NEED = OFF_CB1P + 32768;

struct Params {
  const float *x, *p, *rel_bias, *norm_g, *ffn_wg, *ffn_wu, *ffn_wd, *w_in, *w_out, *sgu_ng, *sgu_w, *sgu_b, *conv_w, *conv_b,
      *lru_wa, *lru_ba, *lru_wx, *lru_bx, *lru_lam, *cmp_pos, *cmp_w1, *cmp_b1, *cmp_w2, *cmp_b2, *ple_wg, *ple_wp;
  float* out;
  char* ws;
};

__device__ __forceinline__ int opaque_tid() { int t; asm volatile("v_mov_b32 %0, %1" : "=v"(t) : "v"(threadIdx.x)); return t; }
#define TIDX opaque_tid()
#define HTID (opaque_tid() & 255)
#define HBLK (opaque_tid() >> 8)
__device__ __forceinline__ float bf2f(bf16_t v) { return __uint_as_float(((unsigned)v) << 16); }
__device__ __forceinline__ bf16_t f2bf(float f) { unsigned u = __float_as_uint(f); u += 0x7fffu + ((u >> 16) & 1u); return (bf16_t)(u >> 16); }
typedef float f32x2v __attribute__((ext_vector_type(2)));
typedef __bf16 bf16x2v __attribute__((ext_vector_type(2)));
__device__ __forceinline__ unsigned pk2(float lo, float hi) { const f32x2v v = {lo, hi}; const bf16x2v r = __builtin_convertvector(v, bf16x2v); return __builtin_bit_cast(unsigned, r); }
__device__ __forceinline__ float sigm(float x) { return __builtin_amdgcn_rcpf(1.f + __expf(-x)); }
__device__ __forceinline__ float gelu_t(float x) { float u = 0.7978845608028654f * (x + 0.044715f * x * x * x); return x * __builtin_amdgcn_rcpf(1.f + __expf(-2.f * u)); }
__device__ __forceinline__ float silu_f(float x) { return x * __builtin_amdgcn_rcpf(1.f + __expf(-x)); }
__device__ __forceinline__ f32x4 mfma16(bf16x8 a, bf16x8 b, f32x4 c) { return __builtin_amdgcn_mfma_f32_16x16x32_bf16(a, b, c, 0, 0, 0); }
__device__ __forceinline__ void glds16(const void* g, void* l) {
  __builtin_amdgcn_global_load_lds((const __attribute__((address_space(1))) unsigned*)g, (__attribute__((address_space(3))) unsigned*)l, 16, 0, 0);
}
__device__ __forceinline__ f32x4 zero4() { f32x4 z; asm volatile("v_mov_b32 %0, 0\n\tv_mov_b32 %1, 0\n\tv_mov_b32 %2, 0\n\tv_mov_b32 %3, 0" : "=v"(z[0]), "=v"(z[1]), "=v"(z[2]), "=v"(z[3])); return z; }
__device__ __forceinline__ float wave_sum(float v) {
#pragma unroll
  for (int o = 32; o > 0; o >>= 1) v += __shfl_xor(v, o);
  return v;
}
__device__ __forceinline__ void unpack8(const u32x4 u, float* f) {
  f[0] = __uint_as_float(u.x << 16); f[1] = __uint_as_float(u.x & 0xffff0000u);
  f[2] = __uint_as_float(u.y << 16); f[3] = __uint_as_float(u.y & 0xffff0000u);
  f[4] = __uint_as_float(u.z << 16); f[5] = __uint_as_float(u.z & 0xffff0000u);
  f[6] = __uint_as_float(u.w << 16); f[7] = __uint_as_float(u.w & 0xffff0000u);
}

__device__ __forceinline__ void tr_cvt(const float* __restrict__ src, int N, int K, bf16_t* __restrict__ dst, int ldd, int rs, int ro, char* ldsc, int& rot) {
  const int ntn = (N + 63) >> 6, nt = ntn * (K >> 6), hb = HBLK, tid = HTID;
  float* lds = (float*)(ldsc + hb * 65536);
  int vb = (int)blockIdx.x - rot; if (vb < 0) vb += gridDim.x;
  rot = (rot + (nt + 5) / 6) % (int)gridDim.x;
  for (int t0 = vb * 6; t0 < nt; t0 += gridDim.x * 6) {
    float4 v[3][4];
#pragma unroll
    for (int u = 0; u < 3; ++u) {
      const int tile = t0 + hb * 3 + u, tk = tile / ntn, tn = tile - tk * ntn, k0 = tk * 64, n0 = tn * 64;
      const bool active = tile < nt;
#pragma unroll
      for (int ps = 0; ps < 4; ++ps) {
        const int i = ps * 16 + (tid >> 4), j = (tid & 15) * 4;
        v[u][ps] = make_float4(0.f, 0.f, 0.f, 0.f);
        if (active && n0 + j < N) v[u][ps] = *(const float4*)(src + (size_t)(k0 + i) * N + n0 + j);
      }
    }
#pragma unroll
    for (int u = 0; u < 3; ++u)
#pragma unroll
      for (int ps = 0; ps < 4; ++ps) {
        const int i = ps * 16 + (tid >> 4), j = (tid & 15) * 4;
        float* d = lds + u * 4160 + i * 65 + j; d[0] = v[u][ps].x; d[1] = v[u][ps].y; d[2] = v[u][ps].z; d[3] = v[u][ps].w;
      }
    __syncthreads();
#pragma unroll
    for (int u = 0; u < 3; ++u) {
      const int tile = t0 + hb * 3 + u, tk = tile / ntn, tn = tile - tk * ntn, k0 = tk * 64, n0 = tn * 64;
      const int j = tid >> 2, kq = tid & 3, n = n0 + j;
      if (tile < nt && n < N) {
        const float* l = lds + u * 4160;
        unsigned w[8];
#pragma unroll
        for (int q = 0; q < 8; ++q) w[q] = pk2(l[(kq * 16 + 2 * q) * 65 + j], l[(kq * 16 + 2 * q + 1) * 65 + j]);
        bf16_t* o = dst + (size_t)((n >> 4) * rs + (n & 15) + ro) * ldd + k0 + kq * 16;
        u32x4 w0, w1; w0.x = w[0]; w0.y = w[1]; w0.z = w[2]; w0.w = w[3]; w1.x = w[4]; w1.y = w[5]; w1.z = w[6]; w1.w = w[7];
        *(u32x4*)o = w0; *(u32x4*)(o + 8) = w1;
      }
    }
    __syncthreads();
  }
}

struct RowRegs { float4 h[4]; u32x2 f[4]; };
__device__ __forceinline__ void rn_load(RowRegs& R, const float* hin32, const bf16_t* hin16, const bf16_t* f, int row, int lane) {
  if (hin32) {
#pragma unroll
    for (int i = 0; i < 4; ++i) R.h[i] = *(const float4*)(hin32 + (size_t)row * 1024 + i * 256 + lane * 4);
  } else {
#pragma unroll
    for (int i = 0; i < 4; ++i) { const u32x2 v = *(const u32x2*)(hin16 + (size_t)row * 1024 + i * 256 + lane * 4);
      R.h[i].x = __uint_as_float(v.x << 16); R.h[i].y = __uint_as_float(v.x & 0xffff0000u); R.h[i].z = __uint_as_float(v.y << 16); R.h[i].w = __uint_as_float(v.y & 0xffff0000u); }
  }
  if (f) {
#pragma unroll
    for (int i = 0; i < 4; ++i) R.f[i] = *(const u32x2*)(f + (size_t)row * 1024 + i * 256 + lane * 4);
  }
}
__device__ __forceinline__ void rn_proc(RowRegs& R, float* hout32, bf16_t* hout16, bool has_f, float scale, const float4 (&gpo)[4], const float4 (&gpr)[4], bf16_t* a, int row, int lane) {
  if (has_f) {
    float fv[4][4]; float ss = 0.f;
#pragma unroll
    for (int i = 0; i < 4; ++i) {
      fv[i][0] = __uint_as_float(R.f[i].x << 16); fv[i][1] = __uint_as_float(R.f[i].x & 0xffff0000u);
      fv[i][2] = __uint_as_float(R.f[i].y << 16); fv[i][3] = __uint_as_float(R.f[i].y & 0xffff0000u);
      ss += fv[i][0] * fv[i][0] + fv[i][1] * fv[i][1] + fv[i][2] * fv[i][2] + fv[i][3] * fv[i][3];
    }
    ss = wave_sum(ss);
    const float r = rsqrtf(ss * (1.f / 1024.f) + 1e-6f) * scale;
#pragma unroll
    for (int i = 0; i < 4; ++i) { const float4 g = gpo[i];
      R.h[i].x += fv[i][0] * r * g.x; R.h[i].y += fv[i][1] * r * g.y; R.h[i].z += fv[i][2] * r * g.z; R.h[i].w += fv[i][3] * r * g.w; }
  }
  if (hout32) {
#pragma unroll
    for (int i = 0; i < 4; ++i) *(float4*)(hout32 + (size_t)row * 1024 + i * 256 + lane * 4) = R.h[i];
  }
  if (hout16) {
#pragma unroll
    for (int i = 0; i < 4; ++i) { u32x2 o; o.x = pk2(R.h[i].x, R.h[i].y); o.y = pk2(R.h[i].z, R.h[i].w); *(u32x2*)(hout16 + (size_t)row * 1024 + i * 256 + lane * 4) = o; }
  }
  if (a) {
    float ss = 0.f;
#pragma unroll
    for (int i = 0; i < 4; ++i) ss += R.h[i].x * R.h[i].x + R.h[i].y * R.h[i].y + R.h[i].z * R.h[i].z + R.h[i].w * R.h[i].w;
    ss = wave_sum(ss);
    const float r = rsqrtf(ss * (1.f / 1024.f) + 1e-6f);
#pragma unroll
    for (int i = 0; i < 4; ++i) { const float4 g = gpr[i];
      u32x2 o; o.x = pk2(R.h[i].x * r * g.x, R.h[i].y * r * g.y); o.y = pk2(R.h[i].z * r * g.z, R.h[i].w * r * g.w);
      *(u32x2*)(a + (size_t)row * 1024 + i * 256 + lane * 4) = o; }
  }
}
__device__ __forceinline__ void resnorm_phase(const float* hin32, const bf16_t* hin16, float* hout32, bf16_t* hout16, const bf16_t* f, float scale, const float* gpost, const float* gpre, bf16_t* a) {
  const int tid = TIDX, lane = tid & 63, stride = gridDim.x * 8;
  int r0 = blockIdx.x * 8 + (tid >> 6), r1 = r0 + 2 * stride;
  RowRegs A0, A1, B0, B1;
  float4 gpo[4], gpr[4];
#pragma unroll
  for (int i = 0; i < 4; ++i) { gpo[i] = f ? *(const float4*)(gpost + i * 256 + lane * 4) : make_float4(0.f, 0.f, 0.f, 0.f); gpr[i] = a ? *(const float4*)(gpre + i * 256 + lane * 4) : make_float4(0.f, 0.f, 0.f, 0.f); }
  const bool hf = f != nullptr;
  if (r0 < M_TOK) { rn_load(A0, hin32, hin16, f, r0, lane); rn_load(A1, hin32, hin16, f, r0 + stride, lane); }
  for (;;) {
    if (r0 >= M_TOK) break;
    if (r1 < M_TOK) { rn_load(B0, hin32, hin16, f, r1, lane); rn_load(B1, hin32, hin16, f, r1 + stride, lane); }
    rn_proc(A0, hout32, hout16, hf, scale, gpo, gpr, a, r0, lane); rn_proc(A1, hout32, hout16, hf, scale, gpo, gpr, a, r0 + stride, lane);
    r0 += 4 * stride;
    if (r1 >= M_TOK) break;
    if (r0 < M_TOK) { rn_load(A0, hin32, hin16, f, r0, lane); rn_load(A1, hin32, hin16, f, r0 + stride, lane); }
    rn_proc(B0, hout32, hout16, hf, scale, gpo, gpr, a, r1, lane); rn_proc(B1, hout32, hout16, hf, scale, gpo, gpr, a, r1 + stride, lane);
    r1 += 4 * stride;
  }
}

__device__ __forceinline__ void prep_phase(const Params& P, char* ldsc) {
  char* ws = P.ws;
  int rot = 0;
  for (int l = 0; l < 2; ++l) {
    for (int j = 0; j < 2; ++j) {
      const int lj = l * 2 + j;
      bf16_t* wgu = (bf16_t*)(ws + OFF_WGU + lj * SZ_WGU);
      tr_cvt(P.ffn_wg + (size_t)lj * 1024 * DFF, DFF, 1024, wgu, 1024, 32, 0, ldsc, rot);
      tr_cvt(P.ffn_wu + (size_t)lj * 1024 * DFF, DFF, 1024, wgu, 1024, 32, 16, ldsc, rot);
      tr_cvt(P.ffn_wd + (size_t)lj * DFF * 1024, 1024, DFF, (bf16_t*)(ws + OFF_WD + lj * SZ_WD), DFF, 16, 0, ldsc, rot);
      tr_cvt(P.cmp_w1 + (size_t)lj * 2048 * 128, 128, 2048, (bf16_t*)(ws + OFF_CW1 + lj * SZ_CW1), 2048, 16, 0, ldsc, rot);
    }
    tr_cvt(P.w_in + (size_t)l * 1024 * NIN, NIN, 1024, (bf16_t*)(ws + OFF_WIN + l * SZ_WIN), 1024, 16, 0, ldsc, rot);
    tr_cvt(P.w_out + (size_t)l * 1024 * 1024, 1024, 1024, (bf16_t*)(ws + OFF_WOUT + l * SZ_SQ), 1024, 16, 0, ldsc, rot);
    tr_cvt(P.ple_wg + (size_t)l * 1024 * 1024, 1024, 1024, (bf16_t*)(ws + OFF_WPG + l * SZ_SQ), 1024, 16, 0, ldsc, rot);
    tr_cvt(P.ple_wp + (size_t)l * 256 * 1024, 1024, 256, (bf16_t*)(ws + OFF_WPP + l * SZ_WPP), 256, 16, 0, ldsc, rot);
    for (int g = 0; g < 4; ++g) {
      tr_cvt(P.lru_wa + (size_t)(l * 4 + g) * 4096, 64, 64, (bf16_t*)(ws + OFF_WAT) + (l * 4 + g) * 4096, 64, 16, 0, ldsc, rot);
      tr_cvt(P.lru_wx + (size_t)(l * 4 + g) * 4096, 64, 64, (bf16_t*)(ws + OFF_WXT) + (l * 4 + g) * 4096, 64, 16, 0, ldsc, rot);
    }
  }
  const int tid = TIDX, gtid = blockIdx.x * 512 + tid, gn = gridDim.x * 512;
  for (int i = gtid; i < 2 * (LDZ - NIN) * 1024 / 8; i += gn) {
    const int l = i / ((LDZ - NIN) * 128), r = i - l * ((LDZ - NIN) * 128);
    *(f32x4*)((bf16_t*)(ws + OFF_WIN + l * SZ_WIN) + (size_t)NIN * 1024 + (size_t)r * 8) = zero4();
  }
  for (int i = gtid; i < 2 * 4 * 128 * 128; i += gn) { const int t = (i >> 7) & 127, s2 = i & 127; ((bf16_t*)(ws + OFF_SGUW))[i] = (s2 <= t) ? f2bf(P.sgu_w[i]) : (bf16_t)0; }
  for (int i = gtid; i < 2 * M_TOK * 256 / 4; i += gn) { const float4 v = ((const float4*)P.p)[i]; uint2 o; o.x = pk2(v.x, v.y); o.y = pk2(v.z, v.w); ((uint2*)(ws + OFF_PBF))[i] = o; }
  {
    float* lds = (float*)(ldsc + HBLK * 65536);
    for (int u = blockIdx.x; u < 64; u += gridDim.x) {
      const int t2 = HTID, kq = t2 >> 5, jq = t2 & 31, lkv = u >> 4, kc = u & 15;
      const float* w1 = P.cmp_w1 + (size_t)lkv * 2048 * 128; const float* pos = P.cmp_pos + (size_t)lkv * 2048;
      float4 sacc = make_float4(0.f, 0.f, 0.f, 0.f);
#pragma unroll
      for (int kk = 0; kk < 16; ++kk) { const int k = kc * 128 + kq * 16 + kk; const float pv = pos[k]; const float4 w = *(const float4*)(w1 + (size_t)k * 128 + jq * 4); sacc.x += pv * w.x; sacc.y += pv * w.y; sacc.z += pv * w.z; sacc.w += pv * w.w; }
      __syncthreads();
      lds[kq * 128 + jq * 4 + 0] = sacc.x; lds[kq * 128 + jq * 4 + 1] = sacc.y; lds[kq * 128 + jq * 4 + 2] = sacc.z; lds[kq * 128 + jq * 4 + 3] = sacc.w;
      __syncthreads();
      if (t2 < 128) { float t = 0.f; for (int q = 0; q < 8; ++q) t += lds[q * 128 + t2]; ((float*)(ws + OFF_CB1P))[u * 128 + t2] = t; }
      __syncthreads();
    }
  }
  resnorm_phase(P.x, nullptr, nullptr, nullptr, nullptr, 0.f, nullptr, P.norm_g, (bf16_t*)(ws + OFF_A));
}

constexpr int G8_HT = 128 * 64;
__device__ __forceinline__ int g8_lds_byte(int r, int c) { const int st = (r >> 4) * 2 + (c >> 5), rr = r & 15, cc = c & 31, ob = rr * 64 + cc * 2; return st * 1024 + (ob ^ (((ob >> 9) & 1) << 5)); }
__device__ __forceinline__ void g8_stage_rc(int b, int& R, int& C) { const int st = b / 1024, sb = b % 1024, swz = sb ^ (((sb >> 9) & 1) << 5); R = (st >> 1) * 16 + swz / 64; C = (st & 1) * 32 + (swz % 64) / 2; }

template <bool ISSUE_ONLY, bool PRE_ISSUED>
__device__ __forceinline__ void gemm_core(f32x4 (&acc)[2][2][4][2], const bf16_t* __restrict__ A, int lda, const bf16_t* __restrict__ Bt, int ldb, int K, char* ldsc) {
  bf16_t* shm = (bf16_t*)ldsc;
  const int tid = TIDX, wid = tid >> 6, lane = tid & 63, wr = wid >> 2, wc = wid & 3, fr = lane & 15, fq = lane >> 4;
  int sr0, sc0;
  g8_stage_rc(tid * 16, sr0, sc0);
  const bf16_t* gA0 = A + (size_t)sr0 * lda + sc0;
  const bf16_t* gB0 = Bt + (size_t)sr0 * ldb + sc0;
  const size_t a64 = (size_t)64 * lda, b64 = (size_t)64 * ldb;
  const int lane_off = (fr * 64 + fq * 16) ^ ((((fr * 64 + fq * 16) >> 9) & 1) << 5);
  const char* ldA = ldsc + wr * 8192 + lane_off;
  const char* ldB = ldsc + 65536 + wc * 4096 + lane_off;
#define SA(b, h) (shm + ((b) * 2 + (h)) * G8_HT)
#define SB(b, h) (shm + (4 + (b) * 2 + (h)) * G8_HT)
#define STAGE_A(P, h, kt) { const bf16_t* g_ = gA0 + (size_t)(h) * 2 * a64 + (kt) * 64; glds16(g_, (char*)(P) + tid * 16); glds16(g_ + a64, (char*)(P) + tid * 16 + 8192); }
#define STAGE_B(P, h, kt) { const bf16_t* g_ = gB0 + (size_t)(h) * 2 * b64 + (kt) * 64; glds16(g_, (char*)(P) + tid * 16); glds16(g_ + b64, (char*)(P) + tid * 16 + 8192); }
#define LDA(dst, b, h) _Pragma("unroll") for (int m = 0; m < 4; ++m) _Pragma("unroll") for (int k = 0; k < 2; ++k) \
    dst[m][k] = *reinterpret_cast<const bf16x8*>(ldA + ((b) * 2 + (h)) * 16384 + (m * 2 + k) * 1024)
#define LDB(dst, b, h) _Pragma("unroll") for (int n = 0; n < 2; ++n) _Pragma("unroll") for (int k = 0; k < 2; ++k) \
    dst[n][k] = *reinterpret_cast<const bf16x8*>(ldB + ((b) * 2 + (h)) * 16384 + (n * 2 + k) * 1024)
#define MMA(ai, bj, At_, Bt_) do { __builtin_amdgcn_s_setprio(1); \
    _Pragma("unroll") for (int m = 0; m < 4; ++m) _Pragma("unroll") for (int n = 0; n < 2; ++n) _Pragma("unroll") for (int k = 0; k < 2; ++k) \
      acc[ai][bj][m][n] = mfma16(Bt_[n][k], At_[m][k], acc[ai][bj][m][n]); \
    __builtin_amdgcn_s_setprio(0); } while (0)
#define WAIT_V(n) asm volatile("s_waitcnt vmcnt(" #n ")" ::: "memory")
#define WAIT_L(n) asm volatile("s_waitcnt lgkmcnt(" #n ")" ::: "memory")
#define BAR __builtin_amdgcn_s_barrier()
#define SCHED __builtin_amdgcn_sched_barrier(0)
  bf16x8 At[4][2], B0[2][2], B1[2][2];
  const int nt = K >> 6;
  if (!PRE_ISSUED) {
    STAGE_B(SB(0, 0), 0, 0); STAGE_A(SA(0, 0), 0, 0);
    STAGE_B(SB(0, 1), 1, 0); STAGE_A(SA(0, 1), 1, 0);
  }
  if (ISSUE_ONLY) return;
  if (wr == 1) BAR;
  if (PRE_ISSUED) { WAIT_V(0); } else { WAIT_V(4); }
  BAR;
  STAGE_B(SB(1, 0), 0, 1); STAGE_A(SA(1, 0), 0, 1); STAGE_B(SB(1, 1), 1, 1);
  WAIT_V(6); BAR;
#pragma nounroll
  for (int t = 0; t < nt - 2; t += 2) {
    LDB(B0, 0, 0); SCHED; LDA(At, 0, 0); STAGE_A(SA(1, 1), 1, t + 1);
    WAIT_L(8); BAR; WAIT_L(0); MMA(0, 0, At, B0); BAR; SCHED;
    LDB(B1, 0, 1); STAGE_B(SB(0, 0), 0, t + 2);
    BAR; WAIT_L(0); MMA(0, 1, At, B1); BAR;
    LDA(At, 0, 1); STAGE_A(SA(0, 0), 0, t + 2);
    BAR; WAIT_L(0); MMA(1, 0, At, B0); BAR; SCHED;
    STAGE_B(SB(0, 1), 1, t + 2);
    WAIT_V(6); BAR; MMA(1, 1, At, B1); BAR;
    LDB(B0, 1, 0); SCHED; LDA(At, 1, 0); STAGE_A(SA(0, 1), 1, t + 2);
    WAIT_L(8); BAR; WAIT_L(0); MMA(0, 0, At, B0); BAR; SCHED;
    LDB(B1, 1, 1); STAGE_B(SB(1, 0), 0, t + 3);
    BAR; WAIT_L(0); MMA(0, 1, At, B1); BAR;
    LDA(At, 1, 1); STAGE_A(SA(1, 0), 0, t + 3);
    BAR; WAIT_L(0); MMA(1, 0, At, B0); BAR; SCHED;
    STAGE_B(SB(1, 1), 1, t + 3);
    WAIT_V(6); BAR; MMA(1, 1, At, B1); BAR;
  }
  { LDB(B0, 0, 0); LDA(At, 0, 0); STAGE_A(SA(1, 1), 1, nt - 1);
    BAR; WAIT_L(0); MMA(0, 0, At, B0); BAR;
    LDB(B1, 0, 1); BAR; WAIT_L(0); MMA(0, 1, At, B1); BAR;
    LDA(At, 0, 1); WAIT_V(4); BAR; WAIT_L(0); MMA(1, 0, At, B0); MMA(1, 1, At, B1); BAR; }
  { LDB(B0, 1, 0); LDA(At, 1, 0); WAIT_V(2); BAR; WAIT_L(0); MMA(0, 0, At, B0); BAR;
    LDB(B1, 1, 1); WAIT_V(0); BAR; WAIT_L(0); MMA(0, 1, At, B1); BAR;
    LDA(At, 1, 1); BAR; WAIT_L(0); MMA(1, 0, At, B0); MMA(1, 1, At, B1); BAR; }
  if (wr == 0) BAR;
  BAR;
#undef SA
#undef SB
#undef STAGE_A
#undef STAGE_B
#undef LDA
#undef LDB
#undef MMA
#undef WAIT_V
#undef WAIT_L
#undef BAR
#undef SCHED
}

struct TileIt {
  int TN, npc, npatch, slot, nslot, pid, s, tm, tn;
  __device__ __forceinline__ void init(int TN_) { TN = TN_; npc = (TN + 1) >> 1; npatch = 8 * npc; slot = blockIdx.x >> 3; nslot = gridDim.x >> 3; pid = blockIdx.x & 7; s = slot - nslot; }
  __device__ __forceinline__ bool next() {
    for (;;) {
      s += nslot;
      if (s >= 32) { s = slot; pid += 8; }
      if (pid >= npatch) return false;
      const int pr = pid / npc, pc = pid - pr * npc;
      tm = pr * 16 + (s & 15); tn = pc * 2 + (s >> 4);
      if (tn < TN) return true;
    }
  }
};

#define GEMM_LANE const int tid_ = TIDX, lane_ = tid_ & 63, wid_ = tid_ >> 6, wr = wid_ >> 2, wc = wid_ & 3, fr = lane_ & 15, fq = lane_ >> 4
#define GEMM_EPI_LOOP _Pragma("unroll") for (int ai = 0; ai < 2; ++ai) _Pragma("unroll") for (int m = 0; m < 4; ++m) _Pragma("unroll") for (int bj = 0; bj < 2; ++bj)

template <class Epi> __device__ __forceinline__ void gemm_phase(const bf16_t* A, int lda, const bf16_t* Bt, int ldb, int K, int TN, char* lds, Epi&& epi) {
  TileIt it; it.init(TN);
  bool have = it.next();
  f32x4 acc[2][2][4][2];
  if (have) gemm_core<true, false>(acc, A + (size_t)it.tm * 256 * lda, lda, Bt + (size_t)it.tn * 256 * ldb, ldb, K, lds);
  while (have) {
    const int tm = it.tm, tn = it.tn;
#pragma unroll
    for (int i0 = 0; i0 < 2; ++i0)
#pragma unroll
      for (int i1 = 0; i1 < 2; ++i1)
#pragma unroll
        for (int i2 = 0; i2 < 4; ++i2)
#pragma unroll
          for (int i3 = 0; i3 < 2; ++i3) acc[i0][i1][i2][i3] = zero4();
    gemm_core<false, true>(acc, A + (size_t)tm * 256 * lda, lda, Bt + (size_t)tn * 256 * ldb, ldb, K, lds);
    have = it.next();
    if (have) { f32x4 dummy[2][2][4][2]; gemm_core<true, false>(dummy, A + (size_t)it.tm * 256 * lda, lda, Bt + (size_t)it.tn * 256 * ldb, ldb, K, lds); }
    epi(acc, tm, tn);
  }
  asm volatile("s_waitcnt vmcnt(0)" ::: "memory");
}

__device__ __forceinline__ void gemm_up_phase(const bf16_t* a, const bf16_t* wgu, bf16_t* act, char* lds) {
  gemm_phase(a, 1024, wgu, 1024, 1024, NGU / 256, lds, [&](f32x4 (&acc)[2][2][4][2], int tm, int tn) {
    GEMM_LANE;
    GEMM_EPI_LOOP {
      const int row = tm * 256 + ai * 128 + wr * 64 + m * 16 + fr;
      const int col = tn * 128 + bj * 64 + wc * 16 + 4 * fq;
      const f32x4 g = acc[ai][bj][m][0], u = acc[ai][bj][m][1];
      u32x2 o; o.x = pk2(silu_f(g[0]) * u[0], silu_f(g[1]) * u[1]); o.y = pk2(silu_f(g[2]) * u[2], silu_f(g[3]) * u[3]);
      *(u32x2*)(act + (size_t)row * DFF + col) = o;
    }
  });
}

__device__ __forceinline__ void gemm_bf16_phase(const bf16_t* A, int lda, const bf16_t* Bt, int K, int TN, bf16_t* out, int ldo, char* lds) {
  gemm_phase(A, lda, Bt, K, K, TN, lds, [&](f32x4 (&acc)[2][2][4][2], int tm, int tn) {
    GEMM_LANE;
    GEMM_EPI_LOOP {
      const int row = tm * 256 + ai * 128 + wr * 64 + m * 16 + fr;
#pragma unroll
      for (int n = 0; n < 2; ++n) {
        u32x2 o; o.x = pk2(acc[ai][bj][m][n][0], acc[ai][bj][m][n][1]); o.y = pk2(acc[ai][bj][m][n][2], acc[ai][bj][m][n][3]);
        *(u32x2*)(out + (size_t)row * ldo + tn * 256 + bj * 128 + wc * 32 + n * 16 + 4 * fq) = o;
      }
    }
  });
}

__device__ __forceinline__ void gemm_ple_phase(const bf16_t* a, const bf16_t* wpg, const bf16_t* pp, bf16_t* out, char* lds) {
  gemm_phase(a, 1024, wpg, 1024, 1024, 4, lds, [&](f32x4 (&acc)[2][2][4][2], int tm, int tn) {
    GEMM_LANE;
    GEMM_EPI_LOOP {
      const int row = tm * 256 + ai * 128 + wr * 64 + m * 16 + fr;
#pragma unroll
      for (int n = 0; n < 2; ++n) {
        const int col = tn * 256 + bj * 128 + wc * 32 + n * 16 + 4 * fq;
        const u32x2 pv = *(const u32x2*)(pp + (size_t)row * 1024 + col);
        const f32x4 av = acc[ai][bj][m][n];
        u32x2 o;
        o.x = pk2(sigm(av[0]) * __uint_as_float(pv.x << 16), sigm(av[1]) * __uint_as_float(pv.x & 0xffff0000u));
        o.y = pk2(sigm(av[2]) * __uint_as_float(pv.y << 16), sigm(av[3]) * __uint_as_float(pv.y & 0xffff0000u));
        *(u32x2*)(out + (size_t)row * 1024 + col) = o;
      }
    }
  });
}

__device__ __forceinline__ void mixA_item(const Params& P, int layer, int idx, const bf16_t* z, bf16_t* y, char* lds) {
  const int g = idx & 3, bc = idx >> 2, tok0 = bc * 128;
  const int tid = HTID, lane = tid & 63, w = tid >> 6, fr = lane & 15, fq = lane >> 4;
  bf16_t* vT = (bf16_t*)lds;
  const float* ng = P.sgu_ng + layer * 256;
  {
    const int s = tid >> 1, half = tid & 1;
    const bf16_t* zr = z + (size_t)(tok0 + s) * LDZ + ZC_AV;
    float ss = 0.f;
#pragma unroll 4
    for (int i = 0; i < 16; ++i) { float v[8]; unpack8(*(const u32x4*)(zr + half * 128 + i * 8), v);
#pragma unroll
      for (int e = 0; e < 8; ++e) { const float t = gelu_t(v[e]); ss += t * t; } }
    ss += __shfl_xor(ss, 1);
    const float rs = rsqrtf(ss * (1.f / 256.f) + 1e-6f);
#pragma unroll
    for (int i = 0; i < 4; ++i) { float v[8]; unpack8(*(const u32x4*)(zr + g * 64 + half * 32 + i * 8), v);
#pragma unroll
      for (int e = 0; e < 8; ++e) { const int d = half * 32 + i * 8 + e; vT[d * 136 + s] = f2bf(gelu_t(v[e]) * rs * ng[g * 64 + d]); } }
  }
  __syncthreads();
  const bf16_t* W = (const bf16_t*)(P.ws + OFF_SGUW) + (size_t)((layer * 4 + g) * 128) * 128;
  f32x4 acc[2][4] = {};
  for (int ks = 0; ks <= w; ++ks) {
    bf16x8 wf[2], vf[4];
#pragma unroll
    for (int tm = 0; tm < 2; ++tm) wf[tm] = *(const bf16x8*)(W + (size_t)(32 * w + tm * 16 + fr) * 128 + ks * 32 + 8 * fq);
#pragma unroll
    for (int dn = 0; dn < 4; ++dn) vf[dn] = *(const bf16x8*)(vT + (dn * 16 + fr) * 136 + ks * 32 + 8 * fq);
#pragma unroll
    for (int tm = 0; tm < 2; ++tm)
#pragma unroll
      for (int dn = 0; dn < 4; ++dn) acc[tm][dn] = mfma16(vf[dn], wf[tm], acc[tm][dn]);
  }
#pragma unroll
  for (int tm = 0; tm < 2; ++tm) {
    const int t = 32 * w + tm * 16 + fr;
    const float bias = P.sgu_b[(layer * 4 + g) * 128 + t];
#pragma unroll
    for (int dn = 0; dn < 4; ++dn) {
      const int d = dn * 16 + 4 * fq;
      const uint2 uu = *(const uint2*)(z + (size_t)(tok0 + t) * LDZ + ZC_AU + g * 64 + d);
      const float u0 = gelu_t(__uint_as_float(uu.x << 16)), u1 = gelu_t(__uint_as_float(uu.x & 0xffff0000u)),
                  u2 = gelu_t(__uint_as_float(uu.y << 16)), u3 = gelu_t(__uint_as_float(uu.y & 0xffff0000u));
      uint2 o; o.x = pk2(u0 * (acc[tm][dn][0] + bias), u1 * (acc[tm][dn][1] + bias)); o.y = pk2(u2 * (acc[tm][dn][2] + bias), u3 * (acc[tm][dn][3] + bias));
      *(uint2*)(y + (size_t)(tok0 + t) * 1024 + g * 64 + d) = o;
    }
  }
  __syncthreads();
}

__device__ __forceinline__ void mixB1_item(const Params& P, int layer, int idx, const bf16_t* z, float* hsl, float* Pc, float* carryP, float* carryH, char* lds) {
  const int c = idx & 63, g = (idx >> 6) & 3, b = idx >> 8;
  const int tid = HTID, lane = tid & 63, w = tid >> 6, fr = lane & 15, fq = lane >> 4;
  bf16_t* xcb = (bf16_t*)lds;
  float* xcf = (float*)(lds + 9216);
  float* aA = (float*)(lds + 9216 + 16384);
  float* bB = (float*)(lds + 9216 + 32768);
  float* sm = (float*)(lds + 9216 + 49152);
  const size_t tokb = (size_t)b * SEQ;
  {
    const int t = tid >> 2, q = tid & 3;
    float accv[16];
#pragma unroll
    for (int i = 0; i < 16; ++i) accv[i] = P.conv_b[layer * 256 + g * 64 + q * 16 + i];
#pragma unroll
    for (int k = 0; k < 4; ++k) {
      const int pos = c * 64 + t - 3 + k;
      if (pos >= 0) {
        const bf16_t* zr = z + (tokb + pos) * LDZ + ZC_BX + g * 64 + q * 16;
        float v[16]; unpack8(*(const u32x4*)zr, v); unpack8(*(const u32x4*)(zr + 8), v + 8);
        const float* cw = P.conv_w + (size_t)(layer * 4 + k) * 256 + g * 64 + q * 16;
#pragma unroll
        for (int i = 0; i < 16; ++i) accv[i] += v[i] * cw[i];
      }
    }
#pragma unroll
    for (int i = 0; i < 16; ++i) { xcf[t * 64 + q * 16 + i] = accv[i]; xcb[t * 72 + q * 16 + i] = f2bf(accv[i]); }
  }
  __syncthreads();
  {
    const bf16_t* wa = (const bf16_t*)(P.ws + OFF_WAT) + (layer * 4 + g) * 4096;
    const bf16_t* wx = (const bf16_t*)(P.ws + OFF_WXT) + (layer * 4 + g) * 4096;
    f32x4 ar[4] = {}, ai[4] = {};
#pragma unroll
    for (int ks = 0; ks < 2; ++ks) {
      const bf16x8 xf = *(const bf16x8*)(xcb + (16 * w + fr) * 72 + ks * 32 + 8 * fq);
#pragma unroll
      for (int jn = 0; jn < 4; ++jn) {
        const bf16x8 fa = *(const bf16x8*)(wa + (jn * 16 + fr) * 64 + ks * 32 + 8 * fq);
        const bf16x8 fx = *(const bf16x8*)(wx + (jn * 16 + fr) * 64 + ks * 32 + 8 * fq);
        ar[jn] = mfma16(fa, xf, ar[jn]); ai[jn] = mfma16(fx, xf, ai[jn]);
      }
    }
    const int t = 16 * w + fr;
#pragma unroll
    for (int jn = 0; jn < 4; ++jn)
#pragma unroll
      for (int e = 0; e < 4; ++e) {
        const int j = jn * 16 + 4 * fq + e, ch = layer * 256 + g * 64 + j;
        const float r = sigm(ar[jn][e] + P.lru_ba[ch]), ig = sigm(ai[jn][e] + P.lru_bx[ch]);
        const float lam = P.lru_lam[ch];
        const float xe = __expf(-lam);
        float m8; asm volatile("v_mov_b32 %0, 0xc1000000" : "=v"(m8));
        const float la = m8 * r * (xe * (1.f - xe * (0.5f - xe * (1.f / 3.f))));
        const float av = __expf(la);
        const float y2 = 2.f * la;
        const float om = -y2 * (1.f + y2 * (0.5f + y2 * ((1.f / 6.f) + y2 * ((1.f / 24.f) + y2 * ((1.f / 120.f) + y2 * (1.f / 720.f))))));
        const float bv = sqrtf(om) * (ig * xcf[t * 64 + j]);
        aA[t * 64 + j] = av; bB[t * 64 + j] = bv;
      }
  }
  __syncthreads();
  {
    const int q = tid >> 6, j = tid & 63;
    float Pq = 1.f, hq = 0.f;
#pragma unroll
    for (int i = 0; i < 16; ++i) { const int t = q * 16 + i; const float av = aA[t * 64 + j], bv = bB[t * 64 + j]; hq = av * hq + bv; Pq *= av; aA[t * 64 + j] = Pq; bB[t * 64 + j] = hq; }
    sm[q * 64 + j] = Pq; sm[256 + q * 64 + j] = hq;
    __syncthreads();
    float Pin = 1.f, Hin = 0.f;
    for (int qq = 0; qq < q; ++qq) { const float pp = sm[qq * 64 + j], hh = sm[256 + qq * 64 + j]; Hin = pp * Hin + hh; Pin *= pp; }
    float hl = 0.f, pl = 1.f;
#pragma unroll
    for (int i = 0; i < 16; ++i) { const int t = q * 16 + i; hl = bB[t * 64 + j] + aA[t * 64 + j] * Hin; pl = aA[t * 64 + j] * Pin;
      const size_t o = (tokb + c * 64 + t) * 256 + g * 64 + j; hsl[o] = hl; Pc[o] = pl; }
    if (q == 3) { const int o = ((b * 4 + g) * 64 + c) * 64 + j; carryP[o] = pl; carryH[o] = hl; }
  }
  __syncthreads();
}

__device__ __forceinline__ void mixB2_item(int idx, const bf16_t* z, const float* hsl, const float* Pc, const float* carryP, const float* carryH, bf16_t* y) {
  const int c = idx & 63, g = (idx >> 6) & 3, b = idx >> 8;
  const int q = HTID >> 6, j = HTID & 63;
  const float* cp = carryP + (size_t)((b * 4 + g) * 64) * 64 + j;
  const float* chh = carryH + (size_t)((b * 4 + g) * 64) * 64 + j;
  float H = 0.f;
  for (int c0 = 0; c0 < c; c0 += 8) {
    float pv[8], hv[8];
#pragma unroll
    for (int i = 0; i < 8; ++i) { const bool ok = c0 + i < c; pv[i] = ok ? cp[(c0 + i) * 64] : 1.f; hv[i] = ok ? chh[(c0 + i) * 64] : 0.f; }
#pragma unroll
    for (int i = 0; i < 8; ++i) H = pv[i] * H + hv[i];
  }
  const size_t tokb = (size_t)b * SEQ + c * 64 + q * 16;
#pragma unroll 4
  for (int i = 0; i < 16; ++i) {
    const size_t o = (tokb + i) * 256 + g * 64 + j;
    const float h = hsl[o] + Pc[o] * H;
    const float gt = bf2f(z[(tokb + i) * LDZ + ZC_BG + g * 64 + j]);
    y[(tokb + i) * 1024 + 256 + g * 64 + j] = f2bf(h * gelu_t(gt));
  }
}

__device__ __forceinline__ void compress_item(const Params& P, int layer, int idx, const bf16_t* z, bf16_t* kcv, char* lds) {
  const int nb = idx & 15, g = (idx >> 4) & 1, b = (idx >> 5) & 7, kv = idx >> 8;
  const int tid = HTID, lane = tid & 63, w = tid >> 6, fr = lane & 15, fq = lane >> 4;
  const int n0 = nb * 16, col = (kv ? ZC_VC : ZC_KC) + g * 64;
  const bf16_t* w1t = (const bf16_t*)(P.ws + OFF_CW1 + (size_t)(layer * 2 + kv) * SZ_CW1);
  float* part = (float*)lds;
  float* hid = (float*)(lds + 34816);
  f32x4 acc[8];
#pragma unroll
  for (int jf = 0; jf < 8; ++jf) acc[jf] = zero4();
  int nn = n0 + fr; if (nn > 254) nn = 254;
  const bf16_t* zb = z + ((size_t)b * SEQ + 16 * nn) * LDZ + col + 8 * fq;
  const bf16_t* wb = w1t + (size_t)fr * 2048 + 8 * fq;
#pragma unroll 4
  for (int kk = 0; kk < 16; ++kk) {
    const int ks = 16 * w + kk, l = ks >> 1, d0 = (ks & 1) * 32;
    const bf16x8 xf = *(const bf16x8*)(zb + (size_t)l * LDZ + d0);
#pragma unroll
    for (int jf = 0; jf < 8; ++jf) { const bf16x8 wf = *(const bf16x8*)(wb + (size_t)jf * 16 * 2048 + ks * 32); acc[jf] = mfma16(wf, xf, acc[jf]); }
  }
#pragma unroll
  for (int jf = 0; jf < 8; ++jf)
#pragma unroll
    for (int e = 0; e < 4; ++e) part[(w * 16 + fr) * 132 + jf * 16 + 4 * fq + e] = acc[jf][e];
  __syncthreads();
  const float* cb1 = (const float*)(P.ws + OFF_CB1) + (layer * 2 + kv) * 128;
  {
    const int n = tid >> 4, j0 = (tid & 15) * 8;
#pragma unroll
    for (int e = 0; e < 8; ++e) { const int j = j0 + e; const float v = ((part[(0 * 16 + n) * 132 + j] + part[(1 * 16 + n) * 132 + j]) + part[(2 * 16 + n) * 132 + j]) + part[(3 * 16 + n) * 132 + j];
      hid[n * 129 + j] = gelu_t(v + cb1[j]); }
  }
  __syncthreads();
  {
    const int n = tid >> 4, d0 = (tid & 15) * 4;
    const float* w2 = P.cmp_w2 + (size_t)(layer * 2 + kv) * 128 * 64 + d0;
    const float4 bb = *(const float4*)(P.cmp_b2 + (layer * 2 + kv) * 64 + d0);
    float o0 = bb.x, o1 = bb.y, o2 = bb.z, o3 = bb.w;
#pragma unroll 8
    for (int j = 0; j < 128; ++j) { const float hv = hid[n * 129 + j]; const float4 wa = *(const float4*)(w2 + j * 64); o0 += hv * wa.x; o1 += hv * wa.y; o2 += hv * wa.z; o3 += hv * wa.w; }
    u32x2 ov; ov.x = pk2(o0, o1); ov.y = pk2(o2, o3);
    if ((n0 + n) >= 255) { ov.x = 0u; ov.y = 0u; }
    *(u32x2*)(kcv + ((size_t)((kv * 8 + b) * 2 + g) * 256 + n0 + n) * 64 + d0) = ov;
  }
  __syncthreads();
}

constexpr int NSA_KT = 0, NSA_VT = 16384, NSA_T = 33792, NSA_TW = NSA_T + 4 * 4160 * 4, NSA_IMP = NSA_TW + 4 * 640 * 4, NSA_WU = NSA_IMP + 2 * 16640;
constexpr int LDS_ST = 147456;
constexpr float LOG2E = 1.4426950408889634f;

__device__ __forceinline__ void nsa_tables(const Params& P, int g, char* lds) {
  float* T = (float*)(lds + NSA_T);
  float* TW = (float*)(lds + NSA_TW);
  const int tid = TIDX;
  for (int i = tid; i < 4160; i += 512) {
    const int n = i - 64;
    int bk = n;
    if (n >= 16) bk = 16 + (n >= 21) + (n >= 27) + (n >= 35) + (n >= 46) + (n >= 59) + (n >= 77) + (n >= 99) + (n >= 128) + (n >= 166) + (n >= 216) + (n >= 280) + (n >= 363) + (n >= 470) + (n >= 609) + (n >= 790);
#pragma unroll
    for (int r = 0; r < 4; ++r) {
      const float v = n >= 0 ? P.rel_bias[bk * 8 + g * 4 + r] * LOG2E : -__builtin_inff();
      T[r * 4160 + i] = v;
      if (i < 640) TW[r * 640 + i] = (n < 512) ? v : -__builtin_inff();
    }
  }
  __syncthreads();
}

struct KVRegs { u32x4 k0, v0; };
__device__ __forceinline__ void kv_gload(KVRegs& r, const bf16_t* kb, const bf16_t* vb, size_t stride) {
  const int tid = TIDX, row = tid >> 3, cq = tid & 7;
  r.k0 = *(const u32x4*)(kb + row * stride + cq * 8); r.v0 = *(const u32x4*)(vb + row * stride + cq * 8);
}
__device__ __forceinline__ void kv_lwrite(const KVRegs& r, char* lds, int buf) {
  const int tid = TIDX, row = tid >> 3, cq = tid & 7;
  char* kt = lds + NSA_KT + buf * 8192 + row * 128;
  *(u32x4*)(kt + ((cq ^ (row & 7)) << 4)) = r.k0;
  bf16_t* vt = (bf16_t*)(lds + NSA_VT + buf * 8704) + (cq * 8) * 68 + row;
#pragma unroll
  for (int i = 0; i < 4; ++i) { vt[(2 * i) * 68] = (bf16_t)(r.v0[i] & 0xffffu); vt[(2 * i + 1) * 68] = (bf16_t)(r.v0[i] >> 16); }
}

template <int MODE>
__device__ __forceinline__ void nsa_compute(int cur, int buf, int t, int hl, u64 mymask, const bf16x8 (&Qf)[2][2], f32x4 (&O)[4][2], float (&m)[2], float (&l)[2],
                                            const float (&inv)[2], float* impw, char* lds) {
  const int lane = TIDX & 63, fr = lane & 15, fq = lane >> 4;
  const char* kt = lds + NSA_KT + buf * 8192;
  const bf16_t* vt = (const bf16_t*)(lds + NSA_VT + buf * 8704);
  const bool selok = (MODE == 2) ? (((mymask >> cur) & 1ull) != 0ull) : true;
  const float* tb = (MODE == 3) ? (const float*)(lds + NSA_TW) + hl * 640 : (const float*)(lds + NSA_T) + hl * 4160;
  constexpr int TS = (MODE == 3) ? 640 : 4160;
  const int base = (MODE <= 1) ? (t - 31 - 16 * (cur * 64 + 4 * fq) + 64) : (t - cur * 64 - 4 * fq + 64);
#pragma unroll
  for (int s2 = 0; s2 < 2; ++s2) {
    f32x4 S[2][2] = {};
    bf16x8 kfr[2][2];
#pragma unroll
    for (int ks = 0; ks < 2; ++ks)
#pragma unroll
      for (int kk = 0; kk < 2; ++kk) kfr[ks][kk] = *(const bf16x8*)(kt + (32 * s2 + 16 * kk + fr) * 128 + (((ks * 4 + fq) ^ (fr & 7)) << 4));
    __builtin_amdgcn_s_setprio(1);
#pragma unroll
    for (int ks = 0; ks < 2; ++ks)
#pragma unroll
      for (int kk = 0; kk < 2; ++kk)
#pragma unroll
        for (int r = 0; r < 2; ++r) S[kk][r] = mfma16(kfr[ks][kk], Qf[r][ks], S[kk][r]);
    __builtin_amdgcn_s_setprio(0);
    bf16x8 Pf[2];
    float g1s[2] = {0.f, 0.f}, p3s[2] = {0.f, 0.f};
#pragma unroll
    for (int r = 0; r < 2; ++r) {
      float sv[2][4];
#pragma unroll
      for (int kk = 0; kk < 2; ++kk)
#pragma unroll
        for (int e = 0; e < 4; ++e) {
          const int off = 32 * s2 + 16 * kk + e;
          int idx;
          if (MODE <= 1) { idx = base - 16 * off; idx = idx > 0 ? idx : 0; } else idx = base - off;
          sv[kk][e] = S[kk][r][e] * (0.125f * LOG2E) + tb[r * TS + idx];
        }
      float pv[2][4];
      if (MODE == 1) {
#pragma unroll
        for (int kk = 0; kk < 2; ++kk)
#pragma unroll
          for (int e = 0; e < 4; ++e) pv[kk][e] = __builtin_amdgcn_exp2f(sv[kk][e] - m[r]) * inv[r];
#pragma unroll
        for (int kk = 0; kk < 2; ++kk) { g1s[kk] += pv[kk][0] + pv[kk][1] + pv[kk][2] + 0.5f * pv[kk][3]; p3s[kk] += 0.5f * pv[kk][3]; }
      } else {
        float mx = fmaxf(fmaxf(fmaxf(sv[0][0], sv[0][1]), fmaxf(sv[0][2], sv[0][3])), fmaxf(fmaxf(sv[1][0], sv[1][1]), fmaxf(sv[1][2], sv[1][3])));
        if (MODE == 2) mx = selok ? mx : -__builtin_inff();
        if (__any(mx > m[r] + 8.0f)) {
          mx = fmaxf(mx, __shfl_xor(mx, 16)); mx = fmaxf(mx, __shfl_xor(mx, 32));
          const float mn = fmaxf(m[r], mx), al = __builtin_amdgcn_exp2f(m[r] - mn);
          m[r] = mn; l[r] *= al;
          if (MODE != 0) {
#pragma unroll
            for (int df = 0; df < 4; ++df) O[df][r] *= al;
          }
        }
        const float me = (MODE == 2) ? (selok ? m[r] : __builtin_inff()) : m[r];
        float ps = 0.f;
#pragma unroll
        for (int kk = 0; kk < 2; ++kk)
#pragma unroll
          for (int e = 0; e < 4; ++e) { pv[kk][e] = __builtin_amdgcn_exp2f(sv[kk][e] - me); ps += pv[kk][e]; }
        l[r] += ps;
      }
      if (MODE != 0) {
        const unsigned w0 = pk2(pv[0][0], pv[0][1]), w1 = pk2(pv[0][2], pv[0][3]), w2 = pk2(pv[1][0], pv[1][1]), w3 = pk2(pv[1][2], pv[1][3]);
        u32x4 pw; pw.x = w0; pw.y = w1; pw.z = w2; pw.w = w3;
        Pf[r] = __builtin_bit_cast(bf16x8, pw);
      }
    }
    if (MODE != 0) {
      bf16x8 vfr[4];
#pragma unroll
      for (int df = 0; df < 4; ++df) {
        const bf16x4 va = *(const bf16x4*)(vt + (df * 16 + fr) * 68 + 32 * s2 + 4 * fq);
        const bf16x4 vb = *(const bf16x4*)(vt + (df * 16 + fr) * 68 + 32 * s2 + 16 + 4 * fq);
        bf16x8 vf; vf[0] = va[0]; vf[1] = va[1]; vf[2] = va[2]; vf[3] = va[3]; vf[4] = vb[0]; vf[5] = vb[1]; vf[6] = vb[2]; vf[7] = vb[3];
        vfr[df] = vf;
      }
      __builtin_amdgcn_s_setprio(1);
#pragma unroll
      for (int df = 0; df < 4; ++df)
#pragma unroll
        for (int r = 0; r < 2; ++r) O[df][r] = mfma16(vfr[df], Pf[r], O[df][r]);
      __builtin_amdgcn_s_setprio(0);
    }
    if (MODE == 1) {
#pragma unroll
      for (int kk = 0; kk < 2; ++kk) {
        const int j = cur * 16 + (2 * s2 + kk) * 4 + fq;
        atomicAdd(&impw[fr * 65 + j], g1s[kk]);
        if (j + 1 < 64) atomicAdd(&impw[fr * 65 + j + 1], p3s[kk]);
      }
    }
  }
}

template <int MODE>
__device__ __forceinline__ void nsa_branch(int first, int ntl, u64 U, const bf16_t* kbase, const bf16_t* vbase, size_t stride, int t, int hl, u64 mymask,
                                           const bf16x8 (&Qf)[2][2], f32x4 (&O)[4][2], float (&m)[2], float (&l)[2], const float (&inv)[2], float* impw, char* lds) {
  KVRegs R0, R1, R2;
  u64 rem = U;
  int seq = first, left = ntl;
#define NSA_NEXT(dst)                                                                                     \
  { if (MODE == 2) { dst = rem ? (int)__builtin_ctzll(rem) : -1; if (rem) rem &= rem - 1; }              \
    else { dst = left > 0 ? seq : -1; ++seq; --left; } }
#define NSA_GLOAD(R, ti) kv_gload(R, kbase + (size_t)(ti) * 64 * stride, vbase + (size_t)(ti) * 64 * stride, stride)
  int tcur, t1, t2, t3;
  NSA_NEXT(tcur); NSA_NEXT(t1); NSA_NEXT(t2);
  if (tcur >= 0) NSA_GLOAD(R0, tcur);
  if (t1 >= 0) NSA_GLOAD(R1, t1);
  if (t2 >= 0) NSA_GLOAD(R2, t2);
  if (tcur >= 0) kv_lwrite(R0, lds, 0);
  __syncthreads();
  NSA_NEXT(t3);
  if (t3 >= 0) NSA_GLOAD(R0, t3);
  int buf = 0;
#define NSA_STEP(RW)                                                                                      \
  if (tcur < 0) break;                                                                                    \
  nsa_compute<MODE>(tcur, buf, t, hl, mymask, Qf, O, m, l, inv, impw, lds);                               \
  if (t1 >= 0) kv_lwrite(RW, lds, buf ^ 1);                                                               \
  __syncthreads();                                                                                        \
  buf ^= 1; tcur = t1; t1 = t2; t2 = t3;                                                                  \
  NSA_NEXT(t3);                                                                                           \
  if (t3 >= 0) NSA_GLOAD(RW, t3);
  for (;;) {
    NSA_STEP(R1)
    NSA_STEP(R2)
    NSA_STEP(R0)
  }
#undef NSA_STEP
#undef NSA_GLOAD
#undef NSA_NEXT
}

#define NSA_RESET()                                                                         \
  _Pragma("unroll") for (int r = 0; r < 2; ++r) { asm volatile("v_mov_b32 %0, 0xf149f2ca" : "=v"(m[r])); l[r] = 0.f; }               \
  _Pragma("unroll") for (int df = 0; df < 4; ++df) _Pragma("unroll") for (int r = 0; r < 2; ++r) O[df][r] = zero4();

__device__ __forceinline__ void nsa_item(const Params& P, int b, int g, int c, const bf16_t* z, const bf16_t* kcv, bf16_t* y, char* lds) {
  const int tid = TIDX, lane = tid & 63, w8 = tid >> 6, qg = w8 & 3, hp = w8 >> 2, fr = lane & 15, fq = lane >> 4;
  const size_t tokb = (size_t)b * SEQ;
  const int t = c * 64 + 16 * qg + fr;
  const bf16_t* zq = z + (tokb + t) * LDZ;
  const int hb = g * 4 + hp * 2;
  bf16x8 Qf[2][2];
#pragma unroll
  for (int r = 0; r < 2; ++r)
#pragma unroll
    for (int ks = 0; ks < 2; ++ks) Qf[r][ks] = *(const bf16x8*)(zq + ZC_Q + g * 256 + (hp * 2 + r) * 64 + ks * 32 + 8 * fq);
  float* impw = (float*)(lds + NSA_IMP) + (hp * 4 + qg) * (16 * 65);
  for (int i = lane; i < 16 * 65; i += 64) impw[i] = 0.f;
  f32x4 O[4][2];
  float m[2], l[2], inv[2];
  bf16_t* yo = y + (tokb + t) * 1024 + 512 + g * 256 + hp * 128 + 4 * fq;
  const bf16_t* kc = kcv + (size_t)((0 * 8 + b) * 2 + g) * 256 * 64;
  const bf16_t* vc = kcv + (size_t)((1 * 8 + b) * 2 + g) * 256 * 64;
  const int nct = ((4 * c + 2) >> 6) + 1;
  NSA_RESET();
  inv[0] = 0.f; inv[1] = 0.f;
  nsa_branch<0>(0, nct, 0ull, kc, vc, 64, t, hp * 2, 0ull, Qf, O, m, l, inv, impw, lds);
#pragma unroll
  for (int r = 0; r < 2; ++r) { float lt = l[r]; lt += __shfl_xor(lt, 16); lt += __shfl_xor(lt, 32); inv[r] = lt > 0.f ? 1.f / lt : 0.f; }
  nsa_branch<1>(0, nct, 0ull, kc, vc, 64, t, hp * 2, 0ull, Qf, O, m, l, inv, impw, lds);
#pragma unroll
  for (int r = 0; r < 2; ++r) {
    const float gt = sigm(bf2f(zq[ZC_GC + hb + r]));
#pragma unroll
    for (int df = 0; df < 4; ++df) { u32x2 o; o.x = pk2(O[df][r][0] * gt, O[df][r][1] * gt); o.y = pk2(O[df][r][2] * gt, O[df][r][3] * gt); *(u32x2*)(yo + r * 64 + df * 16) = o; }
  }
  __syncthreads();
  u64 wU = 0ull;
  {
    const float* imp0 = (const float*)(lds + NSA_IMP) + qg * (16 * 65);
    const float* imp1 = imp0 + 4 * (16 * 65);
    u64* MK = (u64*)(lds + NSA_WU) + 8;
    const u64 V = (c >= 63) ? ~0ull : ((1ull << (c + 1)) - 1ull);
    const bool forced = (lane == 0) | (lane == c) | (lane == c - 1);
    for (int q8 = 0; q8 < 8; ++q8) {
      const int qq = hp * 8 + q8;
      const float sv = imp0[qq * 65 + lane] + imp1[qq * 65 + lane];
      const unsigned u = __float_as_uint(forced ? 1e4f : sv);
      u64 mk = V;
      if (c + 1 > 16) {
        unsigned thr = 0u;
        for (int bb = 30; bb >= 0; --bb) { const unsigned cand = thr | (1u << bb); const u64 ge = __ballot(u >= cand) & V; if (__popcll(ge) >= 16) thr = cand; }
        const u64 G = __ballot(u > thr) & V, E = __ballot(u == thr) & V;
        const int need = 16 - (int)__popcll(G);
        const int below = (int)__popcll(E & ((1ull << lane) - 1ull));
        const bool se = (((E >> lane) & 1ull) != 0ull) && (below < need);
        mk = G | __ballot(se);
      }
      if (lane == 0) MK[qg * 16 + qq] = mk;
      wU |= mk;
    }
  }
  u64* WU = (u64*)(lds + NSA_WU);
  if (lane == 0) WU[w8] = wU;
  __syncthreads();
  const u64 U = WU[0] | WU[1] | WU[2] | WU[3] | WU[4] | WU[5] | WU[6] | WU[7];
  const u64 mymask = ((const u64*)(lds + NSA_WU) + 8)[qg * 16 + fr];
  for (int br = 0; br < 2; ++br) {
    NSA_RESET();
    int zg;
    if (br == 0) {
      nsa_branch<2>(0, 0, U, z + tokb * LDZ + ZC_KS + g * 64, z + tokb * LDZ + ZC_VS + g * 64, LDZ, t, hp * 2, mymask, Qf, O, m, l, inv, impw, lds);
      zg = ZC_GS;
    } else {
      const int kt0 = c > 8 ? c - 8 : 0;
      nsa_branch<3>(kt0, c - kt0 + 1, 0ull, z + tokb * LDZ + ZC_KW + g * 64, z + tokb * LDZ + ZC_VW + g * 64, LDZ, t, hp * 2, 0ull, Qf, O, m, l, inv, impw, lds);
      zg = ZC_GW;
    }
#pragma unroll
    for (int r = 0; r < 2; ++r) {
      float lt = l[r]; lt += __shfl_xor(lt, 16); lt += __shfl_xor(lt, 32);
      const float gt = sigm(bf2f(zq[zg + hb + r])) * (lt > 0.f ? 1.f / lt : 0.f);
#pragma unroll
      for (int df = 0; df < 4; ++df) {
        bf16_t* yp = yo + r * 64 + df * 16;
        const u32x2 pr = *(const u32x2*)yp;
        u32x2 o; o.x = pk2(__uint_as_float(pr.x << 16) + O[df][r][0] * gt, __uint_as_float(pr.x & 0xffff0000u) + O[df][r][1] * gt);
        o.y = pk2(__uint_as_float(pr.y << 16) + O[df][r][2] * gt, __uint_as_float(pr.y & 0xffff0000u) + O[df][r][3] * gt);
        *(u32x2*)yp = o;
      }
    }
  }
  __syncthreads();
}

__device__ __forceinline__ void run_phase(const Params& P, int ph, char* lds) {
  char* ws = P.ws;
  asm volatile("" : "+s"(ws));
  bf16_t* abuf = (bf16_t*)(ws + OFF_A);
  bf16_t* big = (bf16_t*)(ws + OFF_BIG);
  bf16_t* fbuf = (bf16_t*)(ws + OFF_F);
  bf16_t* h16 = (bf16_t*)(ws + OFF_F + (size_t)M_TOK * 1024 * 2);
  float* hsl = (float*)(ws + OFF_F); float* Pc = hsl + (size_t)M_TOK * 256;
  bf16_t* kcv = (bf16_t*)(ws + OFF_KC);
  float* carryP = (float*)(ws + OFF_CARRY); float* carryH = carryP + 8 * 4 * 64 * 64;
  if (ph == 0) { prep_phase(P, lds); return; }
  const int layer = (ph - 1) / 13, sp = (ph - 1) % 13;
  const float* ng = P.norm_g + (size_t)layer * 8 * 1024;
#ifdef ONLY_SP
  if (sp != ONLY_SP) return;
#endif
  switch (sp) {
    case 0: case 8: {
      const int lj = layer * 2 + (sp == 8);
      gemm_up_phase(abuf, (const bf16_t*)(ws + OFF_WGU + lj * SZ_WGU), big, lds);
    } break;
    case 1: case 9: {
      const int lj = layer * 2 + (sp == 9);
      gemm_bf16_phase(big, DFF, (const bf16_t*)(ws + OFF_WD + lj * SZ_WD), DFF, 4, fbuf, 1024, lds);
    } break;
    case 2: resnorm_phase(layer == 0 ? P.x : nullptr, h16, nullptr, h16, fbuf, 0.5f, ng + 1 * 1024, ng + 2 * 1024, abuf); break;
    case 3:
      if (layer == 0 && blockIdx.x < 4) {
        const int t3 = TIDX;
        if (t3 < 128) { const float* pp_ = (const float*)(ws + OFF_CB1P) + (size_t)blockIdx.x * 16 * 128 + t3; float t = P.cmp_b1[blockIdx.x * 128 + t3];
          for (int q = 0; q < 16; ++q) t += pp_[q * 128]; ((float*)(ws + OFF_CB1))[blockIdx.x * 128 + t3] = t; }
      }
      gemm_bf16_phase(abuf, 1024, (const bf16_t*)(ws + OFF_WIN + layer * SZ_WIN), 1024, LDZ / 256, big, LDZ, lds); break;
    case 4: {
      const int hb = HBLK; char* hl = lds + hb * 65536;
      for (int it = blockIdx.x * 2 + hb; it < 512; it += gridDim.x * 2) compress_item(P, layer, it, big, kcv, hl);
      for (int it = blockIdx.x * 2 + hb; it < 1024; it += gridDim.x * 2) mixA_item(P, layer, it, big, abuf, hl);
      for (int it = blockIdx.x * 2 + hb; it < 2048; it += gridDim.x * 2) mixB1_item(P, layer, it, big, hsl, Pc, carryP, carryH, hl);
    } break;
    case 5: {
      nsa_tables(P, blockIdx.x & 1, lds);
      for (int it = blockIdx.x; it < 1024; it += gridDim.x) {
        const int rnd = it / 256, pos = it % 256;
        const int c = (rnd & 1) ? (rnd >> 1) * 16 + (pos >> 4) : 63 - (rnd >> 1) * 16 - (pos >> 4);
        const int bg = pos & 15;
        nsa_item(P, bg >> 1, bg & 1, c, big, kcv, abuf, lds);
      }
      const int hb = HBLK;
      for (int it = blockIdx.x * 2 + hb; it < 2048; it += gridDim.x * 2) mixB2_item(it, big, hsl, Pc, carryP, carryH, abuf);
    } break;
    case 6: gemm_bf16_phase(abuf, 1024, (const bf16_t*)(ws + OFF_WOUT + layer * SZ_SQ), 1024, 4, fbuf, 1024, lds); break;
    case 7: resnorm_phase(nullptr, h16, nullptr, h16, fbuf, 1.0f, ng + 3 * 1024, ng + 4 * 1024, abuf); break;
    case 10:
      gemm_bf16_phase((const bf16_t*)(ws + OFF_PBF) + (size_t)layer * M_TOK * 256, 256, (const bf16_t*)(ws + OFF_WPP + layer * SZ_WPP), 256, 4, big, 1024, lds);
      resnorm_phase(nullptr, h16, nullptr, h16, fbuf, 0.5f, ng + 5 * 1024, ng + 6 * 1024, abuf);
      break;
    case 11: gemm_ple_phase(abuf, (const bf16_t*)(ws + OFF_WPG + layer * SZ_SQ), big, fbuf, lds); break;
    case 12: resnorm_phase(nullptr, h16, layer == 0 ? nullptr : P.out, layer == 0 ? h16 : nullptr, fbuf, 1.0f, ng + 7 * 1024, layer == 0 ? P.norm_g + 8 * 1024 : nullptr, layer == 0 ? abuf : nullptr); break;
  }
}

#define XB_TMO      128
#define XB_XCNT(j)  (256  + 64 * (j))
#define XB_XSUB(j)  (1280 + 64 * (j))
#define XB_XGEN(j)  (2304 + 64 * (j))
#define XB_TOP      3328
#define XB_TOPGEN   3392
#define XCD_BAR_WORDS 3456
#define XB_SPIN_CAP (1u << 20)
#define LAS __attribute__((address_space(3)))
__device__ __forceinline__ unsigned xb_ld(unsigned* p)              { return __hip_atomic_load(p, __ATOMIC_RELAXED, __HIP_MEMORY_SCOPE_AGENT); }
__device__ __forceinline__ unsigned xb_add(unsigned* p, unsigned v) { return __hip_atomic_fetch_add(p, v, __ATOMIC_RELAXED, __HIP_MEMORY_SCOPE_AGENT); }
__device__ __forceinline__ unsigned xb_xcc_id() { return (unsigned)__builtin_amdgcn_s_getreg((3 << 11) | 20) & 0xFu; }
#define XB_SPIN(cond, bar) do { unsigned _sp = 0; while (cond) { __builtin_amdgcn_s_sleep(1); \
    if ((++_sp & 255u) == 0u) { if (xb_ld(&(bar)[XB_TMO])) break; if (_sp > XB_SPIN_CAP) { atomicAdd(&(bar)[XB_TMO], 1u); break; } } } } while (0)
struct XcdBarrier { unsigned* bar; unsigned x; volatile LAS unsigned* st; };
__device__ __forceinline__ XcdBarrier xcd_barrier_post(unsigned* bar, volatile LAS unsigned* st) {
    XcdBarrier b; b.bar = bar; b.x = xb_xcc_id(); b.st = st;
    if (threadIdx.x == 0) (void)xb_add(&bar[XB_XCNT(b.x)], 1u);
    return b;
}
__device__ __forceinline__ void xcd_barrier_complete(unsigned* bar, unsigned x, unsigned& nloc, unsigned& nx) {
    const unsigned G = gridDim.x * gridDim.y * gridDim.z;
    unsigned sum, cnt, mine, sp = 0u;
    for (;;) {
        sum = 0u; cnt = 0u; mine = 0u;
#pragma unroll
        for (unsigned j = 0; j < 16; ++j) { const unsigned c = xb_ld(&bar[XB_XCNT(j)]); sum += c; cnt += (c > 0u) ? 1u : 0u; mine = (j == x) ? c : mine; }
        if (sum == G) break;
        __builtin_amdgcn_s_sleep(1);
        if ((++sp & 255u) == 0u) { if (xb_ld(&bar[XB_TMO])) break; if (sp > XB_SPIN_CAP) { atomicAdd(&bar[XB_TMO], 1u); break; } }
    }
    nloc = mine > 0u ? mine : 1u; nx = cnt > 0u ? cnt : 1u;
}
__device__ __forceinline__ void xcd_barrier(const XcdBarrier& b) {
    asm volatile("s_waitcnt vmcnt(0)" ::: "memory");
    __syncthreads();
    if (threadIdx.x == 0) {
        unsigned* bar = b.bar;
        __builtin_amdgcn_s_waitcnt(0);
        unsigned nloc = b.st[0], nx = b.st[1];
        if (nloc == 0u) { xcd_barrier_complete(bar, b.x, nloc, nx); b.st[0] = nloc; b.st[1] = nx; }
        const unsigned old = xb_add(&bar[XB_XSUB(b.x)], 1u);
        const unsigned gen = old / nloc;
        if (old + 1u == (gen + 1u) * nloc) {
            __builtin_amdgcn_fence(__ATOMIC_RELEASE, "agent");
            asm volatile("s_waitcnt vmcnt(0)" ::: "memory");
            const unsigned og = xb_add(&bar[XB_TOP], 1u);
            const unsigned tg = og / nx;
            if (og + 1u == (tg + 1u) * nx) xb_add(&bar[XB_TOPGEN], 1u);
            else XB_SPIN(xb_ld(&bar[XB_TOPGEN]) == tg, bar);
            __builtin_amdgcn_fence(__ATOMIC_ACQUIRE, "agent");
            xb_add(&bar[XB_XGEN(b.x)], 1u);
            asm volatile("s_waitcnt vmcnt(0)" ::: "memory");
        } else {
            XB_SPIN(xb_ld(&bar[XB_XGEN(b.x)]) == gen, bar);
            __builtin_amdgcn_fence(__ATOMIC_ACQUIRE, "agent");
            asm volatile("s_waitcnt vmcnt(0)" ::: "memory");
        }
    }
    __syncthreads();
}

constexpr int LDS_BYTES = LDS_ST + 16;
__global__ void __launch_bounds__(512, 2) fwd_megakernel(Params P) {
  __shared__ __attribute__((aligned(16))) char lds[LDS_BYTES];
  cg::grid_group grid = cg::this_grid();
  volatile LAS unsigned* st = (volatile LAS unsigned*)(lds + LDS_ST);
  if (threadIdx.x == 0) { st[0] = 0u; st[1] = 0u; }
  __syncthreads();
  XcdBarrier xb = xcd_barrier_post((unsigned*)(P.ws + OFF_BAR), st);
  if (P.ws == nullptr) grid.sync();
  for (int ph = 0; ph < NPHASE; ++ph) {
    run_phase(P, ph, lds);
    if (ph + 1 < NPHASE) xcd_barrier(xb);
  }
}

__global__ void __launch_bounds__(512, 2) phase_kernel(Params P, int ph) {
  __shared__ __attribute__((aligned(16))) char lds[LDS_BYTES];
  run_phase(P, ph, lds);
}

extern "C" void kernel_launch(void* const* d_in, const int* in_sizes, int n_in, void* d_out, int out_size, void* d_ws, size_t ws_size, hipStream_t stream) {
  Params P{};
  const float** pp = (const float**)&P;
  for (int i = 0; i < 26; ++i) pp[i] = (const float*)d_in[i];
  P.out = (float*)d_out;
  P.ws = (char*)d_ws;
  if (ws_size < WS_NEED) { fprintf(stderr, "workspace too small: %zu < %zu\n", ws_size, (size_t)WS_NEED); return; }
#if MK_FUSED
  static int grid_blocks = 0;
  if (!grid_blocks) {
    int dev = 0, cus = 0, per_cu = 0;
    (void)hipGetDevice(&dev);
    (void)hipDeviceGetAttribute(&cus, hipDeviceAttributeMultiprocessorCount, dev);
    (void)hipOccupancyMaxActiveBlocksPerMultiprocessor(&per_cu, fwd_megakernel, 512, 0);
    if (per_cu > 1) per_cu = 1;
    if (per_cu < 1) per_cu = 1;
    grid_blocks = cus * per_cu;
  }
  (void)hipMemsetAsync((char*)d_ws + OFF_BAR, 0, XCD_BAR_WORDS * 4, stream);
  void* args[] = {&P};
  hipError_t e = hipLaunchCooperativeKernel((void*)fwd_megakernel, dim3(grid_blocks), dim3(512), args, 0, stream);
  if (e != hipSuccess) fprintf(stderr, "cooperative launch failed: %s (grid %d)\n", hipGetErrorString(e), grid_blocks);
#else
  for (int ph = 0; ph < NPHASE; ++ph) phase_kernel<<<256, 512, 0, stream>>>(P, ph);
#endif
}
```

```cpp
#include <hip/hip_runtime.h>
#include <hip/hip_cooperative_groups.h>
#include <cstdint>
#include <cstdio>
namespace cg = cooperative_groups;

#ifndef MK_FUSED
#define MK_FUSED 1
#endif

typedef unsigned short bf16_t;
typedef short bf16x8 __attribute__((ext_vector_type(8)));
typedef short bf16x4 __attribute__((ext_vector_type(4)));
typedef float f32x4 __attribute__((ext_vector_type(4)));
typedef unsigned long long u64;
typedef unsigned u32x4 __attribute__((ext_vector_type(4)));
typedef unsigned u32x2 __attribute__((ext_vector_type(2)));

constexpr int M_TOK = 32768, DM = 1024, DFF = 2816, NGU = 5632, NIN = 2328, LDZ = 2560, SEQ = 4096;
constexpr int NPHASE = 27;
constexpr int ZC_AU = 0, ZC_AV = 256, ZC_BX = 512, ZC_BG = 768, ZC_Q = 1024, ZC_KC = 1536, ZC_VC = 1664, ZC_KS = 1792, ZC_VS = 1920,
              ZC_KW = 2048, ZC_VW = 2176, ZC_GC = 2304, ZC_GS = 2312, ZC_GW = 2320;

constexpr size_t SZ_WGU = (size_t)NGU * 1024 * 2, SZ_WD = (size_t)1024 * DFF * 2, SZ_WIN = (size_t)LDZ * 1024 * 2, SZ_SQ = (size_t)1024 * 1024 * 2,
                 SZ_WPP = (size_t)1024 * 256 * 2, SZ_CW1 = (size_t)128 * 2048 * 2;
constexpr size_t OFF_WGU = 0;
constexpr size_t OFF_WD = OFF_WGU + 4 * SZ_WGU;
constexpr size_t OFF_WIN = OFF_WD + 4 * SZ_WD;
constexpr size_t OFF_WOUT = OFF_WIN + 2 * SZ_WIN;
constexpr size_t OFF_WPG = OFF_WOUT + 2 * SZ_SQ;
constexpr size_t OFF_WPP = OFF_WPG + 2 * SZ_SQ;
constexpr size_t OFF_CW1 = OFF_WPP + 2 * SZ_WPP;
constexpr size_t OFF_CB1 = OFF_CW1 + 4 * SZ_CW1;
constexpr size_t OFF_SGUW = OFF_CB1 + 4096;
constexpr size_t OFF_WAT = OFF_SGUW + 2 * 4 * 128 * 128 * 2;
constexpr size_t OFF_WXT = OFF_WAT + 2 * 4 * 64 * 64 * 2;
constexpr size_t OFF_PBF = OFF_WXT + 2 * 4 * 64 * 64 * 2;
constexpr size_t OFF_A = OFF_PBF + (size_t)2 * M_TOK * 256 * 2;
constexpr size_t OFF_BIG = OFF_A + (size_t)M_TOK * 1024 * 2;
constexpr size_t OFF_F = OFF_BIG + (size_t)M_TOK * DFF * 2;
constexpr size_t OFF_KC = OFF_F + (size_t)M_TOK * 1024 * 4;
constexpr size_t OFF_CARRY = OFF_KC + (size_t)2 * 8 * 2 * 256 * 64 * 2;
constexpr size_t OFF_BAR = OFF_CARRY + (size_t)2 * 8 * 4 * 64 * 64 * 4;
constexpr size_t OFF_CB1P = OFF_BAR + 16384;
constexpr size_t WS_NEED = OFF_CB1P + 32768;

struct Params {
  const float *x, *p, *rel_bias, *norm_g, *ffn_wg, *ffn_wu, *ffn_wd, *w_in, *w_out, *sgu_ng, *sgu_w, *sgu_b, *conv_w, *conv_b,
      *lru_wa, *lru_ba, *lru_wx, *lru_bx, *lru_lam, *cmp_pos, *cmp_w1, *cmp_b1, *cmp_w2, *cmp_b2, *ple_wg, *ple_wp;
  float* out;
  char* ws;
};

__device__ __forceinline__ int opaque_tid() { int t; asm volatile("v_mov_b32 %0, %1" : "=v"(t) : "v"(threadIdx.x)); return t; }
#define TIDX opaque_tid()
#define HTID (opaque_tid() & 255)
#define HBLK (opaque_tid() >> 8)
__device__ __forceinline__ float bf2f(bf16_t v) { return __uint_as_float(((unsigned)v) << 16); }
__device__ __forceinline__ bf16_t f2bf(float f) { unsigned u = __float_as_uint(f); u += 0x7fffu + ((u >> 16) & 1u); return (bf16_t)(u >> 16); }
typedef float f32x2v __attribute__((ext_vector_type(2)));
typedef __bf16 bf16x2v __attribute__((ext_vector_type(2)));
__device__ __forceinline__ unsigned pk2(float lo, float hi) { const f32x2v v = {lo, hi}; const bf16x2v r = __builtin_convertvector(v, bf16x2v); return __builtin_bit_cast(unsigned, r); }
__device__ __forceinline__ float sigm(float x) { return __builtin_amdgcn_rcpf(1.f + __expf(-x)); }
__device__ __forceinline__ float gelu_t(float x) { float u = 0.7978845608028654f * (x + 0.044715f * x * x * x); return x * __builtin_amdgcn_rcpf(1.f + __expf(-2.f * u)); }
__device__ __forceinline__ float silu_f(float x) { return x * __builtin_amdgcn_rcpf(1.f + __expf(-x)); }
__device__ __forceinline__ f32x4 mfma16(bf16x8 a, bf16x8 b, f32x4 c) { return __builtin_amdgcn_mfma_f32_16x16x32_bf16(a, b, c, 0, 0, 0); }
__device__ __forceinline__ void glds16(const void* g, void* l) {
  __builtin_amdgcn_global_load_lds((const __attribute__((address_space(1))) unsigned*)g, (__attribute__((address_space(3))) unsigned*)l, 16, 0, 0);
}
__device__ __forceinline__ f32x4 zero4() { f32x4 z; asm volatile("v_mov_b32 %0, 0\n\tv_mov_b32 %1, 0\n\tv_mov_b32 %2, 0\n\tv_mov_b32 %3, 0" : "=v"(z[0]), "=v"(z[1]), "=v"(z[2]), "=v"(z[3])); return z; }
__device__ __forceinline__ float wave_sum(float v) {
#pragma unroll
  for (int o = 32; o > 0; o >>= 1) v += __shfl_xor(v, o);
  return v;
}
__device__ __forceinline__ void unpack8(const u32x4 u, float* f) {
  f[0] = __uint_as_float(u.x << 16); f[1] = __uint_as_float(u.x & 0xffff0000u);
  f[2] = __uint_as_float(u.y << 16); f[3] = __uint_as_float(u.y & 0xffff0000u);
  f[4] = __uint_as_float(u.z << 16); f[5] = __uint_as_float(u.z & 0xffff0000u);
  f[6] = __uint_as_float(u.w << 16); f[7] = __uint_as_float(u.w & 0xffff0000u);
}

__device__ __forceinline__ void tr_cvt(const float* __restrict__ src, int N, int K, bf16_t* __restrict__ dst, int ldd, int rs, int ro, char* ldsc, int& rot) {
  const int ntn = (N + 63) >> 6, nt = ntn * (K >> 6), hb = HBLK, tid = HTID;
  float* lds = (float*)(ldsc + hb * 65536);
  int vb = (int)blockIdx.x - rot; if (vb < 0) vb += gridDim.x;
  rot = (rot + (nt + 5) / 6) % (int)gridDim.x;
  for (int t0 = vb * 6; t0 < nt; t0 += gridDim.x * 6) {
    float4 v[3][4];
#pragma unroll
    for (int u = 0; u < 3; ++u) {
      const int tile = t0 + hb * 3 + u, tk = tile / ntn, tn = tile - tk * ntn, k0 = tk * 64, n0 = tn * 64;
      const bool active = tile < nt;
#pragma unroll
      for (int ps = 0; ps < 4; ++ps) {
        const int i = ps * 16 + (tid >> 4), j = (tid & 15) * 4;
        v[u][ps] = make_float4(0.f, 0.f, 0.f, 0.f);
        if (active && n0 + j < N) v[u][ps] = *(const float4*)(src + (size_t)(k0 + i) * N + n0 + j);
      }
    }
#pragma unroll
    for (int u = 0; u < 3; ++u)
#pragma unroll
      for (int ps = 0; ps < 4; ++ps) {
        const int i = ps * 16 + (tid >> 4), j = (tid & 15) * 4;
        float* d = lds + u * 4160 + i * 65 + j; d[0] = v[u][ps].x; d[1] = v[u][ps].y; d[2] = v[u][ps].z; d[3] = v[u][ps].w;
      }
    __syncthreads();
#pragma unroll
    for (int u = 0; u < 3; ++u) {
      const int tile = t0 + hb * 3 + u, tk = tile / ntn, tn = tile - tk * ntn, k0 = tk * 64, n0 = tn * 64;
      const int j = tid >> 2, kq = tid & 3, n = n0 + j;
      if (tile < nt && n < N) {
        const float* l = lds + u * 4160;
        unsigned w[8];
#pragma unroll
        for (int q = 0; q < 8; ++q) w[q] = pk2(l[(kq * 16 + 2 * q) * 65 + j], l[(kq * 16 + 2 * q + 1) * 65 + j]);
        bf16_t* o = dst + (size_t)((n >> 4) * rs + (n & 15) + ro) * ldd + k0 + kq * 16;
        u32x4 w0, w1; w0.x = w[0]; w0.y = w[1]; w0.z = w[2]; w0.w = w[3]; w1.x = w[4]; w1.y = w[5]; w1.z = w[6]; w1.w = w[7];
        *(u32x4*)o = w0; *(u32x4*)(o + 8) = w1;
      }
    }
    __syncthreads();
  }
}

struct RowRegs { float4 h[4]; u32x2 f[4]; };
__device__ __forceinline__ void rn_load(RowRegs& R, const float* hin32, const bf16_t* hin16, const bf16_t* f, int row, int lane) {
  if (hin32) {
#pragma unroll
    for (int i = 0; i < 4; ++i) R.h[i] = *(const float4*)(hin32 + (size_t)row * 1024 + i * 256 + lane * 4);
  } else {
#pragma unroll
    for (int i = 0; i < 4; ++i) { const u32x2 v = *(const u32x2*)(hin16 + (size_t)row * 1024 + i * 256 + lane * 4);
      R.h[i].x = __uint_as_float(v.x << 16); R.h[i].y = __uint_as_float(v.x & 0xffff0000u); R.h[i].z = __uint_as_float(v.y << 16); R.h[i].w = __uint_as_float(v.y & 0xffff0000u); }
  }
  if (f) {
#pragma unroll
    for (int i = 0; i < 4; ++i) R.f[i] = *(const u32x2*)(f + (size_t)row * 1024 + i * 256 + lane * 4);
  }
}
__device__ __forceinline__ void rn_proc(RowRegs& R, float* hout32, bf16_t* hout16, bool has_f, float scale, const float4 (&gpo)[4], const float4 (&gpr)[4], bf16_t* a, int row, int lane) {
  if (has_f) {
    float fv[4][4]; float ss = 0.f;
#pragma unroll
    for (int i = 0; i < 4; ++i) {
      fv[i][0] = __uint_as_float(R.f[i].x << 16); fv[i][1] = __uint_as_float(R.f[i].x & 0xffff0000u);
      fv[i][2] = __uint_as_float(R.f[i].y << 16); fv[i][3] = __uint_as_float(R.f[i].y & 0xffff0000u);
      ss += fv[i][0] * fv[i][0] + fv[i][1] * fv[i][1] + fv[i][2] * fv[i][2] + fv[i][3] * fv[i][3];
    }
    ss = wave_sum(ss);
    const float r = rsqrtf(ss * (1.f / 1024.f) + 1e-6f) * scale;
#pragma unroll
    for (int i = 0; i < 4; ++i) { const float4 g = gpo[i];
      R.h[i].x += fv[i][0] * r * g.x; R.h[i].y += fv[i][1] * r * g.y; R.h[i].z += fv[i][2] * r * g.z; R.h[i].w += fv[i][3] * r * g.w; }
  }
  if (hout32) {
#pragma unroll
    for (int i = 0; i < 4; ++i) *(float4*)(hout32 + (size_t)row * 1024 + i * 256 + lane * 4) = R.h[i];
  }
  if (hout16) {
#pragma unroll
    for (int i = 0; i < 4; ++i) { u32x2 o; o.x = pk2(R.h[i].x, R.h[i].y); o.y = pk2(R.h[i].z, R.h[i].w); *(u32x2*)(hout16 + (size_t)row * 1024 + i * 256 + lane * 4) = o; }
  }
  if (a) {
    float ss = 0.f;
#pragma unroll
    for (int i = 0; i < 4; ++i) ss += R.h[i].x * R.h[i].x + R.h[i].y * R.h[i].y + R.h[i].z * R.h[i].z + R.h[i].w * R.h[i].w;
    ss = wave_sum(ss);
    const float r = rsqrtf(ss * (1.f / 1024.f) + 1e-6f);
#pragma unroll
    for (int i = 0; i < 4; ++i) { const float4 g = gpr[i];
      u32x2 o; o.x = pk2(R.h[i].x * r * g.x, R.h[i].y * r * g.y); o.y = pk2(R.h[i].z * r * g.z, R.h[i].w * r * g.w);
      *(u32x2*)(a + (size_t)row * 1024 + i * 256 + lane * 4) = o; }
  }
}
__device__ __forceinline__ void resnorm_phase(const float* hin32, const bf16_t* hin16, float* hout32, bf16_t* hout16, const bf16_t* f, float scale, const float* gpost, const float* gpre, bf16_t* a) {
  const int tid = TIDX, lane = tid & 63, stride = gridDim.x * 8;
  int r0 = blockIdx.x * 8 + (tid >> 6), r1 = r0 + 2 * stride;
  RowRegs A0, A1, B0, B1;
  float4 gpo[4], gpr[4];
#pragma unroll
  for (int i = 0; i < 4; ++i) { gpo[i] = f ? *(const float4*)(gpost + i * 256 + lane * 4) : make_float4(0.f, 0.f, 0.f, 0.f); gpr[i] = a ? *(const float4*)(gpre + i * 256 + lane * 4) : make_float4(0.f, 0.f, 0.f, 0.f); }
  const bool hf = f != nullptr;
  if (r0 < M_TOK) { rn_load(A0, hin32, hin16, f, r0, lane); rn_load(A1, hin32, hin16, f, r0 + stride, lane); }
  for (;;) {
    if (r0 >= M_TOK) break;
    if (r1 < M_TOK) { rn_load(B0, hin32, hin16, f, r1, lane); rn_load(B1, hin32, hin16, f, r1 + stride, lane); }
    rn_proc(A0, hout32, hout16, hf, scale, gpo, gpr, a, r0, lane); rn_proc(A1, hout32, hout16, hf, scale, gpo, gpr, a, r0 + stride, lane);
    r0 += 4 * stride;
    if (r1 >= M_TOK) break;
    if (r0 < M_TOK) { rn_load(A0, hin32, hin16, f, r0, lane); rn_load(A1, hin32, hin16, f, r0 + stride, lane); }
    rn_proc(B0, hout32, hout16, hf, scale, gpo, gpr, a, r1, lane); rn_proc(B1, hout32, hout16, hf, scale, gpo, gpr, a, r1 + stride, lane);
    r1 += 4 * stride;
  }
}

__device__ __forceinline__ void prep_phase(const Params& P, char* ldsc) {
  char* ws = P.ws;
  int rot = 0;
  for (int l = 0; l < 2; ++l) {
    for (int j = 0; j < 2; ++j) {
      const int lj = l * 2 + j;
      bf16_t* wgu = (bf16_t*)(ws + OFF_WGU + lj * SZ_WGU);
      tr_cvt(P.ffn_wg + (size_t)lj * 1024 * DFF, DFF, 1024, wgu, 1024, 32, 0, ldsc, rot);
      tr_cvt(P.ffn_wu + (size_t)lj * 1024 * DFF, DFF, 1024, wgu, 1024, 32, 16, ldsc, rot);
      tr_cvt(P.ffn_wd + (size_t)lj * DFF * 1024, 1024, DFF, (bf16_t*)(ws + OFF_WD + lj * SZ_WD), DFF, 16, 0, ldsc, rot);
      tr_cvt(P.cmp_w1 + (size_t)lj * 2048 * 128, 128, 2048, (bf16_t*)(ws + OFF_CW1 + lj * SZ_CW1), 2048, 16, 0, ldsc, rot);
    }
    tr_cvt(P.w_in + (size_t)l * 1024 * NIN, NIN, 1024, (bf16_t*)(ws + OFF_WIN + l * SZ_WIN), 1024, 16, 0, ldsc, rot);
    tr_cvt(P.w_out + (size_t)l * 1024 * 1024, 1024, 1024, (bf16_t*)(ws + OFF_WOUT + l * SZ_SQ), 1024, 16, 0, ldsc, rot);
    tr_cvt(P.ple_wg + (size_t)l * 1024 * 1024, 1024, 1024, (bf16_t*)(ws + OFF_WPG + l * SZ_SQ), 1024, 16, 0, ldsc, rot);
    tr_cvt(P.ple_wp + (size_t)l * 256 * 1024, 1024, 256, (bf16_t*)(ws + OFF_WPP + l * SZ_WPP), 256, 16, 0, ldsc, rot);
    for (int g = 0; g < 4; ++g) {
      tr_cvt(P.lru_wa + (size_t)(l * 4 + g) * 4096, 64, 64, (bf16_t*)(ws + OFF_WAT) + (l * 4 + g) * 4096, 64, 16, 0, ldsc, rot);
      tr_cvt(P.lru_wx + (size_t)(l * 4 + g) * 4096, 64, 64, (bf16_t*)(ws + OFF_WXT) + (l * 4 + g) * 4096, 64, 16, 0, ldsc, rot);
    }
  }
  const int tid = TIDX, gtid = blockIdx.x * 512 + tid, gn = gridDim.x * 512;
  for (int i = gtid; i < 2 * (LDZ - NIN) * 1024 / 8; i += gn) {
    const int l = i / ((LDZ - NIN) * 128), r = i - l * ((LDZ - NIN) * 128);
    *(f32x4*)((bf16_t*)(ws + OFF_WIN + l * SZ_WIN) + (size_t)NIN * 1024 + (size_t)r * 8) = zero4();
  }
  for (int i = gtid; i < 2 * 4 * 128 * 128; i += gn) { const int t = (i >> 7) & 127, s2 = i & 127; ((bf16_t*)(ws + OFF_SGUW))[i] = (s2 <= t) ? f2bf(P.sgu_w[i]) : (bf16_t)0; }
  for (int i = gtid; i < 2 * M_TOK * 256 / 4; i += gn) { const float4 v = ((const float4*)P.p)[i]; uint2 o; o.x = pk2(v.x, v.y); o.y = pk2(v.z, v.w); ((uint2*)(ws + OFF_PBF))[i] = o; }
  {
    float* lds = (float*)(ldsc + HBLK * 65536);
    for (int u = blockIdx.x; u < 64; u += gridDim.x) {
      const int t2 = HTID, kq = t2 >> 5, jq = t2 & 31, lkv = u >> 4, kc = u & 15;
      const float* w1 = P.cmp_w1 + (size_t)lkv * 2048 * 128; const float* pos = P.cmp_pos + (size_t)lkv * 2048;
      float4 sacc = make_float4(0.f, 0.f, 0.f, 0.f);
#pragma unroll
      for (int kk = 0; kk < 16; ++kk) { const int k = kc * 128 + kq * 16 + kk; const float pv = pos[k]; const float4 w = *(const float4*)(w1 + (size_t)k * 128 + jq * 4); sacc.x += pv * w.x; sacc.y += pv * w.y; sacc.z += pv * w.z; sacc.w += pv * w.w; }
      __syncthreads();
      lds[kq * 128 + jq * 4 + 0] = sacc.x; lds[kq * 128 + jq * 4 + 1] = sacc.y; lds[kq * 128 + jq * 4 + 2] = sacc.z; lds[kq * 128 + jq * 4 + 3] = sacc.w;
      __syncthreads();
      if (t2 < 128) { float t = 0.f; for (int q = 0; q < 8; ++q) t += lds[q * 128 + t2]; ((float*)(ws + OFF_CB1P))[u * 128 + t2] = t; }
      __syncthreads();
    }
  }
  resnorm_phase(P.x, nullptr, nullptr, nullptr, nullptr, 0.f, nullptr, P.norm_g, (bf16_t*)(ws + OFF_A));
}

constexpr int G8_HT = 128 * 64;
__device__ __forceinline__ int g8_lds_byte(int r, int c) { const int st = (r >> 4) * 2 + (c >> 5), rr = r & 15, cc = c & 31, ob = rr * 64 + cc * 2; return st * 1024 + (ob ^ (((ob >> 9) & 1) << 5)); }
__device__ __forceinline__ void g8_stage_rc(int b, int& R, int& C) { const int st = b / 1024, sb = b % 1024, swz = sb ^ (((sb >> 9) & 1) << 5); R = (st >> 1) * 16 + swz / 64; C = (st & 1) * 32 + (swz % 64) / 2; }

template <bool ISSUE_ONLY, bool PRE_ISSUED>
__device__ __forceinline__ void gemm_core(f32x4 (&acc)[2][2][4][2], const bf16_t* __restrict__ A, int lda, const bf16_t* __restrict__ Bt, int ldb, int K, char* ldsc) {
  bf16_t* shm = (bf16_t*)ldsc;
  const int tid = TIDX, wid = tid >> 6, lane = tid & 63, wr = wid >> 2, wc = wid & 3, fr = lane & 15, fq = lane >> 4;
  int sr0, sc0;
  g8_stage_rc(tid * 16, sr0, sc0);
  const bf16_t* gA0 = A + (size_t)sr0 * lda + sc0;
  const bf16_t* gB0 = Bt + (size_t)sr0 * ldb + sc0;
  const size_t a64 = (size_t)64 * lda, b64 = (size_t)64 * ldb;
  const int lane_off = (fr * 64 + fq * 16) ^ ((((fr * 64 + fq * 16) >> 9) & 1) << 5);
  const char* ldA = ldsc + wr * 8192 + lane_off;
  const char* ldB = ldsc + 65536 + wc * 4096 + lane_off;
#define SA(b, h) (shm + ((b) * 2 + (h)) * G8_HT)
#define SB(b, h) (shm + (4 + (b) * 2 + (h)) * G8_HT)
#define STAGE_A(P, h, kt) { const bf16_t* g_ = gA0 + (size_t)(h) * 2 * a64 + (kt) * 64; glds16(g_, (char*)(P) + tid * 16); glds16(g_ + a64, (char*)(P) + tid * 16 + 8192); }
#define STAGE_B(P, h, kt) { const bf16_t* g_ = gB0 + (size_t)(h) * 2 * b64 + (kt) * 64; glds16(g_, (char*)(P) + tid * 16); glds16(g_ + b64, (char*)(P) + tid * 16 + 8192); }
#define LDA(dst, b, h) _Pragma("unroll") for (int m = 0; m < 4; ++m) _Pragma("unroll") for (int k = 0; k < 2; ++k) \
    dst[m][k] = *reinterpret_cast<const bf16x8*>(ldA + ((b) * 2 + (h)) * 16384 + (m * 2 + k) * 1024)
#define LDB(dst, b, h) _Pragma("unroll") for (int n = 0; n < 2; ++n) _Pragma("unroll") for (int k = 0; k < 2; ++k) \
    dst[n][k] = *reinterpret_cast<const bf16x8*>(ldB + ((b) * 2 + (h)) * 16384 + (n * 2 + k) * 1024)
#define MMA(ai, bj, At_, Bt_) do { __builtin_amdgcn_s_setprio(1); \
    _Pragma("unroll") for (int m = 0; m < 4; ++m) _Pragma("unroll") for (int n = 0; n < 2; ++n) _Pragma("unroll") for (int k = 0; k < 2; ++k) \
      acc[ai][bj][m][n] = mfma16(Bt_[n][k], At_[m][k], acc[ai][bj][m][n]); \
    __builtin_amdgcn_s_setprio(0); } while (0)
#define WAIT_V(n) asm volatile("s_waitcnt vmcnt(" #n ")" ::: "memory")
#define WAIT_L(n) asm volatile("s_waitcnt lgkmcnt(" #n ")" ::: "memory")
#define BAR __builtin_amdgcn_s_barrier()
#define SCHED __builtin_amdgcn_sched_barrier(0)
  bf16x8 At[4][2], B0[2][2], B1[2][2];
  const int nt = K >> 6;
  if (!PRE_ISSUED) {
    STAGE_B(SB(0, 0), 0, 0); STAGE_A(SA(0, 0), 0, 0);
    STAGE_B(SB(0, 1), 1, 0); STAGE_A(SA(0, 1), 1, 0);
  }
  if (ISSUE_ONLY) return;
  if (wr == 1) BAR;
  if (PRE_ISSUED) { WAIT_V(0); } else { WAIT_V(4); }
  BAR;
  STAGE_B(SB(1, 0), 0, 1); STAGE_A(SA(1, 0), 0, 1); STAGE_B(SB(1, 1), 1, 1);
  WAIT_V(6); BAR;
#pragma nounroll
  for (int t = 0; t < nt - 2; t += 2) {
    LDB(B0, 0, 0); SCHED; LDA(At, 0, 0); STAGE_A(SA(1, 1), 1, t + 1);
    WAIT_L(8); BAR; WAIT_L(0); MMA(0, 0, At, B0); BAR; SCHED;
    LDB(B1, 0, 1); STAGE_B(SB(0, 0), 0, t + 2);
    BAR; WAIT_L(0); MMA(0, 1, At, B1); BAR;
    LDA(At, 0, 1); STAGE_A(SA(0, 0), 0, t + 2);
    BAR; WAIT_L(0); MMA(1, 0, At, B0); BAR; SCHED;
    STAGE_B(SB(0, 1), 1, t + 2);
    WAIT_V(6); BAR; MMA(1, 1, At, B1); BAR;
    LDB(B0, 1, 0); SCHED; LDA(At, 1, 0); STAGE_A(SA(0, 1), 1, t + 2);
    WAIT_L(8); BAR; WAIT_L(0); MMA(0, 0, At, B0); BAR; SCHED;
    LDB(B1, 1, 1); STAGE_B(SB(1, 0), 0, t + 3);
    BAR; WAIT_L(0); MMA(0, 1, At, B1); BAR;
    LDA(At, 1, 1); STAGE_A(SA(1, 0), 0, t + 3);
    BAR; WAIT_L(0); MMA(1, 0, At, B0); BAR; SCHED;
    STAGE_B(SB(1, 1), 1, t + 3);
    WAIT_V(6); BAR; MMA(1, 1, At, B1); BAR;
  }
  { LDB(B0, 0, 0); LDA(At, 0, 0); STAGE_A(SA(1, 1), 1, nt - 1);
    BAR; WAIT_L(0); MMA(0, 0, At, B0); BAR;
    LDB(B1, 0, 1); BAR; WAIT_L(0); MMA(0, 1, At, B1); BAR;
    LDA(At, 0, 1); WAIT_V(4); BAR; WAIT_L(0); MMA(1, 0, At, B0); MMA(1, 1, At, B1); BAR; }
  { LDB(B0, 1, 0); LDA(At, 1, 0); WAIT_V(2); BAR; WAIT_L(0); MMA(0, 0, At, B0); BAR;
    LDB(B1, 1, 1); WAIT_V(0); BAR; WAIT_L(0); MMA(0, 1, At, B1); BAR;
    LDA(At, 1, 1); BAR; WAIT_L(0); MMA(1, 0, At, B0); MMA(1, 1, At, B1); BAR; }
  if (wr == 0) BAR;
  BAR;
#undef SA
#undef SB
#undef STAGE_A
#undef STAGE_B
#undef LDA
#undef LDB
#undef MMA
#undef WAIT_V
#undef WAIT_L
#undef BAR
#undef SCHED
}

struct TileIt {
  int TN, npc, npatch, slot, nslot, pid, s, tm, tn;
  __device__ __forceinline__ void init(int TN_) { TN = TN_; npc = (TN + 1) >> 1; npatch = 8 * npc; slot = blockIdx.x >> 3; nslot = gridDim.x >> 3; pid = blockIdx.x & 7; s = slot - nslot; }
  __device__ __forceinline__ bool next() {
    for (;;) {
      s += nslot;
      if (s >= 32) { s = slot; pid += 8; }
      if (pid >= npatch) return false;
      const int pr = pid / npc, pc = pid - pr * npc;
      tm = pr * 16 + (s & 15); tn = pc * 2 + (s >> 4);
      if (tn < TN) return true;
    }
  }
};

#define GEMM_LANE const int tid_ = TIDX, lane_ = tid_ & 63, wid_ = tid_ >> 6, wr = wid_ >> 2, wc = wid_ & 3, fr = lane_ & 15, fq = lane_ >> 4
#define GEMM_EPI_LOOP _Pragma("unroll") for (int ai = 0; ai < 2; ++ai) _Pragma("unroll") for (int m = 0; m < 4; ++m) _Pragma("unroll") for (int bj = 0; bj < 2; ++bj)

template <class Epi> __device__ __forceinline__ void gemm_phase(const bf16_t* A, int lda, const bf16_t* Bt, int ldb, int K, int TN, char* lds, Epi&& epi) {
  TileIt it; it.init(TN);
  bool have = it.next();
  f32x4 acc[2][2][4][2];
  if (have) gemm_core<true, false>(acc, A + (size_t)it.tm * 256 * lda, lda, Bt + (size_t)it.tn * 256 * ldb, ldb, K, lds);
  while (have) {
    const int tm = it.tm, tn = it.tn;
#pragma unroll
    for (int i0 = 0; i0 < 2; ++i0)
#pragma unroll
      for (int i1 = 0; i1 < 2; ++i1)
#pragma unroll
        for (int i2 = 0; i2 < 4; ++i2)
#pragma unroll
          for (int i3 = 0; i3 < 2; ++i3) acc[i0][i1][i2][i3] = zero4();
    gemm_core<false, true>(acc, A + (size_t)tm * 256 * lda, lda, Bt + (size_t)tn * 256 * ldb, ldb, K, lds);
    have = it.next();
    if (have) { f32x4 dummy[2][2][4][2]; gemm_core<true, false>(dummy, A + (size_t)it.tm * 256 * lda, lda, Bt + (size_t)it.tn * 256 * ldb, ldb, K, lds); }
    epi(acc, tm, tn);
  }
  asm volatile("s_waitcnt vmcnt(0)" ::: "memory");
}

__device__ __forceinline__ void gemm_up_phase(const bf16_t* a, const bf16_t* wgu, bf16_t* act, char* lds) {
  gemm_phase(a, 1024, wgu, 1024, 1024, NGU / 256, lds, [&](f32x4 (&acc)[2][2][4][2], int tm, int tn) {
    GEMM_LANE;
    GEMM_EPI_LOOP {
      const int row = tm * 256 + ai * 128 + wr * 64 + m * 16 + fr;
      const int col = tn * 128 + bj * 64 + wc * 16 + 4 * fq;
      const f32x4 g = acc[ai][bj][m][0], u = acc[ai][bj][m][1];
      u32x2 o; o.x = pk2(silu_f(g[0]) * u[0], silu_f(g[1]) * u[1]); o.y = pk2(silu_f(g[2]) * u[2], silu_f(g[3]) * u[3]);
      *(u32x2*)(act + (size_t)row * DFF + col) = o;
    }
  });
}

__device__ __forceinline__ void gemm_bf16_phase(const bf16_t* A, int lda, const bf16_t* Bt, int K, int TN, bf16_t* out, int ldo, char* lds) {
  gemm_phase(A, lda, Bt, K, K, TN, lds, [&](f32x4 (&acc)[2][2][4][2], int tm, int tn) {
    GEMM_LANE;
    GEMM_EPI_LOOP {
      const int row = tm * 256 + ai * 128 + wr * 64 + m * 16 + fr;
#pragma unroll
      for (int n = 0; n < 2; ++n) {
        u32x2 o; o.x = pk2(acc[ai][bj][m][n][0], acc[ai][bj][m][n][1]); o.y = pk2(acc[ai][bj][m][n][2], acc[ai][bj][m][n][3]);
        *(u32x2*)(out + (size_t)row * ldo + tn * 256 + bj * 128 + wc * 32 + n * 16 + 4 * fq) = o;
      }
    }
  });
}

__device__ __forceinline__ void gemm_ple_phase(const bf16_t* a, const bf16_t* wpg, const bf16_t* pp, bf16_t* out, char* lds) {
  gemm_phase(a, 1024, wpg, 1024, 1024, 4, lds, [&](f32x4 (&acc)[2][2][4][2], int tm, int tn) {
    GEMM_LANE;
    GEMM_EPI_LOOP {
      const int row = tm * 256 + ai * 128 + wr * 64 + m * 16 + fr;
#pragma unroll
      for (int n = 0; n < 2; ++n) {
        const int col = tn * 256 + bj * 128 + wc * 32 + n * 16 + 4 * fq;
        const u32x2 pv = *(const u32x2*)(pp + (size_t)row * 1024 + col);
        const f32x4 av = acc[ai][bj][m][n];
        u32x2 o;
        o.x = pk2(sigm(av[0]) * __uint_as_float(pv.x << 16), sigm(av[1]) * __uint_as_float(pv.x & 0xffff0000u));
        o.y = pk2(sigm(av[2]) * __uint_as_float(pv.y << 16), sigm(av[3]) * __uint_as_float(pv.y & 0xffff0000u));
        *(u32x2*)(out + (size_t)row * 1024 + col) = o;
      }
    }
  });
}

__device__ __forceinline__ void mixA_item(const Params& P, int layer, int idx, const bf16_t* z, bf16_t* y, char* lds) {
  const int g = idx & 3, bc = idx >> 2, tok0 = bc * 128;
  const int tid = HTID, lane = tid & 63, w = tid >> 6, fr = lane & 15, fq = lane >> 4;
  bf16_t* vT = (bf16_t*)lds;
  const float* ng = P.sgu_ng + layer * 256;
  {
    const int s = tid >> 1, half = tid & 1;
    const bf16_t* zr = z + (size_t)(tok0 + s) * LDZ + ZC_AV;
    float ss = 0.f;
#pragma unroll 4
    for (int i = 0; i < 16; ++i) { float v[8]; unpack8(*(const u32x4*)(zr + half * 128 + i * 8), v);
#pragma unroll
      for (int e = 0; e < 8; ++e) { const float t = gelu_t(v[e]); ss += t * t; } }
    ss += __shfl_xor(ss, 1);
    const float rs = rsqrtf(ss * (1.f / 256.f) + 1e-6f);
#pragma unroll
    for (int i = 0; i < 4; ++i) { float v[8]; unpack8(*(const u32x4*)(zr + g * 64 + half * 32 + i * 8), v);
#pragma unroll
      for (int e = 0; e < 8; ++e) { const int d = half * 32 + i * 8 + e; vT[d * 136 + s] = f2bf(gelu_t(v[e]) * rs * ng[g * 64 + d]); } }
  }
  __syncthreads();
  const bf16_t* W = (const bf16_t*)(P.ws + OFF_SGUW) + (size_t)((layer * 4 + g) * 128) * 128;
  f32x4 acc[2][4] = {};
  for (int ks = 0; ks <= w; ++ks) {
    bf16x8 wf[2], vf[4];
#pragma unroll
    for (int tm = 0; tm < 2; ++tm) wf[tm] = *(const bf16x8*)(W + (size_t)(32 * w + tm * 16 + fr) * 128 + ks * 32 + 8 * fq);
#pragma unroll
    for (int dn = 0; dn < 4; ++dn) vf[dn] = *(const bf16x8*)(vT + (dn * 16 + fr) * 136 + ks * 32 + 8 * fq);
#pragma unroll
    for (int tm = 0; tm < 2; ++tm)
#pragma unroll
      for (int dn = 0; dn < 4; ++dn) acc[tm][dn] = mfma16(vf[dn], wf[tm], acc[tm][dn]);
  }
#pragma unroll
  for (int tm = 0; tm < 2; ++tm) {
    const int t = 32 * w + tm * 16 + fr;
    const float bias = P.sgu_b[(layer * 4 + g) * 128 + t];
#pragma unroll
    for (int dn = 0; dn < 4; ++dn) {
      const int d = dn * 16 + 4 * fq;
      const uint2 uu = *(const uint2*)(z + (size_t)(tok0 + t) * LDZ + ZC_AU + g * 64 + d);
      const float u0 = gelu_t(__uint_as_float(uu.x << 16)), u1 = gelu_t(__uint_as_float(uu.x & 0xffff0000u)),
                  u2 = gelu_t(__uint_as_float(uu.y << 16)), u3 = gelu_t(__uint_as_float(uu.y & 0xffff0000u));
      uint2 o; o.x = pk2(u0 * (acc[tm][dn][0] + bias), u1 * (acc[tm][dn][1] + bias)); o.y = pk2(u2 * (acc[tm][dn][2] + bias), u3 * (acc[tm][dn][3] + bias));
      *(uint2*)(y + (size_t)(tok0 + t) * 1024 + g * 64 + d) = o;
    }
  }
  __syncthreads();
}

__device__ __forceinline__ void mixB1_item(const Params& P, int layer, int idx, const bf16_t* z, float* hsl, float* Pc, float* carryP, float* carryH, char* lds) {
  const int c = idx & 63, g = (idx >> 6) & 3, b = idx >> 8;
  const int tid = HTID, lane = tid & 63, w = tid >> 6, fr = lane & 15, fq = lane >> 4;
  bf16_t* xcb = (bf16_t*)lds;
  float* xcf = (float*)(lds + 9216);
  float* aA = (float*)(lds + 9216 + 16384);
  float* bB = (float*)(lds + 9216 + 32768);
  float* sm = (float*)(lds + 9216 + 49152);
  const size_t tokb = (size_t)b * SEQ;
  {
    const int t = tid >> 2, q = tid & 3;
    float accv[16];
#pragma unroll
    for (int i = 0; i < 16; ++i) accv[i] = P.conv_b[layer * 256 + g * 64 + q * 16 + i];
#pragma unroll
    for (int k = 0; k < 4; ++k) {
      const int pos = c * 64 + t - 3 + k;
      if (pos >= 0) {
        const bf16_t* zr = z + (tokb + pos) * LDZ + ZC_BX + g * 64 + q * 16;
        float v[16]; unpack8(*(const u32x4*)zr, v); unpack8(*(const u32x4*)(zr + 8), v + 8);
        const float* cw = P.conv_w + (size_t)(layer * 4 + k) * 256 + g * 64 + q * 16;
#pragma unroll
        for (int i = 0; i < 16; ++i) accv[i] += v[i] * cw[i];
      }
    }
#pragma unroll
    for (int i = 0; i < 16; ++i) { xcf[t * 64 + q * 16 + i] = accv[i]; xcb[t * 72 + q * 16 + i] = f2bf(accv[i]); }
  }
  __syncthreads();
  {
    const bf16_t* wa = (const bf16_t*)(P.ws + OFF_WAT) + (layer * 4 + g) * 4096;
    const bf16_t* wx = (const bf16_t*)(P.ws + OFF_WXT) + (layer * 4 + g) * 4096;
    f32x4 ar[4] = {}, ai[4] = {};
#pragma unroll
    for (int ks = 0; ks < 2; ++ks) {
      const bf16x8 xf = *(const bf16x8*)(xcb + (16 * w + fr) * 72 + ks * 32 + 8 * fq);
#pragma unroll
      for (int jn = 0; jn < 4; ++jn) {
        const bf16x8 fa = *(const bf16x8*)(wa + (jn * 16 + fr) * 64 + ks * 32 + 8 * fq);
        const bf16x8 fx = *(const bf16x8*)(wx + (jn * 16 + fr) * 64 + ks * 32 + 8 * fq);
        ar[jn] = mfma16(fa, xf, ar[jn]); ai[jn] = mfma16(fx, xf, ai[jn]);
      }
    }
    const int t = 16 * w + fr;
#pragma unroll
    for (int jn = 0; jn < 4; ++jn)
#pragma unroll
      for (int e = 0; e < 4; ++e) {
        const int j = jn * 16 + 4 * fq + e, ch = layer * 256 + g * 64 + j;
        const float r = sigm(ar[jn][e] + P.lru_ba[ch]), ig = sigm(ai[jn][e] + P.lru_bx[ch]);
        const float lam = P.lru_lam[ch];
        const float xe = __expf(-lam);
        float m8; asm volatile("v_mov_b32 %0, 0xc1000000" : "=v"(m8));
        const float la = m8 * r * (xe * (1.f - xe * (0.5f - xe * (1.f / 3.f))));
        const float av = __expf(la);
        const float y2 = 2.f * la;
        const float om = -y2 * (1.f + y2 * (0.5f + y2 * ((1.f / 6.f) + y2 * ((1.f / 24.f) + y2 * ((1.f / 120.f) + y2 * (1.f / 720.f))))));
        const float bv = sqrtf(om) * (ig * xcf[t * 64 + j]);
        aA[t * 64 + j] = av; bB[t * 64 + j] = bv;
      }
  }
  __syncthreads();
  {
    const int q = tid >> 6, j = tid & 63;
    float Pq = 1.f, hq = 0.f;
#pragma unroll
    for (int i = 0; i < 16; ++i) { const int t = q * 16 + i; const float av = aA[t * 64 + j], bv = bB[t * 64 + j]; hq = av * hq + bv; Pq *= av; aA[t * 64 + j] = Pq; bB[t * 64 + j] = hq; }
    sm[q * 64 + j] = Pq; sm[256 + q * 64 + j] = hq;
    __syncthreads();
    float Pin = 1.f, Hin = 0.f;
    for (int qq = 0; qq < q; ++qq) { const float pp = sm[qq * 64 + j], hh = sm[256 + qq * 64 + j]; Hin = pp * Hin + hh; Pin *= pp; }
    float hl = 0.f, pl = 1.f;
#pragma unroll
    for (int i = 0; i < 16; ++i) { const int t = q * 16 + i; hl = bB[t * 64 + j] + aA[t * 64 + j] * Hin; pl = aA[t * 64 + j] * Pin;
      const size_t o = (tokb + c * 64 + t) * 256 + g * 64 + j; hsl[o] = hl; Pc[o] = pl; }
    if (q == 3) { const int o = ((b * 4 + g) * 64 + c) * 64 + j; carryP[o] = pl; carryH[o] = hl; }
  }
  __syncthreads();
}

__device__ __forceinline__ void mixB2_item(int idx, const bf16_t* z, const float* hsl, const float* Pc, const float* carryP, const float* carryH, bf16_t* y) {
  const int c = idx & 63, g = (idx >> 6) & 3, b = idx >> 8;
  const int q = HTID >> 6, j = HTID & 63;
  const float* cp = carryP + (size_t)((b * 4 + g) * 64) * 64 + j;
  const float* chh = carryH + (size_t)((b * 4 + g) * 64) * 64 + j;
  float H = 0.f;
  for (int c0 = 0; c0 < c; c0 += 8) {
    float pv[8], hv[8];
#pragma unroll
    for (int i = 0; i < 8; ++i) { const bool ok = c0 + i < c; pv[i] = ok ? cp[(c0 + i) * 64] : 1.f; hv[i] = ok ? chh[(c0 + i) * 64] : 0.f; }
#pragma unroll
    for (int i = 0; i < 8; ++i) H = pv[i] * H + hv[i];
  }
  const size_t tokb = (size_t)b * SEQ + c * 64 + q * 16;
#pragma unroll 4
  for (int i = 0; i < 16; ++i) {
    const size_t o = (tokb + i) * 256 + g * 64 + j;
    const float h = hsl[o] + Pc[o] * H;
    const float gt = bf2f(z[(tokb + i) * LDZ + ZC_BG + g * 64 + j]);
    y[(tokb + i) * 1024 + 256 + g * 64 + j] = f2bf(h * gelu_t(gt));
  }
}

__device__ __forceinline__ void compress_item(const Params& P, int layer, int idx, const bf16_t* z, bf16_t* kcv, char* lds) {
  const int nb = idx & 15, g = (idx >> 4) & 1, b = (idx >> 5) & 7, kv = idx >> 8;
  const int tid = HTID, lane = tid & 63, w = tid >> 6, fr = lane & 15, fq = lane >> 4;
  const int n0 = nb * 16, col = (kv ? ZC_VC : ZC_KC) + g * 64;
  const bf16_t* w1t = (const bf16_t*)(P.ws + OFF_CW1 + (size_t)(layer * 2 + kv) * SZ_CW1);
  float* part = (float*)lds;
  float* hid = (float*)(lds + 34816);
  f32x4 acc[8];
#pragma unroll
  for (int jf = 0; jf < 8; ++jf) acc[jf] = zero4();
  int nn = n0 + fr; if (nn > 254) nn = 254;
  const bf16_t* zb = z + ((size_t)b * SEQ + 16 * nn) * LDZ + col + 8 * fq;
  const bf16_t* wb = w1t + (size_t)fr * 2048 + 8 * fq;
#pragma unroll 4
  for (int kk = 0; kk < 16; ++kk) {
    const int ks = 16 * w + kk, l = ks >> 1, d0 = (ks & 1) * 32;
    const bf16x8 xf = *(const bf16x8*)(zb + (size_t)l * LDZ + d0);
#pragma unroll
    for (int jf = 0; jf < 8; ++jf) { const bf16x8 wf = *(const bf16x8*)(wb + (size_t)jf * 16 * 2048 + ks * 32); acc[jf] = mfma16(wf, xf, acc[jf]); }
  }
#pragma unroll
  for (int jf = 0; jf < 8; ++jf)
#pragma unroll
    for (int e = 0; e < 4; ++e) part[(w * 16 + fr) * 132 + jf * 16 + 4 * fq + e] = acc[jf][e];
  __syncthreads();
  const float* cb1 = (const float*)(P.ws + OFF_CB1) + (layer * 2 + kv) * 128;
  {
    const int n = tid >> 4, j0 = (tid & 15) * 8;
#pragma unroll
    for (int e = 0; e < 8; ++e) { const int j = j0 + e; const float v = ((part[(0 * 16 + n) * 132 + j] + part[(1 * 16 + n) * 132 + j]) + part[(2 * 16 + n) * 132 + j]) + part[(3 * 16 + n) * 132 + j];
      hid[n * 129 + j] = gelu_t(v + cb1[j]); }
  }
  __syncthreads();
  {
    const int n = tid >> 4, d0 = (tid & 15) * 4;
    const float* w2 = P.cmp_w2 + (size_t)(layer * 2 + kv) * 128 * 64 + d0;
    const float4 bb = *(const float4*)(P.cmp_b2 + (layer * 2 + kv) * 64 + d0);
    float o0 = bb.x, o1 = bb.y, o2 = bb.z, o3 = bb.w;
#pragma unroll 8
    for (int j = 0; j < 128; ++j) { const float hv = hid[n * 129 + j]; const float4 wa = *(const float4*)(w2 + j * 64); o0 += hv * wa.x; o1 += hv * wa.y; o2 += hv * wa.z; o3 += hv * wa.w; }
    u32x2 ov; ov.x = pk2(o0, o1); ov.y = pk2(o2, o3);
    if ((n0 + n) >= 255) { ov.x = 0u; ov.y = 0u; }
    *(u32x2*)(kcv + ((size_t)((kv * 8 + b) * 2 + g) * 256 + n0 + n) * 64 + d0) = ov;
  }
  __syncthreads();
}

constexpr int NSA_KT = 0, NSA_VT = 16384, NSA_T = 33792, NSA_TW = NSA_T + 4 * 4160 * 4, NSA_IMP = NSA_TW + 4 * 640 * 4, NSA_WU = NSA_IMP + 2 * 16640;
constexpr int LDS_ST = 147456;
constexpr float LOG2E = 1.4426950408889634f;

__device__ __forceinline__ void nsa_tables(const Params& P, int g, char* lds) {
  float* T = (float*)(lds + NSA_T);
  float* TW = (float*)(lds + NSA_TW);
  const int tid = TIDX;
  for (int i = tid; i < 4160; i += 512) {
    const int n = i - 64;
    int bk = n;
    if (n >= 16) bk = 16 + (n >= 21) + (n >= 27) + (n >= 35) + (n >= 46) + (n >= 59) + (n >= 77) + (n >= 99) + (n >= 128) + (n >= 166) + (n >= 216) + (n >= 280) + (n >= 363) + (n >= 470) + (n >= 609) + (n >= 790);
#pragma unroll
    for (int r = 0; r < 4; ++r) {
      const float v = n >= 0 ? P.rel_bias[bk * 8 + g * 4 + r] * LOG2E : -__builtin_inff();
      T[r * 4160 + i] = v;
      if (i < 640) TW[r * 640 + i] = (n < 512) ? v : -__builtin_inff();
    }
  }
  __syncthreads();
}

struct KVRegs { u32x4 k0, v0; };
__device__ __forceinline__ void kv_gload(KVRegs& r, const bf16_t* kb, const bf16_t* vb, size_t stride) {
  const int tid = TIDX, row = tid >> 3, cq = tid & 7;
  r.k0 = *(const u32x4*)(kb + row * stride + cq * 8); r.v0 = *(const u32x4*)(vb + row * stride + cq * 8);
}
__device__ __forceinline__ void kv_lwrite(const KVRegs& r, char* lds, int buf) {
  const int tid = TIDX, row = tid >> 3, cq = tid & 7;
  char* kt = lds + NSA_KT + buf * 8192 + row * 128;
  *(u32x4*)(kt + ((cq ^ (row & 7)) << 4)) = r.k0;
  bf16_t* vt = (bf16_t*)(lds + NSA_VT + buf * 8704) + (cq * 8) * 68 + row;
#pragma unroll
  for (int i = 0; i < 4; ++i) { vt[(2 * i) * 68] = (bf16_t)(r.v0[i] & 0xffffu); vt[(2 * i + 1) * 68] = (bf16_t)(r.v0[i] >> 16); }
}

template <int MODE>
__device__ __forceinline__ void nsa_compute(int cur, int buf, int t, int hl, u64 mymask, const bf16x8 (&Qf)[2][2], f32x4 (&O)[4][2], float (&m)[2], float (&l)[2],
                                            const float (&inv)[2], float* impw, char* lds) {
  const int lane = TIDX & 63, fr = lane & 15, fq = lane >> 4;
  const char* kt = lds + NSA_KT + buf * 8192;
  const bf16_t* vt = (const bf16_t*)(lds + NSA_VT + buf * 8704);
  const bool selok = (MODE == 2) ? (((mymask >> cur) & 1ull) != 0ull) : true;
  const float* tb = (MODE == 3) ? (const float*)(lds + NSA_TW) + hl * 640 : (const float*)(lds + NSA_T) + hl * 4160;
  constexpr int TS = (MODE == 3) ? 640 : 4160;
  const int base = (MODE <= 1) ? (t - 31 - 16 * (cur * 64 + 4 * fq) + 64) : (t - cur * 64 - 4 * fq + 64);
#pragma unroll
  for (int s2 = 0; s2 < 2; ++s2) {
    f32x4 S[2][2] = {};
    bf16x8 kfr[2][2];
#pragma unroll
    for (int ks = 0; ks < 2; ++ks)
#pragma unroll
      for (int kk = 0; kk < 2; ++kk) kfr[ks][kk] = *(const bf16x8*)(kt + (32 * s2 + 16 * kk + fr) * 128 + (((ks * 4 + fq) ^ (fr & 7)) << 4));
    __builtin_amdgcn_s_setprio(1);
#pragma unroll
    for (int ks = 0; ks < 2; ++ks)
#pragma unroll
      for (int kk = 0; kk < 2; ++kk)
#pragma unroll
        for (int r = 0; r < 2; ++r) S[kk][r] = mfma16(kfr[ks][kk], Qf[r][ks], S[kk][r]);
    __builtin_amdgcn_s_setprio(0);
    bf16x8 Pf[2];
    float g1s[2] = {0.f, 0.f}, p3s[2] = {0.f, 0.f};
#pragma unroll
    for (int r = 0; r < 2; ++r) {
      float sv[2][4];
#pragma unroll
      for (int kk = 0; kk < 2; ++kk)
#pragma unroll
        for (int e = 0; e < 4; ++e) {
          const int off = 32 * s2 + 16 * kk + e;
          int idx;
          if (MODE <= 1) { idx = base - 16 * off; idx = idx > 0 ? idx : 0; } else idx = base - off;
          sv[kk][e] = S[kk][r][e] * (0.125f * LOG2E) + tb[r * TS + idx];
        }
      float pv[2][4];
      if (MODE == 1) {
#pragma unroll
        for (int kk = 0; kk < 2; ++kk)
#pragma unroll
          for (int e = 0; e < 4; ++e) pv[kk][e] = __builtin_amdgcn_exp2f(sv[kk][e] - m[r]) * inv[r];
#pragma unroll
        for (int kk = 0; kk < 2; ++kk) { g1s[kk] += pv[kk][0] + pv[kk][1] + pv[kk][2] + 0.5f * pv[kk][3]; p3s[kk] += 0.5f * pv[kk][3]; }
      } else {
        float mx = fmaxf(fmaxf(fmaxf(sv[0][0], sv[0][1]), fmaxf(sv[0][2], sv[0][3])), fmaxf(fmaxf(sv[1][0], sv[1][1]), fmaxf(sv[1][2], sv[1][3])));
        if (MODE == 2) mx = selok ? mx : -__builtin_inff();
        if (__any(mx > m[r] + 8.0f)) {
          mx = fmaxf(mx, __shfl_xor(mx, 16)); mx = fmaxf(mx, __shfl_xor(mx, 32));
          const float mn = fmaxf(m[r], mx), al = __builtin_amdgcn_exp2f(m[r] - mn);
          m[r] = mn; l[r] *= al;
          if (MODE != 0) {
#pragma unroll
            for (int df = 0; df < 4; ++df) O[df][r] *= al;
          }
        }
        const float me = (MODE == 2) ? (selok ? m[r] : __builtin_inff()) : m[r];
        float ps = 0.f;
#pragma unroll
        for (int kk = 0; kk < 2; ++kk)
#pragma unroll
          for (int e = 0; e < 4; ++e) { pv[kk][e] = __builtin_amdgcn_exp2f(sv[kk][e] - me); ps += pv[kk][e]; }
        l[r] += ps;
      }
      if (MODE != 0) {
        const unsigned w0 = pk2(pv[0][0], pv[0][1]), w1 = pk2(pv[0][2], pv[0][3]), w2 = pk2(pv[1][0], pv[1][1]), w3 = pk2(pv[1][2], pv[1][3]);
        u32x4 pw; pw.x = w0; pw.y = w1; pw.z = w2; pw.w = w3;
        Pf[r] = __builtin_bit_cast(bf16x8, pw);
      }
    }
    if (MODE != 0) {
      bf16x8 vfr[4];
#pragma unroll
      for (int df = 0; df < 4; ++df) {
        const bf16x4 va = *(const bf16x4*)(vt + (df * 16 + fr) * 68 + 32 * s2 + 4 * fq);
        const bf16x4 vb = *(const bf16x4*)(vt + (df * 16 + fr) * 68 + 32 * s2 + 16 + 4 * fq);
        bf16x8 vf; vf[0] = va[0]; vf[1] = va[1]; vf[2] = va[2]; vf[3] = va[3]; vf[4] = vb[0]; vf[5] = vb[1]; vf[6] = vb[2]; vf[7] = vb[3];
        vfr[df] = vf;
      }
      __builtin_amdgcn_s_setprio(1);
#pragma unroll
      for (int df = 0; df < 4; ++df)
#pragma unroll
        for (int r = 0; r < 2; ++r) O[df][r] = mfma16(vfr[df], Pf[r], O[df][r]);
      __builtin_amdgcn_s_setprio(0);
    }
    if (MODE == 1) {
#pragma unroll
      for (int kk = 0; kk < 2; ++kk) {
        const int j = cur * 16 + (2 * s2 + kk) * 4 + fq;
        atomicAdd(&impw[fr * 65 + j], g1s[kk]);
        if (j + 1 < 64) atomicAdd(&impw[fr * 65 + j + 1], p3s[kk]);
      }
    }
  }
}

template <int MODE>
__device__ __forceinline__ void nsa_branch(int first, int ntl, u64 U, const bf16_t* kbase, const bf16_t* vbase, size_t stride, int t, int hl, u64 mymask,
                                           const bf16x8 (&Qf)[2][2], f32x4 (&O)[4][2], float (&m)[2], float (&l)[2], const float (&inv)[2], float* impw, char* lds) {
  KVRegs R0, R1, R2;
  u64 rem = U;
  int seq = first, left = ntl;
#define NSA_NEXT(dst)                                                                                     \
  { if (MODE == 2) { dst = rem ? (int)__builtin_ctzll(rem) : -1; if (rem) rem &= rem - 1; }              \
    else { dst = left > 0 ? seq : -1; ++seq; --left; } }
#define NSA_GLOAD(R, ti) kv_gload(R, kbase + (size_t)(ti) * 64 * stride, vbase + (size_t)(ti) * 64 * stride, stride)
  int tcur, t1, t2, t3;
  NSA_NEXT(tcur); NSA_NEXT(t1); NSA_NEXT(t2);
  if (tcur >= 0) NSA_GLOAD(R0, tcur);
  if (t1 >= 0) NSA_GLOAD(R1, t1);
  if (t2 >= 0) NSA_GLOAD(R2, t2);
  if (tcur >= 0) kv_lwrite(R0, lds, 0);
  __syncthreads();
  NSA_NEXT(t3);
  if (t3 >= 0) NSA_GLOAD(R0, t3);
  int buf = 0;
#define NSA_STEP(RW)                                                                                      \
  if (tcur < 0) break;                                                                                    \
  nsa_compute<MODE>(tcur, buf, t, hl, mymask, Qf, O, m, l, inv, impw, lds);                               \
  if (t1 >= 0) kv_lwrite(RW, lds, buf ^ 1);                                                               \
  __syncthreads();                                                                                        \
  buf ^= 1; tcur = t1; t1 = t2; t2 = t3;                                                                  \
  NSA_NEXT(t3);                                                                                           \
  if (t3 >= 0) NSA_GLOAD(RW, t3);
  for (;;) {
    NSA_STEP(R1)
    NSA_STEP(R2)
    NSA_STEP(R0)
  }
#undef NSA_STEP
#undef NSA_GLOAD
#undef NSA_NEXT
}

#define NSA_RESET()                                                                         \
  _Pragma("unroll") for (int r = 0; r < 2; ++r) { asm volatile("v_mov_b32 %0, 0xf149f2ca" : "=v"(m[r])); l[r] = 0.f; }               \
  _Pragma("unroll") for (int df = 0; df < 4; ++df) _Pragma("unroll") for (int r = 0; r < 2; ++r) O[df][r] = zero4();

__device__ __forceinline__ void nsa_item(const Params& P, int b, int g, int c, const bf16_t* z, const bf16_t* kcv, bf16_t* y, char* lds) {
  const int tid = TIDX, lane = tid & 63, w8 = tid >> 6, qg = w8 & 3, hp = w8 >> 2, fr = lane & 15, fq = lane >> 4;
  const size_t tokb = (size_t)b * SEQ;
  const int t = c * 64 + 16 * qg + fr;
  const bf16_t* zq = z + (tokb + t) * LDZ;
  const int hb = g * 4 + hp * 2;
  bf16x8 Qf[2][2];
#pragma unroll
  for (int r = 0; r < 2; ++r)
#pragma unroll
    for (int ks = 0; ks < 2; ++ks) Qf[r][ks] = *(const bf16x8*)(zq + ZC_Q + g * 256 + (hp * 2 + r) * 64 + ks * 32 + 8 * fq);
  float* impw = (float*)(lds + NSA_IMP) + (hp * 4 + qg) * (16 * 65);
  for (int i = lane; i < 16 * 65; i += 64) impw[i] = 0.f;
  f32x4 O[4][2];
  float m[2], l[2], inv[2];
  bf16_t* yo = y + (tokb + t) * 1024 + 512 + g * 256 + hp * 128 + 4 * fq;
  const bf16_t* kc = kcv + (size_t)((0 * 8 + b) * 2 + g) * 256 * 64;
  const bf16_t* vc = kcv + (size_t)((1 * 8 + b) * 2 + g) * 256 * 64;
  const int nct = ((4 * c + 2) >> 6) + 1;
  NSA_RESET();
  inv[0] = 0.f; inv[1] = 0.f;
  nsa_branch<0>(0, nct, 0ull, kc, vc, 64, t, hp * 2, 0ull, Qf, O, m, l, inv, impw, lds);
#pragma unroll
  for (int r = 0; r < 2; ++r) { float lt = l[r]; lt += __shfl_xor(lt, 16); lt += __shfl_xor(lt, 32); inv[r] = lt > 0.f ? 1.f / lt : 0.f; }
  nsa_branch<1>(0, nct, 0ull, kc, vc, 64, t, hp * 2, 0ull, Qf, O, m, l, inv, impw, lds);
#pragma unroll
  for (int r = 0; r < 2; ++r) {
    const float gt = sigm(bf2f(zq[ZC_GC + hb + r]));
#pragma unroll
    for (int df = 0; df < 4; ++df) { u32x2 o; o.x = pk2(O[df][r][0] * gt, O[df][r][1] * gt); o.y = pk2(O[df][r][2] * gt, O[df][r][3] * gt); *(u32x2*)(yo + r * 64 + df * 16) = o; }
  }
  __syncthreads();
  u64 wU = 0ull;
  {
    const float* imp0 = (const float*)(lds + NSA_IMP) + qg * (16 * 65);
    const float* imp1 = imp0 + 4 * (16 * 65);
    u64* MK = (u64*)(lds + NSA_WU) + 8;
    const u64 V = (c >= 63) ? ~0ull : ((1ull << (c + 1)) - 1ull);
    const bool forced = (lane == 0) | (lane == c) | (lane == c - 1);
    for (int q8 = 0; q8 < 8; ++q8) {
      const int qq = hp * 8 + q8;
      const float sv = imp0[qq * 65 + lane] + imp1[qq * 65 + lane];
      const unsigned u = __float_as_uint(forced ? 1e4f : sv);
      u64 mk = V;
      if (c + 1 > 16) {
        unsigned thr = 0u;
        for (int bb = 30; bb >= 0; --bb) { const unsigned cand = thr | (1u << bb); const u64 ge = __ballot(u >= cand) & V; if (__popcll(ge) >= 16) thr = cand; }
        const u64 G = __ballot(u > thr) & V, E = __ballot(u == thr) & V;
        const int need = 16 - (int)__popcll(G);
        const int below = (int)__popcll(E & ((1ull << lane) - 1ull));
        const bool se = (((E >> lane) & 1ull) != 0ull) && (below < need);
        mk = G | __ballot(se);
      }
      if (lane == 0) MK[qg * 16 + qq] = mk;
      wU |= mk;
    }
  }
  u64* WU = (u64*)(lds + NSA_WU);
  if (lane == 0) WU[w8] = wU;
  __syncthreads();
  const u64 U = WU[0] | WU[1] | WU[2] | WU[3] | WU[4] | WU[5] | WU[6] | WU[7];
  const u64 mymask = ((const u64*)(lds + NSA_WU) + 8)[qg * 16 + fr];
  for (int br = 0; br < 2; ++br) {
    NSA_RESET();
    int zg;
    if (br == 0) {
      nsa_branch<2>(0, 0, U, z + tokb * LDZ + ZC_KS + g * 64, z + tokb * LDZ + ZC_VS + g * 64, LDZ, t, hp * 2, mymask, Qf, O, m, l, inv, impw, lds);
      zg = ZC_GS;
    } else {
      const int kt0 = c > 8 ? c - 8 : 0;
      nsa_branch<3>(kt0, c - kt0 + 1, 0ull, z + tokb * LDZ + ZC_KW + g * 64, z + tokb * LDZ + ZC_VW + g * 64, LDZ, t, hp * 2, 0ull, Qf, O, m, l, inv, impw, lds);
      zg = ZC_GW;
    }
#pragma unroll
    for (int r = 0; r < 2; ++r) {
      float lt = l[r]; lt += __shfl_xor(lt, 16); lt += __shfl_xor(lt, 32);
      const float gt = sigm(bf2f(zq[zg + hb + r])) * (lt > 0.f ? 1.f / lt : 0.f);
#pragma unroll
      for (int df = 0; df < 4; ++df) {
        bf16_t* yp = yo + r * 64 + df * 16;
        const u32x2 pr = *(const u32x2*)yp;
        u32x2 o; o.x = pk2(__uint_as_float(pr.x << 16) + O[df][r][0] * gt, __uint_as_float(pr.x & 0xffff0000u) + O[df][r][1] * gt);
        o.y = pk2(__uint_as_float(pr.y << 16) + O[df][r][2] * gt, __uint_as_float(pr.y & 0xffff0000u) + O[df][r][3] * gt);
        *(u32x2*)yp = o;
      }
    }
  }
  __syncthreads();
}

__device__ __forceinline__ void run_phase(const Params& P, int ph, char* lds) {
  char* ws = P.ws;
  bf16_t* abuf = (bf16_t*)(ws + OFF_A);
  bf16_t* big = (bf16_t*)(ws + OFF_BIG);
  bf16_t* fbuf = (bf16_t*)(ws + OFF_F);
  bf16_t* h16 = (bf16_t*)(ws + OFF_F + (size_t)M_TOK * 1024 * 2);
  float* hsl = (float*)(ws + OFF_F); float* Pc = hsl + (size_t)M_TOK * 256;
  bf16_t* kcv = (bf16_t*)(ws + OFF_KC);
  float* carryP = (float*)(ws + OFF_CARRY); float* carryH = carryP + 8 * 4 * 64 * 64;
  if (ph == 0) { prep_phase(P, lds); return; }
  const int layer = (ph - 1) / 13, sp = (ph - 1) % 13;
  const float* ng = P.norm_g + (size_t)layer * 8 * 1024;
#ifdef ONLY_SP
  if (sp != ONLY_SP) return;
#endif
  switch (sp) {
    case 0: case 8: {
      const int lj = layer * 2 + (sp == 8);
      gemm_up_phase(abuf, (const bf16_t*)(ws + OFF_WGU + lj * SZ_WGU), big, lds);
    } break;
    case 1: case 9: {
      const int lj = layer * 2 + (sp == 9);
      gemm_bf16_phase(big, DFF, (const bf16_t*)(ws + OFF_WD + lj * SZ_WD), DFF, 4, fbuf, 1024, lds);
    } break;
    case 2: resnorm_phase(layer == 0 ? P.x : nullptr, h16, nullptr, h16, fbuf, 0.5f, ng + 1 * 1024, ng + 2 * 1024, abuf); break;
    case 3:
      if (layer == 0 && blockIdx.x < 4) {
        const int t3 = TIDX;
        if (t3 < 128) { const float* pp_ = (const float*)(ws + OFF_CB1P) + (size_t)blockIdx.x * 16 * 128 + t3; float t = P.cmp_b1[blockIdx.x * 128 + t3];
          for (int q = 0; q < 16; ++q) t += pp_[q * 128]; ((float*)(ws + OFF_CB1))[blockIdx.x * 128 + t3] = t; }
      }
      gemm_bf16_phase(abuf, 1024, (const bf16_t*)(ws + OFF_WIN + layer * SZ_WIN), 1024, LDZ / 256, big, LDZ, lds); break;
    case 4: {
      const int hb = HBLK; char* hl = lds + hb * 65536;
      for (int it = blockIdx.x * 2 + hb; it < 512; it += gridDim.x * 2) compress_item(P, layer, it, big, kcv, hl);
      for (int it = blockIdx.x * 2 + hb; it < 1024; it += gridDim.x * 2) mixA_item(P, layer, it, big, abuf, hl);
      for (int it = blockIdx.x * 2 + hb; it < 2048; it += gridDim.x * 2) mixB1_item(P, layer, it, big, hsl, Pc, carryP, carryH, hl);
    } break;
    case 5: {
      nsa_tables(P, blockIdx.x & 1, lds);
      for (int it = blockIdx.x; it < 1024; it += gridDim.x) {
        const int rnd = it / 256, pos = it % 256;
        const int c = (rnd & 1) ? (rnd >> 1) * 16 + (pos >> 4) : 63 - (rnd >> 1) * 16 - (pos >> 4);
        const int bg = pos & 15;
        nsa_item(P, bg >> 1, bg & 1, c, big, kcv, abuf, lds);
      }
      const int hb = HBLK;
      for (int it = blockIdx.x * 2 + hb; it < 2048; it += gridDim.x * 2) mixB2_item(it, big, hsl, Pc, carryP, carryH, abuf);
    } break;
    case 6: gemm_bf16_phase(abuf, 1024, (const bf16_t*)(ws + OFF_WOUT + layer * SZ_SQ), 1024, 4, fbuf, 1024, lds); break;
    case 7: resnorm_phase(nullptr, h16, nullptr, h16, fbuf, 1.0f, ng + 3 * 1024, ng + 4 * 1024, abuf); break;
    case 10:
      gemm_bf16_phase((const bf16_t*)(ws + OFF_PBF) + (size_t)layer * M_TOK * 256, 256, (const bf16_t*)(ws + OFF_WPP + layer * SZ_WPP), 256, 4, big, 1024, lds);
      resnorm_phase(nullptr, h16, nullptr, h16, fbuf, 0.5f, ng + 5 * 1024, ng + 6 * 1024, abuf);
      break;
    case 11: gemm_ple_phase(abuf, (const bf16_t*)(ws + OFF_WPG + layer * SZ_SQ), big, fbuf, lds); break;
    case 12: resnorm_phase(nullptr, h16, layer == 0 ? nullptr : P.out, layer == 0 ? h16 : nullptr, fbuf, 1.0f, ng + 7 * 1024, layer == 0 ? P.norm_g + 8 * 1024 : nullptr, layer == 0 ? abuf : nullptr); break;
  }
}

#define XB_TMO      128
#define XB_XCNT(j)  (256  + 64 * (j))
#define XB_XSUB(j)  (1280 + 64 * (j))
#define XB_XGEN(j)  (2304 + 64 * (j))
#define XB_TOP      3328
#define XB_TOPGEN   3392
#define XCD_BAR_WORDS 3456
#define XB_SPIN_CAP (1u << 20)
#define LAS __attribute__((address_space(3)))
__device__ __forceinline__ unsigned xb_ld(unsigned* p)              { return __hip_atomic_load(p, __ATOMIC_RELAXED, __HIP_MEMORY_SCOPE_AGENT); }
__device__ __forceinline__ unsigned xb_add(unsigned* p, unsigned v) { return __hip_atomic_fetch_add(p, v, __ATOMIC_RELAXED, __HIP_MEMORY_SCOPE_AGENT); }
__device__ __forceinline__ unsigned xb_xcc_id() { return (unsigned)__builtin_amdgcn_s_getreg((3 << 11) | 20) & 0xFu; }
#define XB_SPIN(cond, bar) do { unsigned _sp = 0; while (cond) { __builtin_amdgcn_s_sleep(1); \
    if ((++_sp & 255u) == 0u) { if (xb_ld(&(bar)[XB_TMO])) break; if (_sp > XB_SPIN_CAP) { atomicAdd(&(bar)[XB_TMO], 1u); break; } } } } while (0)
struct XcdBarrier { unsigned* bar; unsigned x; volatile LAS unsigned* st; };
__device__ __forceinline__ XcdBarrier xcd_barrier_post(unsigned* bar, volatile LAS unsigned* st) {
    XcdBarrier b; b.bar = bar; b.x = xb_xcc_id(); b.st = st;
    if (threadIdx.x == 0) (void)xb_add(&bar[XB_XCNT(b.x)], 1u);
    return b;
}
__device__ __forceinline__ void xcd_barrier_complete(unsigned* bar, unsigned x, unsigned& nloc, unsigned& nx) {
    const unsigned G = gridDim.x * gridDim.y * gridDim.z;
    unsigned sum, cnt, mine, sp = 0u;
    for (;;) {
        sum = 0u; cnt = 0u; mine = 0u;
#pragma unroll
        for (unsigned j = 0; j < 16; ++j) { const unsigned c = xb_ld(&bar[XB_XCNT(j)]); sum += c; cnt += (c > 0u) ? 1u : 0u; mine = (j == x) ? c : mine; }
        if (sum == G) break;
        __builtin_amdgcn_s_sleep(1);
        if ((++sp & 255u) == 0u) { if (xb_ld(&bar[XB_TMO])) break; if (sp > XB_SPIN_CAP) { atomicAdd(&bar[XB_TMO], 1u); break; } }
    }
    nloc = mine > 0u ? mine : 1u; nx = cnt > 0u ? cnt : 1u;
}
__device__ __forceinline__ void xcd_barrier(const XcdBarrier& b) {
    asm volatile("s_waitcnt vmcnt(0)" ::: "memory");
    __syncthreads();
    if (threadIdx.x == 0) {
        unsigned* bar = b.bar;
        __builtin_amdgcn_s_waitcnt(0);
        unsigned nloc = b.st[0], nx = b.st[1];
        if (nloc == 0u) { xcd_barrier_complete(bar, b.x, nloc, nx); b.st[0] = nloc; b.st[1] = nx; }
        const unsigned old = xb_add(&bar[XB_XSUB(b.x)], 1u);
        const unsigned gen = old / nloc;
        if (old + 1u == (gen + 1u) * nloc) {
            __builtin_amdgcn_fence(__ATOMIC_RELEASE, "agent");
            asm volatile("s_waitcnt vmcnt(0)" ::: "memory");
            const unsigned og = xb_add(&bar[XB_TOP], 1u);
            const unsigned tg = og / nx;
            if (og + 1u == (tg + 1u) * nx) xb_add(&bar[XB_TOPGEN], 1u);
            else XB_SPIN(xb_ld(&bar[XB_TOPGEN]) == tg, bar);
            __builtin_amdgcn_fence(__ATOMIC_ACQUIRE, "agent");
            xb_add(&bar[XB_XGEN(b.x)], 1u);
            asm volatile("s_waitcnt vmcnt(0)" ::: "memory");
        } else {
            XB_SPIN(xb_ld(&bar[XB_XGEN(b.x)]) == gen, bar);
            __builtin_amdgcn_fence(__ATOMIC_ACQUIRE, "agent");
            asm volatile("s_waitcnt vmcnt(0)" ::: "memory");
        }
    }
    __syncthreads();
}

constexpr int LDS_BYTES = LDS_ST + 16;
__global__ void __launch_bounds__(512, 2) fwd_megakernel(Params P) {
  __shared__ __attribute__((aligned(16))) char lds[LDS_BYTES];
  cg::grid_group grid = cg::this_grid();
  volatile LAS unsigned* st = (volatile LAS unsigned*)(lds + LDS_ST);
  if (threadIdx.x == 0) { st[0] = 0u; st[1] = 0u; }
  __syncthreads();
  XcdBarrier xb = xcd_barrier_post((unsigned*)(P.ws + OFF_BAR), st);
  if (P.ws == nullptr) grid.sync();
  for (int ph = 0; ph < NPHASE; ++ph) {
    run_phase(P, ph, lds);
    if (ph + 1 < NPHASE) xcd_barrier(xb);
  }
}

__global__ void __launch_bounds__(512, 2) phase_kernel(Params P, int ph) {
  __shared__ __attribute__((aligned(16))) char lds[LDS_BYTES];
  run_phase(P, ph, lds);
}

extern "C" void kernel_launch(void* const* d_in, const int* in_sizes, int n_in, void* d_out, int out_size, void* d_ws, size_t ws_size, hipStream_t stream) {
  Params P{};
  const float** pp = (const float**)&P;
  for (int i = 0; i < 26; ++i) pp[i] = (const float*)d_in[i];
  P.out = (float*)d_out;
  P.ws = (char*)d_ws;
  if (ws_size < WS_NEED) { fprintf(stderr, "workspace too small: %zu < %zu\n", ws_size, (size_t)WS_NEED); return; }
#if MK_FUSED
  static int grid_blocks = 0;
  if (!grid_blocks) {
    int dev = 0, cus = 0, per_cu = 0;
    (void)hipGetDevice(&dev);
    (void)hipDeviceGetAttribute(&cus, hipDeviceAttributeMultiprocessorCount, dev);
    (void)hipOccupancyMaxActiveBlocksPerMultiprocessor(&per_cu, fwd_megakernel, 512, 0);
    if (per_cu > 1) per_cu = 1;
    if (per_cu < 1) per_cu = 1;
    grid_blocks = cus * per_cu;
  }
  (void)hipMemsetAsync((char*)d_ws + OFF_BAR, 0, XCD_BAR_WORDS * 4, stream);
  void* args[] = {&P};
  hipError_t e = hipLaunchCooperativeKernel((void*)fwd_megakernel, dim3(grid_blocks), dim3(512), args, 0, stream);
  if (e != hipSuccess) fprintf(stderr, "cooperative launch failed: %s (grid %d)\n", hipGetErrorString(e), grid_blocks);
#else
  for (int ph = 0; ph < NPHASE; ++ph) phase_kernel<<<256, 512, 0, stream>>>(P, ph);
#endif
}
```

```cpp
#include <hip/hip_runtime.h>
#include <hip/hip_cooperative_groups.h>
#include <cstdint>
#include <cstdio>
namespace cg = cooperative_groups;

#ifndef MK_FUSED
#define MK_FUSED 1
#endif

typedef unsigned short bf16_t;
typedef short bf16x8 __attribute__((ext_vector_type(8)));
typedef short bf16x4 __attribute__((ext_vector_type(4)));
typedef float f32x4 __attribute__((ext_vector_type(4)));
typedef unsigned long long u64;
typedef unsigned u32x4 __attribute__((ext_vector_type(4)));
typedef unsigned u32x2 __attribute__((ext_vector_type(2)));

constexpr int M_TOK = 32768, DM = 1024, DFF = 2816, NGU = 5632, NIN = 2328, LDZ = 2560, SEQ = 4096;
constexpr int NPHASE = 27;
constexpr int ZC_AU = 0, ZC_AV = 256, ZC_BX = 512, ZC_BG = 768, ZC_Q = 1024, ZC_KC = 1536, ZC_VC = 1664, ZC_KS = 1792, ZC_VS = 1920,
              ZC_KW = 2048, ZC_VW = 2176, ZC_GC = 2304, ZC_GS = 2312, ZC_GW = 2320;

constexpr size_t SZ_WGU = (size_t)NGU * 1024 * 2, SZ_WD = (size_t)1024 * DFF * 2, SZ_WIN = (size_t)LDZ * 1024 * 2, SZ_SQ = (size_t)1024 * 1024 * 2,
                 SZ_WPP = (size_t)1024 * 256 * 2, SZ_CW1 = (size_t)128 * 2048 * 2;
constexpr size_t OFF_WGU = 0;
constexpr size_t OFF_WD = OFF_WGU + 4 * SZ_WGU;
constexpr size_t OFF_WIN = OFF_WD + 4 * SZ_WD;
constexpr size_t OFF_WOUT = OFF_WIN + 2 * SZ_WIN;
constexpr size_t OFF_WPG = OFF_WOUT + 2 * SZ_SQ;
constexpr size_t OFF_WPP = OFF_WPG + 2 * SZ_SQ;
constexpr size_t OFF_CW1 = OFF_WPP + 2 * SZ_WPP;
constexpr size_t OFF_CB1 = OFF_CW1 + 4 * SZ_CW1;
constexpr size_t OFF_SGUW = OFF_CB1 + 4096;
constexpr size_t OFF_WAT = OFF_SGUW + 2 * 4 * 128 * 128 * 2;
constexpr size_t OFF_WXT = OFF_WAT + 2 * 4 * 64 * 64 * 2;
constexpr size_t OFF_PBF = OFF_WXT + 2 * 4 * 64 * 64 * 2;
constexpr size_t OFF_A = OFF_PBF + (size_t)2 * M_TOK * 256 * 2;
constexpr size_t OFF_BIG = OFF_A + (size_t)M_TOK * 1024 * 2;
constexpr size_t OFF_F = OFF_BIG + (size_t)M_TOK * DFF * 2;
constexpr size_t OFF_KC = OFF_F + (size_t)M_TOK * 1024 * 4;
constexpr size_t OFF_CARRY = OFF_KC + (size_t)2 * 8 * 2 * 256 * 64 * 2;
constexpr size_t OFF_BAR = OFF_CARRY + (size_t)2 * 8 * 4 * 64 * 64 * 4;
constexpr size_t OFF_CB1P = OFF_BAR + 16384;
constexpr size_t WS_NEED = OFF_CB1P + 32768;

struct Params {
  const float *x, *p, *rel_bias, *norm_g, *ffn_wg, *ffn_wu, *ffn_wd, *w_in, *w_out, *sgu_ng, *sgu_w, *sgu_b, *conv_w, *conv_b,
      *lru_wa, *lru_ba, *lru_wx, *lru_bx, *lru_lam, *cmp_pos, *cmp_w1, *cmp_b1, *cmp_w2, *cmp_b2, *ple_wg, *ple_wp;
  float* out;
  char* ws;
};

__device__ __forceinline__ int opaque_tid() { int t; asm volatile("v_mov_b32 %0, %1" : "=v"(t) : "v"(threadIdx.x)); return t; }
#define TIDX opaque_tid()
#define HTID (opaque_tid() & 255)
#define HBLK (opaque_tid() >> 8)
__device__ __forceinline__ float bf2f(bf16_t v) { return __uint_as_float(((unsigned)v) << 16); }
__device__ __forceinline__ bf16_t f2bf(float f) { unsigned u = __float_as_uint(f); u += 0x7fffu + ((u >> 16) & 1u); return (bf16_t)(u >> 16); }
typedef float f32x2v __attribute__((ext_vector_type(2)));
typedef __bf16 bf16x2v __attribute__((ext_vector_type(2)));
__device__ __forceinline__ unsigned pk2(float lo, float hi) { const f32x2v v = {lo, hi}; const bf16x2v r = __builtin_convertvector(v, bf16x2v); return __builtin_bit_cast(unsigned, r); }
__device__ __forceinline__ float sigm(float x) { return __builtin_amdgcn_rcpf(1.f + __expf(-x)); }
__device__ __forceinline__ float gelu_t(float x) { float u = 0.7978845608028654f * (x + 0.044715f * x * x * x); return x * __builtin_amdgcn_rcpf(1.f + __expf(-2.f * u)); }
__device__ __forceinline__ float silu_f(float x) { return x * __builtin_amdgcn_rcpf(1.f + __expf(-x)); }
__device__ __forceinline__ f32x4 mfma16(bf16x8 a, bf16x8 b, f32x4 c) { return __builtin_amdgcn_mfma_f32_16x16x32_bf16(a, b, c, 0, 0, 0); }
__device__ __forceinline__ void glds16(const void* g, void* l) {
  __builtin_amdgcn_global_load_lds((const __attribute__((address_space(1))) unsigned*)g, (__attribute__((address_space(3))) unsigned*)l, 16, 0, 0);
}
__device__ __forceinline__ f32x4 zero4() { f32x4 z; asm volatile("v_mov_b32 %0, 0\n\tv_mov_b32 %1, 0\n\tv_mov_b32 %2, 0\n\tv_mov_b32 %3, 0" : "=v"(z[0]), "=v"(z[1]), "=v"(z[2]), "=v"(z[3])); return z; }
__device__ __forceinline__ float wave_sum(float v) {
#pragma unroll
  for (int o = 32; o > 0; o >>= 1) v += __shfl_xor(v, o);
  return v;
}
__device__ __forceinline__ void unpack8(const u32x4 u, float* f) {
  f[0] = __uint_as_float(u.x << 16); f[1] = __uint_as_float(u.x & 0xffff0000u);
  f[2] = __uint_as_float(u.y << 16); f[3] = __uint_as_float(u.y & 0xffff0000u);
  f[4] = __uint_as_float(u.z << 16); f[5] = __uint_as_float(u.z & 0xffff0000u);
  f[6] = __uint_as_float(u.w << 16); f[7] = __uint_as_float(u.w & 0xffff0000u);
}

__device__ __forceinline__ void tr_cvt(const float* __restrict__ src, int N, int K, bf16_t* __restrict__ dst, int ldd, int rs, int ro, char* ldsc, int& rot) {
  const int ntn = (N + 63) >> 6, nt = ntn * (K >> 6), hb = HBLK, tid = HTID;
  float* lds = (float*)(ldsc + hb * 65536);
  int vb = (int)blockIdx.x - rot; if (vb < 0) vb += gridDim.x;
  rot = (rot + (nt + 5) / 6) % (int)gridDim.x;
  for (int t0 = vb * 6; t0 < nt; t0 += gridDim.x * 6) {
    float4 v[3][4];
#pragma unroll
    for (int u = 0; u < 3; ++u) {
      const int tile = t0 + hb * 3 + u, tk = tile / ntn, tn = tile - tk * ntn, k0 = tk * 64, n0 = tn * 64;
      const bool active = tile < nt;
#pragma unroll
      for (int ps = 0; ps < 4; ++ps) {
        const int i = ps * 16 + (tid >> 4), j = (tid & 15) * 4;
        v[u][ps] = make_float4(0.f, 0.f, 0.f, 0.f);
        if (active && n0 + j < N) v[u][ps] = *(const float4*)(src + (size_t)(k0 + i) * N + n0 + j);
      }
    }
#pragma unroll
    for (int u = 0; u < 3; ++u)
#pragma unroll
      for (int ps = 0; ps < 4; ++ps) {
        const int i = ps * 16 + (tid >> 4), j = (tid & 15) * 4;
        float* d = lds + u * 4160 + i * 65 + j; d[0] = v[u][ps].x; d[1] = v[u][ps].y; d[2] = v[u][ps].z; d[3] = v[u][ps].w;
      }
    __syncthreads();
#pragma unroll
    for (int u = 0; u < 3; ++u) {
      const int tile = t0 + hb * 3 + u, tk = tile / ntn, tn = tile - tk * ntn, k0 = tk * 64, n0 = tn * 64;
      const int j = tid >> 2, kq = tid & 3, n = n0 + j;
      if (tile < nt && n < N) {
        const float* l = lds + u * 4160;
        unsigned w[8];
#pragma unroll
        for (int q = 0; q < 8; ++q) w[q] = pk2(l[(kq * 16 + 2 * q) * 65 + j], l[(kq * 16 + 2 * q + 1) * 65 + j]);
        bf16_t* o = dst + (size_t)((n >> 4) * rs + (n & 15) + ro) * ldd + k0 + kq * 16;
        u32x4 w0, w1; w0.x = w[0]; w0.y = w[1]; w0.z = w[2]; w0.w = w[3]; w1.x = w[4]; w1.y = w[5]; w1.z = w[6]; w1.w = w[7];
        *(u32x4*)o = w0; *(u32x4*)(o + 8) = w1;
      }
    }
    __syncthreads();
  }
}

struct RowRegs { float4 h[4]; u32x2 f[4]; };
__device__ __forceinline__ void rn_load(RowRegs& R, const float* hin32, const bf16_t* hin16, const bf16_t* f, int row, int lane) {
  if (hin32) {
#pragma unroll
    for (int i = 0; i < 4; ++i) R.h[i] = *(const float4*)(hin32 + (size_t)row * 1024 + i * 256 + lane * 4);
  } else {
#pragma unroll
    for (int i = 0; i < 4; ++i) { const u32x2 v = *(const u32x2*)(hin16 + (size_t)row * 1024 + i * 256 + lane * 4);
      R.h[i].x = __uint_as_float(v.x << 16); R.h[i].y = __uint_as_float(v.x & 0xffff0000u); R.h[i].z = __uint_as_float(v.y << 16); R.h[i].w = __uint_as_float(v.y & 0xffff0000u); }
  }
  if (f) {
#pragma unroll
    for (int i = 0; i < 4; ++i) R.f[i] = *(const u32x2*)(f + (size_t)row * 1024 + i * 256 + lane * 4);
  }
}
__device__ __forceinline__ void rn_proc(RowRegs& R, float* hout32, bf16_t* hout16, bool has_f, float scale, const float4 (&gpo)[4], const float4 (&gpr)[4], bf16_t* a, int row, int lane) {
  if (has_f) {
    float fv[4][4]; float ss = 0.f;
#pragma unroll
    for (int i = 0; i < 4; ++i) {
      fv[i][0] = __uint_as_float(R.f[i].x << 16); fv[i][1] = __uint_as_float(R.f[i].x & 0xffff0000u);
      fv[i][2] = __uint_as_float(R.f[i].y << 16); fv[i][3] = __uint_as_float(R.f[i].y & 0xffff0000u);
      ss += fv[i][0] * fv[i][0] + fv[i][1] * fv[i][1] + fv[i][2] * fv[i][2] + fv[i][3] * fv[i][3];
    }
    ss = wave_sum(ss);
    const float r = rsqrtf(ss * (1.f / 1024.f) + 1e-6f) * scale;
#pragma unroll
    for (int i = 0; i < 4; ++i) { const float4 g = gpo[i];
      R.h[i].x += fv[i][0] * r * g.x; R.h[i].y += fv[i][1] * r * g.y; R.h[i].z += fv[i][2] * r * g.z; R.h[i].w += fv[i][3] * r * g.w; }
  }
  if (hout32) {
#pragma unroll
    for (int i = 0; i < 4; ++i) *(float4*)(hout32 + (size_t)row * 1024 + i * 256 + lane * 4) = R.h[i];
  }
  if (hout16) {
#pragma unroll
    for (int i = 0; i < 4; ++i) { u32x2 o; o.x = pk2(R.h[i].x, R.h[i].y); o.y = pk2(R.h[i].z, R.h[i].w); *(u32x2*)(hout16 + (size_t)row * 1024 + i * 256 + lane * 4) = o; }
  }
  if (a) {
    float ss = 0.f;
#pragma unroll
    for (int i = 0; i < 4; ++i) ss += R.h[i].x * R.h[i].x + R.h[i].y * R.h[i].y + R.h[i].z * R.h[i].z + R.h[i].w * R.h[i].w;
    ss = wave_sum(ss);
    const float r = rsqrtf(ss * (1.f / 1024.f) + 1e-6f);
#pragma unroll
    for (int i = 0; i < 4; ++i) { const float4 g = gpr[i];
      u32x2 o; o.x = pk2(R.h[i].x * r * g.x, R.h[i].y * r * g.y); o.y = pk2(R.h[i].z * r * g.z, R.h[i].w * r * g.w);
      *(u32x2*)(a + (size_t)row * 1024 + i * 256 + lane * 4) = o; }
  }
}
__device__ __forceinline__ void resnorm_phase(const float* hin32, const bf16_t* hin16, float* hout32, bf16_t* hout16, const bf16_t* f, float scale, const float* gpost, const float* gpre, bf16_t* a) {
  const int tid = TIDX, lane = tid & 63, stride = gridDim.x * 8;
  int r0 = blockIdx.x * 8 + (tid >> 6), r1 = r0 + 2 * stride;
  RowRegs A0, A1, B0, B1;
  float4 gpo[4], gpr[4];
#pragma unroll
  for (int i = 0; i < 4; ++i) { gpo[i] = f ? *(const float4*)(gpost + i * 256 + lane * 4) : make_float4(0.f, 0.f, 0.f, 0.f); gpr[i] = a ? *(const float4*)(gpre + i * 256 + lane * 4) : make_float4(0.f, 0.f, 0.f, 0.f); }
  const bool hf = f != nullptr;
  if (r0 < M_TOK) { rn_load(A0, hin32, hin16, f, r0, lane); rn_load(A1, hin32, hin16, f, r0 + stride, lane); }
  for (;;) {
    if (r0 >= M_TOK) break;
    if (r1 < M_TOK) { rn_load(B0, hin32, hin16, f, r1, lane); rn_load(B1, hin32, hin16, f, r1 + stride, lane); }
    rn_proc(A0, hout32, hout16, hf, scale, gpo, gpr, a, r0, lane); rn_proc(A1, hout32, hout16, hf, scale, gpo, gpr, a, r0 + stride, lane);
    r0 += 4 * stride;
    if (r1 >= M_TOK) break;
    if (r0 < M_TOK) { rn_load(A0, hin32, hin16, f, r0, lane); rn_load(A1, hin32, hin16, f, r0 + stride, lane); }
    rn_proc(B0, hout32, hout16, hf, scale, gpo, gpr, a, r1, lane); rn_proc(B1, hout32, hout16, hf, scale, gpo, gpr, a, r1 + stride, lane);
    r1 += 4 * stride;
  }
}

__device__ __forceinline__ void prep_phase(const Params& P, char* ldsc) {
  char* ws = P.ws;
  int rot = 0;
  for (int l = 0; l < 2; ++l) {
    for (int j = 0; j < 2; ++j) {
      const int lj = l * 2 + j;
      bf16_t* wgu = (bf16_t*)(ws + OFF_WGU + lj * SZ_WGU);
      tr_cvt(P.ffn_wg + (size_t)lj * 1024 * DFF, DFF, 1024, wgu, 1024, 32, 0, ldsc, rot);
      tr_cvt(P.ffn_wu + (size_t)lj * 1024 * DFF, DFF, 1024, wgu, 1024, 32, 16, ldsc, rot);
      tr_cvt(P.ffn_wd + (size_t)lj * DFF * 1024, 1024, DFF, (bf16_t*)(ws + OFF_WD + lj * SZ_WD), DFF, 16, 0, ldsc, rot);
      tr_cvt(P.cmp_w1 + (size_t)lj * 2048 * 128, 128, 2048, (bf16_t*)(ws + OFF_CW1 + lj * SZ_CW1), 2048, 16, 0, ldsc, rot);
    }
    tr_cvt(P.w_in + (size_t)l * 1024 * NIN, NIN, 1024, (bf16_t*)(ws + OFF_WIN + l * SZ_WIN), 1024, 16, 0, ldsc, rot);
    tr_cvt(P.w_out + (size_t)l * 1024 * 1024, 1024, 1024, (bf16_t*)(ws + OFF_WOUT + l * SZ_SQ), 1024, 16, 0, ldsc, rot);
    tr_cvt(P.ple_wg + (size_t)l * 1024 * 1024, 1024, 1024, (bf16_t*)(ws + OFF_WPG + l * SZ_SQ), 1024, 16, 0, ldsc, rot);
    tr_cvt(P.ple_wp + (size_t)l * 256 * 1024, 1024, 256, (bf16_t*)(ws + OFF_WPP + l * SZ_WPP), 256, 16, 0, ldsc, rot);
    for (int g = 0; g < 4; ++g) {
      tr_cvt(P.lru_wa + (size_t)(l * 4 + g) * 4096, 64, 64, (bf16_t*)(ws + OFF_WAT) + (l * 4 + g) * 4096, 64, 16, 0, ldsc, rot);
      tr_cvt(P.lru_wx + (size_t)(l * 4 + g) * 4096, 64, 64, (bf16_t*)(ws + OFF_WXT) + (l * 4 + g) * 4096, 64, 16, 0, ldsc, rot);
    }
  }
  const int tid = TIDX, gtid = blockIdx.x * 512 + tid, gn = gridDim.x * 512;
  for (int i = gtid; i < 2 * (LDZ - NIN) * 1024 / 8; i += gn) {
    const int l = i / ((LDZ - NIN) * 128), r = i - l * ((LDZ - NIN) * 128);
    *(f32x4*)((bf16_t*)(ws + OFF_WIN + l * SZ_WIN) + (size_t)NIN * 1024 + (size_t)r * 8) = zero4();
  }
  for (int i = gtid; i < 2 * 4 * 128 * 128; i += gn) { const int t = (i >> 7) & 127, s2 = i & 127; ((bf16_t*)(ws + OFF_SGUW))[i] = (s2 <= t) ? f2bf(P.sgu_w[i]) : (bf16_t)0; }
  for (int i = gtid; i < 2 * M_TOK * 256 / 4; i += gn) { const float4 v = ((const float4*)P.p)[i]; uint2 o; o.x = pk2(v.x, v.y); o.y = pk2(v.z, v.w); ((uint2*)(ws + OFF_PBF))[i] = o; }
  {
    float* lds = (float*)(ldsc + HBLK * 65536);
    for (int u = blockIdx.x; u < 64; u += gridDim.x) {
      const int t2 = HTID, kq = t2 >> 5, jq = t2 & 31, lkv = u >> 4, kc = u & 15;
      const float* w1 = P.cmp_w1 + (size_t)lkv * 2048 * 128; const float* pos = P.cmp_pos + (size_t)lkv * 2048;
      float4 sacc = make_float4(0.f, 0.f, 0.f, 0.f);
#pragma unroll
      for (int kk = 0; kk < 16; ++kk) { const int k = kc * 128 + kq * 16 + kk; const float pv = pos[k]; const float4 w = *(const float4*)(w1 + (size_t)k * 128 + jq * 4); sacc.x += pv * w.x; sacc.y += pv * w.y; sacc.z += pv * w.z; sacc.w += pv * w.w; }
      __syncthreads();
      lds[kq * 128 + jq * 4 + 0] = sacc.x; lds[kq * 128 + jq * 4 + 1] = sacc.y; lds[kq * 128 + jq * 4 + 2] = sacc.z; lds[kq * 128 + jq * 4 + 3] = sacc.w;
      __syncthreads();
      if (t2 < 128) { float t = 0.f; for (int q = 0; q < 8; ++q) t += lds[q * 128 + t2]; ((float*)(ws + OFF_CB1P))[u * 128 + t2] = t; }
      __syncthreads();
    }
  }
  resnorm_phase(P.x, nullptr, nullptr, nullptr, nullptr, 0.f, nullptr, P.norm_g, (bf16_t*)(ws + OFF_A));
}

constexpr int G8_HT = 128 * 64;
__device__ __forceinline__ int g8_lds_byte(int r, int c) { const int st = (r >> 4) * 2 + (c >> 5), rr = r & 15, cc = c & 31, ob = rr * 64 + cc * 2; return st * 1024 + (ob ^ (((ob >> 9) & 1) << 5)); }
__device__ __forceinline__ void g8_stage_rc(int b, int& R, int& C) { const int st = b / 1024, sb = b % 1024, swz = sb ^ (((sb >> 9) & 1) << 5); R = (st >> 1) * 16 + swz / 64; C = (st & 1) * 32 + (swz % 64) / 2; }

template <bool ISSUE_ONLY, bool PRE_ISSUED>
__device__ __forceinline__ void gemm_core(f32x4 (&acc)[2][2][4][2], const bf16_t* __restrict__ A, int lda, const bf16_t* __restrict__ Bt, int ldb, int K, char* ldsc) {
  bf16_t* shm = (bf16_t*)ldsc;
  const int tid = TIDX, wid = tid >> 6, lane = tid & 63, wr = wid >> 2, wc = wid & 3, fr = lane & 15, fq = lane >> 4;
  int sr0, sc0;
  g8_stage_rc(tid * 16, sr0, sc0);
  const bf16_t* gA0 = A + (size_t)sr0 * lda + sc0;
  const bf16_t* gB0 = Bt + (size_t)sr0 * ldb + sc0;
  const size_t a64 = (size_t)64 * lda, b64 = (size_t)64 * ldb;
  const int lane_off = (fr * 64 + fq * 16) ^ ((((fr * 64 + fq * 16) >> 9) & 1) << 5);
  const char* ldA = ldsc + wr * 8192 + lane_off;
  const char* ldB = ldsc + 65536 + wc * 4096 + lane_off;
#define SA(b, h) (shm + ((b) * 2 + (h)) * G8_HT)
#define SB(b, h) (shm + (4 + (b) * 2 + (h)) * G8_HT)
#define STAGE_A(P, h, kt) { const bf16_t* g_ = gA0 + (size_t)(h) * 2 * a64 + (kt) * 64; glds16(g_, (char*)(P) + tid * 16); glds16(g_ + a64, (char*)(P) + tid * 16 + 8192); }
#define STAGE_B(P, h, kt) { const bf16_t* g_ = gB0 + (size_t)(h) * 2 * b64 + (kt) * 64; glds16(g_, (char*)(P) + tid * 16); glds16(g_ + b64, (char*)(P) + tid * 16 + 8192); }
#define LDA(dst, b, h) _Pragma("unroll") for (int m = 0; m < 4; ++m) _Pragma("unroll") for (int k = 0; k < 2; ++k) \
    dst[m][k] = *reinterpret_cast<const bf16x8*>(ldA + ((b) * 2 + (h)) * 16384 + (m * 2 + k) * 1024)
#define LDB(dst, b, h) _Pragma("unroll") for (int n = 0; n < 2; ++n) _Pragma("unroll") for (int k = 0; k < 2; ++k) \
    dst[n][k] = *reinterpret_cast<const bf16x8*>(ldB + ((b) * 2 + (h)) * 16384 + (n * 2 + k) * 1024)
#define MMA(ai, bj, At_, Bt_) do { __builtin_amdgcn_s_setprio(1); \
    _Pragma("unroll") for (int m = 0; m < 4; ++m) _Pragma("unroll") for (int n = 0; n < 2; ++n) _Pragma("unroll") for (int k = 0; k < 2; ++k) \
      acc[ai][bj][m][n] = mfma16(Bt_[n][k], At_[m][k], acc[ai][bj][m][n]); \
    __builtin_amdgcn_s_setprio(0); } while (0)
#define WAIT_V(n) asm volatile("s_waitcnt vmcnt(" #n ")" ::: "memory")
#define WAIT_L(n) asm volatile("s_waitcnt lgkmcnt(" #n ")" ::: "memory")
#define BAR __builtin_amdgcn_s_barrier()
#define SCHED __builtin_amdgcn_sched_barrier(0)
  bf16x8 At[4][2], B0[2][2], B1[2][2];
  const int nt = K >> 6;
  if (!PRE_ISSUED) {
    STAGE_B(SB(0, 0), 0, 0); STAGE_A(SA(0, 0), 0, 0);
    STAGE_B(SB(0, 1), 1, 0); STAGE_A(SA(0, 1), 1, 0);
  }
  if (ISSUE_ONLY) return;
  if (wr == 1) BAR;
  if (PRE_ISSUED) { WAIT_V(0); } else { WAIT_V(4); }
  BAR;
  STAGE_B(SB(1, 0), 0, 1); STAGE_A(SA(1, 0), 0, 1); STAGE_B(SB(1, 1), 1, 1);
  WAIT_V(6); BAR;
#pragma nounroll
  for (int t = 0; t < nt - 2; t += 2) {
    LDB(B0, 0, 0); SCHED; LDA(At, 0, 0); STAGE_A(SA(1, 1), 1, t + 1);
    WAIT_L(8); BAR; WAIT_L(0); MMA(0, 0, At, B0); BAR; SCHED;
    LDB(B1, 0, 1); STAGE_B(SB(0, 0), 0, t + 2);
    BAR; WAIT_L(0); MMA(0, 1, At, B1); BAR;
    LDA(At, 0, 1); STAGE_A(SA(0, 0), 0, t + 2);
    BAR; WAIT_L(0); MMA(1, 0, At, B0); BAR; SCHED;
    STAGE_B(SB(0, 1), 1, t + 2);
    WAIT_V(6); BAR; MMA(1, 1, At, B1); BAR;
    LDB(B0, 1, 0); SCHED; LDA(At, 1, 0); STAGE_A(SA(0, 1), 1, t + 2);
    WAIT_L(8); BAR; WAIT_L(0); MMA(0, 0, At, B0); BAR; SCHED;
    LDB(B1, 1, 1); STAGE_B(SB(1, 0), 0, t + 3);
    BAR; WAIT_L(0); MMA(0, 1, At, B1); BAR;
    LDA(At, 1, 1); STAGE_A(SA(1, 0), 0, t + 3);
    BAR; WAIT_L(0); MMA(1, 0, At, B0); BAR; SCHED;
    STAGE_B(SB(1, 1), 1, t + 3);
    WAIT_V(6); BAR; MMA(1, 1, At, B1); BAR;
  }
  { LDB(B0, 0, 0); LDA(At, 0, 0); STAGE_A(SA(1, 1), 1, nt - 1);
    BAR; WAIT_L(0); MMA(0, 0, At, B0); BAR;
    LDB(B1, 0, 1); BAR; WAIT_L(0); MMA(0, 1, At, B1); BAR;
    LDA(At, 0, 1); WAIT_V(4); BAR; WAIT_L(0); MMA(1, 0, At, B0); MMA(1, 1, At, B1); BAR; }
  { LDB(B0, 1, 0); LDA(At, 1, 0); WAIT_V(2); BAR; WAIT_L(0); MMA(0, 0, At, B0); BAR;
    LDB(B1, 1, 1); WAIT_V(0); BAR; WAIT_L(0); MMA(0, 1, At, B1); BAR;
    LDA(At, 1, 1); BAR; WAIT_L(0); MMA(1, 0, At, B0); MMA(1, 1, At, B1); BAR; }
  if (wr == 0) BAR;
  BAR;
#undef SA
#undef SB
#undef STAGE_A
#undef STAGE_B
#undef LDA
#undef LDB
#undef MMA
#undef WAIT_V
#undef WAIT_L
#undef BAR
#undef SCHED
}

struct TileIt {
  int TN, npc, npatch, slot, nslot, pid, s, tm, tn;
  __device__ __forceinline__ void init(int TN_) { TN = TN_; npc = (TN + 1) >> 1; npatch = 8 * npc; slot = blockIdx.x >> 3; nslot = gridDim.x >> 3; pid = blockIdx.x & 7; s = slot - nslot; }
  __device__ __forceinline__ bool next() {
    for (;;) {
      s += nslot;
      if (s >= 32) { s = slot; pid += 8; }
      if (pid >= npatch) return false;
      const int pr = pid / npc, pc = pid - pr * npc;
      tm = pr * 16 + (s & 15); tn = pc * 2 + (s >> 4);
      if (tn < TN) return true;
    }
  }
};

#define GEMM_LANE const int tid_ = TIDX, lane_ = tid_ & 63, wid_ = tid_ >> 6, wr = wid_ >> 2, wc = wid_ & 3, fr = lane_ & 15, fq = lane_ >> 4
#define GEMM_EPI_LOOP _Pragma("unroll") for (int ai = 0; ai < 2; ++ai) _Pragma("unroll") for (int m = 0; m < 4; ++m) _Pragma("unroll") for (int bj = 0; bj < 2; ++bj)

template <class Epi> __device__ __forceinline__ void gemm_phase(const bf16_t* A, int lda, const bf16_t* Bt, int ldb, int K, int TN, char* lds, Epi&& epi) {
  TileIt it; it.init(TN);
  bool have = it.next();
  f32x4 acc[2][2][4][2];
  if (have) gemm_core<true, false>(acc, A + (size_t)it.tm * 256 * lda, lda, Bt + (size_t)it.tn * 256 * ldb, ldb, K, lds);
  while (have) {
    const int tm = it.tm, tn = it.tn;
#pragma unroll
    for (int i0 = 0; i0 < 2; ++i0)
#pragma unroll
      for (int i1 = 0; i1 < 2; ++i1)
#pragma unroll
        for (int i2 = 0; i2 < 4; ++i2)
#pragma unroll
          for (int i3 = 0; i3 < 2; ++i3) acc[i0][i1][i2][i3] = zero4();
    gemm_core<false, true>(acc, A + (size_t)tm * 256 * lda, lda, Bt + (size_t)tn * 256 * ldb, ldb, K, lds);
    have = it.next();
    if (have) { f32x4 dummy[2][2][4][2]; gemm_core<true, false>(dummy, A + (size_t)it.tm * 256 * lda, lda, Bt + (size_t)it.tn * 256 * ldb, ldb, K, lds); }
    epi(acc, tm, tn);
  }
  asm volatile("s_waitcnt vmcnt(0)" ::: "memory");
}

__device__ __forceinline__ void gemm_up_phase(const bf16_t* a, const bf16_t* wgu, bf16_t* act, char* lds) {
  gemm_phase(a, 1024, wgu, 1024, 1024, NGU / 256, lds, [&](f32x4 (&acc)[2][2][4][2], int tm, int tn) {
    GEMM_LANE;
    GEMM_EPI_LOOP {
      const int row = tm * 256 + ai * 128 + wr * 64 + m * 16 + fr;
      const int col = tn * 128 + bj * 64 + wc * 16 + 4 * fq;
      const f32x4 g = acc[ai][bj][m][0], u = acc[ai][bj][m][1];
      u32x2 o; o.x = pk2(silu_f(g[0]) * u[0], silu_f(g[1]) * u[1]); o.y = pk2(silu_f(g[2]) * u[2], silu_f(g[3]) * u[3]);
      *(u32x2*)(act + (size_t)row * DFF + col) = o;
    }
  });
}

__device__ __forceinline__ void gemm_bf16_phase(const bf16_t* A, int lda, const bf16_t* Bt, int K, int TN, bf16_t* out, int ldo, char* lds) {
  gemm_phase(A, lda, Bt, K, K, TN, lds, [&](f32x4 (&acc)[2][2][4][2], int tm, int tn) {
    GEMM_LANE;
    GEMM_EPI_LOOP {
      const int row = tm * 256 + ai * 128 + wr * 64 + m * 16 + fr;
#pragma unroll
      for (int n = 0; n < 2; ++n) {
        u32x2 o; o.x = pk2(acc[ai][bj][m][n][0], acc[ai][bj][m][n][1]); o.y = pk2(acc[ai][bj][m][n][2], acc[ai][bj][m][n][3]);
        *(u32x2*)(out + (size_t)row * ldo + tn * 256 + bj * 128 + wc * 32 + n * 16 + 4 * fq) = o;
      }
    }
  });
}

__device__ __forceinline__ void gemm_ple_phase(const bf16_t* a, const bf16_t* wpg, const bf16_t* pp, bf16_t* out, char* lds) {
  gemm_phase(a, 1024, wpg, 1024, 1024, 4, lds, [&](f32x4 (&acc)[2][2][4][2], int tm, int tn) {
    GEMM_LANE;
    GEMM_EPI_LOOP {
      const int row = tm * 256 + ai * 128 + wr * 64 + m * 16 + fr;
#pragma unroll
      for (int n = 0; n < 2; ++n) {
        const int col = tn * 256 + bj * 128 + wc * 32 + n * 16 + 4 * fq;
        const u32x2 pv = *(const u32x2*)(pp + (size_t)row * 1024 + col);
        const f32x4 av = acc[ai][bj][m][n];
        u32x2 o;
        o.x = pk2(sigm(av[0]) * __uint_as_float(pv.x << 16), sigm(av[1]) * __uint_as_float(pv.x & 0xffff0000u));
        o.y = pk2(sigm(av[2]) * __uint_as_float(pv.y << 16), sigm(av[3]) * __uint_as_float(pv.y & 0xffff0000u));
        *(u32x2*)(out + (size_t)row * 1024 + col) = o;
      }
    }
  });
}

__device__ __forceinline__ void mixA_item(const Params& P, int layer, int idx, const bf16_t* z, bf16_t* y, char* lds) {
  const int g = idx & 3, bc = idx >> 2, tok0 = bc * 128;
  const int tid = HTID, lane = tid & 63, w = tid >> 6, fr = lane & 15, fq = lane >> 4;
  bf16_t* vT = (bf16_t*)lds;
  const float* ng = P.sgu_ng + layer * 256;
  {
    const int s = tid >> 1, half = tid & 1;
    const bf16_t* zr = z + (size_t)(tok0 + s) * LDZ + ZC_AV;
    float ss = 0.f;
#pragma unroll 4
    for (int i = 0; i < 16; ++i) { float v[8]; unpack8(*(const u32x4*)(zr + half * 128 + i * 8), v);
#pragma unroll
      for (int e = 0; e < 8; ++e) { const float t = gelu_t(v[e]); ss += t * t; } }
    ss += __shfl_xor(ss, 1);
    const float rs = rsqrtf(ss * (1.f / 256.f) + 1e-6f);
#pragma unroll
    for (int i = 0; i < 4; ++i) { float v[8]; unpack8(*(const u32x4*)(zr + g * 64 + half * 32 + i * 8), v);
#pragma unroll
      for (int e = 0; e < 8; ++e) { const int d = half * 32 + i * 8 + e; vT[d * 136 + s] = f2bf(gelu_t(v[e]) * rs * ng[g * 64 + d]); } }
  }
  __syncthreads();
  const bf16_t* W = (const bf16_t*)(P.ws + OFF_SGUW) + (size_t)((layer * 4 + g) * 128) * 128;
  f32x4 acc[2][4] = {};
  for (int ks = 0; ks <= w; ++ks) {
    bf16x8 wf[2], vf[4];
#pragma unroll
    for (int tm = 0; tm < 2; ++tm) wf[tm] = *(const bf16x8*)(W + (size_t)(32 * w + tm * 16 + fr) * 128 + ks * 32 + 8 * fq);
#pragma unroll
    for (int dn = 0; dn < 4; ++dn) vf[dn] = *(const bf16x8*)(vT + (dn * 16 + fr) * 136 + ks * 32 + 8 * fq);
#pragma unroll
    for (int tm = 0; tm < 2; ++tm)
#pragma unroll
      for (int dn = 0; dn < 4; ++dn) acc[tm][dn] = mfma16(vf[dn], wf[tm], acc[tm][dn]);
  }
#pragma unroll
  for (int tm = 0; tm < 2; ++tm) {
    const int t = 32 * w + tm * 16 + fr;
    const float bias = P.sgu_b[(layer * 4 + g) * 128 + t];
#pragma unroll
    for (int dn = 0; dn < 4; ++dn) {
      const int d = dn * 16 + 4 * fq;
      const uint2 uu = *(const uint2*)(z + (size_t)(tok0 + t) * LDZ + ZC_AU + g * 64 + d);
      const float u0 = gelu_t(__uint_as_float(uu.x << 16)), u1 = gelu_t(__uint_as_float(uu.x & 0xffff0000u)),
                  u2 = gelu_t(__uint_as_float(uu.y << 16)), u3 = gelu_t(__uint_as_float(uu.y & 0xffff0000u));
      uint2 o; o.x = pk2(u0 * (acc[tm][dn][0] + bias), u1 * (acc[tm][dn][1] + bias)); o.y = pk2(u2 * (acc[tm][dn][2] + bias), u3 * (acc[tm][dn][3] + bias));
      *(uint2*)(y + (size_t)(tok0 + t) * 1024 + g * 64 + d) = o;
    }
  }
  __syncthreads();
}

__device__ __forceinline__ void mixB1_item(const Params& P, int layer, int idx, const bf16_t* z, float* hsl, float* Pc, float* carryP, float* carryH, char* lds) {
  const int c = idx & 63, g = (idx >> 6) & 3, b = idx >> 8;
  const int tid = HTID, lane = tid & 63, w = tid >> 6, fr = lane & 15, fq = lane >> 4;
  bf16_t* xcb = (bf16_t*)lds;
  float* xcf = (float*)(lds + 9216);
  float* aA = (float*)(lds + 9216 + 16640);
  float* bB = (float*)(lds + 9216 + 2 * 16640);
  float* sm = (float*)(lds + 9216 + 3 * 16640);
  const size_t tokb = (size_t)b * SEQ;
  {
    const int t = tid >> 2, q = tid & 3;
    float accv[16];
#pragma unroll
    for (int i = 0; i < 16; ++i) accv[i] = P.conv_b[layer * 256 + g * 64 + q * 16 + i];
#pragma unroll
    for (int k = 0; k < 4; ++k) {
      const int pos = c * 64 + t - 3 + k;
      if (pos >= 0) {
        const bf16_t* zr = z + (tokb + pos) * LDZ + ZC_BX + g * 64 + q * 16;
        float v[16]; unpack8(*(const u32x4*)zr, v); unpack8(*(const u32x4*)(zr + 8), v + 8);
        const float* cw = P.conv_w + (size_t)(layer * 4 + k) * 256 + g * 64 + q * 16;
#pragma unroll
        for (int i = 0; i < 16; ++i) accv[i] += v[i] * cw[i];
      }
    }
#pragma unroll
    for (int i = 0; i < 16; ++i) { xcf[t * 65 + q * 16 + i] = accv[i]; xcb[t * 72 + q * 16 + i] = f2bf(accv[i]); }
  }
  __syncthreads();
  {
    const bf16_t* wa = (const bf16_t*)(P.ws + OFF_WAT) + (layer * 4 + g) * 4096;
    const bf16_t* wx = (const bf16_t*)(P.ws + OFF_WXT) + (layer * 4 + g) * 4096;
    f32x4 ar[4] = {}, ai[4] = {};
#pragma unroll
    for (int ks = 0; ks < 2; ++ks) {
      const bf16x8 xf = *(const bf16x8*)(xcb + (16 * w + fr) * 72 + ks * 32 + 8 * fq);
#pragma unroll
      for (int jn = 0; jn < 4; ++jn) {
        const bf16x8 fa = *(const bf16x8*)(wa + (jn * 16 + fr) * 64 + ks * 32 + 8 * fq);
        const bf16x8 fx = *(const bf16x8*)(wx + (jn * 16 + fr) * 64 + ks * 32 + 8 * fq);
        ar[jn] = mfma16(fa, xf, ar[jn]); ai[jn] = mfma16(fx, xf, ai[jn]);
      }
    }
    const int t = 16 * w + fr;
#pragma unroll
    for (int jn = 0; jn < 4; ++jn)
#pragma unroll
      for (int e = 0; e < 4; ++e) {
        const int j = jn * 16 + 4 * fq + e, ch = layer * 256 + g * 64 + j;
        const float r = sigm(ar[jn][e] + P.lru_ba[ch]), ig = sigm(ai[jn][e] + P.lru_bx[ch]);
        const float lam = P.lru_lam[ch];
        const float xe = __expf(-lam);
        float m8; asm volatile("v_mov_b32 %0, 0xc1000000" : "=v"(m8));
        const float la = m8 * r * (xe * (1.f - xe * (0.5f - xe * (1.f / 3.f))));
        const float av = __expf(la);
        const float y2 = 2.f * la;
        const float om = -y2 * (1.f + y2 * (0.5f + y2 * ((1.f / 6.f) + y2 * ((1.f / 24.f) + y2 * ((1.f / 120.f) + y2 * (1.f / 720.f))))));
        const float bv = sqrtf(om) * (ig * xcf[t * 65 + j]);
        aA[t * 65 + j] = av; bB[t * 65 + j] = bv;
      }
  }
  __syncthreads();
  {
    const int q = tid >> 6, j = tid & 63;
    float Pq = 1.f, hq = 0.f;
#pragma unroll
    for (int i = 0; i < 16; ++i) { const int t = q * 16 + i; const float av = aA[t * 65 + j], bv = bB[t * 65 + j]; hq = av * hq + bv; Pq *= av; aA[t * 65 + j] = Pq; bB[t * 65 + j] = hq; }
    sm[q * 64 + j] = Pq; sm[256 + q * 64 + j] = hq;
    __syncthreads();
    float Pin = 1.f, Hin = 0.f;
    for (int qq = 0; qq < q; ++qq) { const float pp = sm[qq * 64 + j], hh = sm[256 + qq * 64 + j]; Hin = pp * Hin + hh; Pin *= pp; }
    float hl = 0.f, pl = 1.f;
#pragma unroll
    for (int i = 0; i < 16; ++i) { const int t = q * 16 + i; hl = bB[t * 65 + j] + aA[t * 65 + j] * Hin; pl = aA[t * 65 + j] * Pin;
      const size_t o = (tokb + c * 64 + t) * 256 + g * 64 + j; hsl[o] = hl; Pc[o] = pl; }
    if (q == 3) { const int o = ((b * 4 + g) * 64 + c) * 64 + j; carryP[o] = pl; carryH[o] = hl; }
  }
  __syncthreads();
}

__device__ __forceinline__ void mixB2_item(int idx, const bf16_t* z, const float* hsl, const float* Pc, const float* carryP, const float* carryH, bf16_t* y) {
  const int c = idx & 63, g = (idx >> 6) & 3, b = idx >> 8;
  const int q = HTID >> 6, j = HTID & 63;
  const float* cp = carryP + (size_t)((b * 4 + g) * 64) * 64 + j;
  const float* chh = carryH + (size_t)((b * 4 + g) * 64) * 64 + j;
  float H = 0.f;
  for (int c0 = 0; c0 < c; c0 += 8) {
    float pv[8], hv[8];
#pragma unroll
    for (int i = 0; i < 8; ++i) { const bool ok = c0 + i < c; pv[i] = ok ? cp[(c0 + i) * 64] : 1.f; hv[i] = ok ? chh[(c0 + i) * 64] : 0.f; }
#pragma unroll
    for (int i = 0; i < 8; ++i) H = pv[i] * H + hv[i];
  }
  const size_t tokb = (size_t)b * SEQ + c * 64 + q * 16;
#pragma unroll 4
  for (int i = 0; i < 16; ++i) {
    const size_t o = (tokb + i) * 256 + g * 64 + j;
    const float h = hsl[o] + Pc[o] * H;
    const float gt = bf2f(z[(tokb + i) * LDZ + ZC_BG + g * 64 + j]);
    y[(tokb + i) * 1024 + 256 + g * 64 + j] = f2bf(h * gelu_t(gt));
  }
}

__device__ __forceinline__ void compress_item(const Params& P, int layer, int idx, const bf16_t* z, bf16_t* kcv, char* lds) {
  const int nb = idx & 15, g = (idx >> 4) & 1, b = (idx >> 5) & 7, kv = idx >> 8;
  const int tid = HTID, lane = tid & 63, w = tid >> 6, fr = lane & 15, fq = lane >> 4;
  const int n0 = nb * 16, col = (kv ? ZC_VC : ZC_KC) + g * 64;
  const bf16_t* w1t = (const bf16_t*)(P.ws + OFF_CW1 + (size_t)(layer * 2 + kv) * SZ_CW1);
  float* part = (float*)lds;
  float* hid = (float*)(lds + 34816);
  f32x4 acc[8];
#pragma unroll
  for (int jf = 0; jf < 8; ++jf) acc[jf] = zero4();
  int nn = n0 + fr; if (nn > 254) nn = 254;
  const bf16_t* zb = z + ((size_t)b * SEQ + 16 * nn) * LDZ + col + 8 * fq;
  const bf16_t* wb = w1t + (size_t)fr * 2048 + 8 * fq;
#pragma unroll 4
  for (int kk = 0; kk < 16; ++kk) {
    const int ks = 16 * w + kk, l = ks >> 1, d0 = (ks & 1) * 32;
    const bf16x8 xf = *(const bf16x8*)(zb + (size_t)l * LDZ + d0);
#pragma unroll
    for (int jf = 0; jf < 8; ++jf) { const bf16x8 wf = *(const bf16x8*)(wb + (size_t)jf * 16 * 2048 + ks * 32); acc[jf] = mfma16(wf, xf, acc[jf]); }
  }
#pragma unroll
  for (int jf = 0; jf < 8; ++jf)
#pragma unroll
    for (int e = 0; e < 4; ++e) part[(w * 16 + fr) * 132 + jf * 16 + 4 * fq + e] = acc[jf][e];
  __syncthreads();
  const float* cb1 = (const float*)(P.ws + OFF_CB1) + (layer * 2 + kv) * 128;
  {
    const int n = tid >> 4, j0 = (tid & 15) * 8;
#pragma unroll
    for (int e = 0; e < 8; ++e) { const int j = j0 + e; const float v = ((part[(0 * 16 + n) * 132 + j] + part[(1 * 16 + n) * 132 + j]) + part[(2 * 16 + n) * 132 + j]) + part[(3 * 16 + n) * 132 + j];
      hid[n * 129 + j] = gelu_t(v + cb1[j]); }
  }
  __syncthreads();
  {
    const int n = tid >> 4, d0 = (tid & 15) * 4;
    const float* w2 = P.cmp_w2 + (size_t)(layer * 2 + kv) * 128 * 64 + d0;
    const float4 bb = *(const float4*)(P.cmp_b2 + (layer * 2 + kv) * 64 + d0);
    float o0 = bb.x, o1 = bb.y, o2 = bb.z, o3 = bb.w;
#pragma unroll 8
    for (int j = 0; j < 128; ++j) { const float hv = hid[n * 129 + j]; const float4 wa = *(const float4*)(w2 + j * 64); o0 += hv * wa.x; o1 += hv * wa.y; o2 += hv * wa.z; o3 += hv * wa.w; }
    u32x2 ov; ov.x = pk2(o0, o1); ov.y = pk2(o2, o3);
    if ((n0 + n) >= 255) { ov.x = 0u; ov.y = 0u; }
    *(u32x2*)(kcv + ((size_t)((kv * 8 + b) * 2 + g) * 256 + n0 + n) * 64 + d0) = ov;
  }
  __syncthreads();
}

constexpr int NSA_KT = 0, NSA_VT = 16384, NSA_T = 33792, NSA_TW = NSA_T + 4 * 4160 * 4, NSA_IMP = NSA_TW + 4 * 640 * 4, NSA_WU = NSA_IMP + 2 * 16640;
constexpr int LDS_ST = 147456;
constexpr float LOG2E = 1.4426950408889634f;

__device__ __forceinline__ void nsa_tables(const Params& P, int g, char* lds) {
  float* T = (float*)(lds + NSA_T);
  float* TW = (float*)(lds + NSA_TW);
  const int tid = TIDX;
  float* rbs = (float*)(lds + NSA_KT);
  if (tid < 128) rbs[tid] = P.rel_bias[(tid >> 2) * 8 + g * 4 + (tid & 3)] * LOG2E;
  __syncthreads();
  for (int i = tid; i < 4160; i += 512) {
    const int n = i - 64;
    int bk = n;
    if (n >= 16) bk = 16 + (n >= 21) + (n >= 27) + (n >= 35) + (n >= 46) + (n >= 59) + (n >= 77) + (n >= 99) + (n >= 128) + (n >= 166) + (n >= 216) + (n >= 280) + (n >= 363) + (n >= 470) + (n >= 609) + (n >= 790);
#pragma unroll
    for (int r = 0; r < 4; ++r) {
      const float v = n >= 0 ? rbs[bk * 4 + r] : -__builtin_inff();
      T[r * 4160 + i] = v;
      if (i < 640) TW[r * 640 + i] = (n < 512) ? v : -__builtin_inff();
    }
  }
  __syncthreads();
}

struct KVRegs { u32x4 k0, v0; };
__device__ __forceinline__ void kv_gload(KVRegs& r, const bf16_t* kb, const bf16_t* vb, size_t stride) {
  const int tid = TIDX, row = tid >> 3, cq = tid & 7;
  r.k0 = *(const u32x4*)(kb + row * stride + cq * 8); r.v0 = *(const u32x4*)(vb + row * stride + cq * 8);
}
__device__ __forceinline__ void kv_lwrite(const KVRegs& r, char* lds, int buf) {
  const int tid = TIDX, row = tid >> 3, cq = tid & 7;
  char* kt = lds + NSA_KT + buf * 8192 + row * 128;
  *(u32x4*)(kt + ((cq ^ (row & 7)) << 4)) = r.k0;
  bf16_t* vt = (bf16_t*)(lds + NSA_VT + buf * 8704) + (cq * 8) * 68 + row;
#pragma unroll
  for (int i = 0; i < 4; ++i) { vt[(2 * i) * 68] = (bf16_t)(r.v0[i] & 0xffffu); vt[(2 * i + 1) * 68] = (bf16_t)(r.v0[i] >> 16); }
}

template <int MODE>
__device__ __forceinline__ void nsa_compute(int cur, int buf, int t, int hl, u64 mymask, const bf16x8 (&Qf)[2][2], f32x4 (&O)[4][2], float (&m)[2], float (&l)[2],
                                            const float (&inv)[2], float* impw, char* lds) {
  const int lane = TIDX & 63, fr = lane & 15, fq = lane >> 4;
  const char* kt = lds + NSA_KT + buf * 8192;
  const bf16_t* vt = (const bf16_t*)(lds + NSA_VT + buf * 8704);
  const bool selok = (MODE == 2) ? (((mymask >> cur) & 1ull) != 0ull) : true;
  const float* tb = (MODE == 3) ? (const float*)(lds + NSA_TW) + hl * 640 : (const float*)(lds + NSA_T) + hl * 4160;
  constexpr int TS = (MODE == 3) ? 640 : 4160;
  const int base = (MODE <= 1) ? (t - 31 - 16 * (cur * 64 + 4 * fq) + 64) : (t - cur * 64 - 4 * fq + 64);
#pragma unroll
  for (int s2 = 0; s2 < 2; ++s2) {
    f32x4 S[2][2] = {};
    bf16x8 kfr[2][2];
#pragma unroll
    for (int ks = 0; ks < 2; ++ks)
#pragma unroll
      for (int kk = 0; kk < 2; ++kk) kfr[ks][kk] = *(const bf16x8*)(kt + (32 * s2 + 16 * kk + fr) * 128 + (((ks * 4 + fq) ^ (fr & 7)) << 4));
    __builtin_amdgcn_s_setprio(1);
#pragma unroll
    for (int ks = 0; ks < 2; ++ks)
#pragma unroll
      for (int kk = 0; kk < 2; ++kk)
#pragma unroll
        for (int r = 0; r < 2; ++r) S[kk][r] = mfma16(kfr[ks][kk], Qf[r][ks], S[kk][r]);
    __builtin_amdgcn_s_setprio(0);
    bf16x8 Pf[2];
    float g1s[2] = {0.f, 0.f}, p3s[2] = {0.f, 0.f};
#pragma unroll
    for (int r = 0; r < 2; ++r) {
      float sv[2][4];
#pragma unroll
      for (int kk = 0; kk < 2; ++kk)
#pragma unroll
        for (int e = 0; e < 4; ++e) {
          const int off = 32 * s2 + 16 * kk + e;
          int idx;
          if (MODE <= 1) { idx = base - 16 * off; idx = idx > 0 ? idx : 0; } else idx = base - off;
          sv[kk][e] = S[kk][r][e] * (0.125f * LOG2E) + tb[r * TS + idx];
        }
      float pv[2][4];
      if (MODE == 1) {
#pragma unroll
        for (int kk = 0; kk < 2; ++kk)
#pragma unroll
          for (int e = 0; e < 4; ++e) pv[kk][e] = __builtin_amdgcn_exp2f(sv[kk][e] - m[r]) * inv[r];
#pragma unroll
        for (int kk = 0; kk < 2; ++kk) { g1s[kk] += pv[kk][0] + pv[kk][1] + pv[kk][2] + 0.5f * pv[kk][3]; p3s[kk] += 0.5f * pv[kk][3]; }
      } else {
        const float mxa = fmaxf(fmaxf(sv[0][0], sv[0][1]), sv[0][2]), mxb = fmaxf(fmaxf(sv[0][3], sv[1][0]), sv[1][1]);
        float mx = fmaxf(fmaxf(fmaxf(sv[1][2], sv[1][3]), mxa), mxb);
        if (MODE == 2) mx = selok ? mx : -__builtin_inff();
        if (__any(mx > m[r] + 8.0f)) {
          mx = fmaxf(mx, __shfl_xor(mx, 16)); mx = fmaxf(mx, __shfl_xor(mx, 32));
          const float mn = fmaxf(m[r], mx), al = __builtin_amdgcn_exp2f(m[r] - mn);
          m[r] = mn; l[r] *= al;
          if (MODE != 0) {
#pragma unroll
            for (int df = 0; df < 4; ++df) O[df][r] *= al;
          }
        }
        const float me = (MODE == 2) ? (selok ? m[r] : __builtin_inff()) : m[r];
        float ps = 0.f;
#pragma unroll
        for (int kk = 0; kk < 2; ++kk)
#pragma unroll
          for (int e = 0; e < 4; ++e) { pv[kk][e] = __builtin_amdgcn_exp2f(sv[kk][e] - me); ps += pv[kk][e]; }
        l[r] += ps;
      }
      if (MODE != 0) {
        const unsigned w0 = pk2(pv[0][0], pv[0][1]), w1 = pk2(pv[0][2], pv[0][3]), w2 = pk2(pv[1][0], pv[1][1]), w3 = pk2(pv[1][2], pv[1][3]);
        u32x4 pw; pw.x = w0; pw.y = w1; pw.z = w2; pw.w = w3;
        Pf[r] = __builtin_bit_cast(bf16x8, pw);
      }
    }
    if (MODE != 0) {
      bf16x8 vfr[4];
#pragma unroll
      for (int df = 0; df < 4; ++df) {
        const bf16x4 va = *(const bf16x4*)(vt + (df * 16 + fr) * 68 + 32 * s2 + 4 * fq);
        const bf16x4 vb = *(const bf16x4*)(vt + (df * 16 + fr) * 68 + 32 * s2 + 16 + 4 * fq);
        bf16x8 vf; vf[0] = va[0]; vf[1] = va[1]; vf[2] = va[2]; vf[3] = va[3]; vf[4] = vb[0]; vf[5] = vb[1]; vf[6] = vb[2]; vf[7] = vb[3];
        vfr[df] = vf;
      }
      __builtin_amdgcn_s_setprio(1);
#pragma unroll
      for (int df = 0; df < 4; ++df)
#pragma unroll
        for (int r = 0; r < 2; ++r) O[df][r] = mfma16(vfr[df], Pf[r], O[df][r]);
      __builtin_amdgcn_s_setprio(0);
    }
    if (MODE == 1) {
#pragma unroll
      for (int kk = 0; kk < 2; ++kk) {
        const int j = cur * 16 + (2 * s2 + kk) * 4 + fq;
        atomicAdd(&impw[fr * 65 + j], g1s[kk]);
        if (j + 1 < 64) atomicAdd(&impw[fr * 65 + j + 1], p3s[kk]);
      }
    }
  }
}

template <int MODE>
__device__ __forceinline__ void nsa_branch(int first, int ntl, u64 U, const bf16_t* kbase, const bf16_t* vbase, size_t stride, int t, int hl, u64 mymask,
                                           const bf16x8 (&Qf)[2][2], f32x4 (&O)[4][2], float (&m)[2], float (&l)[2], const float (&inv)[2], float* impw, char* lds) {
  KVRegs R0, R1, R2;
  u64 rem = U;
  int seq = first, left = ntl;
#define NSA_NEXT(dst)                                                                                     \
  { if (MODE == 2) { dst = rem ? (int)__builtin_ctzll(rem) : -1; if (rem) rem &= rem - 1; }              \
    else { dst = left > 0 ? seq : -1; ++seq; --left; } }
#define NSA_GLOAD(R, ti) kv_gload(R, kbase + (size_t)(ti) * 64 * stride, vbase + (size_t)(ti) * 64 * stride, stride)
  int tcur, t1, t2, t3;
  NSA_NEXT(tcur); NSA_NEXT(t1); NSA_NEXT(t2);
  if (tcur >= 0) NSA_GLOAD(R0, tcur);
  if (t1 >= 0) NSA_GLOAD(R1, t1);
  if (t2 >= 0) NSA_GLOAD(R2, t2);
  if (tcur >= 0) kv_lwrite(R0, lds, 0);
  __syncthreads();
  NSA_NEXT(t3);
  if (t3 >= 0) NSA_GLOAD(R0, t3);
  int buf = 0;
#define NSA_STEP(RW)                                                                                      \
  if (tcur < 0) break;                                                                                    \
  nsa_compute<MODE>(tcur, buf, t, hl, mymask, Qf, O, m, l, inv, impw, lds);                               \
  if (t1 >= 0) kv_lwrite(RW, lds, buf ^ 1);                                                               \
  __syncthreads();                                                                                        \
  buf ^= 1; tcur = t1; t1 = t2; t2 = t3;                                                                  \
  NSA_NEXT(t3);                                                                                           \
  if (t3 >= 0) NSA_GLOAD(RW, t3);
  for (;;) {
    NSA_STEP(R1)
    NSA_STEP(R2)
    NSA_STEP(R0)
  }
#undef NSA_STEP
#undef NSA_GLOAD
#undef NSA_NEXT
}

#define NSA_RESET()                                                                         \
  _Pragma("unroll") for (int r = 0; r < 2; ++r) { asm volatile("v_mov_b32 %0, 0xf149f2ca" : "=v"(m[r])); l[r] = 0.f; }               \
  _Pragma("unroll") for (int df = 0; df < 4; ++df) _Pragma("unroll") for (int r = 0; r < 2; ++r) O[df][r] = zero4();

__device__ __forceinline__ void nsa_item(const Params& P, int b, int g, int c, const bf16_t* z, const bf16_t* kcv, bf16_t* y, char* lds) {
  const int tid = TIDX, lane = tid & 63, w8 = tid >> 6, qg = w8 & 3, hp = w8 >> 2, fr = lane & 15, fq = lane >> 4;
  const size_t tokb = (size_t)b * SEQ;
  const int t = c * 64 + 16 * qg + fr;
  const bf16_t* zq = z + (tokb + t) * LDZ;
  const int hb = g * 4 + hp * 2;
  bf16x8 Qf[2][2];
#pragma unroll
  for (int r = 0; r < 2; ++r)
#pragma unroll
    for (int ks = 0; ks < 2; ++ks) Qf[r][ks] = *(const bf16x8*)(zq + ZC_Q + g * 256 + (hp * 2 + r) * 64 + ks * 32 + 8 * fq);
  float* impw = (float*)(lds + NSA_IMP) + (hp * 4 + qg) * (16 * 65);
  for (int i = lane; i < 16 * 65; i += 64) impw[i] = 0.f;
  f32x4 O[4][2];
  float m[2], l[2], inv[2];
  bf16_t* yo = y + (tokb + t) * 1024 + 512 + g * 256 + hp * 128 + 4 * fq;
  const bf16_t* kc = kcv + (size_t)((0 * 8 + b) * 2 + g) * 256 * 64;
  const bf16_t* vc = kcv + (size_t)((1 * 8 + b) * 2 + g) * 256 * 64;
  const int nct = ((4 * c + 2) >> 6) + 1;
  NSA_RESET();
  inv[0] = 0.f; inv[1] = 0.f;
  nsa_branch<0>(0, nct, 0ull, kc, vc, 64, t, hp * 2, 0ull, Qf, O, m, l, inv, impw, lds);
#pragma unroll
  for (int r = 0; r < 2; ++r) { float lt = l[r]; lt += __shfl_xor(lt, 16); lt += __shfl_xor(lt, 32); inv[r] = lt > 0.f ? 1.f / lt : 0.f; }
  nsa_branch<1>(0, nct, 0ull, kc, vc, 64, t, hp * 2, 0ull, Qf, O, m, l, inv, impw, lds);
#pragma unroll
  for (int r = 0; r < 2; ++r) {
    const float gt = sigm(bf2f(zq[ZC_GC + hb + r]));
#pragma unroll
    for (int df = 0; df < 4; ++df) { u32x2 o; o.x = pk2(O[df][r][0] * gt, O[df][r][1] * gt); o.y = pk2(O[df][r][2] * gt, O[df][r][3] * gt); *(u32x2*)(yo + r * 64 + df * 16) = o; }
  }
  __syncthreads();
  u64 wU = 0ull;
  {
    const float* imp0 = (const float*)(lds + NSA_IMP) + qg * (16 * 65);
    const float* imp1 = imp0 + 4 * (16 * 65);
    u64* MK = (u64*)(lds + NSA_WU) + 8;
    const u64 V = (c >= 63) ? ~0ull : ((1ull << (c + 1)) - 1ull);
    const bool forced = (lane == 0) | (lane == c) | (lane == c - 1);
    for (int q8 = 0; q8 < 8; ++q8) {
      const int qq = hp * 8 + q8;
      const float sv = imp0[qq * 65 + lane] + imp1[qq * 65 + lane];
      const unsigned u = __float_as_uint(forced ? 1e4f : sv);
      u64 mk = V;
      if (c + 1 > 16) {
        unsigned thr = 0u;
        for (int bb = 30; bb >= 0; --bb) { const unsigned cand = thr | (1u << bb); const u64 ge = __ballot(u >= cand) & V; if (__popcll(ge) >= 16) thr = cand; }
        const u64 G = __ballot(u > thr) & V, E = __ballot(u == thr) & V;
        const int need = 16 - (int)__popcll(G);
        const int below = (int)__popcll(E & ((1ull << lane) - 1ull));
        const bool se = (((E >> lane) & 1ull) != 0ull) && (below < need);
        mk = G | __ballot(se);
      }
      if (lane == 0) MK[qg * 16 + qq] = mk;
      wU |= mk;
    }
  }
  u64* WU = (u64*)(lds + NSA_WU);
  if (lane == 0) WU[w8] = wU;
  __syncthreads();
  const u64 U = WU[0] | WU[1] | WU[2] | WU[3] | WU[4] | WU[5] | WU[6] | WU[7];
  const u64 mymask = ((const u64*)(lds + NSA_WU) + 8)[qg * 16 + fr];
  for (int br = 0; br < 2; ++br) {
    NSA_RESET();
    int zg;
    if (br == 0) {
      nsa_branch<2>(0, 0, U, z + tokb * LDZ + ZC_KS + g * 64, z + tokb * LDZ + ZC_VS + g * 64, LDZ, t, hp * 2, mymask, Qf, O, m, l, inv, impw, lds);
      zg = ZC_GS;
    } else {
      const int kt0 = c > 8 ? c - 8 : 0;
      nsa_branch<3>(kt0, c - kt0 + 1, 0ull, z + tokb * LDZ + ZC_KW + g * 64, z + tokb * LDZ + ZC_VW + g * 64, LDZ, t, hp * 2, 0ull, Qf, O, m, l, inv, impw, lds);
      zg = ZC_GW;
    }
#pragma unroll
    for (int r = 0; r < 2; ++r) {
      float lt = l[r]; lt += __shfl_xor(lt, 16); lt += __shfl_xor(lt, 32);
      const float gt = sigm(bf2f(zq[zg + hb + r])) * (lt > 0.f ? 1.f / lt : 0.f);
#pragma unroll
      for (int df = 0; df < 4; ++df) {
        bf16_t* yp = yo + r * 64 + df * 16;
        const u32x2 pr = *(const u32x2*)yp;
        u32x2 o; o.x = pk2(__uint_as_float(pr.x << 16) + O[df][r][0] * gt, __uint_as_float(pr.x & 0xffff0000u) + O[df][r][1] * gt);
        o.y = pk2(__uint_as_float(pr.y << 16) + O[df][r][2] * gt, __uint_as_float(pr.y & 0xffff0000u) + O[df][r][3] * gt);
        *(u32x2*)yp = o;
      }
    }
  }
  __syncthreads();
}

__device__ __forceinline__ void run_phase(const Params& P, int ph, char* lds) {
  char* ws = P.ws;
  bf16_t* abuf = (bf16_t*)(ws + OFF_A);
  bf16_t* big = (bf16_t*)(ws + OFF_BIG);
  bf16_t* fbuf = (bf16_t*)(ws + OFF_F);
  bf16_t* h16 = (bf16_t*)(ws + OFF_F + (size_t)M_TOK * 1024 * 2);
  float* hsl = (float*)(ws + OFF_F); float* Pc = hsl + (size_t)M_TOK * 256;
  bf16_t* kcv = (bf16_t*)(ws + OFF_KC);
  float* carryP = (float*)(ws + OFF_CARRY); float* carryH = carryP + 8 * 4 * 64 * 64;
  if (ph == 0) { prep_phase(P, lds); return; }
  const int layer = (ph - 1) / 13, sp = (ph - 1) % 13;
  const float* ng = P.norm_g + (size_t)layer * 8 * 1024;
#ifdef ONLY_SP
  if (sp != ONLY_SP) return;
#endif
  switch (sp) {
    case 0: case 8: {
      const int lj = layer * 2 + (sp == 8);
      gemm_up_phase(abuf, (const bf16_t*)(ws + OFF_WGU + lj * SZ_WGU), big, lds);
    } break;
    case 1: case 9: {
      const int lj = layer * 2 + (sp == 9);
      gemm_bf16_phase(big, DFF, (const bf16_t*)(ws + OFF_WD + lj * SZ_WD), DFF, 4, fbuf, 1024, lds);
    } break;
    case 2: resnorm_phase(layer == 0 ? P.x : nullptr, h16, nullptr, h16, fbuf, 0.5f, ng + 1 * 1024, ng + 2 * 1024, abuf); break;
    case 3:
      if (layer == 0 && blockIdx.x < 4) {
        const int t3 = TIDX;
        if (t3 < 128) { const float* pp_ = (const float*)(ws + OFF_CB1P) + (size_t)blockIdx.x * 16 * 128 + t3; float t = P.cmp_b1[blockIdx.x * 128 + t3];
          for (int q = 0; q < 16; ++q) t += pp_[q * 128]; ((float*)(ws + OFF_CB1))[blockIdx.x * 128 + t3] = t; }
      }
      gemm_bf16_phase(abuf, 1024, (const bf16_t*)(ws + OFF_WIN + layer * SZ_WIN), 1024, LDZ / 256, big, LDZ, lds); break;
    case 4: {
      const int hb = HBLK; char* hl = lds + hb * 65536;
      for (int it = blockIdx.x * 2 + hb; it < 512; it += gridDim.x * 2) compress_item(P, layer, it, big, kcv, hl);
      for (int it = blockIdx.x * 2 + hb; it < 1024; it += gridDim.x * 2) mixA_item(P, layer, it, big, abuf, hl);
      for (int it = blockIdx.x * 2 + hb; it < 2048; it += gridDim.x * 2) mixB1_item(P, layer, it, big, hsl, Pc, carryP, carryH, hl);
    } break;
    case 5: {
      nsa_tables(P, blockIdx.x & 1, lds);
      for (int it = blockIdx.x; it < 1024; it += gridDim.x) {
        const int rnd = it / 256, pos = it % 256;
        const int c = (rnd & 1) ? (rnd >> 1) * 16 + (pos >> 4) : 63 - (rnd >> 1) * 16 - (pos >> 4);
        const int bg = pos & 15;
        nsa_item(P, bg >> 1, bg & 1, c, big, kcv, abuf, lds);
      }
      const int hb = HBLK;
      for (int it = blockIdx.x * 2 + hb; it < 2048; it += gridDim.x * 2) mixB2_item(it, big, hsl, Pc, carryP, carryH, abuf);
    } break;
    case 6: gemm_bf16_phase(abuf, 1024, (const bf16_t*)(ws + OFF_WOUT + layer * SZ_SQ), 1024, 4, fbuf, 1024, lds); break;
    case 7: resnorm_phase(nullptr, h16, nullptr, h16, fbuf, 1.0f, ng + 3 * 1024, ng + 4 * 1024, abuf); break;
    case 10:
      gemm_bf16_phase((const bf16_t*)(ws + OFF_PBF) + (size_t)layer * M_TOK * 256, 256, (const bf16_t*)(ws + OFF_WPP + layer * SZ_WPP), 256, 4, big, 1024, lds);
      resnorm_phase(nullptr, h16, nullptr, h16, fbuf, 0.5f, ng + 5 * 1024, ng + 6 * 1024, abuf);
      break;
    case 11: gemm_ple_phase(abuf, (const bf16_t*)(ws + OFF_WPG + layer * SZ_SQ), big, fbuf, lds); break;
    case 12: resnorm_phase(nullptr, h16, layer == 0 ? nullptr : P.out, layer == 0 ? h16 : nullptr, fbuf, 1.0f, ng + 7 * 1024, layer == 0 ? P.norm_g + 8 * 1024 : nullptr, layer == 0 ? abuf : nullptr); break;
  }
}

#define XB_TMO      128
#define XB_XCNT(j)  (256  + 64 * (j))
#define XB_XSUB(j)  (1280 + 64 * (j))
#define XB_XGEN(j)  (2304 + 64 * (j))
#define XB_TOP      3328
#define XB_TOPGEN   3392
#define XCD_BAR_WORDS 3456
#define XB_SPIN_CAP (1u << 20)
#define LAS __attribute__((address_space(3)))
__device__ __forceinline__ unsigned xb_ld(unsigned* p)              { return __hip_atomic_load(p, __ATOMIC_RELAXED, __HIP_MEMORY_SCOPE_AGENT); }
__device__ __forceinline__ unsigned xb_add(unsigned* p, unsigned v) { return __hip_atomic_fetch_add(p, v, __ATOMIC_RELAXED, __HIP_MEMORY_SCOPE_AGENT); }
__device__ __forceinline__ unsigned xb_xcc_id() { return (unsigned)__builtin_amdgcn_s_getreg((3 << 11) | 20) & 0xFu; }
#define XB_SPIN(cond, bar) do { unsigned _sp = 0; while (cond) { __builtin_amdgcn_s_sleep(1); \
    if ((++_sp & 255u) == 0u) { if (xb_ld(&(bar)[XB_TMO])) break; if (_sp > XB_SPIN_CAP) { atomicAdd(&(bar)[XB_TMO], 1u); break; } } } } while (0)
struct XcdBarrier { unsigned* bar; unsigned x; volatile LAS unsigned* st; };
__device__ __forceinline__ XcdBarrier xcd_barrier_post(unsigned* bar, volatile LAS unsigned* st) {
    XcdBarrier b; b.bar = bar; b.x = xb_xcc_id(); b.st = st;
    if (threadIdx.x == 0) (void)xb_add(&bar[XB_XCNT(b.x)], 1u);
    return b;
}
__device__ __forceinline__ void xcd_barrier_complete(unsigned* bar, unsigned x, unsigned& nloc, unsigned& nx) {
    const unsigned G = gridDim.x * gridDim.y * gridDim.z;
    unsigned sum, cnt, mine, sp = 0u;
    for (;;) {
        sum = 0u; cnt = 0u; mine = 0u;
#pragma unroll
        for (unsigned j = 0; j < 16; ++j) { const unsigned c = xb_ld(&bar[XB_XCNT(j)]); sum += c; cnt += (c > 0u) ? 1u : 0u; mine = (j == x) ? c : mine; }
        if (sum == G) break;
        __builtin_amdgcn_s_sleep(1);
        if ((++sp & 255u) == 0u) { if (xb_ld(&bar[XB_TMO])) break; if (sp > XB_SPIN_CAP) { atomicAdd(&bar[XB_TMO], 1u); break; } }
    }
    nloc = mine > 0u ? mine : 1u; nx = cnt > 0u ? cnt : 1u;
}
__device__ __forceinline__ void xcd_barrier(const XcdBarrier& b) {
    asm volatile("s_waitcnt vmcnt(0)" ::: "memory");
    __syncthreads();
    if (threadIdx.x == 0) {
        unsigned* bar = b.bar;
        __builtin_amdgcn_s_waitcnt(0);
        unsigned nloc = b.st[0], nx = b.st[1];
        if (nloc == 0u) { xcd_barrier_complete(bar, b.x, nloc, nx); b.st[0] = nloc; b.st[1] = nx; }
        const unsigned old = xb_add(&bar[XB_XSUB(b.x)], 1u);
        const unsigned gen = old / nloc;
        if (old + 1u == (gen + 1u) * nloc) {
            __builtin_amdgcn_fence(__ATOMIC_RELEASE, "agent");
            asm volatile("s_waitcnt vmcnt(0)" ::: "memory");
            const unsigned og = xb_add(&bar[XB_TOP], 1u);
            const unsigned tg = og / nx;
            if (og + 1u == (tg + 1u) * nx) xb_add(&bar[XB_TOPGEN], 1u);
            else XB_SPIN(xb_ld(&bar[XB_TOPGEN]) == tg, bar);
            __builtin_amdgcn_fence(__ATOMIC_ACQUIRE, "agent");
            xb_add(&bar[XB_XGEN(b.x)], 1u);
            asm volatile("s_waitcnt vmcnt(0)" ::: "memory");
        } else {
            XB_SPIN(xb_ld(&bar[XB_XGEN(b.x)]) == gen, bar);
            __builtin_amdgcn_fence(__ATOMIC_ACQUIRE, "agent");
            asm volatile("s_waitcnt vmcnt(0)" ::: "memory");
        }
    }
    __syncthreads();
}

constexpr int LDS_BYTES = LDS_ST + 16;
__global__ void __launch_bounds__(512, 2) fwd_megakernel(Params P) {
  __shared__ __attribute__((aligned(16))) char lds[LDS_BYTES];
  cg::grid_group grid = cg::this_grid();
  volatile LAS unsigned* st = (volatile LAS unsigned*)(lds + LDS_ST);
  if (threadIdx.x == 0) { st[0] = 0u; st[1] = 0u; }
  __syncthreads();
  XcdBarrier xb = xcd_barrier_post((unsigned*)(P.ws + OFF_BAR), st);
  if (P.ws == nullptr) grid.sync();
  for (int ph = 0; ph < NPHASE; ++ph) {
    run_phase(P, ph, lds);
    if (ph + 1 < NPHASE) xcd_barrier(xb);
  }
}

__global__ void __launch_bounds__(512, 2) phase_kernel(Params P, int ph) {
  __shared__ __attribute__((aligned(16))) char lds[LDS_BYTES];
  run_phase(P, ph, lds);
}

extern "C" void kernel_launch(void* const* d_in, const int* in_sizes, int n_in, void* d_out, int out_size, void* d_ws, size_t ws_size, hipStream_t stream) {
  Params P{};
  const float** pp = (const float**)&P;
  for (int i = 0; i < 26; ++i) pp[i] = (const float*)d_in[i];
  P.out = (float*)d_out;
  P.ws = (char*)d_ws;
  if (ws_size < WS_NEED) { fprintf(stderr, "workspace too small: %zu < %zu\n", ws_size, (size_t)WS_NEED); return; }
#if MK_FUSED
  static int grid_blocks = 0;
  if (!grid_blocks) {
    int dev = 0, cus = 0, per_cu = 0;
    (void)hipGetDevice(&dev);
    (void)hipDeviceGetAttribute(&cus, hipDeviceAttributeMultiprocessorCount, dev);
    (void)hipOccupancyMaxActiveBlocksPerMultiprocessor(&per_cu, fwd_megakernel, 512, 0);
    if (per_cu > 1) per_cu = 1;
    if (per_cu < 1) per_cu = 1;
    grid_blocks = cus * per_cu;
  }
  (void)hipMemsetAsync((char*)d_ws + OFF_BAR, 0, XCD_BAR_WORDS * 4, stream);
  void* args[] = {&P};
  hipError_t e = hipLaunchCooperativeKernel((void*)fwd_megakernel, dim3(grid_blocks), dim3(512), args, 0, stream);
  if (e != hipSuccess) fprintf(stderr, "cooperative launch failed: %s (grid %d)\n", hipGetErrorString(e), grid_blocks);
#else
  for (int ph = 0; ph < NPHASE; ++ph) phase_kernel<<<256, 512, 0, stream>>>(P, ph);
#endif
}
```
